# Optimizing an MI355X kernel written in HIP

```python
import math
import jax, jax.numpy as jnp
from jax import lax
import numpy as np


D_MODEL = 2048
BATCH = 16
SEQ = 2048
DEPTH = 2

HEAD_DIM = 128
A_HEADS = 4
IDX_HEADS = 16
IDX_DIM = 64
TOPK_MAX = 256
Q_BLOCK = 128
B_HEADS = 8
B_KV_HEADS = 2
WINDOW = 128
C_HEADS = 4
C_DK = 64
C_DV = 128
GATE_RANK = 16
GATE_NORM = 16.0
CHUNK = 64
N_BUCKETS = 32
MAX_DIST = 128
N_BIAS_HEADS = A_HEADS + B_HEADS
N_GROUPS = 8
EXP_PER_GROUP = 8
N_EXPERTS = N_GROUPS * EXP_PER_GROUP
TOP_K_EXP = 2
D_EXPERT = 512
MOE_BLOCK = 128
EPS = 1e-6

IN_SPLITS = (
    ('a_q', A_HEADS * HEAD_DIM), ('a_k', HEAD_DIM), ('a_v', HEAD_DIM),
    ('i_q', IDX_HEADS * IDX_DIM), ('i_k', IDX_DIM), ('i_w', IDX_HEADS),
    ('b_q', B_HEADS * HEAD_DIM), ('b_k', B_KV_HEADS * HEAD_DIM), ('b_v', B_KV_HEADS * HEAD_DIM),
    ('c_q', C_HEADS * C_DK), ('c_k', C_HEADS * C_DK), ('c_v', C_HEADS * C_DV),
    ('c_g', GATE_RANK), ('c_r', C_HEADS * C_DV),
    ('g_a', D_MODEL), ('g_b', D_MODEL), ('g_c', D_MODEL),
)
D_IN = sum(n for _, n in IN_SPLITS)

kernel_name = 'hybrid_dsa_swa_gla_hmoe'


def split_in(z):
    out = {}
    off = 0
    for name, n in IN_SPLITS:
        out[name] = z[..., off:off + n]
        off += n
    return out


def rms_norm(x, g):
    xf = x.astype(jnp.float32)
    y = xf * lax.rsqrt(jnp.mean(xf * xf, axis=-1, keepdims=True) + EPS)
    return (y * g.astype(jnp.float32)).astype(x.dtype)


def rel_bucket(dist):
    max_exact = N_BUCKETS // 2
    d = jnp.maximum(dist, 0)
    large = max_exact + (jnp.log(jnp.maximum(d, 1).astype(jnp.float32) / max_exact)
                         / math.log(MAX_DIST / max_exact) * (N_BUCKETS - max_exact)).astype(jnp.int32)
    large = jnp.minimum(large, N_BUCKETS - 1)
    return jnp.where(d < max_exact, d, large)


def dsa_attention(q, k, v, iq, ik, iw, bias_tab, n_keep):
    B, S, H, dh = q.shape
    nb = S // Q_BLOCK
    scale = dh ** -0.5
    iscale = (IDX_HEADS ** -0.5) * (IDX_DIM ** -0.5)
    s_pos = jnp.arange(S)
    take = jax.vmap(lambda a, i: a[i])

    def block(i):
        t0 = i * Q_BLOCK
        t = t0 + jnp.arange(Q_BLOCK)
        q_b = lax.dynamic_slice_in_dim(q, t0, Q_BLOCK, axis=1)
        iq_b = lax.dynamic_slice_in_dim(iq, t0, Q_BLOCK, axis=1)
        iw_b = lax.dynamic_slice_in_dim(iw, t0, Q_BLOCK, axis=1)
        rel = jax.nn.relu(jnp.einsum('bqhd,bsd->bqsh', iq_b, ik).astype(jnp.float32))
        score = jnp.einsum('bqsh,bqh->bqs', rel, iw_b.astype(jnp.float32)) * iscale
        score = jnp.where(s_pos[None, None, :] <= t[None, :, None], score, -jnp.inf)
        _, sel = lax.top_k(score, n_keep)
        valid = sel <= t[None, :, None]
        k_sel = take(k, sel)
        v_sel = take(v, sel)
        logits = jnp.einsum('bqhd,bqkd->bhqk', q_b, k_sel).astype(jnp.float32) * scale
        bias = bias_tab[rel_bucket(t[None, :, None] - sel)]
        logits = logits + bias.transpose(0, 3, 1, 2)
        logits = jnp.where(valid[:, None], logits, -jnp.inf)
        w = jax.nn.softmax(logits, axis=-1)
        return jnp.einsum('bhqk,bqkd->bqhd', w.astype(v.dtype), v_sel)

    out = lax.map(block, jnp.arange(nb))
    return out.transpose(1, 0, 2, 3, 4).reshape(B, S, H * dh).astype(q.dtype)


def sliding_window_attention(q, k, v, sinks, bias_tab):
    B, S, Hq, dh = q.shape
    Hkv = k.shape[2]
    G = Hq // Hkv
    nb = S // WINDOW
    scale = dh ** -0.5
    qb = q.reshape(B, nb, WINDOW, Hkv, G, dh)
    kb = k.reshape(B, nb, WINDOW, Hkv, dh)
    vb = v.reshape(B, nb, WINDOW, Hkv, dh)
    pad = ((0, 0), (1, 0), (0, 0), (0, 0), (0, 0))
    kw = jnp.concatenate([jnp.pad(kb, pad)[:, :-1], kb], axis=2)
    vw = jnp.concatenate([jnp.pad(vb, pad)[:, :-1], vb], axis=2)
    logits = jnp.einsum('bnqhgd,bnshd->bnhgqs', qb, kw).astype(jnp.float32) * scale
    i = jnp.arange(WINDOW)[:, None]
    j = jnp.arange(2 * WINDOW)[None, :]
    dist = i + WINDOW - j
    band = (dist >= 0) & (dist < WINDOW)
    key_ok = (jnp.arange(nb)[:, None, None] * WINDOW + j[None] - WINDOW) >= 0
    mask = band[None] & key_ok
    bias = bias_tab[rel_bucket(dist)].reshape(WINDOW, 2 * WINDOW, Hkv, G).transpose(2, 3, 0, 1)
    logits = jnp.where(mask[None, :, None, None], logits + bias, -jnp.inf)
    sink = sinks.astype(jnp.float32).reshape(Hkv, G)[None, None, :, :, None, None]
    m = jnp.maximum(jnp.max(logits, axis=-1, keepdims=True), sink)
    e = jnp.exp(logits - m)
    p = e / (jnp.sum(e, axis=-1, keepdims=True) + jnp.exp(sink - m))
    out = jnp.einsum('bnhgqs,bnshd->bnqhgd', p.astype(v.dtype), vw)
    return out.reshape(B, S, Hq * dh).astype(q.dtype)


def gla(q, k, v, log_a):
    B, S, H, dk = q.shape
    dv = v.shape[-1]
    nc = S // CHUNK
    f = lambda z: z.astype(jnp.float32).reshape(B, nc, CHUNK, H, -1).transpose(1, 0, 3, 2, 4)
    q, k, v, la = f(q) * dk ** -0.5, f(k), f(v), f(log_a)
    b = jnp.cumsum(la, axis=3)
    b_last = b[..., -1:, :]
    qg = q * jnp.exp(b)
    kg = k * jnp.exp(-b)
    kdec = k * jnp.exp(b_last - b)
    causal = jnp.tril(jnp.ones((CHUNK, CHUNK), dtype=bool))
    att = jnp.where(causal, jnp.einsum('nbhcd,nbhsd->nbhcs', qg, kg), 0.0)
    o_intra = jnp.einsum('nbhcs,nbhsv->nbhcv', att, v)
    chunk_state = jnp.einsum('nbhsd,nbhsv->nbhdv', kdec, v)
    decay = jnp.exp(b_last[..., 0, :])

    def step(state, inp):
        dec, cs = inp
        return dec[..., None] * state + cs, state

    _, prev_states = lax.scan(step, jnp.zeros((B, H, dk, dv), jnp.float32), (decay, chunk_state))
    o_inter = jnp.einsum('nbhcd,nbhdv->nbhcv', qg, prev_states)
    return (o_intra + o_inter).transpose(1, 0, 3, 2, 4).reshape(B, S, H, dv)


def hier_moe(xn, w_rg, b_rg, w_re, b_re, w1, w3, w2):
    B, S, D = xn.shape
    T = B * S
    A = T * TOP_K_EXP
    xt = xn.reshape(T, D)
    lg = (xt @ w_rg).astype(jnp.float32) + b_rg.astype(jnp.float32)
    pg = jax.nn.softmax(lg, axis=-1)
    grp = jnp.argmax(lg, axis=-1)
    gw = jnp.take_along_axis(pg, grp[:, None], axis=1)[:, 0]
    le = ((xt @ w_re).astype(jnp.float32) + b_re.astype(jnp.float32)).reshape(T, N_GROUPS, EXP_PER_GROUP)
    le = jnp.take_along_axis(le, grp[:, None, None], axis=1)[:, 0]
    top_p, top_i = lax.top_k(jax.nn.softmax(le, axis=-1), TOP_K_EXP)
    top_p = top_p / jnp.sum(top_p, axis=-1, keepdims=True)
    eid = (grp[:, None] * EXP_PER_GROUP + top_i).reshape(-1)
    wts = (gw[:, None] * top_p).reshape(-1)
    tok = jnp.arange(A) // TOP_K_EXP
    order = jnp.argsort(eid)
    se = eid[order]
    counts = jnp.bincount(eid, length=N_EXPERTS)
    starts = jnp.cumsum(counts) - counts
    pcounts = (counts + MOE_BLOCK - 1) // MOE_BLOCK * MOE_BLOCK
    pends = jnp.cumsum(pcounts)
    pstarts = pends - pcounts
    dest = pstarts[se] + (jnp.arange(A) - starts[se])
    P = A + N_EXPERTS * MOE_BLOCK
    nblk = P // MOE_BLOCK
    row_tok = jnp.full((P,), T, jnp.int32).at[dest].set(tok[order].astype(jnp.int32))
    row_w = jnp.zeros((P,), jnp.float32).at[dest].set(wts[order])
    blk_exp = jnp.minimum(jnp.searchsorted(pends, jnp.arange(nblk) * MOE_BLOCK, side='right'), N_EXPERTS - 1)
    x_pad = jnp.concatenate([xt, jnp.zeros((1, D), xt.dtype)], axis=0)

    def expert_block(args):
        rows, e = args
        xb = x_pad[rows]
        hdn = jax.nn.silu(xb @ w1[e]) * (xb @ w3[e])
        return hdn @ w2[e]

    ys = lax.map(expert_block, (row_tok.reshape(nblk, MOE_BLOCK), blk_exp)).reshape(P, D)
    y = jax.ops.segment_sum(ys.astype(jnp.float32) * row_w[:, None], row_tok, num_segments=T + 1)[:T]
    return y.reshape(B, S, D).astype(xn.dtype)


def setup_inputs(seed: int = 0) -> dict:
    key = jax.random.key(seed)
    ks = jax.random.split(key, 24)
    L, D = DEPTH, D_MODEL
    nrm = lambda k, s: jax.random.normal(k, s, jnp.float32)
    w = lambda k, s, fan_in: nrm(k, s) * fan_in ** -0.5
    gain = lambda k, s: 1.0 + 0.02 * nrm(k, s)
    return {
        'x': nrm(ks[0], (BATCH, SEQ, D)),
        'rel_bias': 0.1 * nrm(ks[1], (N_BUCKETS, N_BIAS_HEADS)),
        'norm1_g': gain(ks[2], (L, D)),
        'w_in': w(ks[3], (L, D, D_IN), D),
        'a_qn_g': gain(ks[4], (L, HEAD_DIM)),
        'a_kn_g': gain(ks[5], (L, HEAD_DIM)),
        'b_qn_g': gain(ks[6], (L, HEAD_DIM)),
        'b_kn_g': gain(ks[7], (L, HEAD_DIM)),
        'b_sinks': nrm(ks[8], (L, B_HEADS)),
        'c_gate_w': w(ks[9], (L, GATE_RANK, C_HEADS * C_DK), GATE_RANK),
        'c_gate_b': 0.1 * nrm(ks[10], (L, C_HEADS * C_DK)),
        'c_norm_g': gain(ks[11], (L, C_DV)),
        'w_br_a': w(ks[12], (L, A_HEADS * HEAD_DIM, D), A_HEADS * HEAD_DIM),
        'w_br_b': w(ks[13], (L, B_HEADS * HEAD_DIM, D), B_HEADS * HEAD_DIM),
        'w_br_c': w(ks[14], (L, C_HEADS * C_DV, D), C_HEADS * C_DV),
        'w_o': w(ks[15], (L, D, D), D),
        'norm2_g': gain(ks[16], (L, D)),
        'w_rg': w(ks[17], (L, D, N_GROUPS), D),
        'b_rg': 0.01 * nrm(ks[18], (L, N_GROUPS)),
        'w_re': w(ks[19], (L, D, N_EXPERTS), D),
        'b_re': 0.01 * nrm(ks[20], (L, N_EXPERTS)),
        'w1': w(ks[21], (L, N_EXPERTS, D, D_EXPERT), D),
        'w3': w(ks[22], (L, N_EXPERTS, D, D_EXPERT), D),
        'w2': w(ks[23], (L, N_EXPERTS, D_EXPERT, D), D_EXPERT),
    }


def reference(x, rel_bias, norm1_g, w_in, a_qn_g, a_kn_g, b_qn_g, b_kn_g, b_sinks,
              c_gate_w, c_gate_b, c_norm_g, w_br_a, w_br_b, w_br_c, w_o, norm2_g,
              w_rg, b_rg, w_re, b_re, w1, w3, w2):
    B, S, _ = x.shape
    n_keep = min(TOPK_MAX, S // 4)
    bias_a = rel_bias[:, :A_HEADS]
    bias_b = rel_bias[:, A_HEADS:]
    h = x
    for l in range(DEPTH):
        xn = rms_norm(h, norm1_g[l])
        p = split_in(xn @ w_in[l])
        qa = rms_norm(p['a_q'].reshape(B, S, A_HEADS, HEAD_DIM), a_qn_g[l])
        ka = rms_norm(p['a_k'], a_kn_g[l])
        oa = dsa_attention(qa, ka, p['a_v'], p['i_q'].reshape(B, S, IDX_HEADS, IDX_DIM),
                           p['i_k'], p['i_w'], bias_a, n_keep)
        qb = rms_norm(p['b_q'].reshape(B, S, B_HEADS, HEAD_DIM), b_qn_g[l])
        kb = rms_norm(p['b_k'].reshape(B, S, B_KV_HEADS, HEAD_DIM), b_kn_g[l])
        ob = sliding_window_attention(qb, kb, p['b_v'].reshape(B, S, B_KV_HEADS, HEAD_DIM),
                                      b_sinks[l], bias_b)
        log_a = jax.nn.log_sigmoid((p['c_g'] @ c_gate_w[l] + c_gate_b[l]).astype(jnp.float32)) / GATE_NORM
        oc = gla(p['c_q'].reshape(B, S, C_HEADS, C_DK), p['c_k'].reshape(B, S, C_HEADS, C_DK),
                 p['c_v'].reshape(B, S, C_HEADS, C_DV), log_a.reshape(B, S, C_HEADS, C_DK))
        oc = rms_norm(oc, c_norm_g[l]) * jax.nn.silu(p['c_r'].reshape(B, S, C_HEADS, C_DV).astype(jnp.float32))
        oc = oc.reshape(B, S, C_HEADS * C_DV).astype(h.dtype)
        merged = (jax.nn.sigmoid(p['g_a']) * (oa @ w_br_a[l])
                  + jax.nn.sigmoid(p['g_b']) * (ob @ w_br_b[l])
                  + jax.nn.sigmoid(p['g_c']) * (oc @ w_br_c[l]))
        h = h + (merged @ w_o[l]).astype(h.dtype)
        h = h + hier_moe(rms_norm(h, norm2_g[l]), w_rg[l], b_rg[l], w_re[l], b_re[l], w1[l], w3[l], w2[l])
    return h
```

```cpp
#include <hip/hip_runtime.h>
#include <cstdio>
#include <cstdint>

__device__ __forceinline__ int lane_id() { return (int)__builtin_amdgcn_mbcnt_hi(~0u, __builtin_amdgcn_mbcnt_lo(~0u, 0u)); }
namespace pg8 {
#define PG8_LAS __attribute__((address_space(3)))
typedef unsigned short bf16_t;
typedef short bf16x8 __attribute__((ext_vector_type(8)));
typedef float f32x4 __attribute__((ext_vector_type(4)));
typedef unsigned u32x4 __attribute__((ext_vector_type(4)));
typedef unsigned u32x2 __attribute__((ext_vector_type(2)));
constexpr int BM = 256, BK = 64, HALF = 128, HTB = HALF * BK * 2  , STAGE_BYTES = 8 * HTB, NXCD = 8, WGM = 8;

__host__ __device__ __forceinline__ int lds_byte(int r, int c) { const int st = (r >> 4) * 2 + (c >> 5), rr = r & 15, cc = c & 31, ob = rr * 64 + cc * 2; return st * 1024 + (ob ^ (((ob >> 9) & 1) << 5)); }
__host__ __device__ __forceinline__ void stage_rc(int b, int& R, int& C) { const int st = b / 1024, sb = b % 1024, swz = sb ^ (((sb >> 9) & 1) << 5); R = (st >> 1) * 16 + swz / 64; C = (st & 1) * 32 + (swz % 64) / 2; }
__host__ __device__ __forceinline__ int perm32(int rho) { const int n = rho >> 4, i = rho & 15; return 8 * (i >> 2) + 4 * n + (i & 3); }

struct Unit { int pm, pn, koff, nt, seg; };
struct Gemm { const bf16_t* A; const bf16_t* Bt; int M, N, K; };

struct StaticOrder {
    static constexpr bool GATHER = false;
    int nM, nN, nwg, G, c, nt0;
    __device__ __forceinline__ int row_token(const Unit&, int) const { return 0; }
    __device__ void init(int M, int N, int K, int G_, int c_) { nM = M / BM; nN = N / BM; nwg = nM * nN; G = G_; c = c_; nt0 = K / BK; }
    __device__ bool tile(long L, Unit& u) const {
        if (L >= nwg) return false;
        int wgid = (int)L; { const int q = nwg / NXCD, r = nwg % NXCD, xcd = wgid % NXCD, off = wgid / NXCD; wgid = (xcd < r ? xcd * (q + 1) : r * (q + 1) + (xcd - r) * q) + off; }
        const int nig = WGM * nN, gid = wgid / nig, fm = gid * WGM, gsz = (nM - fm) < WGM ? (nM - fm) : WGM;
        u.pm = fm + ((wgid % nig) % gsz); u.pn = (wgid % nig) / gsz; return true;
    }
    __device__ bool next(int i, Unit& u) const { u.koff = 0; u.nt = nt0; u.seg = 0; return tile((long)i * G + c, u); }
    __device__ __forceinline__ void a_ready(const Unit&) const {}
    __device__ __forceinline__ void done(const Unit&) const {}
};
struct MergeOrder : StaticOrder {
    __device__ bool next(int i, Unit& u) const { const int rnd = i / 3, sg = i - 3 * rnd; u.seg = sg; u.koff = sg == 0 ? 0 : (sg == 1 ? 512 : 1536); u.nt = sg == 1 ? 16 : 8; return tile((long)rnd * G + c, u); }
};
struct MoeOrder {
    static constexpr bool GATHER = false;
    int total, G, c, NJ, nt0; const PG8_LAS int* tile_exp;
    __device__ bool next(int i, Unit& u) const {
        const long L = (long)i * G + c; if (L >= total) return false;
        const int R = (int)L / NJ, j = (int)L % NJ; u.pm = R; u.pn = tile_exp[R] * NJ + j; u.koff = 0; u.nt = nt0; u.seg = 0; return true;
    }
    __device__ __forceinline__ int row_token(const Unit&, int) const { return 0; }
    __device__ __forceinline__ void a_ready(const Unit&) const {}
    __device__ __forceinline__ void done(const Unit&) const {}
};
struct MoeGatherOrder : MoeOrder {
    static constexpr bool GATHER = true;
    const PG8_LAS int* pst; const PG8_LAS int* cnt; const int* liste;
    __device__ __forceinline__ int row_token(const Unit& u, int r) const {
        const int e = tile_exp[u.pm], lr = u.pm * 256 - pst[e] + r;
        return lr < cnt[e] ? liste[(size_t)e * 32768 + lr] : 0;
    }
};

typedef __bf16 bf16x2v __attribute__((ext_vector_type(2)));
typedef float f32x2v __attribute__((ext_vector_type(2)));
__device__ __forceinline__ unsigned cvt_pk_bf16(float lo, float hi) { const f32x2v v = {lo, hi}; const bf16x2v b = __builtin_convertvector(v, bf16x2v); return __builtin_bit_cast(unsigned, b); }
__device__ __forceinline__ float bflo(unsigned w) { return __uint_as_float(w << 16); }
__device__ __forceinline__ float bfhi(unsigned w) { return __uint_as_float(w & 0xffff0000u); }
__device__ __forceinline__ float sigm(float v) { return __builtin_amdgcn_rcpf(1.0f + __builtin_amdgcn_exp2f(-1.44269504f * v)); }

constexpr int ZP = 11264;
constexpr int ZC_GA = 5120, ZC_GB = 7168, ZC_GC = 9216;

template <int PN_OFF> struct EpiInProj {
    static constexpr bool PERM = true, AFTER_DRAIN = false, CHAIN = false;
    bf16_t* O; PG8_LAS unsigned long long* ss;
    const PG8_LAS float* gains;
    __device__ __forceinline__ void operator()(const f32x4 (&acc)[2][2][4][2], const Unit& u, int wr, int wc, int fr, int fq) const {
        const int pn = PN_OFF ? u.pn + 13 : (u.pn < 13 ? u.pn : u.pn + 7);
        int row0 = u.pm * BM + wr * 64 + fr, col0 = pn * BM + wc * 32 + 8 * fq;
        asm volatile("" : "+v"(row0), "+v"(col0));
        const int act = pn >= 20 ? 2 : (pn >= 18 ? 1 : 0);
        const bool hn = PN_OFF == 0 && pn <= 7;
        f32x4 gn0 = (f32x4){1.f, 1.f, 1.f, 1.f}, gn1 = gn0; int lr = 0;
        if (hn) {
            lr = wr * 64 + fr; asm volatile("" : "+v"(lr));
#pragma unroll
            for (int ai = 0; ai < 2; ++ai)
#pragma unroll
                for (int m = 0; m < 4; ++m)
#pragma unroll
                    for (int bj = 0; bj < 2; ++bj) { const f32x4 a = acc[ai][bj][m][0], b = acc[ai][bj][m][1];
                        float s = (a[0] * a[0] + a[1] * a[1]) + (a[2] * a[2] + a[3] * a[3]) + (b[0] * b[0] + b[1] * b[1]) + (b[2] * b[2] + b[3] * b[3]);
                        s += __shfl_xor(s, 16); s += __shfl_xor(s, 32);
                        if (fq == 0) __hip_atomic_fetch_add(ss + (ai * HALF + m * 16 + lr) * 2 + bj, (unsigned long long)(s * 1048576.0f), __ATOMIC_RELAXED, __HIP_MEMORY_SCOPE_WORKGROUP); }
            asm volatile("s_waitcnt lgkmcnt(0)" ::: "memory"); __builtin_amdgcn_s_barrier(); asm volatile("" ::: "memory");
            const PG8_LAS float* gp = gains + (pn <= 1 ? 0 : (pn == 2 ? 128 : (pn <= 6 ? 256 : 384))) + wc * 32 + 8 * fq;
            gn0 = *(const PG8_LAS f32x4*)gp; gn1 = *(const PG8_LAS f32x4*)(gp + 4);
        }
#pragma unroll
        for (int ai = 0; ai < 2; ++ai)
#pragma unroll
            for (int m = 0; m < 4; ++m) { bf16_t* rowp = O + (size_t)(row0 + ai * HALF + m * 16) * ZP + col0;
#pragma unroll
                for (int bj = 0; bj < 2; ++bj) { f32x4 v0 = acc[ai][bj][m][0], v1 = acc[ai][bj][m][1];
                    if (hn && !(pn == 2 && bj == 1)) { const float r = rsqrtf((float)ss[(ai * HALF + m * 16 + lr) * 2 + bj] * (0.015625f * 0.015625f / 128.0f / 1048576.0f) + 1e-6f) * 0.015625f;
                        v0 = v0 * r * gn0; v1 = v1 * r * gn1; }
                    else if (PN_OFF == 0) { v0 = v0 * 0.015625f; v1 = v1 * 0.015625f; }
                    if (act) {
#pragma unroll
                        for (int j = 0; j < 4; ++j) { const float s0 = sigm(v0[j]), s1 = sigm(v1[j]); v0[j] = act == 2 ? s0 : v0[j] * s0; v1[j] = act == 2 ? s1 : v1[j] * s1; } }
                    u32x4 w; w.x = cvt_pk_bf16(v0[0], v0[1]); w.y = cvt_pk_bf16(v0[2], v0[3]); w.z = cvt_pk_bf16(v1[0], v1[1]); w.w = cvt_pk_bf16(v1[2], v1[3]);
                    *(u32x4*)(rowp + bj * HALF) = w; } }
        if (hn) { asm volatile("s_waitcnt lgkmcnt(0)" ::: "memory"); __builtin_amdgcn_s_barrier(); asm volatile("" ::: "memory");
            ss[(wr * 4 + wc) * 64 + fq * 16 + fr] = 0ull; }
    }
};
struct EpiMerge {
    static constexpr bool PERM = true, AFTER_DRAIN = false, CHAIN = true;
    const bf16_t* Z; bf16_t* O;
    __device__ __forceinline__ void operator()(f32x4 (&acc)[2][2][4][2], const Unit& u, int wr, int wc, int fr, int fq) const {
        const int row0 = u.pm * BM + wr * 64 + fr, col0 = u.pn * BM + wc * 32 + 8 * fq;
        const int cn = u.seg == 0 ? ZC_GA : (u.seg == 1 ? ZC_GB : ZC_GC), cd = u.seg == 0 ? ZC_GB : ZC_GC;
#pragma unroll
        for (int ai = 0; ai < 2; ++ai) {
            u32x4 gn[4][2], gd[4][2];
#pragma unroll
            for (int m = 0; m < 4; ++m)
#pragma unroll
                for (int bj = 0; bj < 2; ++bj) { const size_t r = (size_t)(row0 + ai * HALF + m * 16);
                    gn[m][bj] = *(const u32x4*)(Z + r * ZP + cn + col0 + bj * HALF);
                    if (u.seg != 2) gd[m][bj] = *(const u32x4*)(Z + r * ZP + cd + col0 + bj * HALF); else gd[m][bj] = (u32x4){0x3f803f80u, 0x3f803f80u, 0x3f803f80u, 0x3f803f80u}; }
#pragma unroll
            for (int m = 0; m < 4; ++m)
#pragma unroll
                for (int bj = 0; bj < 2; ++bj) { const size_t r = (size_t)(row0 + ai * HALF + m * 16);
#pragma unroll
                    for (int w = 0; w < 4; ++w) { const float rl = bflo(gn[m][bj][w]) * __builtin_amdgcn_rcpf(bflo(gd[m][bj][w])), rh = bfhi(gn[m][bj][w]) * __builtin_amdgcn_rcpf(bfhi(gd[m][bj][w]));
                        acc[ai][bj][m][w >> 1][(w & 1) * 2] *= rl; acc[ai][bj][m][w >> 1][(w & 1) * 2 + 1] *= rh; }
                    if (u.seg == 2) { const f32x4 v0 = acc[ai][bj][m][0], v1 = acc[ai][bj][m][1];
                        u32x4 w; w.x = cvt_pk_bf16(v0[0], v0[1]); w.y = cvt_pk_bf16(v0[2], v0[3]); w.z = cvt_pk_bf16(v1[0], v1[1]); w.w = cvt_pk_bf16(v1[2], v1[3]);
                        *(u32x4*)(O + r * 2048 + col0 + bj * HALF) = w; } }
        }
    }
};
template <bool BASE_BF16> struct EpiResid {
    static constexpr bool PERM = true, AFTER_DRAIN = false, CHAIN = false;
    const float* base; bf16_t* hb; unsigned char* xu; const float* gain;
    __device__ __forceinline__ void operator()(const f32x4 (&acc)[2][2][4][2], const Unit& u, int wr, int wc, int fr, int fq) const {
        const int row0 = u.pm * BM + wr * 64 + fr, col0 = u.pn * BM + wc * 32 + 8 * fq;
        f32x4 gv[2][2];
#pragma unroll
        for (int bj = 0; bj < 2; ++bj)
#pragma unroll
            for (int n = 0; n < 2; ++n) gv[bj][n] = *(const f32x4*)(gain + col0 + bj * HALF + 4 * n);
        const f32x4 lo4 = (f32x4){-440.f, -440.f, -440.f, -440.f}, hi4 = (f32x4){440.f, 440.f, 440.f, 440.f};
#pragma unroll
        for (int ai = 0; ai < 2; ++ai) {
            f32x4 bv[4][2][2];
#pragma unroll
            for (int mm = 0; mm < 4; ++mm) { const size_t off = (size_t)(row0 + ai * HALF + mm * 16) * 2048 + col0;
#pragma unroll
                for (int bj = 0; bj < 2; ++bj) {
                    if constexpr (BASE_BF16) { const u32x4 w = *(const u32x4*)(hb + off + bj * HALF);
                        bv[mm][bj][0] = (f32x4){bflo(w.x), bfhi(w.x), bflo(w.y), bfhi(w.y)}; bv[mm][bj][1] = (f32x4){bflo(w.z), bfhi(w.z), bflo(w.w), bfhi(w.w)}; }
                    else { bv[mm][bj][0] = *(const f32x4*)(base + off + bj * HALF); bv[mm][bj][1] = *(const f32x4*)(base + off + bj * HALF + 4); } } }
#pragma unroll
            for (int mm = 0; mm < 4; ++mm) { const size_t off = (size_t)(row0 + ai * HALF + mm * 16) * 2048 + col0;
#pragma unroll
                for (int bj = 0; bj < 2; ++bj) { const f32x4 h0 = bv[mm][bj][0] + acc[ai][bj][mm][0], h1 = bv[mm][bj][1] + acc[ai][bj][mm][1];
                    u32x4 hw; hw.x = cvt_pk_bf16(h0[0], h0[1]); hw.y = cvt_pk_bf16(h0[2], h0[3]); hw.z = cvt_pk_bf16(h1[0], h1[1]); hw.w = cvt_pk_bf16(h1[2], h1[3]);
                    *(u32x4*)(hb + off + bj * HALF) = hw;
                    const f32x4 x0 = __builtin_elementwise_min(__builtin_elementwise_max(h0 * gv[bj][0], lo4), hi4), x1 = __builtin_elementwise_min(__builtin_elementwise_max(h1 * gv[bj][1], lo4), hi4);
                    int w0 = 0, w1 = 0;
                    w0 = __builtin_amdgcn_cvt_pk_fp8_f32(x0[0], x0[1], w0, false); w0 = __builtin_amdgcn_cvt_pk_fp8_f32(x0[2], x0[3], w0, true);
                    w1 = __builtin_amdgcn_cvt_pk_fp8_f32(x1[0], x1[1], w1, false); w1 = __builtin_amdgcn_cvt_pk_fp8_f32(x1[2], x1[3], w1, true);
                    *(u32x2*)(xu + off + bj * HALF) = (u32x2){(unsigned)w0, (unsigned)w1}; } }
        }
    }
};
struct EpiGlu {
    static constexpr bool PERM = false, AFTER_DRAIN = false, CHAIN = false;
    bf16_t* H; const PG8_LAS int* tile_exp; const PG8_LAS int* pst; const PG8_LAS int* cnt; const int* liste; const float* rstd;
    __device__ __forceinline__ void operator()(const f32x4 (&acc)[2][2][4][2], const Unit& u, int wr, int wc, int fr, int fq) const {
        const int row0 = u.pm * BM + wr * 64 + fr, pj = u.pn & 3;
        const int e = tile_exp[u.pm], lr0 = u.pm * 256 - pst[e] + wr * 64 + fr, ce = cnt[e];
        int tok[2][4]; float rs[2][4];
#pragma unroll
        for (int ai = 0; ai < 2; ++ai)
#pragma unroll
            for (int m = 0; m < 4; ++m) { const int lr = lr0 + ai * HALF + m * 16; tok[ai][m] = lr < ce ? liste[(size_t)e * 32768 + lr] : 0; }
#pragma unroll
        for (int ai = 0; ai < 2; ++ai)
#pragma unroll
            for (int m = 0; m < 4; ++m) rs[ai][m] = rstd[tok[ai][m]] * 0.015625f;
#pragma unroll
        for (int ai = 0; ai < 2; ++ai)
#pragma unroll
            for (int m = 0; m < 4; ++m) { unsigned char* rowp = (unsigned char*)H + (size_t)(row0 + ai * HALF + m * 16) * 512; const float r = rs[ai][m];
#pragma unroll
                for (int bj = 0; bj < 2; ++bj) { const f32x4 a = acc[ai][bj][m][0] * r, b = acc[ai][bj][m][1] * r;
                    const int hc = 16 * (8 * pj + 4 * bj + wc) + 4 * fq;
                    float hv[4];
#pragma unroll
                    for (int j = 0; j < 4; ++j) hv[j] = fminf(fmaxf(a[j] * sigm(a[j]) * b[j] * 8.0f, -440.0f), 440.0f);
                    int w = 0; w = __builtin_amdgcn_cvt_pk_fp8_f32(hv[0], hv[1], w, false); w = __builtin_amdgcn_cvt_pk_fp8_f32(hv[2], hv[3], w, true);
                    *(int*)(rowp + hc) = w; } }
    }
};
struct EpiY {
    static constexpr bool PERM = true, AFTER_DRAIN = false, CHAIN = false;
    unsigned char* Y;
    __device__ __forceinline__ void operator()(const f32x4 (&acc)[2][2][4][2], const Unit& u, int wr, int wc, int fr, int fq) const {
        const int row0 = u.pm * BM + wr * 64 + fr, col0 = (u.pn & 7) * BM + wc * 32 + 8 * fq;
        const f32x4 lo4 = (f32x4){-440.f, -440.f, -440.f, -440.f}, hi4 = (f32x4){440.f, 440.f, 440.f, 440.f};
#pragma unroll
        for (int ai = 0; ai < 2; ++ai)
#pragma unroll
            for (int m = 0; m < 4; ++m) { unsigned char* rowp = Y + (size_t)(row0 + ai * HALF + m * 16) * 2048 + col0;
#pragma unroll
                for (int bj = 0; bj < 2; ++bj) {
                    const f32x4 v0 = __builtin_elementwise_min(__builtin_elementwise_max(acc[ai][bj][m][0] * 0.125f, lo4), hi4), v1 = __builtin_elementwise_min(__builtin_elementwise_max(acc[ai][bj][m][1] * 0.125f, lo4), hi4);
                    int w0 = 0, w1 = 0;
                    w0 = __builtin_amdgcn_cvt_pk_fp8_f32(v0[0], v0[1], w0, false); w0 = __builtin_amdgcn_cvt_pk_fp8_f32(v0[2], v0[3], w0, true);
                    w1 = __builtin_amdgcn_cvt_pk_fp8_f32(v1[0], v1[1], w1, false); w1 = __builtin_amdgcn_cvt_pk_fp8_f32(v1[2], v1[3], w1, true);
                    *(u32x2*)(rowp + bj * HALF) = (u32x2){(unsigned)w0, (unsigned)w1}; } }
    }
};

typedef int v4i_t __attribute__((ext_vector_type(4)));
typedef int v8i_t __attribute__((ext_vector_type(8)));
template <class Epi, class Sched, bool ALIGN_EPI = false, bool FP8 = false>
__device__ __forceinline__ void gemm_phase(PG8_LAS unsigned char* lds, const Gemm g, const Sched& S, const Epi& E) {
    int tid = threadIdx.x; asm volatile("" : "+v"(tid));
    const int wid = __builtin_amdgcn_readfirstlane(tid >> 6), lane = tid & 63, wr = wid >> 2, wc = wid & 3, fr = lane & 15, fq = lane >> 4;
    const int K = g.K;
    unsigned voffA[2], voffB[2]; int RA[2]; unsigned CA2[2];
#pragma unroll
    for (int i = 0; i < 2; ++i) { int R, C; stage_rc(tid * 16 + i * 8192, R, C); const int Rb = Epi::PERM ? ((R & ~31) + perm32(R & 31)) : R;
        voffA[i] = (unsigned)(R * K + C) * 2u; voffB[i] = (unsigned)(Rb * K + C) * 2u; RA[i] = R; CA2[i] = (unsigned)C * 2u; }
    unsigned gAc[2][2], gAn[2][2];
#define PG8_GOFF(dst, uu) do { _Pragma("unroll") for (int h_ = 0; h_ < 2; ++h_) _Pragma("unroll") for (int i_ = 0; i_ < 2; ++i_) dst[h_][i_] = (unsigned)S.row_token(uu, 128 * h_ + RA[i_]) * (unsigned)(K * 2) + CA2[i_]; } while (0)
#define PG8_STAGE_A(bufoff, gbase, half, garr) do { if constexpr (Sched::GATHER) PG8_STAGE(bufoff, gbase, garr); else PG8_STAGE(bufoff, (gbase) + (half) * hstep, voffA); } while (0)
    const size_t kstep = (size_t)(BK * 2);
    const size_t hstep = (size_t)HALF * K * 2;
    const size_t tstep = 2 * hstep;
    const unsigned ldsw = (unsigned)wid * 1024u;
    const int aoff = lds_byte(wr * 64 + fr, fq * 8), boff = lds_byte(wc * 32 + fr, fq * 8);
#define PG8_SA(b, h) (((b) * 2 + (h)) * HTB)
#define PG8_SB(b, h) ((4 + (b) * 2 + (h)) * HTB)
#define PG8_STAGE(bufoff, gbase, voff) do { _Pragma("unroll") for (int _i = 0; _i < 2; ++_i) \
        __builtin_amdgcn_global_load_lds((const unsigned*)((const char*)(gbase) + (voff)[_i]), (PG8_LAS unsigned*)(lds + (bufoff) + ldsw + _i * 8192), 16, 0, 0); } while (0)
#define PG8_LDA(dst, b, h) do { if constexpr (FP8) { _Pragma("unroll") for (int m = 0; m < 4; ++m) dst##8[m] = __builtin_shufflevector(*(const PG8_LAS v4i_t*)(lds + PG8_SA(b, h) + aoff + m * 2048), *(const PG8_LAS v4i_t*)(lds + PG8_SA(b, h) + aoff + m * 2048 + 1024), 0, 1, 2, 3, 4, 5, 6, 7); } \
        else { _Pragma("unroll") for (int m = 0; m < 4; ++m) _Pragma("unroll") for (int k = 0; k < 2; ++k) dst[m][k] = *(const PG8_LAS bf16x8*)(lds + PG8_SA(b, h) + aoff + m * 2048 + k * 1024); } } while (0)
#define PG8_LDB(dst, b, h) do { if constexpr (FP8) { _Pragma("unroll") for (int n = 0; n < 2; ++n) dst##8[n] = __builtin_shufflevector(*(const PG8_LAS v4i_t*)(lds + PG8_SB(b, h) + boff + n * 2048), *(const PG8_LAS v4i_t*)(lds + PG8_SB(b, h) + boff + n * 2048 + 1024), 0, 1, 2, 3, 4, 5, 6, 7); } \
        else { _Pragma("unroll") for (int n = 0; n < 2; ++n) _Pragma("unroll") for (int k = 0; k < 2; ++k) dst[n][k] = *(const PG8_LAS bf16x8*)(lds + PG8_SB(b, h) + boff + n * 2048 + k * 1024); } } while (0)
#define PG8_MMA(ai, bj, At, Bt) do { __builtin_amdgcn_s_setprio(1); _Pragma("unroll") for (int m = 0; m < 4; ++m) _Pragma("unroll") for (int n = 0; n < 2; ++n) { \
        if constexpr (FP8) asm volatile("v_mfma_f32_16x16x128_f8f6f4 %0, %1, %2, %0" : "+v"(acc[ai][bj][m][n]) : "v"(Bt##8[n]), "v"(At##8[m])); \
        else { _Pragma("unroll") for (int k = 0; k < 2; ++k) acc[ai][bj][m][n] = __builtin_amdgcn_mfma_f32_16x16x32_bf16(Bt[n][k], At[m][k], acc[ai][bj][m][n], 0, 0, 0); } } \
        __builtin_amdgcn_s_setprio(0); } while (0)
#define PG8_WAIT_V(n) asm volatile("s_waitcnt vmcnt(" #n ")" ::: "memory")
#define PG8_WAIT_L(n) asm volatile("s_waitcnt lgkmcnt(" #n ")" ::: "memory")
#define PG8_BAR __builtin_amdgcn_s_barrier()
#define PG8_SCHED __builtin_amdgcn_sched_barrier(0)
    Unit cur, nxt; int ui = 0;
    if (!S.next(0, cur)) return;
    f32x4 acc[2][2][4][2];
#pragma unroll
    for (int a = 0; a < 2; ++a)
#pragma unroll
        for (int b = 0; b < 2; ++b)
#pragma unroll
            for (int m = 0; m < 4; ++m)
#pragma unroll
                for (int n = 0; n < 2; ++n) acc[a][b][m][n] = (f32x4){0.f, 0.f, 0.f, 0.f};
    bf16x8 At[4][2], B0[2][2], B1[2][2]; v8i_t At8[4], B08[2], B18[2];
    const size_t tstepA = Sched::GATHER ? (size_t)0 : tstep;
    const char* cA = (const char*)g.A + (size_t)cur.pm * tstepA + (size_t)cur.koff * 2; const char* cB = (const char*)g.Bt + (size_t)cur.pn * tstep + (size_t)cur.koff * 2;
    S.a_ready(cur);
    if constexpr (Sched::GATHER) { PG8_GOFF(gAc, cur); }
    PG8_STAGE(PG8_SB(0, 0), cB, voffB); PG8_STAGE(PG8_SB(0, 1), cB + hstep, voffB); PG8_STAGE_A(PG8_SA(0, 0), cA, 0, gAc[0]); PG8_STAGE_A(PG8_SA(0, 1), cA, 1, gAc[1]);
    if (wr == 1) PG8_BAR;
    PG8_WAIT_V(2); PG8_BAR;
    PG8_STAGE(PG8_SB(1, 0), cB + kstep, voffB); PG8_STAGE_A(PG8_SA(1, 0), cA + kstep, 0, gAc[0]); PG8_STAGE(PG8_SB(1, 1), cB + hstep + kstep, voffB);
    PG8_WAIT_V(6); PG8_BAR;
    for (;;) {
        const bool has_next = S.next(ui + 1, nxt);
        const char* nA = has_next ? (const char*)g.A + (size_t)nxt.pm * tstepA + (size_t)nxt.koff * 2 : cA; const char* nB = has_next ? (const char*)g.Bt + (size_t)nxt.pn * tstep + (size_t)nxt.koff * 2 : cB;
        if constexpr (Sched::GATHER) { if (has_next) { PG8_GOFF(gAn, nxt); } else {
#pragma unroll
            for (int h_ = 0; h_ < 2; ++h_)
#pragma unroll
                for (int i_ = 0; i_ < 2; ++i_) gAn[h_][i_] = gAc[h_][i_]; } }
        const int nt = cur.nt;
        for (int t = 0; t < nt; t += 2) {
            const bool last = (t == nt - 2);
            const char* a1 = cA + (size_t)(t + 1) * kstep;
            const char* a2 = last ? nA : cA + (size_t)(t + 2) * kstep; const char* b2 = last ? nB : cB + (size_t)(t + 2) * kstep;
            const char* a3 = a2 + kstep; const char* b3 = b2 + kstep;
            if (last && has_next) S.a_ready(nxt);
            unsigned g2a[2][2];
            if constexpr (Sched::GATHER) {
#pragma unroll
                for (int h_ = 0; h_ < 2; ++h_)
#pragma unroll
                    for (int i_ = 0; i_ < 2; ++i_) g2a[h_][i_] = last ? gAn[h_][i_] : gAc[h_][i_]; }
            PG8_LDB(B0, 0, 0); PG8_LDB(B1, 0, 1); PG8_SCHED; PG8_LDA(At, 0, 0); PG8_STAGE_A(PG8_SA(1, 1), a1, 1, gAc[1]);
            PG8_WAIT_V(8); PG8_WAIT_L(0); PG8_BAR; PG8_MMA(0, 0, At, B0); PG8_MMA(0, 1, At, B1); PG8_BAR; PG8_SCHED;
            PG8_LDA(At, 0, 1); PG8_STAGE(PG8_SB(0, 0), b2, voffB); PG8_STAGE(PG8_SB(0, 1), b2 + hstep, voffB); PG8_STAGE_A(PG8_SA(0, 0), a2, 0, g2a[0]);
            PG8_WAIT_V(8); PG8_WAIT_L(0); PG8_BAR; PG8_MMA(1, 0, At, B0); PG8_MMA(1, 1, At, B1); PG8_BAR; PG8_SCHED;
            PG8_LDB(B0, 1, 0); PG8_LDB(B1, 1, 1); PG8_SCHED; PG8_LDA(At, 1, 0); PG8_STAGE_A(PG8_SA(0, 1), a2, 1, g2a[1]);
            PG8_WAIT_V(8); PG8_WAIT_L(0); PG8_BAR; PG8_MMA(0, 0, At, B0); PG8_MMA(0, 1, At, B1); PG8_BAR; PG8_SCHED;
            PG8_LDA(At, 1, 1); PG8_STAGE(PG8_SB(1, 0), b3, voffB); PG8_STAGE(PG8_SB(1, 1), b3 + hstep, voffB); PG8_STAGE_A(PG8_SA(1, 0), a3, 0, g2a[0]);
            PG8_WAIT_V(8); PG8_WAIT_L(0); PG8_BAR; PG8_MMA(1, 0, At, B0); PG8_MMA(1, 1, At, B1); PG8_BAR; PG8_SCHED;
        }
        if constexpr (ALIGN_EPI) { if (wr == 0) PG8_BAR; }
        if constexpr (FP8) asm volatile("s_nop 15\n\ts_nop 15\n\ts_nop 15\n\ts_nop 15" ::: "memory");
        E(acc, cur, wr, wc, fr, fq); S.done(cur);
        if (!has_next) break;
        if (!Epi::CHAIN || cur.seg == 2)
#pragma unroll
        for (int a = 0; a < 2; ++a)
#pragma unroll
            for (int b = 0; b < 2; ++b)
#pragma unroll
                for (int m = 0; m < 4; ++m)
#pragma unroll
                    for (int n = 0; n < 2; ++n) acc[a][b][m][n] = (f32x4){0.f, 0.f, 0.f, 0.f};
        cur = nxt; cA = nA; cB = nB; ++ui;
        if constexpr (Sched::GATHER) {
#pragma unroll
            for (int h_ = 0; h_ < 2; ++h_)
#pragma unroll
                for (int i_ = 0; i_ < 2; ++i_) gAc[h_][i_] = gAn[h_][i_]; }
        if constexpr (ALIGN_EPI) { if (wr == 1) PG8_BAR; }
    }
    PG8_WAIT_V(0);
    if constexpr (!ALIGN_EPI) { if (wr == 0) PG8_BAR; }
    PG8_BAR;
#undef PG8_SA
#undef PG8_SB
#undef PG8_STAGE_A
#undef PG8_GOFF
#undef PG8_STAGE
#undef PG8_LDA
#undef PG8_LDB
#undef PG8_MMA
#undef PG8_WAIT_V
#undef PG8_WAIT_L
#undef PG8_BAR
#undef PG8_SCHED
}
}

constexpr int NWAVES = 8;
constexpr int T = 32768, SEQ = 2048, NB = 16, D = 2048, DEPTH = 2;
constexpr int ZP = pg8::ZP;
constexpr int ZC_AQ = 0, ZC_AK = 512, ZC_AV = 640, ZC_BQ = 768, ZC_BK = 1792, ZC_BV = 2048, ZC_IQ = 2304, ZC_IK = 3328, ZC_IW = 3392, ZC_CG = 3408, ZC_PAD = 3424, ZC_CQ = 3584, ZC_CK = 3840, ZC_CV = 4096, ZC_CR = 4608;
constexpr int D_IN = 11104;
constexpr int NEXP = 64, DEXP = 512, PMAX_TILES = 320;
constexpr float EPS = 1e-6f;

constexpr size_t MiB = 1u << 20;
constexpr size_t WS_CTL = 0, CTL_ZERO_BYTES = 1 * MiB;
constexpr size_t WS_ROUTE = 2 * MiB;
constexpr size_t WS_WRH = 4 * MiB, WS_WRL = 6 * MiB, WR_L = 96 * 2048 * 2;
constexpr size_t WS_WIN = 16 * MiB, WIN_L = 44 * MiB;
constexpr size_t WS_WBR = 104 * MiB, WBR_L = 8 * MiB;
constexpr size_t WS_WO = 120 * MiB, WO_L = 8 * MiB;
constexpr size_t WS_W13 = 136 * MiB;
constexpr size_t WS_HB = 264 * MiB;
constexpr size_t WS_W2 = 392 * MiB;
constexpr size_t WS_XN = 520 * MiB;
constexpr size_t WS_OCAT = 648 * MiB;
constexpr size_t WS_MERGED = 776 * MiB;
constexpr size_t WS_Z = 904 * MiB;
constexpr size_t WS_S = 1608 * MiB;
constexpr size_t WS_MASK = 1864 * MiB;
constexpr size_t WS_GO = 1872 * MiB;
constexpr size_t WS_GCS = WS_GO;
constexpr size_t WS_GDEC = 8 * MiB;
constexpr size_t WS_RSTD = 9 * MiB;
constexpr size_t WS_LISTE = 904 * MiB;
constexpr size_t WS_XS = 904 * MiB;
constexpr size_t WS_Y = 1224 * MiB;
constexpr size_t WS_H = 1544 * MiB;
constexpr size_t WS_WG8 = 1936 * MiB, WG8_L = 12 * MiB;
constexpr size_t WS_XN8 = WS_S;
constexpr size_t WS_END = 1936 * MiB;
constexpr int CW_BAR = 4096;
constexpr int CW_CNT = 16384;

constexpr int RING_BYTES = 131072, MISC_OFF = RING_BYTES, LDS_BYTES = 155648;
constexpr int MO_BARW = 32, MO_TAB = 256, MO_TEXP = 8192, MO_PST = 9728, MO_TOT = 9984, MO_TAB2 = 10240, MO_CNT = 16640, MO_SS = 16896, MO_GN = 256;

#define GAS __attribute__((address_space(1)))
#define LAS __attribute__((address_space(3)))
typedef unsigned short bf16;
typedef unsigned v4u __attribute__((ext_vector_type(4)));
typedef unsigned v2u __attribute__((ext_vector_type(2)));
typedef float f32x4 __attribute__((ext_vector_type(4)));
#define LDS_WAIT() asm volatile("s_waitcnt lgkmcnt(0)" ::: "memory")
__device__ __forceinline__ unsigned f2bf(float f) { unsigned u = __builtin_bit_cast(unsigned, f); return (u + 0x7fffu + ((u >> 16) & 1u)) >> 16; }
__device__ __forceinline__ unsigned pk2(float lo, float hi) { return f2bf(lo) | (f2bf(hi) << 16); }
__device__ __forceinline__ float bflo(unsigned w) { return __uint_as_float(w << 16); }
__device__ __forceinline__ float bfhi(unsigned w) { return __uint_as_float(w & 0xffff0000u); }
__device__ __forceinline__ float bf1(bf16 h) { return __uint_as_float(((unsigned)h) << 16); }

#define XB_TMO      128
#define XB_XCNT(j)  (256  + 64 * (j))
#define XB_XSUB(j)  (1280 + 64 * (j))
#define XB_XGEN(j)  (2304 + 64 * (j))
#define XB_TOP      3328
#define XB_TOPGEN   3392
#define XCD_BAR_WORDS 3456
#define XB_SPIN_CAP (1u << 18)
__device__ __forceinline__ unsigned xb_ld(unsigned* p)              { return __hip_atomic_load(p, __ATOMIC_RELAXED, __HIP_MEMORY_SCOPE_AGENT); }
__device__ __forceinline__ unsigned xb_add(unsigned* p, unsigned v) { return __hip_atomic_fetch_add(p, v, __ATOMIC_RELAXED, __HIP_MEMORY_SCOPE_AGENT); }
__device__ __forceinline__ unsigned xb_xcc_id() { return (unsigned)__builtin_amdgcn_s_getreg((3 << 11) | 20) & 0xFu; }
#define XB_SPIN(cond, bar) do { unsigned _sp = 0; while (cond) { __builtin_amdgcn_s_sleep(1); \
    if ((++_sp & 255u) == 0u) { if (xb_ld(&(bar)[XB_TMO])) break; if (_sp > XB_SPIN_CAP) { atomicAdd(&(bar)[XB_TMO], 1u); break; } } } } while (0)
struct XcdBarrier { unsigned* bar; unsigned x; volatile LAS unsigned* st; };
__device__ __forceinline__ XcdBarrier xcd_barrier_post(unsigned* bar, volatile LAS unsigned* st) {
    XcdBarrier b; b.bar = bar; b.x = xb_xcc_id(); b.st = st;
    if (threadIdx.x == 0) (void)xb_add(&bar[XB_XCNT(b.x)], 1u);
    return b;
}
__device__ __forceinline__ void xcd_barrier_complete(unsigned* bar, unsigned x, unsigned& nloc, unsigned& nx) {
    const unsigned G = gridDim.x * gridDim.y * gridDim.z;
    unsigned sum, cnt, mine, sp = 0u;
    for (;;) {
        sum = 0u; cnt = 0u; mine = 0u;
#pragma unroll
        for (unsigned j = 0; j < 16; ++j) { const unsigned c = xb_ld(&bar[XB_XCNT(j)]); sum += c; cnt += (c > 0u) ? 1u : 0u; mine = (j == x) ? c : mine; }
        if (sum == G) break;
        __builtin_amdgcn_s_sleep(1);
        if ((++sp & 255u) == 0u) { if (xb_ld(&bar[XB_TMO])) break; if (sp > XB_SPIN_CAP) { atomicAdd(&bar[XB_TMO], 1u); break; } }
    }
    nloc = mine > 0u ? mine : 1u; nx = cnt > 0u ? cnt : 1u;
}
__device__ __forceinline__ void xcd_barrier(const XcdBarrier& b) {
    asm volatile("s_waitcnt vmcnt(0)" ::: "memory");
    __syncthreads();
    if (threadIdx.x == 0) {
        unsigned* bar = b.bar;
        __builtin_amdgcn_s_waitcnt(0);
        unsigned nloc = b.st[0], nx = b.st[1];
        if (nloc == 0u) { xcd_barrier_complete(bar, b.x, nloc, nx); b.st[0] = nloc; b.st[1] = nx; }
        const unsigned old = xb_add(&bar[XB_XSUB(b.x)], 1u);
        const unsigned gen = old / nloc;
        if (old + 1u == (gen + 1u) * nloc) {
            __builtin_amdgcn_fence(__ATOMIC_RELEASE, "agent");
            asm volatile("s_waitcnt vmcnt(0)" ::: "memory");
            const unsigned og = xb_add(&bar[XB_TOP], 1u);
            const unsigned tg = og / nx;
            if (og + 1u == (tg + 1u) * nx) xb_add(&bar[XB_TOPGEN], 1u);
            else XB_SPIN(xb_ld(&bar[XB_TOPGEN]) == tg, bar);
            __builtin_amdgcn_fence(__ATOMIC_ACQUIRE, "agent");
            xb_add(&bar[XB_XGEN(b.x)], 1u);
            asm volatile("s_waitcnt vmcnt(0)" ::: "memory");
        } else {
            XB_SPIN(xb_ld(&bar[XB_XGEN(b.x)]) == gen, bar);
            __builtin_amdgcn_fence(__ATOMIC_ACQUIRE, "agent");
            asm volatile("s_waitcnt vmcnt(0)" ::: "memory");
        }
    }
    __syncthreads();
}

struct Args { const float* in[24]; float* out; unsigned char* ws; int ph_lo, ph_hi; };
enum { I_X = 0, I_RELB, I_N1G, I_WIN, I_AQG, I_AKG, I_BQG, I_BKG, I_SINK, I_CGW, I_CGB, I_CNG, I_WBA, I_WBB, I_WBC, I_WO, I_N2G, I_WRG, I_BRG, I_WRE, I_BRE, I_W1, I_W3, I_W2 };

struct Frame {
    LAS unsigned char* lds; LAS unsigned char* misc;
    unsigned* ctl;
    int tid, lane, wave, vcu, G, gw, NGW;
    const float* const* in; float* out; unsigned char* ws;
    bf16 *Z, *XN, *OCAT, *MERGED, *XS, *Y, *H;
    float *S, *GO; unsigned* MASK;
};

__device__ __forceinline__ float wave_sum(float v) {
#pragma unroll
    for (int o = 1; o < 64; o <<= 1) v += __shfl_xor(v, o);
    return v;
}
__device__ __forceinline__ float wave_max(float v) {
#pragma unroll
    for (int o = 1; o < 64; o <<= 1) v = fmaxf(v, __shfl_xor(v, o));
    return v;
}

template <class MAP>
__device__ __forceinline__ void transpose_item(const float* W, int N, bf16* WT, int dpitch, int koff, LAS float* scr, int item, int lane, const MAP& map) {
    const int nblk = N / 32, kb = item / nblk, nb = item % nblk, k0 = 64 * kb, n0 = 32 * nb;
    f32x4 v[8];
#pragma unroll
    for (int i = 0; i < 8; ++i) v[i] = *(const f32x4*)(W + (size_t)(k0 + 8 * i + (lane >> 3)) * N + n0 + 4 * (lane & 7));
#pragma unroll
    for (int i = 0; i < 8; ++i) { LAS float* d = scr + (8 * i + (lane >> 3)) * 33 + 4 * (lane & 7); d[0] = v[i].x; d[1] = v[i].y; d[2] = v[i].z; d[3] = v[i].w; }
    LDS_WAIT(); asm volatile("" ::: "memory");
    const int c = lane & 7;
#pragma unroll
    for (int j = 0; j < 4; ++j) { const int n = (lane >> 3) + 8 * j; const LAS float* s = scr + (8 * c) * 33 + n;
        v4u o; o.x = pk2(s[0 * 33], s[1 * 33]); o.y = pk2(s[2 * 33], s[3 * 33]); o.z = pk2(s[4 * 33], s[5 * 33]); o.w = pk2(s[6 * 33], s[7 * 33]);
        const int dr_ = map(n0 + n); if (dr_ >= 0) *(v4u*)(WT + (size_t)dr_ * dpitch + koff + k0 + 8 * c) = o; }
    LDS_WAIT(); asm volatile("" ::: "memory");
}
__device__ __forceinline__ float clamp8(float v) { return fminf(fmaxf(v, -440.0f), 440.0f); }
template <class MAP>
__device__ __forceinline__ void transpose_item_fp8(const float* W, int N, unsigned char* WT, int dpitch, float scale, LAS float* scr, int item, int lane, const MAP& map) {
    const int nblk = N / 32, kb = item / nblk, nb = item % nblk, k0 = 64 * kb, n0 = 32 * nb;
    f32x4 v[8];
#pragma unroll
    for (int i = 0; i < 8; ++i) v[i] = *(const f32x4*)(W + (size_t)(k0 + 8 * i + (lane >> 3)) * N + n0 + 4 * (lane & 7));
#pragma unroll
    for (int i = 0; i < 8; ++i) { LAS float* d = scr + (8 * i + (lane >> 3)) * 33 + 4 * (lane & 7); d[0] = v[i].x; d[1] = v[i].y; d[2] = v[i].z; d[3] = v[i].w; }
    LDS_WAIT(); asm volatile("" ::: "memory");
    const int c = lane & 7;
#pragma unroll
    for (int j = 0; j < 4; ++j) { const int n = (lane >> 3) + 8 * j; const LAS float* s = scr + (8 * c) * 33 + n;
        int w0 = 0, w1 = 0;
        w0 = __builtin_amdgcn_cvt_pk_fp8_f32(clamp8(s[0 * 33] * scale), clamp8(s[1 * 33] * scale), w0, false); w0 = __builtin_amdgcn_cvt_pk_fp8_f32(clamp8(s[2 * 33] * scale), clamp8(s[3 * 33] * scale), w0, true);
        w1 = __builtin_amdgcn_cvt_pk_fp8_f32(clamp8(s[4 * 33] * scale), clamp8(s[5 * 33] * scale), w1, false); w1 = __builtin_amdgcn_cvt_pk_fp8_f32(clamp8(s[6 * 33] * scale), clamp8(s[7 * 33] * scale), w1, true);
        const int dr_ = map(n0 + n); if (dr_ >= 0) *(v2u*)(WT + (size_t)dr_ * dpitch + k0 + 8 * c) = (v2u){(unsigned)w0, (unsigned)w1}; }
    LDS_WAIT(); asm volatile("" ::: "memory");
}
struct MapId { int off; __device__ __forceinline__ int operator()(int n) const { return off + n; } };
struct MapWin {
    __device__ __forceinline__ int operator()(int n) const {
        if (n < 512) return ZC_AQ + n;
        if (n < 640) return ZC_AK + (n - 512);
        if (n < 768) return ZC_AV + (n - 640);
        if (n < 1792) return ZC_IQ + (n - 768);
        if (n < 1856) return ZC_IK + (n - 1792);
        if (n < 1872) return ZC_IW + (n - 1856);
        if (n < 2896) return ZC_BQ + (n - 1872);
        if (n < 3152) return ZC_BK + (n - 2896);
        if (n < 3408) return ZC_BV + (n - 3152);
        if (n < 3664) return ZC_CQ + (n - 3408);
        if (n < 3920) return ZC_CK + (n - 3664);
        if (n < 4432) return ZC_CV + (n - 3920);
        if (n < 4448) return ZC_CG + (n - 4432);
        if (n < 4960) return ZC_CR + (n - 4448);
        return pg8::ZC_GA + (n - 4960);
    }
};
struct MapWin8 { __device__ __forceinline__ int operator()(int n) const { const int z = MapWin{}(n); return z < 3328 ? z : (z >= 5120 ? z - 1792 : -1); } };
struct MapWinB { __device__ __forceinline__ int operator()(int n) const { const int z = MapWin{}(n); return (z >= 3328 && z < 5120) ? z - 3328 : -1; } };
struct MapW13 { int sel; __device__ __forceinline__ int operator()(int n) const { return 32 * (n >> 4) + 16 * sel + (n & 15); } };

__device__ __forceinline__ void load_row(const float* row, int lane, f32x4 (&v)[8]) {
    const f32x4* xr = (const f32x4*)row + lane;
#pragma unroll
    for (int j = 0; j < 8; ++j) v[j] = xr[64 * j];
}
__device__ __forceinline__ float row_rstd(const f32x4 (&v)[8]) {
    float s = 0.f;
#pragma unroll
    for (int j = 0; j < 8; ++j) s += (v[j].x * v[j].x + v[j].y * v[j].y) + (v[j].z * v[j].z + v[j].w * v[j].w);
    return rsqrtf(wave_sum(s) * (1.0f / 2048.0f) + EPS);
}
__device__ __forceinline__ void norm_store_bf16(const f32x4 (&v)[8], float rstd, const float* g, bf16* orow, int lane) {
    const f32x4* gr = (const f32x4*)g + lane; unsigned long long* o8 = (unsigned long long*)orow + lane;
#pragma unroll
    for (int j = 0; j < 8; ++j) { const f32x4 gg = gr[64 * j];
        o8[64 * j] = (unsigned long long)pk2(v[j].x * rstd * gg.x, v[j].y * rstd * gg.y) | ((unsigned long long)pk2(v[j].z * rstd * gg.z, v[j].w * rstd * gg.w) << 32); }
}

__device__ __forceinline__ void norm_store_fp8(const f32x4 (&v)[8], float rstd, const float* g, unsigned char* orow, int lane) {
    const f32x4* gr = (const f32x4*)g + lane; unsigned* o4 = (unsigned*)orow + lane;
#pragma unroll
    for (int j = 0; j < 8; ++j) { const f32x4 gg = gr[64 * j]; int w = 0;
        w = __builtin_amdgcn_cvt_pk_fp8_f32(clamp8(v[j].x * rstd * gg.x), clamp8(v[j].y * rstd * gg.y), w, false); w = __builtin_amdgcn_cvt_pk_fp8_f32(clamp8(v[j].z * rstd * gg.z), clamp8(v[j].w * rstd * gg.w), w, true);
        o4[64 * j] = (unsigned)w; }
}
__device__ __forceinline__ void convert_moe(Frame& F, int l, int part, int nparts, int lds_off) {
    LAS float* scr = (LAS float*)(F.lds + lds_off + F.wave * 8704);
    bf16* W13 = (bf16*)(F.ws + WS_W13); bf16* W2 = (bf16*)(F.ws + WS_W2);
    constexpr int I13 = (2048 / 64) * (512 / 32);
    constexpr int I2 = (512 / 64) * (2048 / 32);
    constexpr int NIT = NEXP * (2 * I13 + I2);
    const int it_lo = (int)((long)NIT * part / nparts), it_hi = (int)((long)NIT * (part + 1) / nparts);
    for (int it = it_lo + F.gw; it < it_hi; it += F.NGW) {
        const int e = it / (2 * I13 + I2); int r = it % (2 * I13 + I2);
        if (r < I13) { transpose_item_fp8(F.in[I_W1] + ((size_t)l * NEXP + e) * 2048 * 512, 512, (unsigned char*)W13 + (size_t)e * 1024 * 2048, 2048, 64.0f, scr, r, F.lane, MapW13{0}); continue; } r -= I13;
        if (r < I13) { transpose_item_fp8(F.in[I_W3] + ((size_t)l * NEXP + e) * 2048 * 512, 512, (unsigned char*)W13 + (size_t)e * 1024 * 2048, 2048, 64.0f, scr, r, F.lane, MapW13{1}); continue; } r -= I13;
        transpose_item_fp8(F.in[I_W2] + ((size_t)l * NEXP + e) * 512 * 2048, 2048, (unsigned char*)W2 + (size_t)e * 2048 * 512, 512, 32.0f, scr, r, F.lane, MapId{0});
    }
}

template <int MODE>
__device__ __forceinline__ void naive_attn_wave(Frame& F, int l, int row, int g, LAS float* qs) {
    const int lane = F.lane, b = row >> 11, t = row & 2047;
    const bf16* Zr = F.Z + (size_t)row * ZP;
    const int qcol = MODE == 0 ? ZC_AQ : ZC_BQ + 512 * g, kcol = MODE == 0 ? ZC_AK : ZC_BK + 128 * g, vcol = MODE == 0 ? ZC_AV : ZC_BV + 128 * g;
    const int ocol = MODE == 0 ? 0 : 512 + 512 * g, hb = MODE == 0 ? 0 : 4 + 4 * g;
    const LAS float* tab = (const LAS float*)(F.misc + MO_TAB);
    { const v4u w = *(const v4u*)(Zr + qcol + 8 * lane); LAS float* q8 = qs + 8 * lane;
      q8[0] = bflo(w.x); q8[1] = bfhi(w.x); q8[2] = bflo(w.y); q8[3] = bfhi(w.y); q8[4] = bflo(w.z); q8[5] = bfhi(w.z); q8[6] = bflo(w.w); q8[7] = bfhi(w.w); }
    LDS_WAIT(); asm volatile("" ::: "memory");
    float m[4], ls[4], o0[4], o1[4];
#pragma unroll
    for (int h = 0; h < 4; ++h) { m[h] = -1e30f; ls[h] = 0.f; o0[h] = 0.f; o1[h] = 0.f; }
    const int nblk = MODE == 0 ? (t >> 6) + 1 : 2;
    const float scale = 0.08838834764831845f;
    for (int jb = 0; jb < nblk; ++jb) {
        const int sbase = MODE == 0 ? 64 * jb : t - 127 + 64 * jb;
        const int s = sbase + lane; bool sel;
        if (MODE == 0) { const unsigned wd = F.MASK[(size_t)row * 64 + 2 * jb + (lane >> 5)]; sel = (s <= t) && ((wd >> (lane & 31)) & 1u); }
        else sel = s >= 0;
        const unsigned long long bm = __ballot(sel);
        if (bm == 0ull) continue;
        const int sc = sel ? s : t;
        const bf16* kr = F.Z + (size_t)(b * 2048 + sc) * ZP + kcol;
        float d[4] = {0.f, 0.f, 0.f, 0.f};
#pragma unroll 1
        for (int c = 0; c < 16; ++c) {
            const v4u w = *(const v4u*)(kr + 8 * c);
            const float k0 = bflo(w.x), k1 = bfhi(w.x), k2 = bflo(w.y), k3 = bfhi(w.y), k4 = bflo(w.z), k5 = bfhi(w.z), k6 = bflo(w.w), k7 = bfhi(w.w);
#pragma unroll
            for (int h = 0; h < 4; ++h) { const f32x4 qa = *(const LAS f32x4*)(qs + h * 128 + 8 * c), qb = *(const LAS f32x4*)(qs + h * 128 + 8 * c + 4);
                d[h] += (k0 * qa.x + k1 * qa.y) + (k2 * qa.z + k3 * qa.w) + (k4 * qb.x + k5 * qb.y) + (k6 * qb.z + k7 * qb.w); }
        }
        int di = t - s; di = di < 0 ? 0 : (di > 128 ? 128 : di);
        float pr[4];
#pragma unroll
        for (int h = 0; h < 4; ++h) {
            const float lg = sel ? d[h] * scale + tab[(hb + h) * 129 + di] : -1e30f;
            const float mn = fmaxf(m[h], wave_max(lg));
            const float alpha = __expf(m[h] - mn);
            const float p = sel ? __expf(lg - mn) : 0.f;
            ls[h] = ls[h] * alpha + wave_sum(p); o0[h] *= alpha; o1[h] *= alpha; m[h] = mn; pr[h] = p;
        }
        unsigned long long mm = bm;
        while (mm) {
            const int kk = __builtin_ctzll(mm); mm &= mm - 1ull;
            const unsigned vw = *(const unsigned*)(F.Z + (size_t)(b * 2048 + sbase + kk) * ZP + vcol + 2 * lane);
            const float v0 = bflo(vw), v1 = bfhi(vw);
#pragma unroll
            for (int h = 0; h < 4; ++h) { const float ph = __uint_as_float(__builtin_amdgcn_readlane(__float_as_uint(pr[h]), kk)); o0[h] += ph * v0; o1[h] += ph * v1; }
        }
    }
#pragma unroll
    for (int h = 0; h < 4; ++h) {
        float den = ls[h];
        if (MODE == 1) den += __expf(F.in[I_SINK][l * 8 + 4 * g + h] - m[h]);
        const float inv = 1.0f / den;
        *(unsigned*)(F.OCAT + (size_t)row * 2048 + ocol + 128 * h + 2 * lane) = pk2(o0[h] * inv, o1[h] * inv);
    }
    LDS_WAIT(); asm volatile("" ::: "memory");
}


typedef short bf16x8_t __attribute__((ext_vector_type(8)));
typedef float f32x16 __attribute__((ext_vector_type(16)));
typedef short s16x4 __attribute__((ext_vector_type(4)));
__device__ __forceinline__ void indexer_segment(Frame& F, int b, int qb, int tlo, int thi) {
    const int lane = F.lane, n = lane & 15, kq = lane >> 4;
    const bf16* qrow = F.Z + (size_t)(b * 2048 + 16 * qb + n) * ZP;
    bf16x8_t iqf[16][2];
#pragma unroll
    for (int h = 0; h < 16; ++h)
#pragma unroll
        for (int ks = 0; ks < 2; ++ks) iqf[h][ks] = *(const bf16x8_t*)(qrow + ZC_IQ + h * 64 + 32 * ks + 8 * kq);
    float wv[16];
    { const v4u w0 = *(const v4u*)(qrow + ZC_IW), w1 = *(const v4u*)(qrow + ZC_IW + 8);
      wv[0] = bflo(w0.x); wv[1] = bfhi(w0.x); wv[2] = bflo(w0.y); wv[3] = bfhi(w0.y); wv[4] = bflo(w0.z); wv[5] = bfhi(w0.z); wv[6] = bflo(w0.w); wv[7] = bfhi(w0.w);
      wv[8] = bflo(w1.x); wv[9] = bfhi(w1.x); wv[10] = bflo(w1.y); wv[11] = bfhi(w1.y); wv[12] = bflo(w1.z); wv[13] = bfhi(w1.z); wv[14] = bflo(w1.w); wv[15] = bfhi(w1.w); }
    const bf16* kbase = F.Z + (size_t)(b * 2048 + n) * ZP + ZC_IK + 8 * kq;
    float* srow = F.S + (size_t)(b * 2048 + 16 * qb + n) * 2048 + 4 * kq;
    bf16x8_t a0 = *(const bf16x8_t*)(kbase + (size_t)(16 * tlo) * ZP), a1 = *(const bf16x8_t*)(kbase + (size_t)(16 * tlo) * ZP + 32);
#pragma unroll 1
    for (int tile = tlo; tile < thi; ++tile) {
        const int tn = tile + 1 < thi ? tile + 1 : tile;
        const bf16x8_t n0 = *(const bf16x8_t*)(kbase + (size_t)(16 * tn) * ZP), n1 = *(const bf16x8_t*)(kbase + (size_t)(16 * tn) * ZP + 32);
        f32x4 sc = (f32x4){0.f, 0.f, 0.f, 0.f};
#pragma unroll
        for (int h = 0; h < 16; ++h) {
            f32x4 c = __builtin_amdgcn_mfma_f32_16x16x32_bf16(a0, iqf[h][0], (f32x4){0.f, 0.f, 0.f, 0.f}, 0, 0, 0);
            c = __builtin_amdgcn_mfma_f32_16x16x32_bf16(a1, iqf[h][1], c, 0, 0, 0);
            sc[0] += wv[h] * fmaxf(c[0], 0.f); sc[1] += wv[h] * fmaxf(c[1], 0.f); sc[2] += wv[h] * fmaxf(c[2], 0.f); sc[3] += wv[h] * fmaxf(c[3], 0.f);
        }
        *(f32x4*)(srow + 16 * tile) = sc * 0.03125f;
        a0 = n0; a1 = n1;
    }
}

constexpr int FA_KP = 272, FA_VP = 320;
constexpr int FA_KOFF = 0, FA_VOFF = 2 * 64 * FA_KP, FA_BYTES = FA_VOFF + 2 * 64 * FA_VP;
__device__ __forceinline__ s16x4 fa_vtr(const LAS unsigned char* p) { return __builtin_bit_cast(s16x4, __builtin_amdgcn_ds_read_tr16_b64_v4i16((LAS s16x4*)p)); }
template <int MODE>
__device__ __forceinline__ void flash_unit(Frame& F, int l, int b, int g, int t0) {
    const int tid = F.tid, lane = F.lane, wave = F.wave, hh = wave & 3, qh = wave >> 2, r = lane & 31, hf = lane >> 5;
    const int qcol = (MODE == 0 ? ZC_AQ : ZC_BQ + 512 * g) + 128 * hh, kcol = MODE == 0 ? ZC_AK : ZC_BK + 128 * g, vcol = MODE == 0 ? ZC_AV : ZC_BV + 128 * g;
    const int ocol = (MODE == 0 ? 0 : 512 + 512 * g) + 128 * hh, hd = (MODE == 0 ? 0 : 4 + 4 * g) + hh;
    const int tq = t0 + 32 * qh + r; const size_t qrow = (size_t)(b * 2048 + tq);
    const LAS float* tab2 = (const LAS float*)(F.misc + MO_TAB2) + hd * 129;
    LAS unsigned char* lds = F.lds;
    bf16x8_t qf[8];
#pragma unroll
    for (int ks = 0; ks < 8; ++ks) qf[ks] = *(const bf16x8_t*)(F.Z + qrow * ZP + qcol + 16 * ks + 8 * hf);
    f32x16 oacc[4];
#pragma unroll
    for (int dt = 0; dt < 4; ++dt)
#pragma unroll
        for (int i = 0; i < 16; ++i) oacc[dt][i] = 0.f;
    float m_run = -1e30f, l_run = 0.f;
    const int tile_lo = MODE == 0 ? 0 : (t0 >= 128 ? t0 / 64 - 2 : 0), tile_hi = t0 / 64 + 1;
    const int skey = tid >> 4, sdc = tid & 15;
    v4u kreg[2], vreg[2];
    { const bf16* zr = F.Z + (size_t)(b * 2048 + 64 * tile_lo + skey) * ZP;
#pragma unroll
      for (int i = 0; i < 2; ++i) { kreg[i] = *(const v4u*)(zr + (size_t)(32 * i) * ZP + kcol + 8 * sdc); vreg[i] = *(const v4u*)(zr + (size_t)(32 * i) * ZP + vcol + 8 * sdc); } }
    const float sc2 = 0.08838834764831845f * 1.4426950408889634f;
    unsigned mwn[2] = {0xffffffffu, 0xffffffffu};
    if (MODE == 0) { mwn[0] = F.MASK[qrow * 64 + 2 * tile_lo]; mwn[1] = F.MASK[qrow * 64 + 2 * tile_lo + 1]; }
#pragma unroll 1
    for (int kt = tile_lo; kt < tile_hi; ++kt) {
        const int bf = (kt - tile_lo) & 1, s0 = 64 * kt;
        LAS unsigned char* kb = lds + FA_KOFF + bf * (64 * FA_KP); LAS unsigned char* vb = lds + FA_VOFF + bf * (64 * FA_VP);
#pragma unroll
        for (int i = 0; i < 2; ++i) { *(LAS v4u*)(kb + (skey + 32 * i) * FA_KP + 16 * sdc) = kreg[i]; *(LAS v4u*)(vb + (skey + 32 * i) * FA_VP + 16 * sdc) = vreg[i]; }
        __syncthreads();
        if (kt + 1 < tile_hi) { const bf16* zr = F.Z + (size_t)(b * 2048 + 64 * (kt + 1) + skey) * ZP;
#pragma unroll
            for (int i = 0; i < 2; ++i) { kreg[i] = *(const v4u*)(zr + (size_t)(32 * i) * ZP + kcol + 8 * sdc); vreg[i] = *(const v4u*)(zr + (size_t)(32 * i) * ZP + vcol + 8 * sdc); } }
        unsigned mw[2] = {mwn[0], mwn[1]};
        if (MODE == 0 && kt + 1 < tile_hi) { mwn[0] = F.MASK[qrow * 64 + 2 * (kt + 1)]; mwn[1] = F.MASK[qrow * 64 + 2 * (kt + 1) + 1]; }
        f32x16 sacc[2];
#pragma unroll
        for (int k2 = 0; k2 < 2; ++k2) {
#pragma unroll
            for (int i = 0; i < 16; ++i) sacc[k2][i] = 0.f;
#pragma unroll
            for (int ks = 0; ks < 8; ++ks) { const bf16x8_t kf = *(const LAS bf16x8_t*)(kb + (32 * k2 + r) * FA_KP + (16 * ks + 8 * hf) * 2);
                sacc[k2] = __builtin_amdgcn_mfma_f32_32x32x16_bf16(kf, qf[ks], sacc[k2], 0, 0, 0); }
        }
        float mx = -1e30f;
        if (MODE == 0 && s0 + 63 + 128 <= t0) {
            const float bfar = tab2[128];
#pragma unroll
            for (int k2 = 0; k2 < 2; ++k2)
#pragma unroll
                for (int i = 0; i < 16; ++i) { const int cr = (i & 3) + 8 * (i >> 2) + 4 * hf;
                    const float v = ((mw[k2] >> cr) & 1u) ? sacc[k2][i] * sc2 + bfar : -__builtin_inff();
                    sacc[k2][i] = v; mx = fmaxf(mx, v); }
        } else
#pragma unroll
        for (int k2 = 0; k2 < 2; ++k2)
#pragma unroll
            for (int i = 0; i < 16; ++i) { const int cr = (i & 3) + 8 * (i >> 2) + 4 * hf; const int dist = tq - (s0 + 32 * k2 + cr);
                bool ok; if (MODE == 0) ok = (mw[k2] >> cr) & 1u; else ok = dist >= 0 && dist < 128;
                const int di = dist < 0 ? 0 : (dist > 128 ? 128 : dist);
                float vf = sacc[k2][i] * sc2 + tab2[di];
                asm volatile("" : "+v"(vf));
                const float v = ok ? vf : -__builtin_inff();
                sacc[k2][i] = v; mx = fmaxf(mx, v); }
        { const auto sw_ = __builtin_amdgcn_permlane32_swap(__float_as_uint(mx), __float_as_uint(mx), false, false); mx = fmaxf(__uint_as_float(sw_[0]), __uint_as_float(sw_[1])); }
        const float m_new = fmaxf(m_run, mx), alpha = __builtin_amdgcn_exp2f(m_run - m_new); m_run = m_new;
        float ps = 0.f;
#pragma unroll
        for (int k2 = 0; k2 < 2; ++k2)
#pragma unroll
            for (int i = 0; i < 16; ++i) { const float p = __builtin_amdgcn_exp2f(sacc[k2][i] - m_new); sacc[k2][i] = p; ps += p; }
        l_run = l_run * alpha + ps;
        if (__ballot(alpha != 1.0f)) {
#pragma unroll
        for (int dt = 0; dt < 4; ++dt)
#pragma unroll
            for (int i = 0; i < 16; ++i) oacc[dt][i] *= alpha;
        }
#pragma unroll
        for (int k2 = 0; k2 < 2; ++k2)
#pragma unroll
            for (int s2 = 0; s2 < 2; ++s2) {
                v4u pw; pw.x = pg8::cvt_pk_bf16(sacc[k2][8 * s2 + 0], sacc[k2][8 * s2 + 1]); pw.y = pg8::cvt_pk_bf16(sacc[k2][8 * s2 + 2], sacc[k2][8 * s2 + 3]);
                pw.z = pg8::cvt_pk_bf16(sacc[k2][8 * s2 + 4], sacc[k2][8 * s2 + 5]); pw.w = pg8::cvt_pk_bf16(sacc[k2][8 * s2 + 6], sacc[k2][8 * s2 + 7]);
                const bf16x8_t pb = __builtin_bit_cast(bf16x8_t, pw);
                const int i16 = lane & 15, grp = (lane >> 4) & 1;
                const LAS unsigned char* vp = vb + (32 * k2 + 16 * s2 + 4 * hf + (i16 >> 2)) * FA_VP + (16 * grp + 4 * (i16 & 3)) * 2;
#pragma unroll
                for (int dt = 0; dt < 4; ++dt) { const s16x4 lo = fa_vtr(vp + 64 * dt), hi = fa_vtr(vp + 8 * FA_VP + 64 * dt);
                    const bf16x8_t vf = __builtin_shufflevector(lo, hi, 0, 1, 2, 3, 4, 5, 6, 7);
                    oacc[dt] = __builtin_amdgcn_mfma_f32_32x32x16_bf16(vf, pb, oacc[dt], 0, 0, 0); }
            }
    }
    float l_tot = l_run + __shfl_xor(l_run, 32);
    if (MODE == 1) l_tot += __builtin_amdgcn_exp2f(F.in[I_SINK][l * 8 + hd - 4] * 1.4426950408889634f - m_run);
    const float inv = 1.0f / l_tot;
    bf16* orow = F.OCAT + qrow * 2048 + ocol + 4 * hf;
#pragma unroll
    for (int dt = 0; dt < 4; ++dt)
#pragma unroll
        for (int gq = 0; gq < 4; ++gq) { v2u w; w.x = pk2(oacc[dt][4 * gq] * inv, oacc[dt][4 * gq + 1] * inv); w.y = pk2(oacc[dt][4 * gq + 2] * inv, oacc[dt][4 * gq + 3] * inv);
            *(v2u*)(orow + 32 * dt + 8 * gq) = w; }
    __syncthreads();
}


__device__ __forceinline__ void gla_sequence(Frame& F, int l, int b, int h, int dvq) {
    const int tid = F.tid, lane = F.lane, wave = F.wave, r = lane & 31, hf = lane >> 5, i16 = lane & 15, grp = (lane >> 4) & 1;
    LAS unsigned char* L = F.lds;
    constexpr int QG = 0, KG = 9216, KDT = 18432, VT = 27648, TOT = 31744, DEC = 33792, RP = 144;
    const int dk = lane, cg = wave;
    float gwv[16];
#pragma unroll
    for (int q = 0; q < 16; ++q) gwv[q] = F.in[I_CGW][(size_t)l * 4096 + q * 256 + h * 64 + dk];
    const float gb = F.in[I_CGB][l * 256 + h * 64 + dk];
    f32x16 P[2];
#pragma unroll
    for (int i = 0; i < 16; ++i) { P[0][i] = 0.f; P[1][i] = 0.f; }
    v4u rc0[8], rc1[8]; unsigned short rq[8], rk[8]; v4u rv = (v4u){0u, 0u, 0u, 0u};
#define GLA_LOAD(n_) do { const size_t r0_ = (size_t)(b * 2048 + 64 * (n_)); _Pragma("unroll") for (int i = 0; i < 8; ++i) { const bf16* zr = F.Z + (r0_ + 8 * cg + i) * ZP; \
        rc0[i] = *(const v4u*)(zr + ZC_CG); rc1[i] = *(const v4u*)(zr + ZC_CG + 8); rq[i] = zr[ZC_CQ + h * 64 + dk]; rk[i] = zr[ZC_CK + h * 64 + dk]; } \
        if (tid < 256) rv = *(const v4u*)(F.Z + (r0_ + (tid >> 2)) * ZP + ZC_CV + h * 128 + 32 * dvq + 8 * (tid & 3)); } while (0)
    GLA_LOAD(0);
#pragma unroll 1
    for (int n = 0; n < 32; ++n) {
        const size_t row0 = (size_t)(b * 2048 + 64 * n);
        float la[8], qv[8], kv[8];
#pragma unroll
        for (int i = 0; i < 8; ++i) { const v4u c0 = rc0[i], c1 = rc1[i];
            float x = gb;
            x += bflo(c0.x) * gwv[0] + bfhi(c0.x) * gwv[1] + bflo(c0.y) * gwv[2] + bfhi(c0.y) * gwv[3] + bflo(c0.z) * gwv[4] + bfhi(c0.z) * gwv[5] + bflo(c0.w) * gwv[6] + bfhi(c0.w) * gwv[7];
            x += bflo(c1.x) * gwv[8] + bfhi(c1.x) * gwv[9] + bflo(c1.y) * gwv[10] + bfhi(c1.y) * gwv[11] + bflo(c1.z) * gwv[12] + bfhi(c1.z) * gwv[13] + bflo(c1.w) * gwv[14] + bfhi(c1.w) * gwv[15];
            la[i] = (fminf(x, 0.f) - log1pf(__expf(-fabsf(x)))) * 0.0625f;
            qv[i] = bf1(rq[i]); kv[i] = bf1(rk[i]); }
#pragma unroll
        for (int i = 1; i < 8; ++i) la[i] += la[i - 1];
        ((LAS float*)(L + TOT))[cg * 64 + dk] = la[7];
        if (tid < 256) *(LAS v4u*)(L + VT + (tid >> 2) * 64 + 16 * (tid & 3)) = rv;
        __syncthreads();
        float off = 0.f, tot = 0.f;
#pragma unroll
        for (int g2 = 0; g2 < 8; ++g2) { const float tv = ((const LAS float*)(L + TOT))[g2 * 64 + dk]; tot += tv; off += g2 < cg ? tv : 0.f; }
        float kd[8];
#pragma unroll
        for (int i = 0; i < 8; ++i) { const float bi = off + la[i];
            *(LAS bf16*)(L + QG + (8 * cg + i) * RP + 2 * dk) = (bf16)f2bf(qv[i] * 0.125f * __expf(bi));
            *(LAS bf16*)(L + KG + (8 * cg + i) * RP + 2 * dk) = (bf16)f2bf(kv[i] * __expf(-bi));
            kd[i] = kv[i] * __expf(tot - bi); }
        { v4u w; w.x = pk2(kd[0], kd[1]); w.y = pk2(kd[2], kd[3]); w.z = pk2(kd[4], kd[5]); w.w = pk2(kd[6], kd[7]); *(LAS v4u*)(L + KDT + dk * RP + 16 * cg) = w; }
        if (cg == 0) ((LAS float*)(L + DEC))[dk] = __expf(tot);
        __syncthreads();
        if (n + 1 < 32) GLA_LOAD(n + 1);
        if (wave < 2) {
            const int ct = wave;
            f32x16 o;
#pragma unroll
            for (int i = 0; i < 16; ++i) o[i] = 0.f;
#pragma unroll
            for (int st = 0; st < 2; ++st) if (st <= ct) {
                f32x16 at;
#pragma unroll
                for (int i = 0; i < 16; ++i) at[i] = 0.f;
#pragma unroll
                for (int ks = 0; ks < 4; ++ks) { const bf16x8_t a = *(const LAS bf16x8_t*)(L + KG + (32 * st + r) * RP + (16 * ks + 8 * hf) * 2), bq = *(const LAS bf16x8_t*)(L + QG + (32 * ct + r) * RP + (16 * ks + 8 * hf) * 2);
                    at = __builtin_amdgcn_mfma_f32_32x32x16_bf16(a, bq, at, 0, 0, 0); }
                if (st == ct) {
#pragma unroll
                    for (int i = 0; i < 16; ++i) { const int cr = (i & 3) + 8 * (i >> 2) + 4 * hf; at[i] = cr <= r ? at[i] : 0.f; } }
#pragma unroll
                for (int s2 = 0; s2 < 2; ++s2) {
                    v4u pw; pw.x = pg8::cvt_pk_bf16(at[8 * s2 + 0], at[8 * s2 + 1]); pw.y = pg8::cvt_pk_bf16(at[8 * s2 + 2], at[8 * s2 + 3]); pw.z = pg8::cvt_pk_bf16(at[8 * s2 + 4], at[8 * s2 + 5]); pw.w = pg8::cvt_pk_bf16(at[8 * s2 + 6], at[8 * s2 + 7]);
                    const LAS unsigned char* vp = L + VT + (32 * st + 16 * s2 + 4 * hf + (i16 >> 2)) * 64 + (16 * grp + 4 * (i16 & 3)) * 2;
                    const s16x4 lo = fa_vtr(vp), hi = fa_vtr(vp + 8 * 64);
                    o = __builtin_amdgcn_mfma_f32_32x32x16_bf16(__builtin_bit_cast(bf16x8_t, pw), __builtin_shufflevector(lo, hi, 0, 1, 2, 3, 4, 5, 6, 7), o, 0, 0, 0);
                }
            }
#pragma unroll
            for (int dkt = 0; dkt < 2; ++dkt)
#pragma unroll
                for (int s2 = 0; s2 < 2; ++s2) {
                    const LAS unsigned char* qp = L + QG + (32 * ct + r) * RP + (32 * dkt + 16 * s2 + 4 * hf) * 2;
                    const s16x4 lo = *(const LAS s16x4*)qp, hi = *(const LAS s16x4*)(qp + 16);
                    v4u pw; pw.x = pg8::cvt_pk_bf16(P[dkt][8 * s2 + 0], P[dkt][8 * s2 + 1]); pw.y = pg8::cvt_pk_bf16(P[dkt][8 * s2 + 2], P[dkt][8 * s2 + 3]); pw.z = pg8::cvt_pk_bf16(P[dkt][8 * s2 + 4], P[dkt][8 * s2 + 5]); pw.w = pg8::cvt_pk_bf16(P[dkt][8 * s2 + 6], P[dkt][8 * s2 + 7]);
                    o = __builtin_amdgcn_mfma_f32_32x32x16_bf16(__builtin_shufflevector(lo, hi, 0, 1, 2, 3, 4, 5, 6, 7), __builtin_bit_cast(bf16x8_t, pw), o, 0, 0, 0);
                }
            float* go = F.GO + (row0 + 32 * ct + 4 * hf) * 512 + h * 128 + 32 * dvq + r;
#pragma unroll
            for (int i = 0; i < 16; ++i) go[(size_t)((i & 3) + 8 * (i >> 2)) * 512] = o[i];
#pragma unroll
            for (int dkt = 0; dkt < 2; ++dkt) {
                f32x16 cs;
#pragma unroll
                for (int i = 0; i < 16; ++i) cs[i] = 0.f;
#pragma unroll
                for (int ks = 0; ks < 4; ++ks) { const bf16x8_t a = *(const LAS bf16x8_t*)(L + KDT + (32 * dkt + r) * RP + (16 * ks + 8 * hf) * 2);
                    const LAS unsigned char* vp = L + VT + (16 * ks + 8 * hf + (i16 >> 2)) * 64 + (16 * grp + 4 * (i16 & 3)) * 2;
                    const s16x4 lo = fa_vtr(vp), hi = fa_vtr(vp + 4 * 64);
                    cs = __builtin_amdgcn_mfma_f32_32x32x16_bf16(a, __builtin_shufflevector(lo, hi, 0, 1, 2, 3, 4, 5, 6, 7), cs, 0, 0, 0); }
#pragma unroll
                for (int i = 0; i < 16; ++i) { const float dc = ((const LAS float*)(L + DEC))[32 * dkt + (i & 3) + 8 * (i >> 2) + 4 * hf]; P[dkt][i] = dc * P[dkt][i] + cs[i]; }
            }
        }
        __syncthreads();
    }
}

#undef GLA_LOAD

#define GLA_GATE_PREFIX(LDS_TOT) \
        float la[8]; \
        _Pragma("unroll") for (int i = 0; i < 8; ++i) { const v4u c0 = rc0[i], c1 = rc1[i]; float x = gb; \
            x += bflo(c0.x) * gwv[0] + bfhi(c0.x) * gwv[1] + bflo(c0.y) * gwv[2] + bfhi(c0.y) * gwv[3] + bflo(c0.z) * gwv[4] + bfhi(c0.z) * gwv[5] + bflo(c0.w) * gwv[6] + bfhi(c0.w) * gwv[7]; \
            x += bflo(c1.x) * gwv[8] + bfhi(c1.x) * gwv[9] + bflo(c1.y) * gwv[10] + bfhi(c1.y) * gwv[11] + bflo(c1.z) * gwv[12] + bfhi(c1.z) * gwv[13] + bflo(c1.w) * gwv[14] + bfhi(c1.w) * gwv[15]; \
            la[i] = (fminf(x, 0.f) - log1pf(__expf(-fabsf(x)))) * 0.0625f; } \
        _Pragma("unroll") for (int i = 1; i < 8; ++i) la[i] += la[i - 1]; \
        ((LAS float*)(L + LDS_TOT))[cg * 64 + dk] = la[7];
#define GLA_OFFSETS(LDS_TOT) \
        float off = 0.f, tot = 0.f; \
        _Pragma("unroll") for (int g2 = 0; g2 < 8; ++g2) { const float tv = ((const LAS float*)(L + LDS_TOT))[g2 * 64 + dk]; tot += tv; off += g2 < cg ? tv : 0.f; }

__device__ __forceinline__ void gla_state_phase(Frame& F, int l) {
    const int tid = F.tid, lane = F.lane, wave = F.wave, r = lane & 31, hf = lane >> 5, i16 = lane & 15, grp = (lane >> 4) & 1;
    LAS unsigned char* L = F.lds;
    constexpr int KDT = 0, VT = 9216, TOT = 29696, RP = 144, VP = 320;
    const int dk = lane, cg = wave;
    float* GCS = (float*)(F.ws + WS_GCS); float* GDEC = (float*)(F.ws + WS_GDEC);
    v4u rc0[8], rc1[8], rv[2]; unsigned short rk[8];
#define GLS_LOAD(u_) do { const int bh_ = (u_) >> 5, n_ = (u_) & 31; const size_t r0_ = (size_t)((bh_ >> 2) * 2048 + 64 * n_); const int h_ = bh_ & 3; \
        _Pragma("unroll") for (int i = 0; i < 8; ++i) { const bf16* zr = F.Z + (r0_ + 8 * cg + i) * ZP; rc0[i] = *(const v4u*)(zr + ZC_CG); rc1[i] = *(const v4u*)(zr + ZC_CG + 8); rk[i] = zr[ZC_CK + h_ * 64 + dk]; } \
        _Pragma("unroll") for (int i = 0; i < 2; ++i) rv[i] = *(const v4u*)(F.Z + (r0_ + (tid >> 4) + 32 * i) * ZP + ZC_CV + h_ * 128 + 8 * (tid & 15)); } while (0)
    int u = F.vcu;
    if (u < 2048) GLS_LOAD(u);
    for (; u < 2048; u += F.G) {
        const int h = (u >> 5) & 3;
        float gwv[16];
#pragma unroll
        for (int q = 0; q < 16; ++q) gwv[q] = F.in[I_CGW][(size_t)l * 4096 + q * 256 + h * 64 + dk];
        const float gb = F.in[I_CGB][l * 256 + h * 64 + dk];
        GLA_GATE_PREFIX(TOT)
        float kv[8];
#pragma unroll
        for (int i = 0; i < 8; ++i) kv[i] = bf1(rk[i]);
#pragma unroll
        for (int i = 0; i < 2; ++i) *(LAS v4u*)(L + VT + ((tid >> 4) + 32 * i) * VP + 16 * (tid & 15)) = rv[i];
        __syncthreads();
        GLA_OFFSETS(TOT)
        { float kd[8];
#pragma unroll
          for (int i = 0; i < 8; ++i) kd[i] = kv[i] * __expf(tot - (off + la[i]));
          v4u w; w.x = pk2(kd[0], kd[1]); w.y = pk2(kd[2], kd[3]); w.z = pk2(kd[4], kd[5]); w.w = pk2(kd[6], kd[7]); *(LAS v4u*)(L + KDT + dk * RP + 16 * cg) = w; }
        if (cg == 0) GDEC[(size_t)u * 64 + dk] = __expf(tot);
        __syncthreads();
        if (u + F.G < 2048) GLS_LOAD(u + F.G);
        { const int dkt = wave >> 2, dvt = wave & 3;
          f32x16 cs;
#pragma unroll
          for (int i = 0; i < 16; ++i) cs[i] = 0.f;
#pragma unroll
          for (int ks = 0; ks < 4; ++ks) { const bf16x8_t a = *(const LAS bf16x8_t*)(L + KDT + (32 * dkt + r) * RP + (16 * ks + 8 * hf) * 2);
              const LAS unsigned char* vp = L + VT + (16 * ks + 8 * hf + (i16 >> 2)) * VP + (32 * dvt + 16 * grp + 4 * (i16 & 3)) * 2;
              const s16x4 lo = fa_vtr(vp), hi = fa_vtr(vp + 4 * VP);
              cs = __builtin_amdgcn_mfma_f32_32x32x16_bf16(a, __builtin_shufflevector(lo, hi, 0, 1, 2, 3, 4, 5, 6, 7), cs, 0, 0, 0); }
          float* gp = GCS + (size_t)u * 8192 + (size_t)(32 * dkt + 4 * hf) * 128 + 32 * dvt + r;
#pragma unroll
          for (int i = 0; i < 16; ++i) gp[((i & 3) + 8 * (i >> 2)) * 128] = cs[i]; }
        __syncthreads();
    }
#undef GLS_LOAD
}

__device__ __forceinline__ void gla_scan_phase(Frame& F) {
    float* GCS = (float*)(F.ws + WS_GCS); const float* GDEC = (const float*)(F.ws + WS_GDEC);
    for (int gt = F.gw * 64 + F.lane; gt < 64 * 2048; gt += F.NGW * 64) {
        const int bh = gt >> 11, e4 = gt & 2047, dk = e4 >> 5;
        f32x4* p = (f32x4*)(GCS + (size_t)bh * 32 * 8192) + e4; const float* dp = GDEC + (size_t)bh * 32 * 64 + dk;
        f32x4 st = (f32x4){0.f, 0.f, 0.f, 0.f};
#pragma unroll 1
        for (int n0 = 0; n0 < 32; n0 += 8) {
            f32x4 cs[8]; float dc[8];
#pragma unroll
            for (int j = 0; j < 8; ++j) { cs[j] = p[(size_t)(n0 + j) * 2048]; dc[j] = dp[(n0 + j) * 64]; }
#pragma unroll
            for (int j = 0; j < 8; ++j) { p[(size_t)(n0 + j) * 2048] = st; st = st * dc[j] + cs[j]; }
        }
    }
}

__device__ __forceinline__ void gla_out_phase(Frame& F, int l) {
    const int tid = F.tid, lane = F.lane, wave = F.wave, r = lane & 31, hf = lane >> 5, i16 = lane & 15, grp = (lane >> 4) & 1;
    LAS unsigned char* L = F.lds;
    constexpr int QG = 0, KG = 9216, VT = 18432, PT = 38912, TOT = 59392, OT = 61440, RP = 144, VP = 320, OP = 132;
    const int dk = lane, cg = wave;
    const float* GCS = (const float*)(F.ws + WS_GCS);
    v4u rc0[8], rc1[8], rv[2]; unsigned short rq[8], rk[8]; unsigned rg[8]; f32x4 rp[4];
#define GLO_LOAD(u_) do { const int bh_ = (u_) >> 5, n_ = (u_) & 31; const size_t r0_ = (size_t)((bh_ >> 2) * 2048 + 64 * n_); const int h_ = bh_ & 3; \
        _Pragma("unroll") for (int i = 0; i < 8; ++i) { const bf16* zr = F.Z + (r0_ + 8 * cg + i) * ZP; rc0[i] = *(const v4u*)(zr + ZC_CG); rc1[i] = *(const v4u*)(zr + ZC_CG + 8); rq[i] = zr[ZC_CQ + h_ * 64 + dk]; rk[i] = zr[ZC_CK + h_ * 64 + dk]; \
            rg[i] = *(const unsigned*)(zr + ZC_CR + h_ * 128 + 2 * lane); } \
        _Pragma("unroll") for (int i = 0; i < 2; ++i) rv[i] = *(const v4u*)(F.Z + (r0_ + (tid >> 4) + 32 * i) * ZP + ZC_CV + h_ * 128 + 8 * (tid & 15)); \
        _Pragma("unroll") for (int i = 0; i < 4; ++i) rp[i] = *(const f32x4*)(GCS + (size_t)(u_) * 8192 + (size_t)(tid >> 3) * 128 + 16 * (tid & 7) + 4 * i); } while (0)
    int u = F.vcu;
    if (u < 2048) GLO_LOAD(u);
    const float g0 = F.in[I_CNG][l * 128 + 2 * lane], g1 = F.in[I_CNG][l * 128 + 2 * lane + 1];
    for (; u < 2048; u += F.G) {
        const int bh = u >> 5, n = u & 31, h = bh & 3; const size_t row0 = (size_t)((bh >> 2) * 2048 + 64 * n);
        float gwv[16];
#pragma unroll
        for (int q = 0; q < 16; ++q) gwv[q] = F.in[I_CGW][(size_t)l * 4096 + q * 256 + h * 64 + dk];
        const float gb = F.in[I_CGB][l * 256 + h * 64 + dk];
        GLA_GATE_PREFIX(TOT)
        float qv[8], kv[8]; unsigned gr[8];
#pragma unroll
        for (int i = 0; i < 8; ++i) { qv[i] = bf1(rq[i]); kv[i] = bf1(rk[i]); gr[i] = rg[i]; }
#pragma unroll
        for (int i = 0; i < 2; ++i) *(LAS v4u*)(L + VT + ((tid >> 4) + 32 * i) * VP + 16 * (tid & 15)) = rv[i];
        { v4u w0, w1; w0.x = pk2(rp[0].x, rp[0].y); w0.y = pk2(rp[0].z, rp[0].w); w0.z = pk2(rp[1].x, rp[1].y); w0.w = pk2(rp[1].z, rp[1].w);
          w1.x = pk2(rp[2].x, rp[2].y); w1.y = pk2(rp[2].z, rp[2].w); w1.z = pk2(rp[3].x, rp[3].y); w1.w = pk2(rp[3].z, rp[3].w);
          *(LAS v4u*)(L + PT + (tid >> 3) * VP + 32 * (tid & 7)) = w0; *(LAS v4u*)(L + PT + (tid >> 3) * VP + 32 * (tid & 7) + 16) = w1; }
        __syncthreads();
        GLA_OFFSETS(TOT)
#pragma unroll
        for (int i = 0; i < 8; ++i) { const float bi = off + la[i];
            *(LAS bf16*)(L + QG + (8 * cg + i) * RP + 2 * dk) = (bf16)f2bf(qv[i] * 0.125f * __expf(bi));
            *(LAS bf16*)(L + KG + (8 * cg + i) * RP + 2 * dk) = (bf16)f2bf(kv[i] * __expf(-bi)); }
        __syncthreads();
        if (u + F.G < 2048) GLO_LOAD(u + F.G);
        { const int ct = wave >> 2, dvt = wave & 3;
          f32x16 o;
#pragma unroll
          for (int i = 0; i < 16; ++i) o[i] = 0.f;
#pragma unroll
          for (int st = 0; st < 2; ++st) if (st <= ct) {
              f32x16 at;
#pragma unroll
              for (int i = 0; i < 16; ++i) at[i] = 0.f;
#pragma unroll
              for (int ks = 0; ks < 4; ++ks) { const bf16x8_t a = *(const LAS bf16x8_t*)(L + KG + (32 * st + r) * RP + (16 * ks + 8 * hf) * 2), bq = *(const LAS bf16x8_t*)(L + QG + (32 * ct + r) * RP + (16 * ks + 8 * hf) * 2);
                  at = __builtin_amdgcn_mfma_f32_32x32x16_bf16(a, bq, at, 0, 0, 0); }
              if (st == ct) {
#pragma unroll
                  for (int i = 0; i < 16; ++i) { const int cr = (i & 3) + 8 * (i >> 2) + 4 * hf; at[i] = cr <= r ? at[i] : 0.f; } }
#pragma unroll
              for (int s2 = 0; s2 < 2; ++s2) {
                  v4u pw; pw.x = pg8::cvt_pk_bf16(at[8 * s2 + 0], at[8 * s2 + 1]); pw.y = pg8::cvt_pk_bf16(at[8 * s2 + 2], at[8 * s2 + 3]); pw.z = pg8::cvt_pk_bf16(at[8 * s2 + 4], at[8 * s2 + 5]); pw.w = pg8::cvt_pk_bf16(at[8 * s2 + 6], at[8 * s2 + 7]);
                  const LAS unsigned char* vp = L + VT + (32 * st + 16 * s2 + 4 * hf + (i16 >> 2)) * VP + (32 * dvt + 16 * grp + 4 * (i16 & 3)) * 2;
                  const s16x4 lo = fa_vtr(vp), hi = fa_vtr(vp + 8 * VP);
                  o = __builtin_amdgcn_mfma_f32_32x32x16_bf16(__builtin_bit_cast(bf16x8_t, pw), __builtin_shufflevector(lo, hi, 0, 1, 2, 3, 4, 5, 6, 7), o, 0, 0, 0);
              }
          }
#pragma unroll
          for (int ks = 0; ks < 4; ++ks) { const bf16x8_t a = *(const LAS bf16x8_t*)(L + QG + (32 * ct + r) * RP + (16 * ks + 8 * hf) * 2);
              const LAS unsigned char* pp = L + PT + (16 * ks + 8 * hf + (i16 >> 2)) * VP + (32 * dvt + 16 * grp + 4 * (i16 & 3)) * 2;
              const s16x4 lo = fa_vtr(pp), hi = fa_vtr(pp + 4 * VP);
              o = __builtin_amdgcn_mfma_f32_32x32x16_bf16(a, __builtin_shufflevector(lo, hi, 0, 1, 2, 3, 4, 5, 6, 7), o, 0, 0, 0); }
          LAS float* op = (LAS float*)(L + OT) + (32 * ct + 4 * hf) * OP + 32 * dvt + r;
#pragma unroll
          for (int i = 0; i < 16; ++i) op[((i & 3) + 8 * (i >> 2)) * OP] = o[i]; }
        __syncthreads();
        { float a[8], c[8], ss[8];
#pragma unroll
          for (int i = 0; i < 8; ++i) { const LAS float* orow = (const LAS float*)(L + OT) + (8 * wave + i) * OP + 2 * lane; a[i] = orow[0]; c[i] = orow[1]; ss[i] = a[i] * a[i] + c[i] * c[i]; }
#pragma unroll
          for (int o2 = 1; o2 < 64; o2 <<= 1) {
#pragma unroll
              for (int i = 0; i < 8; ++i) ss[i] += __shfl_xor(ss[i], o2); }
#pragma unroll
          for (int i = 0; i < 8; ++i) { const float rstd = rsqrtf(ss[i] * (1.0f / 128.0f) + EPS);
              *(unsigned*)(F.OCAT + (row0 + 8 * wave + i) * 2048 + 1536 + h * 128 + 2 * lane) = pk2(a[i] * rstd * g0 * bflo(gr[i]), c[i] * rstd * g1 * bfhi(gr[i])); } }
        __syncthreads();
    }
#undef GLO_LOAD
}
#undef GLA_GATE_PREFIX
#undef GLA_OFFSETS

__device__ __forceinline__ bool in_phase(int k, int lo, int hi) { asm volatile("" : "+s"(k)); return lo <= k && k < hi; }
#define IN(k) in_phase((k), lo, hi)
#ifndef PROBE_MASK
#define PROBE_MASK 0
#endif
__device__ __forceinline__ int probe_reps(int k) { int n = 1 + ((PROBE_MASK >> k) & 1); asm volatile("" : "+s"(n)); return n; }
#define PHASE_LANE() do { int _tz = threadIdx.x; asm volatile("" : "+v"(_tz)); F.tid = _tz; F.lane = _tz & 63; } while (0)
#define SEAM(k) do { if (IN(k) && IN((k) + 1)) xcd_barrier(bar); } while (0)
template <int l>
__device__ __forceinline__ void layer_body(Frame& F, const XcdBarrier& bar, const int lo, const int hi) {
    constexpr int pb = 1 + 11 * l;
        if (IN(pb + 0)) {
            { pg8::Gemm g{F.XN, (const bf16*)(F.ws + WS_WIN + l * WIN_L + 24 * MiB), T, 1792, D}; pg8::StaticOrder S; S.init(T, 1792, D, F.G, (int)blockIdx.x);
              pg8::EpiInProj<1> E{F.Z, (LAS unsigned long long*)(F.misc + MO_SS), (const LAS float*)(F.misc + MO_GN) + l * 512};
              pg8::gemm_phase<pg8::EpiInProj<1>, pg8::StaticOrder, true, false>(F.lds, g, S, E); }
            { pg8::Gemm g{(const bf16*)(F.ws + WS_XN8), (const bf16*)(F.ws + WS_WIN + l * WIN_L), T, 9472, D / 2}; pg8::StaticOrder S; S.init(T, 9472, D / 2, F.G, ((int)blockIdx.x + F.G / 2) % F.G);
              pg8::EpiInProj<0> E{F.Z, (LAS unsigned long long*)(F.misc + MO_SS), (const LAS float*)(F.misc + MO_GN) + l * 512};
              pg8::gemm_phase<pg8::EpiInProj<0>, pg8::StaticOrder, true, true>(F.lds, g, S, E); }
        }
        SEAM(pb + 0);
        if (IN(pb + 1)) { PHASE_LANE();
            if (F.wave & 4) convert_moe(F, l, 0, 4, 40960);
            for (int it = F.gw; it < NB * 128; it += F.NGW) {
                const int b = it >> 7, j = it & 127;
                indexer_segment(F, b, j, 0, j < 64 ? j + 1 : 64);
                if (j < 64) indexer_segment(F, b, 127 - j, 64, 128 - j);
            }
            if (!(F.wave & 4)) convert_moe(F, l, 0, 4, 40960);
            PHASE_LANE();
            gla_state_phase(F, l);
        }
        SEAM(pb + 1);
        if (IN(pb + 2)) { PHASE_LANE();
            if (F.wave & 4) convert_moe(F, l, 1, 4, 0);
            for (int row = F.gw; row < T; row += F.NGW) {
                const int t = row & 2047;
                if (t < 256) { const int nb = t + 1 - 32 * F.lane; F.MASK[(size_t)row * 64 + F.lane] = nb >= 32 ? 0xffffffffu : (nb <= 0 ? 0u : ((1u << nb) - 1u)); continue; }
                float val[32];
#pragma unroll
                for (int j = 0; j < 32; ++j) { const int s_ = 64 * j + F.lane; val[j] = F.S[(size_t)row * 2048 + (s_ < t ? s_ : t)]; }
                float vmx = -3.0e38f, vmn = 3.0e38f;
#pragma unroll
                for (int j = 0; j < 32; ++j) { const bool ok = 64 * j + F.lane <= t; val[j] = ok ? val[j] : -3.0e38f; vmx = fmaxf(vmx, val[j]); vmn = fminf(vmn, ok ? val[j] : 3.0e38f); }
#pragma unroll
                for (int o = 1; o < 64; o <<= 1) { vmx = fmaxf(vmx, __shfl_xor(vmx, o)); vmn = fminf(vmn, __shfl_xor(vmn, o)); }
                float lo = vmn, hi = vmx, thf = 0.f; bool exact = false;
#pragma unroll 1
                for (int it = 0; it < 28; ++it) { const float mid = 0.5f * (lo + hi); if (!(mid > lo && mid < hi)) break; int cnt = 0;
#pragma unroll
                    for (int j = 0; j < 32; ++j) cnt += __popcll(__ballot(val[j] >= mid));
                    if (cnt == 256) { exact = true; thf = mid; break; }
                    if (cnt > 256) lo = mid; else hi = mid; }
                unsigned th = 0u; int need = 0;
#define KEYOF(x) ({ const unsigned u_ = __float_as_uint(x); (u_ & 0x80000000u) ? ~u_ : (u_ | 0x80000000u); })
                if (!exact) {
#pragma unroll 1
                    for (int bit = 31; bit >= 0; --bit) { const unsigned cand = th | (1u << bit); int cnt = 0;
#pragma unroll
                        for (int j = 0; j < 32; ++j) cnt += __popcll(__ballot(KEYOF(val[j]) >= cand));
                        if (cnt >= 256) th = cand; }
                    int cgt = 0;
#pragma unroll
                    for (int j = 0; j < 32; ++j) cgt += __popcll(__ballot(KEYOF(val[j]) > th));
                    need = 256 - cgt;
                }
                int run = 0; unsigned myword = 0u;
#pragma unroll
                for (int j = 0; j < 32; ++j) {
                    bool sel;
                    if (exact) sel = val[j] >= thf;
                    else { const unsigned kj = KEYOF(val[j]); const bool eq = kj == th; const unsigned long long eqm = __ballot(eq);
                        const int pre = run + __popcll(eqm & ((1ull << F.lane) - 1ull)); sel = (kj > th) || (eq && pre < need); run += __popcll(eqm); sel = sel && (64 * j + F.lane <= t); }
                    const unsigned long long sm = __ballot(sel);
                    if ((F.lane >> 1) == j) myword = (F.lane & 1) ? (unsigned)(sm >> 32) : (unsigned)sm;
                }
#undef KEYOF
                F.MASK[(size_t)row * 64 + F.lane] = myword;
            }
            if (!(F.wave & 4)) convert_moe(F, l, 1, 4, 0);
            gla_scan_phase(F);
        }
        SEAM(pb + 2);
        if (IN(pb + 3)) { PHASE_LANE();
            if (F.vcu & 1) { convert_moe(F, l, 1, 2, 0); __syncthreads(); PHASE_LANE(); }
            for (int u = F.vcu; u < NB * 16; u += F.G) { const int b = u >> 4, p = u & 15; flash_unit<0>(F, l, b, 0, 64 * (31 - p)); flash_unit<0>(F, l, b, 0, 64 * p); }
            for (int u = F.vcu; u < NB * 2 * 32; u += F.G) { const int b = u >> 6, g = (u >> 5) & 1, qb = u & 31; flash_unit<1>(F, l, b, g, 64 * qb); }
            gla_out_phase(F, l);
            if (!(F.vcu & 1)) { PHASE_LANE(); convert_moe(F, l, 1, 2, 0); }
        }
        SEAM(pb + 3);
        if (IN(pb + 4)) {
            pg8::Gemm g{F.OCAT, (const bf16*)(F.ws + WS_WBR + l * WBR_L), T, D, D}; pg8::MergeOrder S; S.init(T, D, D, F.G, (int)blockIdx.x);
            pg8::EpiMerge E{F.Z, F.MERGED};
            pg8::gemm_phase<pg8::EpiMerge, pg8::MergeOrder, false>(F.lds, g, S, E);
        }
        SEAM(pb + 4);
        if (IN(pb + 5)) {
            pg8::Gemm g{F.MERGED, (const bf16*)(F.ws + WS_WO + l * WO_L), T, D, D}; pg8::StaticOrder S; S.init(T, D, D, F.G, (int)blockIdx.x);
            pg8::EpiResid<(l > 0)> E{F.in[I_X], (bf16*)(F.ws + WS_HB), (unsigned char*)F.XN, F.in[I_N2G] + l * D};
            pg8::gemm_phase<pg8::EpiResid<(l > 0)>, pg8::StaticOrder, false>(F.lds, g, S, E);
        }
        SEAM(pb + 5);
        if (IN(pb + 6)) { PHASE_LANE();
            unsigned* cnt = F.ctl + CW_CNT + 64 * l;
            const int lane = F.lane, fr = lane & 15, fq = lane >> 4;
            LAS float* LG = (LAS float*)(F.lds + F.wave * 8192);
            const bf16* wrh = (const bf16*)(F.ws + WS_WRH + l * WR_L) + (size_t)fr * 2048 + 8 * fq; const bf16* wrl = (const bf16*)(F.ws + WS_WRL + l * WR_L) + (size_t)fr * 2048 + 8 * fq;
            for (int tile = F.gw; tile < T / 16; tile += F.NGW) {
                const bf16* hrow = (const bf16*)(F.ws + WS_HB) + (size_t)(16 * tile + fr) * D + 8 * fq;
                f32x4 acc[6];
#pragma unroll
                for (int nt = 0; nt < 6; ++nt) acc[nt] = (f32x4){0.f, 0.f, 0.f, 0.f};
                float ss = 0.f;
#pragma unroll 2
                for (int ks = 0; ks < 64; ++ks) {
                    const v4u hw = *(const v4u*)(hrow + 32 * ks);
                    { const float a0 = bflo(hw.x), a1 = bfhi(hw.x), a2 = bflo(hw.y), a3 = bfhi(hw.y), a4 = bflo(hw.z), a5 = bfhi(hw.z), a6 = bflo(hw.w), a7 = bfhi(hw.w);
                      ss += (a0 * a0 + a1 * a1) + (a2 * a2 + a3 * a3) + (a4 * a4 + a5 * a5) + (a6 * a6 + a7 * a7); }
                    const bf16x8_t ah = __builtin_bit_cast(bf16x8_t, hw);
#pragma unroll
                    for (int nt = 0; nt < 6; ++nt) { const bf16x8_t bh = *(const bf16x8_t*)(wrh + (size_t)(16 * nt) * 2048 + 32 * ks), bl = *(const bf16x8_t*)(wrl + (size_t)(16 * nt) * 2048 + 32 * ks);
                        acc[nt] = __builtin_amdgcn_mfma_f32_16x16x32_bf16(ah, bh, acc[nt], 0, 0, 0);
                        acc[nt] = __builtin_amdgcn_mfma_f32_16x16x32_bf16(ah, bl, acc[nt], 0, 0, 0); }
                }
                ss += __shfl_xor(ss, 16); ss += __shfl_xor(ss, 32);
                if (fq == 0) { const float rs_ = rsqrtf(ss * (1.0f / 2048.0f) + EPS); LG[1600 + fr] = rs_; ((float*)(F.ws + WS_RSTD))[16 * tile + fr] = rs_; }
#pragma unroll
                for (int nt = 0; nt < 6; ++nt)
#pragma unroll
                    for (int i = 0; i < 4; ++i) LG[(4 * fq + i) * 100 + 16 * nt + fr] = acc[nt][i];
                LDS_WAIT(); asm volatile("" ::: "memory");
                if (lane < 16) {
                    const int row = 16 * tile + lane; const float rstd = LG[1600 + lane]; const LAS float* lr = LG + lane * 100;
                    float lg[8]; int grp = 0; float gmax = -3.0e38f;
#pragma unroll
                    for (int e = 0; e < 8; ++e) { lg[e] = lr[e] * rstd + F.in[I_BRG][l * 8 + e]; if (lg[e] > gmax) { gmax = lg[e]; grp = e; } }
                    float gden = 0.f;
#pragma unroll
                    for (int e = 0; e < 8; ++e) gden += __expf(lg[e] - gmax);
                    const float gwt = 1.0f / gden;
                    int i0 = 0, i1 = 0; float m0 = -3.0e38f, m1 = -3.0e38f;
#pragma unroll
                    for (int e = 0; e < 8; ++e) { const float v = lr[8 + grp * 8 + e] * rstd + F.in[I_BRE][l * 64 + grp * 8 + e];
                        if (v > m0) { m1 = m0; i1 = i0; m0 = v; i0 = e; } else if (v > m1) { m1 = v; i1 = e; } }
                    const float e1 = __expf(m1 - m0); const float p0 = 1.0f / (1.0f + e1), p1 = e1 / (1.0f + e1);
                    const int ex0 = grp * 8 + i0, ex1 = grp * 8 + i1;
                    const unsigned r0 = atomicAdd(&cnt[ex0], 1u), r1 = atomicAdd(&cnt[ex1], 1u);
                    unsigned* rec = (unsigned*)(F.ws + WS_ROUTE) + (size_t)row * 8;
                    rec[0] = (unsigned)ex0; rec[1] = r0; rec[2] = (unsigned)ex1; rec[3] = r1; rec[4] = __float_as_uint(gwt * p0); rec[5] = __float_as_uint(gwt * p1);
                    int* liste = (int*)(F.ws + WS_LISTE); liste[(size_t)ex0 * 32768 + r0] = row; liste[(size_t)ex1 * 32768 + r1] = row;
                }
                LDS_WAIT(); asm volatile("" ::: "memory");
            }
        }
        SEAM(pb + 6);
        if (IN(pb + 7) || IN(pb + 8) || IN(pb + 9) || IN(pb + 10)) { PHASE_LANE();
            if (F.tid == 0) { const unsigned* cnt = F.ctl + CW_CNT + 64 * l; LAS int* texp = (LAS int*)(F.misc + MO_TEXP); LAS int* pst = (LAS int*)(F.misc + MO_PST); int tb = 0;
                for (int e = 0; e < NEXP; ++e) { const int c = (int)__hip_atomic_load(&cnt[e], __ATOMIC_RELAXED, __HIP_MEMORY_SCOPE_AGENT); const int nt_ = (c + 255) >> 8; pst[e] = tb * 256; ((LAS int*)(F.misc + MO_CNT))[e] = c;
                    for (int r = 0; r < nt_; ++r) texp[tb + r] = e; tb += nt_; }
                *(LAS int*)(F.misc + MO_TOT) = tb; }
            __syncthreads();
        }
        if (IN(pb + 8)) {
            pg8::Gemm g{F.XN, (const bf16*)(F.ws + WS_W13), 0, 0, D / 2};
            pg8::MoeGatherOrder S; S.total = *(const LAS int*)(F.misc + MO_TOT) * 4; S.G = F.G; S.c = F.vcu; S.NJ = 4; S.nt0 = D / 128; S.tile_exp = (const LAS int*)(F.misc + MO_TEXP);
            S.pst = (const LAS int*)(F.misc + MO_PST); S.cnt = (const LAS int*)(F.misc + MO_CNT); S.liste = (const int*)(F.ws + WS_LISTE);
            pg8::EpiGlu E{F.H, S.tile_exp, S.pst, S.cnt, S.liste, (const float*)(F.ws + WS_RSTD)};
            pg8::gemm_phase<pg8::EpiGlu, pg8::MoeGatherOrder, true, true>(F.lds, g, S, E);
        }
        SEAM(pb + 8);
        if (IN(pb + 9)) {
            pg8::Gemm g{F.H, (const bf16*)(F.ws + WS_W2), 0, 0, DEXP / 2};
            pg8::MoeOrder S{*(const LAS int*)(F.misc + MO_TOT) * 8, F.G, F.vcu, 8, DEXP / 128, (const LAS int*)(F.misc + MO_TEXP)};
            pg8::EpiY E{(unsigned char*)F.Y};
            pg8::gemm_phase<pg8::EpiY, pg8::MoeOrder, true, true>(F.lds, g, S, E);
        }
        SEAM(pb + 9);
        if (IN(pb + 10)) { PHASE_LANE();
            for (int row = F.gw; row < T; row += F.NGW) {
                const unsigned* rec = (const unsigned*)(F.ws + WS_ROUTE) + (size_t)row * 8;
                const float w0 = __uint_as_float(rec[4]) * 0.03125f, w1 = __uint_as_float(rec[5]) * 0.03125f;
                const LAS int* pst = (const LAS int*)(F.misc + MO_PST); const int p0 = pst[rec[0]] + (int)rec[1], p1 = pst[rec[2]] + (int)rec[3];
                const unsigned* y0 = (const unsigned*)((const unsigned char*)F.Y + (size_t)p0 * D) + F.lane; const unsigned* y1 = (const unsigned*)((const unsigned char*)F.Y + (size_t)p1 * D) + F.lane;
                f32x4 v[8];
                { const v2u* hr = (const v2u*)((const bf16*)(F.ws + WS_HB) + (size_t)row * D) + F.lane;
#pragma unroll
                  for (int j = 0; j < 8; ++j) { const v2u w = hr[64 * j]; v[j] = (f32x4){bflo(w.x), bfhi(w.x), bflo(w.y), bfhi(w.y)}; } }
#pragma unroll
                for (int j = 0; j < 8; ++j) { const int a = (int)y0[64 * j], c = (int)y1[64 * j];
                    const auto a01 = __builtin_amdgcn_cvt_pk_f32_fp8(a, false), a23 = __builtin_amdgcn_cvt_pk_f32_fp8(a, true), c01 = __builtin_amdgcn_cvt_pk_f32_fp8(c, false), c23 = __builtin_amdgcn_cvt_pk_f32_fp8(c, true);
                    v[j].x += w0 * a01[0] + w1 * c01[0]; v[j].y += w0 * a01[1] + w1 * c01[1]; v[j].z += w0 * a23[0] + w1 * c23[0]; v[j].w += w0 * a23[1] + w1 * c23[1]; }
                if (l + 1 < DEPTH) { v2u* hw_ = (v2u*)((bf16*)(F.ws + WS_HB) + (size_t)row * D) + F.lane;
#pragma unroll
                    for (int j = 0; j < 8; ++j) hw_[64 * j] = (v2u){pg8::cvt_pk_bf16(v[j].x, v[j].y), pg8::cvt_pk_bf16(v[j].z, v[j].w)}; }
                else { f32x4* orow = (f32x4*)(F.out + (size_t)row * D) + F.lane;
#pragma unroll
                    for (int j = 0; j < 8; ++j) orow[64 * j] = v[j]; }
                if (l + 1 < DEPTH) { const float rstd = row_rstd(v); norm_store_bf16(v, rstd, F.in[I_N1G] + (l + 1) * D, F.XN + (size_t)row * D, F.lane); norm_store_fp8(v, rstd, F.in[I_N1G] + (l + 1) * D, (unsigned char*)(F.ws + WS_XN8) + (size_t)row * D, F.lane); }
            }
        }
        SEAM(pb + 10);
    }
__global__ void __launch_bounds__(NWAVES * 64, 2) fwd_kernel(Args args) {
    extern __shared__ __attribute__((aligned(16))) unsigned char lds_raw[];
    Frame F;
    F.lds = (LAS unsigned char*)lds_raw; F.misc = F.lds + MISC_OFF;
    F.tid = threadIdx.x; F.lane = F.tid & 63; F.wave = __builtin_amdgcn_readfirstlane(F.tid >> 6);
    F.G = gridDim.x; { const int bx = blockIdx.x; F.vcu = (F.G % 8 == 0) ? (bx % 8) * (F.G / 8) + bx / 8 : bx; }
    F.gw = F.vcu * NWAVES + F.wave; F.NGW = F.G * NWAVES;
    F.in = args.in; F.out = args.out; F.ws = args.ws; F.ctl = (unsigned*)(args.ws + WS_CTL);
    F.Z = (bf16*)(args.ws + WS_Z); F.XN = (bf16*)(args.ws + WS_XN); F.OCAT = (bf16*)(args.ws + WS_OCAT); F.MERGED = (bf16*)(args.ws + WS_MERGED);
    F.XS = (bf16*)(args.ws + WS_XS); F.Y = (bf16*)(args.ws + WS_Y); F.H = (bf16*)(args.ws + WS_H);
    F.S = (float*)(args.ws + WS_S); F.GO = (float*)(args.ws + WS_GO); F.MASK = (unsigned*)(args.ws + WS_MASK);
    const int lo = args.ph_lo, hi = args.ph_hi;
    const bool use_bar = (hi - lo) > 1;
    for (int u = F.tid; u < 64; u += NWAVES * 64) ((LAS unsigned*)F.misc)[u] = 0u;
    ((LAS unsigned long long*)(F.misc + MO_SS))[F.tid] = 0ull;
    for (int i = F.tid; i < 2 * 4 * 128; i += NWAVES * 64) { const int l_ = i >> 9, k_ = (i >> 7) & 3, d_ = i & 127; ((LAS float*)(F.misc + MO_GN))[i] = F.in[k_ == 0 ? I_AQG : (k_ == 1 ? I_AKG : (k_ == 2 ? I_BQG : I_BKG))][l_ * 128 + d_]; }
    for (int i = F.tid; i < 12 * 129; i += NWAVES * 64) { const int hd = i / 129, dd = i % 129; int bk;
        if (dd < 16) bk = dd; else { bk = 16 + (int)(logf((float)dd / 16.0f) / 2.0794415416798357f * 16.0f); bk = bk > 31 ? 31 : bk; }
        ((LAS float*)(F.misc + MO_TAB2))[i] = F.in[I_RELB][bk * 12 + hd] * 1.4426950408889634f; }
    __syncthreads();
    XcdBarrier bar; bar.bar = F.ctl + CW_BAR; bar.x = 0; bar.st = nullptr;
    if (use_bar) bar = xcd_barrier_post(F.ctl + CW_BAR, (volatile LAS unsigned*)(F.misc + MO_BARW));

    if (IN(0)) { PHASE_LANE();
        LAS float* scr = (LAS float*)(F.lds + F.wave * 16384);
        constexpr int I_IN = (2048 / 64) * (D_IN / 32);
        constexpr int I_BA = (512 / 64) * (2048 / 32), I_BB = (1024 / 64) * (2048 / 32), I_BC = I_BA, I_O = (2048 / 64) * (2048 / 32);
        constexpr int PER_L = I_IN + I_BA + I_BB + I_BC + I_O;
        for (int it = F.gw; it < DEPTH * PER_L; it += F.NGW) {
            const int l = it / PER_L; int r = it % PER_L;
            bf16* win = (bf16*)(F.ws + WS_WIN + l * WIN_L); bf16* wbr = (bf16*)(F.ws + WS_WBR + l * WBR_L); bf16* wo = (bf16*)(F.ws + WS_WO + l * WO_L);
            if (r < I_IN) { const int nb_ = r % (D_IN / 32);
                const bool has8 = nb_ < 56 || (nb_ >= 58 && nb_ <= 106) || nb_ >= 155, hasb = (nb_ >= 56 && nb_ <= 58) || (nb_ >= 106 && nb_ < 155);
                if (has8) transpose_item_fp8(F.in[I_WIN] + (size_t)l * 2048 * D_IN, D_IN, (unsigned char*)win, 2048, 64.0f, scr, r, F.lane, MapWin8{});
                if (hasb) transpose_item(F.in[I_WIN] + (size_t)l * 2048 * D_IN, D_IN, win + (size_t)12 * 1024 * 1024, 2048, 0, scr, r, F.lane, MapWinB{});
                continue; } r -= I_IN;
            if (r < I_BA) { transpose_item(F.in[I_WBA] + (size_t)l * 512 * 2048, 2048, wbr, 2048, 0, scr, r, F.lane, MapId{0}); continue; } r -= I_BA;
            if (r < I_BB) { transpose_item(F.in[I_WBB] + (size_t)l * 1024 * 2048, 2048, wbr, 2048, 512, scr, r, F.lane, MapId{0}); continue; } r -= I_BB;
            if (r < I_BC) { transpose_item(F.in[I_WBC] + (size_t)l * 512 * 2048, 2048, wbr, 2048, 1536, scr, r, F.lane, MapId{0}); continue; } r -= I_BC;
            transpose_item(F.in[I_WO] + (size_t)l * 2048 * 2048, 2048, wo, 2048, 0, scr, r, F.lane, MapId{0});
        }
        for (int i = F.gw * 64 + F.lane; i < DEPTH * 160 * 256; i += F.NGW * 64) { const int l = i / (160 * 256), r = (i / 256) % 160, c = i % 256;
            *(v4u*)((bf16*)(F.ws + WS_WIN + l * WIN_L) + (size_t)12 * 1024 * 1024 + (size_t)(ZC_PAD - 3328 + r) * 2048 + 8 * c) = (v4u){0u, 0u, 0u, 0u}; }
        for (int i = F.gw * 64 + F.lane; i < DEPTH * 96 * 2048; i += F.NGW * 64) { const int l = i / (96 * 2048), e = (i / 2048) % 96, k = i % 2048;
            float val = 0.f; if (e < 8) val = F.in[I_WRG][(size_t)l * D * 8 + (size_t)k * 8 + e]; else if (e < 72) val = F.in[I_WRE][(size_t)l * D * 64 + (size_t)k * 64 + (e - 8)];
            val *= F.in[I_N2G][l * D + k];
            const unsigned hi = f2bf(val); const float rem = val - bf1((bf16)hi);
            ((bf16*)(F.ws + WS_WRH + l * WR_L))[e * 2048 + k] = (bf16)hi; ((bf16*)(F.ws + WS_WRL + l * WR_L))[e * 2048 + k] = (bf16)f2bf(rem); }
        for (int mrow = F.gw; mrow < T; mrow += F.NGW) { f32x4 v[8]; load_row(F.in[I_X] + (size_t)mrow * D, F.lane, v); const float rstd = row_rstd(v);
            norm_store_bf16(v, rstd, F.in[I_N1G], F.XN + (size_t)mrow * D, F.lane); norm_store_fp8(v, rstd, F.in[I_N1G], (unsigned char*)(F.ws + WS_XN8) + (size_t)mrow * D, F.lane); }
    }
    SEAM(0);

    layer_body<0>(F, bar, lo, hi);
    layer_body<1>(F, bar, lo, hi);
}


#ifndef N_LAUNCH_MODE
#define N_LAUNCH_MODE 1
#endif
extern "C" void kernel_launch(void* const* d_in, const int* in_sizes, int n_in, void* d_out, int out_size, void* d_ws, size_t ws_size, hipStream_t stream) {
    static int grid = 0;
    if (grid == 0) {
        if (n_in != 24 || out_size != T * D || ws_size < WS_END) { fprintf(stderr, "kernel_launch: unexpected shapes (n_in %d out %d ws %zu)\n", n_in, out_size, ws_size); grid = -1; return; }
        int dev = 0, cus = 0, per_cu = 0;
        if (hipGetDevice(&dev) != hipSuccess || hipDeviceGetAttribute(&cus, hipDeviceAttributeMultiprocessorCount, dev) != hipSuccess) { grid = -1; return; }
        if (hipFuncSetAttribute((const void*)fwd_kernel, hipFuncAttributeMaxDynamicSharedMemorySize, LDS_BYTES) != hipSuccess) { fprintf(stderr, "kernel_launch: hipFuncSetAttribute failed\n"); grid = -1; return; }
        if (hipOccupancyMaxActiveBlocksPerMultiprocessor(&per_cu, (const void*)fwd_kernel, NWAVES * 64, LDS_BYTES) != hipSuccess || per_cu < 1) { fprintf(stderr, "kernel_launch: occupancy query says %d\n", per_cu); }
        (void)hipGetLastError();
        grid = cus;
    }
    if (grid < 0) return;
    (void)hipMemsetAsync((char*)d_ws + WS_CTL, 0, CTL_ZERO_BYTES, stream);
    Args a{};
    for (int i = 0; i < 24; ++i) a.in[i] = (const float*)d_in[i];
    a.out = (float*)d_out; a.ws = (unsigned char*)d_ws;
    constexpr int NPH = 1 + 11 * DEPTH;
#if N_LAUNCH_MODE == 1
    a.ph_lo = 0; a.ph_hi = NPH;
    hipLaunchKernelGGL(fwd_kernel, dim3(grid), dim3(NWAVES * 64), LDS_BYTES, stream, a);
#else
    for (int p = 0; p < NPH; ++p) { a.ph_lo = p; a.ph_hi = p + 1; hipLaunchKernelGGL(fwd_kernel, dim3(grid), dim3(NWAVES * 64), LDS_BYTES, stream, a); }
#endif
    const hipError_t le = hipPeekAtLastError();
    if (le != hipSuccess) fprintf(stderr, "kernel_launch: launch failed: %s\n", hipGetErrorName(le));
}
```

```cpp
#include <hip/hip_runtime.h>
#include <cstdio>
#include <cstdint>

__device__ __forceinline__ int lane_id() { return (int)__builtin_amdgcn_mbcnt_hi(~0u, __builtin_amdgcn_mbcnt_lo(~0u, 0u)); }
namespace pg8 {
#define PG8_LAS __attribute__((address_space(3)))
typedef unsigned short bf16_t;
typedef short bf16x8 __attribute__((ext_vector_type(8)));
typedef float f32x4 __attribute__((ext_vector_type(4)));
typedef unsigned u32x4 __attribute__((ext_vector_type(4)));
typedef unsigned u32x2 __attribute__((ext_vector_type(2)));
constexpr int BM = 256, BK = 64, HALF = 128, HTB = HALF * BK * 2  , STAGE_BYTES = 8 * HTB, NXCD = 8, WGM = 8;

__host__ __device__ __forceinline__ int lds_byte(int r, int c) { const int st = (r >> 4) * 2 + (c >> 5), rr = r & 15, cc = c & 31, ob = rr * 64 + cc * 2; return st * 1024 + (ob ^ (((ob >> 9) & 1) << 5)); }
__host__ __device__ __forceinline__ void stage_rc(int b, int& R, int& C) { const int st = b / 1024, sb = b % 1024, swz = sb ^ (((sb >> 9) & 1) << 5); R = (st >> 1) * 16 + swz / 64; C = (st & 1) * 32 + (swz % 64) / 2; }
__host__ __device__ __forceinline__ int perm32(int rho) { const int n = rho >> 4, i = rho & 15; return 8 * (i >> 2) + 4 * n + (i & 3); }

struct Unit { int pm, pn, koff, nt, seg; };
struct Gemm { const bf16_t* A; const bf16_t* Bt; int M, N, K; };

struct StaticOrder {
    static constexpr bool GATHER = false;
    int nM, nN, nwg, G, c, nt0;
    __device__ __forceinline__ int row_token(const Unit&, int) const { return 0; }
    __device__ void init(int M, int N, int K, int G_, int c_) { nM = M / BM; nN = N / BM; nwg = nM * nN; G = G_; c = c_; nt0 = K / BK; }
    __device__ bool tile(long L, Unit& u) const {
        if (L >= nwg) return false;
        int wgid = (int)L; { const int q = nwg / NXCD, r = nwg % NXCD, xcd = wgid % NXCD, off = wgid / NXCD; wgid = (xcd < r ? xcd * (q + 1) : r * (q + 1) + (xcd - r) * q) + off; }
        const int nig = WGM * nN, gid = wgid / nig, fm = gid * WGM, gsz = (nM - fm) < WGM ? (nM - fm) : WGM;
        u.pm = fm + ((wgid % nig) % gsz); u.pn = (wgid % nig) / gsz; return true;
    }
    __device__ bool next(int i, Unit& u) const { u.koff = 0; u.nt = nt0; u.seg = 0; return tile((long)i * G + c, u); }
    __device__ __forceinline__ void a_ready(const Unit&) const {}
    __device__ __forceinline__ void done(const Unit&) const {}
};
struct MergeOrder : StaticOrder {
    __device__ bool next(int i, Unit& u) const { const int rnd = i / 3, sg = i - 3 * rnd; u.seg = sg; u.koff = sg == 0 ? 0 : (sg == 1 ? 512 : 1536); u.nt = sg == 1 ? 16 : 8; return tile((long)rnd * G + c, u); }
};
struct MoeOrder {
    static constexpr bool GATHER = false;
    int total, G, c, NJ, nt0; const PG8_LAS int* tile_exp;
    __device__ bool next(int i, Unit& u) const {
        const long L = (long)i * G + c; if (L >= total) return false;
        const int R = (int)L / NJ, j = (int)L % NJ; u.pm = R; u.pn = tile_exp[R] * NJ + j; u.koff = 0; u.nt = nt0; u.seg = 0; return true;
    }
    __device__ __forceinline__ int row_token(const Unit&, int) const { return 0; }
    __device__ __forceinline__ void a_ready(const Unit&) const {}
    __device__ __forceinline__ void done(const Unit&) const {}
};
struct MoeGatherOrder : MoeOrder {
    static constexpr bool GATHER = true;
    const PG8_LAS int* pst; const PG8_LAS int* cnt; const int* liste;
    __device__ __forceinline__ int row_token(const Unit& u, int r) const {
        const int e = tile_exp[u.pm], lr = u.pm * 256 - pst[e] + r;
        return lr < cnt[e] ? liste[(size_t)e * 32768 + lr] : 0;
    }
};

typedef __bf16 bf16x2v __attribute__((ext_vector_type(2)));
typedef float f32x2v __attribute__((ext_vector_type(2)));
__device__ __forceinline__ unsigned cvt_pk_bf16(float lo, float hi) { const f32x2v v = {lo, hi}; const bf16x2v b = __builtin_convertvector(v, bf16x2v); return __builtin_bit_cast(unsigned, b); }
__device__ __forceinline__ float bflo(unsigned w) { return __uint_as_float(w << 16); }
__device__ __forceinline__ float bfhi(unsigned w) { return __uint_as_float(w & 0xffff0000u); }
__device__ __forceinline__ float sigm(float v) { return __builtin_amdgcn_rcpf(1.0f + __builtin_amdgcn_exp2f(-1.44269504f * v)); }

constexpr int ZP = 11264;
constexpr int ZC_GA = 5120, ZC_GB = 7168, ZC_GC = 9216;

template <int PN_OFF> struct EpiInProj {
    static constexpr bool PERM = true, AFTER_DRAIN = false, CHAIN = false;
    bf16_t* O; PG8_LAS unsigned long long* ss;
    const PG8_LAS float* gains;
    __device__ __forceinline__ void operator()(const f32x4 (&acc)[2][2][4][2], const Unit& u, int wr, int wc, int fr, int fq) const {
        const int pn = PN_OFF ? u.pn + 13 : (u.pn < 13 ? u.pn : u.pn + 7);
        int row0 = u.pm * BM + wr * 64 + fr, col0 = pn * BM + wc * 32 + 8 * fq;
        asm volatile("" : "+v"(row0), "+v"(col0));
        const int act = pn >= 20 ? 2 : (pn >= 18 ? 1 : 0);
        const bool hn = PN_OFF == 0 && pn <= 7;
        f32x4 gn0 = (f32x4){1.f, 1.f, 1.f, 1.f}, gn1 = gn0; int lr = 0;
        if (hn) {
            lr = wr * 64 + fr; asm volatile("" : "+v"(lr));
#pragma unroll
            for (int ai = 0; ai < 2; ++ai)
#pragma unroll
                for (int m = 0; m < 4; ++m)
#pragma unroll
                    for (int bj = 0; bj < 2; ++bj) { const f32x4 a = acc[ai][bj][m][0], b = acc[ai][bj][m][1];
                        float s = (a[0] * a[0] + a[1] * a[1]) + (a[2] * a[2] + a[3] * a[3]) + (b[0] * b[0] + b[1] * b[1]) + (b[2] * b[2] + b[3] * b[3]);
                        s += __shfl_xor(s, 16); s += __shfl_xor(s, 32);
                        if (fq == 0) __hip_atomic_fetch_add(ss + (ai * HALF + m * 16 + lr) * 2 + bj, (unsigned long long)(s * 1048576.0f), __ATOMIC_RELAXED, __HIP_MEMORY_SCOPE_WORKGROUP); }
            asm volatile("s_waitcnt lgkmcnt(0)" ::: "memory"); __builtin_amdgcn_s_barrier(); asm volatile("" ::: "memory");
            const PG8_LAS float* gp = gains + (pn <= 1 ? 0 : (pn == 2 ? 128 : (pn <= 6 ? 256 : 384))) + wc * 32 + 8 * fq;
            gn0 = *(const PG8_LAS f32x4*)gp; gn1 = *(const PG8_LAS f32x4*)(gp + 4);
        }
#pragma unroll
        for (int ai = 0; ai < 2; ++ai)
#pragma unroll
            for (int m = 0; m < 4; ++m) { bf16_t* rowp = O + (size_t)(row0 + ai * HALF + m * 16) * ZP + col0;
#pragma unroll
                for (int bj = 0; bj < 2; ++bj) { f32x4 v0 = acc[ai][bj][m][0], v1 = acc[ai][bj][m][1];
                    if (hn && !(pn == 2 && bj == 1)) { const float r = rsqrtf((float)ss[(ai * HALF + m * 16 + lr) * 2 + bj] * (0.015625f * 0.015625f / 128.0f / 1048576.0f) + 1e-6f) * 0.015625f;
                        v0 = v0 * r * gn0; v1 = v1 * r * gn1; }
                    else if (PN_OFF == 0) { v0 = v0 * 0.015625f; v1 = v1 * 0.015625f; }
                    if (act) {
#pragma unroll
                        for (int j = 0; j < 4; ++j) { const float s0 = sigm(v0[j]), s1 = sigm(v1[j]); v0[j] = act == 2 ? s0 : v0[j] * s0; v1[j] = act == 2 ? s1 : v1[j] * s1; } }
                    u32x4 w; w.x = cvt_pk_bf16(v0[0], v0[1]); w.y = cvt_pk_bf16(v0[2], v0[3]); w.z = cvt_pk_bf16(v1[0], v1[1]); w.w = cvt_pk_bf16(v1[2], v1[3]);
                    *(u32x4*)(rowp + bj * HALF) = w; } }
        if (hn) { asm volatile("s_waitcnt lgkmcnt(0)" ::: "memory"); __builtin_amdgcn_s_barrier(); asm volatile("" ::: "memory");
            ss[(wr * 4 + wc) * 64 + fq * 16 + fr] = 0ull; }
    }
};
struct EpiMerge {
    static constexpr bool PERM = true, AFTER_DRAIN = false, CHAIN = true;
    const bf16_t* Z; bf16_t* O;
    __device__ __forceinline__ void operator()(f32x4 (&acc)[2][2][4][2], const Unit& u, int wr, int wc, int fr, int fq) const {
        const int row0 = u.pm * BM + wr * 64 + fr, col0 = u.pn * BM + wc * 32 + 8 * fq;
        const int cn = u.seg == 0 ? ZC_GA : (u.seg == 1 ? ZC_GB : ZC_GC), cd = u.seg == 0 ? ZC_GB : ZC_GC;
#pragma unroll
        for (int ai = 0; ai < 2; ++ai) {
            u32x4 gn[4][2], gd[4][2];
#pragma unroll
            for (int m = 0; m < 4; ++m)
#pragma unroll
                for (int bj = 0; bj < 2; ++bj) { const size_t r = (size_t)(row0 + ai * HALF + m * 16);
                    gn[m][bj] = *(const u32x4*)(Z + r * ZP + cn + col0 + bj * HALF);
                    if (u.seg != 2) gd[m][bj] = *(const u32x4*)(Z + r * ZP + cd + col0 + bj * HALF); else gd[m][bj] = (u32x4){0x3f803f80u, 0x3f803f80u, 0x3f803f80u, 0x3f803f80u}; }
#pragma unroll
            for (int m = 0; m < 4; ++m)
#pragma unroll
                for (int bj = 0; bj < 2; ++bj) { const size_t r = (size_t)(row0 + ai * HALF + m * 16);
#pragma unroll
                    for (int w = 0; w < 4; ++w) { const float rl = bflo(gn[m][bj][w]) * __builtin_amdgcn_rcpf(bflo(gd[m][bj][w])), rh = bfhi(gn[m][bj][w]) * __builtin_amdgcn_rcpf(bfhi(gd[m][bj][w]));
                        acc[ai][bj][m][w >> 1][(w & 1) * 2] *= rl; acc[ai][bj][m][w >> 1][(w & 1) * 2 + 1] *= rh; }
                    if (u.seg == 2) { const f32x4 v0 = acc[ai][bj][m][0], v1 = acc[ai][bj][m][1];
                        u32x4 w; w.x = cvt_pk_bf16(v0[0], v0[1]); w.y = cvt_pk_bf16(v0[2], v0[3]); w.z = cvt_pk_bf16(v1[0], v1[1]); w.w = cvt_pk_bf16(v1[2], v1[3]);
                        *(u32x4*)(O + r * 2048 + col0 + bj * HALF) = w; } }
        }
    }
};
template <bool BASE_BF16> struct EpiResid {
    static constexpr bool PERM = true, AFTER_DRAIN = false, CHAIN = false;
    const float* base; bf16_t* hb; unsigned char* xu; const float* gain;
    __device__ __forceinline__ void operator()(const f32x4 (&acc)[2][2][4][2], const Unit& u, int wr, int wc, int fr, int fq) const {
        const int row0 = u.pm * BM + wr * 64 + fr, col0 = u.pn * BM + wc * 32 + 8 * fq;
        f32x4 gv[2][2];
#pragma unroll
        for (int bj = 0; bj < 2; ++bj)
#pragma unroll
            for (int n = 0; n < 2; ++n) gv[bj][n] = *(const f32x4*)(gain + col0 + bj * HALF + 4 * n);
        const f32x4 lo4 = (f32x4){-440.f, -440.f, -440.f, -440.f}, hi4 = (f32x4){440.f, 440.f, 440.f, 440.f};
#pragma unroll
        for (int ai = 0; ai < 2; ++ai) {
            f32x4 bv[4][2][2];
#pragma unroll
            for (int mm = 0; mm < 4; ++mm) { const size_t off = (size_t)(row0 + ai * HALF + mm * 16) * 2048 + col0;
#pragma unroll
                for (int bj = 0; bj < 2; ++bj) {
                    if constexpr (BASE_BF16) { const u32x4 w = *(const u32x4*)(hb + off + bj * HALF);
                        bv[mm][bj][0] = (f32x4){bflo(w.x), bfhi(w.x), bflo(w.y), bfhi(w.y)}; bv[mm][bj][1] = (f32x4){bflo(w.z), bfhi(w.z), bflo(w.w), bfhi(w.w)}; }
                    else { bv[mm][bj][0] = *(const f32x4*)(base + off + bj * HALF); bv[mm][bj][1] = *(const f32x4*)(base + off + bj * HALF + 4); } } }
#pragma unroll
            for (int mm = 0; mm < 4; ++mm) { const size_t off = (size_t)(row0 + ai * HALF + mm * 16) * 2048 + col0;
#pragma unroll
                for (int bj = 0; bj < 2; ++bj) { const f32x4 h0 = bv[mm][bj][0] + acc[ai][bj][mm][0], h1 = bv[mm][bj][1] + acc[ai][bj][mm][1];
                    u32x4 hw; hw.x = cvt_pk_bf16(h0[0], h0[1]); hw.y = cvt_pk_bf16(h0[2], h0[3]); hw.z = cvt_pk_bf16(h1[0], h1[1]); hw.w = cvt_pk_bf16(h1[2], h1[3]);
                    *(u32x4*)(hb + off + bj * HALF) = hw;
                    const f32x4 x0 = __builtin_elementwise_min(__builtin_elementwise_max(h0 * gv[bj][0], lo4), hi4), x1 = __builtin_elementwise_min(__builtin_elementwise_max(h1 * gv[bj][1], lo4), hi4);
                    int w0 = 0, w1 = 0;
                    w0 = __builtin_amdgcn_cvt_pk_fp8_f32(x0[0], x0[1], w0, false); w0 = __builtin_amdgcn_cvt_pk_fp8_f32(x0[2], x0[3], w0, true);
                    w1 = __builtin_amdgcn_cvt_pk_fp8_f32(x1[0], x1[1], w1, false); w1 = __builtin_amdgcn_cvt_pk_fp8_f32(x1[2], x1[3], w1, true);
                    *(u32x2*)(xu + off + bj * HALF) = (u32x2){(unsigned)w0, (unsigned)w1}; } }
        }
    }
};
struct EpiGlu {
    static constexpr bool PERM = false, AFTER_DRAIN = false, CHAIN = false;
    bf16_t* H; const PG8_LAS int* tile_exp; const PG8_LAS int* pst; const PG8_LAS int* cnt; const int* liste; const float* rstd;
    __device__ __forceinline__ void operator()(const f32x4 (&acc)[2][2][4][2], const Unit& u, int wr, int wc, int fr, int fq) const {
        const int row0 = u.pm * BM + wr * 64 + fr, pj = u.pn & 3;
        const int e = tile_exp[u.pm], lr0 = u.pm * 256 - pst[e] + wr * 64 + fr, ce = cnt[e];
        int tok[2][4]; float rs[2][4];
#pragma unroll
        for (int ai = 0; ai < 2; ++ai)
#pragma unroll
            for (int m = 0; m < 4; ++m) { const int lr = lr0 + ai * HALF + m * 16; tok[ai][m] = lr < ce ? liste[(size_t)e * 32768 + lr] : 0; }
#pragma unroll
        for (int ai = 0; ai < 2; ++ai)
#pragma unroll
            for (int m = 0; m < 4; ++m) rs[ai][m] = rstd[tok[ai][m]] * 0.015625f;
#pragma unroll
        for (int ai = 0; ai < 2; ++ai)
#pragma unroll
            for (int m = 0; m < 4; ++m) { unsigned char* rowp = (unsigned char*)H + (size_t)(row0 + ai * HALF + m * 16) * 512; const float r = rs[ai][m];
#pragma unroll
                for (int bj = 0; bj < 2; ++bj) { const f32x4 a = acc[ai][bj][m][0] * r, b = acc[ai][bj][m][1] * r;
                    const int hc = 16 * (8 * pj + 4 * bj + wc) + 4 * fq;
                    float hv[4];
#pragma unroll
                    for (int j = 0; j < 4; ++j) hv[j] = fminf(fmaxf(a[j] * sigm(a[j]) * b[j] * 8.0f, -440.0f), 440.0f);
                    int w = 0; w = __builtin_amdgcn_cvt_pk_fp8_f32(hv[0], hv[1], w, false); w = __builtin_amdgcn_cvt_pk_fp8_f32(hv[2], hv[3], w, true);
                    *(int*)(rowp + hc) = w; } }
    }
};
struct EpiY {
    static constexpr bool PERM = true, AFTER_DRAIN = false, CHAIN = false;
    unsigned char* Y;
    __device__ __forceinline__ void operator()(const f32x4 (&acc)[2][2][4][2], const Unit& u, int wr, int wc, int fr, int fq) const {
        const int row0 = u.pm * BM + wr * 64 + fr, col0 = (u.pn & 7) * BM + wc * 32 + 8 * fq;
        const f32x4 lo4 = (f32x4){-440.f, -440.f, -440.f, -440.f}, hi4 = (f32x4){440.f, 440.f, 440.f, 440.f};
#pragma unroll
        for (int ai = 0; ai < 2; ++ai)
#pragma unroll
            for (int m = 0; m < 4; ++m) { unsigned char* rowp = Y + (size_t)(row0 + ai * HALF + m * 16) * 2048 + col0;
#pragma unroll
                for (int bj = 0; bj < 2; ++bj) {
                    const f32x4 v0 = __builtin_elementwise_min(__builtin_elementwise_max(acc[ai][bj][m][0] * 0.125f, lo4), hi4), v1 = __builtin_elementwise_min(__builtin_elementwise_max(acc[ai][bj][m][1] * 0.125f, lo4), hi4);
                    int w0 = 0, w1 = 0;
                    w0 = __builtin_amdgcn_cvt_pk_fp8_f32(v0[0], v0[1], w0, false); w0 = __builtin_amdgcn_cvt_pk_fp8_f32(v0[2], v0[3], w0, true);
                    w1 = __builtin_amdgcn_cvt_pk_fp8_f32(v1[0], v1[1], w1, false); w1 = __builtin_amdgcn_cvt_pk_fp8_f32(v1[2], v1[3], w1, true);
                    *(u32x2*)(rowp + bj * HALF) = (u32x2){(unsigned)w0, (unsigned)w1}; } }
    }
};

typedef int v4i_t __attribute__((ext_vector_type(4)));
typedef int v8i_t __attribute__((ext_vector_type(8)));
template <class Epi, class Sched, bool ALIGN_EPI = false, bool FP8 = false>
__device__ __forceinline__ void gemm_phase(PG8_LAS unsigned char* lds, const Gemm g, const Sched& S, const Epi& E) {
    int tid = threadIdx.x; asm volatile("" : "+v"(tid));
    const int wid = __builtin_amdgcn_readfirstlane(tid >> 6), lane = tid & 63, wr = wid >> 2, wc = wid & 3, fr = lane & 15, fq = lane >> 4;
    const int K = g.K;
    unsigned voffA[2], voffB[2]; int RA[2]; unsigned CA2[2];
#pragma unroll
    for (int i = 0; i < 2; ++i) { int R, C; stage_rc(tid * 16 + i * 8192, R, C); const int Rb = Epi::PERM ? ((R & ~31) + perm32(R & 31)) : R;
        voffA[i] = (unsigned)(R * K + C) * 2u; voffB[i] = (unsigned)(Rb * K + C) * 2u; RA[i] = R; CA2[i] = (unsigned)C * 2u; }
    unsigned gAc[2][2], gAn[2][2];
#define PG8_GOFF(dst, uu) do { _Pragma("unroll") for (int h_ = 0; h_ < 2; ++h_) _Pragma("unroll") for (int i_ = 0; i_ < 2; ++i_) dst[h_][i_] = (unsigned)S.row_token(uu, 128 * h_ + RA[i_]) * (unsigned)(K * 2) + CA2[i_]; } while (0)
#define PG8_STAGE_A(bufoff, gbase, half, garr) do { if constexpr (Sched::GATHER) PG8_STAGE(bufoff, gbase, garr); else PG8_STAGE(bufoff, (gbase) + (half) * hstep, voffA); } while (0)
    const size_t kstep = (size_t)(BK * 2);
    const size_t hstep = (size_t)HALF * K * 2;
    const size_t tstep = 2 * hstep;
    const unsigned ldsw = (unsigned)wid * 1024u;
    const int aoff = lds_byte(wr * 64 + fr, fq * 8), boff = lds_byte(wc * 32 + fr, fq * 8);
#define PG8_SA(b, h) (((b) * 2 + (h)) * HTB)
#define PG8_SB(b, h) ((4 + (b) * 2 + (h)) * HTB)
#define PG8_STAGE(bufoff, gbase, voff) do { _Pragma("unroll") for (int _i = 0; _i < 2; ++_i) \
        __builtin_amdgcn_global_load_lds((const unsigned*)((const char*)(gbase) + (voff)[_i]), (PG8_LAS unsigned*)(lds + (bufoff) + ldsw + _i * 8192), 16, 0, 0); } while (0)
#define PG8_LDA(dst, b, h) do { if constexpr (FP8) { _Pragma("unroll") for (int m = 0; m < 4; ++m) dst##8[m] = __builtin_shufflevector(*(const PG8_LAS v4i_t*)(lds + PG8_SA(b, h) + aoff + m * 2048), *(const PG8_LAS v4i_t*)(lds + PG8_SA(b, h) + aoff + m * 2048 + 1024), 0, 1, 2, 3, 4, 5, 6, 7); } \
        else { _Pragma("unroll") for (int m = 0; m < 4; ++m) _Pragma("unroll") for (int k = 0; k < 2; ++k) dst[m][k] = *(const PG8_LAS bf16x8*)(lds + PG8_SA(b, h) + aoff + m * 2048 + k * 1024); } } while (0)
#define PG8_LDB(dst, b, h) do { if constexpr (FP8) { _Pragma("unroll") for (int n = 0; n < 2; ++n) dst##8[n] = __builtin_shufflevector(*(const PG8_LAS v4i_t*)(lds + PG8_SB(b, h) + boff + n * 2048), *(const PG8_LAS v4i_t*)(lds + PG8_SB(b, h) + boff + n * 2048 + 1024), 0, 1, 2, 3, 4, 5, 6, 7); } \
        else { _Pragma("unroll") for (int n = 0; n < 2; ++n) _Pragma("unroll") for (int k = 0; k < 2; ++k) dst[n][k] = *(const PG8_LAS bf16x8*)(lds + PG8_SB(b, h) + boff + n * 2048 + k * 1024); } } while (0)
#define PG8_MMA(ai, bj, At, Bt) do { __builtin_amdgcn_s_setprio(1); _Pragma("unroll") for (int m = 0; m < 4; ++m) _Pragma("unroll") for (int n = 0; n < 2; ++n) { \
        if constexpr (FP8) asm volatile("v_mfma_f32_16x16x128_f8f6f4 %0, %1, %2, %0" : "+v"(acc[ai][bj][m][n]) : "v"(Bt##8[n]), "v"(At##8[m])); \
        else { _Pragma("unroll") for (int k = 0; k < 2; ++k) acc[ai][bj][m][n] = __builtin_amdgcn_mfma_f32_16x16x32_bf16(Bt[n][k], At[m][k], acc[ai][bj][m][n], 0, 0, 0); } } \
        __builtin_amdgcn_s_setprio(0); } while (0)
#define PG8_WAIT_V(n) asm volatile("s_waitcnt vmcnt(" #n ")" ::: "memory")
#define PG8_WAIT_L(n) asm volatile("s_waitcnt lgkmcnt(" #n ")" ::: "memory")
#define PG8_BAR __builtin_amdgcn_s_barrier()
#define PG8_SCHED __builtin_amdgcn_sched_barrier(0)
    Unit cur, nxt; int ui = 0;
    if (!S.next(0, cur)) return;
    f32x4 acc[2][2][4][2];
#pragma unroll
    for (int a = 0; a < 2; ++a)
#pragma unroll
        for (int b = 0; b < 2; ++b)
#pragma unroll
            for (int m = 0; m < 4; ++m)
#pragma unroll
                for (int n = 0; n < 2; ++n) acc[a][b][m][n] = (f32x4){0.f, 0.f, 0.f, 0.f};
    bf16x8 At[4][2], B0[2][2], B1[2][2]; v8i_t At8[4], B08[2], B18[2];
    const size_t tstepA = Sched::GATHER ? (size_t)0 : tstep;
    const char* cA = (const char*)g.A + (size_t)cur.pm * tstepA + (size_t)cur.koff * 2; const char* cB = (const char*)g.Bt + (size_t)cur.pn * tstep + (size_t)cur.koff * 2;
    S.a_ready(cur);
    if constexpr (Sched::GATHER) { PG8_GOFF(gAc, cur); }
    PG8_STAGE(PG8_SB(0, 0), cB, voffB); PG8_STAGE(PG8_SB(0, 1), cB + hstep, voffB); PG8_STAGE_A(PG8_SA(0, 0), cA, 0, gAc[0]); PG8_STAGE_A(PG8_SA(0, 1), cA, 1, gAc[1]);
    if (wr == 1) PG8_BAR;
    PG8_WAIT_V(2); PG8_BAR;
    PG8_STAGE(PG8_SB(1, 0), cB + kstep, voffB); PG8_STAGE_A(PG8_SA(1, 0), cA + kstep, 0, gAc[0]); PG8_STAGE(PG8_SB(1, 1), cB + hstep + kstep, voffB);
    PG8_WAIT_V(6); PG8_BAR;
    for (;;) {
        const bool has_next = S.next(ui + 1, nxt);
        const char* nA = has_next ? (const char*)g.A + (size_t)nxt.pm * tstepA + (size_t)nxt.koff * 2 : cA; const char* nB = has_next ? (const char*)g.Bt + (size_t)nxt.pn * tstep + (size_t)nxt.koff * 2 : cB;
        if constexpr (Sched::GATHER) { if (has_next) { PG8_GOFF(gAn, nxt); } else {
#pragma unroll
            for (int h_ = 0; h_ < 2; ++h_)
#pragma unroll
                for (int i_ = 0; i_ < 2; ++i_) gAn[h_][i_] = gAc[h_][i_]; } }
        const int nt = cur.nt;
        for (int t = 0; t < nt; t += 2) {
            const bool last = (t == nt - 2);
            const char* a1 = cA + (size_t)(t + 1) * kstep;
            const char* a2 = last ? nA : cA + (size_t)(t + 2) * kstep; const char* b2 = last ? nB : cB + (size_t)(t + 2) * kstep;
            const char* a3 = a2 + kstep; const char* b3 = b2 + kstep;
            if (last && has_next) S.a_ready(nxt);
            unsigned g2a[2][2];
            if constexpr (Sched::GATHER) {
#pragma unroll
                for (int h_ = 0; h_ < 2; ++h_)
#pragma unroll
                    for (int i_ = 0; i_ < 2; ++i_) g2a[h_][i_] = last ? gAn[h_][i_] : gAc[h_][i_]; }
            PG8_LDB(B0, 0, 0); PG8_LDB(B1, 0, 1); PG8_SCHED; PG8_LDA(At, 0, 0); PG8_STAGE_A(PG8_SA(1, 1), a1, 1, gAc[1]);
            PG8_WAIT_V(8); PG8_WAIT_L(0); PG8_BAR; PG8_MMA(0, 0, At, B0); PG8_MMA(0, 1, At, B1); PG8_BAR; PG8_SCHED;
            PG8_LDA(At, 0, 1); PG8_STAGE(PG8_SB(0, 0), b2, voffB); PG8_STAGE(PG8_SB(0, 1), b2 + hstep, voffB); PG8_STAGE_A(PG8_SA(0, 0), a2, 0, g2a[0]);
            PG8_WAIT_V(8); PG8_WAIT_L(0); PG8_BAR; PG8_MMA(1, 0, At, B0); PG8_MMA(1, 1, At, B1); PG8_BAR; PG8_SCHED;
            PG8_LDB(B0, 1, 0); PG8_LDB(B1, 1, 1); PG8_SCHED; PG8_LDA(At, 1, 0); PG8_STAGE_A(PG8_SA(0, 1), a2, 1, g2a[1]);
            PG8_WAIT_V(8); PG8_WAIT_L(0); PG8_BAR; PG8_MMA(0, 0, At, B0); PG8_MMA(0, 1, At, B1); PG8_BAR; PG8_SCHED;
            PG8_LDA(At, 1, 1); PG8_STAGE(PG8_SB(1, 0), b3, voffB); PG8_STAGE(PG8_SB(1, 1), b3 + hstep, voffB); PG8_STAGE_A(PG8_SA(1, 0), a3, 0, g2a[0]);
            PG8_WAIT_V(8); PG8_WAIT_L(0); PG8_BAR; PG8_MMA(1, 0, At, B0); PG8_MMA(1, 1, At, B1); PG8_BAR; PG8_SCHED;
        }
        if constexpr (ALIGN_EPI) { if (wr == 0) PG8_BAR; }
        if constexpr (FP8) asm volatile("s_nop 15\n\ts_nop 15\n\ts_nop 15\n\ts_nop 15" ::: "memory");
        E(acc, cur, wr, wc, fr, fq); S.done(cur);
        if (!has_next) break;
        if (!Epi::CHAIN || cur.seg == 2)
#pragma unroll
        for (int a = 0; a < 2; ++a)
#pragma unroll
            for (int b = 0; b < 2; ++b)
#pragma unroll
                for (int m = 0; m < 4; ++m)
#pragma unroll
                    for (int n = 0; n < 2; ++n) acc[a][b][m][n] = (f32x4){0.f, 0.f, 0.f, 0.f};
        cur = nxt; cA = nA; cB = nB; ++ui;
        if constexpr (Sched::GATHER) {
#pragma unroll
            for (int h_ = 0; h_ < 2; ++h_)
#pragma unroll
                for (int i_ = 0; i_ < 2; ++i_) gAc[h_][i_] = gAn[h_][i_]; }
        if constexpr (ALIGN_EPI) { if (wr == 1) PG8_BAR; }
    }
    PG8_WAIT_V(0);
    if constexpr (!ALIGN_EPI) { if (wr == 0) PG8_BAR; }
    PG8_BAR;
#undef PG8_SA
#undef PG8_SB
#undef PG8_STAGE_A
#undef PG8_GOFF
#undef PG8_STAGE
#undef PG8_LDA
#undef PG8_LDB
#undef PG8_MMA
#undef PG8_WAIT_V
#undef PG8_WAIT_L
#undef PG8_BAR
#undef PG8_SCHED
}
}

constexpr int NWAVES = 8;
constexpr int T = 32768, SEQ = 2048, NB = 16, D = 2048, DEPTH = 2;
constexpr int ZP = pg8::ZP;
constexpr int ZC_AQ = 0, ZC_AK = 512, ZC_AV = 640, ZC_BQ = 768, ZC_BK = 1792, ZC_BV = 2048, ZC_IQ = 2304, ZC_IK = 3328, ZC_IW = 3392, ZC_CG = 3408, ZC_PAD = 3424, ZC_CQ = 3584, ZC_CK = 3840, ZC_CV = 4096, ZC_CR = 4608;
constexpr int D_IN = 11104;
constexpr int NEXP = 64, DEXP = 512, PMAX_TILES = 320;
constexpr float EPS = 1e-6f;

constexpr size_t MiB = 1u << 20;
constexpr size_t WS_CTL = 0, CTL_ZERO_BYTES = 1 * MiB;
constexpr size_t WS_ROUTE = 2 * MiB;
constexpr size_t WS_WRH = 4 * MiB, WS_WRL = 6 * MiB, WR_L = 96 * 2048 * 2;
constexpr size_t WS_WIN = 16 * MiB, WIN_L = 44 * MiB;
constexpr size_t WS_WBR = 104 * MiB, WBR_L = 8 * MiB;
constexpr size_t WS_WO = 120 * MiB, WO_L = 8 * MiB;
constexpr size_t WS_W13 = 136 * MiB;
constexpr size_t WS_HB = 264 * MiB;
constexpr size_t WS_W2 = 392 * MiB;
constexpr size_t WS_XN = 520 * MiB;
constexpr size_t WS_OCAT = 648 * MiB;
constexpr size_t WS_MERGED = 776 * MiB;
constexpr size_t WS_Z = 904 * MiB;
constexpr size_t WS_S = 1608 * MiB;
constexpr size_t WS_MASK = 1864 * MiB;
constexpr size_t WS_GO = 1872 * MiB;
constexpr size_t WS_GCS = WS_GO;
constexpr size_t WS_GDEC = 8 * MiB;
constexpr size_t WS_RSTD = 9 * MiB;
constexpr size_t WS_LISTE = 904 * MiB;
constexpr size_t WS_XS = 904 * MiB;
constexpr size_t WS_Y = 1224 * MiB;
constexpr size_t WS_H = 1544 * MiB;
constexpr size_t WS_WG8 = 1936 * MiB, WG8_L = 12 * MiB;
constexpr size_t WS_XN8 = WS_S;
constexpr size_t WS_END = 1936 * MiB;
constexpr int CW_BAR = 4096;
constexpr int CW_CNT = 16384;

constexpr int RING_BYTES = 131072, MISC_OFF = RING_BYTES, LDS_BYTES = 155648;
constexpr int MO_BARW = 32, MO_GN = 256, MO_TEXP = 8192, MO_PST = 9728, MO_TOT = 9984, MO_TAB2 = 10240, MO_CNT = 16640, MO_SS = 16896;

#define GAS __attribute__((address_space(1)))
#define LAS __attribute__((address_space(3)))
typedef unsigned short bf16;
typedef unsigned v4u __attribute__((ext_vector_type(4)));
typedef unsigned v2u __attribute__((ext_vector_type(2)));
typedef float f32x4 __attribute__((ext_vector_type(4)));
#define LDS_WAIT() asm volatile("s_waitcnt lgkmcnt(0)" ::: "memory")
__device__ __forceinline__ unsigned f2bf(float f) { unsigned u = __builtin_bit_cast(unsigned, f); return (u + 0x7fffu + ((u >> 16) & 1u)) >> 16; }
__device__ __forceinline__ unsigned pk2(float lo, float hi) { return f2bf(lo) | (f2bf(hi) << 16); }
__device__ __forceinline__ float bflo(unsigned w) { return __uint_as_float(w << 16); }
__device__ __forceinline__ float bfhi(unsigned w) { return __uint_as_float(w & 0xffff0000u); }
__device__ __forceinline__ float bf1(bf16 h) { return __uint_as_float(((unsigned)h) << 16); }

#define XB_TMO      128
#define XB_XCNT(j)  (256  + 64 * (j))
#define XB_XSUB(j)  (1280 + 64 * (j))
#define XB_XGEN(j)  (2304 + 64 * (j))
#define XB_TOP      3328
#define XB_TOPGEN   3392
#define XCD_BAR_WORDS 3456
#define XB_SPIN_CAP (1u << 18)
__device__ __forceinline__ unsigned xb_ld(unsigned* p)              { return __hip_atomic_load(p, __ATOMIC_RELAXED, __HIP_MEMORY_SCOPE_AGENT); }
__device__ __forceinline__ unsigned xb_add(unsigned* p, unsigned v) { return __hip_atomic_fetch_add(p, v, __ATOMIC_RELAXED, __HIP_MEMORY_SCOPE_AGENT); }
__device__ __forceinline__ unsigned xb_xcc_id() { return (unsigned)__builtin_amdgcn_s_getreg((3 << 11) | 20) & 0xFu; }
#define XB_SPIN(cond, bar) do { unsigned _sp = 0; while (cond) { __builtin_amdgcn_s_sleep(1); \
    if ((++_sp & 255u) == 0u) { if (xb_ld(&(bar)[XB_TMO])) break; if (_sp > XB_SPIN_CAP) { atomicAdd(&(bar)[XB_TMO], 1u); break; } } } } while (0)
struct XcdBarrier { unsigned* bar; unsigned x; volatile LAS unsigned* st; };
__device__ __forceinline__ XcdBarrier xcd_barrier_post(unsigned* bar, volatile LAS unsigned* st) {
    XcdBarrier b; b.bar = bar; b.x = xb_xcc_id(); b.st = st;
    if (threadIdx.x == 0) (void)xb_add(&bar[XB_XCNT(b.x)], 1u);
    return b;
}
__device__ __forceinline__ void xcd_barrier_complete(unsigned* bar, unsigned x, unsigned& nloc, unsigned& nx) {
    const unsigned G = gridDim.x * gridDim.y * gridDim.z;
    unsigned sum, cnt, mine, sp = 0u;
    for (;;) {
        sum = 0u; cnt = 0u; mine = 0u;
#pragma unroll
        for (unsigned j = 0; j < 16; ++j) { const unsigned c = xb_ld(&bar[XB_XCNT(j)]); sum += c; cnt += (c > 0u) ? 1u : 0u; mine = (j == x) ? c : mine; }
        if (sum == G) break;
        __builtin_amdgcn_s_sleep(1);
        if ((++sp & 255u) == 0u) { if (xb_ld(&bar[XB_TMO])) break; if (sp > XB_SPIN_CAP) { atomicAdd(&bar[XB_TMO], 1u); break; } }
    }
    nloc = mine > 0u ? mine : 1u; nx = cnt > 0u ? cnt : 1u;
}
__device__ __forceinline__ void xcd_barrier(const XcdBarrier& b) {
    asm volatile("s_waitcnt vmcnt(0)" ::: "memory");
    __syncthreads();
    if (threadIdx.x == 0) {
        unsigned* bar = b.bar;
        __builtin_amdgcn_s_waitcnt(0);
        unsigned nloc = b.st[0], nx = b.st[1];
        if (nloc == 0u) { xcd_barrier_complete(bar, b.x, nloc, nx); b.st[0] = nloc; b.st[1] = nx; }
        const unsigned old = xb_add(&bar[XB_XSUB(b.x)], 1u);
        const unsigned gen = old / nloc;
        if (old + 1u == (gen + 1u) * nloc) {
            __builtin_amdgcn_fence(__ATOMIC_RELEASE, "agent");
            asm volatile("s_waitcnt vmcnt(0)" ::: "memory");
            const unsigned og = xb_add(&bar[XB_TOP], 1u);
            const unsigned tg = og / nx;
            if (og + 1u == (tg + 1u) * nx) xb_add(&bar[XB_TOPGEN], 1u);
            else XB_SPIN(xb_ld(&bar[XB_TOPGEN]) == tg, bar);
            __builtin_amdgcn_fence(__ATOMIC_ACQUIRE, "agent");
            xb_add(&bar[XB_XGEN(b.x)], 1u);
            asm volatile("s_waitcnt vmcnt(0)" ::: "memory");
        } else {
            XB_SPIN(xb_ld(&bar[XB_XGEN(b.x)]) == gen, bar);
            __builtin_amdgcn_fence(__ATOMIC_ACQUIRE, "agent");
            asm volatile("s_waitcnt vmcnt(0)" ::: "memory");
        }
    }
    __syncthreads();
}

struct Args { const float* in[24]; float* out; unsigned char* ws; int ph_lo, ph_hi; };
enum { I_X = 0, I_RELB, I_N1G, I_WIN, I_AQG, I_AKG, I_BQG, I_BKG, I_SINK, I_CGW, I_CGB, I_CNG, I_WBA, I_WBB, I_WBC, I_WO, I_N2G, I_WRG, I_BRG, I_WRE, I_BRE, I_W1, I_W3, I_W2 };

struct Frame {
    LAS unsigned char* lds; LAS unsigned char* misc;
    unsigned* ctl;
    int tid, lane, wave, vcu, G, gw, NGW;
    const float* const* in; float* out; unsigned char* ws;
    bf16 *Z, *XN, *OCAT, *MERGED, *XS, *Y, *H;
    float *S, *GO; unsigned* MASK;
};

__device__ __forceinline__ float wave_sum(float v) {
#pragma unroll
    for (int o = 1; o < 64; o <<= 1) v += __shfl_xor(v, o);
    return v;
}
__device__ __forceinline__ float wave_max(float v) {
#pragma unroll
    for (int o = 1; o < 64; o <<= 1) v = fmaxf(v, __shfl_xor(v, o));
    return v;
}

template <class MAP>
__device__ __forceinline__ void transpose_item(const float* W, int N, bf16* WT, int dpitch, int koff, LAS float* scr, int item, int lane, const MAP& map) {
    const int nblk = N / 32, kb = item / nblk, nb = item % nblk, k0 = 64 * kb, n0 = 32 * nb;
    f32x4 v[8];
#pragma unroll
    for (int i = 0; i < 8; ++i) v[i] = *(const f32x4*)(W + (size_t)(k0 + 8 * i + (lane >> 3)) * N + n0 + 4 * (lane & 7));
#pragma unroll
    for (int i = 0; i < 8; ++i) { LAS float* d = scr + (8 * i + (lane >> 3)) * 33 + 4 * (lane & 7); d[0] = v[i].x; d[1] = v[i].y; d[2] = v[i].z; d[3] = v[i].w; }
    LDS_WAIT(); asm volatile("" ::: "memory");
    const int c = lane & 7;
#pragma unroll
    for (int j = 0; j < 4; ++j) { const int n = (lane >> 3) + 8 * j; const LAS float* s = scr + (8 * c) * 33 + n;
        v4u o; o.x = pk2(s[0 * 33], s[1 * 33]); o.y = pk2(s[2 * 33], s[3 * 33]); o.z = pk2(s[4 * 33], s[5 * 33]); o.w = pk2(s[6 * 33], s[7 * 33]);
        const int dr_ = map(n0 + n); if (dr_ >= 0) *(v4u*)(WT + (size_t)dr_ * dpitch + koff + k0 + 8 * c) = o; }
    LDS_WAIT(); asm volatile("" ::: "memory");
}
__device__ __forceinline__ float clamp8(float v) { return fminf(fmaxf(v, -440.0f), 440.0f); }
template <class MAP>
__device__ __forceinline__ void transpose_item_fp8(const float* W, int N, unsigned char* WT, int dpitch, float scale, LAS float* scr, int item, int lane, const MAP& map) {
    const int nblk = N / 32, kb = item / nblk, nb = item % nblk, k0 = 64 * kb, n0 = 32 * nb;
    f32x4 v[8];
#pragma unroll
    for (int i = 0; i < 8; ++i) v[i] = *(const f32x4*)(W + (size_t)(k0 + 8 * i + (lane >> 3)) * N + n0 + 4 * (lane & 7));
#pragma unroll
    for (int i = 0; i < 8; ++i) { LAS float* d = scr + (8 * i + (lane >> 3)) * 33 + 4 * (lane & 7); d[0] = v[i].x; d[1] = v[i].y; d[2] = v[i].z; d[3] = v[i].w; }
    LDS_WAIT(); asm volatile("" ::: "memory");
    const int c = lane & 7;
#pragma unroll
    for (int j = 0; j < 4; ++j) { const int n = (lane >> 3) + 8 * j; const LAS float* s = scr + (8 * c) * 33 + n;
        int w0 = 0, w1 = 0;
        w0 = __builtin_amdgcn_cvt_pk_fp8_f32(clamp8(s[0 * 33] * scale), clamp8(s[1 * 33] * scale), w0, false); w0 = __builtin_amdgcn_cvt_pk_fp8_f32(clamp8(s[2 * 33] * scale), clamp8(s[3 * 33] * scale), w0, true);
        w1 = __builtin_amdgcn_cvt_pk_fp8_f32(clamp8(s[4 * 33] * scale), clamp8(s[5 * 33] * scale), w1, false); w1 = __builtin_amdgcn_cvt_pk_fp8_f32(clamp8(s[6 * 33] * scale), clamp8(s[7 * 33] * scale), w1, true);
        const int dr_ = map(n0 + n); if (dr_ >= 0) *(v2u*)(WT + (size_t)dr_ * dpitch + k0 + 8 * c) = (v2u){(unsigned)w0, (unsigned)w1}; }
    LDS_WAIT(); asm volatile("" ::: "memory");
}
struct MapId { int off; __device__ __forceinline__ int operator()(int n) const { return off + n; } };
struct MapWin {
    __device__ __forceinline__ int operator()(int n) const {
        if (n < 512) return ZC_AQ + n;
        if (n < 640) return ZC_AK + (n - 512);
        if (n < 768) return ZC_AV + (n - 640);
        if (n < 1792) return ZC_IQ + (n - 768);
        if (n < 1856) return ZC_IK + (n - 1792);
        if (n < 1872) return ZC_IW + (n - 1856);
        if (n < 2896) return ZC_BQ + (n - 1872);
        if (n < 3152) return ZC_BK + (n - 2896);
        if (n < 3408) return ZC_BV + (n - 3152);
        if (n < 3664) return ZC_CQ + (n - 3408);
        if (n < 3920) return ZC_CK + (n - 3664);
        if (n < 4432) return ZC_CV + (n - 3920);
        if (n < 4448) return ZC_CG + (n - 4432);
        if (n < 4960) return ZC_CR + (n - 4448);
        return pg8::ZC_GA + (n - 4960);
    }
};
struct MapWin8 { __device__ __forceinline__ int operator()(int n) const { const int z = MapWin{}(n); return z < 3328 ? z : (z >= 5120 ? z - 1792 : -1); } };
struct MapWinB { __device__ __forceinline__ int operator()(int n) const { const int z = MapWin{}(n); return (z >= 3328 && z < 5120) ? z - 3328 : -1; } };
struct MapW13 { int sel; __device__ __forceinline__ int operator()(int n) const { return 32 * (n >> 4) + 16 * sel + (n & 15); } };

__device__ __forceinline__ void load_row(const float* row, int lane, f32x4 (&v)[8]) {
    const f32x4* xr = (const f32x4*)row + lane;
#pragma unroll
    for (int j = 0; j < 8; ++j) v[j] = xr[64 * j];
}
__device__ __forceinline__ float row_rstd(const f32x4 (&v)[8]) {
    float s = 0.f;
#pragma unroll
    for (int j = 0; j < 8; ++j) s += (v[j].x * v[j].x + v[j].y * v[j].y) + (v[j].z * v[j].z + v[j].w * v[j].w);
    return rsqrtf(wave_sum(s) * (1.0f / 2048.0f) + EPS);
}
__device__ __forceinline__ void norm_store_bf16(const f32x4 (&v)[8], float rstd, const float* g, bf16* orow, int lane) {
    const f32x4* gr = (const f32x4*)g + lane; unsigned long long* o8 = (unsigned long long*)orow + lane;
#pragma unroll
    for (int j = 0; j < 8; ++j) { const f32x4 gg = gr[64 * j];
        o8[64 * j] = (unsigned long long)pk2(v[j].x * rstd * gg.x, v[j].y * rstd * gg.y) | ((unsigned long long)pk2(v[j].z * rstd * gg.z, v[j].w * rstd * gg.w) << 32); }
}

__device__ __forceinline__ void norm_store_fp8(const f32x4 (&v)[8], float rstd, const float* g, unsigned char* orow, int lane) {
    const f32x4* gr = (const f32x4*)g + lane; unsigned* o4 = (unsigned*)orow + lane;
#pragma unroll
    for (int j = 0; j < 8; ++j) { const f32x4 gg = gr[64 * j]; int w = 0;
        w = __builtin_amdgcn_cvt_pk_fp8_f32(clamp8(v[j].x * rstd * gg.x), clamp8(v[j].y * rstd * gg.y), w, false); w = __builtin_amdgcn_cvt_pk_fp8_f32(clamp8(v[j].z * rstd * gg.z), clamp8(v[j].w * rstd * gg.w), w, true);
        o4[64 * j] = (unsigned)w; }
}
__device__ __forceinline__ void convert_moe(Frame& F, int l, int part, int nparts, int lds_off) {
    LAS float* scr = (LAS float*)(F.lds + lds_off + F.wave * 8704);
    bf16* W13 = (bf16*)(F.ws + WS_W13); bf16* W2 = (bf16*)(F.ws + WS_W2);
    constexpr int I13 = (2048 / 64) * (512 / 32);
    constexpr int I2 = (512 / 64) * (2048 / 32);
    constexpr int NIT = NEXP * (2 * I13 + I2);
    const int it_lo = (int)((long)NIT * part / nparts), it_hi = (int)((long)NIT * (part + 1) / nparts);
    for (int it = it_lo + F.gw; it < it_hi; it += F.NGW) {
        const int e = it / (2 * I13 + I2); int r = it % (2 * I13 + I2);
        if (r < I13) { transpose_item_fp8(F.in[I_W1] + ((size_t)l * NEXP + e) * 2048 * 512, 512, (unsigned char*)W13 + (size_t)e * 1024 * 2048, 2048, 64.0f, scr, r, F.lane, MapW13{0}); continue; } r -= I13;
        if (r < I13) { transpose_item_fp8(F.in[I_W3] + ((size_t)l * NEXP + e) * 2048 * 512, 512, (unsigned char*)W13 + (size_t)e * 1024 * 2048, 2048, 64.0f, scr, r, F.lane, MapW13{1}); continue; } r -= I13;
        transpose_item_fp8(F.in[I_W2] + ((size_t)l * NEXP + e) * 512 * 2048, 2048, (unsigned char*)W2 + (size_t)e * 2048 * 512, 512, 32.0f, scr, r, F.lane, MapId{0});
    }
}

typedef short bf16x8_t __attribute__((ext_vector_type(8)));
typedef float f32x16 __attribute__((ext_vector_type(16)));
typedef short s16x4 __attribute__((ext_vector_type(4)));
__device__ __forceinline__ void indexer_segment(Frame& F, int b, int qb, int tlo, int thi) {
    const int lane = F.lane, n = lane & 15, kq = lane >> 4;
    const bf16* qrow = F.Z + (size_t)(b * 2048 + 16 * qb + n) * ZP;
    bf16x8_t iqf[16][2];
#pragma unroll
    for (int h = 0; h < 16; ++h)
#pragma unroll
        for (int ks = 0; ks < 2; ++ks) iqf[h][ks] = *(const bf16x8_t*)(qrow + ZC_IQ + h * 64 + 32 * ks + 8 * kq);
    float wv[16];
    { const v4u w0 = *(const v4u*)(qrow + ZC_IW), w1 = *(const v4u*)(qrow + ZC_IW + 8);
      wv[0] = bflo(w0.x); wv[1] = bfhi(w0.x); wv[2] = bflo(w0.y); wv[3] = bfhi(w0.y); wv[4] = bflo(w0.z); wv[5] = bfhi(w0.z); wv[6] = bflo(w0.w); wv[7] = bfhi(w0.w);
      wv[8] = bflo(w1.x); wv[9] = bfhi(w1.x); wv[10] = bflo(w1.y); wv[11] = bfhi(w1.y); wv[12] = bflo(w1.z); wv[13] = bfhi(w1.z); wv[14] = bflo(w1.w); wv[15] = bfhi(w1.w); }
    const bf16* kbase = F.Z + (size_t)(b * 2048 + n) * ZP + ZC_IK + 8 * kq;
    float* srow = F.S + (size_t)(b * 2048 + 16 * qb + n) * 2048 + 4 * kq;
    bf16x8_t a0 = *(const bf16x8_t*)(kbase + (size_t)(16 * tlo) * ZP), a1 = *(const bf16x8_t*)(kbase + (size_t)(16 * tlo) * ZP + 32);
#pragma unroll 1
    for (int tile = tlo; tile < thi; ++tile) {
        const int tn = tile + 1 < thi ? tile + 1 : tile;
        const bf16x8_t n0 = *(const bf16x8_t*)(kbase + (size_t)(16 * tn) * ZP), n1 = *(const bf16x8_t*)(kbase + (size_t)(16 * tn) * ZP + 32);
        f32x4 sc = (f32x4){0.f, 0.f, 0.f, 0.f};
#pragma unroll
        for (int h = 0; h < 16; ++h) {
            f32x4 c = __builtin_amdgcn_mfma_f32_16x16x32_bf16(a0, iqf[h][0], (f32x4){0.f, 0.f, 0.f, 0.f}, 0, 0, 0);
            c = __builtin_amdgcn_mfma_f32_16x16x32_bf16(a1, iqf[h][1], c, 0, 0, 0);
            sc[0] += wv[h] * fmaxf(c[0], 0.f); sc[1] += wv[h] * fmaxf(c[1], 0.f); sc[2] += wv[h] * fmaxf(c[2], 0.f); sc[3] += wv[h] * fmaxf(c[3], 0.f);
        }
        *(f32x4*)(srow + 16 * tile) = sc * 0.03125f;
        a0 = n0; a1 = n1;
    }
}

constexpr int FA_KP = 272, FA_VP = 320;
constexpr int FA_KOFF = 0, FA_VOFF = 2 * 64 * FA_KP, FA_BYTES = FA_VOFF + 2 * 64 * FA_VP;
__device__ __forceinline__ s16x4 fa_vtr(const LAS unsigned char* p) { return __builtin_bit_cast(s16x4, __builtin_amdgcn_ds_read_tr16_b64_v4i16((LAS s16x4*)p)); }
template <int MODE>
__device__ __forceinline__ void flash_unit(Frame& F, int l, int b, int g, int t0) {
    const int tid = F.tid, lane = F.lane, wave = F.wave, hh = wave & 3, qh = wave >> 2, r = lane & 31, hf = lane >> 5;
    const int qcol = (MODE == 0 ? ZC_AQ : ZC_BQ + 512 * g) + 128 * hh, kcol = MODE == 0 ? ZC_AK : ZC_BK + 128 * g, vcol = MODE == 0 ? ZC_AV : ZC_BV + 128 * g;
    const int ocol = (MODE == 0 ? 0 : 512 + 512 * g) + 128 * hh, hd = (MODE == 0 ? 0 : 4 + 4 * g) + hh;
    const int tq = t0 + 32 * qh + r; const size_t qrow = (size_t)(b * 2048 + tq);
    const LAS float* tab2 = (const LAS float*)(F.misc + MO_TAB2) + hd * 129;
    LAS unsigned char* lds = F.lds;
    bf16x8_t qf[8];
#pragma unroll
    for (int ks = 0; ks < 8; ++ks) qf[ks] = *(const bf16x8_t*)(F.Z + qrow * ZP + qcol + 16 * ks + 8 * hf);
    f32x16 oacc[4];
#pragma unroll
    for (int dt = 0; dt < 4; ++dt)
#pragma unroll
        for (int i = 0; i < 16; ++i) oacc[dt][i] = 0.f;
    float m_run = -1e30f, l_run = 0.f;
    const int tile_lo = MODE == 0 ? 0 : (t0 >= 128 ? t0 / 64 - 2 : 0), tile_hi = t0 / 64 + 1;
    const int skey = tid >> 4, sdc = tid & 15;
    v4u kreg[2], vreg[2];
    { const bf16* zr = F.Z + (size_t)(b * 2048 + 64 * tile_lo + skey) * ZP;
#pragma unroll
      for (int i = 0; i < 2; ++i) { kreg[i] = *(const v4u*)(zr + (size_t)(32 * i) * ZP + kcol + 8 * sdc); vreg[i] = *(const v4u*)(zr + (size_t)(32 * i) * ZP + vcol + 8 * sdc); } }
    const float sc2 = 0.08838834764831845f * 1.4426950408889634f;
    unsigned mwn[2] = {0xffffffffu, 0xffffffffu};
    if (MODE == 0) { mwn[0] = F.MASK[qrow * 64 + 2 * tile_lo]; mwn[1] = F.MASK[qrow * 64 + 2 * tile_lo + 1]; }
#pragma unroll 1
    for (int kt = tile_lo; kt < tile_hi; ++kt) {
        const int bf = (kt - tile_lo) & 1, s0 = 64 * kt;
        LAS unsigned char* kb = lds + FA_KOFF + bf * (64 * FA_KP); LAS unsigned char* vb = lds + FA_VOFF + bf * (64 * FA_VP);
#pragma unroll
        for (int i = 0; i < 2; ++i) { *(LAS v4u*)(kb + (skey + 32 * i) * FA_KP + 16 * sdc) = kreg[i]; *(LAS v4u*)(vb + (skey + 32 * i) * FA_VP + 16 * sdc) = vreg[i]; }
        __syncthreads();
        if (kt + 1 < tile_hi) { const bf16* zr = F.Z + (size_t)(b * 2048 + 64 * (kt + 1) + skey) * ZP;
#pragma unroll
            for (int i = 0; i < 2; ++i) { kreg[i] = *(const v4u*)(zr + (size_t)(32 * i) * ZP + kcol + 8 * sdc); vreg[i] = *(const v4u*)(zr + (size_t)(32 * i) * ZP + vcol + 8 * sdc); } }
        unsigned mw[2] = {mwn[0], mwn[1]};
        if (MODE == 0 && kt + 1 < tile_hi) { mwn[0] = F.MASK[qrow * 64 + 2 * (kt + 1)]; mwn[1] = F.MASK[qrow * 64 + 2 * (kt + 1) + 1]; }
        f32x16 sacc[2];
#pragma unroll
        for (int k2 = 0; k2 < 2; ++k2) {
#pragma unroll
            for (int i = 0; i < 16; ++i) sacc[k2][i] = 0.f;
#pragma unroll
            for (int ks = 0; ks < 8; ++ks) { const bf16x8_t kf = *(const LAS bf16x8_t*)(kb + (32 * k2 + r) * FA_KP + (16 * ks + 8 * hf) * 2);
                sacc[k2] = __builtin_amdgcn_mfma_f32_32x32x16_bf16(kf, qf[ks], sacc[k2], 0, 0, 0); }
        }
        float mx = -1e30f;
        if (MODE == 0 && s0 + 63 + 128 <= t0) {
            const float bfar = tab2[128];
#pragma unroll
            for (int k2 = 0; k2 < 2; ++k2)
#pragma unroll
                for (int i = 0; i < 16; ++i) { const int cr = (i & 3) + 8 * (i >> 2) + 4 * hf;
                    const float v = ((mw[k2] >> cr) & 1u) ? sacc[k2][i] * sc2 + bfar : -__builtin_inff();
                    sacc[k2][i] = v; mx = fmaxf(mx, v); }
        } else
#pragma unroll
        for (int k2 = 0; k2 < 2; ++k2)
#pragma unroll
            for (int i = 0; i < 16; ++i) { const int cr = (i & 3) + 8 * (i >> 2) + 4 * hf; const int dist = tq - (s0 + 32 * k2 + cr);
                bool ok; if (MODE == 0) ok = (mw[k2] >> cr) & 1u; else ok = dist >= 0 && dist < 128;
                const int di = dist < 0 ? 0 : (dist > 128 ? 128 : dist);
                float vf = sacc[k2][i] * sc2 + tab2[di];
                asm volatile("" : "+v"(vf));
                const float v = ok ? vf : -__builtin_inff();
                sacc[k2][i] = v; mx = fmaxf(mx, v); }
        { const auto sw_ = __builtin_amdgcn_permlane32_swap(__float_as_uint(mx), __float_as_uint(mx), false, false); mx = fmaxf(__uint_as_float(sw_[0]), __uint_as_float(sw_[1])); }
        const float m_new = fmaxf(m_run, mx), alpha = __builtin_amdgcn_exp2f(m_run - m_new); m_run = m_new;
        float ps = 0.f;
#pragma unroll
        for (int k2 = 0; k2 < 2; ++k2)
#pragma unroll
            for (int i = 0; i < 16; ++i) { const float p = __builtin_amdgcn_exp2f(sacc[k2][i] - m_new); sacc[k2][i] = p; ps += p; }
        l_run = l_run * alpha + ps;
        if (__ballot(alpha != 1.0f)) {
#pragma unroll
        for (int dt = 0; dt < 4; ++dt)
#pragma unroll
            for (int i = 0; i < 16; ++i) oacc[dt][i] *= alpha;
        }
#pragma unroll
        for (int k2 = 0; k2 < 2; ++k2)
#pragma unroll
            for (int s2 = 0; s2 < 2; ++s2) {
                v4u pw; pw.x = pg8::cvt_pk_bf16(sacc[k2][8 * s2 + 0], sacc[k2][8 * s2 + 1]); pw.y = pg8::cvt_pk_bf16(sacc[k2][8 * s2 + 2], sacc[k2][8 * s2 + 3]);
                pw.z = pg8::cvt_pk_bf16(sacc[k2][8 * s2 + 4], sacc[k2][8 * s2 + 5]); pw.w = pg8::cvt_pk_bf16(sacc[k2][8 * s2 + 6], sacc[k2][8 * s2 + 7]);
                const bf16x8_t pb = __builtin_bit_cast(bf16x8_t, pw);
                const int i16 = lane & 15, grp = (lane >> 4) & 1;
                const LAS unsigned char* vp = vb + (32 * k2 + 16 * s2 + 4 * hf + (i16 >> 2)) * FA_VP + (16 * grp + 4 * (i16 & 3)) * 2;
#pragma unroll
                for (int dt = 0; dt < 4; ++dt) { const s16x4 lo = fa_vtr(vp + 64 * dt), hi = fa_vtr(vp + 8 * FA_VP + 64 * dt);
                    const bf16x8_t vf = __builtin_shufflevector(lo, hi, 0, 1, 2, 3, 4, 5, 6, 7);
                    oacc[dt] = __builtin_amdgcn_mfma_f32_32x32x16_bf16(vf, pb, oacc[dt], 0, 0, 0); }
            }
    }
    float l_tot = l_run + __shfl_xor(l_run, 32);
    if (MODE == 1) l_tot += __builtin_amdgcn_exp2f(F.in[I_SINK][l * 8 + hd - 4] * 1.4426950408889634f - m_run);
    const float inv = 1.0f / l_tot;
    bf16* orow = F.OCAT + qrow * 2048 + ocol + 4 * hf;
#pragma unroll
    for (int dt = 0; dt < 4; ++dt)
#pragma unroll
        for (int gq = 0; gq < 4; ++gq) { v2u w; w.x = pk2(oacc[dt][4 * gq] * inv, oacc[dt][4 * gq + 1] * inv); w.y = pk2(oacc[dt][4 * gq + 2] * inv, oacc[dt][4 * gq + 3] * inv);
            *(v2u*)(orow + 32 * dt + 8 * gq) = w; }
    __syncthreads();
}


#define GLA_GATE_PREFIX(LDS_TOT) \
        float la[8]; \
        _Pragma("unroll") for (int i = 0; i < 8; ++i) { const v4u c0 = rc0[i], c1 = rc1[i]; float x = gb; \
            x += bflo(c0.x) * gwv[0] + bfhi(c0.x) * gwv[1] + bflo(c0.y) * gwv[2] + bfhi(c0.y) * gwv[3] + bflo(c0.z) * gwv[4] + bfhi(c0.z) * gwv[5] + bflo(c0.w) * gwv[6] + bfhi(c0.w) * gwv[7]; \
            x += bflo(c1.x) * gwv[8] + bfhi(c1.x) * gwv[9] + bflo(c1.y) * gwv[10] + bfhi(c1.y) * gwv[11] + bflo(c1.z) * gwv[12] + bfhi(c1.z) * gwv[13] + bflo(c1.w) * gwv[14] + bfhi(c1.w) * gwv[15]; \
            la[i] = (fminf(x, 0.f) - log1pf(__expf(-fabsf(x)))) * 0.0625f; } \
        _Pragma("unroll") for (int i = 1; i < 8; ++i) la[i] += la[i - 1]; \
        ((LAS float*)(L + LDS_TOT))[cg * 64 + dk] = la[7];
#define GLA_OFFSETS(LDS_TOT) \
        float off = 0.f, tot = 0.f; \
        _Pragma("unroll") for (int g2 = 0; g2 < 8; ++g2) { const float tv = ((const LAS float*)(L + LDS_TOT))[g2 * 64 + dk]; tot += tv; off += g2 < cg ? tv : 0.f; }

__device__ __forceinline__ void gla_state_phase(Frame& F, int l) {
    const int tid = F.tid, lane = F.lane, wave = F.wave, r = lane & 31, hf = lane >> 5, i16 = lane & 15, grp = (lane >> 4) & 1;
    LAS unsigned char* L = F.lds;
    constexpr int KDT = 0, VT = 9216, TOT = 29696, RP = 144, VP = 320;
    const int dk = lane, cg = wave;
    float* GCS = (float*)(F.ws + WS_GCS); float* GDEC = (float*)(F.ws + WS_GDEC);
    v4u rc0[8], rc1[8], rv[2]; unsigned short rk[8];
#define GLS_LOAD(u_) do { const int bh_ = (u_) >> 5, n_ = (u_) & 31; const size_t r0_ = (size_t)((bh_ >> 2) * 2048 + 64 * n_); const int h_ = bh_ & 3; \
        _Pragma("unroll") for (int i = 0; i < 8; ++i) { const bf16* zr = F.Z + (r0_ + 8 * cg + i) * ZP; rc0[i] = *(const v4u*)(zr + ZC_CG); rc1[i] = *(const v4u*)(zr + ZC_CG + 8); rk[i] = zr[ZC_CK + h_ * 64 + dk]; } \
        _Pragma("unroll") for (int i = 0; i < 2; ++i) rv[i] = *(const v4u*)(F.Z + (r0_ + (tid >> 4) + 32 * i) * ZP + ZC_CV + h_ * 128 + 8 * (tid & 15)); } while (0)
    int u = F.vcu;
    if (u < 2048) GLS_LOAD(u);
    for (; u < 2048; u += F.G) {
        const int h = (u >> 5) & 3;
        float gwv[16];
#pragma unroll
        for (int q = 0; q < 16; ++q) gwv[q] = F.in[I_CGW][(size_t)l * 4096 + q * 256 + h * 64 + dk];
        const float gb = F.in[I_CGB][l * 256 + h * 64 + dk];
        GLA_GATE_PREFIX(TOT)
        float kv[8];
#pragma unroll
        for (int i = 0; i < 8; ++i) kv[i] = bf1(rk[i]);
#pragma unroll
        for (int i = 0; i < 2; ++i) *(LAS v4u*)(L + VT + ((tid >> 4) + 32 * i) * VP + 16 * (tid & 15)) = rv[i];
        __syncthreads();
        GLA_OFFSETS(TOT)
        { float kd[8];
#pragma unroll
          for (int i = 0; i < 8; ++i) kd[i] = kv[i] * __expf(tot - (off + la[i]));
          v4u w; w.x = pk2(kd[0], kd[1]); w.y = pk2(kd[2], kd[3]); w.z = pk2(kd[4], kd[5]); w.w = pk2(kd[6], kd[7]); *(LAS v4u*)(L + KDT + dk * RP + 16 * cg) = w; }
        if (cg == 0) GDEC[(size_t)u * 64 + dk] = __expf(tot);
        __syncthreads();
        if (u + F.G < 2048) GLS_LOAD(u + F.G);
        { const int dkt = wave >> 2, dvt = wave & 3;
          f32x16 cs;
#pragma unroll
          for (int i = 0; i < 16; ++i) cs[i] = 0.f;
#pragma unroll
          for (int ks = 0; ks < 4; ++ks) { const bf16x8_t a = *(const LAS bf16x8_t*)(L + KDT + (32 * dkt + r) * RP + (16 * ks + 8 * hf) * 2);
              const LAS unsigned char* vp = L + VT + (16 * ks + 8 * hf + (i16 >> 2)) * VP + (32 * dvt + 16 * grp + 4 * (i16 & 3)) * 2;
              const s16x4 lo = fa_vtr(vp), hi = fa_vtr(vp + 4 * VP);
              cs = __builtin_amdgcn_mfma_f32_32x32x16_bf16(a, __builtin_shufflevector(lo, hi, 0, 1, 2, 3, 4, 5, 6, 7), cs, 0, 0, 0); }
          float* gp = GCS + (size_t)u * 8192 + (size_t)(32 * dkt + 4 * hf) * 128 + 32 * dvt + r;
#pragma unroll
          for (int i = 0; i < 16; ++i) gp[((i & 3) + 8 * (i >> 2)) * 128] = cs[i]; }
        __syncthreads();
    }
#undef GLS_LOAD
}

__device__ __forceinline__ void gla_scan_phase(Frame& F) {
    float* GCS = (float*)(F.ws + WS_GCS); const float* GDEC = (const float*)(F.ws + WS_GDEC);
    for (int gt = F.gw * 64 + F.lane; gt < 64 * 2048; gt += F.NGW * 64) {
        const int bh = gt >> 11, e4 = gt & 2047, dk = e4 >> 5;
        f32x4* p = (f32x4*)(GCS + (size_t)bh * 32 * 8192) + e4; const float* dp = GDEC + (size_t)bh * 32 * 64 + dk;
        f32x4 st = (f32x4){0.f, 0.f, 0.f, 0.f};
#pragma unroll 1
        for (int n0 = 0; n0 < 32; n0 += 8) {
            f32x4 cs[8]; float dc[8];
#pragma unroll
            for (int j = 0; j < 8; ++j) { cs[j] = p[(size_t)(n0 + j) * 2048]; dc[j] = dp[(n0 + j) * 64]; }
#pragma unroll
            for (int j = 0; j < 8; ++j) { p[(size_t)(n0 + j) * 2048] = st; st = st * dc[j] + cs[j]; }
        }
    }
}

__device__ __forceinline__ void gla_out_phase(Frame& F, int l) {
    const int tid = F.tid, lane = F.lane, wave = F.wave, r = lane & 31, hf = lane >> 5, i16 = lane & 15, grp = (lane >> 4) & 1;
    LAS unsigned char* L = F.lds;
    constexpr int QG = 0, KG = 9216, VT = 18432, PT = 38912, TOT = 59392, OT = 61440, RP = 144, VP = 320, OP = 132;
    const int dk = lane, cg = wave;
    const float* GCS = (const float*)(F.ws + WS_GCS);
    v4u rc0[8], rc1[8], rv[2]; unsigned short rq[8], rk[8]; unsigned rg[8]; f32x4 rp[4];
#define GLO_LOAD(u_) do { const int bh_ = (u_) >> 5, n_ = (u_) & 31; const size_t r0_ = (size_t)((bh_ >> 2) * 2048 + 64 * n_); const int h_ = bh_ & 3; \
        _Pragma("unroll") for (int i = 0; i < 8; ++i) { const bf16* zr = F.Z + (r0_ + 8 * cg + i) * ZP; rc0[i] = *(const v4u*)(zr + ZC_CG); rc1[i] = *(const v4u*)(zr + ZC_CG + 8); rq[i] = zr[ZC_CQ + h_ * 64 + dk]; rk[i] = zr[ZC_CK + h_ * 64 + dk]; \
            rg[i] = *(const unsigned*)(zr + ZC_CR + h_ * 128 + 2 * lane); } \
        _Pragma("unroll") for (int i = 0; i < 2; ++i) rv[i] = *(const v4u*)(F.Z + (r0_ + (tid >> 4) + 32 * i) * ZP + ZC_CV + h_ * 128 + 8 * (tid & 15)); \
        _Pragma("unroll") for (int i = 0; i < 4; ++i) rp[i] = *(const f32x4*)(GCS + (size_t)(u_) * 8192 + (size_t)(tid >> 3) * 128 + 16 * (tid & 7) + 4 * i); } while (0)
    int u = F.vcu;
    if (u < 2048) GLO_LOAD(u);
    const float g0 = F.in[I_CNG][l * 128 + 2 * lane], g1 = F.in[I_CNG][l * 128 + 2 * lane + 1];
    for (; u < 2048; u += F.G) {
        const int bh = u >> 5, n = u & 31, h = bh & 3; const size_t row0 = (size_t)((bh >> 2) * 2048 + 64 * n);
        float gwv[16];
#pragma unroll
        for (int q = 0; q < 16; ++q) gwv[q] = F.in[I_CGW][(size_t)l * 4096 + q * 256 + h * 64 + dk];
        const float gb = F.in[I_CGB][l * 256 + h * 64 + dk];
        GLA_GATE_PREFIX(TOT)
        float qv[8], kv[8]; unsigned gr[8];
#pragma unroll
        for (int i = 0; i < 8; ++i) { qv[i] = bf1(rq[i]); kv[i] = bf1(rk[i]); gr[i] = rg[i]; }
#pragma unroll
        for (int i = 0; i < 2; ++i) *(LAS v4u*)(L + VT + ((tid >> 4) + 32 * i) * VP + 16 * (tid & 15)) = rv[i];
        { v4u w0, w1; w0.x = pk2(rp[0].x, rp[0].y); w0.y = pk2(rp[0].z, rp[0].w); w0.z = pk2(rp[1].x, rp[1].y); w0.w = pk2(rp[1].z, rp[1].w);
          w1.x = pk2(rp[2].x, rp[2].y); w1.y = pk2(rp[2].z, rp[2].w); w1.z = pk2(rp[3].x, rp[3].y); w1.w = pk2(rp[3].z, rp[3].w);
          *(LAS v4u*)(L + PT + (tid >> 3) * VP + 32 * (tid & 7)) = w0; *(LAS v4u*)(L + PT + (tid >> 3) * VP + 32 * (tid & 7) + 16) = w1; }
        __syncthreads();
        GLA_OFFSETS(TOT)
#pragma unroll
        for (int i = 0; i < 8; ++i) { const float bi = off + la[i];
            *(LAS bf16*)(L + QG + (8 * cg + i) * RP + 2 * dk) = (bf16)f2bf(qv[i] * 0.125f * __expf(bi));
            *(LAS bf16*)(L + KG + (8 * cg + i) * RP + 2 * dk) = (bf16)f2bf(kv[i] * __expf(-bi)); }
        __syncthreads();
        if (u + F.G < 2048) GLO_LOAD(u + F.G);
        { const int ct = wave >> 2, dvt = wave & 3;
          f32x16 o;
#pragma unroll
          for (int i = 0; i < 16; ++i) o[i] = 0.f;
#pragma unroll
          for (int st = 0; st < 2; ++st) if (st <= ct) {
              f32x16 at;
#pragma unroll
              for (int i = 0; i < 16; ++i) at[i] = 0.f;
#pragma unroll
              for (int ks = 0; ks < 4; ++ks) { const bf16x8_t a = *(const LAS bf16x8_t*)(L + KG + (32 * st + r) * RP + (16 * ks + 8 * hf) * 2), bq = *(const LAS bf16x8_t*)(L + QG + (32 * ct + r) * RP + (16 * ks + 8 * hf) * 2);
                  at = __builtin_amdgcn_mfma_f32_32x32x16_bf16(a, bq, at, 0, 0, 0); }
              if (st == ct) {
#pragma unroll
                  for (int i = 0; i < 16; ++i) { const int cr = (i & 3) + 8 * (i >> 2) + 4 * hf; at[i] = cr <= r ? at[i] : 0.f; } }
#pragma unroll
              for (int s2 = 0; s2 < 2; ++s2) {
                  v4u pw; pw.x = pg8::cvt_pk_bf16(at[8 * s2 + 0], at[8 * s2 + 1]); pw.y = pg8::cvt_pk_bf16(at[8 * s2 + 2], at[8 * s2 + 3]); pw.z = pg8::cvt_pk_bf16(at[8 * s2 + 4], at[8 * s2 + 5]); pw.w = pg8::cvt_pk_bf16(at[8 * s2 + 6], at[8 * s2 + 7]);
                  const LAS unsigned char* vp = L + VT + (32 * st + 16 * s2 + 4 * hf + (i16 >> 2)) * VP + (32 * dvt + 16 * grp + 4 * (i16 & 3)) * 2;
                  const s16x4 lo = fa_vtr(vp), hi = fa_vtr(vp + 8 * VP);
                  o = __builtin_amdgcn_mfma_f32_32x32x16_bf16(__builtin_bit_cast(bf16x8_t, pw), __builtin_shufflevector(lo, hi, 0, 1, 2, 3, 4, 5, 6, 7), o, 0, 0, 0);
              }
          }
#pragma unroll
          for (int ks = 0; ks < 4; ++ks) { const bf16x8_t a = *(const LAS bf16x8_t*)(L + QG + (32 * ct + r) * RP + (16 * ks + 8 * hf) * 2);
              const LAS unsigned char* pp = L + PT + (16 * ks + 8 * hf + (i16 >> 2)) * VP + (32 * dvt + 16 * grp + 4 * (i16 & 3)) * 2;
              const s16x4 lo = fa_vtr(pp), hi = fa_vtr(pp + 4 * VP);
              o = __builtin_amdgcn_mfma_f32_32x32x16_bf16(a, __builtin_shufflevector(lo, hi, 0, 1, 2, 3, 4, 5, 6, 7), o, 0, 0, 0); }
          LAS float* op = (LAS float*)(L + OT) + (32 * ct + 4 * hf) * OP + 32 * dvt + r;
#pragma unroll
          for (int i = 0; i < 16; ++i) op[((i & 3) + 8 * (i >> 2)) * OP] = o[i]; }
        __syncthreads();
        { float a[8], c[8], ss[8];
#pragma unroll
          for (int i = 0; i < 8; ++i) { const LAS float* orow = (const LAS float*)(L + OT) + (8 * wave + i) * OP + 2 * lane; a[i] = orow[0]; c[i] = orow[1]; ss[i] = a[i] * a[i] + c[i] * c[i]; }
#pragma unroll
          for (int o2 = 1; o2 < 64; o2 <<= 1) {
#pragma unroll
              for (int i = 0; i < 8; ++i) ss[i] += __shfl_xor(ss[i], o2); }
#pragma unroll
          for (int i = 0; i < 8; ++i) { const float rstd = rsqrtf(ss[i] * (1.0f / 128.0f) + EPS);
              *(unsigned*)(F.OCAT + (row0 + 8 * wave + i) * 2048 + 1536 + h * 128 + 2 * lane) = pk2(a[i] * rstd * g0 * bflo(gr[i]), c[i] * rstd * g1 * bfhi(gr[i])); } }
        __syncthreads();
    }
#undef GLO_LOAD
}
#undef GLA_GATE_PREFIX
#undef GLA_OFFSETS

__device__ __forceinline__ bool in_phase(int k, int lo, int hi) { asm volatile("" : "+s"(k)); return lo <= k && k < hi; }
#define IN(k) in_phase((k), lo, hi)
#define PHASE_LANE() do { int _tz = threadIdx.x; asm volatile("" : "+v"(_tz)); F.tid = _tz; F.lane = _tz & 63; } while (0)
#define SEAM(k) do { if (IN(k) && IN((k) + 1)) xcd_barrier(bar); } while (0)
template <int l>
__device__ __forceinline__ void layer_body(Frame& F, const XcdBarrier& bar, const int lo, const int hi) {
    constexpr int pb = 1 + 11 * l;
        if (IN(pb + 0)) {
            { pg8::Gemm g{F.XN, (const bf16*)(F.ws + WS_WIN + l * WIN_L + 24 * MiB), T, 1792, D}; pg8::StaticOrder S; S.init(T, 1792, D, F.G, (int)blockIdx.x);
              pg8::EpiInProj<1> E{F.Z, (LAS unsigned long long*)(F.misc + MO_SS), (const LAS float*)(F.misc + MO_GN) + l * 512};
              pg8::gemm_phase<pg8::EpiInProj<1>, pg8::StaticOrder, true, false>(F.lds, g, S, E); }
            { pg8::Gemm g{(const bf16*)(F.ws + WS_XN8), (const bf16*)(F.ws + WS_WIN + l * WIN_L), T, 9472, D / 2}; pg8::StaticOrder S; S.init(T, 9472, D / 2, F.G, ((int)blockIdx.x + F.G / 2) % F.G);
              pg8::EpiInProj<0> E{F.Z, (LAS unsigned long long*)(F.misc + MO_SS), (const LAS float*)(F.misc + MO_GN) + l * 512};
              pg8::gemm_phase<pg8::EpiInProj<0>, pg8::StaticOrder, true, true>(F.lds, g, S, E); }
        }
        SEAM(pb + 0);
        if (IN(pb + 1)) { PHASE_LANE();
            if (F.wave & 4) convert_moe(F, l, 0, 4, 40960);
            for (int it = F.gw; it < NB * 128; it += F.NGW) {
                const int b = it >> 7, j = it & 127;
                indexer_segment(F, b, j, 0, j < 64 ? j + 1 : 64);
                if (j < 64) indexer_segment(F, b, 127 - j, 64, 128 - j);
            }
            if (!(F.wave & 4)) convert_moe(F, l, 0, 4, 40960);
            PHASE_LANE();
            gla_state_phase(F, l);
        }
        SEAM(pb + 1);
        if (IN(pb + 2)) { PHASE_LANE();
            if (F.wave & 4) convert_moe(F, l, 1, 4, 0);
            for (int row = F.gw; row < T; row += F.NGW) {
                const int t = row & 2047;
                if (t < 256) { const int nb = t + 1 - 32 * F.lane; F.MASK[(size_t)row * 64 + F.lane] = nb >= 32 ? 0xffffffffu : (nb <= 0 ? 0u : ((1u << nb) - 1u)); continue; }
                float val[32];
#pragma unroll
                for (int j = 0; j < 32; ++j) { const int s_ = 64 * j + F.lane; val[j] = F.S[(size_t)row * 2048 + (s_ < t ? s_ : t)]; }
                float vmx = -3.0e38f, vmn = 3.0e38f;
#pragma unroll
                for (int j = 0; j < 32; ++j) { const bool ok = 64 * j + F.lane <= t; val[j] = ok ? val[j] : -3.0e38f; vmx = fmaxf(vmx, val[j]); vmn = fminf(vmn, ok ? val[j] : 3.0e38f); }
#pragma unroll
                for (int o = 1; o < 64; o <<= 1) { vmx = fmaxf(vmx, __shfl_xor(vmx, o)); vmn = fminf(vmn, __shfl_xor(vmn, o)); }
                float lo = vmn, hi = vmx, thf = 0.f; bool exact = false;
#pragma unroll 1
                for (int it = 0; it < 28; ++it) { const float mid = 0.5f * (lo + hi); if (!(mid > lo && mid < hi)) break; int cnt = 0;
#pragma unroll
                    for (int j = 0; j < 32; ++j) cnt += __popcll(__ballot(val[j] >= mid));
                    if (cnt == 256) { exact = true; thf = mid; break; }
                    if (cnt > 256) lo = mid; else hi = mid; }
                unsigned th = 0u; int need = 0;
#define KEYOF(x) ({ const unsigned u_ = __float_as_uint(x); (u_ & 0x80000000u) ? ~u_ : (u_ | 0x80000000u); })
                if (!exact) {
#pragma unroll 1
                    for (int bit = 31; bit >= 0; --bit) { const unsigned cand = th | (1u << bit); int cnt = 0;
#pragma unroll
                        for (int j = 0; j < 32; ++j) cnt += __popcll(__ballot(KEYOF(val[j]) >= cand));
                        if (cnt >= 256) th = cand; }
                    int cgt = 0;
#pragma unroll
                    for (int j = 0; j < 32; ++j) cgt += __popcll(__ballot(KEYOF(val[j]) > th));
                    need = 256 - cgt;
                }
                int run = 0; unsigned myword = 0u;
#pragma unroll
                for (int j = 0; j < 32; ++j) {
                    bool sel;
                    if (exact) sel = val[j] >= thf;
                    else { const unsigned kj = KEYOF(val[j]); const bool eq = kj == th; const unsigned long long eqm = __ballot(eq);
                        const int pre = run + __popcll(eqm & ((1ull << F.lane) - 1ull)); sel = (kj > th) || (eq && pre < need); run += __popcll(eqm); sel = sel && (64 * j + F.lane <= t); }
                    const unsigned long long sm = __ballot(sel);
                    if ((F.lane >> 1) == j) myword = (F.lane & 1) ? (unsigned)(sm >> 32) : (unsigned)sm;
                }
#undef KEYOF
                F.MASK[(size_t)row * 64 + F.lane] = myword;
            }
            if (!(F.wave & 4)) convert_moe(F, l, 1, 4, 0);
            gla_scan_phase(F);
        }
        SEAM(pb + 2);
        if (IN(pb + 3)) { PHASE_LANE();
            if (F.vcu & 1) { convert_moe(F, l, 1, 2, 0); __syncthreads(); PHASE_LANE(); }
            for (int u = F.vcu; u < NB * 16; u += F.G) { const int b = u >> 4, p = u & 15; flash_unit<0>(F, l, b, 0, 64 * (31 - p)); flash_unit<0>(F, l, b, 0, 64 * p); }
            for (int u = F.vcu; u < NB * 2 * 32; u += F.G) { const int b = u >> 6, g = (u >> 5) & 1, qb = u & 31; flash_unit<1>(F, l, b, g, 64 * qb); }
            gla_out_phase(F, l);
            if (!(F.vcu & 1)) { PHASE_LANE(); convert_moe(F, l, 1, 2, 0); }
        }
        SEAM(pb + 3);
        if (IN(pb + 4)) {
            pg8::Gemm g{F.OCAT, (const bf16*)(F.ws + WS_WBR + l * WBR_L), T, D, D}; pg8::MergeOrder S; S.init(T, D, D, F.G, (int)blockIdx.x);
            pg8::EpiMerge E{F.Z, F.MERGED};
            pg8::gemm_phase<pg8::EpiMerge, pg8::MergeOrder, true>(F.lds, g, S, E);
        }
        SEAM(pb + 4);
        if (IN(pb + 5)) {
            pg8::Gemm g{F.MERGED, (const bf16*)(F.ws + WS_WO + l * WO_L), T, D, D}; pg8::StaticOrder S; S.init(T, D, D, F.G, (int)blockIdx.x);
            pg8::EpiResid<(l > 0)> E{F.in[I_X], (bf16*)(F.ws + WS_HB), (unsigned char*)F.XN, F.in[I_N2G] + l * D};
            pg8::gemm_phase<pg8::EpiResid<(l > 0)>, pg8::StaticOrder, true>(F.lds, g, S, E);
        }
        SEAM(pb + 5);
        if (IN(pb + 6)) { PHASE_LANE();
            unsigned* cnt = F.ctl + CW_CNT + 64 * l;
            const int lane = F.lane, fr = lane & 15, fq = lane >> 4;
            LAS float* LG = (LAS float*)(F.lds + F.wave * 8192);
            const bf16* wrh = (const bf16*)(F.ws + WS_WRH + l * WR_L) + (size_t)fr * 2048 + 8 * fq; const bf16* wrl = (const bf16*)(F.ws + WS_WRL + l * WR_L) + (size_t)fr * 2048 + 8 * fq;
            for (int tile = F.gw; tile < T / 16; tile += F.NGW) {
                const bf16* hrow = (const bf16*)(F.ws + WS_HB) + (size_t)(16 * tile + fr) * D + 8 * fq;
                f32x4 acc[6];
#pragma unroll
                for (int nt = 0; nt < 6; ++nt) acc[nt] = (f32x4){0.f, 0.f, 0.f, 0.f};
                float ss = 0.f;
#pragma unroll 2
                for (int ks = 0; ks < 64; ++ks) {
                    const v4u hw = *(const v4u*)(hrow + 32 * ks);
                    { const float a0 = bflo(hw.x), a1 = bfhi(hw.x), a2 = bflo(hw.y), a3 = bfhi(hw.y), a4 = bflo(hw.z), a5 = bfhi(hw.z), a6 = bflo(hw.w), a7 = bfhi(hw.w);
                      ss += (a0 * a0 + a1 * a1) + (a2 * a2 + a3 * a3) + (a4 * a4 + a5 * a5) + (a6 * a6 + a7 * a7); }
                    const bf16x8_t ah = __builtin_bit_cast(bf16x8_t, hw);
#pragma unroll
                    for (int nt = 0; nt < 6; ++nt) { const bf16x8_t bh = *(const bf16x8_t*)(wrh + (size_t)(16 * nt) * 2048 + 32 * ks), bl = *(const bf16x8_t*)(wrl + (size_t)(16 * nt) * 2048 + 32 * ks);
                        acc[nt] = __builtin_amdgcn_mfma_f32_16x16x32_bf16(ah, bh, acc[nt], 0, 0, 0);
                        acc[nt] = __builtin_amdgcn_mfma_f32_16x16x32_bf16(ah, bl, acc[nt], 0, 0, 0); }
                }
                ss += __shfl_xor(ss, 16); ss += __shfl_xor(ss, 32);
                if (fq == 0) { const float rs_ = rsqrtf(ss * (1.0f / 2048.0f) + EPS); LG[1600 + fr] = rs_; ((float*)(F.ws + WS_RSTD))[16 * tile + fr] = rs_; }
#pragma unroll
                for (int nt = 0; nt < 6; ++nt)
#pragma unroll
                    for (int i = 0; i < 4; ++i) LG[(4 * fq + i) * 100 + 16 * nt + fr] = acc[nt][i];
                LDS_WAIT(); asm volatile("" ::: "memory");
                if (lane < 16) {
                    const int row = 16 * tile + lane; const float rstd = LG[1600 + lane]; const LAS float* lr = LG + lane * 100;
                    float lg[8]; int grp = 0; float gmax = -3.0e38f;
#pragma unroll
                    for (int e = 0; e < 8; ++e) { lg[e] = lr[e] * rstd + F.in[I_BRG][l * 8 + e]; if (lg[e] > gmax) { gmax = lg[e]; grp = e; } }
                    float gden = 0.f;
#pragma unroll
                    for (int e = 0; e < 8; ++e) gden += __expf(lg[e] - gmax);
                    const float gwt = 1.0f / gden;
                    int i0 = 0, i1 = 0; float m0 = -3.0e38f, m1 = -3.0e38f;
#pragma unroll
                    for (int e = 0; e < 8; ++e) { const float v = lr[8 + grp * 8 + e] * rstd + F.in[I_BRE][l * 64 + grp * 8 + e];
                        if (v > m0) { m1 = m0; i1 = i0; m0 = v; i0 = e; } else if (v > m1) { m1 = v; i1 = e; } }
                    const float e1 = __expf(m1 - m0); const float p0 = 1.0f / (1.0f + e1), p1 = e1 / (1.0f + e1);
                    const int ex0 = grp * 8 + i0, ex1 = grp * 8 + i1;
                    const unsigned r0 = atomicAdd(&cnt[ex0], 1u), r1 = atomicAdd(&cnt[ex1], 1u);
                    unsigned* rec = (unsigned*)(F.ws + WS_ROUTE) + (size_t)row * 8;
                    rec[0] = (unsigned)ex0; rec[1] = r0; rec[2] = (unsigned)ex1; rec[3] = r1; rec[4] = __float_as_uint(gwt * p0); rec[5] = __float_as_uint(gwt * p1);
                    int* liste = (int*)(F.ws + WS_LISTE); liste[(size_t)ex0 * 32768 + r0] = row; liste[(size_t)ex1 * 32768 + r1] = row;
                }
                LDS_WAIT(); asm volatile("" ::: "memory");
            }
        }
        SEAM(pb + 6);
        if (IN(pb + 7) || IN(pb + 8) || IN(pb + 9) || IN(pb + 10)) { PHASE_LANE();
            if (F.tid == 0) { const unsigned* cnt = F.ctl + CW_CNT + 64 * l; LAS int* texp = (LAS int*)(F.misc + MO_TEXP); LAS int* pst = (LAS int*)(F.misc + MO_PST); int tb = 0;
                for (int e = 0; e < NEXP; ++e) { const int c = (int)__hip_atomic_load(&cnt[e], __ATOMIC_RELAXED, __HIP_MEMORY_SCOPE_AGENT); const int nt_ = (c + 255) >> 8; pst[e] = tb * 256; ((LAS int*)(F.misc + MO_CNT))[e] = c;
                    for (int r = 0; r < nt_; ++r) texp[tb + r] = e; tb += nt_; }
                *(LAS int*)(F.misc + MO_TOT) = tb; }
            __syncthreads();
        }
        if (IN(pb + 8)) {
            pg8::Gemm g{F.XN, (const bf16*)(F.ws + WS_W13), 0, 0, D / 2};
            pg8::MoeGatherOrder S; S.total = *(const LAS int*)(F.misc + MO_TOT) * 4; S.G = F.G; S.c = F.vcu; S.NJ = 4; S.nt0 = D / 128; S.tile_exp = (const LAS int*)(F.misc + MO_TEXP);
            S.pst = (const LAS int*)(F.misc + MO_PST); S.cnt = (const LAS int*)(F.misc + MO_CNT); S.liste = (const int*)(F.ws + WS_LISTE);
            pg8::EpiGlu E{F.H, S.tile_exp, S.pst, S.cnt, S.liste, (const float*)(F.ws + WS_RSTD)};
            pg8::gemm_phase<pg8::EpiGlu, pg8::MoeGatherOrder, true, true>(F.lds, g, S, E);
        }
        SEAM(pb + 8);
        if (IN(pb + 9)) {
            pg8::Gemm g{F.H, (const bf16*)(F.ws + WS_W2), 0, 0, DEXP / 2};
            pg8::MoeOrder S{*(const LAS int*)(F.misc + MO_TOT) * 8, F.G, F.vcu, 8, DEXP / 128, (const LAS int*)(F.misc + MO_TEXP)};
            pg8::EpiY E{(unsigned char*)F.Y};
            pg8::gemm_phase<pg8::EpiY, pg8::MoeOrder, true, true>(F.lds, g, S, E);
        }
        SEAM(pb + 9);
        if (IN(pb + 10)) { PHASE_LANE();
            for (int row = F.gw; row < T; row += F.NGW) {
                const unsigned* rec = (const unsigned*)(F.ws + WS_ROUTE) + (size_t)row * 8;
                const float w0 = __uint_as_float(rec[4]) * 0.03125f, w1 = __uint_as_float(rec[5]) * 0.03125f;
                const LAS int* pst = (const LAS int*)(F.misc + MO_PST); const int p0 = pst[rec[0]] + (int)rec[1], p1 = pst[rec[2]] + (int)rec[3];
                const unsigned* y0 = (const unsigned*)((const unsigned char*)F.Y + (size_t)p0 * D) + F.lane; const unsigned* y1 = (const unsigned*)((const unsigned char*)F.Y + (size_t)p1 * D) + F.lane;
                f32x4 v[8];
                { const v2u* hr = (const v2u*)((const bf16*)(F.ws + WS_HB) + (size_t)row * D) + F.lane;
#pragma unroll
                  for (int j = 0; j < 8; ++j) { const v2u w = hr[64 * j]; v[j] = (f32x4){bflo(w.x), bfhi(w.x), bflo(w.y), bfhi(w.y)}; } }
#pragma unroll
                for (int j = 0; j < 8; ++j) { const int a = (int)y0[64 * j], c = (int)y1[64 * j];
                    const auto a01 = __builtin_amdgcn_cvt_pk_f32_fp8(a, false), a23 = __builtin_amdgcn_cvt_pk_f32_fp8(a, true), c01 = __builtin_amdgcn_cvt_pk_f32_fp8(c, false), c23 = __builtin_amdgcn_cvt_pk_f32_fp8(c, true);
                    v[j].x += w0 * a01[0] + w1 * c01[0]; v[j].y += w0 * a01[1] + w1 * c01[1]; v[j].z += w0 * a23[0] + w1 * c23[0]; v[j].w += w0 * a23[1] + w1 * c23[1]; }
                if (l + 1 < DEPTH) { v2u* hw_ = (v2u*)((bf16*)(F.ws + WS_HB) + (size_t)row * D) + F.lane;
#pragma unroll
                    for (int j = 0; j < 8; ++j) hw_[64 * j] = (v2u){pg8::cvt_pk_bf16(v[j].x, v[j].y), pg8::cvt_pk_bf16(v[j].z, v[j].w)}; }
                else { f32x4* orow = (f32x4*)(F.out + (size_t)row * D) + F.lane;
#pragma unroll
                    for (int j = 0; j < 8; ++j) orow[64 * j] = v[j]; }
                if (l + 1 < DEPTH) { const float rstd = row_rstd(v); norm_store_bf16(v, rstd, F.in[I_N1G] + (l + 1) * D, F.XN + (size_t)row * D, F.lane); norm_store_fp8(v, rstd, F.in[I_N1G] + (l + 1) * D, (unsigned char*)(F.ws + WS_XN8) + (size_t)row * D, F.lane); }
            }
        }
        SEAM(pb + 10);
    }
__global__ void __launch_bounds__(NWAVES * 64, 2) fwd_kernel(Args args) {
    extern __shared__ __attribute__((aligned(16))) unsigned char lds_raw[];
    Frame F;
    F.lds = (LAS unsigned char*)lds_raw; F.misc = F.lds + MISC_OFF;
    F.tid = threadIdx.x; F.lane = F.tid & 63; F.wave = __builtin_amdgcn_readfirstlane(F.tid >> 6);
    F.G = gridDim.x; { const int bx = blockIdx.x; F.vcu = (F.G % 8 == 0) ? (bx % 8) * (F.G / 8) + bx / 8 : bx; }
    F.gw = F.vcu * NWAVES + F.wave; F.NGW = F.G * NWAVES;
    F.in = args.in; F.out = args.out; F.ws = args.ws; F.ctl = (unsigned*)(args.ws + WS_CTL);
    F.Z = (bf16*)(args.ws + WS_Z); F.XN = (bf16*)(args.ws + WS_XN); F.OCAT = (bf16*)(args.ws + WS_OCAT); F.MERGED = (bf16*)(args.ws + WS_MERGED);
    F.XS = (bf16*)(args.ws + WS_XS); F.Y = (bf16*)(args.ws + WS_Y); F.H = (bf16*)(args.ws + WS_H);
    F.S = (float*)(args.ws + WS_S); F.GO = (float*)(args.ws + WS_GO); F.MASK = (unsigned*)(args.ws + WS_MASK);
    const int lo = args.ph_lo, hi = args.ph_hi;
    const bool use_bar = (hi - lo) > 1;
    for (int u = F.tid; u < 64; u += NWAVES * 64) ((LAS unsigned*)F.misc)[u] = 0u;
    ((LAS unsigned long long*)(F.misc + MO_SS))[F.tid] = 0ull;
    for (int i = F.tid; i < 2 * 4 * 128; i += NWAVES * 64) { const int l_ = i >> 9, k_ = (i >> 7) & 3, d_ = i & 127; ((LAS float*)(F.misc + MO_GN))[i] = F.in[k_ == 0 ? I_AQG : (k_ == 1 ? I_AKG : (k_ == 2 ? I_BQG : I_BKG))][l_ * 128 + d_]; }
    for (int i = F.tid; i < 12 * 129; i += NWAVES * 64) { const int hd = i / 129, dd = i % 129; int bk;
        if (dd < 16) bk = dd; else { bk = 16 + (int)(logf((float)dd / 16.0f) / 2.0794415416798357f * 16.0f); bk = bk > 31 ? 31 : bk; }
        ((LAS float*)(F.misc + MO_TAB2))[i] = F.in[I_RELB][bk * 12 + hd] * 1.4426950408889634f; }
    __syncthreads();
    XcdBarrier bar; bar.bar = F.ctl + CW_BAR; bar.x = 0; bar.st = nullptr;
    if (use_bar) bar = xcd_barrier_post(F.ctl + CW_BAR, (volatile LAS unsigned*)(F.misc + MO_BARW));

    if (IN(0)) { PHASE_LANE();
        LAS float* scr = (LAS float*)(F.lds + F.wave * 16384);
        constexpr int I_IN = (2048 / 64) * (D_IN / 32);
        constexpr int I_BA = (512 / 64) * (2048 / 32), I_BB = (1024 / 64) * (2048 / 32), I_BC = I_BA, I_O = (2048 / 64) * (2048 / 32);
        constexpr int PER_L = I_IN + I_BA + I_BB + I_BC + I_O;
        for (int it = F.gw; it < DEPTH * PER_L; it += F.NGW) {
            const int l = it / PER_L; int r = it % PER_L;
            bf16* win = (bf16*)(F.ws + WS_WIN + l * WIN_L); bf16* wbr = (bf16*)(F.ws + WS_WBR + l * WBR_L); bf16* wo = (bf16*)(F.ws + WS_WO + l * WO_L);
            if (r < I_IN) { const int nb_ = r % (D_IN / 32);
                const bool has8 = nb_ < 56 || (nb_ >= 58 && nb_ <= 106) || nb_ >= 155, hasb = (nb_ >= 56 && nb_ <= 58) || (nb_ >= 106 && nb_ < 155);
                if (has8) transpose_item_fp8(F.in[I_WIN] + (size_t)l * 2048 * D_IN, D_IN, (unsigned char*)win, 2048, 64.0f, scr, r, F.lane, MapWin8{});
                if (hasb) transpose_item(F.in[I_WIN] + (size_t)l * 2048 * D_IN, D_IN, win + (size_t)12 * 1024 * 1024, 2048, 0, scr, r, F.lane, MapWinB{});
                continue; } r -= I_IN;
            if (r < I_BA) { transpose_item(F.in[I_WBA] + (size_t)l * 512 * 2048, 2048, wbr, 2048, 0, scr, r, F.lane, MapId{0}); continue; } r -= I_BA;
            if (r < I_BB) { transpose_item(F.in[I_WBB] + (size_t)l * 1024 * 2048, 2048, wbr, 2048, 512, scr, r, F.lane, MapId{0}); continue; } r -= I_BB;
            if (r < I_BC) { transpose_item(F.in[I_WBC] + (size_t)l * 512 * 2048, 2048, wbr, 2048, 1536, scr, r, F.lane, MapId{0}); continue; } r -= I_BC;
            transpose_item(F.in[I_WO] + (size_t)l * 2048 * 2048, 2048, wo, 2048, 0, scr, r, F.lane, MapId{0});
        }
        for (int i = F.gw * 64 + F.lane; i < DEPTH * 160 * 256; i += F.NGW * 64) { const int l = i / (160 * 256), r = (i / 256) % 160, c = i % 256;
            *(v4u*)((bf16*)(F.ws + WS_WIN + l * WIN_L) + (size_t)12 * 1024 * 1024 + (size_t)(ZC_PAD - 3328 + r) * 2048 + 8 * c) = (v4u){0u, 0u, 0u, 0u}; }
        for (int i = F.gw * 64 + F.lane; i < DEPTH * 96 * 2048; i += F.NGW * 64) { const int l = i / (96 * 2048), e = (i / 2048) % 96, k = i % 2048;
            float val = 0.f; if (e < 8) val = F.in[I_WRG][(size_t)l * D * 8 + (size_t)k * 8 + e]; else if (e < 72) val = F.in[I_WRE][(size_t)l * D * 64 + (size_t)k * 64 + (e - 8)];
            val *= F.in[I_N2G][l * D + k];
            const unsigned hi = f2bf(val); const float rem = val - bf1((bf16)hi);
            ((bf16*)(F.ws + WS_WRH + l * WR_L))[e * 2048 + k] = (bf16)hi; ((bf16*)(F.ws + WS_WRL + l * WR_L))[e * 2048 + k] = (bf16)f2bf(rem); }
        for (int mrow = F.gw; mrow < T; mrow += F.NGW) { f32x4 v[8]; load_row(F.in[I_X] + (size_t)mrow * D, F.lane, v); const float rstd = row_rstd(v);
            norm_store_bf16(v, rstd, F.in[I_N1G], F.XN + (size_t)mrow * D, F.lane); norm_store_fp8(v, rstd, F.in[I_N1G], (unsigned char*)(F.ws + WS_XN8) + (size_t)mrow * D, F.lane); }
    }
    SEAM(0);

    layer_body<0>(F, bar, lo, hi);
    layer_body<1>(F, bar, lo, hi);
}


#ifndef N_LAUNCH_MODE
#define N_LAUNCH_MODE 1
#endif
extern "C" void kernel_launch(void* const* d_in, const int* in_sizes, int n_in, void* d_out, int out_size, void* d_ws, size_t ws_size, hipStream_t stream) {
    static int grid = 0;
    if (grid == 0) {
        if (n_in != 24 || out_size != T * D || ws_size < WS_END) { fprintf(stderr, "kernel_launch: unexpected shapes (n_in %d out %d ws %zu)\n", n_in, out_size, ws_size); grid = -1; return; }
        int dev = 0, cus = 0, per_cu = 0;
        if (hipGetDevice(&dev) != hipSuccess || hipDeviceGetAttribute(&cus, hipDeviceAttributeMultiprocessorCount, dev) != hipSuccess) { grid = -1; return; }
        if (hipFuncSetAttribute((const void*)fwd_kernel, hipFuncAttributeMaxDynamicSharedMemorySize, LDS_BYTES) != hipSuccess) { fprintf(stderr, "kernel_launch: hipFuncSetAttribute failed\n"); grid = -1; return; }
        if (hipOccupancyMaxActiveBlocksPerMultiprocessor(&per_cu, (const void*)fwd_kernel, NWAVES * 64, LDS_BYTES) != hipSuccess || per_cu < 1) { fprintf(stderr, "kernel_launch: occupancy query says %d\n", per_cu); }
        (void)hipGetLastError();
        grid = cus;
    }
    if (grid < 0) return;
    (void)hipMemsetAsync((char*)d_ws + WS_CTL, 0, CTL_ZERO_BYTES, stream);
    Args a{};
    for (int i = 0; i < 24; ++i) a.in[i] = (const float*)d_in[i];
    a.out = (float*)d_out; a.ws = (unsigned char*)d_ws;
    constexpr int NPH = 1 + 11 * DEPTH;
#if N_LAUNCH_MODE == 1
    a.ph_lo = 0; a.ph_hi = NPH;
    hipLaunchKernelGGL(fwd_kernel, dim3(grid), dim3(NWAVES * 64), LDS_BYTES, stream, a);
#else
    for (int p = 0; p < NPH; ++p) { a.ph_lo = p; a.ph_hi = p + 1; hipLaunchKernelGGL(fwd_kernel, dim3(grid), dim3(NWAVES * 64), LDS_BYTES, stream, a); }
#endif
    const hipError_t le = hipPeekAtLastError();
    if (le != hipSuccess) fprintf(stderr, "kernel_launch: launch failed: %s\n", hipGetErrorName(le));
}
```

```cpp
#include <hip/hip_runtime.h>
#include <cstdio>
#include <cstdint>

__device__ __forceinline__ int lane_id() { return (int)__builtin_amdgcn_mbcnt_hi(~0u, __builtin_amdgcn_mbcnt_lo(~0u, 0u)); }
namespace pg8 {
#define PG8_LAS __attribute__((address_space(3)))
typedef unsigned short bf16_t;
typedef short bf16x8 __attribute__((ext_vector_type(8)));
typedef float f32x4 __attribute__((ext_vector_type(4)));
typedef unsigned u32x4 __attribute__((ext_vector_type(4)));
typedef unsigned u32x2 __attribute__((ext_vector_type(2)));
constexpr int BM = 256, BK = 64, HALF = 128, HTB = HALF * BK * 2  , STAGE_BYTES = 8 * HTB, NXCD = 8, WGM = 8;

__host__ __device__ __forceinline__ int lds_byte(int r, int c) { const int st = (r >> 4) * 2 + (c >> 5), rr = r & 15, cc = c & 31, ob = rr * 64 + cc * 2; return st * 1024 + (ob ^ (((ob >> 9) & 1) << 5)); }
__host__ __device__ __forceinline__ void stage_rc(int b, int& R, int& C) { const int st = b / 1024, sb = b % 1024, swz = sb ^ (((sb >> 9) & 1) << 5); R = (st >> 1) * 16 + swz / 64; C = (st & 1) * 32 + (swz % 64) / 2; }
__host__ __device__ __forceinline__ int perm32(int rho) { const int n = rho >> 4, i = rho & 15; return 8 * (i >> 2) + 4 * n + (i & 3); }

struct Unit { int pm, pn, koff, nt, seg; };
struct Gemm { const bf16_t* A; const bf16_t* Bt; int M, N, K; };

struct StaticOrder {
    static constexpr bool GATHER = false;
    int nM, nN, nwg, G, c, nt0;
    __device__ __forceinline__ int row_token(const Unit&, int) const { return 0; }
    __device__ void init(int M, int N, int K, int G_, int c_) { nM = M / BM; nN = N / BM; nwg = nM * nN; G = G_; c = c_; nt0 = K / BK; }
    __device__ bool tile(long L, Unit& u) const {
        if (L >= nwg) return false;
        int wgid = (int)L; { const int q = nwg / NXCD, r = nwg % NXCD, xcd = wgid % NXCD, off = wgid / NXCD; wgid = (xcd < r ? xcd * (q + 1) : r * (q + 1) + (xcd - r) * q) + off; }
        const int nig = WGM * nN, gid = wgid / nig, fm = gid * WGM, gsz = (nM - fm) < WGM ? (nM - fm) : WGM;
        u.pm = fm + ((wgid % nig) % gsz); u.pn = (wgid % nig) / gsz; return true;
    }
    __device__ bool next(int i, Unit& u) const { u.koff = 0; u.nt = nt0; u.seg = 0; return tile((long)i * G + c, u); }
    __device__ __forceinline__ void a_ready(const Unit&) const {}
    __device__ __forceinline__ void done(const Unit&) const {}
};
struct MergeOrder : StaticOrder {
    __device__ bool next(int i, Unit& u) const { const int rnd = i / 3, sg = i - 3 * rnd; u.seg = sg; u.koff = sg == 0 ? 0 : (sg == 1 ? 512 : 1536); u.nt = sg == 1 ? 16 : 8; return tile((long)rnd * G + c, u); }
};
struct MoeOrder {
    static constexpr bool GATHER = false;
    int total, G, c, NJ, nt0; const PG8_LAS int* tile_exp;
    __device__ bool next(int i, Unit& u) const {
        const long L = (long)i * G + c; if (L >= total) return false;
        const int R = (int)L / NJ, j = (int)L % NJ; u.pm = R; u.pn = tile_exp[R] * NJ + j; u.koff = 0; u.nt = nt0; u.seg = 0; return true;
    }
    __device__ __forceinline__ int row_token(const Unit&, int) const { return 0; }
    __device__ __forceinline__ void a_ready(const Unit&) const {}
    __device__ __forceinline__ void done(const Unit&) const {}
};
struct MoeGatherOrder : MoeOrder {
    static constexpr bool GATHER = true;
    const PG8_LAS int* pst; const PG8_LAS int* cnt; const int* liste;
    __device__ __forceinline__ int row_token(const Unit& u, int r) const {
        const int e = tile_exp[u.pm], lr = u.pm * 256 - pst[e] + r;
        return lr < cnt[e] ? liste[(size_t)e * 32768 + lr] : 0;
    }
};

typedef __bf16 bf16x2v __attribute__((ext_vector_type(2)));
typedef float f32x2v __attribute__((ext_vector_type(2)));
__device__ __forceinline__ unsigned cvt_pk_bf16(float lo, float hi) { const f32x2v v = {lo, hi}; const bf16x2v b = __builtin_convertvector(v, bf16x2v); return __builtin_bit_cast(unsigned, b); }
__device__ __forceinline__ float bflo(unsigned w) { return __uint_as_float(w << 16); }
__device__ __forceinline__ float bfhi(unsigned w) { return __uint_as_float(w & 0xffff0000u); }
__device__ __forceinline__ float sigm(float v) { return __builtin_amdgcn_rcpf(1.0f + __builtin_amdgcn_exp2f(-1.44269504f * v)); }
__device__ __forceinline__ unsigned q8x4(const f32x4 s) {
    const unsigned a = (unsigned)fminf(s[0] * 256.0f, 255.5f), b = (unsigned)fminf(s[1] * 256.0f, 255.5f), c = (unsigned)fminf(s[2] * 256.0f, 255.5f), d = (unsigned)fminf(s[3] * 256.0f, 255.5f);
    return a | (b << 8) | (c << 16) | (d << 24);
}

constexpr int ZP = 11264;
constexpr int ZC_GA = 5120, ZC_GB = 7168, ZC_GC = 9216;
constexpr int GATE_BYTE0 = ZC_GA * 2;

template <int PN_OFF> struct EpiInProj {
    static constexpr bool PERM = true, AFTER_DRAIN = false, CHAIN = false;
    bf16_t* O; PG8_LAS unsigned long long* ss;
    const PG8_LAS float* gains;
    __device__ __forceinline__ void operator()(const f32x4 (&acc)[2][2][4][2], const Unit& u, int wr, int wc, int fr, int fq) const {
        const int pn = PN_OFF ? u.pn + 13 : (u.pn < 13 ? u.pn : u.pn + 7);
        int row0 = u.pm * BM + wr * 64 + fr, col0 = pn * BM + wc * 32 + 8 * fq;
        asm volatile("" : "+v"(row0), "+v"(col0));
        const int act = pn >= 20 ? 2 : (pn >= 18 ? 1 : 0);
        const bool hn = PN_OFF == 0 && pn <= 7;
        f32x4 gn0 = (f32x4){1.f, 1.f, 1.f, 1.f}, gn1 = gn0; int lr = 0;
        if (hn) {
            lr = wr * 64 + fr; asm volatile("" : "+v"(lr));
#pragma unroll
            for (int ai = 0; ai < 2; ++ai)
#pragma unroll
                for (int m = 0; m < 4; ++m)
#pragma unroll
                    for (int bj = 0; bj < 2; ++bj) { const f32x4 a = acc[ai][bj][m][0], b = acc[ai][bj][m][1];
                        float s = (a[0] * a[0] + a[1] * a[1]) + (a[2] * a[2] + a[3] * a[3]) + (b[0] * b[0] + b[1] * b[1]) + (b[2] * b[2] + b[3] * b[3]);
                        s += __shfl_xor(s, 16); s += __shfl_xor(s, 32);
                        if (fq == 0) __hip_atomic_fetch_add(ss + (ai * HALF + m * 16 + lr) * 2 + bj, (unsigned long long)(s * 1048576.0f), __ATOMIC_RELAXED, __HIP_MEMORY_SCOPE_WORKGROUP); }
            asm volatile("s_waitcnt lgkmcnt(0)" ::: "memory"); __builtin_amdgcn_s_barrier(); asm volatile("" ::: "memory");
            const PG8_LAS float* gp = gains + (pn <= 1 ? 0 : (pn == 2 ? 128 : (pn <= 6 ? 256 : 384))) + wc * 32 + 8 * fq;
            gn0 = *(const PG8_LAS f32x4*)gp; gn1 = *(const PG8_LAS f32x4*)(gp + 4);
        }
#pragma unroll
        for (int ai = 0; ai < 2; ++ai)
#pragma unroll
            for (int m = 0; m < 4; ++m) { bf16_t* rowp = O + (size_t)(row0 + ai * HALF + m * 16) * ZP + col0;
#pragma unroll
                for (int bj = 0; bj < 2; ++bj) { f32x4 v0 = acc[ai][bj][m][0], v1 = acc[ai][bj][m][1];
                    if (hn && !(pn == 2 && bj == 1)) { const float r = rsqrtf((float)ss[(ai * HALF + m * 16 + lr) * 2 + bj] * (0.015625f * 0.015625f / 128.0f / 1048576.0f) + 1e-6f) * 0.015625f;
                        v0 = v0 * r * gn0; v1 = v1 * r * gn1; }
                    else if (PN_OFF == 0) { v0 = v0 * 0.015625f; v1 = v1 * 0.015625f; }
                    if (act == 2) {
                        f32x4 s0, s1;
#pragma unroll
                        for (int j = 0; j < 4; ++j) { s0[j] = sigm(v0[j]); s1[j] = sigm(v1[j]); }
                        *(u32x2*)((unsigned char*)(rowp - col0) + GATE_BYTE0 + (col0 - ZC_GA) + bj * HALF) = (u32x2){q8x4(s0), q8x4(s1)}; }
                    else {
                        if (act) {
#pragma unroll
                            for (int j = 0; j < 4; ++j) { v0[j] *= sigm(v0[j]); v1[j] *= sigm(v1[j]); } }
                        u32x4 w; w.x = cvt_pk_bf16(v0[0], v0[1]); w.y = cvt_pk_bf16(v0[2], v0[3]); w.z = cvt_pk_bf16(v1[0], v1[1]); w.w = cvt_pk_bf16(v1[2], v1[3]);
                        *(u32x4*)(rowp + bj * HALF) = w; } } }
        if (hn) { asm volatile("s_waitcnt lgkmcnt(0)" ::: "memory"); __builtin_amdgcn_s_barrier(); asm volatile("" ::: "memory");
            ss[(wr * 4 + wc) * 64 + fq * 16 + fr] = 0ull; }
    }
};
struct EpiMerge {
    static constexpr bool PERM = true, AFTER_DRAIN = false, CHAIN = true;
    const bf16_t* Z; bf16_t* O;
    __device__ __forceinline__ void operator()(f32x4 (&acc)[2][2][4][2], const Unit& u, int wr, int wc, int fr, int fq) const {
        const int row0 = u.pm * BM + wr * 64 + fr, col0 = u.pn * BM + wc * 32 + 8 * fq;
        const unsigned char* G = (const unsigned char*)Z + GATE_BYTE0 + col0;
        const int cn = u.seg * 2048, cd = u.seg == 0 ? 2048 : 4096;
        const bool fin = u.seg == 2;
#pragma unroll
        for (int ai = 0; ai < 2; ++ai) {
            u32x2 gn[4][2], gd[4][2];
#pragma unroll
            for (int m = 0; m < 4; ++m)
#pragma unroll
                for (int bj = 0; bj < 2; ++bj) { const size_t r = (size_t)(row0 + ai * HALF + m * 16);
                    gn[m][bj] = *(const u32x2*)(G + r * (ZP * 2) + cn + bj * HALF);
                    if (!fin) gd[m][bj] = *(const u32x2*)(G + r * (ZP * 2) + cd + bj * HALF); else gd[m][bj] = gn[m][bj]; }
#pragma unroll
            for (int m = 0; m < 4; ++m)
#pragma unroll
                for (int bj = 0; bj < 2; ++bj) { const size_t r = (size_t)(row0 + ai * HALF + m * 16);
#pragma unroll
                    for (int w = 0; w < 2; ++w)
#pragma unroll
                        for (int k = 0; k < 4; ++k) { const float qn = (float)((gn[m][bj][w] >> (8 * k)) & 0xffu) + 0.5f, qd = (float)((gd[m][bj][w] >> (8 * k)) & 0xffu) + 0.5f;
                            acc[ai][bj][m][w][k] *= qn * __builtin_amdgcn_rcpf(fin ? 256.0f : qd); }
                    if (fin) { const f32x4 v0 = acc[ai][bj][m][0], v1 = acc[ai][bj][m][1];
                        u32x4 w; w.x = cvt_pk_bf16(v0[0], v0[1]); w.y = cvt_pk_bf16(v0[2], v0[3]); w.z = cvt_pk_bf16(v1[0], v1[1]); w.w = cvt_pk_bf16(v1[2], v1[3]);
                        *(u32x4*)(O + r * 2048 + col0 + bj * HALF) = w; } }
        }
    }
};
template <bool BASE_BF16> struct EpiResid {
    static constexpr bool PERM = true, AFTER_DRAIN = false, CHAIN = false;
    const float* base; bf16_t* hb; unsigned char* xu; const float* gain;
    __device__ __forceinline__ void operator()(const f32x4 (&acc)[2][2][4][2], const Unit& u, int wr, int wc, int fr, int fq) const {
        const int row0 = u.pm * BM + wr * 64 + fr, col0 = u.pn * BM + wc * 32 + 8 * fq;
        f32x4 gv[2][2];
#pragma unroll
        for (int bj = 0; bj < 2; ++bj)
#pragma unroll
            for (int n = 0; n < 2; ++n) gv[bj][n] = *(const f32x4*)(gain + col0 + bj * HALF + 4 * n);
        const f32x4 lo4 = (f32x4){-440.f, -440.f, -440.f, -440.f}, hi4 = (f32x4){440.f, 440.f, 440.f, 440.f};
#pragma unroll
        for (int ai = 0; ai < 2; ++ai) {
            f32x4 bv[4][2][2];
#pragma unroll
            for (int mm = 0; mm < 4; ++mm) { const size_t off = (size_t)(row0 + ai * HALF + mm * 16) * 2048 + col0;
#pragma unroll
                for (int bj = 0; bj < 2; ++bj) {
                    if constexpr (BASE_BF16) { const u32x4 w = *(const u32x4*)(hb + off + bj * HALF);
                        bv[mm][bj][0] = (f32x4){bflo(w.x), bfhi(w.x), bflo(w.y), bfhi(w.y)}; bv[mm][bj][1] = (f32x4){bflo(w.z), bfhi(w.z), bflo(w.w), bfhi(w.w)}; }
                    else { bv[mm][bj][0] = *(const f32x4*)(base + off + bj * HALF); bv[mm][bj][1] = *(const f32x4*)(base + off + bj * HALF + 4); } } }
#pragma unroll
            for (int mm = 0; mm < 4; ++mm) { const size_t off = (size_t)(row0 + ai * HALF + mm * 16) * 2048 + col0;
#pragma unroll
                for (int bj = 0; bj < 2; ++bj) { const f32x4 h0 = bv[mm][bj][0] + acc[ai][bj][mm][0], h1 = bv[mm][bj][1] + acc[ai][bj][mm][1];
                    u32x4 hw; hw.x = cvt_pk_bf16(h0[0], h0[1]); hw.y = cvt_pk_bf16(h0[2], h0[3]); hw.z = cvt_pk_bf16(h1[0], h1[1]); hw.w = cvt_pk_bf16(h1[2], h1[3]);
                    *(u32x4*)(hb + off + bj * HALF) = hw;
                    const f32x4 x0 = __builtin_elementwise_min(__builtin_elementwise_max(h0 * gv[bj][0], lo4), hi4), x1 = __builtin_elementwise_min(__builtin_elementwise_max(h1 * gv[bj][1], lo4), hi4);
                    int w0 = 0, w1 = 0;
                    w0 = __builtin_amdgcn_cvt_pk_fp8_f32(x0[0], x0[1], w0, false); w0 = __builtin_amdgcn_cvt_pk_fp8_f32(x0[2], x0[3], w0, true);
                    w1 = __builtin_amdgcn_cvt_pk_fp8_f32(x1[0], x1[1], w1, false); w1 = __builtin_amdgcn_cvt_pk_fp8_f32(x1[2], x1[3], w1, true);
                    *(u32x2*)(xu + off + bj * HALF) = (u32x2){(unsigned)w0, (unsigned)w1}; } }
        }
    }
};
struct EpiGlu {
    static constexpr bool PERM = false, AFTER_DRAIN = false, CHAIN = false;
    bf16_t* H; const PG8_LAS int* tile_exp; const PG8_LAS int* pst; const PG8_LAS int* cnt; const int* liste; const float* rstd;
    __device__ __forceinline__ void operator()(const f32x4 (&acc)[2][2][4][2], const Unit& u, int wr, int wc, int fr, int fq) const {
        const int row0 = u.pm * BM + wr * 64 + fr, pj = u.pn & 3;
        const int e = tile_exp[u.pm], lr0 = u.pm * 256 - pst[e] + wr * 64 + fr, ce = cnt[e];
        int tok[2][4]; float rs[2][4];
#pragma unroll
        for (int ai = 0; ai < 2; ++ai)
#pragma unroll
            for (int m = 0; m < 4; ++m) { const int lr = lr0 + ai * HALF + m * 16; tok[ai][m] = lr < ce ? liste[(size_t)e * 32768 + lr] : 0; }
#pragma unroll
        for (int ai = 0; ai < 2; ++ai)
#pragma unroll
            for (int m = 0; m < 4; ++m) rs[ai][m] = rstd[tok[ai][m]] * 0.015625f;
#pragma unroll
        for (int ai = 0; ai < 2; ++ai)
#pragma unroll
            for (int m = 0; m < 4; ++m) { unsigned char* rowp = (unsigned char*)H + (size_t)(row0 + ai * HALF + m * 16) * 512; const float r = rs[ai][m];
#pragma unroll
                for (int bj = 0; bj < 2; ++bj) { const f32x4 a = acc[ai][bj][m][0] * r, b = acc[ai][bj][m][1] * r;
                    const int hc = 16 * (8 * pj + 4 * bj + wc) + 4 * fq;
                    float hv[4];
#pragma unroll
                    for (int j = 0; j < 4; ++j) hv[j] = fminf(fmaxf(a[j] * sigm(a[j]) * b[j] * 8.0f, -440.0f), 440.0f);
                    int w = 0; w = __builtin_amdgcn_cvt_pk_fp8_f32(hv[0], hv[1], w, false); w = __builtin_amdgcn_cvt_pk_fp8_f32(hv[2], hv[3], w, true);
                    *(int*)(rowp + hc) = w; } }
    }
};
struct EpiY {
    static constexpr bool PERM = true, AFTER_DRAIN = false, CHAIN = false;
    unsigned char* Y;
    __device__ __forceinline__ void operator()(const f32x4 (&acc)[2][2][4][2], const Unit& u, int wr, int wc, int fr, int fq) const {
        const int row0 = u.pm * BM + wr * 64 + fr, col0 = (u.pn & 7) * BM + wc * 32 + 8 * fq;
        const f32x4 lo4 = (f32x4){-440.f, -440.f, -440.f, -440.f}, hi4 = (f32x4){440.f, 440.f, 440.f, 440.f};
#pragma unroll
        for (int ai = 0; ai < 2; ++ai)
#pragma unroll
            for (int m = 0; m < 4; ++m) { unsigned char* rowp = Y + (size_t)(row0 + ai * HALF + m * 16) * 2048 + col0;
#pragma unroll
                for (int bj = 0; bj < 2; ++bj) {
                    const f32x4 v0 = __builtin_elementwise_min(__builtin_elementwise_max(acc[ai][bj][m][0] * 0.125f, lo4), hi4), v1 = __builtin_elementwise_min(__builtin_elementwise_max(acc[ai][bj][m][1] * 0.125f, lo4), hi4);
                    int w0 = 0, w1 = 0;
                    w0 = __builtin_amdgcn_cvt_pk_fp8_f32(v0[0], v0[1], w0, false); w0 = __builtin_amdgcn_cvt_pk_fp8_f32(v0[2], v0[3], w0, true);
                    w1 = __builtin_amdgcn_cvt_pk_fp8_f32(v1[0], v1[1], w1, false); w1 = __builtin_amdgcn_cvt_pk_fp8_f32(v1[2], v1[3], w1, true);
                    *(u32x2*)(rowp + bj * HALF) = (u32x2){(unsigned)w0, (unsigned)w1}; } }
    }
};

typedef int v4i_t __attribute__((ext_vector_type(4)));
typedef int v8i_t __attribute__((ext_vector_type(8)));
template <class Epi, class Sched, bool ALIGN_EPI = false, bool FP8 = false>
__device__ __forceinline__ void gemm_phase(PG8_LAS unsigned char* lds, const Gemm g, const Sched& S, const Epi& E) {
    int tid = threadIdx.x; asm volatile("" : "+v"(tid));
    const int wid = __builtin_amdgcn_readfirstlane(tid >> 6), lane = tid & 63, wr = wid >> 2, wc = wid & 3, fr = lane & 15, fq = lane >> 4;
    const int K = g.K;
    unsigned voffA[2], voffB[2]; int RA[2]; unsigned CA2[2];
#pragma unroll
    for (int i = 0; i < 2; ++i) { int R, C; stage_rc(tid * 16 + i * 8192, R, C); const int Rb = Epi::PERM ? ((R & ~31) + perm32(R & 31)) : R;
        voffA[i] = (unsigned)(R * K + C) * 2u; voffB[i] = (unsigned)(Rb * K + C) * 2u; RA[i] = R; CA2[i] = (unsigned)C * 2u; }
    unsigned gAc[2][2], gAn[2][2];
#define PG8_GOFF(dst, uu) do { _Pragma("unroll") for (int h_ = 0; h_ < 2; ++h_) _Pragma("unroll") for (int i_ = 0; i_ < 2; ++i_) dst[h_][i_] = (unsigned)S.row_token(uu, 128 * h_ + RA[i_]) * (unsigned)(K * 2) + CA2[i_]; } while (0)
#define PG8_STAGE_A(bufoff, gbase, half, garr) do { if constexpr (Sched::GATHER) PG8_STAGE(bufoff, gbase, garr); else PG8_STAGE(bufoff, (gbase) + (half) * hstep, voffA); } while (0)
    const size_t kstep = (size_t)(BK * 2);
    const size_t hstep = (size_t)HALF * K * 2;
    const size_t tstep = 2 * hstep;
    const unsigned ldsw = (unsigned)wid * 1024u;
    const int aoff = lds_byte(wr * 64 + fr, fq * 8), boff = lds_byte(wc * 32 + fr, fq * 8);
#define PG8_SA(b, h) (((b) * 2 + (h)) * HTB)
#define PG8_SB(b, h) ((4 + (b) * 2 + (h)) * HTB)
#define PG8_STAGE(bufoff, gbase, voff) do { _Pragma("unroll") for (int _i = 0; _i < 2; ++_i) \
        __builtin_amdgcn_global_load_lds((const unsigned*)((const char*)(gbase) + (voff)[_i]), (PG8_LAS unsigned*)(lds + (bufoff) + ldsw + _i * 8192), 16, 0, 0); } while (0)
#define PG8_LDA(dst, b, h) do { if constexpr (FP8) { _Pragma("unroll") for (int m = 0; m < 4; ++m) dst##8[m] = __builtin_shufflevector(*(const PG8_LAS v4i_t*)(lds + PG8_SA(b, h) + aoff + m * 2048), *(const PG8_LAS v4i_t*)(lds + PG8_SA(b, h) + aoff + m * 2048 + 1024), 0, 1, 2, 3, 4, 5, 6, 7); } \
        else { _Pragma("unroll") for (int m = 0; m < 4; ++m) _Pragma("unroll") for (int k = 0; k < 2; ++k) dst[m][k] = *(const PG8_LAS bf16x8*)(lds + PG8_SA(b, h) + aoff + m * 2048 + k * 1024); } } while (0)
#define PG8_LDB(dst, b, h) do { if constexpr (FP8) { _Pragma("unroll") for (int n = 0; n < 2; ++n) dst##8[n] = __builtin_shufflevector(*(const PG8_LAS v4i_t*)(lds + PG8_SB(b, h) + boff + n * 2048), *(const PG8_LAS v4i_t*)(lds + PG8_SB(b, h) + boff + n * 2048 + 1024), 0, 1, 2, 3, 4, 5, 6, 7); } \
        else { _Pragma("unroll") for (int n = 0; n < 2; ++n) _Pragma("unroll") for (int k = 0; k < 2; ++k) dst[n][k] = *(const PG8_LAS bf16x8*)(lds + PG8_SB(b, h) + boff + n * 2048 + k * 1024); } } while (0)
#define PG8_MMA(ai, bj, At, Bt) do { __builtin_amdgcn_s_setprio(1); _Pragma("unroll") for (int m = 0; m < 4; ++m) _Pragma("unroll") for (int n = 0; n < 2; ++n) { \
        if constexpr (FP8) asm volatile("v_mfma_f32_16x16x128_f8f6f4 %0, %1, %2, %0" : "+v"(acc[ai][bj][m][n]) : "v"(Bt##8[n]), "v"(At##8[m])); \
        else { _Pragma("unroll") for (int k = 0; k < 2; ++k) acc[ai][bj][m][n] = __builtin_amdgcn_mfma_f32_16x16x32_bf16(Bt[n][k], At[m][k], acc[ai][bj][m][n], 0, 0, 0); } } \
        __builtin_amdgcn_s_setprio(0); } while (0)
#define PG8_WAIT_V(n) asm volatile("s_waitcnt vmcnt(" #n ")" ::: "memory")
#define PG8_WAIT_L(n) asm volatile("s_waitcnt lgkmcnt(" #n ")" ::: "memory")
#define PG8_BAR __builtin_amdgcn_s_barrier()
#define PG8_SCHED __builtin_amdgcn_sched_barrier(0)
    Unit cur, nxt; int ui = 0;
    if (!S.next(0, cur)) return;
    f32x4 acc[2][2][4][2];
#pragma unroll
    for (int a = 0; a < 2; ++a)
#pragma unroll
        for (int b = 0; b < 2; ++b)
#pragma unroll
            for (int m = 0; m < 4; ++m)
#pragma unroll
                for (int n = 0; n < 2; ++n) acc[a][b][m][n] = (f32x4){0.f, 0.f, 0.f, 0.f};
    bf16x8 At[4][2], B0[2][2], B1[2][2]; v8i_t At8[4], B08[2], B18[2];
    const size_t tstepA = Sched::GATHER ? (size_t)0 : tstep;
    const char* cA = (const char*)g.A + (size_t)cur.pm * tstepA + (size_t)cur.koff * 2; const char* cB = (const char*)g.Bt + (size_t)cur.pn * tstep + (size_t)cur.koff * 2;
    S.a_ready(cur);
    if constexpr (Sched::GATHER) { PG8_GOFF(gAc, cur); }
    PG8_STAGE(PG8_SB(0, 0), cB, voffB); PG8_STAGE(PG8_SB(0, 1), cB + hstep, voffB); PG8_STAGE_A(PG8_SA(0, 0), cA, 0, gAc[0]); PG8_STAGE_A(PG8_SA(0, 1), cA, 1, gAc[1]);
    if (wr == 1) PG8_BAR;
    PG8_WAIT_V(2); PG8_BAR;
    PG8_STAGE(PG8_SB(1, 0), cB + kstep, voffB); PG8_STAGE_A(PG8_SA(1, 0), cA + kstep, 0, gAc[0]); PG8_STAGE(PG8_SB(1, 1), cB + hstep + kstep, voffB);
    PG8_WAIT_V(6); PG8_BAR;
    for (;;) {
        const bool has_next = S.next(ui + 1, nxt);
        const char* nA = has_next ? (const char*)g.A + (size_t)nxt.pm * tstepA + (size_t)nxt.koff * 2 : cA; const char* nB = has_next ? (const char*)g.Bt + (size_t)nxt.pn * tstep + (size_t)nxt.koff * 2 : cB;
        if constexpr (Sched::GATHER) { if (has_next) { PG8_GOFF(gAn, nxt); } else {
#pragma unroll
            for (int h_ = 0; h_ < 2; ++h_)
#pragma unroll
                for (int i_ = 0; i_ < 2; ++i_) gAn[h_][i_] = gAc[h_][i_]; } }
        const int nt = cur.nt;
        for (int t = 0; t < nt; t += 2) {
            const bool last = (t == nt - 2);
            const char* a1 = cA + (size_t)(t + 1) * kstep;
            const char* a2 = last ? nA : cA + (size_t)(t + 2) * kstep; const char* b2 = last ? nB : cB + (size_t)(t + 2) * kstep;
            const char* a3 = a2 + kstep; const char* b3 = b2 + kstep;
            if (last && has_next) S.a_ready(nxt);
            unsigned g2a[2][2];
            if constexpr (Sched::GATHER) {
#pragma unroll
                for (int h_ = 0; h_ < 2; ++h_)
#pragma unroll
                    for (int i_ = 0; i_ < 2; ++i_) g2a[h_][i_] = last ? gAn[h_][i_] : gAc[h_][i_]; }
            PG8_LDB(B0, 0, 0); PG8_LDB(B1, 0, 1); PG8_SCHED; PG8_LDA(At, 0, 0); PG8_STAGE_A(PG8_SA(1, 1), a1, 1, gAc[1]);
            PG8_WAIT_V(8); PG8_WAIT_L(0); PG8_BAR; PG8_MMA(0, 0, At, B0); PG8_MMA(0, 1, At, B1); PG8_BAR; PG8_SCHED;
            PG8_LDA(At, 0, 1); PG8_STAGE(PG8_SB(0, 0), b2, voffB); PG8_STAGE(PG8_SB(0, 1), b2 + hstep, voffB); PG8_STAGE_A(PG8_SA(0, 0), a2, 0, g2a[0]);
            PG8_WAIT_V(8); PG8_WAIT_L(0); PG8_BAR; PG8_MMA(1, 0, At, B0); PG8_MMA(1, 1, At, B1); PG8_BAR; PG8_SCHED;
            PG8_LDB(B0, 1, 0); PG8_LDB(B1, 1, 1); PG8_SCHED; PG8_LDA(At, 1, 0); PG8_STAGE_A(PG8_SA(0, 1), a2, 1, g2a[1]);
            PG8_WAIT_V(8); PG8_WAIT_L(0); PG8_BAR; PG8_MMA(0, 0, At, B0); PG8_MMA(0, 1, At, B1); PG8_BAR; PG8_SCHED;
            PG8_LDA(At, 1, 1); PG8_STAGE(PG8_SB(1, 0), b3, voffB); PG8_STAGE(PG8_SB(1, 1), b3 + hstep, voffB); PG8_STAGE_A(PG8_SA(1, 0), a3, 0, g2a[0]);
            PG8_WAIT_V(8); PG8_WAIT_L(0); PG8_BAR; PG8_MMA(1, 0, At, B0); PG8_MMA(1, 1, At, B1); PG8_BAR; PG8_SCHED;
        }
        if constexpr (ALIGN_EPI) { if (wr == 0) PG8_BAR; }
        if constexpr (FP8) asm volatile("s_nop 15\n\ts_nop 15\n\ts_nop 15\n\ts_nop 15" ::: "memory");
        E(acc, cur, wr, wc, fr, fq); S.done(cur);
        if (!has_next) break;
        if (!Epi::CHAIN || cur.seg == 2)
#pragma unroll
        for (int a = 0; a < 2; ++a)
#pragma unroll
            for (int b = 0; b < 2; ++b)
#pragma unroll
                for (int m = 0; m < 4; ++m)
#pragma unroll
                    for (int n = 0; n < 2; ++n) acc[a][b][m][n] = (f32x4){0.f, 0.f, 0.f, 0.f};
        cur = nxt; cA = nA; cB = nB; ++ui;
        if constexpr (Sched::GATHER) {
#pragma unroll
            for (int h_ = 0; h_ < 2; ++h_)
#pragma unroll
                for (int i_ = 0; i_ < 2; ++i_) gAc[h_][i_] = gAn[h_][i_]; }
        if constexpr (ALIGN_EPI) { if (wr == 1) PG8_BAR; }
    }
    PG8_WAIT_V(0);
    if constexpr (!ALIGN_EPI) { if (wr == 0) PG8_BAR; }
    PG8_BAR;
#undef PG8_SA
#undef PG8_SB
#undef PG8_STAGE_A
#undef PG8_GOFF
#undef PG8_STAGE
#undef PG8_LDA
#undef PG8_LDB
#undef PG8_MMA
#undef PG8_WAIT_V
#undef PG8_WAIT_L
#undef PG8_BAR
#undef PG8_SCHED
}
}

constexpr int NWAVES = 8;
constexpr int T = 32768, SEQ = 2048, NB = 16, D = 2048, DEPTH = 2;
constexpr int ZP = pg8::ZP;
constexpr int ZC_AQ = 0, ZC_AK = 512, ZC_AV = 640, ZC_BQ = 768, ZC_BK = 1792, ZC_BV = 2048, ZC_IQ = 2304, ZC_IK = 3328, ZC_IW = 3392, ZC_CG = 3408, ZC_PAD = 3424, ZC_CQ = 3584, ZC_CK = 3840, ZC_CV = 4096, ZC_CR = 4608;
constexpr int D_IN = 11104;
constexpr int NEXP = 64, DEXP = 512, PMAX_TILES = 320;
constexpr float EPS = 1e-6f;

constexpr size_t MiB = 1u << 20;
constexpr size_t WS_CTL = 0, CTL_ZERO_BYTES = 1 * MiB;
constexpr size_t WS_ROUTE = 2 * MiB;
constexpr size_t WS_WRH = 4 * MiB, WS_WRL = 6 * MiB, WR_L = 96 * 2048 * 2;
constexpr size_t WS_WIN = 16 * MiB, WIN_L = 44 * MiB;
constexpr size_t WS_WBR = 104 * MiB, WBR_L = 8 * MiB;
constexpr size_t WS_WO = 120 * MiB, WO_L = 8 * MiB;
constexpr size_t WS_W13 = 136 * MiB;
constexpr size_t WS_HB = 264 * MiB;
constexpr size_t WS_W2 = 392 * MiB;
constexpr size_t WS_XN = 520 * MiB;
constexpr size_t WS_OCAT = 648 * MiB;
constexpr size_t WS_MERGED = 776 * MiB;
constexpr size_t WS_Z = 904 * MiB;
constexpr size_t WS_S = 1608 * MiB;
constexpr size_t WS_MASK = 1864 * MiB;
constexpr size_t WS_GO = 1872 * MiB;
constexpr size_t WS_GCS = WS_GO;
constexpr size_t WS_GDEC = 8 * MiB;
constexpr size_t WS_RSTD = 9 * MiB;
constexpr size_t WS_LISTE = 904 * MiB;
constexpr size_t WS_XS = 904 * MiB;
constexpr size_t WS_Y = 1224 * MiB;
constexpr size_t WS_H = 1544 * MiB;
constexpr size_t WS_WG8 = 1936 * MiB, WG8_L = 12 * MiB;
constexpr size_t WS_XN8 = WS_S;
constexpr size_t WS_END = 1936 * MiB;
constexpr int CW_BAR = 4096;
constexpr int CW_CNT = 16384;

constexpr int RING_BYTES = 131072, MISC_OFF = RING_BYTES, LDS_BYTES = 155648;
constexpr int MO_BARW = 32, MO_GN = 256, MO_TEXP = 8192, MO_PST = 9728, MO_TOT = 9984, MO_TAB2 = 10240, MO_CNT = 16640, MO_SS = 16896;

#define GAS __attribute__((address_space(1)))
#define LAS __attribute__((address_space(3)))
typedef unsigned short bf16;
typedef unsigned v4u __attribute__((ext_vector_type(4)));
typedef unsigned v2u __attribute__((ext_vector_type(2)));
typedef float f32x4 __attribute__((ext_vector_type(4)));
#define LDS_WAIT() asm volatile("s_waitcnt lgkmcnt(0)" ::: "memory")
__device__ __forceinline__ unsigned f2bf(float f) { unsigned u = __builtin_bit_cast(unsigned, f); return (u + 0x7fffu + ((u >> 16) & 1u)) >> 16; }
__device__ __forceinline__ unsigned pk2(float lo, float hi) { return f2bf(lo) | (f2bf(hi) << 16); }
__device__ __forceinline__ float bflo(unsigned w) { return __uint_as_float(w << 16); }
__device__ __forceinline__ float bfhi(unsigned w) { return __uint_as_float(w & 0xffff0000u); }
__device__ __forceinline__ float bf1(bf16 h) { return __uint_as_float(((unsigned)h) << 16); }

#define XB_TMO      128
#define XB_XCNT(j)  (256  + 64 * (j))
#define XB_XSUB(j)  (1280 + 64 * (j))
#define XB_XGEN(j)  (2304 + 64 * (j))
#define XB_TOP      3328
#define XB_TOPGEN   3392
#define XCD_BAR_WORDS 3456
#define XB_SPIN_CAP (1u << 18)
__device__ __forceinline__ unsigned xb_ld(unsigned* p)              { return __hip_atomic_load(p, __ATOMIC_RELAXED, __HIP_MEMORY_SCOPE_AGENT); }
__device__ __forceinline__ unsigned xb_add(unsigned* p, unsigned v) { return __hip_atomic_fetch_add(p, v, __ATOMIC_RELAXED, __HIP_MEMORY_SCOPE_AGENT); }
__device__ __forceinline__ unsigned xb_xcc_id() { return (unsigned)__builtin_amdgcn_s_getreg((3 << 11) | 20) & 0xFu; }
#define XB_SPIN(cond, bar) do { unsigned _sp = 0; while (cond) { __builtin_amdgcn_s_sleep(1); \
    if ((++_sp & 255u) == 0u) { if (xb_ld(&(bar)[XB_TMO])) break; if (_sp > XB_SPIN_CAP) { atomicAdd(&(bar)[XB_TMO], 1u); break; } } } } while (0)
struct XcdBarrier { unsigned* bar; unsigned x; volatile LAS unsigned* st; };
__device__ __forceinline__ XcdBarrier xcd_barrier_post(unsigned* bar, volatile LAS unsigned* st) {
    XcdBarrier b; b.bar = bar; b.x = xb_xcc_id(); b.st = st;
    if (threadIdx.x == 0) (void)xb_add(&bar[XB_XCNT(b.x)], 1u);
    return b;
}
__device__ __forceinline__ void xcd_barrier_complete(unsigned* bar, unsigned x, unsigned& nloc, unsigned& nx) {
    const unsigned G = gridDim.x * gridDim.y * gridDim.z;
    unsigned sum, cnt, mine, sp = 0u;
    for (;;) {
        sum = 0u; cnt = 0u; mine = 0u;
#pragma unroll
        for (unsigned j = 0; j < 16; ++j) { const unsigned c = xb_ld(&bar[XB_XCNT(j)]); sum += c; cnt += (c > 0u) ? 1u : 0u; mine = (j == x) ? c : mine; }
        if (sum == G) break;
        __builtin_amdgcn_s_sleep(1);
        if ((++sp & 255u) == 0u) { if (xb_ld(&bar[XB_TMO])) break; if (sp > XB_SPIN_CAP) { atomicAdd(&bar[XB_TMO], 1u); break; } }
    }
    nloc = mine > 0u ? mine : 1u; nx = cnt > 0u ? cnt : 1u;
}
__device__ __forceinline__ void xcd_barrier(const XcdBarrier& b) {
    asm volatile("s_waitcnt vmcnt(0)" ::: "memory");
    __syncthreads();
    if (threadIdx.x == 0) {
        unsigned* bar = b.bar;
        __builtin_amdgcn_s_waitcnt(0);
        unsigned nloc = b.st[0], nx = b.st[1];
        if (nloc == 0u) { xcd_barrier_complete(bar, b.x, nloc, nx); b.st[0] = nloc; b.st[1] = nx; }
        const unsigned old = xb_add(&bar[XB_XSUB(b.x)], 1u);
        const unsigned gen = old / nloc;
        if (old + 1u == (gen + 1u) * nloc) {
            __builtin_amdgcn_fence(__ATOMIC_RELEASE, "agent");
            asm volatile("s_waitcnt vmcnt(0)" ::: "memory");
            const unsigned og = xb_add(&bar[XB_TOP], 1u);
            const unsigned tg = og / nx;
            if (og + 1u == (tg + 1u) * nx) xb_add(&bar[XB_TOPGEN], 1u);
            else XB_SPIN(xb_ld(&bar[XB_TOPGEN]) == tg, bar);
            __builtin_amdgcn_fence(__ATOMIC_ACQUIRE, "agent");
            xb_add(&bar[XB_XGEN(b.x)], 1u);
            asm volatile("s_waitcnt vmcnt(0)" ::: "memory");
        } else {
            XB_SPIN(xb_ld(&bar[XB_XGEN(b.x)]) == gen, bar);
            __builtin_amdgcn_fence(__ATOMIC_ACQUIRE, "agent");
            asm volatile("s_waitcnt vmcnt(0)" ::: "memory");
        }
    }
    __syncthreads();
}

struct Args { const float* in[24]; float* out; unsigned char* ws; int ph_lo, ph_hi; };
enum { I_X = 0, I_RELB, I_N1G, I_WIN, I_AQG, I_AKG, I_BQG, I_BKG, I_SINK, I_CGW, I_CGB, I_CNG, I_WBA, I_WBB, I_WBC, I_WO, I_N2G, I_WRG, I_BRG, I_WRE, I_BRE, I_W1, I_W3, I_W2 };

struct Frame {
    LAS unsigned char* lds; LAS unsigned char* misc;
    unsigned* ctl;
    int tid, lane, wave, vcu, G, gw, NGW;
    const float* const* in; float* out; unsigned char* ws;
    bf16 *Z, *XN, *OCAT, *MERGED, *XS, *Y, *H;
    float *S, *GO; unsigned* MASK;
};

__device__ __forceinline__ float wave_sum(float v) {
#pragma unroll
    for (int o = 1; o < 64; o <<= 1) v += __shfl_xor(v, o);
    return v;
}
__device__ __forceinline__ float wave_max(float v) {
#pragma unroll
    for (int o = 1; o < 64; o <<= 1) v = fmaxf(v, __shfl_xor(v, o));
    return v;
}

template <class MAP>
__device__ __forceinline__ void transpose_item(const float* W, int N, bf16* WT, int dpitch, int koff, LAS float* scr, int item, int lane, const MAP& map) {
    const int nblk = N / 32, kb = item / nblk, nb = item % nblk, k0 = 64 * kb, n0 = 32 * nb;
    f32x4 v[8];
#pragma unroll
    for (int i = 0; i < 8; ++i) v[i] = *(const f32x4*)(W + (size_t)(k0 + 8 * i + (lane >> 3)) * N + n0 + 4 * (lane & 7));
#pragma unroll
    for (int i = 0; i < 8; ++i) { LAS float* d = scr + (8 * i + (lane >> 3)) * 33 + 4 * (lane & 7); d[0] = v[i].x; d[1] = v[i].y; d[2] = v[i].z; d[3] = v[i].w; }
    LDS_WAIT(); asm volatile("" ::: "memory");
    const int c = lane & 7;
#pragma unroll
    for (int j = 0; j < 4; ++j) { const int n = (lane >> 3) + 8 * j; const LAS float* s = scr + (8 * c) * 33 + n;
        v4u o; o.x = pk2(s[0 * 33], s[1 * 33]); o.y = pk2(s[2 * 33], s[3 * 33]); o.z = pk2(s[4 * 33], s[5 * 33]); o.w = pk2(s[6 * 33], s[7 * 33]);
        const int dr_ = map(n0 + n); if (dr_ >= 0) *(v4u*)(WT + (size_t)dr_ * dpitch + koff + k0 + 8 * c) = o; }
    LDS_WAIT(); asm volatile("" ::: "memory");
}
__device__ __forceinline__ float clamp8(float v) { return fminf(fmaxf(v, -440.0f), 440.0f); }
template <class MAP>
__device__ __forceinline__ void transpose_item_fp8(const float* W, int N, unsigned char* WT, int dpitch, float scale, LAS float* scr, int item, int lane, const MAP& map) {
    const int nblk = N / 32, kb = item / nblk, nb = item % nblk, k0 = 64 * kb, n0 = 32 * nb;
    f32x4 v[8];
#pragma unroll
    for (int i = 0; i < 8; ++i) v[i] = *(const f32x4*)(W + (size_t)(k0 + 8 * i + (lane >> 3)) * N + n0 + 4 * (lane & 7));
#pragma unroll
    for (int i = 0; i < 8; ++i) { LAS float* d = scr + (8 * i + (lane >> 3)) * 33 + 4 * (lane & 7); d[0] = v[i].x; d[1] = v[i].y; d[2] = v[i].z; d[3] = v[i].w; }
    LDS_WAIT(); asm volatile("" ::: "memory");
    const int c = lane & 7;
#pragma unroll
    for (int j = 0; j < 4; ++j) { const int n = (lane >> 3) + 8 * j; const LAS float* s = scr + (8 * c) * 33 + n;
        int w0 = 0, w1 = 0;
        w0 = __builtin_amdgcn_cvt_pk_fp8_f32(clamp8(s[0 * 33] * scale), clamp8(s[1 * 33] * scale), w0, false); w0 = __builtin_amdgcn_cvt_pk_fp8_f32(clamp8(s[2 * 33] * scale), clamp8(s[3 * 33] * scale), w0, true);
        w1 = __builtin_amdgcn_cvt_pk_fp8_f32(clamp8(s[4 * 33] * scale), clamp8(s[5 * 33] * scale), w1, false); w1 = __builtin_amdgcn_cvt_pk_fp8_f32(clamp8(s[6 * 33] * scale), clamp8(s[7 * 33] * scale), w1, true);
        const int dr_ = map(n0 + n); if (dr_ >= 0) *(v2u*)(WT + (size_t)dr_ * dpitch + k0 + 8 * c) = (v2u){(unsigned)w0, (unsigned)w1}; }
    LDS_WAIT(); asm volatile("" ::: "memory");
}
struct MapId { int off; __device__ __forceinline__ int operator()(int n) const { return off + n; } };
struct MapWin {
    __device__ __forceinline__ int operator()(int n) const {
        if (n < 512) return ZC_AQ + n;
        if (n < 640) return ZC_AK + (n - 512);
        if (n < 768) return ZC_AV + (n - 640);
        if (n < 1792) return ZC_IQ + (n - 768);
        if (n < 1856) return ZC_IK + (n - 1792);
        if (n < 1872) return ZC_IW + (n - 1856);
        if (n < 2896) return ZC_BQ + (n - 1872);
        if (n < 3152) return ZC_BK + (n - 2896);
        if (n < 3408) return ZC_BV + (n - 3152);
        if (n < 3664) return ZC_CQ + (n - 3408);
        if (n < 3920) return ZC_CK + (n - 3664);
        if (n < 4432) return ZC_CV + (n - 3920);
        if (n < 4448) return ZC_CG + (n - 4432);
        if (n < 4960) return ZC_CR + (n - 4448);
        return pg8::ZC_GA + (n - 4960);
    }
};
struct MapWin8 { __device__ __forceinline__ int operator()(int n) const { const int z = MapWin{}(n); return z < 3328 ? z : (z >= 5120 ? z - 1792 : -1); } };
struct MapWinB { __device__ __forceinline__ int operator()(int n) const { const int z = MapWin{}(n); return (z >= 3328 && z < 5120) ? z - 3328 : -1; } };
struct MapW13 { int sel; __device__ __forceinline__ int operator()(int n) const { return 32 * (n >> 4) + 16 * sel + (n & 15); } };

__device__ __forceinline__ void load_row(const float* row, int lane, f32x4 (&v)[8]) {
    const f32x4* xr = (const f32x4*)row + lane;
#pragma unroll
    for (int j = 0; j < 8; ++j) v[j] = xr[64 * j];
}
__device__ __forceinline__ float row_rstd(const f32x4 (&v)[8]) {
    float s = 0.f;
#pragma unroll
    for (int j = 0; j < 8; ++j) s += (v[j].x * v[j].x + v[j].y * v[j].y) + (v[j].z * v[j].z + v[j].w * v[j].w);
    return rsqrtf(wave_sum(s) * (1.0f / 2048.0f) + EPS);
}
__device__ __forceinline__ void norm_store_bf16(const f32x4 (&v)[8], float rstd, const float* g, bf16* orow, int lane) {
    const f32x4* gr = (const f32x4*)g + lane; unsigned long long* o8 = (unsigned long long*)orow + lane;
#pragma unroll
    for (int j = 0; j < 8; ++j) { const f32x4 gg = gr[64 * j];
        o8[64 * j] = (unsigned long long)pk2(v[j].x * rstd * gg.x, v[j].y * rstd * gg.y) | ((unsigned long long)pk2(v[j].z * rstd * gg.z, v[j].w * rstd * gg.w) << 32); }
}

__device__ __forceinline__ void norm_store_fp8(const f32x4 (&v)[8], float rstd, const float* g, unsigned char* orow, int lane) {
    const f32x4* gr = (const f32x4*)g + lane; unsigned* o4 = (unsigned*)orow + lane;
#pragma unroll
    for (int j = 0; j < 8; ++j) { const f32x4 gg = gr[64 * j]; int w = 0;
        w = __builtin_amdgcn_cvt_pk_fp8_f32(clamp8(v[j].x * rstd * gg.x), clamp8(v[j].y * rstd * gg.y), w, false); w = __builtin_amdgcn_cvt_pk_fp8_f32(clamp8(v[j].z * rstd * gg.z), clamp8(v[j].w * rstd * gg.w), w, true);
        o4[64 * j] = (unsigned)w; }
}
__device__ __forceinline__ void convert_moe(Frame& F, int l, int part, int nparts, int lds_off) {
    LAS float* scr = (LAS float*)(F.lds + lds_off + F.wave * 8704);
    bf16* W13 = (bf16*)(F.ws + WS_W13); bf16* W2 = (bf16*)(F.ws + WS_W2);
    constexpr int I13 = (2048 / 64) * (512 / 32);
    constexpr int I2 = (512 / 64) * (2048 / 32);
    constexpr int NIT = NEXP * (2 * I13 + I2);
    const int it_lo = (int)((long)NIT * part / nparts), it_hi = (int)((long)NIT * (part + 1) / nparts);
    for (int it = it_lo + F.gw; it < it_hi; it += F.NGW) {
        const int e = it / (2 * I13 + I2); int r = it % (2 * I13 + I2);
        if (r < I13) { transpose_item_fp8(F.in[I_W1] + ((size_t)l * NEXP + e) * 2048 * 512, 512, (unsigned char*)W13 + (size_t)e * 1024 * 2048, 2048, 64.0f, scr, r, F.lane, MapW13{0}); continue; } r -= I13;
        if (r < I13) { transpose_item_fp8(F.in[I_W3] + ((size_t)l * NEXP + e) * 2048 * 512, 512, (unsigned char*)W13 + (size_t)e * 1024 * 2048, 2048, 64.0f, scr, r, F.lane, MapW13{1}); continue; } r -= I13;
        transpose_item_fp8(F.in[I_W2] + ((size_t)l * NEXP + e) * 512 * 2048, 2048, (unsigned char*)W2 + (size_t)e * 2048 * 512, 512, 32.0f, scr, r, F.lane, MapId{0});
    }
}

typedef short bf16x8_t __attribute__((ext_vector_type(8)));
typedef float f32x16 __attribute__((ext_vector_type(16)));
typedef short s16x4 __attribute__((ext_vector_type(4)));
__device__ __forceinline__ void indexer_segment(Frame& F, int b, int qb, int tlo, int thi) {
    const int lane = F.lane, n = lane & 15, kq = lane >> 4;
    const bf16* qrow = F.Z + (size_t)(b * 2048 + 16 * qb + n) * ZP;
    bf16x8_t iqf[16][2];
#pragma unroll
    for (int h = 0; h < 16; ++h)
#pragma unroll
        for (int ks = 0; ks < 2; ++ks) iqf[h][ks] = *(const bf16x8_t*)(qrow + ZC_IQ + h * 64 + 32 * ks + 8 * kq);
    float wv[16];
    { const v4u w0 = *(const v4u*)(qrow + ZC_IW), w1 = *(const v4u*)(qrow + ZC_IW + 8);
      wv[0] = bflo(w0.x); wv[1] = bfhi(w0.x); wv[2] = bflo(w0.y); wv[3] = bfhi(w0.y); wv[4] = bflo(w0.z); wv[5] = bfhi(w0.z); wv[6] = bflo(w0.w); wv[7] = bfhi(w0.w);
      wv[8] = bflo(w1.x); wv[9] = bfhi(w1.x); wv[10] = bflo(w1.y); wv[11] = bfhi(w1.y); wv[12] = bflo(w1.z); wv[13] = bfhi(w1.z); wv[14] = bflo(w1.w); wv[15] = bfhi(w1.w); }
    const bf16* kbase = F.Z + (size_t)(b * 2048 + n) * ZP + ZC_IK + 8 * kq;
    float* srow = F.S + (size_t)(b * 2048 + 16 * qb + n) * 2048 + 4 * kq;
    bf16x8_t a0 = *(const bf16x8_t*)(kbase + (size_t)(16 * tlo) * ZP), a1 = *(const bf16x8_t*)(kbase + (size_t)(16 * tlo) * ZP + 32);
#pragma unroll 1
    for (int tile = tlo; tile < thi; ++tile) {
        const int tn = tile + 1 < thi ? tile + 1 : tile;
        const bf16x8_t n0 = *(const bf16x8_t*)(kbase + (size_t)(16 * tn) * ZP), n1 = *(const bf16x8_t*)(kbase + (size_t)(16 * tn) * ZP + 32);
        f32x4 sc = (f32x4){0.f, 0.f, 0.f, 0.f};
#pragma unroll
        for (int h = 0; h < 16; ++h) {
            f32x4 c = __builtin_amdgcn_mfma_f32_16x16x32_bf16(a0, iqf[h][0], (f32x4){0.f, 0.f, 0.f, 0.f}, 0, 0, 0);
            c = __builtin_amdgcn_mfma_f32_16x16x32_bf16(a1, iqf[h][1], c, 0, 0, 0);
            sc[0] += wv[h] * fmaxf(c[0], 0.f); sc[1] += wv[h] * fmaxf(c[1], 0.f); sc[2] += wv[h] * fmaxf(c[2], 0.f); sc[3] += wv[h] * fmaxf(c[3], 0.f);
        }
        *(f32x4*)(srow + 16 * tile) = sc * 0.03125f;
        a0 = n0; a1 = n1;
    }
}

constexpr int FA_KP = 272, FA_VP = 320;
constexpr int FA_KOFF = 0, FA_VOFF = 2 * 64 * FA_KP, FA_BYTES = FA_VOFF + 2 * 64 * FA_VP;
__device__ __forceinline__ s16x4 fa_vtr(const LAS unsigned char* p) { return __builtin_bit_cast(s16x4, __builtin_amdgcn_ds_read_tr16_b64_v4i16((LAS s16x4*)p)); }
template <int MODE>
__device__ __forceinline__ void flash_unit(Frame& F, int l, int b, int g, int t0) {
    const int tid = F.tid, lane = F.lane, wave = F.wave, hh = wave & 3, qh = wave >> 2, r = lane & 31, hf = lane >> 5;
    const int qcol = (MODE == 0 ? ZC_AQ : ZC_BQ + 512 * g) + 128 * hh, kcol = MODE == 0 ? ZC_AK : ZC_BK + 128 * g, vcol = MODE == 0 ? ZC_AV : ZC_BV + 128 * g;
    const int ocol = (MODE == 0 ? 0 : 512 + 512 * g) + 128 * hh, hd = (MODE == 0 ? 0 : 4 + 4 * g) + hh;
    const int tq = t0 + 32 * qh + r; const size_t qrow = (size_t)(b * 2048 + tq);
    const LAS float* tab2 = (const LAS float*)(F.misc + MO_TAB2) + hd * 129;
    LAS unsigned char* lds = F.lds;
    bf16x8_t qf[8];
#pragma unroll
    for (int ks = 0; ks < 8; ++ks) qf[ks] = *(const bf16x8_t*)(F.Z + qrow * ZP + qcol + 16 * ks + 8 * hf);
    f32x16 oacc[4];
#pragma unroll
    for (int dt = 0; dt < 4; ++dt)
#pragma unroll
        for (int i = 0; i < 16; ++i) oacc[dt][i] = 0.f;
    float m_run = -1e30f, l_run = 0.f;
    const int tile_lo = MODE == 0 ? 0 : (t0 >= 128 ? t0 / 64 - 2 : 0), tile_hi = t0 / 64 + 1;
    const int skey = tid >> 4, sdc = tid & 15;
    v4u kreg[2], vreg[2];
    { const bf16* zr = F.Z + (size_t)(b * 2048 + 64 * tile_lo + skey) * ZP;
#pragma unroll
      for (int i = 0; i < 2; ++i) { kreg[i] = *(const v4u*)(zr + (size_t)(32 * i) * ZP + kcol + 8 * sdc); vreg[i] = *(const v4u*)(zr + (size_t)(32 * i) * ZP + vcol + 8 * sdc); } }
    const float sc2 = 0.08838834764831845f * 1.4426950408889634f;
    unsigned mwn[2] = {0xffffffffu, 0xffffffffu};
    if (MODE == 0) { mwn[0] = F.MASK[qrow * 64 + 2 * tile_lo]; mwn[1] = F.MASK[qrow * 64 + 2 * tile_lo + 1]; }
#pragma unroll 1
    for (int kt = tile_lo; kt < tile_hi; ++kt) {
        const int bf = (kt - tile_lo) & 1, s0 = 64 * kt;
        LAS unsigned char* kb = lds + FA_KOFF + bf * (64 * FA_KP); LAS unsigned char* vb = lds + FA_VOFF + bf * (64 * FA_VP);
#pragma unroll
        for (int i = 0; i < 2; ++i) { *(LAS v4u*)(kb + (skey + 32 * i) * FA_KP + 16 * sdc) = kreg[i]; *(LAS v4u*)(vb + (skey + 32 * i) * FA_VP + 16 * sdc) = vreg[i]; }
        __syncthreads();
        if (kt + 1 < tile_hi) { const bf16* zr = F.Z + (size_t)(b * 2048 + 64 * (kt + 1) + skey) * ZP;
#pragma unroll
            for (int i = 0; i < 2; ++i) { kreg[i] = *(const v4u*)(zr + (size_t)(32 * i) * ZP + kcol + 8 * sdc); vreg[i] = *(const v4u*)(zr + (size_t)(32 * i) * ZP + vcol + 8 * sdc); } }
        unsigned mw[2] = {mwn[0], mwn[1]};
        if (MODE == 0 && kt + 1 < tile_hi) { mwn[0] = F.MASK[qrow * 64 + 2 * (kt + 1)]; mwn[1] = F.MASK[qrow * 64 + 2 * (kt + 1) + 1]; }
        f32x16 sacc[2];
#pragma unroll
        for (int k2 = 0; k2 < 2; ++k2) {
#pragma unroll
            for (int i = 0; i < 16; ++i) sacc[k2][i] = 0.f;
#pragma unroll
            for (int ks = 0; ks < 8; ++ks) { const bf16x8_t kf = *(const LAS bf16x8_t*)(kb + (32 * k2 + r) * FA_KP + (16 * ks + 8 * hf) * 2);
                sacc[k2] = __builtin_amdgcn_mfma_f32_32x32x16_bf16(kf, qf[ks], sacc[k2], 0, 0, 0); }
        }
        float mx = -1e30f;
        if (MODE == 0 && s0 + 63 + 128 <= t0) {
            const float bfar = tab2[128];
#pragma unroll
            for (int k2 = 0; k2 < 2; ++k2)
#pragma unroll
                for (int i = 0; i < 16; ++i) { const int cr = (i & 3) + 8 * (i >> 2) + 4 * hf;
                    const float v = ((mw[k2] >> cr) & 1u) ? sacc[k2][i] * sc2 + bfar : -__builtin_inff();
                    sacc[k2][i] = v; mx = fmaxf(mx, v); }
        } else
#pragma unroll
        for (int k2 = 0; k2 < 2; ++k2)
#pragma unroll
            for (int i = 0; i < 16; ++i) { const int cr = (i & 3) + 8 * (i >> 2) + 4 * hf; const int dist = tq - (s0 + 32 * k2 + cr);
                bool ok; if (MODE == 0) ok = (mw[k2] >> cr) & 1u; else ok = dist >= 0 && dist < 128;
                const int di = dist < 0 ? 0 : (dist > 128 ? 128 : dist);
                float vf = sacc[k2][i] * sc2 + tab2[di];
                asm volatile("" : "+v"(vf));
                const float v = ok ? vf : -__builtin_inff();
                sacc[k2][i] = v; mx = fmaxf(mx, v); }
        { const auto sw_ = __builtin_amdgcn_permlane32_swap(__float_as_uint(mx), __float_as_uint(mx), false, false); mx = fmaxf(__uint_as_float(sw_[0]), __uint_as_float(sw_[1])); }
        const float m_new = fmaxf(m_run, mx), alpha = __builtin_amdgcn_exp2f(m_run - m_new); m_run = m_new;
        float ps = 0.f;
#pragma unroll
        for (int k2 = 0; k2 < 2; ++k2)
#pragma unroll
            for (int i = 0; i < 16; ++i) { const float p = __builtin_amdgcn_exp2f(sacc[k2][i] - m_new); sacc[k2][i] = p; ps += p; }
        l_run = l_run * alpha + ps;
        if (__ballot(alpha != 1.0f)) {
#pragma unroll
        for (int dt = 0; dt < 4; ++dt)
#pragma unroll
            for (int i = 0; i < 16; ++i) oacc[dt][i] *= alpha;
        }
#pragma unroll
        for (int k2 = 0; k2 < 2; ++k2)
#pragma unroll
            for (int s2 = 0; s2 < 2; ++s2) {
                v4u pw; pw.x = pg8::cvt_pk_bf16(sacc[k2][8 * s2 + 0], sacc[k2][8 * s2 + 1]); pw.y = pg8::cvt_pk_bf16(sacc[k2][8 * s2 + 2], sacc[k2][8 * s2 + 3]);
                pw.z = pg8::cvt_pk_bf16(sacc[k2][8 * s2 + 4], sacc[k2][8 * s2 + 5]); pw.w = pg8::cvt_pk_bf16(sacc[k2][8 * s2 + 6], sacc[k2][8 * s2 + 7]);
                const bf16x8_t pb = __builtin_bit_cast(bf16x8_t, pw);
                const int i16 = lane & 15, grp = (lane >> 4) & 1;
                const LAS unsigned char* vp = vb + (32 * k2 + 16 * s2 + 4 * hf + (i16 >> 2)) * FA_VP + (16 * grp + 4 * (i16 & 3)) * 2;
#pragma unroll
                for (int dt = 0; dt < 4; ++dt) { const s16x4 lo = fa_vtr(vp + 64 * dt), hi = fa_vtr(vp + 8 * FA_VP + 64 * dt);
                    const bf16x8_t vf = __builtin_shufflevector(lo, hi, 0, 1, 2, 3, 4, 5, 6, 7);
                    oacc[dt] = __builtin_amdgcn_mfma_f32_32x32x16_bf16(vf, pb, oacc[dt], 0, 0, 0); }
            }
    }
    float l_tot = l_run + __shfl_xor(l_run, 32);
    if (MODE == 1) l_tot += __builtin_amdgcn_exp2f(F.in[I_SINK][l * 8 + hd - 4] * 1.4426950408889634f - m_run);
    const float inv = 1.0f / l_tot;
    bf16* orow = F.OCAT + qrow * 2048 + ocol + 4 * hf;
#pragma unroll
    for (int dt = 0; dt < 4; ++dt)
#pragma unroll
        for (int gq = 0; gq < 4; ++gq) { v2u w; w.x = pk2(oacc[dt][4 * gq] * inv, oacc[dt][4 * gq + 1] * inv); w.y = pk2(oacc[dt][4 * gq + 2] * inv, oacc[dt][4 * gq + 3] * inv);
            *(v2u*)(orow + 32 * dt + 8 * gq) = w; }
    __syncthreads();
}


#define GLA_GATE_PREFIX(LDS_TOT) \
        float la[8]; \
        _Pragma("unroll") for (int i = 0; i < 8; ++i) { const v4u c0 = rc0[i], c1 = rc1[i]; float x = gb; \
            x += bflo(c0.x) * gwv[0] + bfhi(c0.x) * gwv[1] + bflo(c0.y) * gwv[2] + bfhi(c0.y) * gwv[3] + bflo(c0.z) * gwv[4] + bfhi(c0.z) * gwv[5] + bflo(c0.w) * gwv[6] + bfhi(c0.w) * gwv[7]; \
            x += bflo(c1.x) * gwv[8] + bfhi(c1.x) * gwv[9] + bflo(c1.y) * gwv[10] + bfhi(c1.y) * gwv[11] + bflo(c1.z) * gwv[12] + bfhi(c1.z) * gwv[13] + bflo(c1.w) * gwv[14] + bfhi(c1.w) * gwv[15]; \
            la[i] = (fminf(x, 0.f) - log1pf(__expf(-fabsf(x)))) * 0.0625f; } \
        _Pragma("unroll") for (int i = 1; i < 8; ++i) la[i] += la[i - 1]; \
        ((LAS float*)(L + LDS_TOT))[cg * 64 + dk] = la[7];
#define GLA_OFFSETS(LDS_TOT) \
        float off = 0.f, tot = 0.f; \
        _Pragma("unroll") for (int g2 = 0; g2 < 8; ++g2) { const float tv = ((const LAS float*)(L + LDS_TOT))[g2 * 64 + dk]; tot += tv; off += g2 < cg ? tv : 0.f; }

__device__ __forceinline__ void gla_state_phase(Frame& F, int l) {
    const int tid = F.tid, lane = F.lane, wave = F.wave, r = lane & 31, hf = lane >> 5, i16 = lane & 15, grp = (lane >> 4) & 1;
    LAS unsigned char* L = F.lds;
    constexpr int KDT = 0, VT = 9216, TOT = 29696, RP = 144, VP = 320;
    const int dk = lane, cg = wave;
    float* GCS = (float*)(F.ws + WS_GCS); float* GDEC = (float*)(F.ws + WS_GDEC);
    v4u rc0[8], rc1[8], rv[2]; unsigned short rk[8];
#define GLS_LOAD(u_) do { const int bh_ = (u_) >> 5, n_ = (u_) & 31; const size_t r0_ = (size_t)((bh_ >> 2) * 2048 + 64 * n_); const int h_ = bh_ & 3; \
        _Pragma("unroll") for (int i = 0; i < 8; ++i) { const bf16* zr = F.Z + (r0_ + 8 * cg + i) * ZP; rc0[i] = *(const v4u*)(zr + ZC_CG); rc1[i] = *(const v4u*)(zr + ZC_CG + 8); rk[i] = zr[ZC_CK + h_ * 64 + dk]; } \
        _Pragma("unroll") for (int i = 0; i < 2; ++i) rv[i] = *(const v4u*)(F.Z + (r0_ + (tid >> 4) + 32 * i) * ZP + ZC_CV + h_ * 128 + 8 * (tid & 15)); } while (0)
    int u = F.vcu;
    if (u < 2048) GLS_LOAD(u);
    for (; u < 2048; u += F.G) {
        const int h = (u >> 5) & 3;
        float gwv[16];
#pragma unroll
        for (int q = 0; q < 16; ++q) gwv[q] = F.in[I_CGW][(size_t)l * 4096 + q * 256 + h * 64 + dk];
        const float gb = F.in[I_CGB][l * 256 + h * 64 + dk];
        GLA_GATE_PREFIX(TOT)
        float kv[8];
#pragma unroll
        for (int i = 0; i < 8; ++i) kv[i] = bf1(rk[i]);
#pragma unroll
        for (int i = 0; i < 2; ++i) *(LAS v4u*)(L + VT + ((tid >> 4) + 32 * i) * VP + 16 * (tid & 15)) = rv[i];
        __syncthreads();
        GLA_OFFSETS(TOT)
        { float kd[8];
#pragma unroll
          for (int i = 0; i < 8; ++i) kd[i] = kv[i] * __expf(tot - (off + la[i]));
          v4u w; w.x = pk2(kd[0], kd[1]); w.y = pk2(kd[2], kd[3]); w.z = pk2(kd[4], kd[5]); w.w = pk2(kd[6], kd[7]); *(LAS v4u*)(L + KDT + dk * RP + 16 * cg) = w; }
        if (cg == 0) GDEC[(size_t)u * 64 + dk] = __expf(tot);
        __syncthreads();
        if (u + F.G < 2048) GLS_LOAD(u + F.G);
        { const int dkt = wave >> 2, dvt = wave & 3;
          f32x16 cs;
#pragma unroll
          for (int i = 0; i < 16; ++i) cs[i] = 0.f;
#pragma unroll
          for (int ks = 0; ks < 4; ++ks) { const bf16x8_t a = *(const LAS bf16x8_t*)(L + KDT + (32 * dkt + r) * RP + (16 * ks + 8 * hf) * 2);
              const LAS unsigned char* vp = L + VT + (16 * ks + 8 * hf + (i16 >> 2)) * VP + (32 * dvt + 16 * grp + 4 * (i16 & 3)) * 2;
              const s16x4 lo = fa_vtr(vp), hi = fa_vtr(vp + 4 * VP);
              cs = __builtin_amdgcn_mfma_f32_32x32x16_bf16(a, __builtin_shufflevector(lo, hi, 0, 1, 2, 3, 4, 5, 6, 7), cs, 0, 0, 0); }
          float* gp = GCS + (size_t)u * 8192 + (size_t)(32 * dkt + 4 * hf) * 128 + 32 * dvt + r;
#pragma unroll
          for (int i = 0; i < 16; ++i) gp[((i & 3) + 8 * (i >> 2)) * 128] = cs[i]; }
        __syncthreads();
    }
#undef GLS_LOAD
}

__device__ __forceinline__ void gla_scan_phase(Frame& F) {
    float* GCS = (float*)(F.ws + WS_GCS); const float* GDEC = (const float*)(F.ws + WS_GDEC);
    for (int gt = F.gw * 64 + F.lane; gt < 64 * 2048; gt += F.NGW * 64) {
        const int bh = gt >> 11, e4 = gt & 2047, dk = e4 >> 5;
        f32x4* p = (f32x4*)(GCS + (size_t)bh * 32 * 8192) + e4; const float* dp = GDEC + (size_t)bh * 32 * 64 + dk;
        f32x4 st = (f32x4){0.f, 0.f, 0.f, 0.f};
#pragma unroll 1
        for (int n0 = 0; n0 < 32; n0 += 8) {
            f32x4 cs[8]; float dc[8];
#pragma unroll
            for (int j = 0; j < 8; ++j) { cs[j] = p[(size_t)(n0 + j) * 2048]; dc[j] = dp[(n0 + j) * 64]; }
#pragma unroll
            for (int j = 0; j < 8; ++j) { p[(size_t)(n0 + j) * 2048] = st; st = st * dc[j] + cs[j]; }
        }
    }
}

__device__ __forceinline__ void gla_out_phase(Frame& F, int l) {
    const int tid = F.tid, lane = F.lane, wave = F.wave, r = lane & 31, hf = lane >> 5, i16 = lane & 15, grp = (lane >> 4) & 1;
    LAS unsigned char* L = F.lds;
    constexpr int QG = 0, KG = 9216, VT = 18432, PT = 38912, TOT = 59392, OT = 61440, RP = 144, VP = 320, OP = 132;
    const int dk = lane, cg = wave;
    const float* GCS = (const float*)(F.ws + WS_GCS);
    v4u rc0[8], rc1[8], rv[2]; unsigned short rq[8], rk[8]; unsigned rg[8]; f32x4 rp[4];
#define GLO_LOAD(u_) do { const int bh_ = (u_) >> 5, n_ = (u_) & 31; const size_t r0_ = (size_t)((bh_ >> 2) * 2048 + 64 * n_); const int h_ = bh_ & 3; \
        _Pragma("unroll") for (int i = 0; i < 8; ++i) { const bf16* zr = F.Z + (r0_ + 8 * cg + i) * ZP; rc0[i] = *(const v4u*)(zr + ZC_CG); rc1[i] = *(const v4u*)(zr + ZC_CG + 8); rq[i] = zr[ZC_CQ + h_ * 64 + dk]; rk[i] = zr[ZC_CK + h_ * 64 + dk]; \
            rg[i] = *(const unsigned*)(zr + ZC_CR + h_ * 128 + 2 * lane); } \
        _Pragma("unroll") for (int i = 0; i < 2; ++i) rv[i] = *(const v4u*)(F.Z + (r0_ + (tid >> 4) + 32 * i) * ZP + ZC_CV + h_ * 128 + 8 * (tid & 15)); \
        _Pragma("unroll") for (int i = 0; i < 4; ++i) rp[i] = *(const f32x4*)(GCS + (size_t)(u_) * 8192 + (size_t)(tid >> 3) * 128 + 16 * (tid & 7) + 4 * i); } while (0)
    int u = F.vcu;
    if (u < 2048) GLO_LOAD(u);
    const float g0 = F.in[I_CNG][l * 128 + 2 * lane], g1 = F.in[I_CNG][l * 128 + 2 * lane + 1];
    for (; u < 2048; u += F.G) {
        const int bh = u >> 5, n = u & 31, h = bh & 3; const size_t row0 = (size_t)((bh >> 2) * 2048 + 64 * n);
        float gwv[16];
#pragma unroll
        for (int q = 0; q < 16; ++q) gwv[q] = F.in[I_CGW][(size_t)l * 4096 + q * 256 + h * 64 + dk];
        const float gb = F.in[I_CGB][l * 256 + h * 64 + dk];
        GLA_GATE_PREFIX(TOT)
        float qv[8], kv[8]; unsigned gr[8];
#pragma unroll
        for (int i = 0; i < 8; ++i) { qv[i] = bf1(rq[i]); kv[i] = bf1(rk[i]); gr[i] = rg[i]; }
#pragma unroll
        for (int i = 0; i < 2; ++i) *(LAS v4u*)(L + VT + ((tid >> 4) + 32 * i) * VP + 16 * (tid & 15)) = rv[i];
        { v4u w0, w1; w0.x = pk2(rp[0].x, rp[0].y); w0.y = pk2(rp[0].z, rp[0].w); w0.z = pk2(rp[1].x, rp[1].y); w0.w = pk2(rp[1].z, rp[1].w);
          w1.x = pk2(rp[2].x, rp[2].y); w1.y = pk2(rp[2].z, rp[2].w); w1.z = pk2(rp[3].x, rp[3].y); w1.w = pk2(rp[3].z, rp[3].w);
          *(LAS v4u*)(L + PT + (tid >> 3) * VP + 32 * (tid & 7)) = w0; *(LAS v4u*)(L + PT + (tid >> 3) * VP + 32 * (tid & 7) + 16) = w1; }
        __syncthreads();
        GLA_OFFSETS(TOT)
#pragma unroll
        for (int i = 0; i < 8; ++i) { const float bi = off + la[i];
            *(LAS bf16*)(L + QG + (8 * cg + i) * RP + 2 * dk) = (bf16)f2bf(qv[i] * 0.125f * __expf(bi));
            *(LAS bf16*)(L + KG + (8 * cg + i) * RP + 2 * dk) = (bf16)f2bf(kv[i] * __expf(-bi)); }
        __syncthreads();
        if (u + F.G < 2048) GLO_LOAD(u + F.G);
        { const int ct = wave >> 2, dvt = wave & 3;
          f32x16 o;
#pragma unroll
          for (int i = 0; i < 16; ++i) o[i] = 0.f;
#pragma unroll
          for (int st = 0; st < 2; ++st) if (st <= ct) {
              f32x16 at;
#pragma unroll
              for (int i = 0; i < 16; ++i) at[i] = 0.f;
#pragma unroll
              for (int ks = 0; ks < 4; ++ks) { const bf16x8_t a = *(const LAS bf16x8_t*)(L + KG + (32 * st + r) * RP + (16 * ks + 8 * hf) * 2), bq = *(const LAS bf16x8_t*)(L + QG + (32 * ct + r) * RP + (16 * ks + 8 * hf) * 2);
                  at = __builtin_amdgcn_mfma_f32_32x32x16_bf16(a, bq, at, 0, 0, 0); }
              if (st == ct) {
#pragma unroll
                  for (int i = 0; i < 16; ++i) { const int cr = (i & 3) + 8 * (i >> 2) + 4 * hf; at[i] = cr <= r ? at[i] : 0.f; } }
#pragma unroll
              for (int s2 = 0; s2 < 2; ++s2) {
                  v4u pw; pw.x = pg8::cvt_pk_bf16(at[8 * s2 + 0], at[8 * s2 + 1]); pw.y = pg8::cvt_pk_bf16(at[8 * s2 + 2], at[8 * s2 + 3]); pw.z = pg8::cvt_pk_bf16(at[8 * s2 + 4], at[8 * s2 + 5]); pw.w = pg8::cvt_pk_bf16(at[8 * s2 + 6], at[8 * s2 + 7]);
                  const LAS unsigned char* vp = L + VT + (32 * st + 16 * s2 + 4 * hf + (i16 >> 2)) * VP + (32 * dvt + 16 * grp + 4 * (i16 & 3)) * 2;
                  const s16x4 lo = fa_vtr(vp), hi = fa_vtr(vp + 8 * VP);
                  o = __builtin_amdgcn_mfma_f32_32x32x16_bf16(__builtin_bit_cast(bf16x8_t, pw), __builtin_shufflevector(lo, hi, 0, 1, 2, 3, 4, 5, 6, 7), o, 0, 0, 0);
              }
          }
#pragma unroll
          for (int ks = 0; ks < 4; ++ks) { const bf16x8_t a = *(const LAS bf16x8_t*)(L + QG + (32 * ct + r) * RP + (16 * ks + 8 * hf) * 2);
              const LAS unsigned char* pp = L + PT + (16 * ks + 8 * hf + (i16 >> 2)) * VP + (32 * dvt + 16 * grp + 4 * (i16 & 3)) * 2;
              const s16x4 lo = fa_vtr(pp), hi = fa_vtr(pp + 4 * VP);
              o = __builtin_amdgcn_mfma_f32_32x32x16_bf16(a, __builtin_shufflevector(lo, hi, 0, 1, 2, 3, 4, 5, 6, 7), o, 0, 0, 0); }
          LAS float* op = (LAS float*)(L + OT) + (32 * ct + 4 * hf) * OP + 32 * dvt + r;
#pragma unroll
          for (int i = 0; i < 16; ++i) op[((i & 3) + 8 * (i >> 2)) * OP] = o[i]; }
        __syncthreads();
        { float a[8], c[8], ss[8];
#pragma unroll
          for (int i = 0; i < 8; ++i) { const LAS float* orow = (const LAS float*)(L + OT) + (8 * wave + i) * OP + 2 * lane; a[i] = orow[0]; c[i] = orow[1]; ss[i] = a[i] * a[i] + c[i] * c[i]; }
#pragma unroll
          for (int o2 = 1; o2 < 64; o2 <<= 1) {
#pragma unroll
              for (int i = 0; i < 8; ++i) ss[i] += __shfl_xor(ss[i], o2); }
#pragma unroll
          for (int i = 0; i < 8; ++i) { const float rstd = rsqrtf(ss[i] * (1.0f / 128.0f) + EPS);
              *(unsigned*)(F.OCAT + (row0 + 8 * wave + i) * 2048 + 1536 + h * 128 + 2 * lane) = pk2(a[i] * rstd * g0 * bflo(gr[i]), c[i] * rstd * g1 * bfhi(gr[i])); } }
        __syncthreads();
    }
#undef GLO_LOAD
}
#undef GLA_GATE_PREFIX
#undef GLA_OFFSETS

__device__ __forceinline__ bool in_phase(int k, int lo, int hi) { asm volatile("" : "+s"(k)); return lo <= k && k < hi; }
#define IN(k) in_phase((k), lo, hi)
#define PHASE_LANE() do { int _tz = threadIdx.x; asm volatile("" : "+v"(_tz)); F.tid = _tz; F.lane = _tz & 63; } while (0)
#define SEAM(k) do { if (IN(k) && IN((k) + 1)) xcd_barrier(bar); } while (0)
template <int l>
__device__ __forceinline__ void layer_body(Frame& F, const XcdBarrier& bar, const int lo, const int hi) {
    constexpr int pb = 1 + 11 * l;
        if (IN(pb + 0)) {
            { pg8::Gemm g{F.XN, (const bf16*)(F.ws + WS_WIN + l * WIN_L + 24 * MiB), T, 1792, D}; pg8::StaticOrder S; S.init(T, 1792, D, F.G, (int)blockIdx.x);
              pg8::EpiInProj<1> E{F.Z, (LAS unsigned long long*)(F.misc + MO_SS), (const LAS float*)(F.misc + MO_GN) + l * 512};
              pg8::gemm_phase<pg8::EpiInProj<1>, pg8::StaticOrder, true, false>(F.lds, g, S, E); }
            { pg8::Gemm g{(const bf16*)(F.ws + WS_XN8), (const bf16*)(F.ws + WS_WIN + l * WIN_L), T, 9472, D / 2}; pg8::StaticOrder S; S.init(T, 9472, D / 2, F.G, ((int)blockIdx.x + F.G / 2) % F.G);
              pg8::EpiInProj<0> E{F.Z, (LAS unsigned long long*)(F.misc + MO_SS), (const LAS float*)(F.misc + MO_GN) + l * 512};
              pg8::gemm_phase<pg8::EpiInProj<0>, pg8::StaticOrder, true, true>(F.lds, g, S, E); }
        }
        SEAM(pb + 0);
        if (IN(pb + 1)) { PHASE_LANE();
            if (F.wave & 4) convert_moe(F, l, 0, 4, 40960);
            for (int it = F.gw; it < NB * 128; it += F.NGW) {
                const int b = it >> 7, j = it & 127;
                indexer_segment(F, b, j, 0, j < 64 ? j + 1 : 64);
                if (j < 64) indexer_segment(F, b, 127 - j, 64, 128 - j);
            }
            if (!(F.wave & 4)) convert_moe(F, l, 0, 4, 40960);
            PHASE_LANE();
            gla_state_phase(F, l);
        }
        SEAM(pb + 1);
        if (IN(pb + 2)) { PHASE_LANE();
            if (F.wave & 4) convert_moe(F, l, 1, 4, 0);
            for (int row = F.gw; row < T; row += F.NGW) {
                const int t = row & 2047;
                if (t < 256) { const int nb = t + 1 - 32 * F.lane; F.MASK[(size_t)row * 64 + F.lane] = nb >= 32 ? 0xffffffffu : (nb <= 0 ? 0u : ((1u << nb) - 1u)); continue; }
                float val[32];
#pragma unroll
                for (int j = 0; j < 32; ++j) { const int s_ = 64 * j + F.lane; val[j] = F.S[(size_t)row * 2048 + (s_ < t ? s_ : t)]; }
                float vmx = -3.0e38f, vmn = 3.0e38f;
#pragma unroll
                for (int j = 0; j < 32; ++j) { const bool ok = 64 * j + F.lane <= t; val[j] = ok ? val[j] : -3.0e38f; vmx = fmaxf(vmx, val[j]); vmn = fminf(vmn, ok ? val[j] : 3.0e38f); }
#pragma unroll
                for (int o = 1; o < 64; o <<= 1) { vmx = fmaxf(vmx, __shfl_xor(vmx, o)); vmn = fminf(vmn, __shfl_xor(vmn, o)); }
                float lo = vmn, hi = vmx, thf = 0.f; bool exact = false;
#pragma unroll 1
                for (int it = 0; it < 28; ++it) { const float mid = 0.5f * (lo + hi); if (!(mid > lo && mid < hi)) break; int cnt = 0;
#pragma unroll
                    for (int j = 0; j < 32; ++j) cnt += __popcll(__ballot(val[j] >= mid));
                    if (cnt == 256) { exact = true; thf = mid; break; }
                    if (cnt > 256) lo = mid; else hi = mid; }
                unsigned th = 0u; int need = 0;
#define KEYOF(x) ({ const unsigned u_ = __float_as_uint(x); (u_ & 0x80000000u) ? ~u_ : (u_ | 0x80000000u); })
                if (!exact) {
#pragma unroll 1
                    for (int bit = 31; bit >= 0; --bit) { const unsigned cand = th | (1u << bit); int cnt = 0;
#pragma unroll
                        for (int j = 0; j < 32; ++j) cnt += __popcll(__ballot(KEYOF(val[j]) >= cand));
                        if (cnt >= 256) th = cand; }
                    int cgt = 0;
#pragma unroll
                    for (int j = 0; j < 32; ++j) cgt += __popcll(__ballot(KEYOF(val[j]) > th));
                    need = 256 - cgt;
                }
                int run = 0; unsigned myword = 0u;
#pragma unroll
                for (int j = 0; j < 32; ++j) {
                    bool sel;
                    if (exact) sel = val[j] >= thf;
                    else { const unsigned kj = KEYOF(val[j]); const bool eq = kj == th; const unsigned long long eqm = __ballot(eq);
                        const int pre = run + __popcll(eqm & ((1ull << F.lane) - 1ull)); sel = (kj > th) || (eq && pre < need); run += __popcll(eqm); sel = sel && (64 * j + F.lane <= t); }
                    const unsigned long long sm = __ballot(sel);
                    if ((F.lane >> 1) == j) myword = (F.lane & 1) ? (unsigned)(sm >> 32) : (unsigned)sm;
                }
#undef KEYOF
                F.MASK[(size_t)row * 64 + F.lane] = myword;
            }
            if (!(F.wave & 4)) convert_moe(F, l, 1, 4, 0);
            gla_scan_phase(F);
        }
        SEAM(pb + 2);
        if (IN(pb + 3)) { PHASE_LANE();
            if (F.vcu & 1) { convert_moe(F, l, 1, 2, 0); __syncthreads(); PHASE_LANE(); }
            for (int u = F.vcu; u < NB * 16; u += F.G) { const int b = u >> 4, p = u & 15; flash_unit<0>(F, l, b, 0, 64 * (31 - p)); flash_unit<0>(F, l, b, 0, 64 * p); }
            for (int u = F.vcu; u < NB * 2 * 32; u += F.G) { const int b = u >> 6, g = (u >> 5) & 1, qb = u & 31; flash_unit<1>(F, l, b, g, 64 * qb); }
            gla_out_phase(F, l);
            if (!(F.vcu & 1)) { PHASE_LANE(); convert_moe(F, l, 1, 2, 0); }
        }
        SEAM(pb + 3);
        if (IN(pb + 4)) {
            pg8::Gemm g{F.OCAT, (const bf16*)(F.ws + WS_WBR + l * WBR_L), T, D, D}; pg8::MergeOrder S; S.init(T, D, D, F.G, (int)blockIdx.x);
            pg8::EpiMerge E{F.Z, F.MERGED};
            pg8::gemm_phase<pg8::EpiMerge, pg8::MergeOrder, true>(F.lds, g, S, E);
        }
        SEAM(pb + 4);
        if (IN(pb + 5)) {
            pg8::Gemm g{F.MERGED, (const bf16*)(F.ws + WS_WO + l * WO_L), T, D, D}; pg8::StaticOrder S; S.init(T, D, D, F.G, (int)blockIdx.x);
            pg8::EpiResid<(l > 0)> E{F.in[I_X], (bf16*)(F.ws + WS_HB), (unsigned char*)F.XN, F.in[I_N2G] + l * D};
            pg8::gemm_phase<pg8::EpiResid<(l > 0)>, pg8::StaticOrder, true>(F.lds, g, S, E);
        }
        SEAM(pb + 5);
        if (IN(pb + 6)) { PHASE_LANE();
            unsigned* cnt = F.ctl + CW_CNT + 64 * l;
            const int lane = F.lane, fr = lane & 15, fq = lane >> 4;
            LAS float* LG = (LAS float*)(F.lds + F.wave * 8192);
            const bf16* wrh = (const bf16*)(F.ws + WS_WRH + l * WR_L) + (size_t)fr * 2048 + 8 * fq; const bf16* wrl = (const bf16*)(F.ws + WS_WRL + l * WR_L) + (size_t)fr * 2048 + 8 * fq;
            for (int tile = F.gw; tile < T / 16; tile += F.NGW) {
                const bf16* hrow = (const bf16*)(F.ws + WS_HB) + (size_t)(16 * tile + fr) * D + 8 * fq;
                f32x4 acc[6];
#pragma unroll
                for (int nt = 0; nt < 6; ++nt) acc[nt] = (f32x4){0.f, 0.f, 0.f, 0.f};
                float ss = 0.f;
#pragma unroll 2
                for (int ks = 0; ks < 64; ++ks) {
                    const v4u hw = *(const v4u*)(hrow + 32 * ks);
                    { const float a0 = bflo(hw.x), a1 = bfhi(hw.x), a2 = bflo(hw.y), a3 = bfhi(hw.y), a4 = bflo(hw.z), a5 = bfhi(hw.z), a6 = bflo(hw.w), a7 = bfhi(hw.w);
                      ss += (a0 * a0 + a1 * a1) + (a2 * a2 + a3 * a3) + (a4 * a4 + a5 * a5) + (a6 * a6 + a7 * a7); }
                    const bf16x8_t ah = __builtin_bit_cast(bf16x8_t, hw);
#pragma unroll
                    for (int nt = 0; nt < 6; ++nt) { const bf16x8_t bh = *(const bf16x8_t*)(wrh + (size_t)(16 * nt) * 2048 + 32 * ks), bl = *(const bf16x8_t*)(wrl + (size_t)(16 * nt) * 2048 + 32 * ks);
                        acc[nt] = __builtin_amdgcn_mfma_f32_16x16x32_bf16(ah, bh, acc[nt], 0, 0, 0);
                        acc[nt] = __builtin_amdgcn_mfma_f32_16x16x32_bf16(ah, bl, acc[nt], 0, 0, 0); }
                }
                ss += __shfl_xor(ss, 16); ss += __shfl_xor(ss, 32);
                if (fq == 0) { const float rs_ = rsqrtf(ss * (1.0f / 2048.0f) + EPS); LG[1600 + fr] = rs_; ((float*)(F.ws + WS_RSTD))[16 * tile + fr] = rs_; }
#pragma unroll
                for (int nt = 0; nt < 6; ++nt)
#pragma unroll
                    for (int i = 0; i < 4; ++i) LG[(4 * fq + i) * 100 + 16 * nt + fr] = acc[nt][i];
                LDS_WAIT(); asm volatile("" ::: "memory");
                if (lane < 16) {
                    const int row = 16 * tile + lane; const float rstd = LG[1600 + lane]; const LAS float* lr = LG + lane * 100;
                    float lg[8]; int grp = 0; float gmax = -3.0e38f;
#pragma unroll
                    for (int e = 0; e < 8; ++e) { lg[e] = lr[e] * rstd + F.in[I_BRG][l * 8 + e]; if (lg[e] > gmax) { gmax = lg[e]; grp = e; } }
                    float gden = 0.f;
#pragma unroll
                    for (int e = 0; e < 8; ++e) gden += __expf(lg[e] - gmax);
                    const float gwt = 1.0f / gden;
                    int i0 = 0, i1 = 0; float m0 = -3.0e38f, m1 = -3.0e38f;
#pragma unroll
                    for (int e = 0; e < 8; ++e) { const float v = lr[8 + grp * 8 + e] * rstd + F.in[I_BRE][l * 64 + grp * 8 + e];
                        if (v > m0) { m1 = m0; i1 = i0; m0 = v; i0 = e; } else if (v > m1) { m1 = v; i1 = e; } }
                    const float e1 = __expf(m1 - m0); const float p0 = 1.0f / (1.0f + e1), p1 = e1 / (1.0f + e1);
                    const int ex0 = grp * 8 + i0, ex1 = grp * 8 + i1;
                    const unsigned r0 = atomicAdd(&cnt[ex0], 1u), r1 = atomicAdd(&cnt[ex1], 1u);
                    unsigned* rec = (unsigned*)(F.ws + WS_ROUTE) + (size_t)row * 8;
                    rec[0] = (unsigned)ex0; rec[1] = r0; rec[2] = (unsigned)ex1; rec[3] = r1; rec[4] = __float_as_uint(gwt * p0); rec[5] = __float_as_uint(gwt * p1);
                    int* liste = (int*)(F.ws + WS_LISTE); liste[(size_t)ex0 * 32768 + r0] = row; liste[(size_t)ex1 * 32768 + r1] = row;
                }
                LDS_WAIT(); asm volatile("" ::: "memory");
            }
        }
        SEAM(pb + 6);
        if (IN(pb + 7) || IN(pb + 8) || IN(pb + 9) || IN(pb + 10)) { PHASE_LANE();
            if (F.tid == 0) { const unsigned* cnt = F.ctl + CW_CNT + 64 * l; LAS int* texp = (LAS int*)(F.misc + MO_TEXP); LAS int* pst = (LAS int*)(F.misc + MO_PST); int tb = 0;
                for (int e = 0; e < NEXP; ++e) { const int c = (int)__hip_atomic_load(&cnt[e], __ATOMIC_RELAXED, __HIP_MEMORY_SCOPE_AGENT); const int nt_ = (c + 255) >> 8; pst[e] = tb * 256; ((LAS int*)(F.misc + MO_CNT))[e] = c;
                    for (int r = 0; r < nt_; ++r) texp[tb + r] = e; tb += nt_; }
                *(LAS int*)(F.misc + MO_TOT) = tb; }
            __syncthreads();
        }
        if (IN(pb + 8)) {
            pg8::Gemm g{F.XN, (const bf16*)(F.ws + WS_W13), 0, 0, D / 2};
            pg8::MoeGatherOrder S; S.total = *(const LAS int*)(F.misc + MO_TOT) * 4; S.G = F.G; S.c = F.vcu; S.NJ = 4; S.nt0 = D / 128; S.tile_exp = (const LAS int*)(F.misc + MO_TEXP);
            S.pst = (const LAS int*)(F.misc + MO_PST); S.cnt = (const LAS int*)(F.misc + MO_CNT); S.liste = (const int*)(F.ws + WS_LISTE);
            pg8::EpiGlu E{F.H, S.tile_exp, S.pst, S.cnt, S.liste, (const float*)(F.ws + WS_RSTD)};
            pg8::gemm_phase<pg8::EpiGlu, pg8::MoeGatherOrder, true, true>(F.lds, g, S, E);
        }
        SEAM(pb + 8);
        if (IN(pb + 9)) {
            pg8::Gemm g{F.H, (const bf16*)(F.ws + WS_W2), 0, 0, DEXP / 2};
            pg8::MoeOrder S{*(const LAS int*)(F.misc + MO_TOT) * 8, F.G, F.vcu, 8, DEXP / 128, (const LAS int*)(F.misc + MO_TEXP)};
            pg8::EpiY E{(unsigned char*)F.Y};
            pg8::gemm_phase<pg8::EpiY, pg8::MoeOrder, true, true>(F.lds, g, S, E);
        }
        SEAM(pb + 9);
        if (IN(pb + 10)) { PHASE_LANE();
            for (int row = F.gw; row < T; row += F.NGW) {
                const unsigned* rec = (const unsigned*)(F.ws + WS_ROUTE) + (size_t)row * 8;
                const float w0 = __uint_as_float(rec[4]) * 0.03125f, w1 = __uint_as_float(rec[5]) * 0.03125f;
                const LAS int* pst = (const LAS int*)(F.misc + MO_PST); const int p0 = pst[rec[0]] + (int)rec[1], p1 = pst[rec[2]] + (int)rec[3];
                const unsigned* y0 = (const unsigned*)((const unsigned char*)F.Y + (size_t)p0 * D) + F.lane; const unsigned* y1 = (const unsigned*)((const unsigned char*)F.Y + (size_t)p1 * D) + F.lane;
                f32x4 v[8];
                { const v2u* hr = (const v2u*)((const bf16*)(F.ws + WS_HB) + (size_t)row * D) + F.lane;
#pragma unroll
                  for (int j = 0; j < 8; ++j) { const v2u w = hr[64 * j]; v[j] = (f32x4){bflo(w.x), bfhi(w.x), bflo(w.y), bfhi(w.y)}; } }
#pragma unroll
                for (int j = 0; j < 8; ++j) { const int a = (int)y0[64 * j], c = (int)y1[64 * j];
                    const auto a01 = __builtin_amdgcn_cvt_pk_f32_fp8(a, false), a23 = __builtin_amdgcn_cvt_pk_f32_fp8(a, true), c01 = __builtin_amdgcn_cvt_pk_f32_fp8(c, false), c23 = __builtin_amdgcn_cvt_pk_f32_fp8(c, true);
                    v[j].x += w0 * a01[0] + w1 * c01[0]; v[j].y += w0 * a01[1] + w1 * c01[1]; v[j].z += w0 * a23[0] + w1 * c23[0]; v[j].w += w0 * a23[1] + w1 * c23[1]; }
                if (l + 1 < DEPTH) { v2u* hw_ = (v2u*)((bf16*)(F.ws + WS_HB) + (size_t)row * D) + F.lane;
#pragma unroll
                    for (int j = 0; j < 8; ++j) hw_[64 * j] = (v2u){pg8::cvt_pk_bf16(v[j].x, v[j].y), pg8::cvt_pk_bf16(v[j].z, v[j].w)}; }
                else { f32x4* orow = (f32x4*)(F.out + (size_t)row * D) + F.lane;
#pragma unroll
                    for (int j = 0; j < 8; ++j) orow[64 * j] = v[j]; }
                if (l + 1 < DEPTH) { const float rstd = row_rstd(v); norm_store_bf16(v, rstd, F.in[I_N1G] + (l + 1) * D, F.XN + (size_t)row * D, F.lane); norm_store_fp8(v, rstd, F.in[I_N1G] + (l + 1) * D, (unsigned char*)(F.ws + WS_XN8) + (size_t)row * D, F.lane); }
            }
        }
        SEAM(pb + 10);
    }
__global__ void __launch_bounds__(NWAVES * 64, 2) fwd_kernel(Args args) {
    extern __shared__ __attribute__((aligned(16))) unsigned char lds_raw[];
    Frame F;
    F.lds = (LAS unsigned char*)lds_raw; F.misc = F.lds + MISC_OFF;
    F.tid = threadIdx.x; F.lane = F.tid & 63; F.wave = __builtin_amdgcn_readfirstlane(F.tid >> 6);
    F.G = gridDim.x; { const int bx = blockIdx.x; F.vcu = (F.G % 8 == 0) ? (bx % 8) * (F.G / 8) + bx / 8 : bx; }
    F.gw = F.vcu * NWAVES + F.wave; F.NGW = F.G * NWAVES;
    F.in = args.in; F.out = args.out; F.ws = args.ws; F.ctl = (unsigned*)(args.ws + WS_CTL);
    F.Z = (bf16*)(args.ws + WS_Z); F.XN = (bf16*)(args.ws + WS_XN); F.OCAT = (bf16*)(args.ws + WS_OCAT); F.MERGED = (bf16*)(args.ws + WS_MERGED);
    F.XS = (bf16*)(args.ws + WS_XS); F.Y = (bf16*)(args.ws + WS_Y); F.H = (bf16*)(args.ws + WS_H);
    F.S = (float*)(args.ws + WS_S); F.GO = (float*)(args.ws + WS_GO); F.MASK = (unsigned*)(args.ws + WS_MASK);
    const int lo = args.ph_lo, hi = args.ph_hi;
    const bool use_bar = (hi - lo) > 1;
    for (int u = F.tid; u < 64; u += NWAVES * 64) ((LAS unsigned*)F.misc)[u] = 0u;
    ((LAS unsigned long long*)(F.misc + MO_SS))[F.tid] = 0ull;
    for (int i = F.tid; i < 2 * 4 * 128; i += NWAVES * 64) { const int l_ = i >> 9, k_ = (i >> 7) & 3, d_ = i & 127; ((LAS float*)(F.misc + MO_GN))[i] = F.in[k_ == 0 ? I_AQG : (k_ == 1 ? I_AKG : (k_ == 2 ? I_BQG : I_BKG))][l_ * 128 + d_]; }
    for (int i = F.tid; i < 12 * 129; i += NWAVES * 64) { const int hd = i / 129, dd = i % 129; int bk;
        if (dd < 16) bk = dd; else { bk = 16 + (int)(logf((float)dd / 16.0f) / 2.0794415416798357f * 16.0f); bk = bk > 31 ? 31 : bk; }
        ((LAS float*)(F.misc + MO_TAB2))[i] = F.in[I_RELB][bk * 12 + hd] * 1.4426950408889634f; }
    __syncthreads();
    XcdBarrier bar; bar.bar = F.ctl + CW_BAR; bar.x = 0; bar.st = nullptr;
    if (use_bar) bar = xcd_barrier_post(F.ctl + CW_BAR, (volatile LAS unsigned*)(F.misc + MO_BARW));

    if (IN(0)) { PHASE_LANE();
        LAS float* scr = (LAS float*)(F.lds + F.wave * 16384);
        constexpr int I_IN = (2048 / 64) * (D_IN / 32);
        constexpr int I_BA = (512 / 64) * (2048 / 32), I_BB = (1024 / 64) * (2048 / 32), I_BC = I_BA, I_O = (2048 / 64) * (2048 / 32);
        constexpr int PER_L = I_IN + I_BA + I_BB + I_BC + I_O;
        for (int it = F.gw; it < DEPTH * PER_L; it += F.NGW) {
            const int l = it / PER_L; int r = it % PER_L;
            bf16* win = (bf16*)(F.ws + WS_WIN + l * WIN_L); bf16* wbr = (bf16*)(F.ws + WS_WBR + l * WBR_L); bf16* wo = (bf16*)(F.ws + WS_WO + l * WO_L);
            if (r < I_IN) { const int nb_ = r % (D_IN / 32);
                const bool has8 = nb_ < 56 || (nb_ >= 58 && nb_ <= 106) || nb_ >= 155, hasb = (nb_ >= 56 && nb_ <= 58) || (nb_ >= 106 && nb_ < 155);
                if (has8) transpose_item_fp8(F.in[I_WIN] + (size_t)l * 2048 * D_IN, D_IN, (unsigned char*)win, 2048, 64.0f, scr, r, F.lane, MapWin8{});
                if (hasb) transpose_item(F.in[I_WIN] + (size_t)l * 2048 * D_IN, D_IN, win + (size_t)12 * 1024 * 1024, 2048, 0, scr, r, F.lane, MapWinB{});
                continue; } r -= I_IN;
            if (r < I_BA) { transpose_item(F.in[I_WBA] + (size_t)l * 512 * 2048, 2048, wbr, 2048, 0, scr, r, F.lane, MapId{0}); continue; } r -= I_BA;
            if (r < I_BB) { transpose_item(F.in[I_WBB] + (size_t)l * 1024 * 2048, 2048, wbr, 2048, 512, scr, r, F.lane, MapId{0}); continue; } r -= I_BB;
            if (r < I_BC) { transpose_item(F.in[I_WBC] + (size_t)l * 512 * 2048, 2048, wbr, 2048, 1536, scr, r, F.lane, MapId{0}); continue; } r -= I_BC;
            transpose_item(F.in[I_WO] + (size_t)l * 2048 * 2048, 2048, wo, 2048, 0, scr, r, F.lane, MapId{0});
        }
        for (int i = F.gw * 64 + F.lane; i < DEPTH * 160 * 256; i += F.NGW * 64) { const int l = i / (160 * 256), r = (i / 256) % 160, c = i % 256;
            *(v4u*)((bf16*)(F.ws + WS_WIN + l * WIN_L) + (size_t)12 * 1024 * 1024 + (size_t)(ZC_PAD - 3328 + r) * 2048 + 8 * c) = (v4u){0u, 0u, 0u, 0u}; }
        for (int i = F.gw * 64 + F.lane; i < DEPTH * 96 * 2048; i += F.NGW * 64) { const int l = i / (96 * 2048), e = (i / 2048) % 96, k = i % 2048;
            float val = 0.f; if (e < 8) val = F.in[I_WRG][(size_t)l * D * 8 + (size_t)k * 8 + e]; else if (e < 72) val = F.in[I_WRE][(size_t)l * D * 64 + (size_t)k * 64 + (e - 8)];
            val *= F.in[I_N2G][l * D + k];
            const unsigned hi = f2bf(val); const float rem = val - bf1((bf16)hi);
            ((bf16*)(F.ws + WS_WRH + l * WR_L))[e * 2048 + k] = (bf16)hi; ((bf16*)(F.ws + WS_WRL + l * WR_L))[e * 2048 + k] = (bf16)f2bf(rem); }
        for (int mrow = F.gw; mrow < T; mrow += F.NGW) { f32x4 v[8]; load_row(F.in[I_X] + (size_t)mrow * D, F.lane, v); const float rstd = row_rstd(v);
            norm_store_bf16(v, rstd, F.in[I_N1G], F.XN + (size_t)mrow * D, F.lane); norm_store_fp8(v, rstd, F.in[I_N1G], (unsigned char*)(F.ws + WS_XN8) + (size_t)mrow * D, F.lane); }
    }
    SEAM(0);

    layer_body<0>(F, bar, lo, hi);
    layer_body<1>(F, bar, lo, hi);
}


#ifndef N_LAUNCH_MODE
#define N_LAUNCH_MODE 1
#endif
extern "C" void kernel_launch(void* const* d_in, const int* in_sizes, int n_in, void* d_out, int out_size, void* d_ws, size_t ws_size, hipStream_t stream) {
    static int grid = 0;
    if (grid == 0) {
        if (n_in != 24 || out_size != T * D || ws_size < WS_END) { fprintf(stderr, "kernel_launch: unexpected shapes (n_in %d out %d ws %zu)\n", n_in, out_size, ws_size); grid = -1; return; }
        int dev = 0, cus = 0, per_cu = 0;
        if (hipGetDevice(&dev) != hipSuccess || hipDeviceGetAttribute(&cus, hipDeviceAttributeMultiprocessorCount, dev) != hipSuccess) { grid = -1; return; }
        if (hipFuncSetAttribute((const void*)fwd_kernel, hipFuncAttributeMaxDynamicSharedMemorySize, LDS_BYTES) != hipSuccess) { fprintf(stderr, "kernel_launch: hipFuncSetAttribute failed\n"); grid = -1; return; }
        if (hipOccupancyMaxActiveBlocksPerMultiprocessor(&per_cu, (const void*)fwd_kernel, NWAVES * 64, LDS_BYTES) != hipSuccess || per_cu < 1) { fprintf(stderr, "kernel_launch: occupancy query says %d\n", per_cu); }
        (void)hipGetLastError();
        grid = cus;
    }
    if (grid < 0) return;
    (void)hipMemsetAsync((char*)d_ws + WS_CTL, 0, CTL_ZERO_BYTES, stream);
    Args a{};
    for (int i = 0; i < 24; ++i) a.in[i] = (const float*)d_in[i];
    a.out = (float*)d_out; a.ws = (unsigned char*)d_ws;
    constexpr int NPH = 1 + 11 * DEPTH;
#if N_LAUNCH_MODE == 1
    a.ph_lo = 0; a.ph_hi = NPH;
    hipLaunchKernelGGL(fwd_kernel, dim3(grid), dim3(NWAVES * 64), LDS_BYTES, stream, a);
#else
    for (int p = 0; p < NPH; ++p) { a.ph_lo = p; a.ph_hi = p + 1; hipLaunchKernelGGL(fwd_kernel, dim3(grid), dim3(NWAVES * 64), LDS_BYTES, stream, a); }
#endif
    const hipError_t le = hipPeekAtLastError();
    if (le != hipSuccess) fprintf(stderr, "kernel_launch: launch failed: %s\n", hipGetErrorName(le));
}
```

```cpp
#include <hip/hip_runtime.h>
#include <cstdio>
#include <cstdint>

__device__ __forceinline__ int lane_id() { return (int)__builtin_amdgcn_mbcnt_hi(~0u, __builtin_amdgcn_mbcnt_lo(~0u, 0u)); }
namespace pg8 {
#define PG8_LAS __attribute__((address_space(3)))
typedef unsigned short bf16_t;
typedef short bf16x8 __attribute__((ext_vector_type(8)));
typedef float f32x4 __attribute__((ext_vector_type(4)));
typedef unsigned u32x4 __attribute__((ext_vector_type(4)));
typedef unsigned u32x2 __attribute__((ext_vector_type(2)));
constexpr int BM = 256, BK = 64, HALF = 128, HTB = HALF * BK * 2  , STAGE_BYTES = 8 * HTB, NXCD = 8, WGM = 8;

__host__ __device__ __forceinline__ int lds_byte(int r, int c) { const int st = (r >> 4) * 2 + (c >> 5), rr = r & 15, cc = c & 31, ob = rr * 64 + cc * 2; return st * 1024 + (ob ^ (((ob >> 9) & 1) << 5)); }
__host__ __device__ __forceinline__ void stage_rc(int b, int& R, int& C) { const int st = b / 1024, sb = b % 1024, swz = sb ^ (((sb >> 9) & 1) << 5); R = (st >> 1) * 16 + swz / 64; C = (st & 1) * 32 + (swz % 64) / 2; }
__host__ __device__ __forceinline__ int perm32(int rho) { const int n = rho >> 4, i = rho & 15; return 8 * (i >> 2) + 4 * n + (i & 3); }

struct Unit { int pm, pn, koff, nt, seg; };
struct Gemm { const bf16_t* A; const bf16_t* Bt; int M, N, K; };

struct StaticOrder {
    static constexpr bool GATHER = false;
    int nM, nN, nwg, G, c, nt0;
    __device__ __forceinline__ int row_token(const Unit&, int) const { return 0; }
    __device__ void init(int M, int N, int K, int G_, int c_) { nM = M / BM; nN = N / BM; nwg = nM * nN; G = G_; c = c_; nt0 = K / BK; }
    __device__ bool tile(long L, Unit& u) const {
        if (L >= nwg) return false;
        int wgid = (int)L; { const int q = nwg / NXCD, r = nwg % NXCD, xcd = wgid % NXCD, off = wgid / NXCD; wgid = (xcd < r ? xcd * (q + 1) : r * (q + 1) + (xcd - r) * q) + off; }
        const int nig = WGM * nN, gid = wgid / nig, fm = gid * WGM, gsz = (nM - fm) < WGM ? (nM - fm) : WGM;
        u.pm = fm + ((wgid % nig) % gsz); u.pn = (wgid % nig) / gsz; return true;
    }
    __device__ bool next(int i, Unit& u) const { u.koff = 0; u.nt = nt0; u.seg = 0; return tile((long)i * G + c, u); }
    __device__ __forceinline__ void a_ready(const Unit&) const {}
    __device__ __forceinline__ void done(const Unit&) const {}
};
struct MergeOrder : StaticOrder {
    __device__ bool next(int i, Unit& u) const { const int rnd = i / 3, sg = i - 3 * rnd; u.seg = sg; u.koff = sg == 0 ? 0 : (sg == 1 ? 512 : 1536); u.nt = sg == 1 ? 16 : 8; return tile((long)rnd * G + c, u); }
};
struct MoeOrder {
    static constexpr bool GATHER = false;
    int total, G, c, NJ, nt0; const PG8_LAS int* tile_exp;
    __device__ bool next(int i, Unit& u) const {
        const long L = (long)i * G + c; if (L >= total) return false;
        const int R = (int)L / NJ, j = (int)L % NJ; u.pm = R; u.pn = tile_exp[R] * NJ + j; u.koff = 0; u.nt = nt0; u.seg = 0; return true;
    }
    __device__ __forceinline__ int row_token(const Unit&, int) const { return 0; }
    __device__ __forceinline__ void a_ready(const Unit&) const {}
    __device__ __forceinline__ void done(const Unit&) const {}
};
struct MoeGatherOrder : MoeOrder {
    static constexpr bool GATHER = true;
    const PG8_LAS int* pst; const PG8_LAS int* cnt; const int* liste;
    __device__ __forceinline__ int row_token(const Unit& u, int r) const {
        const int e = tile_exp[u.pm], lr = u.pm * 256 - pst[e] + r;
        return lr < cnt[e] ? liste[(size_t)e * 32768 + lr] : 0;
    }
};

typedef __bf16 bf16x2v __attribute__((ext_vector_type(2)));
typedef float f32x2v __attribute__((ext_vector_type(2)));
__device__ __forceinline__ unsigned cvt_pk_bf16(float lo, float hi) { const f32x2v v = {lo, hi}; const bf16x2v b = __builtin_convertvector(v, bf16x2v); return __builtin_bit_cast(unsigned, b); }
__device__ __forceinline__ float bflo(unsigned w) { return __uint_as_float(w << 16); }
__device__ __forceinline__ float bfhi(unsigned w) { return __uint_as_float(w & 0xffff0000u); }
__device__ __forceinline__ float sigm(float v) { return __builtin_amdgcn_rcpf(1.0f + __builtin_amdgcn_exp2f(-1.44269504f * v)); }
__device__ __forceinline__ unsigned q8x4(const f32x4 s) {
    const unsigned a = (unsigned)fminf(s[0] * 256.0f, 255.5f), b = (unsigned)fminf(s[1] * 256.0f, 255.5f), c = (unsigned)fminf(s[2] * 256.0f, 255.5f), d = (unsigned)fminf(s[3] * 256.0f, 255.5f);
    return a | (b << 8) | (c << 16) | (d << 24);
}

constexpr int ZP = 5120;
constexpr int ZC_GA = 5120, ZC_GB = 7168, ZC_GC = 9216;
constexpr size_t GT_TILE = 65536, GT_GATE = (size_t)128 * 8 * GT_TILE;

template <int PN_OFF> struct EpiInProj {
    static constexpr bool PERM = true, AFTER_DRAIN = false, CHAIN = false;
    bf16_t* O; unsigned char* GT; PG8_LAS unsigned long long* ss;
    const PG8_LAS float* gains;
    __device__ __forceinline__ void operator()(const f32x4 (&acc)[2][2][4][2], const Unit& u, int wr, int wc, int fr, int fq) const {
        const int pn = PN_OFF ? u.pn + 13 : (u.pn < 13 ? u.pn : u.pn + 7);
        int row0 = u.pm * BM + wr * 64 + fr, col0 = pn * BM + wc * 32 + 8 * fq;
        asm volatile("" : "+v"(row0), "+v"(col0));
        const int act = pn >= 20 ? 2 : (pn >= 18 ? 1 : 0);
        const bool hn = PN_OFF == 0 && pn <= 7;
        f32x4 gn0 = (f32x4){1.f, 1.f, 1.f, 1.f}, gn1 = gn0; int lr = 0;
        if (hn) {
            lr = wr * 64 + fr; asm volatile("" : "+v"(lr));
#pragma unroll
            for (int ai = 0; ai < 2; ++ai)
#pragma unroll
                for (int m = 0; m < 4; ++m)
#pragma unroll
                    for (int bj = 0; bj < 2; ++bj) { const f32x4 a = acc[ai][bj][m][0], b = acc[ai][bj][m][1];
                        float s = (a[0] * a[0] + a[1] * a[1]) + (a[2] * a[2] + a[3] * a[3]) + (b[0] * b[0] + b[1] * b[1]) + (b[2] * b[2] + b[3] * b[3]);
                        s += __shfl_xor(s, 16); s += __shfl_xor(s, 32);
                        if (fq == 0) __hip_atomic_fetch_add(ss + (ai * HALF + m * 16 + lr) * 2 + bj, (unsigned long long)(s * 1048576.0f), __ATOMIC_RELAXED, __HIP_MEMORY_SCOPE_WORKGROUP); }
            asm volatile("s_waitcnt lgkmcnt(0)" ::: "memory"); __builtin_amdgcn_s_barrier(); asm volatile("" ::: "memory");
            const PG8_LAS float* gp = gains + (pn <= 1 ? 0 : (pn == 2 ? 128 : (pn <= 6 ? 256 : 384))) + wc * 32 + 8 * fq;
            gn0 = *(const PG8_LAS f32x4*)gp; gn1 = *(const PG8_LAS f32x4*)(gp + 4);
        }
        if (act == 2) {
            int lo16 = (wr * 4 + wc) * 8192 + (fq * 16 + fr) * 16; asm volatile("" : "+v"(lo16));
            unsigned char* gp = GT + (size_t)((pn - 20) >> 3) * GT_GATE + ((size_t)u.pm * 8 + ((pn - 20) & 7)) * GT_TILE + lo16;
#pragma unroll
            for (int ai = 0; ai < 2; ++ai)
#pragma unroll
                for (int m = 0; m < 4; ++m) { u32x4 w;
#pragma unroll
                    for (int bj = 0; bj < 2; ++bj) { const f32x4 v0 = acc[ai][bj][m][0] * 0.015625f, v1 = acc[ai][bj][m][1] * 0.015625f; f32x4 s0, s1;
#pragma unroll
                        for (int j = 0; j < 4; ++j) { s0[j] = sigm(v0[j]); s1[j] = sigm(v1[j]); }
                        w[2 * bj] = q8x4(s0); w[2 * bj + 1] = q8x4(s1); }
                    *(u32x4*)(gp + (ai * 4 + m) * 1024) = w; }
            return;
        }
#pragma unroll
        for (int ai = 0; ai < 2; ++ai)
#pragma unroll
            for (int m = 0; m < 4; ++m) { bf16_t* rowp = O + (size_t)(row0 + ai * HALF + m * 16) * ZP + col0;
#pragma unroll
                for (int bj = 0; bj < 2; ++bj) { f32x4 v0 = acc[ai][bj][m][0], v1 = acc[ai][bj][m][1];
                    if (hn && !(pn == 2 && bj == 1)) { const float r = rsqrtf((float)ss[(ai * HALF + m * 16 + lr) * 2 + bj] * (0.015625f * 0.015625f / 128.0f / 1048576.0f) + 1e-6f) * 0.015625f;
                        v0 = v0 * r * gn0; v1 = v1 * r * gn1; }
                    else if (PN_OFF == 0) { v0 = v0 * 0.015625f; v1 = v1 * 0.015625f; }
                    if (act) {
#pragma unroll
                        for (int j = 0; j < 4; ++j) { v0[j] *= sigm(v0[j]); v1[j] *= sigm(v1[j]); } }
                    u32x4 w; w.x = cvt_pk_bf16(v0[0], v0[1]); w.y = cvt_pk_bf16(v0[2], v0[3]); w.z = cvt_pk_bf16(v1[0], v1[1]); w.w = cvt_pk_bf16(v1[2], v1[3]);
                    *(u32x4*)(rowp + bj * HALF) = w; } }
        if (hn) { asm volatile("s_waitcnt lgkmcnt(0)" ::: "memory"); __builtin_amdgcn_s_barrier(); asm volatile("" ::: "memory");
            ss[(wr * 4 + wc) * 64 + fq * 16 + fr] = 0ull; }
    }
};
template <int MODE = 0> struct EpiMergeT {
    static constexpr bool PERM = true, AFTER_DRAIN = false, CHAIN = true;
    const unsigned char* GT; bf16_t* O;
    __device__ __forceinline__ void operator()(f32x4 (&acc)[2][2][4][2], const Unit& u, int wr, int wc, int fr, int fq) const {
        if (MODE == 2) return;
        const int row0 = u.pm * BM + wr * 64 + fr, col0 = u.pn * BM + wc * 32 + 8 * fq;
        int lo16 = (wr * 4 + wc) * 8192 + (fq * 16 + fr) * 16; asm volatile("" : "+v"(lo16));
        const unsigned char* gp = GT + ((size_t)u.pm * 8 + u.pn) * GT_TILE + lo16;
        const size_t cn = (size_t)u.seg * GT_GATE, cd = (size_t)(u.seg == 0 ? 1 : 2) * GT_GATE;
        const bool fin = u.seg == 2;
        u32x4 gn[2][4], gd[2][4];
#pragma unroll
        for (int ai = 0; ai < 2; ++ai)
#pragma unroll
            for (int m = 0; m < 4; ++m) {
                if (MODE == 1) { gn[ai][m] = (u32x4){0x80808080u + (unsigned)u.pm, 0x80808080u, 0x80808080u, 0x80808080u}; gd[ai][m] = gn[ai][m]; } else {
                gn[ai][m] = *(const u32x4*)(gp + cn + (ai * 4 + m) * 1024); gd[ai][m] = *(const u32x4*)(gp + cd + (ai * 4 + m) * 1024); } }
#pragma unroll
        for (int ai = 0; ai < 2; ++ai)
#pragma unroll
            for (int m = 0; m < 4; ++m)
#pragma unroll
                for (int bj = 0; bj < 2; ++bj) { const size_t r = (size_t)(row0 + ai * HALF + m * 16);
#pragma unroll
                    for (int w = 0; w < 2; ++w)
#pragma unroll
                        for (int k = 0; k < 4; ++k) { const float qn = (float)((gn[ai][m][2 * bj + w] >> (8 * k)) & 0xffu) + 0.5f, qd = (float)((gd[ai][m][2 * bj + w] >> (8 * k)) & 0xffu) + 0.5f;
                            acc[ai][bj][m][w][k] *= qn * __builtin_amdgcn_rcpf(fin ? 256.0f : qd); }
                    if (fin) { const f32x4 v0 = acc[ai][bj][m][0], v1 = acc[ai][bj][m][1];
                        u32x4 w; w.x = cvt_pk_bf16(v0[0], v0[1]); w.y = cvt_pk_bf16(v0[2], v0[3]); w.z = cvt_pk_bf16(v1[0], v1[1]); w.w = cvt_pk_bf16(v1[2], v1[3]);
                        *(u32x4*)(O + r * 2048 + col0 + bj * HALF) = w; } }
    }
};
typedef EpiMergeT<0> EpiMerge;
template <bool BASE_BF16> struct EpiResid {
    static constexpr bool PERM = true, AFTER_DRAIN = false, CHAIN = false;
    const float* base; bf16_t* hb; unsigned char* xu; const float* gain;
    __device__ __forceinline__ void operator()(const f32x4 (&acc)[2][2][4][2], const Unit& u, int wr, int wc, int fr, int fq) const {
        const int row0 = u.pm * BM + wr * 64 + fr, col0 = u.pn * BM + wc * 32 + 8 * fq;
        f32x4 gv[2][2];
#pragma unroll
        for (int bj = 0; bj < 2; ++bj)
#pragma unroll
            for (int n = 0; n < 2; ++n) gv[bj][n] = *(const f32x4*)(gain + col0 + bj * HALF + 4 * n);
        const f32x4 lo4 = (f32x4){-440.f, -440.f, -440.f, -440.f}, hi4 = (f32x4){440.f, 440.f, 440.f, 440.f};
#pragma unroll
        for (int ai = 0; ai < 2; ++ai) {
            f32x4 bv[4][2][2];
#pragma unroll
            for (int mm = 0; mm < 4; ++mm) { const size_t off = (size_t)(row0 + ai * HALF + mm * 16) * 2048 + col0;
#pragma unroll
                for (int bj = 0; bj < 2; ++bj) {
                    if constexpr (BASE_BF16) { const u32x4 w = *(const u32x4*)(hb + off + bj * HALF);
                        bv[mm][bj][0] = (f32x4){bflo(w.x), bfhi(w.x), bflo(w.y), bfhi(w.y)}; bv[mm][bj][1] = (f32x4){bflo(w.z), bfhi(w.z), bflo(w.w), bfhi(w.w)}; }
                    else { bv[mm][bj][0] = *(const f32x4*)(base + off + bj * HALF); bv[mm][bj][1] = *(const f32x4*)(base + off + bj * HALF + 4); } } }
#pragma unroll
            for (int mm = 0; mm < 4; ++mm) { const size_t off = (size_t)(row0 + ai * HALF + mm * 16) * 2048 + col0;
#pragma unroll
                for (int bj = 0; bj < 2; ++bj) { const f32x4 h0 = bv[mm][bj][0] + acc[ai][bj][mm][0], h1 = bv[mm][bj][1] + acc[ai][bj][mm][1];
                    u32x4 hw; hw.x = cvt_pk_bf16(h0[0], h0[1]); hw.y = cvt_pk_bf16(h0[2], h0[3]); hw.z = cvt_pk_bf16(h1[0], h1[1]); hw.w = cvt_pk_bf16(h1[2], h1[3]);
                    *(u32x4*)(hb + off + bj * HALF) = hw;
                    const f32x4 x0 = __builtin_elementwise_min(__builtin_elementwise_max(h0 * gv[bj][0], lo4), hi4), x1 = __builtin_elementwise_min(__builtin_elementwise_max(h1 * gv[bj][1], lo4), hi4);
                    int w0 = 0, w1 = 0;
                    w0 = __builtin_amdgcn_cvt_pk_fp8_f32(x0[0], x0[1], w0, false); w0 = __builtin_amdgcn_cvt_pk_fp8_f32(x0[2], x0[3], w0, true);
                    w1 = __builtin_amdgcn_cvt_pk_fp8_f32(x1[0], x1[1], w1, false); w1 = __builtin_amdgcn_cvt_pk_fp8_f32(x1[2], x1[3], w1, true);
                    *(u32x2*)(xu + off + bj * HALF) = (u32x2){(unsigned)w0, (unsigned)w1}; } }
        }
    }
};
struct EpiGlu {
    static constexpr bool PERM = false, AFTER_DRAIN = false, CHAIN = false;
    bf16_t* H; const PG8_LAS int* tile_exp; const PG8_LAS int* pst; const PG8_LAS int* cnt; const int* liste; const float* rstd;
    __device__ __forceinline__ void operator()(const f32x4 (&acc)[2][2][4][2], const Unit& u, int wr, int wc, int fr, int fq) const {
        const int row0 = u.pm * BM + wr * 64 + fr, pj = u.pn & 3;
        const int e = tile_exp[u.pm], lr0 = u.pm * 256 - pst[e] + wr * 64 + fr, ce = cnt[e];
        int tok[2][4]; float rs[2][4];
#pragma unroll
        for (int ai = 0; ai < 2; ++ai)
#pragma unroll
            for (int m = 0; m < 4; ++m) { const int lr = lr0 + ai * HALF + m * 16; tok[ai][m] = lr < ce ? liste[(size_t)e * 32768 + lr] : 0; }
#pragma unroll
        for (int ai = 0; ai < 2; ++ai)
#pragma unroll
            for (int m = 0; m < 4; ++m) rs[ai][m] = rstd[tok[ai][m]] * 0.015625f;
#pragma unroll
        for (int ai = 0; ai < 2; ++ai)
#pragma unroll
            for (int m = 0; m < 4; ++m) { unsigned char* rowp = (unsigned char*)H + (size_t)(row0 + ai * HALF + m * 16) * 512; const float r = rs[ai][m];
#pragma unroll
                for (int bj = 0; bj < 2; ++bj) { const f32x4 a = acc[ai][bj][m][0] * r, b = acc[ai][bj][m][1] * r;
                    const int hc = 16 * (8 * pj + 4 * bj + wc) + 4 * fq;
                    float hv[4];
#pragma unroll
                    for (int j = 0; j < 4; ++j) hv[j] = fminf(fmaxf(a[j] * sigm(a[j]) * b[j] * 8.0f, -440.0f), 440.0f);
                    int w = 0; w = __builtin_amdgcn_cvt_pk_fp8_f32(hv[0], hv[1], w, false); w = __builtin_amdgcn_cvt_pk_fp8_f32(hv[2], hv[3], w, true);
                    *(int*)(rowp + hc) = w; } }
    }
};
struct EpiY {
    static constexpr bool PERM = true, AFTER_DRAIN = false, CHAIN = false;
    unsigned char* Y;
    __device__ __forceinline__ void operator()(const f32x4 (&acc)[2][2][4][2], const Unit& u, int wr, int wc, int fr, int fq) const {
        const int row0 = u.pm * BM + wr * 64 + fr, col0 = (u.pn & 7) * BM + wc * 32 + 8 * fq;
        const f32x4 lo4 = (f32x4){-440.f, -440.f, -440.f, -440.f}, hi4 = (f32x4){440.f, 440.f, 440.f, 440.f};
#pragma unroll
        for (int ai = 0; ai < 2; ++ai)
#pragma unroll
            for (int m = 0; m < 4; ++m) { unsigned char* rowp = Y + (size_t)(row0 + ai * HALF + m * 16) * 2048 + col0;
#pragma unroll
                for (int bj = 0; bj < 2; ++bj) {
                    const f32x4 v0 = __builtin_elementwise_min(__builtin_elementwise_max(acc[ai][bj][m][0] * 0.125f, lo4), hi4), v1 = __builtin_elementwise_min(__builtin_elementwise_max(acc[ai][bj][m][1] * 0.125f, lo4), hi4);
                    int w0 = 0, w1 = 0;
                    w0 = __builtin_amdgcn_cvt_pk_fp8_f32(v0[0], v0[1], w0, false); w0 = __builtin_amdgcn_cvt_pk_fp8_f32(v0[2], v0[3], w0, true);
                    w1 = __builtin_amdgcn_cvt_pk_fp8_f32(v1[0], v1[1], w1, false); w1 = __builtin_amdgcn_cvt_pk_fp8_f32(v1[2], v1[3], w1, true);
                    *(u32x2*)(rowp + bj * HALF) = (u32x2){(unsigned)w0, (unsigned)w1}; } }
    }
};

typedef int v4i_t __attribute__((ext_vector_type(4)));
typedef int v8i_t __attribute__((ext_vector_type(8)));
template <class Epi, class Sched, bool ALIGN_EPI = false, bool FP8 = false>
__device__ __forceinline__ void gemm_phase(PG8_LAS unsigned char* lds, const Gemm g, const Sched& S, const Epi& E) {
    int tid = threadIdx.x; asm volatile("" : "+v"(tid));
    const int wid = __builtin_amdgcn_readfirstlane(tid >> 6), lane = tid & 63, wr = wid >> 2, wc = wid & 3, fr = lane & 15, fq = lane >> 4;
    const int K = g.K;
    unsigned voffA[2], voffB[2]; int RA[2]; unsigned CA2[2];
#pragma unroll
    for (int i = 0; i < 2; ++i) { int R, C; stage_rc(tid * 16 + i * 8192, R, C); const int Rb = Epi::PERM ? ((R & ~31) + perm32(R & 31)) : R;
        voffA[i] = (unsigned)(R * K + C) * 2u; voffB[i] = (unsigned)(Rb * K + C) * 2u; RA[i] = R; CA2[i] = (unsigned)C * 2u; }
    unsigned gAc[2][2], gAn[2][2];
#define PG8_GOFF(dst, uu) do { _Pragma("unroll") for (int h_ = 0; h_ < 2; ++h_) _Pragma("unroll") for (int i_ = 0; i_ < 2; ++i_) dst[h_][i_] = (unsigned)S.row_token(uu, 128 * h_ + RA[i_]) * (unsigned)(K * 2) + CA2[i_]; } while (0)
#define PG8_STAGE_A(bufoff, gbase, half, garr) do { if constexpr (Sched::GATHER) PG8_STAGE(bufoff, gbase, garr); else PG8_STAGE(bufoff, (gbase) + (half) * hstep, voffA); } while (0)
    const size_t kstep = (size_t)(BK * 2);
    const size_t hstep = (size_t)HALF * K * 2;
    const size_t tstep = 2 * hstep;
    const unsigned ldsw = (unsigned)wid * 1024u;
    const int aoff = lds_byte(wr * 64 + fr, fq * 8), boff = lds_byte(wc * 32 + fr, fq * 8);
#define PG8_SA(b, h) (((b) * 2 + (h)) * HTB)
#define PG8_SB(b, h) ((4 + (b) * 2 + (h)) * HTB)
#define PG8_STAGE(bufoff, gbase, voff) do { _Pragma("unroll") for (int _i = 0; _i < 2; ++_i) \
        __builtin_amdgcn_global_load_lds((const unsigned*)((const char*)(gbase) + (voff)[_i]), (PG8_LAS unsigned*)(lds + (bufoff) + ldsw + _i * 8192), 16, 0, 0); } while (0)
#define PG8_LDA(dst, b, h) do { if constexpr (FP8) { _Pragma("unroll") for (int m = 0; m < 4; ++m) dst##8[m] = __builtin_shufflevector(*(const PG8_LAS v4i_t*)(lds + PG8_SA(b, h) + aoff + m * 2048), *(const PG8_LAS v4i_t*)(lds + PG8_SA(b, h) + aoff + m * 2048 + 1024), 0, 1, 2, 3, 4, 5, 6, 7); } \
        else { _Pragma("unroll") for (int m = 0; m < 4; ++m) _Pragma("unroll") for (int k = 0; k < 2; ++k) dst[m][k] = *(const PG8_LAS bf16x8*)(lds + PG8_SA(b, h) + aoff + m * 2048 + k * 1024); } } while (0)
#define PG8_LDB(dst, b, h) do { if constexpr (FP8) { _Pragma("unroll") for (int n = 0; n < 2; ++n) dst##8[n] = __builtin_shufflevector(*(const PG8_LAS v4i_t*)(lds + PG8_SB(b, h) + boff + n * 2048), *(const PG8_LAS v4i_t*)(lds + PG8_SB(b, h) + boff + n * 2048 + 1024), 0, 1, 2, 3, 4, 5, 6, 7); } \
        else { _Pragma("unroll") for (int n = 0; n < 2; ++n) _Pragma("unroll") for (int k = 0; k < 2; ++k) dst[n][k] = *(const PG8_LAS bf16x8*)(lds + PG8_SB(b, h) + boff + n * 2048 + k * 1024); } } while (0)
#define PG8_MMA(ai, bj, At, Bt) do { __builtin_amdgcn_s_setprio(1); _Pragma("unroll") for (int m = 0; m < 4; ++m) _Pragma("unroll") for (int n = 0; n < 2; ++n) { \
        if constexpr (FP8) asm volatile("v_mfma_f32_16x16x128_f8f6f4 %0, %1, %2, %0" : "+v"(acc[ai][bj][m][n]) : "v"(Bt##8[n]), "v"(At##8[m])); \
        else { _Pragma("unroll") for (int k = 0; k < 2; ++k) acc[ai][bj][m][n] = __builtin_amdgcn_mfma_f32_16x16x32_bf16(Bt[n][k], At[m][k], acc[ai][bj][m][n], 0, 0, 0); } } \
        __builtin_amdgcn_s_setprio(0); } while (0)
#define PG8_WAIT_V(n) asm volatile("s_waitcnt vmcnt(" #n ")" ::: "memory")
#define PG8_WAIT_L(n) asm volatile("s_waitcnt lgkmcnt(" #n ")" ::: "memory")
#define PG8_BAR __builtin_amdgcn_s_barrier()
#define PG8_SCHED __builtin_amdgcn_sched_barrier(0)
    Unit cur, nxt; int ui = 0;
    if (!S.next(0, cur)) return;
    f32x4 acc[2][2][4][2];
#pragma unroll
    for (int a = 0; a < 2; ++a)
#pragma unroll
        for (int b = 0; b < 2; ++b)
#pragma unroll
            for (int m = 0; m < 4; ++m)
#pragma unroll
                for (int n = 0; n < 2; ++n) acc[a][b][m][n] = (f32x4){0.f, 0.f, 0.f, 0.f};
    bf16x8 At[4][2], B0[2][2], B1[2][2]; v8i_t At8[4], B08[2], B18[2];
    const size_t tstepA = Sched::GATHER ? (size_t)0 : tstep;
    const char* cA = (const char*)g.A + (size_t)cur.pm * tstepA + (size_t)cur.koff * 2; const char* cB = (const char*)g.Bt + (size_t)cur.pn * tstep + (size_t)cur.koff * 2;
    S.a_ready(cur);
    if constexpr (Sched::GATHER) { PG8_GOFF(gAc, cur); }
    PG8_STAGE(PG8_SB(0, 0), cB, voffB); PG8_STAGE(PG8_SB(0, 1), cB + hstep, voffB); PG8_STAGE_A(PG8_SA(0, 0), cA, 0, gAc[0]); PG8_STAGE_A(PG8_SA(0, 1), cA, 1, gAc[1]);
    if (wr == 1) PG8_BAR;
    PG8_WAIT_V(2); PG8_BAR;
    PG8_STAGE(PG8_SB(1, 0), cB + kstep, voffB); PG8_STAGE_A(PG8_SA(1, 0), cA + kstep, 0, gAc[0]); PG8_STAGE(PG8_SB(1, 1), cB + hstep + kstep, voffB);
    PG8_WAIT_V(6); PG8_BAR;
    for (;;) {
        const bool has_next = S.next(ui + 1, nxt);
        const char* nA = has_next ? (const char*)g.A + (size_t)nxt.pm * tstepA + (size_t)nxt.koff * 2 : cA; const char* nB = has_next ? (const char*)g.Bt + (size_t)nxt.pn * tstep + (size_t)nxt.koff * 2 : cB;
        if constexpr (Sched::GATHER) { if (has_next) { PG8_GOFF(gAn, nxt); } else {
#pragma unroll
            for (int h_ = 0; h_ < 2; ++h_)
#pragma unroll
                for (int i_ = 0; i_ < 2; ++i_) gAn[h_][i_] = gAc[h_][i_]; } }
        const int nt = cur.nt;
        for (int t = 0; t < nt; t += 2) {
            const bool last = (t == nt - 2);
            const char* a1 = cA + (size_t)(t + 1) * kstep;
            const char* a2 = last ? nA : cA + (size_t)(t + 2) * kstep; const char* b2 = last ? nB : cB + (size_t)(t + 2) * kstep;
            const char* a3 = a2 + kstep; const char* b3 = b2 + kstep;
            if (last && has_next) S.a_ready(nxt);
            unsigned g2a[2][2];
            if constexpr (Sched::GATHER) {
#pragma unroll
                for (int h_ = 0; h_ < 2; ++h_)
#pragma unroll
                    for (int i_ = 0; i_ < 2; ++i_) g2a[h_][i_] = last ? gAn[h_][i_] : gAc[h_][i_]; }
            PG8_LDB(B0, 0, 0); PG8_LDB(B1, 0, 1); PG8_SCHED; PG8_LDA(At, 0, 0); PG8_STAGE_A(PG8_SA(1, 1), a1, 1, gAc[1]);
            PG8_WAIT_V(8); PG8_WAIT_L(0); PG8_BAR; PG8_MMA(0, 0, At, B0); PG8_MMA(0, 1, At, B1); PG8_BAR; PG8_SCHED;
            PG8_LDA(At, 0, 1); PG8_STAGE(PG8_SB(0, 0), b2, voffB); PG8_STAGE(PG8_SB(0, 1), b2 + hstep, voffB); PG8_STAGE_A(PG8_SA(0, 0), a2, 0, g2a[0]);
            PG8_WAIT_V(8); PG8_WAIT_L(0); PG8_BAR; PG8_MMA(1, 0, At, B0); PG8_MMA(1, 1, At, B1); PG8_BAR; PG8_SCHED;
            PG8_LDB(B0, 1, 0); PG8_LDB(B1, 1, 1); PG8_SCHED; PG8_LDA(At, 1, 0); PG8_STAGE_A(PG8_SA(0, 1), a2, 1, g2a[1]);
            PG8_WAIT_V(8); PG8_WAIT_L(0); PG8_BAR; PG8_MMA(0, 0, At, B0); PG8_MMA(0, 1, At, B1); PG8_BAR; PG8_SCHED;
            PG8_LDA(At, 1, 1); PG8_STAGE(PG8_SB(1, 0), b3, voffB); PG8_STAGE(PG8_SB(1, 1), b3 + hstep, voffB); PG8_STAGE_A(PG8_SA(1, 0), a3, 0, g2a[0]);
            PG8_WAIT_V(8); PG8_WAIT_L(0); PG8_BAR; PG8_MMA(1, 0, At, B0); PG8_MMA(1, 1, At, B1); PG8_BAR; PG8_SCHED;
        }
        if constexpr (ALIGN_EPI) { if (wr == 0) PG8_BAR; }
        if constexpr (FP8) asm volatile("s_nop 15\n\ts_nop 15\n\ts_nop 15\n\ts_nop 15" ::: "memory");
        E(acc, cur, wr, wc, fr, fq); S.done(cur);
        if (!has_next) break;
        if (!Epi::CHAIN || cur.seg == 2)
#pragma unroll
        for (int a = 0; a < 2; ++a)
#pragma unroll
            for (int b = 0; b < 2; ++b)
#pragma unroll
                for (int m = 0; m < 4; ++m)
#pragma unroll
                    for (int n = 0; n < 2; ++n) acc[a][b][m][n] = (f32x4){0.f, 0.f, 0.f, 0.f};
        cur = nxt; cA = nA; cB = nB; ++ui;
        if constexpr (Sched::GATHER) {
#pragma unroll
            for (int h_ = 0; h_ < 2; ++h_)
#pragma unroll
                for (int i_ = 0; i_ < 2; ++i_) gAc[h_][i_] = gAn[h_][i_]; }
        if constexpr (ALIGN_EPI) { if (wr == 1) PG8_BAR; }
    }
    PG8_WAIT_V(0);
    if constexpr (!ALIGN_EPI) { if (wr == 0) PG8_BAR; }
    PG8_BAR;
#undef PG8_SA
#undef PG8_SB
#undef PG8_STAGE_A
#undef PG8_GOFF
#undef PG8_STAGE
#undef PG8_LDA
#undef PG8_LDB
#undef PG8_MMA
#undef PG8_WAIT_V
#undef PG8_WAIT_L
#undef PG8_BAR
#undef PG8_SCHED
}
}

constexpr int NWAVES = 8;
constexpr int T = 32768, SEQ = 2048, NB = 16, D = 2048, DEPTH = 2;
constexpr int ZP = pg8::ZP;
constexpr int ZC_AQ = 0, ZC_AK = 512, ZC_AV = 640, ZC_BQ = 768, ZC_BK = 1792, ZC_BV = 2048, ZC_IQ = 2304, ZC_IK = 3328, ZC_IW = 3392, ZC_CG = 3408, ZC_PAD = 3424, ZC_CQ = 3584, ZC_CK = 3840, ZC_CV = 4096, ZC_CR = 4608;
constexpr int D_IN = 11104;
constexpr int NEXP = 64, DEXP = 512, PMAX_TILES = 320;
constexpr float EPS = 1e-6f;

constexpr size_t MiB = 1u << 20;
constexpr size_t WS_CTL = 0, CTL_ZERO_BYTES = 1 * MiB;
constexpr size_t WS_ROUTE = 2 * MiB;
constexpr size_t WS_WRH = 4 * MiB, WS_WRL = 6 * MiB, WR_L = 96 * 2048 * 2;
constexpr size_t WS_WIN = 16 * MiB, WIN_L = 44 * MiB;
constexpr size_t WS_WBR = 104 * MiB, WBR_L = 8 * MiB;
constexpr size_t WS_WO = 120 * MiB, WO_L = 8 * MiB;
constexpr size_t WS_W13 = 136 * MiB;
constexpr size_t WS_HB = 264 * MiB;
constexpr size_t WS_W2 = 392 * MiB;
constexpr size_t WS_XN = 520 * MiB;
constexpr size_t WS_OCAT = 648 * MiB;
constexpr size_t WS_MERGED = 776 * MiB;
constexpr size_t WS_Z = 904 * MiB;
constexpr size_t WS_GT = 1224 * MiB;
constexpr size_t WS_S = 1608 * MiB;
constexpr size_t WS_MASK = 1864 * MiB;
constexpr size_t WS_GO = 1872 * MiB;
constexpr size_t WS_GCS = WS_GO;
constexpr size_t WS_GDEC = 8 * MiB;
constexpr size_t WS_RSTD = 9 * MiB;
constexpr size_t WS_LISTE = 904 * MiB;
constexpr size_t WS_XS = 904 * MiB;
constexpr size_t WS_Y = 1224 * MiB;
constexpr size_t WS_H = 1544 * MiB;
constexpr size_t WS_WG8 = 1936 * MiB, WG8_L = 12 * MiB;
constexpr size_t WS_XN8 = WS_S;
constexpr size_t WS_END = 1936 * MiB;
constexpr int CW_BAR = 4096;
constexpr int CW_CNT = 16384;

constexpr int RING_BYTES = 131072, MISC_OFF = RING_BYTES, LDS_BYTES = 155648;
constexpr int MO_BARW = 32, MO_GN = 256, MO_TEXP = 8192, MO_PST = 9728, MO_TOT = 9984, MO_TAB2 = 10240, MO_CNT = 16640, MO_SS = 16896;

#define GAS __attribute__((address_space(1)))
#define LAS __attribute__((address_space(3)))
typedef unsigned short bf16;
typedef unsigned v4u __attribute__((ext_vector_type(4)));
typedef unsigned v2u __attribute__((ext_vector_type(2)));
typedef float f32x4 __attribute__((ext_vector_type(4)));
#define LDS_WAIT() asm volatile("s_waitcnt lgkmcnt(0)" ::: "memory")
__device__ __forceinline__ unsigned f2bf(float f) { unsigned u = __builtin_bit_cast(unsigned, f); return (u + 0x7fffu + ((u >> 16) & 1u)) >> 16; }
__device__ __forceinline__ unsigned pk2(float lo, float hi) { return f2bf(lo) | (f2bf(hi) << 16); }
__device__ __forceinline__ float bflo(unsigned w) { return __uint_as_float(w << 16); }
__device__ __forceinline__ float bfhi(unsigned w) { return __uint_as_float(w & 0xffff0000u); }
__device__ __forceinline__ float bf1(bf16 h) { return __uint_as_float(((unsigned)h) << 16); }

#define XB_TMO      128
#define XB_XCNT(j)  (256  + 64 * (j))
#define XB_XSUB(j)  (1280 + 64 * (j))
#define XB_XGEN(j)  (2304 + 64 * (j))
#define XB_TOP      3328
#define XB_TOPGEN   3392
#define XCD_BAR_WORDS 3456
#define XB_SPIN_CAP (1u << 18)
__device__ __forceinline__ unsigned xb_ld(unsigned* p)              { return __hip_atomic_load(p, __ATOMIC_RELAXED, __HIP_MEMORY_SCOPE_AGENT); }
__device__ __forceinline__ unsigned xb_add(unsigned* p, unsigned v) { return __hip_atomic_fetch_add(p, v, __ATOMIC_RELAXED, __HIP_MEMORY_SCOPE_AGENT); }
__device__ __forceinline__ unsigned xb_xcc_id() { return (unsigned)__builtin_amdgcn_s_getreg((3 << 11) | 20) & 0xFu; }
#define XB_SPIN(cond, bar) do { unsigned _sp = 0; while (cond) { __builtin_amdgcn_s_sleep(1); \
    if ((++_sp & 255u) == 0u) { if (xb_ld(&(bar)[XB_TMO])) break; if (_sp > XB_SPIN_CAP) { atomicAdd(&(bar)[XB_TMO], 1u); break; } } } } while (0)
struct XcdBarrier { unsigned* bar; unsigned x; volatile LAS unsigned* st; };
__device__ __forceinline__ XcdBarrier xcd_barrier_post(unsigned* bar, volatile LAS unsigned* st) {
    XcdBarrier b; b.bar = bar; b.x = xb_xcc_id(); b.st = st;
    if (threadIdx.x == 0) (void)xb_add(&bar[XB_XCNT(b.x)], 1u);
    return b;
}
__device__ __forceinline__ void xcd_barrier_complete(unsigned* bar, unsigned x, unsigned& nloc, unsigned& nx) {
    const unsigned G = gridDim.x * gridDim.y * gridDim.z;
    unsigned sum, cnt, mine, sp = 0u;
    for (;;) {
        sum = 0u; cnt = 0u; mine = 0u;
#pragma unroll
        for (unsigned j = 0; j < 16; ++j) { const unsigned c = xb_ld(&bar[XB_XCNT(j)]); sum += c; cnt += (c > 0u) ? 1u : 0u; mine = (j == x) ? c : mine; }
        if (sum == G) break;
        __builtin_amdgcn_s_sleep(1);
        if ((++sp & 255u) == 0u) { if (xb_ld(&bar[XB_TMO])) break; if (sp > XB_SPIN_CAP) { atomicAdd(&bar[XB_TMO], 1u); break; } }
    }
    nloc = mine > 0u ? mine : 1u; nx = cnt > 0u ? cnt : 1u;
}
__device__ __forceinline__ void xcd_barrier(const XcdBarrier& b) {
    asm volatile("s_waitcnt vmcnt(0)" ::: "memory");
    __syncthreads();
    if (threadIdx.x == 0) {
        unsigned* bar = b.bar;
        __builtin_amdgcn_s_waitcnt(0);
        unsigned nloc = b.st[0], nx = b.st[1];
        if (nloc == 0u) { xcd_barrier_complete(bar, b.x, nloc, nx); b.st[0] = nloc; b.st[1] = nx; }
        const unsigned old = xb_add(&bar[XB_XSUB(b.x)], 1u);
        const unsigned gen = old / nloc;
        if (old + 1u == (gen + 1u) * nloc) {
            __builtin_amdgcn_fence(__ATOMIC_RELEASE, "agent");
            asm volatile("s_waitcnt vmcnt(0)" ::: "memory");
            const unsigned og = xb_add(&bar[XB_TOP], 1u);
            const unsigned tg = og / nx;
            if (og + 1u == (tg + 1u) * nx) xb_add(&bar[XB_TOPGEN], 1u);
            else XB_SPIN(xb_ld(&bar[XB_TOPGEN]) == tg, bar);
            __builtin_amdgcn_fence(__ATOMIC_ACQUIRE, "agent");
            xb_add(&bar[XB_XGEN(b.x)], 1u);
            asm volatile("s_waitcnt vmcnt(0)" ::: "memory");
        } else {
            XB_SPIN(xb_ld(&bar[XB_XGEN(b.x)]) == gen, bar);
            __builtin_amdgcn_fence(__ATOMIC_ACQUIRE, "agent");
            asm volatile("s_waitcnt vmcnt(0)" ::: "memory");
        }
    }
    __syncthreads();
}

struct Args { const float* in[24]; float* out; unsigned char* ws; int ph_lo, ph_hi; };
enum { I_X = 0, I_RELB, I_N1G, I_WIN, I_AQG, I_AKG, I_BQG, I_BKG, I_SINK, I_CGW, I_CGB, I_CNG, I_WBA, I_WBB, I_WBC, I_WO, I_N2G, I_WRG, I_BRG, I_WRE, I_BRE, I_W1, I_W3, I_W2 };

struct Frame {
    LAS unsigned char* lds; LAS unsigned char* misc;
    unsigned* ctl;
    int tid, lane, wave, vcu, G, gw, NGW;
    const float* const* in; float* out; unsigned char* ws;
    bf16 *Z, *XN, *OCAT, *MERGED, *XS, *Y, *H;
    float *S, *GO; unsigned* MASK;
};

__device__ __forceinline__ float wave_sum(float v) {
#pragma unroll
    for (int o = 1; o < 64; o <<= 1) v += __shfl_xor(v, o);
    return v;
}
__device__ __forceinline__ float wave_max(float v) {
#pragma unroll
    for (int o = 1; o < 64; o <<= 1) v = fmaxf(v, __shfl_xor(v, o));
    return v;
}

template <class MAP>
__device__ __forceinline__ void transpose_item(const float* W, int N, bf16* WT, int dpitch, int koff, LAS float* scr, int item, int lane, const MAP& map) {
    const int nblk = N / 32, kb = item / nblk, nb = item % nblk, k0 = 64 * kb, n0 = 32 * nb;
    f32x4 v[8];
#pragma unroll
    for (int i = 0; i < 8; ++i) v[i] = *(const f32x4*)(W + (size_t)(k0 + 8 * i + (lane >> 3)) * N + n0 + 4 * (lane & 7));
#pragma unroll
    for (int i = 0; i < 8; ++i) { LAS float* d = scr + (8 * i + (lane >> 3)) * 33 + 4 * (lane & 7); d[0] = v[i].x; d[1] = v[i].y; d[2] = v[i].z; d[3] = v[i].w; }
    LDS_WAIT(); asm volatile("" ::: "memory");
    const int c = lane & 7;
#pragma unroll
    for (int j = 0; j < 4; ++j) { const int n = (lane >> 3) + 8 * j; const LAS float* s = scr + (8 * c) * 33 + n;
        v4u o; o.x = pk2(s[0 * 33], s[1 * 33]); o.y = pk2(s[2 * 33], s[3 * 33]); o.z = pk2(s[4 * 33], s[5 * 33]); o.w = pk2(s[6 * 33], s[7 * 33]);
        const int dr_ = map(n0 + n); if (dr_ >= 0) *(v4u*)(WT + (size_t)dr_ * dpitch + koff + k0 + 8 * c) = o; }
    LDS_WAIT(); asm volatile("" ::: "memory");
}
__device__ __forceinline__ float clamp8(float v) { return fminf(fmaxf(v, -440.0f), 440.0f); }
template <class MAP>
__device__ __forceinline__ void transpose_item_fp8(const float* W, int N, unsigned char* WT, int dpitch, float scale, LAS float* scr, int item, int lane, const MAP& map) {
    const int nblk = N / 32, kb = item / nblk, nb = item % nblk, k0 = 64 * kb, n0 = 32 * nb;
    f32x4 v[8];
#pragma unroll
    for (int i = 0; i < 8; ++i) v[i] = *(const f32x4*)(W + (size_t)(k0 + 8 * i + (lane >> 3)) * N + n0 + 4 * (lane & 7));
#pragma unroll
    for (int i = 0; i < 8; ++i) { LAS float* d = scr + (8 * i + (lane >> 3)) * 33 + 4 * (lane & 7); d[0] = v[i].x; d[1] = v[i].y; d[2] = v[i].z; d[3] = v[i].w; }
    LDS_WAIT(); asm volatile("" ::: "memory");
    const int c = lane & 7;
#pragma unroll
    for (int j = 0; j < 4; ++j) { const int n = (lane >> 3) + 8 * j; const LAS float* s = scr + (8 * c) * 33 + n;
        int w0 = 0, w1 = 0;
        w0 = __builtin_amdgcn_cvt_pk_fp8_f32(clamp8(s[0 * 33] * scale), clamp8(s[1 * 33] * scale), w0, false); w0 = __builtin_amdgcn_cvt_pk_fp8_f32(clamp8(s[2 * 33] * scale), clamp8(s[3 * 33] * scale), w0, true);
        w1 = __builtin_amdgcn_cvt_pk_fp8_f32(clamp8(s[4 * 33] * scale), clamp8(s[5 * 33] * scale), w1, false); w1 = __builtin_amdgcn_cvt_pk_fp8_f32(clamp8(s[6 * 33] * scale), clamp8(s[7 * 33] * scale), w1, true);
        const int dr_ = map(n0 + n); if (dr_ >= 0) *(v2u*)(WT + (size_t)dr_ * dpitch + k0 + 8 * c) = (v2u){(unsigned)w0, (unsigned)w1}; }
    LDS_WAIT(); asm volatile("" ::: "memory");
}
struct MapId { int off; __device__ __forceinline__ int operator()(int n) const { return off + n; } };
struct MapWin {
    __device__ __forceinline__ int operator()(int n) const {
        if (n < 512) return ZC_AQ + n;
        if (n < 640) return ZC_AK + (n - 512);
        if (n < 768) return ZC_AV + (n - 640);
        if (n < 1792) return ZC_IQ + (n - 768);
        if (n < 1856) return ZC_IK + (n - 1792);
        if (n < 1872) return ZC_IW + (n - 1856);
        if (n < 2896) return ZC_BQ + (n - 1872);
        if (n < 3152) return ZC_BK + (n - 2896);
        if (n < 3408) return ZC_BV + (n - 3152);
        if (n < 3664) return ZC_CQ + (n - 3408);
        if (n < 3920) return ZC_CK + (n - 3664);
        if (n < 4432) return ZC_CV + (n - 3920);
        if (n < 4448) return ZC_CG + (n - 4432);
        if (n < 4960) return ZC_CR + (n - 4448);
        return pg8::ZC_GA + (n - 4960);
    }
};
struct MapWin8 { __device__ __forceinline__ int operator()(int n) const { const int z = MapWin{}(n); return z < 3328 ? z : (z >= 5120 ? z - 1792 : -1); } };
struct MapWinB { __device__ __forceinline__ int operator()(int n) const { const int z = MapWin{}(n); return (z >= 3328 && z < 5120) ? z - 3328 : -1; } };
struct MapW13 { int sel; __device__ __forceinline__ int operator()(int n) const { return 32 * (n >> 4) + 16 * sel + (n & 15); } };

__device__ __forceinline__ void load_row(const float* row, int lane, f32x4 (&v)[8]) {
    const f32x4* xr = (const f32x4*)row + lane;
#pragma unroll
    for (int j = 0; j < 8; ++j) v[j] = xr[64 * j];
}
__device__ __forceinline__ float row_rstd(const f32x4 (&v)[8]) {
    float s = 0.f;
#pragma unroll
    for (int j = 0; j < 8; ++j) s += (v[j].x * v[j].x + v[j].y * v[j].y) + (v[j].z * v[j].z + v[j].w * v[j].w);
    return rsqrtf(wave_sum(s) * (1.0f / 2048.0f) + EPS);
}
__device__ __forceinline__ void norm_store_bf16(const f32x4 (&v)[8], float rstd, const float* g, bf16* orow, int lane) {
    const f32x4* gr = (const f32x4*)g + lane; unsigned long long* o8 = (unsigned long long*)orow + lane;
#pragma unroll
    for (int j = 0; j < 8; ++j) { const f32x4 gg = gr[64 * j];
        o8[64 * j] = (unsigned long long)pk2(v[j].x * rstd * gg.x, v[j].y * rstd * gg.y) | ((unsigned long long)pk2(v[j].z * rstd * gg.z, v[j].w * rstd * gg.w) << 32); }
}

__device__ __forceinline__ void norm_store_fp8(const f32x4 (&v)[8], float rstd, const float* g, unsigned char* orow, int lane) {
    const f32x4* gr = (const f32x4*)g + lane; unsigned* o4 = (unsigned*)orow + lane;
#pragma unroll
    for (int j = 0; j < 8; ++j) { const f32x4 gg = gr[64 * j]; int w = 0;
        w = __builtin_amdgcn_cvt_pk_fp8_f32(clamp8(v[j].x * rstd * gg.x), clamp8(v[j].y * rstd * gg.y), w, false); w = __builtin_amdgcn_cvt_pk_fp8_f32(clamp8(v[j].z * rstd * gg.z), clamp8(v[j].w * rstd * gg.w), w, true);
        o4[64 * j] = (unsigned)w; }
}
__device__ __forceinline__ void convert_moe(Frame& F, int l, int part, int nparts, int lds_off) {
    LAS float* scr = (LAS float*)(F.lds + lds_off + F.wave * 8704);
    bf16* W13 = (bf16*)(F.ws + WS_W13); bf16* W2 = (bf16*)(F.ws + WS_W2);
    constexpr int I13 = (2048 / 64) * (512 / 32);
    constexpr int I2 = (512 / 64) * (2048 / 32);
    constexpr int NIT = NEXP * (2 * I13 + I2);
    const int it_lo = (int)((long)NIT * part / nparts), it_hi = (int)((long)NIT * (part + 1) / nparts);
    for (int it = it_lo + F.gw; it < it_hi; it += F.NGW) {
        const int e = it / (2 * I13 + I2); int r = it % (2 * I13 + I2);
        if (r < I13) { transpose_item_fp8(F.in[I_W1] + ((size_t)l * NEXP + e) * 2048 * 512, 512, (unsigned char*)W13 + (size_t)e * 1024 * 2048, 2048, 64.0f, scr, r, F.lane, MapW13{0}); continue; } r -= I13;
        if (r < I13) { transpose_item_fp8(F.in[I_W3] + ((size_t)l * NEXP + e) * 2048 * 512, 512, (unsigned char*)W13 + (size_t)e * 1024 * 2048, 2048, 64.0f, scr, r, F.lane, MapW13{1}); continue; } r -= I13;
        transpose_item_fp8(F.in[I_W2] + ((size_t)l * NEXP + e) * 512 * 2048, 2048, (unsigned char*)W2 + (size_t)e * 2048 * 512, 512, 32.0f, scr, r, F.lane, MapId{0});
    }
}

typedef short bf16x8_t __attribute__((ext_vector_type(8)));
typedef float f32x16 __attribute__((ext_vector_type(16)));
typedef short s16x4 __attribute__((ext_vector_type(4)));
__device__ __forceinline__ void indexer_segment(Frame& F, int b, int qb, int tlo, int thi) {
    const int lane = F.lane, n = lane & 15, kq = lane >> 4;
    const bf16* qrow = F.Z + (size_t)(b * 2048 + 16 * qb + n) * ZP;
    bf16x8_t iqf[16][2];
#pragma unroll
    for (int h = 0; h < 16; ++h)
#pragma unroll
        for (int ks = 0; ks < 2; ++ks) iqf[h][ks] = *(const bf16x8_t*)(qrow + ZC_IQ + h * 64 + 32 * ks + 8 * kq);
    float wv[16];
    { const v4u w0 = *(const v4u*)(qrow + ZC_IW), w1 = *(const v4u*)(qrow + ZC_IW + 8);
      wv[0] = bflo(w0.x); wv[1] = bfhi(w0.x); wv[2] = bflo(w0.y); wv[3] = bfhi(w0.y); wv[4] = bflo(w0.z); wv[5] = bfhi(w0.z); wv[6] = bflo(w0.w); wv[7] = bfhi(w0.w);
      wv[8] = bflo(w1.x); wv[9] = bfhi(w1.x); wv[10] = bflo(w1.y); wv[11] = bfhi(w1.y); wv[12] = bflo(w1.z); wv[13] = bfhi(w1.z); wv[14] = bflo(w1.w); wv[15] = bfhi(w1.w); }
    const bf16* kbase = F.Z + (size_t)(b * 2048 + n) * ZP + ZC_IK + 8 * kq;
    float* srow = F.S + (size_t)(b * 2048 + 16 * qb + n) * 2048 + 4 * kq;
    bf16x8_t a0 = *(const bf16x8_t*)(kbase + (size_t)(16 * tlo) * ZP), a1 = *(const bf16x8_t*)(kbase + (size_t)(16 * tlo) * ZP + 32);
#pragma unroll 1
    for (int tile = tlo; tile < thi; ++tile) {
        const int tn = tile + 1 < thi ? tile + 1 : tile;
        const bf16x8_t n0 = *(const bf16x8_t*)(kbase + (size_t)(16 * tn) * ZP), n1 = *(const bf16x8_t*)(kbase + (size_t)(16 * tn) * ZP + 32);
        f32x4 sc = (f32x4){0.f, 0.f, 0.f, 0.f};
#pragma unroll
        for (int h = 0; h < 16; ++h) {
            f32x4 c = __builtin_amdgcn_mfma_f32_16x16x32_bf16(a0, iqf[h][0], (f32x4){0.f, 0.f, 0.f, 0.f}, 0, 0, 0);
            c = __builtin_amdgcn_mfma_f32_16x16x32_bf16(a1, iqf[h][1], c, 0, 0, 0);
            sc[0] += wv[h] * fmaxf(c[0], 0.f); sc[1] += wv[h] * fmaxf(c[1], 0.f); sc[2] += wv[h] * fmaxf(c[2], 0.f); sc[3] += wv[h] * fmaxf(c[3], 0.f);
        }
        *(f32x4*)(srow + 16 * tile) = sc * 0.03125f;
        a0 = n0; a1 = n1;
    }
}

constexpr int FA_KP = 272, FA_VP = 320;
constexpr int FA_KOFF = 0, FA_VOFF = 2 * 64 * FA_KP, FA_BYTES = FA_VOFF + 2 * 64 * FA_VP;
__device__ __forceinline__ s16x4 fa_vtr(const LAS unsigned char* p) { return __builtin_bit_cast(s16x4, __builtin_amdgcn_ds_read_tr16_b64_v4i16((LAS s16x4*)p)); }
template <int MODE>
__device__ __forceinline__ void flash_unit(Frame& F, int l, int b, int g, int t0) {
    const int tid = F.tid, lane = F.lane, wave = F.wave, hh = wave & 3, qh = wave >> 2, r = lane & 31, hf = lane >> 5;
    const int qcol = (MODE == 0 ? ZC_AQ : ZC_BQ + 512 * g) + 128 * hh, kcol = MODE == 0 ? ZC_AK : ZC_BK + 128 * g, vcol = MODE == 0 ? ZC_AV : ZC_BV + 128 * g;
    const int ocol = (MODE == 0 ? 0 : 512 + 512 * g) + 128 * hh, hd = (MODE == 0 ? 0 : 4 + 4 * g) + hh;
    const int tq = t0 + 32 * qh + r; const size_t qrow = (size_t)(b * 2048 + tq);
    const LAS float* tab2 = (const LAS float*)(F.misc + MO_TAB2) + hd * 129;
    LAS unsigned char* lds = F.lds;
    bf16x8_t qf[8];
#pragma unroll
    for (int ks = 0; ks < 8; ++ks) qf[ks] = *(const bf16x8_t*)(F.Z + qrow * ZP + qcol + 16 * ks + 8 * hf);
    f32x16 oacc[4];
#pragma unroll
    for (int dt = 0; dt < 4; ++dt)
#pragma unroll
        for (int i = 0; i < 16; ++i) oacc[dt][i] = 0.f;
    float m_run = -1e30f, l_run = 0.f;
    const int tile_lo = MODE == 0 ? 0 : (t0 >= 128 ? t0 / 64 - 2 : 0), tile_hi = t0 / 64 + 1;
    const int skey = tid >> 4, sdc = tid & 15;
    v4u kreg[2], vreg[2];
    { const bf16* zr = F.Z + (size_t)(b * 2048 + 64 * tile_lo + skey) * ZP;
#pragma unroll
      for (int i = 0; i < 2; ++i) { kreg[i] = *(const v4u*)(zr + (size_t)(32 * i) * ZP + kcol + 8 * sdc); vreg[i] = *(const v4u*)(zr + (size_t)(32 * i) * ZP + vcol + 8 * sdc); } }
    const float sc2 = 0.08838834764831845f * 1.4426950408889634f;
    unsigned mwn[2] = {0xffffffffu, 0xffffffffu};
    if (MODE == 0) { mwn[0] = F.MASK[qrow * 64 + 2 * tile_lo]; mwn[1] = F.MASK[qrow * 64 + 2 * tile_lo + 1]; }
#pragma unroll 1
    for (int kt = tile_lo; kt < tile_hi; ++kt) {
        const int bf = (kt - tile_lo) & 1, s0 = 64 * kt;
        LAS unsigned char* kb = lds + FA_KOFF + bf * (64 * FA_KP); LAS unsigned char* vb = lds + FA_VOFF + bf * (64 * FA_VP);
#pragma unroll
        for (int i = 0; i < 2; ++i) { *(LAS v4u*)(kb + (skey + 32 * i) * FA_KP + 16 * sdc) = kreg[i]; *(LAS v4u*)(vb + (skey + 32 * i) * FA_VP + 16 * sdc) = vreg[i]; }
        __syncthreads();
        if (kt + 1 < tile_hi) { const bf16* zr = F.Z + (size_t)(b * 2048 + 64 * (kt + 1) + skey) * ZP;
#pragma unroll
            for (int i = 0; i < 2; ++i) { kreg[i] = *(const v4u*)(zr + (size_t)(32 * i) * ZP + kcol + 8 * sdc); vreg[i] = *(const v4u*)(zr + (size_t)(32 * i) * ZP + vcol + 8 * sdc); } }
        unsigned mw[2] = {mwn[0], mwn[1]};
        if (MODE == 0 && kt + 1 < tile_hi) { mwn[0] = F.MASK[qrow * 64 + 2 * (kt + 1)]; mwn[1] = F.MASK[qrow * 64 + 2 * (kt + 1) + 1]; }
        f32x16 sacc[2];
#pragma unroll
        for (int k2 = 0; k2 < 2; ++k2) {
#pragma unroll
            for (int i = 0; i < 16; ++i) sacc[k2][i] = 0.f;
#pragma unroll
            for (int ks = 0; ks < 8; ++ks) { const bf16x8_t kf = *(const LAS bf16x8_t*)(kb + (32 * k2 + r) * FA_KP + (16 * ks + 8 * hf) * 2);
                sacc[k2] = __builtin_amdgcn_mfma_f32_32x32x16_bf16(kf, qf[ks], sacc[k2], 0, 0, 0); }
        }
        float mx = -1e30f;
        if (MODE == 0 && s0 + 63 + 128 <= t0) {
            const float bfar = tab2[128];
#pragma unroll
            for (int k2 = 0; k2 < 2; ++k2)
#pragma unroll
                for (int i = 0; i < 16; ++i) { const int cr = (i & 3) + 8 * (i >> 2) + 4 * hf;
                    const float v = ((mw[k2] >> cr) & 1u) ? sacc[k2][i] * sc2 + bfar : -__builtin_inff();
                    sacc[k2][i] = v; mx = fmaxf(mx, v); }
        } else
#pragma unroll
        for (int k2 = 0; k2 < 2; ++k2)
#pragma unroll
            for (int i = 0; i < 16; ++i) { const int cr = (i & 3) + 8 * (i >> 2) + 4 * hf; const int dist = tq - (s0 + 32 * k2 + cr);
                bool ok; if (MODE == 0) ok = (mw[k2] >> cr) & 1u; else ok = dist >= 0 && dist < 128;
                const int di = dist < 0 ? 0 : (dist > 128 ? 128 : dist);
                float vf = sacc[k2][i] * sc2 + tab2[di];
                asm volatile("" : "+v"(vf));
                const float v = ok ? vf : -__builtin_inff();
                sacc[k2][i] = v; mx = fmaxf(mx, v); }
        { const auto sw_ = __builtin_amdgcn_permlane32_swap(__float_as_uint(mx), __float_as_uint(mx), false, false); mx = fmaxf(__uint_as_float(sw_[0]), __uint_as_float(sw_[1])); }
        const float m_new = fmaxf(m_run, mx), alpha = __builtin_amdgcn_exp2f(m_run - m_new); m_run = m_new;
        float ps = 0.f;
#pragma unroll
        for (int k2 = 0; k2 < 2; ++k2)
#pragma unroll
            for (int i = 0; i < 16; ++i) { const float p = __builtin_amdgcn_exp2f(sacc[k2][i] - m_new); sacc[k2][i] = p; ps += p; }
        l_run = l_run * alpha + ps;
        if (__ballot(alpha != 1.0f)) {
#pragma unroll
        for (int dt = 0; dt < 4; ++dt)
#pragma unroll
            for (int i = 0; i < 16; ++i) oacc[dt][i] *= alpha;
        }
#pragma unroll
        for (int k2 = 0; k2 < 2; ++k2)
#pragma unroll
            for (int s2 = 0; s2 < 2; ++s2) {
                v4u pw; pw.x = pg8::cvt_pk_bf16(sacc[k2][8 * s2 + 0], sacc[k2][8 * s2 + 1]); pw.y = pg8::cvt_pk_bf16(sacc[k2][8 * s2 + 2], sacc[k2][8 * s2 + 3]);
                pw.z = pg8::cvt_pk_bf16(sacc[k2][8 * s2 + 4], sacc[k2][8 * s2 + 5]); pw.w = pg8::cvt_pk_bf16(sacc[k2][8 * s2 + 6], sacc[k2][8 * s2 + 7]);
                const bf16x8_t pb = __builtin_bit_cast(bf16x8_t, pw);
                const int i16 = lane & 15, grp = (lane >> 4) & 1;
                const LAS unsigned char* vp = vb + (32 * k2 + 16 * s2 + 4 * hf + (i16 >> 2)) * FA_VP + (16 * grp + 4 * (i16 & 3)) * 2;
#pragma unroll
                for (int dt = 0; dt < 4; ++dt) { const s16x4 lo = fa_vtr(vp + 64 * dt), hi = fa_vtr(vp + 8 * FA_VP + 64 * dt);
                    const bf16x8_t vf = __builtin_shufflevector(lo, hi, 0, 1, 2, 3, 4, 5, 6, 7);
                    oacc[dt] = __builtin_amdgcn_mfma_f32_32x32x16_bf16(vf, pb, oacc[dt], 0, 0, 0); }
            }
    }
    float l_tot = l_run + __shfl_xor(l_run, 32);
    if (MODE == 1) l_tot += __builtin_amdgcn_exp2f(F.in[I_SINK][l * 8 + hd - 4] * 1.4426950408889634f - m_run);
    const float inv = 1.0f / l_tot;
    bf16* orow = F.OCAT + qrow * 2048 + ocol + 4 * hf;
#pragma unroll
    for (int dt = 0; dt < 4; ++dt)
#pragma unroll
        for (int gq = 0; gq < 4; ++gq) { v2u w; w.x = pk2(oacc[dt][4 * gq] * inv, oacc[dt][4 * gq + 1] * inv); w.y = pk2(oacc[dt][4 * gq + 2] * inv, oacc[dt][4 * gq + 3] * inv);
            *(v2u*)(orow + 32 * dt + 8 * gq) = w; }
    __syncthreads();
}


#define GLA_GATE_PREFIX(LDS_TOT) \
        float la[8]; \
        _Pragma("unroll") for (int i = 0; i < 8; ++i) { const v4u c0 = rc0[i], c1 = rc1[i]; float x = gb; \
            x += bflo(c0.x) * gwv[0] + bfhi(c0.x) * gwv[1] + bflo(c0.y) * gwv[2] + bfhi(c0.y) * gwv[3] + bflo(c0.z) * gwv[4] + bfhi(c0.z) * gwv[5] + bflo(c0.w) * gwv[6] + bfhi(c0.w) * gwv[7]; \
            x += bflo(c1.x) * gwv[8] + bfhi(c1.x) * gwv[9] + bflo(c1.y) * gwv[10] + bfhi(c1.y) * gwv[11] + bflo(c1.z) * gwv[12] + bfhi(c1.z) * gwv[13] + bflo(c1.w) * gwv[14] + bfhi(c1.w) * gwv[15]; \
            la[i] = (fminf(x, 0.f) - log1pf(__expf(-fabsf(x)))) * 0.0625f; } \
        _Pragma("unroll") for (int i = 1; i < 8; ++i) la[i] += la[i - 1]; \
        ((LAS float*)(L + LDS_TOT))[cg * 64 + dk] = la[7];
#define GLA_OFFSETS(LDS_TOT) \
        float off = 0.f, tot = 0.f; \
        _Pragma("unroll") for (int g2 = 0; g2 < 8; ++g2) { const float tv = ((const LAS float*)(L + LDS_TOT))[g2 * 64 + dk]; tot += tv; off += g2 < cg ? tv : 0.f; }

__device__ __forceinline__ void gla_state_phase(Frame& F, int l) {
    const int tid = F.tid, lane = F.lane, wave = F.wave, r = lane & 31, hf = lane >> 5, i16 = lane & 15, grp = (lane >> 4) & 1;
    LAS unsigned char* L = F.lds;
    constexpr int KDT = 0, VT = 9216, TOT = 29696, RP = 144, VP = 320;
    const int dk = lane, cg = wave;
    float* GCS = (float*)(F.ws + WS_GCS); float* GDEC = (float*)(F.ws + WS_GDEC);
    v4u rc0[8], rc1[8], rv[2]; unsigned short rk[8];
#define GLS_LOAD(u_) do { const int bh_ = (u_) >> 5, n_ = (u_) & 31; const size_t r0_ = (size_t)((bh_ >> 2) * 2048 + 64 * n_); const int h_ = bh_ & 3; \
        _Pragma("unroll") for (int i = 0; i < 8; ++i) { const bf16* zr = F.Z + (r0_ + 8 * cg + i) * ZP; rc0[i] = *(const v4u*)(zr + ZC_CG); rc1[i] = *(const v4u*)(zr + ZC_CG + 8); rk[i] = zr[ZC_CK + h_ * 64 + dk]; } \
        _Pragma("unroll") for (int i = 0; i < 2; ++i) rv[i] = *(const v4u*)(F.Z + (r0_ + (tid >> 4) + 32 * i) * ZP + ZC_CV + h_ * 128 + 8 * (tid & 15)); } while (0)
    int u = F.vcu;
    if (u < 2048) GLS_LOAD(u);
    for (; u < 2048; u += F.G) {
        const int h = (u >> 5) & 3;
        float gwv[16];
#pragma unroll
        for (int q = 0; q < 16; ++q) gwv[q] = F.in[I_CGW][(size_t)l * 4096 + q * 256 + h * 64 + dk];
        const float gb = F.in[I_CGB][l * 256 + h * 64 + dk];
        GLA_GATE_PREFIX(TOT)
        float kv[8];
#pragma unroll
        for (int i = 0; i < 8; ++i) kv[i] = bf1(rk[i]);
#pragma unroll
        for (int i = 0; i < 2; ++i) *(LAS v4u*)(L + VT + ((tid >> 4) + 32 * i) * VP + 16 * (tid & 15)) = rv[i];
        __syncthreads();
        GLA_OFFSETS(TOT)
        { float kd[8];
#pragma unroll
          for (int i = 0; i < 8; ++i) kd[i] = kv[i] * __expf(tot - (off + la[i]));
          v4u w; w.x = pk2(kd[0], kd[1]); w.y = pk2(kd[2], kd[3]); w.z = pk2(kd[4], kd[5]); w.w = pk2(kd[6], kd[7]); *(LAS v4u*)(L + KDT + dk * RP + 16 * cg) = w; }
        if (cg == 0) GDEC[(size_t)u * 64 + dk] = __expf(tot);
        __syncthreads();
        if (u + F.G < 2048) GLS_LOAD(u + F.G);
        { const int dkt = wave >> 2, dvt = wave & 3;
          f32x16 cs;
#pragma unroll
          for (int i = 0; i < 16; ++i) cs[i] = 0.f;
#pragma unroll
          for (int ks = 0; ks < 4; ++ks) { const bf16x8_t a = *(const LAS bf16x8_t*)(L + KDT + (32 * dkt + r) * RP + (16 * ks + 8 * hf) * 2);
              const LAS unsigned char* vp = L + VT + (16 * ks + 8 * hf + (i16 >> 2)) * VP + (32 * dvt + 16 * grp + 4 * (i16 & 3)) * 2;
              const s16x4 lo = fa_vtr(vp), hi = fa_vtr(vp + 4 * VP);
              cs = __builtin_amdgcn_mfma_f32_32x32x16_bf16(a, __builtin_shufflevector(lo, hi, 0, 1, 2, 3, 4, 5, 6, 7), cs, 0, 0, 0); }
          float* gp = GCS + (size_t)u * 8192 + (size_t)(32 * dkt + 4 * hf) * 128 + 32 * dvt + r;
#pragma unroll
          for (int i = 0; i < 16; ++i) gp[((i & 3) + 8 * (i >> 2)) * 128] = cs[i]; }
        __syncthreads();
    }
#undef GLS_LOAD
}

__device__ __forceinline__ void gla_scan_phase(Frame& F) {
    float* GCS = (float*)(F.ws + WS_GCS); const float* GDEC = (const float*)(F.ws + WS_GDEC);
    for (int gt = F.gw * 64 + F.lane; gt < 64 * 2048; gt += F.NGW * 64) {
        const int bh = gt >> 11, e4 = gt & 2047, dk = e4 >> 5;
        f32x4* p = (f32x4*)(GCS + (size_t)bh * 32 * 8192) + e4; const float* dp = GDEC + (size_t)bh * 32 * 64 + dk;
        f32x4 st = (f32x4){0.f, 0.f, 0.f, 0.f};
#pragma unroll 1
        for (int n0 = 0; n0 < 32; n0 += 8) {
            f32x4 cs[8]; float dc[8];
#pragma unroll
            for (int j = 0; j < 8; ++j) { cs[j] = p[(size_t)(n0 + j) * 2048]; dc[j] = dp[(n0 + j) * 64]; }
#pragma unroll
            for (int j = 0; j < 8; ++j) { p[(size_t)(n0 + j) * 2048] = st; st = st * dc[j] + cs[j]; }
        }
    }
}

__device__ __forceinline__ void gla_out_phase(Frame& F, int l) {
    const int tid = F.tid, lane = F.lane, wave = F.wave, r = lane & 31, hf = lane >> 5, i16 = lane & 15, grp = (lane >> 4) & 1;
    LAS unsigned char* L = F.lds;
    constexpr int QG = 0, KG = 9216, VT = 18432, PT = 38912, TOT = 59392, OT = 61440, RP = 144, VP = 320, OP = 132;
    const int dk = lane, cg = wave;
    const float* GCS = (const float*)(F.ws + WS_GCS);
    v4u rc0[8], rc1[8], rv[2]; unsigned short rq[8], rk[8]; unsigned rg[8]; f32x4 rp[4];
#define GLO_LOAD(u_) do { const int bh_ = (u_) >> 5, n_ = (u_) & 31; const size_t r0_ = (size_t)((bh_ >> 2) * 2048 + 64 * n_); const int h_ = bh_ & 3; \
        _Pragma("unroll") for (int i = 0; i < 8; ++i) { const bf16* zr = F.Z + (r0_ + 8 * cg + i) * ZP; rc0[i] = *(const v4u*)(zr + ZC_CG); rc1[i] = *(const v4u*)(zr + ZC_CG + 8); rq[i] = zr[ZC_CQ + h_ * 64 + dk]; rk[i] = zr[ZC_CK + h_ * 64 + dk]; \
            rg[i] = *(const unsigned*)(zr + ZC_CR + h_ * 128 + 2 * lane); } \
        _Pragma("unroll") for (int i = 0; i < 2; ++i) rv[i] = *(const v4u*)(F.Z + (r0_ + (tid >> 4) + 32 * i) * ZP + ZC_CV + h_ * 128 + 8 * (tid & 15)); \
        _Pragma("unroll") for (int i = 0; i < 4; ++i) rp[i] = *(const f32x4*)(GCS + (size_t)(u_) * 8192 + (size_t)(tid >> 3) * 128 + 16 * (tid & 7) + 4 * i); } while (0)
    int u = F.vcu;
    if (u < 2048) GLO_LOAD(u);
    const float g0 = F.in[I_CNG][l * 128 + 2 * lane], g1 = F.in[I_CNG][l * 128 + 2 * lane + 1];
    for (; u < 2048; u += F.G) {
        const int bh = u >> 5, n = u & 31, h = bh & 3; const size_t row0 = (size_t)((bh >> 2) * 2048 + 64 * n);
        float gwv[16];
#pragma unroll
        for (int q = 0; q < 16; ++q) gwv[q] = F.in[I_CGW][(size_t)l * 4096 + q * 256 + h * 64 + dk];
        const float gb = F.in[I_CGB][l * 256 + h * 64 + dk];
        GLA_GATE_PREFIX(TOT)
        float qv[8], kv[8]; unsigned gr[8];
#pragma unroll
        for (int i = 0; i < 8; ++i) { qv[i] = bf1(rq[i]); kv[i] = bf1(rk[i]); gr[i] = rg[i]; }
#pragma unroll
        for (int i = 0; i < 2; ++i) *(LAS v4u*)(L + VT + ((tid >> 4) + 32 * i) * VP + 16 * (tid & 15)) = rv[i];
        { v4u w0, w1; w0.x = pk2(rp[0].x, rp[0].y); w0.y = pk2(rp[0].z, rp[0].w); w0.z = pk2(rp[1].x, rp[1].y); w0.w = pk2(rp[1].z, rp[1].w);
          w1.x = pk2(rp[2].x, rp[2].y); w1.y = pk2(rp[2].z, rp[2].w); w1.z = pk2(rp[3].x, rp[3].y); w1.w = pk2(rp[3].z, rp[3].w);
          *(LAS v4u*)(L + PT + (tid >> 3) * VP + 32 * (tid & 7)) = w0; *(LAS v4u*)(L + PT + (tid >> 3) * VP + 32 * (tid & 7) + 16) = w1; }
        __syncthreads();
        GLA_OFFSETS(TOT)
#pragma unroll
        for (int i = 0; i < 8; ++i) { const float bi = off + la[i];
            *(LAS bf16*)(L + QG + (8 * cg + i) * RP + 2 * dk) = (bf16)f2bf(qv[i] * 0.125f * __expf(bi));
            *(LAS bf16*)(L + KG + (8 * cg + i) * RP + 2 * dk) = (bf16)f2bf(kv[i] * __expf(-bi)); }
        __syncthreads();
        if (u + F.G < 2048) GLO_LOAD(u + F.G);
        { const int ct = wave >> 2, dvt = wave & 3;
          f32x16 o;
#pragma unroll
          for (int i = 0; i < 16; ++i) o[i] = 0.f;
#pragma unroll
          for (int st = 0; st < 2; ++st) if (st <= ct) {
              f32x16 at;
#pragma unroll
              for (int i = 0; i < 16; ++i) at[i] = 0.f;
#pragma unroll
              for (int ks = 0; ks < 4; ++ks) { const bf16x8_t a = *(const LAS bf16x8_t*)(L + KG + (32 * st + r) * RP + (16 * ks + 8 * hf) * 2), bq = *(const LAS bf16x8_t*)(L + QG + (32 * ct + r) * RP + (16 * ks + 8 * hf) * 2);
                  at = __builtin_amdgcn_mfma_f32_32x32x16_bf16(a, bq, at, 0, 0, 0); }
              if (st == ct) {
#pragma unroll
                  for (int i = 0; i < 16; ++i) { const int cr = (i & 3) + 8 * (i >> 2) + 4 * hf; at[i] = cr <= r ? at[i] : 0.f; } }
#pragma unroll
              for (int s2 = 0; s2 < 2; ++s2) {
                  v4u pw; pw.x = pg8::cvt_pk_bf16(at[8 * s2 + 0], at[8 * s2 + 1]); pw.y = pg8::cvt_pk_bf16(at[8 * s2 + 2], at[8 * s2 + 3]); pw.z = pg8::cvt_pk_bf16(at[8 * s2 + 4], at[8 * s2 + 5]); pw.w = pg8::cvt_pk_bf16(at[8 * s2 + 6], at[8 * s2 + 7]);
                  const LAS unsigned char* vp = L + VT + (32 * st + 16 * s2 + 4 * hf + (i16 >> 2)) * VP + (32 * dvt + 16 * grp + 4 * (i16 & 3)) * 2;
                  const s16x4 lo = fa_vtr(vp), hi = fa_vtr(vp + 8 * VP);
                  o = __builtin_amdgcn_mfma_f32_32x32x16_bf16(__builtin_bit_cast(bf16x8_t, pw), __builtin_shufflevector(lo, hi, 0, 1, 2, 3, 4, 5, 6, 7), o, 0, 0, 0);
              }
          }
#pragma unroll
          for (int ks = 0; ks < 4; ++ks) { const bf16x8_t a = *(const LAS bf16x8_t*)(L + QG + (32 * ct + r) * RP + (16 * ks + 8 * hf) * 2);
              const LAS unsigned char* pp = L + PT + (16 * ks + 8 * hf + (i16 >> 2)) * VP + (32 * dvt + 16 * grp + 4 * (i16 & 3)) * 2;
              const s16x4 lo = fa_vtr(pp), hi = fa_vtr(pp + 4 * VP);
              o = __builtin_amdgcn_mfma_f32_32x32x16_bf16(a, __builtin_shufflevector(lo, hi, 0, 1, 2, 3, 4, 5, 6, 7), o, 0, 0, 0); }
          LAS float* op = (LAS float*)(L + OT) + (32 * ct + 4 * hf) * OP + 32 * dvt + r;
#pragma unroll
          for (int i = 0; i < 16; ++i) op[((i & 3) + 8 * (i >> 2)) * OP] = o[i]; }
        __syncthreads();
        { float a[8], c[8], ss[8];
#pragma unroll
          for (int i = 0; i < 8; ++i) { const LAS float* orow = (const LAS float*)(L + OT) + (8 * wave + i) * OP + 2 * lane; a[i] = orow[0]; c[i] = orow[1]; ss[i] = a[i] * a[i] + c[i] * c[i]; }
#pragma unroll
          for (int o2 = 1; o2 < 64; o2 <<= 1) {
#pragma unroll
              for (int i = 0; i < 8; ++i) ss[i] += __shfl_xor(ss[i], o2); }
#pragma unroll
          for (int i = 0; i < 8; ++i) { const float rstd = rsqrtf(ss[i] * (1.0f / 128.0f) + EPS);
              *(unsigned*)(F.OCAT + (row0 + 8 * wave + i) * 2048 + 1536 + h * 128 + 2 * lane) = pk2(a[i] * rstd * g0 * bflo(gr[i]), c[i] * rstd * g1 * bfhi(gr[i])); } }
        __syncthreads();
    }
#undef GLO_LOAD
}
#undef GLA_GATE_PREFIX
#undef GLA_OFFSETS

__device__ __forceinline__ bool in_phase(int k, int lo, int hi) { asm volatile("" : "+s"(k)); return lo <= k && k < hi; }
#define IN(k) in_phase((k), lo, hi)
#define PHASE_LANE() do { int _tz = threadIdx.x; asm volatile("" : "+v"(_tz)); F.tid = _tz; F.lane = _tz & 63; } while (0)
#define SEAM(k) do { if (IN(k) && IN((k) + 1)) xcd_barrier(bar); } while (0)
template <int l>
__device__ __forceinline__ void layer_body(Frame& F, const XcdBarrier& bar, const int lo, const int hi) {
    constexpr int pb = 1 + 11 * l;
        if (IN(pb + 0)) {
            { pg8::Gemm g{F.XN, (const bf16*)(F.ws + WS_WIN + l * WIN_L + 24 * MiB), T, 1792, D}; pg8::StaticOrder S; S.init(T, 1792, D, F.G, (int)blockIdx.x);
              pg8::EpiInProj<1> E{F.Z, F.ws + WS_GT, (LAS unsigned long long*)(F.misc + MO_SS), (const LAS float*)(F.misc + MO_GN) + l * 512};
              pg8::gemm_phase<pg8::EpiInProj<1>, pg8::StaticOrder, true, false>(F.lds, g, S, E); }
            { pg8::Gemm g{(const bf16*)(F.ws + WS_XN8), (const bf16*)(F.ws + WS_WIN + l * WIN_L), T, 9472, D / 2}; pg8::StaticOrder S; S.init(T, 9472, D / 2, F.G, ((int)blockIdx.x + F.G / 2) % F.G);
              pg8::EpiInProj<0> E{F.Z, F.ws + WS_GT, (LAS unsigned long long*)(F.misc + MO_SS), (const LAS float*)(F.misc + MO_GN) + l * 512};
              pg8::gemm_phase<pg8::EpiInProj<0>, pg8::StaticOrder, true, true>(F.lds, g, S, E); }
        }
        SEAM(pb + 0);
        if (IN(pb + 1)) { PHASE_LANE();
            if (F.wave & 4) convert_moe(F, l, 0, 4, 40960);
            for (int it = F.gw; it < NB * 128; it += F.NGW) {
                const int b = it >> 7, j = it & 127;
                indexer_segment(F, b, j, 0, j < 64 ? j + 1 : 64);
                if (j < 64) indexer_segment(F, b, 127 - j, 64, 128 - j);
            }
            if (!(F.wave & 4)) convert_moe(F, l, 0, 4, 40960);
            PHASE_LANE();
            gla_state_phase(F, l);
        }
        SEAM(pb + 1);
        if (IN(pb + 2)) { PHASE_LANE();
            if (F.wave & 4) convert_moe(F, l, 1, 4, 0);
            for (int row = F.gw; row < T; row += F.NGW) {
                const int t = row & 2047;
                if (t < 256) { const int nb = t + 1 - 32 * F.lane; F.MASK[(size_t)row * 64 + F.lane] = nb >= 32 ? 0xffffffffu : (nb <= 0 ? 0u : ((1u << nb) - 1u)); continue; }
                float val[32];
#pragma unroll
                for (int j = 0; j < 32; ++j) { const int s_ = 64 * j + F.lane; val[j] = F.S[(size_t)row * 2048 + (s_ < t ? s_ : t)]; }
                float vmx = -3.0e38f, vmn = 3.0e38f;
#pragma unroll
                for (int j = 0; j < 32; ++j) { const bool ok = 64 * j + F.lane <= t; val[j] = ok ? val[j] : -3.0e38f; vmx = fmaxf(vmx, val[j]); vmn = fminf(vmn, ok ? val[j] : 3.0e38f); }
#pragma unroll
                for (int o = 1; o < 64; o <<= 1) { vmx = fmaxf(vmx, __shfl_xor(vmx, o)); vmn = fminf(vmn, __shfl_xor(vmn, o)); }
                float lo = vmn, hi = vmx, thf = 0.f; bool exact = false;
#pragma unroll 1
                for (int it = 0; it < 28; ++it) { const float mid = 0.5f * (lo + hi); if (!(mid > lo && mid < hi)) break; int cnt = 0;
#pragma unroll
                    for (int j = 0; j < 32; ++j) cnt += __popcll(__ballot(val[j] >= mid));
                    if (cnt == 256) { exact = true; thf = mid; break; }
                    if (cnt > 256) lo = mid; else hi = mid; }
                unsigned th = 0u; int need = 0;
#define KEYOF(x) ({ const unsigned u_ = __float_as_uint(x); (u_ & 0x80000000u) ? ~u_ : (u_ | 0x80000000u); })
                if (!exact) {
#pragma unroll 1
                    for (int bit = 31; bit >= 0; --bit) { const unsigned cand = th | (1u << bit); int cnt = 0;
#pragma unroll
                        for (int j = 0; j < 32; ++j) cnt += __popcll(__ballot(KEYOF(val[j]) >= cand));
                        if (cnt >= 256) th = cand; }
                    int cgt = 0;
#pragma unroll
                    for (int j = 0; j < 32; ++j) cgt += __popcll(__ballot(KEYOF(val[j]) > th));
                    need = 256 - cgt;
                }
                int run = 0; unsigned myword = 0u;
#pragma unroll
                for (int j = 0; j < 32; ++j) {
                    bool sel;
                    if (exact) sel = val[j] >= thf;
                    else { const unsigned kj = KEYOF(val[j]); const bool eq = kj == th; const unsigned long long eqm = __ballot(eq);
                        const int pre = run + __popcll(eqm & ((1ull << F.lane) - 1ull)); sel = (kj > th) || (eq && pre < need); run += __popcll(eqm); sel = sel && (64 * j + F.lane <= t); }
                    const unsigned long long sm = __ballot(sel);
                    if ((F.lane >> 1) == j) myword = (F.lane & 1) ? (unsigned)(sm >> 32) : (unsigned)sm;
                }
#undef KEYOF
                F.MASK[(size_t)row * 64 + F.lane] = myword;
            }
            if (!(F.wave & 4)) convert_moe(F, l, 1, 4, 0);
            gla_scan_phase(F);
        }
        SEAM(pb + 2);
        if (IN(pb + 3)) { PHASE_LANE();
            if (F.vcu & 1) { convert_moe(F, l, 1, 2, 0); __syncthreads(); PHASE_LANE(); }
            for (int u = F.vcu; u < NB * 16; u += F.G) { const int b = u >> 4, p = u & 15; flash_unit<0>(F, l, b, 0, 64 * (31 - p)); flash_unit<0>(F, l, b, 0, 64 * p); }
            for (int u = F.vcu; u < NB * 2 * 32; u += F.G) { const int b = u >> 6, g = (u >> 5) & 1, qb = u & 31; flash_unit<1>(F, l, b, g, 64 * qb); }
            gla_out_phase(F, l);
            if (!(F.vcu & 1)) { PHASE_LANE(); convert_moe(F, l, 1, 2, 0); }
        }
        SEAM(pb + 3);
        if (IN(pb + 4)) {
            pg8::Gemm g{F.OCAT, (const bf16*)(F.ws + WS_WBR + l * WBR_L), T, D, D}; pg8::MergeOrder S; S.init(T, D, D, F.G, (int)blockIdx.x);
#ifdef PROBE_MERGE
            { pg8::EpiMergeT<PROBE_MERGE> E{F.ws + WS_GT, (bf16*)(F.ws + WS_S)}; pg8::gemm_phase<pg8::EpiMergeT<PROBE_MERGE>, pg8::MergeOrder, true>(F.lds, g, S, E); }
#endif
            pg8::EpiMerge E{F.ws + WS_GT, F.MERGED};
            pg8::gemm_phase<pg8::EpiMerge, pg8::MergeOrder, true>(F.lds, g, S, E);
        }
        SEAM(pb + 4);
        if (IN(pb + 5)) {
            pg8::Gemm g{F.MERGED, (const bf16*)(F.ws + WS_WO + l * WO_L), T, D, D}; pg8::StaticOrder S; S.init(T, D, D, F.G, (int)blockIdx.x);
            pg8::EpiResid<(l > 0)> E{F.in[I_X], (bf16*)(F.ws + WS_HB), (unsigned char*)F.XN, F.in[I_N2G] + l * D};
            pg8::gemm_phase<pg8::EpiResid<(l > 0)>, pg8::StaticOrder, true>(F.lds, g, S, E);
        }
        SEAM(pb + 5);
        if (IN(pb + 6)) { PHASE_LANE();
            unsigned* cnt = F.ctl + CW_CNT + 64 * l;
            const int lane = F.lane, fr = lane & 15, fq = lane >> 4;
            LAS float* LG = (LAS float*)(F.lds + F.wave * 8192);
            const bf16* wrh = (const bf16*)(F.ws + WS_WRH + l * WR_L) + (size_t)fr * 2048 + 8 * fq; const bf16* wrl = (const bf16*)(F.ws + WS_WRL + l * WR_L) + (size_t)fr * 2048 + 8 * fq;
            for (int tile = F.gw; tile < T / 16; tile += F.NGW) {
                const bf16* hrow = (const bf16*)(F.ws + WS_HB) + (size_t)(16 * tile + fr) * D + 8 * fq;
                f32x4 acc[6];
#pragma unroll
                for (int nt = 0; nt < 6; ++nt) acc[nt] = (f32x4){0.f, 0.f, 0.f, 0.f};
                float ss = 0.f;
#pragma unroll 2
                for (int ks = 0; ks < 64; ++ks) {
                    const v4u hw = *(const v4u*)(hrow + 32 * ks);
                    { const float a0 = bflo(hw.x), a1 = bfhi(hw.x), a2 = bflo(hw.y), a3 = bfhi(hw.y), a4 = bflo(hw.z), a5 = bfhi(hw.z), a6 = bflo(hw.w), a7 = bfhi(hw.w);
                      ss += (a0 * a0 + a1 * a1) + (a2 * a2 + a3 * a3) + (a4 * a4 + a5 * a5) + (a6 * a6 + a7 * a7); }
                    const bf16x8_t ah = __builtin_bit_cast(bf16x8_t, hw);
#pragma unroll
                    for (int nt = 0; nt < 6; ++nt) { const bf16x8_t bh = *(const bf16x8_t*)(wrh + (size_t)(16 * nt) * 2048 + 32 * ks), bl = *(const bf16x8_t*)(wrl + (size_t)(16 * nt) * 2048 + 32 * ks);
                        acc[nt] = __builtin_amdgcn_mfma_f32_16x16x32_bf16(ah, bh, acc[nt], 0, 0, 0);
                        acc[nt] = __builtin_amdgcn_mfma_f32_16x16x32_bf16(ah, bl, acc[nt], 0, 0, 0); }
                }
                ss += __shfl_xor(ss, 16); ss += __shfl_xor(ss, 32);
                if (fq == 0) { const float rs_ = rsqrtf(ss * (1.0f / 2048.0f) + EPS); LG[1600 + fr] = rs_; ((float*)(F.ws + WS_RSTD))[16 * tile + fr] = rs_; }
#pragma unroll
                for (int nt = 0; nt < 6; ++nt)
#pragma unroll
                    for (int i = 0; i < 4; ++i) LG[(4 * fq + i) * 100 + 16 * nt + fr] = acc[nt][i];
                LDS_WAIT(); asm volatile("" ::: "memory");
                if (lane < 16) {
                    const int row = 16 * tile + lane; const float rstd = LG[1600 + lane]; const LAS float* lr = LG + lane * 100;
                    float lg[8]; int grp = 0; float gmax = -3.0e38f;
#pragma unroll
                    for (int e = 0; e < 8; ++e) { lg[e] = lr[e] * rstd + F.in[I_BRG][l * 8 + e]; if (lg[e] > gmax) { gmax = lg[e]; grp = e; } }
                    float gden = 0.f;
#pragma unroll
                    for (int e = 0; e < 8; ++e) gden += __expf(lg[e] - gmax);
                    const float gwt = 1.0f / gden;
                    int i0 = 0, i1 = 0; float m0 = -3.0e38f, m1 = -3.0e38f;
#pragma unroll
                    for (int e = 0; e < 8; ++e) { const float v = lr[8 + grp * 8 + e] * rstd + F.in[I_BRE][l * 64 + grp * 8 + e];
                        if (v > m0) { m1 = m0; i1 = i0; m0 = v; i0 = e; } else if (v > m1) { m1 = v; i1 = e; } }
                    const float e1 = __expf(m1 - m0); const float p0 = 1.0f / (1.0f + e1), p1 = e1 / (1.0f + e1);
                    const int ex0 = grp * 8 + i0, ex1 = grp * 8 + i1;
                    const unsigned r0 = atomicAdd(&cnt[ex0], 1u), r1 = atomicAdd(&cnt[ex1], 1u);
                    unsigned* rec = (unsigned*)(F.ws + WS_ROUTE) + (size_t)row * 8;
                    rec[0] = (unsigned)ex0; rec[1] = r0; rec[2] = (unsigned)ex1; rec[3] = r1; rec[4] = __float_as_uint(gwt * p0); rec[5] = __float_as_uint(gwt * p1);
                    int* liste = (int*)(F.ws + WS_LISTE); liste[(size_t)ex0 * 32768 + r0] = row; liste[(size_t)ex1 * 32768 + r1] = row;
                }
                LDS_WAIT(); asm volatile("" ::: "memory");
            }
        }
        SEAM(pb + 6);
        if (IN(pb + 7) || IN(pb + 8) || IN(pb + 9) || IN(pb + 10)) { PHASE_LANE();
            if (F.tid == 0) { const unsigned* cnt = F.ctl + CW_CNT + 64 * l; LAS int* texp = (LAS int*)(F.misc + MO_TEXP); LAS int* pst = (LAS int*)(F.misc + MO_PST); int tb = 0;
                for (int e = 0; e < NEXP; ++e) { const int c = (int)__hip_atomic_load(&cnt[e], __ATOMIC_RELAXED, __HIP_MEMORY_SCOPE_AGENT); const int nt_ = (c + 255) >> 8; pst[e] = tb * 256; ((LAS int*)(F.misc + MO_CNT))[e] = c;
                    for (int r = 0; r < nt_; ++r) texp[tb + r] = e; tb += nt_; }
                *(LAS int*)(F.misc + MO_TOT) = tb; }
            __syncthreads();
        }
        if (IN(pb + 8)) {
            pg8::Gemm g{F.XN, (const bf16*)(F.ws + WS_W13), 0, 0, D / 2};
            pg8::MoeGatherOrder S; S.total = *(const LAS int*)(F.misc + MO_TOT) * 4; S.G = F.G; S.c = F.vcu; S.NJ = 4; S.nt0 = D / 128; S.tile_exp = (const LAS int*)(F.misc + MO_TEXP);
            S.pst = (const LAS int*)(F.misc + MO_PST); S.cnt = (const LAS int*)(F.misc + MO_CNT); S.liste = (const int*)(F.ws + WS_LISTE);
            pg8::EpiGlu E{F.H, S.tile_exp, S.pst, S.cnt, S.liste, (const float*)(F.ws + WS_RSTD)};
            pg8::gemm_phase<pg8::EpiGlu, pg8::MoeGatherOrder, true, true>(F.lds, g, S, E);
        }
        SEAM(pb + 8);
        if (IN(pb + 9)) {
            pg8::Gemm g{F.H, (const bf16*)(F.ws + WS_W2), 0, 0, DEXP / 2};
            pg8::MoeOrder S{*(const LAS int*)(F.misc + MO_TOT) * 8, F.G, F.vcu, 8, DEXP / 128, (const LAS int*)(F.misc + MO_TEXP)};
            pg8::EpiY E{(unsigned char*)F.Y};
            pg8::gemm_phase<pg8::EpiY, pg8::MoeOrder, true, true>(F.lds, g, S, E);
        }
        SEAM(pb + 9);
        if (IN(pb + 10)) { PHASE_LANE();
            for (int row = F.gw; row < T; row += F.NGW) {
                const unsigned* rec = (const unsigned*)(F.ws + WS_ROUTE) + (size_t)row * 8;
                const float w0 = __uint_as_float(rec[4]) * 0.03125f, w1 = __uint_as_float(rec[5]) * 0.03125f;
                const LAS int* pst = (const LAS int*)(F.misc + MO_PST); const int p0 = pst[rec[0]] + (int)rec[1], p1 = pst[rec[2]] + (int)rec[3];
                const unsigned* y0 = (const unsigned*)((const unsigned char*)F.Y + (size_t)p0 * D) + F.lane; const unsigned* y1 = (const unsigned*)((const unsigned char*)F.Y + (size_t)p1 * D) + F.lane;
                f32x4 v[8];
                { const v2u* hr = (const v2u*)((const bf16*)(F.ws + WS_HB) + (size_t)row * D) + F.lane;
#pragma unroll
                  for (int j = 0; j < 8; ++j) { const v2u w = hr[64 * j]; v[j] = (f32x4){bflo(w.x), bfhi(w.x), bflo(w.y), bfhi(w.y)}; } }
#pragma unroll
                for (int j = 0; j < 8; ++j) { const int a = (int)y0[64 * j], c = (int)y1[64 * j];
                    const auto a01 = __builtin_amdgcn_cvt_pk_f32_fp8(a, false), a23 = __builtin_amdgcn_cvt_pk_f32_fp8(a, true), c01 = __builtin_amdgcn_cvt_pk_f32_fp8(c, false), c23 = __builtin_amdgcn_cvt_pk_f32_fp8(c, true);
                    v[j].x += w0 * a01[0] + w1 * c01[0]; v[j].y += w0 * a01[1] + w1 * c01[1]; v[j].z += w0 * a23[0] + w1 * c23[0]; v[j].w += w0 * a23[1] + w1 * c23[1]; }
                if (l + 1 < DEPTH) { v2u* hw_ = (v2u*)((bf16*)(F.ws + WS_HB) + (size_t)row * D) + F.lane;
#pragma unroll
                    for (int j = 0; j < 8; ++j) hw_[64 * j] = (v2u){pg8::cvt_pk_bf16(v[j].x, v[j].y), pg8::cvt_pk_bf16(v[j].z, v[j].w)}; }
                else { f32x4* orow = (f32x4*)(F.out + (size_t)row * D) + F.lane;
#pragma unroll
                    for (int j = 0; j < 8; ++j) orow[64 * j] = v[j]; }
                if (l + 1 < DEPTH) { const float rstd = row_rstd(v); norm_store_bf16(v, rstd, F.in[I_N1G] + (l + 1) * D, F.XN + (size_t)row * D, F.lane); norm_store_fp8(v, rstd, F.in[I_N1G] + (l + 1) * D, (unsigned char*)(F.ws + WS_XN8) + (size_t)row * D, F.lane); }
            }
        }
        SEAM(pb + 10);
    }
__global__ void __launch_bounds__(NWAVES * 64, 2) fwd_kernel(Args args) {
    extern __shared__ __attribute__((aligned(16))) unsigned char lds_raw[];
    Frame F;
    F.lds = (LAS unsigned char*)lds_raw; F.misc = F.lds + MISC_OFF;
    F.tid = threadIdx.x; F.lane = F.tid & 63; F.wave = __builtin_amdgcn_readfirstlane(F.tid >> 6);
    F.G = gridDim.x; { const int bx = blockIdx.x; F.vcu = (F.G % 8 == 0) ? (bx % 8) * (F.G / 8) + bx / 8 : bx; }
    F.gw = F.vcu * NWAVES + F.wave; F.NGW = F.G * NWAVES;
    F.in = args.in; F.out = args.out; F.ws = args.ws; F.ctl = (unsigned*)(args.ws + WS_CTL);
    F.Z = (bf16*)(args.ws + WS_Z); F.XN = (bf16*)(args.ws + WS_XN); F.OCAT = (bf16*)(args.ws + WS_OCAT); F.MERGED = (bf16*)(args.ws + WS_MERGED);
    F.XS = (bf16*)(args.ws + WS_XS); F.Y = (bf16*)(args.ws + WS_Y); F.H = (bf16*)(args.ws + WS_H);
    F.S = (float*)(args.ws + WS_S); F.GO = (float*)(args.ws + WS_GO); F.MASK = (unsigned*)(args.ws + WS_MASK);
    const int lo = args.ph_lo, hi = args.ph_hi;
    const bool use_bar = (hi - lo) > 1;
    for (int u = F.tid; u < 64; u += NWAVES * 64) ((LAS unsigned*)F.misc)[u] = 0u;
    ((LAS unsigned long long*)(F.misc + MO_SS))[F.tid] = 0ull;
    for (int i = F.tid; i < 2 * 4 * 128; i += NWAVES * 64) { const int l_ = i >> 9, k_ = (i >> 7) & 3, d_ = i & 127; ((LAS float*)(F.misc + MO_GN))[i] = F.in[k_ == 0 ? I_AQG : (k_ == 1 ? I_AKG : (k_ == 2 ? I_BQG : I_BKG))][l_ * 128 + d_]; }
    for (int i = F.tid; i < 12 * 129; i += NWAVES * 64) { const int hd = i / 129, dd = i % 129; int bk;
        if (dd < 16) bk = dd; else { bk = 16 + (int)(logf((float)dd / 16.0f) / 2.0794415416798357f * 16.0f); bk = bk > 31 ? 31 : bk; }
        ((LAS float*)(F.misc + MO_TAB2))[i] = F.in[I_RELB][bk * 12 + hd] * 1.4426950408889634f; }
    __syncthreads();
    XcdBarrier bar; bar.bar = F.ctl + CW_BAR; bar.x = 0; bar.st = nullptr;
    if (use_bar) bar = xcd_barrier_post(F.ctl + CW_BAR, (volatile LAS unsigned*)(F.misc + MO_BARW));

    if (IN(0)) { PHASE_LANE();
        LAS float* scr = (LAS float*)(F.lds + F.wave * 16384);
        constexpr int I_IN = (2048 / 64) * (D_IN / 32);
        constexpr int I_BA = (512 / 64) * (2048 / 32), I_BB = (1024 / 64) * (2048 / 32), I_BC = I_BA, I_O = (2048 / 64) * (2048 / 32);
        constexpr int PER_L = I_IN + I_BA + I_BB + I_BC + I_O;
        for (int it = F.gw; it < DEPTH * PER_L; it += F.NGW) {
            const int l = it / PER_L; int r = it % PER_L;
            bf16* win = (bf16*)(F.ws + WS_WIN + l * WIN_L); bf16* wbr = (bf16*)(F.ws + WS_WBR + l * WBR_L); bf16* wo = (bf16*)(F.ws + WS_WO + l * WO_L);
            if (r < I_IN) { const int nb_ = r % (D_IN / 32);
                const bool has8 = nb_ < 56 || (nb_ >= 58 && nb_ <= 106) || nb_ >= 155, hasb = (nb_ >= 56 && nb_ <= 58) || (nb_ >= 106 && nb_ < 155);
                if (has8) transpose_item_fp8(F.in[I_WIN] + (size_t)l * 2048 * D_IN, D_IN, (unsigned char*)win, 2048, 64.0f, scr, r, F.lane, MapWin8{});
                if (hasb) transpose_item(F.in[I_WIN] + (size_t)l * 2048 * D_IN, D_IN, win + (size_t)12 * 1024 * 1024, 2048, 0, scr, r, F.lane, MapWinB{});
                continue; } r -= I_IN;
            if (r < I_BA) { transpose_item(F.in[I_WBA] + (size_t)l * 512 * 2048, 2048, wbr, 2048, 0, scr, r, F.lane, MapId{0}); continue; } r -= I_BA;
            if (r < I_BB) { transpose_item(F.in[I_WBB] + (size_t)l * 1024 * 2048, 2048, wbr, 2048, 512, scr, r, F.lane, MapId{0}); continue; } r -= I_BB;
            if (r < I_BC) { transpose_item(F.in[I_WBC] + (size_t)l * 512 * 2048, 2048, wbr, 2048, 1536, scr, r, F.lane, MapId{0}); continue; } r -= I_BC;
            transpose_item(F.in[I_WO] + (size_t)l * 2048 * 2048, 2048, wo, 2048, 0, scr, r, F.lane, MapId{0});
        }
        for (int i = F.gw * 64 + F.lane; i < DEPTH * 160 * 256; i += F.NGW * 64) { const int l = i / (160 * 256), r = (i / 256) % 160, c = i % 256;
            *(v4u*)((bf16*)(F.ws + WS_WIN + l * WIN_L) + (size_t)12 * 1024 * 1024 + (size_t)(ZC_PAD - 3328 + r) * 2048 + 8 * c) = (v4u){0u, 0u, 0u, 0u}; }
        for (int i = F.gw * 64 + F.lane; i < DEPTH * 96 * 2048; i += F.NGW * 64) { const int l = i / (96 * 2048), e = (i / 2048) % 96, k = i % 2048;
            float val = 0.f; if (e < 8) val = F.in[I_WRG][(size_t)l * D * 8 + (size_t)k * 8 + e]; else if (e < 72) val = F.in[I_WRE][(size_t)l * D * 64 + (size_t)k * 64 + (e - 8)];
            val *= F.in[I_N2G][l * D + k];
            const unsigned hi = f2bf(val); const float rem = val - bf1((bf16)hi);
            ((bf16*)(F.ws + WS_WRH + l * WR_L))[e * 2048 + k] = (bf16)hi; ((bf16*)(F.ws + WS_WRL + l * WR_L))[e * 2048 + k] = (bf16)f2bf(rem); }
        for (int mrow = F.gw; mrow < T; mrow += F.NGW) { f32x4 v[8]; load_row(F.in[I_X] + (size_t)mrow * D, F.lane, v); const float rstd = row_rstd(v);
            norm_store_bf16(v, rstd, F.in[I_N1G], F.XN + (size_t)mrow * D, F.lane); norm_store_fp8(v, rstd, F.in[I_N1G], (unsigned char*)(F.ws + WS_XN8) + (size_t)mrow * D, F.lane); }
    }
    SEAM(0);

    layer_body<0>(F, bar, lo, hi);
    layer_body<1>(F, bar, lo, hi);
}


#ifndef N_LAUNCH_MODE
#define N_LAUNCH_MODE 1
#endif
extern "C" void kernel_launch(void* const* d_in, const int* in_sizes, int n_in, void* d_out, int out_size, void* d_ws, size_t ws_size, hipStream_t stream) {
    static int grid = 0;
    if (grid == 0) {
        if (n_in != 24 || out_size != T * D || ws_size < WS_END) { fprintf(stderr, "kernel_launch: unexpected shapes (n_in %d out %d ws %zu)\n", n_in, out_size, ws_size); grid = -1; return; }
        int dev = 0, cus = 0, per_cu = 0;
        if (hipGetDevice(&dev) != hipSuccess || hipDeviceGetAttribute(&cus, hipDeviceAttributeMultiprocessorCount, dev) != hipSuccess) { grid = -1; return; }
        if (hipFuncSetAttribute((const void*)fwd_kernel, hipFuncAttributeMaxDynamicSharedMemorySize, LDS_BYTES) != hipSuccess) { fprintf(stderr, "kernel_launch: hipFuncSetAttribute failed\n"); grid = -1; return; }
        if (hipOccupancyMaxActiveBlocksPerMultiprocessor(&per_cu, (const void*)fwd_kernel, NWAVES * 64, LDS_BYTES) != hipSuccess || per_cu < 1) { fprintf(stderr, "kernel_launch: occupancy query says %d\n", per_cu); }
        (void)hipGetLastError();
        grid = cus;
    }
    if (grid < 0) return;
    (void)hipMemsetAsync((char*)d_ws + WS_CTL, 0, CTL_ZERO_BYTES, stream);
    Args a{};
    for (int i = 0; i < 24; ++i) a.in[i] = (const float*)d_in[i];
    a.out = (float*)d_out; a.ws = (unsigned char*)d_ws;
    constexpr int NPH = 1 + 11 * DEPTH;
#if N_LAUNCH_MODE == 1
    a.ph_lo = 0; a.ph_hi = NPH;
    hipLaunchKernelGGL(fwd_kernel, dim3(grid), dim3(NWAVES * 64), LDS_BYTES, stream, a);
#else
    for (int p = 0; p < NPH; ++p) { a.ph_lo = p; a.ph_hi = p + 1; hipLaunchKernelGGL(fwd_kernel, dim3(grid), dim3(NWAVES * 64), LDS_BYTES, stream, a); }
#endif
    const hipError_t le = hipPeekAtLastError();
    if (le != hipSuccess) fprintf(stderr, "kernel_launch: launch failed: %s\n", hipGetErrorName(le));
}
```

```cpp
#include <hip/hip_runtime.h>
#include <cstdio>
#include <cstdint>

__device__ __forceinline__ int lane_id() { return (int)__builtin_amdgcn_mbcnt_hi(~0u, __builtin_amdgcn_mbcnt_lo(~0u, 0u)); }
namespace pg8 {
#define PG8_LAS __attribute__((address_space(3)))
typedef unsigned short bf16_t;
typedef short bf16x8 __attribute__((ext_vector_type(8)));
typedef float f32x4 __attribute__((ext_vector_type(4)));
typedef unsigned u32x4 __attribute__((ext_vector_type(4)));
typedef unsigned u32x2 __attribute__((ext_vector_type(2)));
constexpr int BM = 256, BK = 64, HALF = 128, HTB = HALF * BK * 2  , STAGE_BYTES = 8 * HTB, NXCD = 8, WGM = 8;

__host__ __device__ __forceinline__ int lds_byte(int r, int c) { const int st = (r >> 4) * 2 + (c >> 5), rr = r & 15, cc = c & 31, ob = rr * 64 + cc * 2; return st * 1024 + (ob ^ (((ob >> 9) & 1) << 5)); }
__host__ __device__ __forceinline__ void stage_rc(int b, int& R, int& C) { const int st = b / 1024, sb = b % 1024, swz = sb ^ (((sb >> 9) & 1) << 5); R = (st >> 1) * 16 + swz / 64; C = (st & 1) * 32 + (swz % 64) / 2; }
__host__ __device__ __forceinline__ int perm32(int rho) { const int n = rho >> 4, i = rho & 15; return 8 * (i >> 2) + 4 * n + (i & 3); }

struct Unit { int pm, pn, koff, nt, seg; };
struct Gemm { const bf16_t* A; const bf16_t* Bt; int M, N, K; };

struct StaticOrder {
    static constexpr bool GATHER = false;
    int nM, nN, nwg, G, c, nt0;
    __device__ __forceinline__ int row_token(const Unit&, int) const { return 0; }
    __device__ void init(int M, int N, int K, int G_, int c_) { nM = M / BM; nN = N / BM; nwg = nM * nN; G = G_; c = c_; nt0 = K / BK; }
    __device__ bool tile(long L, Unit& u) const {
        if (L >= nwg) return false;
        int wgid = (int)L; { const int q = nwg / NXCD, r = nwg % NXCD, xcd = wgid % NXCD, off = wgid / NXCD; wgid = (xcd < r ? xcd * (q + 1) : r * (q + 1) + (xcd - r) * q) + off; }
        const int nig = WGM * nN, gid = wgid / nig, fm = gid * WGM, gsz = (nM - fm) < WGM ? (nM - fm) : WGM;
        u.pm = fm + ((wgid % nig) % gsz); u.pn = (wgid % nig) / gsz; return true;
    }
    __device__ bool next(int i, Unit& u) const { u.koff = 0; u.nt = nt0; u.seg = 0; return tile((long)i * G + c, u); }
    __device__ __forceinline__ void a_ready(const Unit&) const {}
    __device__ __forceinline__ void done(const Unit&) const {}
};
struct MergeOrder : StaticOrder {
    __device__ bool next(int i, Unit& u) const { const int rnd = i / 3, sg = i - 3 * rnd; u.seg = sg; u.koff = sg == 0 ? 0 : (sg == 1 ? 512 : 1536); u.nt = sg == 1 ? 16 : 8; return tile((long)rnd * G + c, u); }
};
struct MoeOrder {
    static constexpr bool GATHER = false;
    int total, G, c, NJ, nt0; const PG8_LAS int* tile_exp;
    __device__ bool next(int i, Unit& u) const {
        const long L = (long)i * G + c; if (L >= total) return false;
        const int R = (int)L / NJ, j = (int)L % NJ; u.pm = R; u.pn = tile_exp[R] * NJ + j; u.koff = 0; u.nt = nt0; u.seg = 0; return true;
    }
    __device__ __forceinline__ int row_token(const Unit&, int) const { return 0; }
    __device__ __forceinline__ void a_ready(const Unit&) const {}
    __device__ __forceinline__ void done(const Unit&) const {}
};
struct MoeGatherOrder : MoeOrder {
    static constexpr bool GATHER = true;
    const PG8_LAS int* pst; const PG8_LAS int* cnt; const int* liste;
    __device__ __forceinline__ int row_token(const Unit& u, int r) const {
        const int e = tile_exp[u.pm], lr = u.pm * 256 - pst[e] + r;
        return lr < cnt[e] ? liste[(size_t)e * 32768 + lr] : 0;
    }
};

typedef __bf16 bf16x2v __attribute__((ext_vector_type(2)));
typedef float f32x2v __attribute__((ext_vector_type(2)));
__device__ __forceinline__ unsigned cvt_pk_bf16(float lo, float hi) { const f32x2v v = {lo, hi}; const bf16x2v b = __builtin_convertvector(v, bf16x2v); return __builtin_bit_cast(unsigned, b); }
__device__ __forceinline__ float bflo(unsigned w) { return __uint_as_float(w << 16); }
__device__ __forceinline__ float bfhi(unsigned w) { return __uint_as_float(w & 0xffff0000u); }
__device__ __forceinline__ float sigm(float v) { return __builtin_amdgcn_rcpf(1.0f + __builtin_amdgcn_exp2f(-1.44269504f * v)); }
__device__ __forceinline__ unsigned q8x4(const f32x4 s) {
    const unsigned a = (unsigned)fminf(s[0] * 256.0f, 255.5f), b = (unsigned)fminf(s[1] * 256.0f, 255.5f), c = (unsigned)fminf(s[2] * 256.0f, 255.5f), d = (unsigned)fminf(s[3] * 256.0f, 255.5f);
    return a | (b << 8) | (c << 16) | (d << 24);
}

constexpr int ZP = 5120;
constexpr int ZC_GA = 5120, ZC_GB = 7168, ZC_GC = 9216;
constexpr size_t GT_TILE = 65536, GT_GATE = (size_t)128 * 8 * GT_TILE;

template <int PN_OFF> struct EpiInProj {
    static constexpr bool PERM = true, AFTER_DRAIN = false, CHAIN = false;
    bf16_t* O; unsigned char* GT; PG8_LAS unsigned long long* ss;
    const PG8_LAS float* gains;
    __device__ __forceinline__ void operator()(const f32x4 (&acc)[2][2][4][2], const Unit& u, int wr, int wc, int fr, int fq) const {
        const int pn = PN_OFF ? u.pn + 13 : (u.pn < 13 ? u.pn : u.pn + 3);
        int row0 = u.pm * BM + wr * 64 + fr, col0 = pn * BM + wc * 32 + 8 * fq;
        asm volatile("" : "+v"(row0), "+v"(col0));
        const int act = pn >= 20 ? 2 : (pn >= 18 ? 1 : 0);
        const bool hn = PN_OFF == 0 && pn <= 7;
        f32x4 gn0 = (f32x4){1.f, 1.f, 1.f, 1.f}, gn1 = gn0; int lr = 0;
        if (hn) {
            lr = wr * 64 + fr; asm volatile("" : "+v"(lr));
#pragma unroll
            for (int ai = 0; ai < 2; ++ai)
#pragma unroll
                for (int m = 0; m < 4; ++m)
#pragma unroll
                    for (int bj = 0; bj < 2; ++bj) { const f32x4 a = acc[ai][bj][m][0], b = acc[ai][bj][m][1];
                        float s = (a[0] * a[0] + a[1] * a[1]) + (a[2] * a[2] + a[3] * a[3]) + (b[0] * b[0] + b[1] * b[1]) + (b[2] * b[2] + b[3] * b[3]);
                        s += __shfl_xor(s, 16); s += __shfl_xor(s, 32);
                        if (fq == 0) __hip_atomic_fetch_add(ss + (ai * HALF + m * 16 + lr) * 2 + bj, (unsigned long long)(s * 1048576.0f), __ATOMIC_RELAXED, __HIP_MEMORY_SCOPE_WORKGROUP); }
            asm volatile("s_waitcnt lgkmcnt(0)" ::: "memory"); __builtin_amdgcn_s_barrier(); asm volatile("" ::: "memory");
            const PG8_LAS float* gp = gains + (pn <= 1 ? 0 : (pn == 2 ? 128 : (pn <= 6 ? 256 : 384))) + wc * 32 + 8 * fq;
            gn0 = *(const PG8_LAS f32x4*)gp; gn1 = *(const PG8_LAS f32x4*)(gp + 4);
        }
        if (act == 2) {
            int lo16 = (wr * 4 + wc) * 8192 + (fq * 16 + fr) * 16; asm volatile("" : "+v"(lo16));
            unsigned char* gp = GT + (size_t)((pn - 20) >> 3) * GT_GATE + ((size_t)u.pm * 8 + ((pn - 20) & 7)) * GT_TILE + lo16;
#pragma unroll
            for (int ai = 0; ai < 2; ++ai)
#pragma unroll
                for (int m = 0; m < 4; ++m) { u32x4 w;
#pragma unroll
                    for (int bj = 0; bj < 2; ++bj) { const f32x4 v0 = acc[ai][bj][m][0] * 0.015625f, v1 = acc[ai][bj][m][1] * 0.015625f; f32x4 s0, s1;
#pragma unroll
                        for (int j = 0; j < 4; ++j) { s0[j] = sigm(v0[j]); s1[j] = sigm(v1[j]); }
                        w[2 * bj] = q8x4(s0); w[2 * bj + 1] = q8x4(s1); }
                    *(u32x4*)(gp + (ai * 4 + m) * 1024) = w; }
            return;
        }
#pragma unroll
        for (int ai = 0; ai < 2; ++ai)
#pragma unroll
            for (int m = 0; m < 4; ++m) { bf16_t* rowp = O + (size_t)(row0 + ai * HALF + m * 16) * ZP + col0;
#pragma unroll
                for (int bj = 0; bj < 2; ++bj) { f32x4 v0 = acc[ai][bj][m][0], v1 = acc[ai][bj][m][1];
                    if (hn && !(pn == 2 && bj == 1)) { const float r = rsqrtf((float)ss[(ai * HALF + m * 16 + lr) * 2 + bj] * (0.015625f * 0.015625f / 128.0f / 1048576.0f) + 1e-6f) * 0.015625f;
                        v0 = v0 * r * gn0; v1 = v1 * r * gn1; }
                    else if (PN_OFF == 0) { v0 = v0 * 0.015625f; v1 = v1 * 0.015625f; }
                    if (act) {
#pragma unroll
                        for (int j = 0; j < 4; ++j) { v0[j] *= sigm(v0[j]); v1[j] *= sigm(v1[j]); } }
                    u32x4 w; w.x = cvt_pk_bf16(v0[0], v0[1]); w.y = cvt_pk_bf16(v0[2], v0[3]); w.z = cvt_pk_bf16(v1[0], v1[1]); w.w = cvt_pk_bf16(v1[2], v1[3]);
                    *(u32x4*)(rowp + bj * HALF) = w; } }
        if (hn) { asm volatile("s_waitcnt lgkmcnt(0)" ::: "memory"); __builtin_amdgcn_s_barrier(); asm volatile("" ::: "memory");
            ss[(wr * 4 + wc) * 64 + fq * 16 + fr] = 0ull; }
    }
};
template <int MODE = 0> struct EpiMergeT {
    static constexpr bool PERM = true, AFTER_DRAIN = false, CHAIN = true;
    const unsigned char* GT; bf16_t* O;
    __device__ __forceinline__ void operator()(f32x4 (&acc)[2][2][4][2], const Unit& u, int wr, int wc, int fr, int fq) const {
        if (MODE == 2) return;
        const int row0 = u.pm * BM + wr * 64 + fr, col0 = u.pn * BM + wc * 32 + 8 * fq;
        int lo16 = (wr * 4 + wc) * 8192 + (fq * 16 + fr) * 16; asm volatile("" : "+v"(lo16));
        const unsigned char* gp = GT + ((size_t)u.pm * 8 + u.pn) * GT_TILE + lo16;
        const size_t cn = (size_t)u.seg * GT_GATE, cd = (size_t)(u.seg == 0 ? 1 : 2) * GT_GATE;
        const bool fin = u.seg == 2;
        u32x4 gn[2][4], gd[2][4];
#pragma unroll
        for (int ai = 0; ai < 2; ++ai)
#pragma unroll
            for (int m = 0; m < 4; ++m) {
                if (MODE == 1) { gn[ai][m] = (u32x4){0x80808080u + (unsigned)u.pm, 0x80808080u, 0x80808080u, 0x80808080u}; gd[ai][m] = gn[ai][m]; } else {
                gn[ai][m] = *(const u32x4*)(gp + cn + (ai * 4 + m) * 1024); gd[ai][m] = *(const u32x4*)(gp + cd + (ai * 4 + m) * 1024); } }
#pragma unroll
        for (int ai = 0; ai < 2; ++ai)
#pragma unroll
            for (int m = 0; m < 4; ++m)
#pragma unroll
                for (int bj = 0; bj < 2; ++bj) { const size_t r = (size_t)(row0 + ai * HALF + m * 16);
#pragma unroll
                    for (int w = 0; w < 2; ++w)
#pragma unroll
                        for (int k = 0; k < 4; ++k) { const float qn = (float)((gn[ai][m][2 * bj + w] >> (8 * k)) & 0xffu) + 0.5f, qd = (float)((gd[ai][m][2 * bj + w] >> (8 * k)) & 0xffu) + 0.5f;
                            acc[ai][bj][m][w][k] *= qn * __builtin_amdgcn_rcpf(fin ? 256.0f : qd); }
                    if (fin) { const f32x4 v0 = acc[ai][bj][m][0], v1 = acc[ai][bj][m][1];
                        u32x4 w; w.x = cvt_pk_bf16(v0[0], v0[1]); w.y = cvt_pk_bf16(v0[2], v0[3]); w.z = cvt_pk_bf16(v1[0], v1[1]); w.w = cvt_pk_bf16(v1[2], v1[3]);
                        *(u32x4*)(O + r * 2048 + col0 + bj * HALF) = w; } }
    }
};
typedef EpiMergeT<0> EpiMerge;
struct EpiResid {
    static constexpr int PERM = 2; static constexpr bool AFTER_DRAIN = false, CHAIN = false;
    bf16_t* hb; unsigned char* xu; const float* gain; PG8_LAS unsigned char* stg;
    __device__ __forceinline__ void operator()(const f32x4 (&acc)[2][2][4][2], const Unit& u, int wr, int wc, int fr, int fq) const {
        int lane = fq * 16 + fr; asm volatile("" : "+v"(lane));
        PG8_LAS unsigned char* s0 = stg + (wr * 4 + wc) * 1024;
        const int r8 = lane >> 3, pc = lane & 7;
        const int offc = r8 * 128 + ((pc ^ r8) << 4);
        const int offa0 = (fr >> 3) * 8192 + (fr & 7) * 128 + ((fq ^ (fr & 7)) << 4), offa1 = (fr >> 3) * 8192 + (fr & 7) * 128 + (((4 + fq) ^ (fr & 7)) << 4);
        const int xs = 2 * (fr >> 2), offxw0 = fr * 64 + ((fq ^ xs) << 3), offxw1 = fr * 64 + (((4 + fq) ^ xs) << 3);
        const int xr = lane >> 2, xq = lane & 3, offxr = xr * 64 + (((2 * xq) ^ (2 * (xr >> 2))) << 3);
        const size_t goff = (size_t)(u.pm * BM + wr * 64 + r8) * 2048 + u.pn * BM + wc * 64 + pc * 8;
        const size_t xoff = (size_t)(u.pm * BM + wr * 64 + xr) * 2048 + u.pn * BM + wc * 64 + xq * 16;
        f32x4 gv[2][2];
#pragma unroll
        for (int bj = 0; bj < 2; ++bj)
#pragma unroll
            for (int n = 0; n < 2; ++n) gv[bj][n] = *(const f32x4*)(gain + u.pn * BM + wc * 64 + bj * 32 + 8 * fq + 4 * n);
        const f32x4 lo4 = (f32x4){-440.f, -440.f, -440.f, -440.f}, hi4 = (f32x4){440.f, 440.f, 440.f, 440.f};
#pragma unroll
        for (int ai = 0; ai < 2; ++ai) {
            u32x4 bb[4][2];
#pragma unroll
            for (int m = 0; m < 4; ++m)
#pragma unroll
                for (int j = 0; j < 2; ++j) bb[m][j] = *(const u32x4*)(hb + goff + (size_t)(ai * HALF + m * 16 + 8 * j) * 2048);
#pragma unroll
            for (int m = 0; m < 4; ++m) {
                *(PG8_LAS u32x4*)(s0 + offc) = bb[m][0]; *(PG8_LAS u32x4*)(s0 + 8192 + offc) = bb[m][1];
                asm volatile("" ::: "memory");
                const u32x4 a0 = *(const PG8_LAS u32x4*)(s0 + offa0), a1 = *(const PG8_LAS u32x4*)(s0 + offa1);
                asm volatile("" ::: "memory");
                u32x2 xw[2];
#pragma unroll
                for (int bj = 0; bj < 2; ++bj) { const u32x4 w = bj ? a1 : a0;
                    const f32x4 h0 = (f32x4){bflo(w.x), bfhi(w.x), bflo(w.y), bfhi(w.y)} + acc[ai][bj][m][0], h1 = (f32x4){bflo(w.z), bfhi(w.z), bflo(w.w), bfhi(w.w)} + acc[ai][bj][m][1];
                    u32x4 hw; hw.x = cvt_pk_bf16(h0[0], h0[1]); hw.y = cvt_pk_bf16(h0[2], h0[3]); hw.z = cvt_pk_bf16(h1[0], h1[1]); hw.w = cvt_pk_bf16(h1[2], h1[3]);
                    *(PG8_LAS u32x4*)(s0 + (bj ? offa1 : offa0)) = hw;
                    const f32x4 x0 = __builtin_elementwise_min(__builtin_elementwise_max(h0 * gv[bj][0], lo4), hi4), x1 = __builtin_elementwise_min(__builtin_elementwise_max(h1 * gv[bj][1], lo4), hi4);
                    int w0 = 0, w1 = 0;
                    w0 = __builtin_amdgcn_cvt_pk_fp8_f32(x0[0], x0[1], w0, false); w0 = __builtin_amdgcn_cvt_pk_fp8_f32(x0[2], x0[3], w0, true);
                    w1 = __builtin_amdgcn_cvt_pk_fp8_f32(x1[0], x1[1], w1, false); w1 = __builtin_amdgcn_cvt_pk_fp8_f32(x1[2], x1[3], w1, true);
                    xw[bj] = (u32x2){(unsigned)w0, (unsigned)w1}; }
                asm volatile("" ::: "memory");
                const u32x4 o0 = *(const PG8_LAS u32x4*)(s0 + offc), o1 = *(const PG8_LAS u32x4*)(s0 + 8192 + offc);
                asm volatile("" ::: "memory");
                *(PG8_LAS u32x2*)(s0 + offxw0) = xw[0]; *(PG8_LAS u32x2*)(s0 + offxw1) = xw[1];
                asm volatile("" ::: "memory");
                const u32x4 xo = *(const PG8_LAS u32x4*)(s0 + offxr);
                asm volatile("" ::: "memory");
                *(u32x4*)(hb + goff + (size_t)(ai * HALF + m * 16) * 2048) = o0; *(u32x4*)(hb + goff + (size_t)(ai * HALF + m * 16 + 8) * 2048) = o1;
                *(u32x4*)(xu + xoff + (size_t)(ai * HALF + m * 16) * 2048) = xo;
            }
        }
        asm volatile("s_waitcnt lgkmcnt(0)" ::: "memory");
    }
};
struct EpiGlu {
    static constexpr bool PERM = false, AFTER_DRAIN = false, CHAIN = false;
    bf16_t* H; const PG8_LAS int* tile_exp; const PG8_LAS int* pst; const PG8_LAS int* cnt; const int* liste; const float* rstd;
    __device__ __forceinline__ void operator()(const f32x4 (&acc)[2][2][4][2], const Unit& u, int wr, int wc, int fr, int fq) const {
        const int row0 = u.pm * BM + wr * 64 + fr, pj = u.pn & 3;
        const int e = tile_exp[u.pm], lr0 = u.pm * 256 - pst[e] + wr * 64 + fr, ce = cnt[e];
        int tok[2][4]; float rs[2][4];
#pragma unroll
        for (int ai = 0; ai < 2; ++ai)
#pragma unroll
            for (int m = 0; m < 4; ++m) { const int lr = lr0 + ai * HALF + m * 16; tok[ai][m] = lr < ce ? liste[(size_t)e * 32768 + lr] : 0; }
#pragma unroll
        for (int ai = 0; ai < 2; ++ai)
#pragma unroll
            for (int m = 0; m < 4; ++m) rs[ai][m] = rstd[tok[ai][m]] * 0.015625f;
#pragma unroll
        for (int ai = 0; ai < 2; ++ai)
#pragma unroll
            for (int m = 0; m < 4; ++m) { unsigned char* rowp = (unsigned char*)H + (size_t)(row0 + ai * HALF + m * 16) * 512; const float r = rs[ai][m];
#pragma unroll
                for (int bj = 0; bj < 2; ++bj) { const f32x4 a = acc[ai][bj][m][0] * r, b = acc[ai][bj][m][1] * r;
                    const int hc = 16 * (8 * pj + 4 * bj + wc) + 4 * fq;
                    float hv[4];
#pragma unroll
                    for (int j = 0; j < 4; ++j) hv[j] = fminf(fmaxf(a[j] * sigm(a[j]) * b[j] * 8.0f, -440.0f), 440.0f);
                    int w = 0; w = __builtin_amdgcn_cvt_pk_fp8_f32(hv[0], hv[1], w, false); w = __builtin_amdgcn_cvt_pk_fp8_f32(hv[2], hv[3], w, true);
                    *(int*)(rowp + hc) = w; } }
    }
};
struct EpiY {
    static constexpr bool PERM = true, AFTER_DRAIN = false, CHAIN = false;
    unsigned char* Y;
    __device__ __forceinline__ void operator()(const f32x4 (&acc)[2][2][4][2], const Unit& u, int wr, int wc, int fr, int fq) const {
        const int row0 = u.pm * BM + wr * 64 + fr, col0 = (u.pn & 7) * BM + wc * 32 + 8 * fq;
        const f32x4 lo4 = (f32x4){-440.f, -440.f, -440.f, -440.f}, hi4 = (f32x4){440.f, 440.f, 440.f, 440.f};
#pragma unroll
        for (int ai = 0; ai < 2; ++ai)
#pragma unroll
            for (int m = 0; m < 4; ++m) { unsigned char* rowp = Y + (size_t)(row0 + ai * HALF + m * 16) * 2048 + col0;
#pragma unroll
                for (int bj = 0; bj < 2; ++bj) {
                    const f32x4 v0 = __builtin_elementwise_min(__builtin_elementwise_max(acc[ai][bj][m][0] * 0.125f, lo4), hi4), v1 = __builtin_elementwise_min(__builtin_elementwise_max(acc[ai][bj][m][1] * 0.125f, lo4), hi4);
                    int w0 = 0, w1 = 0;
                    w0 = __builtin_amdgcn_cvt_pk_fp8_f32(v0[0], v0[1], w0, false); w0 = __builtin_amdgcn_cvt_pk_fp8_f32(v0[2], v0[3], w0, true);
                    w1 = __builtin_amdgcn_cvt_pk_fp8_f32(v1[0], v1[1], w1, false); w1 = __builtin_amdgcn_cvt_pk_fp8_f32(v1[2], v1[3], w1, true);
                    *(u32x2*)(rowp + bj * HALF) = (u32x2){(unsigned)w0, (unsigned)w1}; } }
    }
};

typedef int v4i_t __attribute__((ext_vector_type(4)));
typedef int v8i_t __attribute__((ext_vector_type(8)));
template <class Epi, class Sched, bool ALIGN_EPI = false, bool FP8 = false>
__device__ __forceinline__ void gemm_phase(PG8_LAS unsigned char* lds, const Gemm g, const Sched& S, const Epi& E) {
    int tid = threadIdx.x; asm volatile("" : "+v"(tid));
    const int wid = __builtin_amdgcn_readfirstlane(tid >> 6), lane = tid & 63, wr = wid >> 2, wc = wid & 3, fr = lane & 15, fq = lane >> 4;
    const int K = g.K;
    unsigned voffA[2], voffB[2]; int RA[2]; unsigned CA2[2];
#pragma unroll
    for (int i = 0; i < 2; ++i) { int R, C; stage_rc(tid * 16 + i * 8192, R, C); const int Rb = Epi::PERM == 2 ? ((R >> 5) * 64 + perm32(R & 31)) : (Epi::PERM ? ((R & ~31) + perm32(R & 31)) : R);
        voffA[i] = (unsigned)(R * K + C) * 2u; voffB[i] = (unsigned)(Rb * K + C) * 2u; RA[i] = R; CA2[i] = (unsigned)C * 2u; }
    unsigned gAc[2][2], gAn[2][2];
#define PG8_GOFF(dst, uu) do { _Pragma("unroll") for (int h_ = 0; h_ < 2; ++h_) _Pragma("unroll") for (int i_ = 0; i_ < 2; ++i_) dst[h_][i_] = (unsigned)S.row_token(uu, 128 * h_ + RA[i_]) * (unsigned)(K * 2) + CA2[i_]; } while (0)
#define PG8_STAGE_A(bufoff, gbase, half, garr) do { if constexpr (Sched::GATHER) PG8_STAGE(bufoff, gbase, garr); else PG8_STAGE(bufoff, (gbase) + (half) * hstep, voffA); } while (0)
    const size_t kstep = (size_t)(BK * 2);
    const size_t hstep = (size_t)HALF * K * 2;
    const size_t hstepB = Epi::PERM == 2 ? (size_t)32 * K * 2 : hstep;
    const size_t tstep = 2 * hstep;
    const unsigned ldsw = (unsigned)wid * 1024u;
    const int aoff = lds_byte(wr * 64 + fr, fq * 8), boff = lds_byte(wc * 32 + fr, fq * 8);
#define PG8_SA(b, h) (((b) * 2 + (h)) * HTB)
#define PG8_SB(b, h) ((4 + (b) * 2 + (h)) * HTB)
#define PG8_STAGE(bufoff, gbase, voff) do { _Pragma("unroll") for (int _i = 0; _i < 2; ++_i) \
        __builtin_amdgcn_global_load_lds((const unsigned*)((const char*)(gbase) + (voff)[_i]), (PG8_LAS unsigned*)(lds + (bufoff) + ldsw + _i * 8192), 16, 0, 0); } while (0)
#define PG8_LDA(dst, b, h) do { if constexpr (FP8) { _Pragma("unroll") for (int m = 0; m < 4; ++m) dst##8[m] = __builtin_shufflevector(*(const PG8_LAS v4i_t*)(lds + PG8_SA(b, h) + aoff + m * 2048), *(const PG8_LAS v4i_t*)(lds + PG8_SA(b, h) + aoff + m * 2048 + 1024), 0, 1, 2, 3, 4, 5, 6, 7); } \
        else { _Pragma("unroll") for (int m = 0; m < 4; ++m) _Pragma("unroll") for (int k = 0; k < 2; ++k) dst[m][k] = *(const PG8_LAS bf16x8*)(lds + PG8_SA(b, h) + aoff + m * 2048 + k * 1024); } } while (0)
#define PG8_LDB(dst, b, h) do { if constexpr (FP8) { _Pragma("unroll") for (int n = 0; n < 2; ++n) dst##8[n] = __builtin_shufflevector(*(const PG8_LAS v4i_t*)(lds + PG8_SB(b, h) + boff + n * 2048), *(const PG8_LAS v4i_t*)(lds + PG8_SB(b, h) + boff + n * 2048 + 1024), 0, 1, 2, 3, 4, 5, 6, 7); } \
        else { _Pragma("unroll") for (int n = 0; n < 2; ++n) _Pragma("unroll") for (int k = 0; k < 2; ++k) dst[n][k] = *(const PG8_LAS bf16x8*)(lds + PG8_SB(b, h) + boff + n * 2048 + k * 1024); } } while (0)
#define PG8_MMA(ai, bj, At, Bt) do { __builtin_amdgcn_s_setprio(1); _Pragma("unroll") for (int m = 0; m < 4; ++m) _Pragma("unroll") for (int n = 0; n < 2; ++n) { \
        if constexpr (FP8) asm volatile("v_mfma_f32_16x16x128_f8f6f4 %0, %1, %2, %0" : "+v"(acc[ai][bj][m][n]) : "v"(Bt##8[n]), "v"(At##8[m])); \
        else { _Pragma("unroll") for (int k = 0; k < 2; ++k) acc[ai][bj][m][n] = __builtin_amdgcn_mfma_f32_16x16x32_bf16(Bt[n][k], At[m][k], acc[ai][bj][m][n], 0, 0, 0); } } \
        __builtin_amdgcn_s_setprio(0); } while (0)
#define PG8_WAIT_V(n) asm volatile("s_waitcnt vmcnt(" #n ")" ::: "memory")
#define PG8_WAIT_L(n) asm volatile("s_waitcnt lgkmcnt(" #n ")" ::: "memory")
#define PG8_BAR __builtin_amdgcn_s_barrier()
#define PG8_SCHED __builtin_amdgcn_sched_barrier(0)
    Unit cur, nxt; int ui = 0;
    if (!S.next(0, cur)) return;
    f32x4 acc[2][2][4][2];
#pragma unroll
    for (int a = 0; a < 2; ++a)
#pragma unroll
        for (int b = 0; b < 2; ++b)
#pragma unroll
            for (int m = 0; m < 4; ++m)
#pragma unroll
                for (int n = 0; n < 2; ++n) acc[a][b][m][n] = (f32x4){0.f, 0.f, 0.f, 0.f};
    bf16x8 At[4][2], B0[2][2], B1[2][2]; v8i_t At8[4], B08[2], B18[2];
    const size_t tstepA = Sched::GATHER ? (size_t)0 : tstep;
    const char* cA = (const char*)g.A + (size_t)cur.pm * tstepA + (size_t)cur.koff * 2; const char* cB = (const char*)g.Bt + (size_t)cur.pn * tstep + (size_t)cur.koff * 2;
    S.a_ready(cur);
    if constexpr (Sched::GATHER) { PG8_GOFF(gAc, cur); }
    PG8_STAGE(PG8_SB(0, 0), cB, voffB); PG8_STAGE(PG8_SB(0, 1), cB + hstepB, voffB); PG8_STAGE_A(PG8_SA(0, 0), cA, 0, gAc[0]); PG8_STAGE_A(PG8_SA(0, 1), cA, 1, gAc[1]);
    if (wr == 1) PG8_BAR;
    PG8_WAIT_V(2); PG8_BAR;
    PG8_STAGE(PG8_SB(1, 0), cB + kstep, voffB); PG8_STAGE_A(PG8_SA(1, 0), cA + kstep, 0, gAc[0]); PG8_STAGE(PG8_SB(1, 1), cB + hstepB + kstep, voffB);
    PG8_WAIT_V(6); PG8_BAR;
    for (;;) {
        const bool has_next = S.next(ui + 1, nxt);
        const char* nA = has_next ? (const char*)g.A + (size_t)nxt.pm * tstepA + (size_t)nxt.koff * 2 : cA; const char* nB = has_next ? (const char*)g.Bt + (size_t)nxt.pn * tstep + (size_t)nxt.koff * 2 : cB;
        if constexpr (Sched::GATHER) { if (has_next) { PG8_GOFF(gAn, nxt); } else {
#pragma unroll
            for (int h_ = 0; h_ < 2; ++h_)
#pragma unroll
                for (int i_ = 0; i_ < 2; ++i_) gAn[h_][i_] = gAc[h_][i_]; } }
        const int nt = cur.nt;
        for (int t = 0; t < nt; t += 2) {
            const bool last = (t == nt - 2);
            const char* a1 = cA + (size_t)(t + 1) * kstep;
            const char* a2 = last ? nA : cA + (size_t)(t + 2) * kstep; const char* b2 = last ? nB : cB + (size_t)(t + 2) * kstep;
            const char* a3 = a2 + kstep; const char* b3 = b2 + kstep;
            if (last && has_next) S.a_ready(nxt);
            unsigned g2a[2][2];
            if constexpr (Sched::GATHER) {
#pragma unroll
                for (int h_ = 0; h_ < 2; ++h_)
#pragma unroll
                    for (int i_ = 0; i_ < 2; ++i_) g2a[h_][i_] = last ? gAn[h_][i_] : gAc[h_][i_]; }
            PG8_LDB(B0, 0, 0); PG8_LDB(B1, 0, 1); PG8_SCHED; PG8_LDA(At, 0, 0); PG8_STAGE_A(PG8_SA(1, 1), a1, 1, gAc[1]);
            PG8_WAIT_V(8); PG8_WAIT_L(0); PG8_BAR; PG8_MMA(0, 0, At, B0); PG8_MMA(0, 1, At, B1); PG8_BAR; PG8_SCHED;
            PG8_LDA(At, 0, 1); PG8_STAGE(PG8_SB(0, 0), b2, voffB); PG8_STAGE(PG8_SB(0, 1), b2 + hstepB, voffB); PG8_STAGE_A(PG8_SA(0, 0), a2, 0, g2a[0]);
            PG8_WAIT_V(8); PG8_WAIT_L(0); PG8_BAR; PG8_MMA(1, 0, At, B0); PG8_MMA(1, 1, At, B1); PG8_BAR; PG8_SCHED;
            PG8_LDB(B0, 1, 0); PG8_LDB(B1, 1, 1); PG8_SCHED; PG8_LDA(At, 1, 0); PG8_STAGE_A(PG8_SA(0, 1), a2, 1, g2a[1]);
            PG8_WAIT_V(8); PG8_WAIT_L(0); PG8_BAR; PG8_MMA(0, 0, At, B0); PG8_MMA(0, 1, At, B1); PG8_BAR; PG8_SCHED;
            PG8_LDA(At, 1, 1); PG8_STAGE(PG8_SB(1, 0), b3, voffB); PG8_STAGE(PG8_SB(1, 1), b3 + hstepB, voffB); PG8_STAGE_A(PG8_SA(1, 0), a3, 0, g2a[0]);
            PG8_WAIT_V(8); PG8_WAIT_L(0); PG8_BAR; PG8_MMA(1, 0, At, B0); PG8_MMA(1, 1, At, B1); PG8_BAR; PG8_SCHED;
        }
        if constexpr (ALIGN_EPI) { if (wr == 0) PG8_BAR; }
        if constexpr (FP8) asm volatile("s_nop 15\n\ts_nop 15\n\ts_nop 15\n\ts_nop 15" ::: "memory");
        E(acc, cur, wr, wc, fr, fq); S.done(cur);
        if (!has_next) break;
        if (!Epi::CHAIN || cur.seg == 2)
#pragma unroll
        for (int a = 0; a < 2; ++a)
#pragma unroll
            for (int b = 0; b < 2; ++b)
#pragma unroll
                for (int m = 0; m < 4; ++m)
#pragma unroll
                    for (int n = 0; n < 2; ++n) acc[a][b][m][n] = (f32x4){0.f, 0.f, 0.f, 0.f};
        cur = nxt; cA = nA; cB = nB; ++ui;
        if constexpr (Sched::GATHER) {
#pragma unroll
            for (int h_ = 0; h_ < 2; ++h_)
#pragma unroll
                for (int i_ = 0; i_ < 2; ++i_) gAc[h_][i_] = gAn[h_][i_]; }
        if constexpr (ALIGN_EPI) { if (wr == 1) PG8_BAR; }
    }
    PG8_WAIT_V(0);
    if constexpr (!ALIGN_EPI) { if (wr == 0) PG8_BAR; }
    PG8_BAR;
#undef PG8_SA
#undef PG8_SB
#undef PG8_STAGE_A
#undef PG8_GOFF
#undef PG8_STAGE
#undef PG8_LDA
#undef PG8_LDB
#undef PG8_MMA
#undef PG8_WAIT_V
#undef PG8_WAIT_L
#undef PG8_BAR
#undef PG8_SCHED
}
}

constexpr int NWAVES = 8;
constexpr int T = 32768, SEQ = 2048, NB = 16, D = 2048, DEPTH = 2;
constexpr int ZP = pg8::ZP;
constexpr int ZC_AQ = 0, ZC_AK = 512, ZC_AV = 640, ZC_BQ = 768, ZC_BK = 1792, ZC_BV = 2048, ZC_IQ = 2304, ZC_IK = 3328, ZC_IW = 3392, ZC_CG = 3408, ZC_PAD = 3424, ZC_CQ = 3584, ZC_CK = 3840, ZC_CV = 4096, ZC_CR = 4608;
constexpr int D_IN = 11104;
constexpr int NEXP = 64, DEXP = 512, PMAX_TILES = 320;
constexpr float EPS = 1e-6f;

constexpr size_t MiB = 1u << 20;
constexpr size_t WS_CTL = 0, CTL_ZERO_BYTES = 1 * MiB;
constexpr size_t WS_ROUTE = 2 * MiB;
constexpr size_t WS_WRH = 4 * MiB, WS_WRL = 6 * MiB, WR_L = 96 * 2048 * 2;
constexpr size_t WS_WIN = 16 * MiB, WIN_L = 44 * MiB;
constexpr size_t WS_WBR = 104 * MiB, WBR_L = 8 * MiB;
constexpr size_t WS_WO = 120 * MiB, WO_L = 8 * MiB;
constexpr size_t WS_W13 = 136 * MiB;
constexpr size_t WS_HB = 264 * MiB;
constexpr size_t WS_W2 = 392 * MiB;
constexpr size_t WS_XN = 520 * MiB;
constexpr size_t WS_OCAT = 648 * MiB;
constexpr size_t WS_MERGED = 776 * MiB;
constexpr size_t WS_Z = 904 * MiB;
constexpr size_t WS_GT = 1224 * MiB;
constexpr size_t WS_S = 1608 * MiB;
constexpr size_t WS_MASK = 1864 * MiB;
constexpr size_t WS_GO = 1872 * MiB;
constexpr size_t WS_GCS = WS_GO;
constexpr size_t WS_GDEC = 8 * MiB;
constexpr size_t WS_RSTD = 9 * MiB;
constexpr size_t WS_LISTE = 904 * MiB;
constexpr size_t WS_XS = 904 * MiB;
constexpr size_t WS_Y = 1224 * MiB;
constexpr size_t WS_H = 1544 * MiB;
constexpr size_t WS_WG8 = 1936 * MiB, WG8_L = 12 * MiB;
constexpr size_t WS_XN8 = WS_S;
constexpr size_t WS_END = 1936 * MiB;
constexpr int CW_BAR = 4096;
constexpr int CW_CNT = 16384;

constexpr int RING_BYTES = 131072, MISC_OFF = RING_BYTES, LDS_BYTES = 155648;
constexpr int MO_BARW = 32, MO_GN = 256, MO_TEXP = 8192, MO_PST = 9728, MO_TOT = 9984, MO_TAB2 = 10240, MO_CNT = 16640, MO_SS = 16896;

#define GAS __attribute__((address_space(1)))
#define LAS __attribute__((address_space(3)))
typedef unsigned short bf16;
typedef unsigned v4u __attribute__((ext_vector_type(4)));
typedef unsigned v2u __attribute__((ext_vector_type(2)));
typedef float f32x4 __attribute__((ext_vector_type(4)));
#define LDS_WAIT() asm volatile("s_waitcnt lgkmcnt(0)" ::: "memory")
__device__ __forceinline__ unsigned f2bf(float f) { unsigned u = __builtin_bit_cast(unsigned, f); return (u + 0x7fffu + ((u >> 16) & 1u)) >> 16; }
__device__ __forceinline__ unsigned pk2(float lo, float hi) { return f2bf(lo) | (f2bf(hi) << 16); }
__device__ __forceinline__ float bflo(unsigned w) { return __uint_as_float(w << 16); }
__device__ __forceinline__ float bfhi(unsigned w) { return __uint_as_float(w & 0xffff0000u); }
__device__ __forceinline__ float bf1(bf16 h) { return __uint_as_float(((unsigned)h) << 16); }

#define XB_TMO      128
#define XB_XCNT(j)  (256  + 64 * (j))
#define XB_XSUB(j)  (1280 + 64 * (j))
#define XB_XGEN(j)  (2304 + 64 * (j))
#define XB_TOP      3328
#define XB_TOPGEN   3392
#define XCD_BAR_WORDS 3456
#define XB_SPIN_CAP (1u << 18)
__device__ __forceinline__ unsigned xb_ld(unsigned* p)              { return __hip_atomic_load(p, __ATOMIC_RELAXED, __HIP_MEMORY_SCOPE_AGENT); }
__device__ __forceinline__ unsigned xb_add(unsigned* p, unsigned v) { return __hip_atomic_fetch_add(p, v, __ATOMIC_RELAXED, __HIP_MEMORY_SCOPE_AGENT); }
__device__ __forceinline__ unsigned xb_xcc_id() { return (unsigned)__builtin_amdgcn_s_getreg((3 << 11) | 20) & 0xFu; }
#define XB_SPIN(cond, bar) do { unsigned _sp = 0; while (cond) { __builtin_amdgcn_s_sleep(1); \
    if ((++_sp & 255u) == 0u) { if (xb_ld(&(bar)[XB_TMO])) break; if (_sp > XB_SPIN_CAP) { atomicAdd(&(bar)[XB_TMO], 1u); break; } } } } while (0)
struct XcdBarrier { unsigned* bar; unsigned x; volatile LAS unsigned* st; };
__device__ __forceinline__ XcdBarrier xcd_barrier_post(unsigned* bar, volatile LAS unsigned* st) {
    XcdBarrier b; b.bar = bar; b.x = xb_xcc_id(); b.st = st;
    if (threadIdx.x == 0) (void)xb_add(&bar[XB_XCNT(b.x)], 1u);
    return b;
}
__device__ __forceinline__ void xcd_barrier_complete(unsigned* bar, unsigned x, unsigned& nloc, unsigned& nx) {
    const unsigned G = gridDim.x * gridDim.y * gridDim.z;
    unsigned sum, cnt, mine, sp = 0u;
    for (;;) {
        sum = 0u; cnt = 0u; mine = 0u;
#pragma unroll
        for (unsigned j = 0; j < 16; ++j) { const unsigned c = xb_ld(&bar[XB_XCNT(j)]); sum += c; cnt += (c > 0u) ? 1u : 0u; mine = (j == x) ? c : mine; }
        if (sum == G) break;
        __builtin_amdgcn_s_sleep(1);
        if ((++sp & 255u) == 0u) { if (xb_ld(&bar[XB_TMO])) break; if (sp > XB_SPIN_CAP) { atomicAdd(&bar[XB_TMO], 1u); break; } }
    }
    nloc = mine > 0u ? mine : 1u; nx = cnt > 0u ? cnt : 1u;
}
__device__ __forceinline__ void xcd_barrier(const XcdBarrier& b) {
    asm volatile("s_waitcnt vmcnt(0)" ::: "memory");
    __syncthreads();
    if (threadIdx.x == 0) {
        unsigned* bar = b.bar;
        __builtin_amdgcn_s_waitcnt(0);
        unsigned nloc = b.st[0], nx = b.st[1];
        if (nloc == 0u) { xcd_barrier_complete(bar, b.x, nloc, nx); b.st[0] = nloc; b.st[1] = nx; }
        const unsigned old = xb_add(&bar[XB_XSUB(b.x)], 1u);
        const unsigned gen = old / nloc;
        if (old + 1u == (gen + 1u) * nloc) {
            __builtin_amdgcn_fence(__ATOMIC_RELEASE, "agent");
            asm volatile("s_waitcnt vmcnt(0)" ::: "memory");
            const unsigned og = xb_add(&bar[XB_TOP], 1u);
            const unsigned tg = og / nx;
            if (og + 1u == (tg + 1u) * nx) xb_add(&bar[XB_TOPGEN], 1u);
            else XB_SPIN(xb_ld(&bar[XB_TOPGEN]) == tg, bar);
            __builtin_amdgcn_fence(__ATOMIC_ACQUIRE, "agent");
            xb_add(&bar[XB_XGEN(b.x)], 1u);
            asm volatile("s_waitcnt vmcnt(0)" ::: "memory");
        } else {
            XB_SPIN(xb_ld(&bar[XB_XGEN(b.x)]) == gen, bar);
            __builtin_amdgcn_fence(__ATOMIC_ACQUIRE, "agent");
            asm volatile("s_waitcnt vmcnt(0)" ::: "memory");
        }
    }
    __syncthreads();
}

struct Args { const float* in[24]; float* out; unsigned char* ws; int ph_lo, ph_hi; };
enum { I_X = 0, I_RELB, I_N1G, I_WIN, I_AQG, I_AKG, I_BQG, I_BKG, I_SINK, I_CGW, I_CGB, I_CNG, I_WBA, I_WBB, I_WBC, I_WO, I_N2G, I_WRG, I_BRG, I_WRE, I_BRE, I_W1, I_W3, I_W2 };

struct Frame {
    LAS unsigned char* lds; LAS unsigned char* misc;
    unsigned* ctl;
    int tid, lane, wave, vcu, G, gw, NGW;
    const float* const* in; float* out; unsigned char* ws;
    bf16 *Z, *XN, *OCAT, *MERGED, *XS, *Y, *H;
    float *S, *GO; unsigned* MASK;
};

__device__ __forceinline__ float wave_sum(float v) {
#pragma unroll
    for (int o = 1; o < 64; o <<= 1) v += __shfl_xor(v, o);
    return v;
}
__device__ __forceinline__ float wave_max(float v) {
#pragma unroll
    for (int o = 1; o < 64; o <<= 1) v = fmaxf(v, __shfl_xor(v, o));
    return v;
}

template <class MAP>
__device__ __forceinline__ void transpose_item(const float* W, int N, bf16* WT, int dpitch, int koff, LAS float* scr, int item, int lane, const MAP& map) {
    const int nblk = N / 32, kb = item / nblk, nb = item % nblk, k0 = 64 * kb, n0 = 32 * nb;
    f32x4 v[8];
#pragma unroll
    for (int i = 0; i < 8; ++i) v[i] = *(const f32x4*)(W + (size_t)(k0 + 8 * i + (lane >> 3)) * N + n0 + 4 * (lane & 7));
#pragma unroll
    for (int i = 0; i < 8; ++i) { LAS float* d = scr + (8 * i + (lane >> 3)) * 33 + 4 * (lane & 7); d[0] = v[i].x; d[1] = v[i].y; d[2] = v[i].z; d[3] = v[i].w; }
    LDS_WAIT(); asm volatile("" ::: "memory");
    const int c = lane & 7;
#pragma unroll
    for (int j = 0; j < 4; ++j) { const int n = (lane >> 3) + 8 * j; const LAS float* s = scr + (8 * c) * 33 + n;
        v4u o; o.x = pk2(s[0 * 33], s[1 * 33]); o.y = pk2(s[2 * 33], s[3 * 33]); o.z = pk2(s[4 * 33], s[5 * 33]); o.w = pk2(s[6 * 33], s[7 * 33]);
        const int dr_ = map(n0 + n); if (dr_ >= 0) *(v4u*)(WT + (size_t)dr_ * dpitch + koff + k0 + 8 * c) = o; }
    LDS_WAIT(); asm volatile("" ::: "memory");
}
__device__ __forceinline__ float clamp8(float v) { return fminf(fmaxf(v, -440.0f), 440.0f); }
template <class MAP>
__device__ __forceinline__ void transpose_item_fp8(const float* W, int N, unsigned char* WT, int dpitch, float scale, LAS float* scr, int item, int lane, const MAP& map) {
    const int nblk = N / 32, kb = item / nblk, nb = item % nblk, k0 = 64 * kb, n0 = 32 * nb;
    f32x4 v[8];
#pragma unroll
    for (int i = 0; i < 8; ++i) v[i] = *(const f32x4*)(W + (size_t)(k0 + 8 * i + (lane >> 3)) * N + n0 + 4 * (lane & 7));
#pragma unroll
    for (int i = 0; i < 8; ++i) { LAS float* d = scr + (8 * i + (lane >> 3)) * 33 + 4 * (lane & 7); d[0] = v[i].x; d[1] = v[i].y; d[2] = v[i].z; d[3] = v[i].w; }
    LDS_WAIT(); asm volatile("" ::: "memory");
    const int c = lane & 7;
#pragma unroll
    for (int j = 0; j < 4; ++j) { const int n = (lane >> 3) + 8 * j; const LAS float* s = scr + (8 * c) * 33 + n;
        int w0 = 0, w1 = 0;
        w0 = __builtin_amdgcn_cvt_pk_fp8_f32(clamp8(s[0 * 33] * scale), clamp8(s[1 * 33] * scale), w0, false); w0 = __builtin_amdgcn_cvt_pk_fp8_f32(clamp8(s[2 * 33] * scale), clamp8(s[3 * 33] * scale), w0, true);
        w1 = __builtin_amdgcn_cvt_pk_fp8_f32(clamp8(s[4 * 33] * scale), clamp8(s[5 * 33] * scale), w1, false); w1 = __builtin_amdgcn_cvt_pk_fp8_f32(clamp8(s[6 * 33] * scale), clamp8(s[7 * 33] * scale), w1, true);
        const int dr_ = map(n0 + n); if (dr_ >= 0) *(v2u*)(WT + (size_t)dr_ * dpitch + k0 + 8 * c) = (v2u){(unsigned)w0, (unsigned)w1}; }
    LDS_WAIT(); asm volatile("" ::: "memory");
}
struct MapId { int off; __device__ __forceinline__ int operator()(int n) const { return off + n; } };
struct MapWin {
    __device__ __forceinline__ int operator()(int n) const {
        if (n < 512) return ZC_AQ + n;
        if (n < 640) return ZC_AK + (n - 512);
        if (n < 768) return ZC_AV + (n - 640);
        if (n < 1792) return ZC_IQ + (n - 768);
        if (n < 1856) return ZC_IK + (n - 1792);
        if (n < 1872) return ZC_IW + (n - 1856);
        if (n < 2896) return ZC_BQ + (n - 1872);
        if (n < 3152) return ZC_BK + (n - 2896);
        if (n < 3408) return ZC_BV + (n - 3152);
        if (n < 3664) return ZC_CQ + (n - 3408);
        if (n < 3920) return ZC_CK + (n - 3664);
        if (n < 4432) return ZC_CV + (n - 3920);
        if (n < 4448) return ZC_CG + (n - 4432);
        if (n < 4960) return ZC_CR + (n - 4448);
        return pg8::ZC_GA + (n - 4960);
    }
};
struct MapWin8 { __device__ __forceinline__ int operator()(int n) const { const int z = MapWin{}(n); return z < 3328 ? z : (z >= 4096 ? z - 768 : -1); } };
struct MapWinB { __device__ __forceinline__ int operator()(int n) const { const int z = MapWin{}(n); return (z >= 3328 && z < 4096) ? z - 3328 : -1; } };
struct MapW13 { int sel; __device__ __forceinline__ int operator()(int n) const { return 32 * (n >> 4) + 16 * sel + (n & 15); } };

__device__ __forceinline__ void load_row(const float* row, int lane, f32x4 (&v)[8]) {
    const f32x4* xr = (const f32x4*)row + lane;
#pragma unroll
    for (int j = 0; j < 8; ++j) v[j] = xr[64 * j];
}
__device__ __forceinline__ float row_rstd(const f32x4 (&v)[8]) {
    float s = 0.f;
#pragma unroll
    for (int j = 0; j < 8; ++j) s += (v[j].x * v[j].x + v[j].y * v[j].y) + (v[j].z * v[j].z + v[j].w * v[j].w);
    return rsqrtf(wave_sum(s) * (1.0f / 2048.0f) + EPS);
}
__device__ __forceinline__ void norm_store_bf16(const f32x4 (&v)[8], float rstd, const float* g, bf16* orow, int lane) {
    const f32x4* gr = (const f32x4*)g + lane; unsigned long long* o8 = (unsigned long long*)orow + lane;
#pragma unroll
    for (int j = 0; j < 8; ++j) { const f32x4 gg = gr[64 * j];
        o8[64 * j] = (unsigned long long)pk2(v[j].x * rstd * gg.x, v[j].y * rstd * gg.y) | ((unsigned long long)pk2(v[j].z * rstd * gg.z, v[j].w * rstd * gg.w) << 32); }
}

__device__ __forceinline__ void norm_store_fp8(const f32x4 (&v)[8], float rstd, const float* g, unsigned char* orow, int lane) {
    const f32x4* gr = (const f32x4*)g + lane; unsigned* o4 = (unsigned*)orow + lane;
#pragma unroll
    for (int j = 0; j < 8; ++j) { const f32x4 gg = gr[64 * j]; int w = 0;
        w = __builtin_amdgcn_cvt_pk_fp8_f32(clamp8(v[j].x * rstd * gg.x), clamp8(v[j].y * rstd * gg.y), w, false); w = __builtin_amdgcn_cvt_pk_fp8_f32(clamp8(v[j].z * rstd * gg.z), clamp8(v[j].w * rstd * gg.w), w, true);
        o4[64 * j] = (unsigned)w; }
}
__device__ __forceinline__ void convert_moe(Frame& F, int l, int part, int nparts, int lds_off) {
    LAS float* scr = (LAS float*)(F.lds + lds_off + F.wave * 8704);
    bf16* W13 = (bf16*)(F.ws + WS_W13); bf16* W2 = (bf16*)(F.ws + WS_W2);
    constexpr int I13 = (2048 / 64) * (512 / 32);
    constexpr int I2 = (512 / 64) * (2048 / 32);
    constexpr int NIT = NEXP * (2 * I13 + I2);
    const int it_lo = (int)((long)NIT * part / nparts), it_hi = (int)((long)NIT * (part + 1) / nparts);
    for (int it = it_lo + F.gw; it < it_hi; it += F.NGW) {
        const int e = it / (2 * I13 + I2); int r = it % (2 * I13 + I2);
        if (r < I13) { transpose_item_fp8(F.in[I_W1] + ((size_t)l * NEXP + e) * 2048 * 512, 512, (unsigned char*)W13 + (size_t)e * 1024 * 2048, 2048, 64.0f, scr, r, F.lane, MapW13{0}); continue; } r -= I13;
        if (r < I13) { transpose_item_fp8(F.in[I_W3] + ((size_t)l * NEXP + e) * 2048 * 512, 512, (unsigned char*)W13 + (size_t)e * 1024 * 2048, 2048, 64.0f, scr, r, F.lane, MapW13{1}); continue; } r -= I13;
        transpose_item_fp8(F.in[I_W2] + ((size_t)l * NEXP + e) * 512 * 2048, 2048, (unsigned char*)W2 + (size_t)e * 2048 * 512, 512, 32.0f, scr, r, F.lane, MapId{0});
    }
}

typedef short bf16x8_t __attribute__((ext_vector_type(8)));
typedef float f32x16 __attribute__((ext_vector_type(16)));
typedef short s16x4 __attribute__((ext_vector_type(4)));
__device__ __forceinline__ void indexer_segment(Frame& F, int b, int qb, int tlo, int thi) {
    const int lane = F.lane, n = lane & 15, kq = lane >> 4;
    const bf16* qrow = F.Z + (size_t)(b * 2048 + 16 * qb + n) * ZP;
    bf16x8_t iqf[16][2];
#pragma unroll
    for (int h = 0; h < 16; ++h)
#pragma unroll
        for (int ks = 0; ks < 2; ++ks) iqf[h][ks] = *(const bf16x8_t*)(qrow + ZC_IQ + h * 64 + 32 * ks + 8 * kq);
    float wv[16];
    { const v4u w0 = *(const v4u*)(qrow + ZC_IW), w1 = *(const v4u*)(qrow + ZC_IW + 8);
      wv[0] = bflo(w0.x); wv[1] = bfhi(w0.x); wv[2] = bflo(w0.y); wv[3] = bfhi(w0.y); wv[4] = bflo(w0.z); wv[5] = bfhi(w0.z); wv[6] = bflo(w0.w); wv[7] = bfhi(w0.w);
      wv[8] = bflo(w1.x); wv[9] = bfhi(w1.x); wv[10] = bflo(w1.y); wv[11] = bfhi(w1.y); wv[12] = bflo(w1.z); wv[13] = bfhi(w1.z); wv[14] = bflo(w1.w); wv[15] = bfhi(w1.w); }
    const bf16* kbase = F.Z + (size_t)(b * 2048 + n) * ZP + ZC_IK + 8 * kq;
    float* srow = F.S + (size_t)(b * 2048 + 16 * qb + n) * 2048 + 4 * kq;
    bf16x8_t a0 = *(const bf16x8_t*)(kbase + (size_t)(16 * tlo) * ZP), a1 = *(const bf16x8_t*)(kbase + (size_t)(16 * tlo) * ZP + 32);
#pragma unroll 1
    for (int tile = tlo; tile < thi; ++tile) {
        const int tn = tile + 1 < thi ? tile + 1 : tile;
        const bf16x8_t n0 = *(const bf16x8_t*)(kbase + (size_t)(16 * tn) * ZP), n1 = *(const bf16x8_t*)(kbase + (size_t)(16 * tn) * ZP + 32);
        f32x4 sc = (f32x4){0.f, 0.f, 0.f, 0.f};
#pragma unroll
        for (int h = 0; h < 16; ++h) {
            f32x4 c = __builtin_amdgcn_mfma_f32_16x16x32_bf16(a0, iqf[h][0], (f32x4){0.f, 0.f, 0.f, 0.f}, 0, 0, 0);
            c = __builtin_amdgcn_mfma_f32_16x16x32_bf16(a1, iqf[h][1], c, 0, 0, 0);
            sc[0] += wv[h] * fmaxf(c[0], 0.f); sc[1] += wv[h] * fmaxf(c[1], 0.f); sc[2] += wv[h] * fmaxf(c[2], 0.f); sc[3] += wv[h] * fmaxf(c[3], 0.f);
        }
        *(f32x4*)(srow + 16 * tile) = sc * 0.03125f;
        a0 = n0; a1 = n1;
    }
}

constexpr int FA_KP = 272, FA_VP = 320;
constexpr int FA_KOFF = 0, FA_VOFF = 2 * 64 * FA_KP, FA_BYTES = FA_VOFF + 2 * 64 * FA_VP;
__device__ __forceinline__ s16x4 fa_vtr(const LAS unsigned char* p) { return __builtin_bit_cast(s16x4, __builtin_amdgcn_ds_read_tr16_b64_v4i16((LAS s16x4*)p)); }
template <int MODE>
__device__ __forceinline__ void flash_unit(Frame& F, int l, int b, int g, int t0) {
    const int tid = F.tid, lane = F.lane, wave = F.wave, hh = wave & 3, qh = wave >> 2, r = lane & 31, hf = lane >> 5;
    const int qcol = (MODE == 0 ? ZC_AQ : ZC_BQ + 512 * g) + 128 * hh, kcol = MODE == 0 ? ZC_AK : ZC_BK + 128 * g, vcol = MODE == 0 ? ZC_AV : ZC_BV + 128 * g;
    const int ocol = (MODE == 0 ? 0 : 512 + 512 * g) + 128 * hh, hd = (MODE == 0 ? 0 : 4 + 4 * g) + hh;
    const int tq = t0 + 32 * qh + r; const size_t qrow = (size_t)(b * 2048 + tq);
    const LAS float* tab2 = (const LAS float*)(F.misc + MO_TAB2) + hd * 129;
    LAS unsigned char* lds = F.lds;
    bf16x8_t qf[8];
#pragma unroll
    for (int ks = 0; ks < 8; ++ks) qf[ks] = *(const bf16x8_t*)(F.Z + qrow * ZP + qcol + 16 * ks + 8 * hf);
    f32x16 oacc[4];
#pragma unroll
    for (int dt = 0; dt < 4; ++dt)
#pragma unroll
        for (int i = 0; i < 16; ++i) oacc[dt][i] = 0.f;
    float m_run = -1e30f, l_run = 0.f;
    const int tile_lo = MODE == 0 ? 0 : (t0 >= 128 ? t0 / 64 - 2 : 0), tile_hi = t0 / 64 + 1;
    const int skey = tid >> 4, sdc = tid & 15;
    v4u kreg[2], vreg[2];
    { const bf16* zr = F.Z + (size_t)(b * 2048 + 64 * tile_lo + skey) * ZP;
#pragma unroll
      for (int i = 0; i < 2; ++i) { kreg[i] = *(const v4u*)(zr + (size_t)(32 * i) * ZP + kcol + 8 * sdc); vreg[i] = *(const v4u*)(zr + (size_t)(32 * i) * ZP + vcol + 8 * sdc); } }
    const float sc2 = 0.08838834764831845f * 1.4426950408889634f;
    unsigned mwn[2] = {0xffffffffu, 0xffffffffu};
    if (MODE == 0) { mwn[0] = F.MASK[qrow * 64 + 2 * tile_lo]; mwn[1] = F.MASK[qrow * 64 + 2 * tile_lo + 1]; }
#pragma unroll 1
    for (int kt = tile_lo; kt < tile_hi; ++kt) {
        const int bf = (kt - tile_lo) & 1, s0 = 64 * kt;
        LAS unsigned char* kb = lds + FA_KOFF + bf * (64 * FA_KP); LAS unsigned char* vb = lds + FA_VOFF + bf * (64 * FA_VP);
#pragma unroll
        for (int i = 0; i < 2; ++i) { *(LAS v4u*)(kb + (skey + 32 * i) * FA_KP + 16 * sdc) = kreg[i]; *(LAS v4u*)(vb + (skey + 32 * i) * FA_VP + 16 * sdc) = vreg[i]; }
        __syncthreads();
        if (kt + 1 < tile_hi) { const bf16* zr = F.Z + (size_t)(b * 2048 + 64 * (kt + 1) + skey) * ZP;
#pragma unroll
            for (int i = 0; i < 2; ++i) { kreg[i] = *(const v4u*)(zr + (size_t)(32 * i) * ZP + kcol + 8 * sdc); vreg[i] = *(const v4u*)(zr + (size_t)(32 * i) * ZP + vcol + 8 * sdc); } }
        unsigned mw[2] = {mwn[0], mwn[1]};
        if (MODE == 0 && kt + 1 < tile_hi) { mwn[0] = F.MASK[qrow * 64 + 2 * (kt + 1)]; mwn[1] = F.MASK[qrow * 64 + 2 * (kt + 1) + 1]; }
        f32x16 sacc[2];
#pragma unroll
        for (int k2 = 0; k2 < 2; ++k2) {
#pragma unroll
            for (int i = 0; i < 16; ++i) sacc[k2][i] = 0.f;
#pragma unroll
            for (int ks = 0; ks < 8; ++ks) { const bf16x8_t kf = *(const LAS bf16x8_t*)(kb + (32 * k2 + r) * FA_KP + (16 * ks + 8 * hf) * 2);
                sacc[k2] = __builtin_amdgcn_mfma_f32_32x32x16_bf16(kf, qf[ks], sacc[k2], 0, 0, 0); }
        }
        float mx = -1e30f;
        if (MODE == 0 && s0 + 63 + 128 <= t0) {
            const float bfar = tab2[128];
#pragma unroll
            for (int k2 = 0; k2 < 2; ++k2)
#pragma unroll
                for (int i = 0; i < 16; ++i) { const int cr = (i & 3) + 8 * (i >> 2) + 4 * hf;
                    const float v = ((mw[k2] >> cr) & 1u) ? sacc[k2][i] * sc2 + bfar : -__builtin_inff();
                    sacc[k2][i] = v; mx = fmaxf(mx, v); }
        } else
#pragma unroll
        for (int k2 = 0; k2 < 2; ++k2)
#pragma unroll
            for (int i = 0; i < 16; ++i) { const int cr = (i & 3) + 8 * (i >> 2) + 4 * hf; const int dist = tq - (s0 + 32 * k2 + cr);
                bool ok; if (MODE == 0) ok = (mw[k2] >> cr) & 1u; else ok = dist >= 0 && dist < 128;
                const int di = dist < 0 ? 0 : (dist > 128 ? 128 : dist);
                float vf = sacc[k2][i] * sc2 + tab2[di];
                asm volatile("" : "+v"(vf));
                const float v = ok ? vf : -__builtin_inff();
                sacc[k2][i] = v; mx = fmaxf(mx, v); }
        { const auto sw_ = __builtin_amdgcn_permlane32_swap(__float_as_uint(mx), __float_as_uint(mx), false, false); mx = fmaxf(__uint_as_float(sw_[0]), __uint_as_float(sw_[1])); }
        const float m_new = fmaxf(m_run, mx), alpha = __builtin_amdgcn_exp2f(m_run - m_new); m_run = m_new;
        float ps = 0.f;
#pragma unroll
        for (int k2 = 0; k2 < 2; ++k2)
#pragma unroll
            for (int i = 0; i < 16; ++i) { const float p = __builtin_amdgcn_exp2f(sacc[k2][i] - m_new); sacc[k2][i] = p; ps += p; }
        l_run = l_run * alpha + ps;
        if (__ballot(alpha != 1.0f)) {
#pragma unroll
        for (int dt = 0; dt < 4; ++dt)
#pragma unroll
            for (int i = 0; i < 16; ++i) oacc[dt][i] *= alpha;
        }
#pragma unroll
        for (int k2 = 0; k2 < 2; ++k2)
#pragma unroll
            for (int s2 = 0; s2 < 2; ++s2) {
                v4u pw; pw.x = pg8::cvt_pk_bf16(sacc[k2][8 * s2 + 0], sacc[k2][8 * s2 + 1]); pw.y = pg8::cvt_pk_bf16(sacc[k2][8 * s2 + 2], sacc[k2][8 * s2 + 3]);
                pw.z = pg8::cvt_pk_bf16(sacc[k2][8 * s2 + 4], sacc[k2][8 * s2 + 5]); pw.w = pg8::cvt_pk_bf16(sacc[k2][8 * s2 + 6], sacc[k2][8 * s2 + 7]);
                const bf16x8_t pb = __builtin_bit_cast(bf16x8_t, pw);
                const int i16 = lane & 15, grp = (lane >> 4) & 1;
                const LAS unsigned char* vp = vb + (32 * k2 + 16 * s2 + 4 * hf + (i16 >> 2)) * FA_VP + (16 * grp + 4 * (i16 & 3)) * 2;
#pragma unroll
                for (int dt = 0; dt < 4; ++dt) { const s16x4 lo = fa_vtr(vp + 64 * dt), hi = fa_vtr(vp + 8 * FA_VP + 64 * dt);
                    const bf16x8_t vf = __builtin_shufflevector(lo, hi, 0, 1, 2, 3, 4, 5, 6, 7);
                    oacc[dt] = __builtin_amdgcn_mfma_f32_32x32x16_bf16(vf, pb, oacc[dt], 0, 0, 0); }
            }
    }
    float l_tot = l_run + __shfl_xor(l_run, 32);
    if (MODE == 1) l_tot += __builtin_amdgcn_exp2f(F.in[I_SINK][l * 8 + hd - 4] * 1.4426950408889634f - m_run);
    const float inv = 1.0f / l_tot;
    bf16* orow = F.OCAT + qrow * 2048 + ocol + 4 * hf;
#pragma unroll
    for (int dt = 0; dt < 4; ++dt)
#pragma unroll
        for (int gq = 0; gq < 4; ++gq) { v2u w; w.x = pk2(oacc[dt][4 * gq] * inv, oacc[dt][4 * gq + 1] * inv); w.y = pk2(oacc[dt][4 * gq + 2] * inv, oacc[dt][4 * gq + 3] * inv);
            *(v2u*)(orow + 32 * dt + 8 * gq) = w; }
    __syncthreads();
}


#define GLA_GATE_PREFIX(LDS_TOT) \
        float la[8]; \
        _Pragma("unroll") for (int i = 0; i < 8; ++i) { const v4u c0 = rc0[i], c1 = rc1[i]; float x = gb; \
            x += bflo(c0.x) * gwv[0] + bfhi(c0.x) * gwv[1] + bflo(c0.y) * gwv[2] + bfhi(c0.y) * gwv[3] + bflo(c0.z) * gwv[4] + bfhi(c0.z) * gwv[5] + bflo(c0.w) * gwv[6] + bfhi(c0.w) * gwv[7]; \
            x += bflo(c1.x) * gwv[8] + bfhi(c1.x) * gwv[9] + bflo(c1.y) * gwv[10] + bfhi(c1.y) * gwv[11] + bflo(c1.z) * gwv[12] + bfhi(c1.z) * gwv[13] + bflo(c1.w) * gwv[14] + bfhi(c1.w) * gwv[15]; \
            la[i] = (fminf(x, 0.f) - log1pf(__expf(-fabsf(x)))) * 0.0625f; } \
        _Pragma("unroll") for (int i = 1; i < 8; ++i) la[i] += la[i - 1]; \
        ((LAS float*)(L + LDS_TOT))[cg * 64 + dk] = la[7];
#define GLA_OFFSETS(LDS_TOT) \
        float off = 0.f, tot = 0.f; \
        _Pragma("unroll") for (int g2 = 0; g2 < 8; ++g2) { const float tv = ((const LAS float*)(L + LDS_TOT))[g2 * 64 + dk]; tot += tv; off += g2 < cg ? tv : 0.f; }

__device__ __forceinline__ void gla_state_phase(Frame& F, int l) {
    const int tid = F.tid, lane = F.lane, wave = F.wave, r = lane & 31, hf = lane >> 5, i16 = lane & 15, grp = (lane >> 4) & 1;
    LAS unsigned char* L = F.lds;
    constexpr int KDT = 0, VT = 9216, TOT = 29696, RP = 144, VP = 320;
    const int dk = lane, cg = wave;
    float* GCS = (float*)(F.ws + WS_GCS); float* GDEC = (float*)(F.ws + WS_GDEC);
    v4u rc0[8], rc1[8], rv[2]; unsigned short rk[8];
#define GLS_LOAD(u_) do { const int bh_ = (u_) >> 5, n_ = (u_) & 31; const size_t r0_ = (size_t)((bh_ >> 2) * 2048 + 64 * n_); const int h_ = bh_ & 3; \
        _Pragma("unroll") for (int i = 0; i < 8; ++i) { const bf16* zr = F.Z + (r0_ + 8 * cg + i) * ZP; rc0[i] = *(const v4u*)(zr + ZC_CG); rc1[i] = *(const v4u*)(zr + ZC_CG + 8); rk[i] = zr[ZC_CK + h_ * 64 + dk]; } \
        _Pragma("unroll") for (int i = 0; i < 2; ++i) rv[i] = *(const v4u*)(F.Z + (r0_ + (tid >> 4) + 32 * i) * ZP + ZC_CV + h_ * 128 + 8 * (tid & 15)); } while (0)
    int u = F.vcu;
    if (u < 2048) GLS_LOAD(u);
    for (; u < 2048; u += F.G) {
        const int h = (u >> 5) & 3;
        float gwv[16];
#pragma unroll
        for (int q = 0; q < 16; ++q) gwv[q] = F.in[I_CGW][(size_t)l * 4096 + q * 256 + h * 64 + dk];
        const float gb = F.in[I_CGB][l * 256 + h * 64 + dk];
        GLA_GATE_PREFIX(TOT)
        float kv[8];
#pragma unroll
        for (int i = 0; i < 8; ++i) kv[i] = bf1(rk[i]);
#pragma unroll
        for (int i = 0; i < 2; ++i) *(LAS v4u*)(L + VT + ((tid >> 4) + 32 * i) * VP + 16 * (tid & 15)) = rv[i];
        __syncthreads();
        GLA_OFFSETS(TOT)
        { float kd[8];
#pragma unroll
          for (int i = 0; i < 8; ++i) kd[i] = kv[i] * __expf(tot - (off + la[i]));
          v4u w; w.x = pk2(kd[0], kd[1]); w.y = pk2(kd[2], kd[3]); w.z = pk2(kd[4], kd[5]); w.w = pk2(kd[6], kd[7]); *(LAS v4u*)(L + KDT + dk * RP + 16 * cg) = w; }
        if (cg == 0) GDEC[(size_t)u * 64 + dk] = __expf(tot);
        __syncthreads();
        if (u + F.G < 2048) GLS_LOAD(u + F.G);
        { const int dkt = wave >> 2, dvt = wave & 3;
          f32x16 cs;
#pragma unroll
          for (int i = 0; i < 16; ++i) cs[i] = 0.f;
#pragma unroll
          for (int ks = 0; ks < 4; ++ks) { const bf16x8_t a = *(const LAS bf16x8_t*)(L + KDT + (32 * dkt + r) * RP + (16 * ks + 8 * hf) * 2);
              const LAS unsigned char* vp = L + VT + (16 * ks + 8 * hf + (i16 >> 2)) * VP + (32 * dvt + 16 * grp + 4 * (i16 & 3)) * 2;
              const s16x4 lo = fa_vtr(vp), hi = fa_vtr(vp + 4 * VP);
              cs = __builtin_amdgcn_mfma_f32_32x32x16_bf16(a, __builtin_shufflevector(lo, hi, 0, 1, 2, 3, 4, 5, 6, 7), cs, 0, 0, 0); }
          float* gp = GCS + (size_t)u * 8192 + (size_t)(32 * dkt + 4 * hf) * 128 + 32 * dvt + r;
#pragma unroll
          for (int i = 0; i < 16; ++i) gp[((i & 3) + 8 * (i >> 2)) * 128] = cs[i]; }
        __syncthreads();
    }
#undef GLS_LOAD
}

__device__ __forceinline__ void gla_scan_phase(Frame& F) {
    float* GCS = (float*)(F.ws + WS_GCS); const float* GDEC = (const float*)(F.ws + WS_GDEC);
    for (int gt = F.gw * 64 + F.lane; gt < 64 * 2048; gt += F.NGW * 64) {
        const int bh = gt >> 11, e4 = gt & 2047, dk = e4 >> 5;
        f32x4* p = (f32x4*)(GCS + (size_t)bh * 32 * 8192) + e4; const float* dp = GDEC + (size_t)bh * 32 * 64 + dk;
        f32x4 st = (f32x4){0.f, 0.f, 0.f, 0.f};
#pragma unroll 1
        for (int n0 = 0; n0 < 32; n0 += 8) {
            f32x4 cs[8]; float dc[8];
#pragma unroll
            for (int j = 0; j < 8; ++j) { cs[j] = p[(size_t)(n0 + j) * 2048]; dc[j] = dp[(n0 + j) * 64]; }
#pragma unroll
            for (int j = 0; j < 8; ++j) { p[(size_t)(n0 + j) * 2048] = st; st = st * dc[j] + cs[j]; }
        }
    }
}

__device__ __forceinline__ void gla_out_phase(Frame& F, int l) {
    const int tid = F.tid, lane = F.lane, wave = F.wave, r = lane & 31, hf = lane >> 5, i16 = lane & 15, grp = (lane >> 4) & 1;
    LAS unsigned char* L = F.lds;
    constexpr int QG = 0, KG = 9216, VT = 18432, PT = 38912, TOT = 59392, OT = 61440, RP = 144, VP = 320, OP = 132;
    const int dk = lane, cg = wave;
    const float* GCS = (const float*)(F.ws + WS_GCS);
    v4u rc0[8], rc1[8], rv[2]; unsigned short rq[8], rk[8]; unsigned rg[8]; f32x4 rp[4];
#define GLO_LOAD(u_) do { const int bh_ = (u_) >> 5, n_ = (u_) & 31; const size_t r0_ = (size_t)((bh_ >> 2) * 2048 + 64 * n_); const int h_ = bh_ & 3; \
        _Pragma("unroll") for (int i = 0; i < 8; ++i) { const bf16* zr = F.Z + (r0_ + 8 * cg + i) * ZP; rc0[i] = *(const v4u*)(zr + ZC_CG); rc1[i] = *(const v4u*)(zr + ZC_CG + 8); rq[i] = zr[ZC_CQ + h_ * 64 + dk]; rk[i] = zr[ZC_CK + h_ * 64 + dk]; \
            rg[i] = *(const unsigned*)(zr + ZC_CR + h_ * 128 + 2 * lane); } \
        _Pragma("unroll") for (int i = 0; i < 2; ++i) rv[i] = *(const v4u*)(F.Z + (r0_ + (tid >> 4) + 32 * i) * ZP + ZC_CV + h_ * 128 + 8 * (tid & 15)); \
        _Pragma("unroll") for (int i = 0; i < 4; ++i) rp[i] = *(const f32x4*)(GCS + (size_t)(u_) * 8192 + (size_t)(tid >> 3) * 128 + 16 * (tid & 7) + 4 * i); } while (0)
    int u = F.vcu;
    if (u < 2048) GLO_LOAD(u);
    const float g0 = F.in[I_CNG][l * 128 + 2 * lane], g1 = F.in[I_CNG][l * 128 + 2 * lane + 1];
    for (; u < 2048; u += F.G) {
        const int bh = u >> 5, n = u & 31, h = bh & 3; const size_t row0 = (size_t)((bh >> 2) * 2048 + 64 * n);
        float gwv[16];
#pragma unroll
        for (int q = 0; q < 16; ++q) gwv[q] = F.in[I_CGW][(size_t)l * 4096 + q * 256 + h * 64 + dk];
        const float gb = F.in[I_CGB][l * 256 + h * 64 + dk];
        GLA_GATE_PREFIX(TOT)
        float qv[8], kv[8]; unsigned gr[8];
#pragma unroll
        for (int i = 0; i < 8; ++i) { qv[i] = bf1(rq[i]); kv[i] = bf1(rk[i]); gr[i] = rg[i]; }
#pragma unroll
        for (int i = 0; i < 2; ++i) *(LAS v4u*)(L + VT + ((tid >> 4) + 32 * i) * VP + 16 * (tid & 15)) = rv[i];
        { v4u w0, w1; w0.x = pk2(rp[0].x, rp[0].y); w0.y = pk2(rp[0].z, rp[0].w); w0.z = pk2(rp[1].x, rp[1].y); w0.w = pk2(rp[1].z, rp[1].w);
          w1.x = pk2(rp[2].x, rp[2].y); w1.y = pk2(rp[2].z, rp[2].w); w1.z = pk2(rp[3].x, rp[3].y); w1.w = pk2(rp[3].z, rp[3].w);
          *(LAS v4u*)(L + PT + (tid >> 3) * VP + 32 * (tid & 7)) = w0; *(LAS v4u*)(L + PT + (tid >> 3) * VP + 32 * (tid & 7) + 16) = w1; }
        __syncthreads();
        GLA_OFFSETS(TOT)
#pragma unroll
        for (int i = 0; i < 8; ++i) { const float bi = off + la[i];
            *(LAS bf16*)(L + QG + (8 * cg + i) * RP + 2 * dk) = (bf16)f2bf(qv[i] * 0.125f * __expf(bi));
            *(LAS bf16*)(L + KG + (8 * cg + i) * RP + 2 * dk) = (bf16)f2bf(kv[i] * __expf(-bi)); }
        __syncthreads();
        if (u + F.G < 2048) GLO_LOAD(u + F.G);
        { const int ct = wave >> 2, dvt = wave & 3;
          f32x16 o;
#pragma unroll
          for (int i = 0; i < 16; ++i) o[i] = 0.f;
#pragma unroll
          for (int st = 0; st < 2; ++st) if (st <= ct) {
              f32x16 at;
#pragma unroll
              for (int i = 0; i < 16; ++i) at[i] = 0.f;
#pragma unroll
              for (int ks = 0; ks < 4; ++ks) { const bf16x8_t a = *(const LAS bf16x8_t*)(L + KG + (32 * st + r) * RP + (16 * ks + 8 * hf) * 2), bq = *(const LAS bf16x8_t*)(L + QG + (32 * ct + r) * RP + (16 * ks + 8 * hf) * 2);
                  at = __builtin_amdgcn_mfma_f32_32x32x16_bf16(a, bq, at, 0, 0, 0); }
              if (st == ct) {
#pragma unroll
                  for (int i = 0; i < 16; ++i) { const int cr = (i & 3) + 8 * (i >> 2) + 4 * hf; at[i] = cr <= r ? at[i] : 0.f; } }
#pragma unroll
              for (int s2 = 0; s2 < 2; ++s2) {
                  v4u pw; pw.x = pg8::cvt_pk_bf16(at[8 * s2 + 0], at[8 * s2 + 1]); pw.y = pg8::cvt_pk_bf16(at[8 * s2 + 2], at[8 * s2 + 3]); pw.z = pg8::cvt_pk_bf16(at[8 * s2 + 4], at[8 * s2 + 5]); pw.w = pg8::cvt_pk_bf16(at[8 * s2 + 6], at[8 * s2 + 7]);
                  const LAS unsigned char* vp = L + VT + (32 * st + 16 * s2 + 4 * hf + (i16 >> 2)) * VP + (32 * dvt + 16 * grp + 4 * (i16 & 3)) * 2;
                  const s16x4 lo = fa_vtr(vp), hi = fa_vtr(vp + 8 * VP);
                  o = __builtin_amdgcn_mfma_f32_32x32x16_bf16(__builtin_bit_cast(bf16x8_t, pw), __builtin_shufflevector(lo, hi, 0, 1, 2, 3, 4, 5, 6, 7), o, 0, 0, 0);
              }
          }
#pragma unroll
          for (int ks = 0; ks < 4; ++ks) { const bf16x8_t a = *(const LAS bf16x8_t*)(L + QG + (32 * ct + r) * RP + (16 * ks + 8 * hf) * 2);
              const LAS unsigned char* pp = L + PT + (16 * ks + 8 * hf + (i16 >> 2)) * VP + (32 * dvt + 16 * grp + 4 * (i16 & 3)) * 2;
              const s16x4 lo = fa_vtr(pp), hi = fa_vtr(pp + 4 * VP);
              o = __builtin_amdgcn_mfma_f32_32x32x16_bf16(a, __builtin_shufflevector(lo, hi, 0, 1, 2, 3, 4, 5, 6, 7), o, 0, 0, 0); }
          LAS float* op = (LAS float*)(L + OT) + (32 * ct + 4 * hf) * OP + 32 * dvt + r;
#pragma unroll
          for (int i = 0; i < 16; ++i) op[((i & 3) + 8 * (i >> 2)) * OP] = o[i]; }
        __syncthreads();
        { float a[8], c[8], ss[8];
#pragma unroll
          for (int i = 0; i < 8; ++i) { const LAS float* orow = (const LAS float*)(L + OT) + (8 * wave + i) * OP + 2 * lane; a[i] = orow[0]; c[i] = orow[1]; ss[i] = a[i] * a[i] + c[i] * c[i]; }
#pragma unroll
          for (int o2 = 1; o2 < 64; o2 <<= 1) {
#pragma unroll
              for (int i = 0; i < 8; ++i) ss[i] += __shfl_xor(ss[i], o2); }
#pragma unroll
          for (int i = 0; i < 8; ++i) { const float rstd = rsqrtf(ss[i] * (1.0f / 128.0f) + EPS);
              *(unsigned*)(F.OCAT + (row0 + 8 * wave + i) * 2048 + 1536 + h * 128 + 2 * lane) = pk2(a[i] * rstd * g0 * bflo(gr[i]), c[i] * rstd * g1 * bfhi(gr[i])); } }
        __syncthreads();
    }
#undef GLO_LOAD
}
#undef GLA_GATE_PREFIX
#undef GLA_OFFSETS

__device__ __forceinline__ bool in_phase(int k, int lo, int hi) { asm volatile("" : "+s"(k)); return lo <= k && k < hi; }
#define IN(k) in_phase((k), lo, hi)
#define PHASE_LANE() do { int _tz = threadIdx.x; asm volatile("" : "+v"(_tz)); F.tid = _tz; F.lane = _tz & 63; } while (0)
#define SEAM(k) do { if (IN(k) && IN((k) + 1)) xcd_barrier(bar); } while (0)
template <int l>
__device__ __forceinline__ void layer_body(Frame& F, const XcdBarrier& bar, const int lo, const int hi) {
    constexpr int pb = 1 + 11 * l;
        if (IN(pb + 0)) {
            { pg8::Gemm g{F.XN, (const bf16*)(F.ws + WS_WIN + l * WIN_L + 24 * MiB), T, 768, D}; pg8::StaticOrder S; S.init(T, 768, D, F.G, (int)blockIdx.x);
              pg8::EpiInProj<1> E{F.Z, F.ws + WS_GT, (LAS unsigned long long*)(F.misc + MO_SS), (const LAS float*)(F.misc + MO_GN) + l * 512};
              pg8::gemm_phase<pg8::EpiInProj<1>, pg8::StaticOrder, true, false>(F.lds, g, S, E); }
            { pg8::Gemm g{(const bf16*)(F.ws + WS_XN8), (const bf16*)(F.ws + WS_WIN + l * WIN_L), T, 10496, D / 2}; pg8::StaticOrder S; S.init(T, 10496, D / 2, F.G, ((int)blockIdx.x + F.G / 2) % F.G);
              pg8::EpiInProj<0> E{F.Z, F.ws + WS_GT, (LAS unsigned long long*)(F.misc + MO_SS), (const LAS float*)(F.misc + MO_GN) + l * 512};
              pg8::gemm_phase<pg8::EpiInProj<0>, pg8::StaticOrder, true, true>(F.lds, g, S, E); }
        }
        SEAM(pb + 0);
        if (IN(pb + 1)) { PHASE_LANE();
            if (F.wave & 4) convert_moe(F, l, 0, 4, 40960);
            for (int it = F.gw; it < NB * 128; it += F.NGW) {
                const int b = it >> 7, j = it & 127;
                indexer_segment(F, b, j, 0, j < 64 ? j + 1 : 64);
                if (j < 64) indexer_segment(F, b, 127 - j, 64, 128 - j);
            }
            if (!(F.wave & 4)) convert_moe(F, l, 0, 4, 40960);
            PHASE_LANE();
            gla_state_phase(F, l);
        }
        SEAM(pb + 1);
        if (IN(pb + 2)) { PHASE_LANE();
            if (F.wave & 4) convert_moe(F, l, 1, 4, 0);
            for (int row = F.gw; row < T; row += F.NGW) {
                const int t = row & 2047;
                if (t < 256) { const int nb = t + 1 - 32 * F.lane; F.MASK[(size_t)row * 64 + F.lane] = nb >= 32 ? 0xffffffffu : (nb <= 0 ? 0u : ((1u << nb) - 1u)); continue; }
                float val[32];
#pragma unroll
                for (int j = 0; j < 32; ++j) { const int s_ = 64 * j + F.lane; val[j] = F.S[(size_t)row * 2048 + (s_ < t ? s_ : t)]; }
                float vmx = -3.0e38f, vmn = 3.0e38f;
#pragma unroll
                for (int j = 0; j < 32; ++j) { const bool ok = 64 * j + F.lane <= t; val[j] = ok ? val[j] : -3.0e38f; vmx = fmaxf(vmx, val[j]); vmn = fminf(vmn, ok ? val[j] : 3.0e38f); }
#pragma unroll
                for (int o = 1; o < 64; o <<= 1) { vmx = fmaxf(vmx, __shfl_xor(vmx, o)); vmn = fminf(vmn, __shfl_xor(vmn, o)); }
                float lo = vmn, hi = vmx, thf = 0.f; bool exact = false;
#pragma unroll 1
                for (int it = 0; it < 28; ++it) { const float mid = 0.5f * (lo + hi); if (!(mid > lo && mid < hi)) break; int cnt = 0;
#pragma unroll
                    for (int j = 0; j < 32; ++j) cnt += __popcll(__ballot(val[j] >= mid));
                    if (cnt == 256) { exact = true; thf = mid; break; }
                    if (cnt > 256) lo = mid; else hi = mid; }
                unsigned th = 0u; int need = 0;
#define KEYOF(x) ({ const unsigned u_ = __float_as_uint(x); (u_ & 0x80000000u) ? ~u_ : (u_ | 0x80000000u); })
                if (!exact) {
#pragma unroll 1
                    for (int bit = 31; bit >= 0; --bit) { const unsigned cand = th | (1u << bit); int cnt = 0;
#pragma unroll
                        for (int j = 0; j < 32; ++j) cnt += __popcll(__ballot(KEYOF(val[j]) >= cand));
                        if (cnt >= 256) th = cand; }
                    int cgt = 0;
#pragma unroll
                    for (int j = 0; j < 32; ++j) cgt += __popcll(__ballot(KEYOF(val[j]) > th));
                    need = 256 - cgt;
                }
                int run = 0; unsigned myword = 0u;
#pragma unroll
                for (int j = 0; j < 32; ++j) {
                    bool sel;
                    if (exact) sel = val[j] >= thf;
                    else { const unsigned kj = KEYOF(val[j]); const bool eq = kj == th; const unsigned long long eqm = __ballot(eq);
                        const int pre = run + __popcll(eqm & ((1ull << F.lane) - 1ull)); sel = (kj > th) || (eq && pre < need); run += __popcll(eqm); sel = sel && (64 * j + F.lane <= t); }
                    const unsigned long long sm = __ballot(sel);
                    if ((F.lane >> 1) == j) myword = (F.lane & 1) ? (unsigned)(sm >> 32) : (unsigned)sm;
                }
#undef KEYOF
                F.MASK[(size_t)row * 64 + F.lane] = myword;
            }
            if (!(F.wave & 4)) convert_moe(F, l, 1, 4, 0);
            gla_scan_phase(F);
        }
        SEAM(pb + 2);
        if (IN(pb + 3)) { PHASE_LANE();
            if (F.vcu & 1) { convert_moe(F, l, 1, 2, 0); __syncthreads(); PHASE_LANE(); }
            for (int u = F.vcu; u < NB * 16; u += F.G) { const int b = u >> 4, p = u & 15; flash_unit<0>(F, l, b, 0, 64 * (31 - p)); flash_unit<0>(F, l, b, 0, 64 * p); }
            for (int u = F.vcu; u < NB * 2 * 32; u += F.G) { const int b = u >> 6, g = (u >> 5) & 1, qb = u & 31; flash_unit<1>(F, l, b, g, 64 * qb); }
            gla_out_phase(F, l);
            if (!(F.vcu & 1)) { PHASE_LANE(); convert_moe(F, l, 1, 2, 0); }
        }
        SEAM(pb + 3);
        if (IN(pb + 4)) {
            pg8::Gemm g{F.OCAT, (const bf16*)(F.ws + WS_WBR + l * WBR_L), T, D, D}; pg8::MergeOrder S; S.init(T, D, D, F.G, (int)blockIdx.x);
#ifdef PROBE_MERGE
            { pg8::EpiMergeT<PROBE_MERGE> E{F.ws + WS_GT, (bf16*)(F.ws + WS_S)}; pg8::gemm_phase<pg8::EpiMergeT<PROBE_MERGE>, pg8::MergeOrder, true>(F.lds, g, S, E); }
#endif
            pg8::EpiMerge E{F.ws + WS_GT, F.MERGED};
            pg8::gemm_phase<pg8::EpiMerge, pg8::MergeOrder, true>(F.lds, g, S, E);
        }
        SEAM(pb + 4);
        if (IN(pb + 5)) {
            pg8::Gemm g{F.MERGED, (const bf16*)(F.ws + WS_WO + l * WO_L), T, D, D}; pg8::StaticOrder S; S.init(T, D, D, F.G, (int)blockIdx.x);
            pg8::EpiResid E{(bf16*)(F.ws + WS_HB), (unsigned char*)F.XN, F.in[I_N2G] + l * D, F.lds + 3 * pg8::HTB};
            pg8::gemm_phase<pg8::EpiResid, pg8::StaticOrder, true>(F.lds, g, S, E);
        }
        SEAM(pb + 5);
        if (IN(pb + 6)) { PHASE_LANE();
            unsigned* cnt = F.ctl + CW_CNT + 64 * l;
            const int lane = F.lane, fr = lane & 15, fq = lane >> 4;
            LAS float* LG = (LAS float*)(F.lds + F.wave * 8192);
            const bf16* wrh = (const bf16*)(F.ws + WS_WRH + l * WR_L) + (size_t)fr * 2048 + 8 * fq; const bf16* wrl = (const bf16*)(F.ws + WS_WRL + l * WR_L) + (size_t)fr * 2048 + 8 * fq;
            for (int tile = F.gw; tile < T / 16; tile += F.NGW) {
                const bf16* hrow = (const bf16*)(F.ws + WS_HB) + (size_t)(16 * tile + fr) * D + 8 * fq;
                f32x4 acc[6];
#pragma unroll
                for (int nt = 0; nt < 6; ++nt) acc[nt] = (f32x4){0.f, 0.f, 0.f, 0.f};
                float ss = 0.f;
#pragma unroll 2
                for (int ks = 0; ks < 64; ++ks) {
                    const v4u hw = *(const v4u*)(hrow + 32 * ks);
                    { const float a0 = bflo(hw.x), a1 = bfhi(hw.x), a2 = bflo(hw.y), a3 = bfhi(hw.y), a4 = bflo(hw.z), a5 = bfhi(hw.z), a6 = bflo(hw.w), a7 = bfhi(hw.w);
                      ss += (a0 * a0 + a1 * a1) + (a2 * a2 + a3 * a3) + (a4 * a4 + a5 * a5) + (a6 * a6 + a7 * a7); }
                    const bf16x8_t ah = __builtin_bit_cast(bf16x8_t, hw);
#pragma unroll
                    for (int nt = 0; nt < 6; ++nt) { const bf16x8_t bh = *(const bf16x8_t*)(wrh + (size_t)(16 * nt) * 2048 + 32 * ks), bl = *(const bf16x8_t*)(wrl + (size_t)(16 * nt) * 2048 + 32 * ks);
                        acc[nt] = __builtin_amdgcn_mfma_f32_16x16x32_bf16(ah, bh, acc[nt], 0, 0, 0);
                        acc[nt] = __builtin_amdgcn_mfma_f32_16x16x32_bf16(ah, bl, acc[nt], 0, 0, 0); }
                }
                ss += __shfl_xor(ss, 16); ss += __shfl_xor(ss, 32);
                if (fq == 0) { const float rs_ = rsqrtf(ss * (1.0f / 2048.0f) + EPS); LG[1600 + fr] = rs_; ((float*)(F.ws + WS_RSTD))[16 * tile + fr] = rs_; }
#pragma unroll
                for (int nt = 0; nt < 6; ++nt)
#pragma unroll
                    for (int i = 0; i < 4; ++i) LG[(4 * fq + i) * 100 + 16 * nt + fr] = acc[nt][i];
                LDS_WAIT(); asm volatile("" ::: "memory");
                if (lane < 16) {
                    const int row = 16 * tile + lane; const float rstd = LG[1600 + lane]; const LAS float* lr = LG + lane * 100;
                    float lg[8]; int grp = 0; float gmax = -3.0e38f;
#pragma unroll
                    for (int e = 0; e < 8; ++e) { lg[e] = lr[e] * rstd + F.in[I_BRG][l * 8 + e]; if (lg[e] > gmax) { gmax = lg[e]; grp = e; } }
                    float gden = 0.f;
#pragma unroll
                    for (int e = 0; e < 8; ++e) gden += __expf(lg[e] - gmax);
                    const float gwt = 1.0f / gden;
                    int i0 = 0, i1 = 0; float m0 = -3.0e38f, m1 = -3.0e38f;
#pragma unroll
                    for (int e = 0; e < 8; ++e) { const float v = lr[8 + grp * 8 + e] * rstd + F.in[I_BRE][l * 64 + grp * 8 + e];
                        if (v > m0) { m1 = m0; i1 = i0; m0 = v; i0 = e; } else if (v > m1) { m1 = v; i1 = e; } }
                    const float e1 = __expf(m1 - m0); const float p0 = 1.0f / (1.0f + e1), p1 = e1 / (1.0f + e1);
                    const int ex0 = grp * 8 + i0, ex1 = grp * 8 + i1;
                    const unsigned r0 = atomicAdd(&cnt[ex0], 1u), r1 = atomicAdd(&cnt[ex1], 1u);
                    unsigned* rec = (unsigned*)(F.ws + WS_ROUTE) + (size_t)row * 8;
                    rec[0] = (unsigned)ex0; rec[1] = r0; rec[2] = (unsigned)ex1; rec[3] = r1; rec[4] = __float_as_uint(gwt * p0); rec[5] = __float_as_uint(gwt * p1);
                    int* liste = (int*)(F.ws + WS_LISTE); liste[(size_t)ex0 * 32768 + r0] = row; liste[(size_t)ex1 * 32768 + r1] = row;
                }
                LDS_WAIT(); asm volatile("" ::: "memory");
            }
        }
        SEAM(pb + 6);
        if (IN(pb + 7) || IN(pb + 8) || IN(pb + 9) || IN(pb + 10)) { PHASE_LANE();
            if (F.tid == 0) { const unsigned* cnt = F.ctl + CW_CNT + 64 * l; LAS int* texp = (LAS int*)(F.misc + MO_TEXP); LAS int* pst = (LAS int*)(F.misc + MO_PST); int tb = 0;
                for (int e = 0; e < NEXP; ++e) { const int c = (int)__hip_atomic_load(&cnt[e], __ATOMIC_RELAXED, __HIP_MEMORY_SCOPE_AGENT); const int nt_ = (c + 255) >> 8; pst[e] = tb * 256; ((LAS int*)(F.misc + MO_CNT))[e] = c;
                    for (int r = 0; r < nt_; ++r) texp[tb + r] = e; tb += nt_; }
                *(LAS int*)(F.misc + MO_TOT) = tb; }
            __syncthreads();
        }
        if (IN(pb + 8)) {
            pg8::Gemm g{F.XN, (const bf16*)(F.ws + WS_W13), 0, 0, D / 2};
            pg8::MoeGatherOrder S; S.total = *(const LAS int*)(F.misc + MO_TOT) * 4; S.G = F.G; S.c = F.vcu; S.NJ = 4; S.nt0 = D / 128; S.tile_exp = (const LAS int*)(F.misc + MO_TEXP);
            S.pst = (const LAS int*)(F.misc + MO_PST); S.cnt = (const LAS int*)(F.misc + MO_CNT); S.liste = (const int*)(F.ws + WS_LISTE);
            pg8::EpiGlu E{F.H, S.tile_exp, S.pst, S.cnt, S.liste, (const float*)(F.ws + WS_RSTD)};
            pg8::gemm_phase<pg8::EpiGlu, pg8::MoeGatherOrder, true, true>(F.lds, g, S, E);
        }
        SEAM(pb + 8);
        if (IN(pb + 9)) {
            pg8::Gemm g{F.H, (const bf16*)(F.ws + WS_W2), 0, 0, DEXP / 2};
            pg8::MoeOrder S{*(const LAS int*)(F.misc + MO_TOT) * 8, F.G, F.vcu, 8, DEXP / 128, (const LAS int*)(F.misc + MO_TEXP)};
            pg8::EpiY E{(unsigned char*)F.Y};
            pg8::gemm_phase<pg8::EpiY, pg8::MoeOrder, true, true>(F.lds, g, S, E);
        }
        SEAM(pb + 9);
        if (IN(pb + 10)) { PHASE_LANE();
            for (int row = F.gw; row < T; row += F.NGW) {
                const unsigned* rec = (const unsigned*)(F.ws + WS_ROUTE) + (size_t)row * 8;
                const float w0 = __uint_as_float(rec[4]) * 0.03125f, w1 = __uint_as_float(rec[5]) * 0.03125f;
                const LAS int* pst = (const LAS int*)(F.misc + MO_PST); const int p0 = pst[rec[0]] + (int)rec[1], p1 = pst[rec[2]] + (int)rec[3];
                const unsigned* y0 = (const unsigned*)((const unsigned char*)F.Y + (size_t)p0 * D) + F.lane; const unsigned* y1 = (const unsigned*)((const unsigned char*)F.Y + (size_t)p1 * D) + F.lane;
                f32x4 v[8];
                { const v2u* hr = (const v2u*)((const bf16*)(F.ws + WS_HB) + (size_t)row * D) + F.lane;
#pragma unroll
                  for (int j = 0; j < 8; ++j) { const v2u w = hr[64 * j]; v[j] = (f32x4){bflo(w.x), bfhi(w.x), bflo(w.y), bfhi(w.y)}; } }
#pragma unroll
                for (int j = 0; j < 8; ++j) { const int a = (int)y0[64 * j], c = (int)y1[64 * j];
                    const auto a01 = __builtin_amdgcn_cvt_pk_f32_fp8(a, false), a23 = __builtin_amdgcn_cvt_pk_f32_fp8(a, true), c01 = __builtin_amdgcn_cvt_pk_f32_fp8(c, false), c23 = __builtin_amdgcn_cvt_pk_f32_fp8(c, true);
                    v[j].x += w0 * a01[0] + w1 * c01[0]; v[j].y += w0 * a01[1] + w1 * c01[1]; v[j].z += w0 * a23[0] + w1 * c23[0]; v[j].w += w0 * a23[1] + w1 * c23[1]; }
                if (l + 1 < DEPTH) { v2u* hw_ = (v2u*)((bf16*)(F.ws + WS_HB) + (size_t)row * D) + F.lane;
#pragma unroll
                    for (int j = 0; j < 8; ++j) hw_[64 * j] = (v2u){pg8::cvt_pk_bf16(v[j].x, v[j].y), pg8::cvt_pk_bf16(v[j].z, v[j].w)}; }
                else { f32x4* orow = (f32x4*)(F.out + (size_t)row * D) + F.lane;
#pragma unroll
                    for (int j = 0; j < 8; ++j) orow[64 * j] = v[j]; }
                if (l + 1 < DEPTH) { const float rstd = row_rstd(v); norm_store_bf16(v, rstd, F.in[I_N1G] + (l + 1) * D, F.XN + (size_t)row * D, F.lane); norm_store_fp8(v, rstd, F.in[I_N1G] + (l + 1) * D, (unsigned char*)(F.ws + WS_XN8) + (size_t)row * D, F.lane); }
            }
        }
        SEAM(pb + 10);
    }
__global__ void __launch_bounds__(NWAVES * 64, 2) fwd_kernel(Args args) {
    extern __shared__ __attribute__((aligned(16))) unsigned char lds_raw[];
    Frame F;
    F.lds = (LAS unsigned char*)lds_raw; F.misc = F.lds + MISC_OFF;
    F.tid = threadIdx.x; F.lane = F.tid & 63; F.wave = __builtin_amdgcn_readfirstlane(F.tid >> 6);
    F.G = gridDim.x; { const int bx = blockIdx.x; F.vcu = (F.G % 8 == 0) ? (bx % 8) * (F.G / 8) + bx / 8 : bx; }
    F.gw = F.vcu * NWAVES + F.wave; F.NGW = F.G * NWAVES;
    F.in = args.in; F.out = args.out; F.ws = args.ws; F.ctl = (unsigned*)(args.ws + WS_CTL);
    F.Z = (bf16*)(args.ws + WS_Z); F.XN = (bf16*)(args.ws + WS_XN); F.OCAT = (bf16*)(args.ws + WS_OCAT); F.MERGED = (bf16*)(args.ws + WS_MERGED);
    F.XS = (bf16*)(args.ws + WS_XS); F.Y = (bf16*)(args.ws + WS_Y); F.H = (bf16*)(args.ws + WS_H);
    F.S = (float*)(args.ws + WS_S); F.GO = (float*)(args.ws + WS_GO); F.MASK = (unsigned*)(args.ws + WS_MASK);
    const int lo = args.ph_lo, hi = args.ph_hi;
    const bool use_bar = (hi - lo) > 1;
    for (int u = F.tid; u < 64; u += NWAVES * 64) ((LAS unsigned*)F.misc)[u] = 0u;
    ((LAS unsigned long long*)(F.misc + MO_SS))[F.tid] = 0ull;
    for (int i = F.tid; i < 2 * 4 * 128; i += NWAVES * 64) { const int l_ = i >> 9, k_ = (i >> 7) & 3, d_ = i & 127; ((LAS float*)(F.misc + MO_GN))[i] = F.in[k_ == 0 ? I_AQG : (k_ == 1 ? I_AKG : (k_ == 2 ? I_BQG : I_BKG))][l_ * 128 + d_]; }
    for (int i = F.tid; i < 12 * 129; i += NWAVES * 64) { const int hd = i / 129, dd = i % 129; int bk;
        if (dd < 16) bk = dd; else { bk = 16 + (int)(logf((float)dd / 16.0f) / 2.0794415416798357f * 16.0f); bk = bk > 31 ? 31 : bk; }
        ((LAS float*)(F.misc + MO_TAB2))[i] = F.in[I_RELB][bk * 12 + hd] * 1.4426950408889634f; }
    __syncthreads();
    XcdBarrier bar; bar.bar = F.ctl + CW_BAR; bar.x = 0; bar.st = nullptr;
    if (use_bar) bar = xcd_barrier_post(F.ctl + CW_BAR, (volatile LAS unsigned*)(F.misc + MO_BARW));

    if (IN(0)) { PHASE_LANE();
        LAS float* scr = (LAS float*)(F.lds + F.wave * 16384);
        constexpr int I_IN = (2048 / 64) * (D_IN / 32);
        constexpr int I_BA = (512 / 64) * (2048 / 32), I_BB = (1024 / 64) * (2048 / 32), I_BC = I_BA, I_O = (2048 / 64) * (2048 / 32);
        constexpr int PER_L = I_IN + I_BA + I_BB + I_BC + I_O;
        for (int it = F.gw; it < DEPTH * PER_L; it += F.NGW) {
            const int l = it / PER_L; int r = it % PER_L;
            bf16* win = (bf16*)(F.ws + WS_WIN + l * WIN_L); bf16* wbr = (bf16*)(F.ws + WS_WBR + l * WBR_L); bf16* wo = (bf16*)(F.ws + WS_WO + l * WO_L);
            if (r < I_IN) { const int nb_ = r % (D_IN / 32);
                const bool has8 = nb_ < 56 || (nb_ >= 58 && nb_ <= 106) || nb_ >= 122, hasb = (nb_ >= 56 && nb_ <= 58) || (nb_ >= 106 && nb_ <= 122) || nb_ == 138;
                if (has8) transpose_item_fp8(F.in[I_WIN] + (size_t)l * 2048 * D_IN, D_IN, (unsigned char*)win, 2048, 64.0f, scr, r, F.lane, MapWin8{});
                if (hasb) transpose_item(F.in[I_WIN] + (size_t)l * 2048 * D_IN, D_IN, win + (size_t)12 * 1024 * 1024, 2048, 0, scr, r, F.lane, MapWinB{});
                continue; } r -= I_IN;
            if (r < I_BA) { transpose_item(F.in[I_WBA] + (size_t)l * 512 * 2048, 2048, wbr, 2048, 0, scr, r, F.lane, MapId{0}); continue; } r -= I_BA;
            if (r < I_BB) { transpose_item(F.in[I_WBB] + (size_t)l * 1024 * 2048, 2048, wbr, 2048, 512, scr, r, F.lane, MapId{0}); continue; } r -= I_BB;
            if (r < I_BC) { transpose_item(F.in[I_WBC] + (size_t)l * 512 * 2048, 2048, wbr, 2048, 1536, scr, r, F.lane, MapId{0}); continue; } r -= I_BC;
            transpose_item(F.in[I_WO] + (size_t)l * 2048 * 2048, 2048, wo, 2048, 0, scr, r, F.lane, MapId{0});
        }
        for (int i = F.gw * 64 + F.lane; i < DEPTH * 160 * 256; i += F.NGW * 64) { const int l = i / (160 * 256), r = (i / 256) % 160, c = i % 256;
            *(v4u*)((bf16*)(F.ws + WS_WIN + l * WIN_L) + (size_t)12 * 1024 * 1024 + (size_t)(ZC_PAD - 3328 + r) * 2048 + 8 * c) = (v4u){0u, 0u, 0u, 0u}; }
        for (int i = F.gw * 64 + F.lane; i < DEPTH * 96 * 2048; i += F.NGW * 64) { const int l = i / (96 * 2048), e = (i / 2048) % 96, k = i % 2048;
            float val = 0.f; if (e < 8) val = F.in[I_WRG][(size_t)l * D * 8 + (size_t)k * 8 + e]; else if (e < 72) val = F.in[I_WRE][(size_t)l * D * 64 + (size_t)k * 64 + (e - 8)];
            val *= F.in[I_N2G][l * D + k];
            const unsigned hi = f2bf(val); const float rem = val - bf1((bf16)hi);
            ((bf16*)(F.ws + WS_WRH + l * WR_L))[e * 2048 + k] = (bf16)hi; ((bf16*)(F.ws + WS_WRL + l * WR_L))[e * 2048 + k] = (bf16)f2bf(rem); }
        for (int mrow = F.gw; mrow < T; mrow += F.NGW) { f32x4 v[8]; load_row(F.in[I_X] + (size_t)mrow * D, F.lane, v); const float rstd = row_rstd(v);
            { v2u* hw_ = (v2u*)((bf16*)(F.ws + WS_HB) + (size_t)mrow * D) + F.lane;
#pragma unroll
              for (int j = 0; j < 8; ++j) hw_[64 * j] = (v2u){pg8::cvt_pk_bf16(v[j].x, v[j].y), pg8::cvt_pk_bf16(v[j].z, v[j].w)}; }
            norm_store_bf16(v, rstd, F.in[I_N1G], F.XN + (size_t)mrow * D, F.lane); norm_store_fp8(v, rstd, F.in[I_N1G], (unsigned char*)(F.ws + WS_XN8) + (size_t)mrow * D, F.lane); }
    }
    SEAM(0);

    layer_body<0>(F, bar, lo, hi);
    layer_body<1>(F, bar, lo, hi);
}


#ifndef N_LAUNCH_MODE
#define N_LAUNCH_MODE 1
#endif
extern "C" void kernel_launch(void* const* d_in, const int* in_sizes, int n_in, void* d_out, int out_size, void* d_ws, size_t ws_size, hipStream_t stream) {
    static int grid = 0;
    if (grid == 0) {
        if (n_in != 24 || out_size != T * D || ws_size < WS_END) { fprintf(stderr, "kernel_launch: unexpected shapes (n_in %d out %d ws %zu)\n", n_in, out_size, ws_size); grid = -1; return; }
        int dev = 0, cus = 0, per_cu = 0;
        if (hipGetDevice(&dev) != hipSuccess || hipDeviceGetAttribute(&cus, hipDeviceAttributeMultiprocessorCount, dev) != hipSuccess) { grid = -1; return; }
        if (hipFuncSetAttribute((const void*)fwd_kernel, hipFuncAttributeMaxDynamicSharedMemorySize, LDS_BYTES) != hipSuccess) { fprintf(stderr, "kernel_launch: hipFuncSetAttribute failed\n"); grid = -1; return; }
        if (hipOccupancyMaxActiveBlocksPerMultiprocessor(&per_cu, (const void*)fwd_kernel, NWAVES * 64, LDS_BYTES) != hipSuccess || per_cu < 1) { fprintf(stderr, "kernel_launch: occupancy query says %d\n", per_cu); }
        (void)hipGetLastError();
        grid = cus;
    }
    if (grid < 0) return;
    (void)hipMemsetAsync((char*)d_ws + WS_CTL, 0, CTL_ZERO_BYTES, stream);
    Args a{};
    for (int i = 0; i < 24; ++i) a.in[i] = (const float*)d_in[i];
    a.out = (float*)d_out; a.ws = (unsigned char*)d_ws;
    constexpr int NPH = 1 + 11 * DEPTH;
#if N_LAUNCH_MODE == 1
    a.ph_lo = 0; a.ph_hi = NPH;
    hipLaunchKernelGGL(fwd_kernel, dim3(grid), dim3(NWAVES * 64), LDS_BYTES, stream, a);
#else
    for (int p = 0; p < NPH; ++p) { a.ph_lo = p; a.ph_hi = p + 1; hipLaunchKernelGGL(fwd_kernel, dim3(grid), dim3(NWAVES * 64), LDS_BYTES, stream, a); }
#endif
    const hipError_t le = hipPeekAtLastError();
    if (le != hipSuccess) fprintf(stderr, "kernel_launch: launch failed: %s\n", hipGetErrorName(le));
}
```

```cpp
#include <hip/hip_runtime.h>
#include <cstdio>
#include <cstdint>

__device__ __forceinline__ int lane_id() { return (int)__builtin_amdgcn_mbcnt_hi(~0u, __builtin_amdgcn_mbcnt_lo(~0u, 0u)); }
namespace pg8 {
#define PG8_LAS __attribute__((address_space(3)))
typedef unsigned short bf16_t;
typedef short bf16x8 __attribute__((ext_vector_type(8)));
typedef float f32x4 __attribute__((ext_vector_type(4)));
typedef unsigned u32x4 __attribute__((ext_vector_type(4)));
typedef unsigned u32x2 __attribute__((ext_vector_type(2)));
constexpr int BM = 256, BK = 64, HALF = 128, HTB = HALF * BK * 2  , STAGE_BYTES = 8 * HTB, NXCD = 8, WGM = 8;

__host__ __device__ __forceinline__ int lds_byte(int r, int c) { const int st = (r >> 4) * 2 + (c >> 5), rr = r & 15, cc = c & 31, ob = rr * 64 + cc * 2; return st * 1024 + (ob ^ (((ob >> 9) & 1) << 5)); }
__host__ __device__ __forceinline__ void stage_rc(int b, int& R, int& C) { const int st = b / 1024, sb = b % 1024, swz = sb ^ (((sb >> 9) & 1) << 5); R = (st >> 1) * 16 + swz / 64; C = (st & 1) * 32 + (swz % 64) / 2; }
__host__ __device__ __forceinline__ int perm32(int rho) { const int n = rho >> 4, i = rho & 15; return 8 * (i >> 2) + 4 * n + (i & 3); }

struct Unit { int pm, pn, koff, nt, seg; };
struct Gemm { const bf16_t* A; const bf16_t* Bt; int M, N, K; };

struct StaticOrder {
    static constexpr bool GATHER = false;
    int nM, nN, nwg, G, c, nt0;
    __device__ __forceinline__ int row_token(const Unit&, int) const { return 0; }
    __device__ void init(int M, int N, int K, int G_, int c_) { nM = M / BM; nN = N / BM; nwg = nM * nN; G = G_; c = c_; nt0 = K / BK; }
    __device__ bool tile(long L, Unit& u) const {
        if (L >= nwg) return false;
        int wgid = (int)L; { const int q = nwg / NXCD, r = nwg % NXCD, xcd = wgid % NXCD, off = wgid / NXCD; wgid = (xcd < r ? xcd * (q + 1) : r * (q + 1) + (xcd - r) * q) + off; }
        const int nig = WGM * nN, gid = wgid / nig, fm = gid * WGM, gsz = (nM - fm) < WGM ? (nM - fm) : WGM;
        u.pm = fm + ((wgid % nig) % gsz); u.pn = (wgid % nig) / gsz; return true;
    }
    __device__ bool next(int i, Unit& u) const { u.koff = 0; u.nt = nt0; u.seg = 0; return tile((long)i * G + c, u); }
    __device__ __forceinline__ void a_ready(const Unit&) const {}
    __device__ __forceinline__ void done(const Unit&) const {}
};
struct MergeOrder : StaticOrder {
    __device__ bool next(int i, Unit& u) const { const int rnd = i / 3, sg = i - 3 * rnd; u.seg = sg; u.koff = sg == 0 ? 0 : (sg == 1 ? 512 : 1536); u.nt = sg == 1 ? 16 : 8; return tile((long)rnd * G + c, u); }
};
struct MoeOrder {
    static constexpr bool GATHER = false;
    int total, G, c, NJ, nt0; const PG8_LAS int* tile_exp;
    __device__ bool next(int i, Unit& u) const {
        const long L = (long)i * G + c; if (L >= total) return false;
        const int R = (int)L / NJ, j = (int)L % NJ; u.pm = R; u.pn = tile_exp[R] * NJ + j; u.koff = 0; u.nt = nt0; u.seg = 0; return true;
    }
    __device__ __forceinline__ int row_token(const Unit&, int) const { return 0; }
    __device__ __forceinline__ void a_ready(const Unit&) const {}
    __device__ __forceinline__ void done(const Unit&) const {}
};
struct MoeGatherOrder : MoeOrder {
    static constexpr bool GATHER = true;
    const PG8_LAS int* pst; const PG8_LAS int* cnt; const int* liste;
    __device__ __forceinline__ int row_token(const Unit& u, int r) const {
        const int e = tile_exp[u.pm], lr = u.pm * 256 - pst[e] + r;
        return lr < cnt[e] ? liste[(size_t)e * 32768 + lr] : 0;
    }
};

typedef __bf16 bf16x2v __attribute__((ext_vector_type(2)));
typedef float f32x2v __attribute__((ext_vector_type(2)));
__device__ __forceinline__ unsigned cvt_pk_bf16(float lo, float hi) { const f32x2v v = {lo, hi}; const bf16x2v b = __builtin_convertvector(v, bf16x2v); return __builtin_bit_cast(unsigned, b); }
__device__ __forceinline__ float bflo(unsigned w) { return __uint_as_float(w << 16); }
__device__ __forceinline__ float bfhi(unsigned w) { return __uint_as_float(w & 0xffff0000u); }
__device__ __forceinline__ float sigm(float v) { return __builtin_amdgcn_rcpf(1.0f + __builtin_amdgcn_exp2f(-1.44269504f * v)); }
__device__ __forceinline__ unsigned q8x4(const f32x4 s) {
    const unsigned a = (unsigned)fminf(s[0] * 256.0f, 255.5f), b = (unsigned)fminf(s[1] * 256.0f, 255.5f), c = (unsigned)fminf(s[2] * 256.0f, 255.5f), d = (unsigned)fminf(s[3] * 256.0f, 255.5f);
    return a | (b << 8) | (c << 16) | (d << 24);
}

constexpr int ZP = 5120;
constexpr int ZC_GA = 5120, ZC_GB = 7168, ZC_GC = 9216;
constexpr size_t GT_TILE = 65536, GT_GATE = (size_t)128 * 8 * GT_TILE;

template <int PN_OFF> struct EpiInProj {
    static constexpr bool PERM = true, AFTER_DRAIN = false, CHAIN = false;
    bf16_t* O; unsigned char* GT; PG8_LAS unsigned long long* ss;
    const PG8_LAS float* gains;
    __device__ __forceinline__ void operator()(const f32x4 (&acc)[2][2][4][2], const Unit& u, int wr, int wc, int fr, int fq) const {
        const int pn = PN_OFF ? u.pn + 13 : (u.pn < 13 ? u.pn : u.pn + 3);
        int row0 = u.pm * BM + wr * 64 + fr, col0 = pn * BM + wc * 32 + 8 * fq;
        asm volatile("" : "+v"(row0), "+v"(col0));
        const int act = pn >= 20 ? 2 : (pn >= 18 ? 1 : 0);
        const bool hn = PN_OFF == 0 && pn <= 7;
        f32x4 gn0 = (f32x4){1.f, 1.f, 1.f, 1.f}, gn1 = gn0; int lr = 0;
        if (hn) {
            lr = wr * 64 + fr; asm volatile("" : "+v"(lr));
#pragma unroll
            for (int ai = 0; ai < 2; ++ai)
#pragma unroll
                for (int m = 0; m < 4; ++m)
#pragma unroll
                    for (int bj = 0; bj < 2; ++bj) { const f32x4 a = acc[ai][bj][m][0], b = acc[ai][bj][m][1];
                        float s = (a[0] * a[0] + a[1] * a[1]) + (a[2] * a[2] + a[3] * a[3]) + (b[0] * b[0] + b[1] * b[1]) + (b[2] * b[2] + b[3] * b[3]);
                        s += __shfl_xor(s, 16); s += __shfl_xor(s, 32);
                        if (fq == 0) __hip_atomic_fetch_add(ss + (ai * HALF + m * 16 + lr) * 2 + bj, (unsigned long long)(s * 1048576.0f), __ATOMIC_RELAXED, __HIP_MEMORY_SCOPE_WORKGROUP); }
            asm volatile("s_waitcnt lgkmcnt(0)" ::: "memory"); __builtin_amdgcn_s_barrier(); asm volatile("" ::: "memory");
            const PG8_LAS float* gp = gains + (pn <= 1 ? 0 : (pn == 2 ? 128 : (pn <= 6 ? 256 : 384))) + wc * 32 + 8 * fq;
            gn0 = *(const PG8_LAS f32x4*)gp; gn1 = *(const PG8_LAS f32x4*)(gp + 4);
        }
        if (act == 2) {
            int lo16 = (wr * 4 + wc) * 8192 + (fq * 16 + fr) * 16; asm volatile("" : "+v"(lo16));
            unsigned char* gp = GT + (size_t)((pn - 20) >> 3) * GT_GATE + ((size_t)u.pm * 8 + ((pn - 20) & 7)) * GT_TILE + lo16;
#pragma unroll
            for (int ai = 0; ai < 2; ++ai)
#pragma unroll
                for (int m = 0; m < 4; ++m) { u32x4 w;
#pragma unroll
                    for (int bj = 0; bj < 2; ++bj) { const f32x4 v0 = acc[ai][bj][m][0] * 0.015625f, v1 = acc[ai][bj][m][1] * 0.015625f; f32x4 s0, s1;
#pragma unroll
                        for (int j = 0; j < 4; ++j) { s0[j] = sigm(v0[j]); s1[j] = sigm(v1[j]); }
                        w[2 * bj] = q8x4(s0); w[2 * bj + 1] = q8x4(s1); }
                    *(u32x4*)(gp + (ai * 4 + m) * 1024) = w; }
            return;
        }
#pragma unroll
        for (int ai = 0; ai < 2; ++ai)
#pragma unroll
            for (int m = 0; m < 4; ++m) { bf16_t* rowp = O + (size_t)(row0 + ai * HALF + m * 16) * ZP + col0;
#pragma unroll
                for (int bj = 0; bj < 2; ++bj) { f32x4 v0 = acc[ai][bj][m][0], v1 = acc[ai][bj][m][1];
                    if (hn && !(pn == 2 && bj == 1)) { const float r = rsqrtf((float)ss[(ai * HALF + m * 16 + lr) * 2 + bj] * (0.015625f * 0.015625f / 128.0f / 1048576.0f) + 1e-6f) * 0.015625f;
                        v0 = v0 * r * gn0; v1 = v1 * r * gn1; }
                    else if (PN_OFF == 0) { v0 = v0 * 0.015625f; v1 = v1 * 0.015625f; }
                    if (act) {
#pragma unroll
                        for (int j = 0; j < 4; ++j) { v0[j] *= sigm(v0[j]); v1[j] *= sigm(v1[j]); } }
                    u32x4 w; w.x = cvt_pk_bf16(v0[0], v0[1]); w.y = cvt_pk_bf16(v0[2], v0[3]); w.z = cvt_pk_bf16(v1[0], v1[1]); w.w = cvt_pk_bf16(v1[2], v1[3]);
                    *(u32x4*)(rowp + bj * HALF) = w; } }
        if (hn) { asm volatile("s_waitcnt lgkmcnt(0)" ::: "memory"); __builtin_amdgcn_s_barrier(); asm volatile("" ::: "memory");
            ss[(wr * 4 + wc) * 64 + fq * 16 + fr] = 0ull; }
    }
};
template <int MODE = 0> struct EpiMergeT {
    static constexpr bool PERM = true, AFTER_DRAIN = false, CHAIN = true;
    const unsigned char* GT; bf16_t* O;
    __device__ __forceinline__ void operator()(f32x4 (&acc)[2][2][4][2], const Unit& u, int wr, int wc, int fr, int fq) const {
        if (MODE == 2) return;
        const int row0 = u.pm * BM + wr * 64 + fr, col0 = u.pn * BM + wc * 32 + 8 * fq;
        int lo16 = (wr * 4 + wc) * 8192 + (fq * 16 + fr) * 16; asm volatile("" : "+v"(lo16));
        const unsigned char* gp = GT + ((size_t)u.pm * 8 + u.pn) * GT_TILE + lo16;
        const size_t cn = (size_t)u.seg * GT_GATE, cd = (size_t)(u.seg == 0 ? 1 : 2) * GT_GATE;
        const bool fin = u.seg == 2;
        u32x4 gn[2][4], gd[2][4];
#pragma unroll
        for (int ai = 0; ai < 2; ++ai)
#pragma unroll
            for (int m = 0; m < 4; ++m) {
                if (MODE == 1) { gn[ai][m] = (u32x4){0x80808080u + (unsigned)u.pm, 0x80808080u, 0x80808080u, 0x80808080u}; gd[ai][m] = gn[ai][m]; } else {
                gn[ai][m] = *(const u32x4*)(gp + cn + (ai * 4 + m) * 1024); gd[ai][m] = *(const u32x4*)(gp + cd + (ai * 4 + m) * 1024); } }
#pragma unroll
        for (int ai = 0; ai < 2; ++ai)
#pragma unroll
            for (int m = 0; m < 4; ++m)
#pragma unroll
                for (int bj = 0; bj < 2; ++bj) { const size_t r = (size_t)(row0 + ai * HALF + m * 16);
#pragma unroll
                    for (int w = 0; w < 2; ++w)
#pragma unroll
                        for (int k = 0; k < 4; ++k) { const float qn = (float)((gn[ai][m][2 * bj + w] >> (8 * k)) & 0xffu) + 0.5f, qd = (float)((gd[ai][m][2 * bj + w] >> (8 * k)) & 0xffu) + 0.5f;
                            acc[ai][bj][m][w][k] *= qn * __builtin_amdgcn_rcpf(fin ? 256.0f : qd); }
                    if (fin) { const f32x4 v0 = acc[ai][bj][m][0], v1 = acc[ai][bj][m][1];
                        u32x4 w; w.x = cvt_pk_bf16(v0[0], v0[1]); w.y = cvt_pk_bf16(v0[2], v0[3]); w.z = cvt_pk_bf16(v1[0], v1[1]); w.w = cvt_pk_bf16(v1[2], v1[3]);
                        *(u32x4*)(O + r * 2048 + col0 + bj * HALF) = w; } }
    }
};
typedef EpiMergeT<0> EpiMerge;
struct EpiResid {
    static constexpr int PERM = 2; static constexpr bool AFTER_DRAIN = false, CHAIN = false;
    bf16_t* hb; unsigned char* xu; const float* gain; PG8_LAS unsigned char* stg;
    __device__ __forceinline__ void operator()(const f32x4 (&acc)[2][2][4][2], const Unit& u, int wr, int wc, int fr, int fq) const {
        int lane = fq * 16 + fr; asm volatile("" : "+v"(lane));
        PG8_LAS unsigned char* s0 = stg + (wr * 4 + wc) * 1024;
        const int r8 = lane >> 3, pc = lane & 7;
        const int offc = r8 * 128 + ((pc ^ r8) << 4);
        const int offa0 = (fr >> 3) * 8192 + (fr & 7) * 128 + ((fq ^ (fr & 7)) << 4), offa1 = (fr >> 3) * 8192 + (fr & 7) * 128 + (((4 + fq) ^ (fr & 7)) << 4);
        const int xs = 2 * (fr >> 2), offxw0 = fr * 64 + ((fq ^ xs) << 3), offxw1 = fr * 64 + (((4 + fq) ^ xs) << 3);
        const int xr = lane >> 2, xq = lane & 3, offxr = xr * 64 + (((2 * xq) ^ (2 * (xr >> 2))) << 3);
        const size_t goff = (size_t)(u.pm * BM + wr * 64 + r8) * 2048 + u.pn * BM + wc * 64 + pc * 8;
        const size_t xoff = (size_t)(u.pm * BM + wr * 64 + xr) * 2048 + u.pn * BM + wc * 64 + xq * 16;
        f32x4 gv[2][2];
#pragma unroll
        for (int bj = 0; bj < 2; ++bj)
#pragma unroll
            for (int n = 0; n < 2; ++n) gv[bj][n] = *(const f32x4*)(gain + u.pn * BM + wc * 64 + bj * 32 + 8 * fq + 4 * n);
        const f32x4 lo4 = (f32x4){-440.f, -440.f, -440.f, -440.f}, hi4 = (f32x4){440.f, 440.f, 440.f, 440.f};
#pragma unroll
        for (int ai = 0; ai < 2; ++ai) {
            u32x4 bb[4][2];
#pragma unroll
            for (int m = 0; m < 4; ++m)
#pragma unroll
                for (int j = 0; j < 2; ++j) bb[m][j] = *(const u32x4*)(hb + goff + (size_t)(ai * HALF + m * 16 + 8 * j) * 2048);
#pragma unroll
            for (int m = 0; m < 4; ++m) {
                *(PG8_LAS u32x4*)(s0 + offc) = bb[m][0]; *(PG8_LAS u32x4*)(s0 + 8192 + offc) = bb[m][1];
                asm volatile("" ::: "memory");
                const u32x4 a0 = *(const PG8_LAS u32x4*)(s0 + offa0), a1 = *(const PG8_LAS u32x4*)(s0 + offa1);
                asm volatile("" ::: "memory");
                u32x2 xw[2];
#pragma unroll
                for (int bj = 0; bj < 2; ++bj) { const u32x4 w = bj ? a1 : a0;
                    const f32x4 h0 = (f32x4){bflo(w.x), bfhi(w.x), bflo(w.y), bfhi(w.y)} + acc[ai][bj][m][0], h1 = (f32x4){bflo(w.z), bfhi(w.z), bflo(w.w), bfhi(w.w)} + acc[ai][bj][m][1];
                    u32x4 hw; hw.x = cvt_pk_bf16(h0[0], h0[1]); hw.y = cvt_pk_bf16(h0[2], h0[3]); hw.z = cvt_pk_bf16(h1[0], h1[1]); hw.w = cvt_pk_bf16(h1[2], h1[3]);
                    *(PG8_LAS u32x4*)(s0 + (bj ? offa1 : offa0)) = hw;
                    const f32x4 x0 = __builtin_elementwise_min(__builtin_elementwise_max(h0 * gv[bj][0], lo4), hi4), x1 = __builtin_elementwise_min(__builtin_elementwise_max(h1 * gv[bj][1], lo4), hi4);
                    int w0 = 0, w1 = 0;
                    w0 = __builtin_amdgcn_cvt_pk_fp8_f32(x0[0], x0[1], w0, false); w0 = __builtin_amdgcn_cvt_pk_fp8_f32(x0[2], x0[3], w0, true);
                    w1 = __builtin_amdgcn_cvt_pk_fp8_f32(x1[0], x1[1], w1, false); w1 = __builtin_amdgcn_cvt_pk_fp8_f32(x1[2], x1[3], w1, true);
                    xw[bj] = (u32x2){(unsigned)w0, (unsigned)w1}; }
                asm volatile("" ::: "memory");
                const u32x4 o0 = *(const PG8_LAS u32x4*)(s0 + offc), o1 = *(const PG8_LAS u32x4*)(s0 + 8192 + offc);
                asm volatile("" ::: "memory");
                *(PG8_LAS u32x2*)(s0 + offxw0) = xw[0]; *(PG8_LAS u32x2*)(s0 + offxw1) = xw[1];
                asm volatile("" ::: "memory");
                const u32x4 xo = *(const PG8_LAS u32x4*)(s0 + offxr);
                asm volatile("" ::: "memory");
                *(u32x4*)(hb + goff + (size_t)(ai * HALF + m * 16) * 2048) = o0; *(u32x4*)(hb + goff + (size_t)(ai * HALF + m * 16 + 8) * 2048) = o1;
                *(u32x4*)(xu + xoff + (size_t)(ai * HALF + m * 16) * 2048) = xo;
            }
        }
        asm volatile("s_waitcnt lgkmcnt(0)" ::: "memory");
    }
};
struct EpiGlu {
    static constexpr bool PERM = false, AFTER_DRAIN = false, CHAIN = false;
    bf16_t* H; const PG8_LAS int* tile_exp; const PG8_LAS int* pst; const PG8_LAS int* cnt; const int* liste; const float* rstd;
    __device__ __forceinline__ void operator()(const f32x4 (&acc)[2][2][4][2], const Unit& u, int wr, int wc, int fr, int fq) const {
        const int row0 = u.pm * BM + wr * 64 + fr, pj = u.pn & 3;
        const int e = tile_exp[u.pm], lr0 = u.pm * 256 - pst[e] + wr * 64 + fr, ce = cnt[e];
        int tok[2][4]; float rs[2][4];
#pragma unroll
        for (int ai = 0; ai < 2; ++ai)
#pragma unroll
            for (int m = 0; m < 4; ++m) { const int lr = lr0 + ai * HALF + m * 16; tok[ai][m] = lr < ce ? liste[(size_t)e * 32768 + lr] : 0; }
#pragma unroll
        for (int ai = 0; ai < 2; ++ai)
#pragma unroll
            for (int m = 0; m < 4; ++m) rs[ai][m] = rstd[tok[ai][m]] * 0.015625f;
#pragma unroll
        for (int ai = 0; ai < 2; ++ai)
#pragma unroll
            for (int m = 0; m < 4; ++m) { unsigned char* rowp = (unsigned char*)H + (size_t)(row0 + ai * HALF + m * 16) * 512; const float r = rs[ai][m];
#pragma unroll
                for (int bj = 0; bj < 2; ++bj) { const f32x4 a = acc[ai][bj][m][0] * r, b = acc[ai][bj][m][1] * r;
                    const int hc = 16 * (8 * pj + 4 * bj + wc) + 4 * fq;
                    float hv[4];
#pragma unroll
                    for (int j = 0; j < 4; ++j) hv[j] = fminf(fmaxf(a[j] * sigm(a[j]) * b[j] * 8.0f, -440.0f), 440.0f);
                    int w = 0; w = __builtin_amdgcn_cvt_pk_fp8_f32(hv[0], hv[1], w, false); w = __builtin_amdgcn_cvt_pk_fp8_f32(hv[2], hv[3], w, true);
                    *(int*)(rowp + hc) = w; } }
    }
};
struct EpiY {
    static constexpr bool PERM = true, AFTER_DRAIN = false, CHAIN = false;
    unsigned char* Y;
    __device__ __forceinline__ void operator()(const f32x4 (&acc)[2][2][4][2], const Unit& u, int wr, int wc, int fr, int fq) const {
        const int row0 = u.pm * BM + wr * 64 + fr, col0 = (u.pn & 7) * BM + wc * 32 + 8 * fq;
        const f32x4 lo4 = (f32x4){-440.f, -440.f, -440.f, -440.f}, hi4 = (f32x4){440.f, 440.f, 440.f, 440.f};
#pragma unroll
        for (int ai = 0; ai < 2; ++ai)
#pragma unroll
            for (int m = 0; m < 4; ++m) { unsigned char* rowp = Y + (size_t)(row0 + ai * HALF + m * 16) * 2048 + col0;
#pragma unroll
                for (int bj = 0; bj < 2; ++bj) {
                    const f32x4 v0 = __builtin_elementwise_min(__builtin_elementwise_max(acc[ai][bj][m][0] * 0.125f, lo4), hi4), v1 = __builtin_elementwise_min(__builtin_elementwise_max(acc[ai][bj][m][1] * 0.125f, lo4), hi4);
                    int w0 = 0, w1 = 0;
                    w0 = __builtin_amdgcn_cvt_pk_fp8_f32(v0[0], v0[1], w0, false); w0 = __builtin_amdgcn_cvt_pk_fp8_f32(v0[2], v0[3], w0, true);
                    w1 = __builtin_amdgcn_cvt_pk_fp8_f32(v1[0], v1[1], w1, false); w1 = __builtin_amdgcn_cvt_pk_fp8_f32(v1[2], v1[3], w1, true);
                    *(u32x2*)(rowp + bj * HALF) = (u32x2){(unsigned)w0, (unsigned)w1}; } }
    }
};

typedef int v4i_t __attribute__((ext_vector_type(4)));
typedef int v8i_t __attribute__((ext_vector_type(8)));
template <class Epi, class Sched, bool ALIGN_EPI = false, bool FP8 = false>
__device__ __forceinline__ void gemm_phase(PG8_LAS unsigned char* lds, const Gemm g, const Sched& S, const Epi& E) {
    int tid = threadIdx.x; asm volatile("" : "+v"(tid));
    const int wid = __builtin_amdgcn_readfirstlane(tid >> 6), lane = tid & 63, wr = wid >> 2, wc = wid & 3, fr = lane & 15, fq = lane >> 4;
    const int K = g.K;
    unsigned voffA[2], voffB[2]; int RA[2]; unsigned CA2[2];
#pragma unroll
    for (int i = 0; i < 2; ++i) { int R, C; stage_rc(tid * 16 + i * 8192, R, C); const int Rb = Epi::PERM == 2 ? ((R >> 5) * 64 + perm32(R & 31)) : (Epi::PERM ? ((R & ~31) + perm32(R & 31)) : R);
        voffA[i] = (unsigned)(R * K + C) * 2u; voffB[i] = (unsigned)(Rb * K + C) * 2u; RA[i] = R; CA2[i] = (unsigned)C * 2u; }
    unsigned gAc[2][2], gAn[2][2];
#define PG8_GOFF(dst, uu) do { _Pragma("unroll") for (int h_ = 0; h_ < 2; ++h_) _Pragma("unroll") for (int i_ = 0; i_ < 2; ++i_) dst[h_][i_] = (unsigned)S.row_token(uu, 128 * h_ + RA[i_]) * (unsigned)(K * 2) + CA2[i_]; } while (0)
#define PG8_STAGE_A(bufoff, gbase, half, garr) do { if constexpr (Sched::GATHER) PG8_STAGE(bufoff, gbase, garr); else PG8_STAGE(bufoff, (gbase) + (half) * hstep, voffA); } while (0)
    const size_t kstep = (size_t)(BK * 2);
    const size_t hstep = (size_t)HALF * K * 2;
    const size_t hstepB = Epi::PERM == 2 ? (size_t)32 * K * 2 : hstep;
    const size_t tstep = 2 * hstep;
    const unsigned ldsw = (unsigned)wid * 1024u;
    const int aoff = lds_byte(wr * 64 + fr, fq * 8), boff = lds_byte(wc * 32 + fr, fq * 8);
#define PG8_SA(b, h) (((b) * 2 + (h)) * HTB)
#define PG8_SB(b, h) ((4 + (b) * 2 + (h)) * HTB)
#define PG8_STAGE(bufoff, gbase, voff) do { _Pragma("unroll") for (int _i = 0; _i < 2; ++_i) \
        __builtin_amdgcn_global_load_lds((const unsigned*)((const char*)(gbase) + (voff)[_i]), (PG8_LAS unsigned*)(lds + (bufoff) + ldsw + _i * 8192), 16, 0, 0); } while (0)
#define PG8_LDA(dst, b, h) do { if constexpr (FP8) { _Pragma("unroll") for (int m = 0; m < 4; ++m) dst##8[m] = __builtin_shufflevector(*(const PG8_LAS v4i_t*)(lds + PG8_SA(b, h) + aoff + m * 2048), *(const PG8_LAS v4i_t*)(lds + PG8_SA(b, h) + aoff + m * 2048 + 1024), 0, 1, 2, 3, 4, 5, 6, 7); } \
        else { _Pragma("unroll") for (int m = 0; m < 4; ++m) _Pragma("unroll") for (int k = 0; k < 2; ++k) dst[m][k] = *(const PG8_LAS bf16x8*)(lds + PG8_SA(b, h) + aoff + m * 2048 + k * 1024); } } while (0)
#define PG8_LDB(dst, b, h) do { if constexpr (FP8) { _Pragma("unroll") for (int n = 0; n < 2; ++n) dst##8[n] = __builtin_shufflevector(*(const PG8_LAS v4i_t*)(lds + PG8_SB(b, h) + boff + n * 2048), *(const PG8_LAS v4i_t*)(lds + PG8_SB(b, h) + boff + n * 2048 + 1024), 0, 1, 2, 3, 4, 5, 6, 7); } \
        else { _Pragma("unroll") for (int n = 0; n < 2; ++n) _Pragma("unroll") for (int k = 0; k < 2; ++k) dst[n][k] = *(const PG8_LAS bf16x8*)(lds + PG8_SB(b, h) + boff + n * 2048 + k * 1024); } } while (0)
#define PG8_MMA(ai, bj, At, Bt) do { __builtin_amdgcn_s_setprio(1); _Pragma("unroll") for (int m = 0; m < 4; ++m) _Pragma("unroll") for (int n = 0; n < 2; ++n) { \
        if constexpr (FP8) asm volatile("v_mfma_f32_16x16x128_f8f6f4 %0, %1, %2, %0" : "+v"(acc[ai][bj][m][n]) : "v"(Bt##8[n]), "v"(At##8[m])); \
        else { _Pragma("unroll") for (int k = 0; k < 2; ++k) acc[ai][bj][m][n] = __builtin_amdgcn_mfma_f32_16x16x32_bf16(Bt[n][k], At[m][k], acc[ai][bj][m][n], 0, 0, 0); } } \
        __builtin_amdgcn_s_setprio(0); } while (0)
#define PG8_WAIT_V(n) asm volatile("s_waitcnt vmcnt(" #n ")" ::: "memory")
#define PG8_WAIT_L(n) asm volatile("s_waitcnt lgkmcnt(" #n ")" ::: "memory")
#define PG8_BAR __builtin_amdgcn_s_barrier()
#define PG8_SCHED __builtin_amdgcn_sched_barrier(0)
    Unit cur, nxt; int ui = 0;
    if (!S.next(0, cur)) return;
    f32x4 acc[2][2][4][2];
#pragma unroll
    for (int a = 0; a < 2; ++a)
#pragma unroll
        for (int b = 0; b < 2; ++b)
#pragma unroll
            for (int m = 0; m < 4; ++m)
#pragma unroll
                for (int n = 0; n < 2; ++n) acc[a][b][m][n] = (f32x4){0.f, 0.f, 0.f, 0.f};
    bf16x8 At[4][2], B0[2][2], B1[2][2]; v8i_t At8[4], B08[2], B18[2];
    const size_t tstepA = Sched::GATHER ? (size_t)0 : tstep;
    const char* cA = (const char*)g.A + (size_t)cur.pm * tstepA + (size_t)cur.koff * 2; const char* cB = (const char*)g.Bt + (size_t)cur.pn * tstep + (size_t)cur.koff * 2;
    S.a_ready(cur);
    if constexpr (Sched::GATHER) { PG8_GOFF(gAc, cur); }
    PG8_STAGE(PG8_SB(0, 0), cB, voffB); PG8_STAGE(PG8_SB(0, 1), cB + hstepB, voffB); PG8_STAGE_A(PG8_SA(0, 0), cA, 0, gAc[0]); PG8_STAGE_A(PG8_SA(0, 1), cA, 1, gAc[1]);
    if (wr == 1) PG8_BAR;
    PG8_WAIT_V(2); PG8_BAR;
    PG8_STAGE(PG8_SB(1, 0), cB + kstep, voffB); PG8_STAGE_A(PG8_SA(1, 0), cA + kstep, 0, gAc[0]); PG8_STAGE(PG8_SB(1, 1), cB + hstepB + kstep, voffB);
    PG8_WAIT_V(6); PG8_BAR;
    for (;;) {
        const bool has_next = S.next(ui + 1, nxt);
        const char* nA = has_next ? (const char*)g.A + (size_t)nxt.pm * tstepA + (size_t)nxt.koff * 2 : cA; const char* nB = has_next ? (const char*)g.Bt + (size_t)nxt.pn * tstep + (size_t)nxt.koff * 2 : cB;
        if constexpr (Sched::GATHER) { if (has_next) { PG8_GOFF(gAn, nxt); } else {
#pragma unroll
            for (int h_ = 0; h_ < 2; ++h_)
#pragma unroll
                for (int i_ = 0; i_ < 2; ++i_) gAn[h_][i_] = gAc[h_][i_]; } }
        const int nt = cur.nt;
        for (int t = 0; t < nt; t += 2) {
            const bool last = (t == nt - 2);
            const char* a1 = cA + (size_t)(t + 1) * kstep;
            const char* a2 = last ? nA : cA + (size_t)(t + 2) * kstep; const char* b2 = last ? nB : cB + (size_t)(t + 2) * kstep;
            const char* a3 = a2 + kstep; const char* b3 = b2 + kstep;
            if (last && has_next) S.a_ready(nxt);
            unsigned g2a[2][2];
            if constexpr (Sched::GATHER) {
#pragma unroll
                for (int h_ = 0; h_ < 2; ++h_)
#pragma unroll
                    for (int i_ = 0; i_ < 2; ++i_) g2a[h_][i_] = last ? gAn[h_][i_] : gAc[h_][i_]; }
            PG8_LDB(B0, 0, 0); PG8_LDB(B1, 0, 1); PG8_SCHED; PG8_LDA(At, 0, 0); PG8_STAGE_A(PG8_SA(1, 1), a1, 1, gAc[1]);
            PG8_WAIT_V(8); PG8_WAIT_L(0); PG8_BAR; PG8_MMA(0, 0, At, B0); PG8_MMA(0, 1, At, B1); PG8_BAR; PG8_SCHED;
            PG8_LDA(At, 0, 1); PG8_STAGE(PG8_SB(0, 0), b2, voffB); PG8_STAGE(PG8_SB(0, 1), b2 + hstepB, voffB); PG8_STAGE_A(PG8_SA(0, 0), a2, 0, g2a[0]);
            PG8_WAIT_V(8); PG8_WAIT_L(0); PG8_BAR; PG8_MMA(1, 0, At, B0); PG8_MMA(1, 1, At, B1); PG8_BAR; PG8_SCHED;
            PG8_LDB(B0, 1, 0); PG8_LDB(B1, 1, 1); PG8_SCHED; PG8_LDA(At, 1, 0); PG8_STAGE_A(PG8_SA(0, 1), a2, 1, g2a[1]);
            PG8_WAIT_V(8); PG8_WAIT_L(0); PG8_BAR; PG8_MMA(0, 0, At, B0); PG8_MMA(0, 1, At, B1); PG8_BAR; PG8_SCHED;
            PG8_LDA(At, 1, 1); PG8_STAGE(PG8_SB(1, 0), b3, voffB); PG8_STAGE(PG8_SB(1, 1), b3 + hstepB, voffB); PG8_STAGE_A(PG8_SA(1, 0), a3, 0, g2a[0]);
            PG8_WAIT_V(8); PG8_WAIT_L(0); PG8_BAR; PG8_MMA(1, 0, At, B0); PG8_MMA(1, 1, At, B1); PG8_BAR; PG8_SCHED;
        }
        if constexpr (ALIGN_EPI) { if (wr == 0) PG8_BAR; }
        if constexpr (FP8) asm volatile("s_nop 15\n\ts_nop 15\n\ts_nop 15\n\ts_nop 15" ::: "memory");
        E(acc, cur, wr, wc, fr, fq); S.done(cur);
        if (!has_next) break;
        if (!Epi::CHAIN || cur.seg == 2)
#pragma unroll
        for (int a = 0; a < 2; ++a)
#pragma unroll
            for (int b = 0; b < 2; ++b)
#pragma unroll
                for (int m = 0; m < 4; ++m)
#pragma unroll
                    for (int n = 0; n < 2; ++n) acc[a][b][m][n] = (f32x4){0.f, 0.f, 0.f, 0.f};
        cur = nxt; cA = nA; cB = nB; ++ui;
        if constexpr (Sched::GATHER) {
#pragma unroll
            for (int h_ = 0; h_ < 2; ++h_)
#pragma unroll
                for (int i_ = 0; i_ < 2; ++i_) gAc[h_][i_] = gAn[h_][i_]; }
        if constexpr (ALIGN_EPI) { if (wr == 1) PG8_BAR; }
    }
    PG8_WAIT_V(0);
    if constexpr (!ALIGN_EPI) { if (wr == 0) PG8_BAR; }
    PG8_BAR;
#undef PG8_SA
#undef PG8_SB
#undef PG8_STAGE_A
#undef PG8_GOFF
#undef PG8_STAGE
#undef PG8_LDA
#undef PG8_LDB
#undef PG8_MMA
#undef PG8_WAIT_V
#undef PG8_WAIT_L
#undef PG8_BAR
#undef PG8_SCHED
}
}

constexpr int NWAVES = 8;
constexpr int T = 32768, SEQ = 2048, NB = 16, D = 2048, DEPTH = 2;
constexpr int ZP = pg8::ZP;
constexpr int ZC_AQ = 0, ZC_AK = 512, ZC_AV = 640, ZC_BQ = 768, ZC_BK = 1792, ZC_BV = 2048, ZC_IQ = 2304, ZC_IK = 3328, ZC_IW = 3392, ZC_CG = 3408, ZC_PAD = 3424, ZC_CQ = 3584, ZC_CK = 3840, ZC_CV = 4096, ZC_CR = 4608;
constexpr int D_IN = 11104;
constexpr int NEXP = 64, DEXP = 512, PMAX_TILES = 320;
constexpr float EPS = 1e-6f;

constexpr size_t MiB = 1u << 20;
constexpr size_t WS_CTL = 0, CTL_ZERO_BYTES = 1 * MiB;
constexpr size_t WS_ROUTE = 2 * MiB;
constexpr size_t WS_WRH = 4 * MiB, WS_WRL = 6 * MiB, WR_L = 96 * 2048 * 2;
constexpr size_t WS_WIN = 16 * MiB, WIN_L = 44 * MiB;
constexpr size_t WS_WBR = 104 * MiB, WBR_L = 8 * MiB;
constexpr size_t WS_WO = 120 * MiB, WO_L = 8 * MiB;
constexpr size_t WS_W13 = 136 * MiB;
constexpr size_t WS_HB = 264 * MiB;
constexpr size_t WS_W2 = 392 * MiB;
constexpr size_t WS_XN = 520 * MiB;
constexpr size_t WS_OCAT = 648 * MiB;
constexpr size_t WS_MERGED = 776 * MiB;
constexpr size_t WS_Z = 904 * MiB;
constexpr size_t WS_GT = 1224 * MiB;
constexpr size_t WS_S = 1608 * MiB;
constexpr size_t WS_MASK = 1864 * MiB;
constexpr size_t WS_GO = 1872 * MiB;
constexpr size_t WS_GCS = WS_GO;
constexpr size_t WS_GDEC = 8 * MiB;
constexpr size_t WS_RSTD = 9 * MiB;
constexpr size_t WS_LISTE = 904 * MiB;
constexpr size_t WS_XS = 904 * MiB;
constexpr size_t WS_Y = 1224 * MiB;
constexpr size_t WS_H = 1544 * MiB;
constexpr size_t WS_WG8 = 1936 * MiB, WG8_L = 12 * MiB;
constexpr size_t WS_XN8 = WS_S;
constexpr size_t WS_END = 1936 * MiB;
constexpr int CW_BAR = 4096;
constexpr int CW_CNT = 16384;

constexpr int RING_BYTES = 131072, MISC_OFF = RING_BYTES, LDS_BYTES = 155648;
constexpr int MO_BARW = 32, MO_GN = 256, MO_TEXP = 8192, MO_PST = 9728, MO_TOT = 9984, MO_TAB2 = 10240, MO_CNT = 16640, MO_SS = 16896;

#define GAS __attribute__((address_space(1)))
#define LAS __attribute__((address_space(3)))
typedef unsigned short bf16;
typedef unsigned v4u __attribute__((ext_vector_type(4)));
typedef unsigned v2u __attribute__((ext_vector_type(2)));
typedef float f32x4 __attribute__((ext_vector_type(4)));
#define LDS_WAIT() asm volatile("s_waitcnt lgkmcnt(0)" ::: "memory")
__device__ __forceinline__ unsigned f2bf(float f) { unsigned u = __builtin_bit_cast(unsigned, f); return (u + 0x7fffu + ((u >> 16) & 1u)) >> 16; }
__device__ __forceinline__ unsigned pk2(float lo, float hi) { return f2bf(lo) | (f2bf(hi) << 16); }
__device__ __forceinline__ float bflo(unsigned w) { return __uint_as_float(w << 16); }
__device__ __forceinline__ float bfhi(unsigned w) { return __uint_as_float(w & 0xffff0000u); }
__device__ __forceinline__ float bf1(bf16 h) { return __uint_as_float(((unsigned)h) << 16); }

#define XB_TMO      128
#define XB_XCNT(j)  (256  + 64 * (j))
#define XB_XSUB(j)  (1280 + 64 * (j))
#define XB_XGEN(j)  (2304 + 64 * (j))
#define XB_TOP      3328
#define XB_TOPGEN   3392
#define XCD_BAR_WORDS 3456
#define XB_SPIN_CAP (1u << 18)
__device__ __forceinline__ unsigned xb_ld(unsigned* p)              { return __hip_atomic_load(p, __ATOMIC_RELAXED, __HIP_MEMORY_SCOPE_AGENT); }
__device__ __forceinline__ unsigned xb_add(unsigned* p, unsigned v) { return __hip_atomic_fetch_add(p, v, __ATOMIC_RELAXED, __HIP_MEMORY_SCOPE_AGENT); }
__device__ __forceinline__ unsigned xb_xcc_id() { return (unsigned)__builtin_amdgcn_s_getreg((3 << 11) | 20) & 0xFu; }
#define XB_SPIN(cond, bar) do { unsigned _sp = 0; while (cond) { __builtin_amdgcn_s_sleep(1); \
    if ((++_sp & 255u) == 0u) { if (xb_ld(&(bar)[XB_TMO])) break; if (_sp > XB_SPIN_CAP) { atomicAdd(&(bar)[XB_TMO], 1u); break; } } } } while (0)
struct XcdBarrier { unsigned* bar; unsigned x; volatile LAS unsigned* st; };
__device__ __forceinline__ XcdBarrier xcd_barrier_post(unsigned* bar, volatile LAS unsigned* st) {
    XcdBarrier b; b.bar = bar; b.x = xb_xcc_id(); b.st = st;
    if (threadIdx.x == 0) (void)xb_add(&bar[XB_XCNT(b.x)], 1u);
    return b;
}
__device__ __forceinline__ void xcd_barrier_complete(unsigned* bar, unsigned x, unsigned& nloc, unsigned& nx) {
    const unsigned G = gridDim.x * gridDim.y * gridDim.z;
    unsigned sum, cnt, mine, sp = 0u;
    for (;;) {
        sum = 0u; cnt = 0u; mine = 0u;
#pragma unroll
        for (unsigned j = 0; j < 16; ++j) { const unsigned c = xb_ld(&bar[XB_XCNT(j)]); sum += c; cnt += (c > 0u) ? 1u : 0u; mine = (j == x) ? c : mine; }
        if (sum == G) break;
        __builtin_amdgcn_s_sleep(1);
        if ((++sp & 255u) == 0u) { if (xb_ld(&bar[XB_TMO])) break; if (sp > XB_SPIN_CAP) { atomicAdd(&bar[XB_TMO], 1u); break; } }
    }
    nloc = mine > 0u ? mine : 1u; nx = cnt > 0u ? cnt : 1u;
}
__device__ __forceinline__ void xcd_barrier(const XcdBarrier& b) {
    asm volatile("s_waitcnt vmcnt(0)" ::: "memory");
    __syncthreads();
    if (threadIdx.x == 0) {
        unsigned* bar = b.bar;
        __builtin_amdgcn_s_waitcnt(0);
        unsigned nloc = b.st[0], nx = b.st[1];
        if (nloc == 0u) { xcd_barrier_complete(bar, b.x, nloc, nx); b.st[0] = nloc; b.st[1] = nx; }
        const unsigned old = xb_add(&bar[XB_XSUB(b.x)], 1u);
        const unsigned gen = old / nloc;
        if (old + 1u == (gen + 1u) * nloc) {
            __builtin_amdgcn_fence(__ATOMIC_RELEASE, "agent");
            asm volatile("s_waitcnt vmcnt(0)" ::: "memory");
            const unsigned og = xb_add(&bar[XB_TOP], 1u);
            const unsigned tg = og / nx;
            if (og + 1u == (tg + 1u) * nx) xb_add(&bar[XB_TOPGEN], 1u);
            else XB_SPIN(xb_ld(&bar[XB_TOPGEN]) == tg, bar);
            __builtin_amdgcn_fence(__ATOMIC_ACQUIRE, "agent");
            xb_add(&bar[XB_XGEN(b.x)], 1u);
            asm volatile("s_waitcnt vmcnt(0)" ::: "memory");
        } else {
            XB_SPIN(xb_ld(&bar[XB_XGEN(b.x)]) == gen, bar);
            __builtin_amdgcn_fence(__ATOMIC_ACQUIRE, "agent");
            asm volatile("s_waitcnt vmcnt(0)" ::: "memory");
        }
    }
    __syncthreads();
}

struct Args { const float* in[24]; float* out; unsigned char* ws; int ph_lo, ph_hi; };
enum { I_X = 0, I_RELB, I_N1G, I_WIN, I_AQG, I_AKG, I_BQG, I_BKG, I_SINK, I_CGW, I_CGB, I_CNG, I_WBA, I_WBB, I_WBC, I_WO, I_N2G, I_WRG, I_BRG, I_WRE, I_BRE, I_W1, I_W3, I_W2 };

struct Frame {
    LAS unsigned char* lds; LAS unsigned char* misc;
    unsigned* ctl;
    int tid, lane, wave, vcu, G, gw, NGW;
    const float* const* in; float* out; unsigned char* ws;
    bf16 *Z, *XN, *OCAT, *MERGED, *XS, *Y, *H;
    float *S, *GO; unsigned* MASK;
};

__device__ __forceinline__ float wave_sum(float v) {
#pragma unroll
    for (int o = 1; o < 64; o <<= 1) v += __shfl_xor(v, o);
    return v;
}
__device__ __forceinline__ float wave_max(float v) {
#pragma unroll
    for (int o = 1; o < 64; o <<= 1) v = fmaxf(v, __shfl_xor(v, o));
    return v;
}

template <class MAP>
__device__ __forceinline__ void transpose_item(const float* W, int N, bf16* WT, int dpitch, int koff, LAS float* scr, int item, int lane, const MAP& map) {
    const int nblk = N / 32, kb = item / nblk, nb = item % nblk, k0 = 64 * kb, n0 = 32 * nb;
    f32x4 v[8];
#pragma unroll
    for (int i = 0; i < 8; ++i) v[i] = *(const f32x4*)(W + (size_t)(k0 + 8 * i + (lane >> 3)) * N + n0 + 4 * (lane & 7));
#pragma unroll
    for (int i = 0; i < 8; ++i) { LAS float* d = scr + (8 * i + (lane >> 3)) * 33 + 4 * (lane & 7); d[0] = v[i].x; d[1] = v[i].y; d[2] = v[i].z; d[3] = v[i].w; }
    LDS_WAIT(); asm volatile("" ::: "memory");
    const int c = lane & 7;
#pragma unroll
    for (int j = 0; j < 4; ++j) { const int n = (lane >> 3) + 8 * j; const LAS float* s = scr + (8 * c) * 33 + n;
        v4u o; o.x = pk2(s[0 * 33], s[1 * 33]); o.y = pk2(s[2 * 33], s[3 * 33]); o.z = pk2(s[4 * 33], s[5 * 33]); o.w = pk2(s[6 * 33], s[7 * 33]);
        const int dr_ = map(n0 + n); if (dr_ >= 0) *(v4u*)(WT + (size_t)dr_ * dpitch + koff + k0 + 8 * c) = o; }
    LDS_WAIT(); asm volatile("" ::: "memory");
}
__device__ __forceinline__ float clamp8(float v) { return fminf(fmaxf(v, -440.0f), 440.0f); }
template <class MAP>
__device__ __forceinline__ void transpose_item_fp8(const float* W, int N, unsigned char* WT, int dpitch, float scale, LAS float* scr, int item, int lane, const MAP& map) {
    const int nblk = N / 32, kb = item / nblk, nb = item % nblk, k0 = 64 * kb, n0 = 32 * nb;
    f32x4 v[8];
#pragma unroll
    for (int i = 0; i < 8; ++i) v[i] = *(const f32x4*)(W + (size_t)(k0 + 8 * i + (lane >> 3)) * N + n0 + 4 * (lane & 7));
#pragma unroll
    for (int i = 0; i < 8; ++i) { LAS float* d = scr + (8 * i + (lane >> 3)) * 33 + 4 * (lane & 7); d[0] = v[i].x; d[1] = v[i].y; d[2] = v[i].z; d[3] = v[i].w; }
    LDS_WAIT(); asm volatile("" ::: "memory");
    const int c = lane & 7;
#pragma unroll
    for (int j = 0; j < 4; ++j) { const int n = (lane >> 3) + 8 * j; const LAS float* s = scr + (8 * c) * 33 + n;
        int w0 = 0, w1 = 0;
        w0 = __builtin_amdgcn_cvt_pk_fp8_f32(clamp8(s[0 * 33] * scale), clamp8(s[1 * 33] * scale), w0, false); w0 = __builtin_amdgcn_cvt_pk_fp8_f32(clamp8(s[2 * 33] * scale), clamp8(s[3 * 33] * scale), w0, true);
        w1 = __builtin_amdgcn_cvt_pk_fp8_f32(clamp8(s[4 * 33] * scale), clamp8(s[5 * 33] * scale), w1, false); w1 = __builtin_amdgcn_cvt_pk_fp8_f32(clamp8(s[6 * 33] * scale), clamp8(s[7 * 33] * scale), w1, true);
        const int dr_ = map(n0 + n); if (dr_ >= 0) *(v2u*)(WT + (size_t)dr_ * dpitch + k0 + 8 * c) = (v2u){(unsigned)w0, (unsigned)w1}; }
    LDS_WAIT(); asm volatile("" ::: "memory");
}
struct MapId { int off; __device__ __forceinline__ int operator()(int n) const { return off + n; } };
struct MapWin {
    __device__ __forceinline__ int operator()(int n) const {
        if (n < 512) return ZC_AQ + n;
        if (n < 640) return ZC_AK + (n - 512);
        if (n < 768) return ZC_AV + (n - 640);
        if (n < 1792) return ZC_IQ + (n - 768);
        if (n < 1856) return ZC_IK + (n - 1792);
        if (n < 1872) return ZC_IW + (n - 1856);
        if (n < 2896) return ZC_BQ + (n - 1872);
        if (n < 3152) return ZC_BK + (n - 2896);
        if (n < 3408) return ZC_BV + (n - 3152);
        if (n < 3664) return ZC_CQ + (n - 3408);
        if (n < 3920) return ZC_CK + (n - 3664);
        if (n < 4432) return ZC_CV + (n - 3920);
        if (n < 4448) return ZC_CG + (n - 4432);
        if (n < 4960) return ZC_CR + (n - 4448);
        return pg8::ZC_GA + (n - 4960);
    }
};
struct MapWin8 { __device__ __forceinline__ int operator()(int n) const { const int z = MapWin{}(n); return z < 3328 ? z : (z >= 4096 ? z - 768 : -1); } };
struct MapWinB { __device__ __forceinline__ int operator()(int n) const { const int z = MapWin{}(n); return (z >= 3328 && z < 4096) ? z - 3328 : -1; } };
struct MapW13 { int sel; __device__ __forceinline__ int operator()(int n) const { return 32 * (n >> 4) + 16 * sel + (n & 15); } };

__device__ __forceinline__ void load_row(const float* row, int lane, f32x4 (&v)[8]) {
    const f32x4* xr = (const f32x4*)row + lane;
#pragma unroll
    for (int j = 0; j < 8; ++j) v[j] = xr[64 * j];
}
__device__ __forceinline__ float row_rstd(const f32x4 (&v)[8]) {
    float s = 0.f;
#pragma unroll
    for (int j = 0; j < 8; ++j) s += (v[j].x * v[j].x + v[j].y * v[j].y) + (v[j].z * v[j].z + v[j].w * v[j].w);
    return rsqrtf(wave_sum(s) * (1.0f / 2048.0f) + EPS);
}
__device__ __forceinline__ void norm_store_bf16(const f32x4 (&v)[8], float rstd, const float* g, bf16* orow, int lane) {
    const f32x4* gr = (const f32x4*)g + lane; unsigned long long* o8 = (unsigned long long*)orow + lane;
#pragma unroll
    for (int j = 0; j < 8; ++j) { const f32x4 gg = gr[64 * j];
        o8[64 * j] = (unsigned long long)pk2(v[j].x * rstd * gg.x, v[j].y * rstd * gg.y) | ((unsigned long long)pk2(v[j].z * rstd * gg.z, v[j].w * rstd * gg.w) << 32); }
}

__device__ __forceinline__ void norm_store_fp8(const f32x4 (&v)[8], float rstd, const float* g, unsigned char* orow, int lane) {
    const f32x4* gr = (const f32x4*)g + lane; unsigned* o4 = (unsigned*)orow + lane;
#pragma unroll
    for (int j = 0; j < 8; ++j) { const f32x4 gg = gr[64 * j]; int w = 0;
        w = __builtin_amdgcn_cvt_pk_fp8_f32(clamp8(v[j].x * rstd * gg.x), clamp8(v[j].y * rstd * gg.y), w, false); w = __builtin_amdgcn_cvt_pk_fp8_f32(clamp8(v[j].z * rstd * gg.z), clamp8(v[j].w * rstd * gg.w), w, true);
        o4[64 * j] = (unsigned)w; }
}
__device__ __forceinline__ void convert_moe(Frame& F, int l, int part, int nparts, int lds_off) {
    LAS float* scr = (LAS float*)(F.lds + lds_off + F.wave * 8704);
    bf16* W13 = (bf16*)(F.ws + WS_W13); bf16* W2 = (bf16*)(F.ws + WS_W2);
    constexpr int I13 = (2048 / 64) * (512 / 32);
    constexpr int I2 = (512 / 64) * (2048 / 32);
    constexpr int NIT = NEXP * (2 * I13 + I2);
    const int it_lo = (int)((long)NIT * part / nparts), it_hi = (int)((long)NIT * (part + 1) / nparts);
    for (int it = it_lo + F.gw; it < it_hi; it += F.NGW) {
        const int e = it / (2 * I13 + I2); int r = it % (2 * I13 + I2);
        if (r < I13) { transpose_item_fp8(F.in[I_W1] + ((size_t)l * NEXP + e) * 2048 * 512, 512, (unsigned char*)W13 + (size_t)e * 1024 * 2048, 2048, 64.0f, scr, r, F.lane, MapW13{0}); continue; } r -= I13;
        if (r < I13) { transpose_item_fp8(F.in[I_W3] + ((size_t)l * NEXP + e) * 2048 * 512, 512, (unsigned char*)W13 + (size_t)e * 1024 * 2048, 2048, 64.0f, scr, r, F.lane, MapW13{1}); continue; } r -= I13;
        transpose_item_fp8(F.in[I_W2] + ((size_t)l * NEXP + e) * 512 * 2048, 2048, (unsigned char*)W2 + (size_t)e * 2048 * 512, 512, 32.0f, scr, r, F.lane, MapId{0});
    }
}

typedef short bf16x8_t __attribute__((ext_vector_type(8)));
typedef float f32x16 __attribute__((ext_vector_type(16)));
typedef short s16x4 __attribute__((ext_vector_type(4)));
__device__ __forceinline__ void indexer_segment(Frame& F, int b, int qb, int tlo, int thi) {
    const int lane = F.lane, n = lane & 15, kq = lane >> 4;
    const bf16* qrow = F.Z + (size_t)(b * 2048 + 16 * qb + n) * ZP;
    bf16x8_t iqf[16][2];
#pragma unroll
    for (int h = 0; h < 16; ++h)
#pragma unroll
        for (int ks = 0; ks < 2; ++ks) iqf[h][ks] = *(const bf16x8_t*)(qrow + ZC_IQ + h * 64 + 32 * ks + 8 * kq);
    float wv[16];
    { const v4u w0 = *(const v4u*)(qrow + ZC_IW), w1 = *(const v4u*)(qrow + ZC_IW + 8);
      wv[0] = bflo(w0.x); wv[1] = bfhi(w0.x); wv[2] = bflo(w0.y); wv[3] = bfhi(w0.y); wv[4] = bflo(w0.z); wv[5] = bfhi(w0.z); wv[6] = bflo(w0.w); wv[7] = bfhi(w0.w);
      wv[8] = bflo(w1.x); wv[9] = bfhi(w1.x); wv[10] = bflo(w1.y); wv[11] = bfhi(w1.y); wv[12] = bflo(w1.z); wv[13] = bfhi(w1.z); wv[14] = bflo(w1.w); wv[15] = bfhi(w1.w); }
    const bf16* kbase = F.Z + (size_t)(b * 2048 + n) * ZP + ZC_IK + 8 * kq;
    float* srow = F.S + (size_t)(b * 2048 + 16 * qb + n) * 2048 + 4 * kq;
    bf16x8_t a0 = *(const bf16x8_t*)(kbase + (size_t)(16 * tlo) * ZP), a1 = *(const bf16x8_t*)(kbase + (size_t)(16 * tlo) * ZP + 32);
#pragma unroll 1
    for (int tile = tlo; tile < thi; ++tile) {
        const int tn = tile + 1 < thi ? tile + 1 : tile;
        const bf16x8_t n0 = *(const bf16x8_t*)(kbase + (size_t)(16 * tn) * ZP), n1 = *(const bf16x8_t*)(kbase + (size_t)(16 * tn) * ZP + 32);
        f32x4 sc = (f32x4){0.f, 0.f, 0.f, 0.f};
#pragma unroll
        for (int h = 0; h < 16; ++h) {
            f32x4 c = __builtin_amdgcn_mfma_f32_16x16x32_bf16(a0, iqf[h][0], (f32x4){0.f, 0.f, 0.f, 0.f}, 0, 0, 0);
            c = __builtin_amdgcn_mfma_f32_16x16x32_bf16(a1, iqf[h][1], c, 0, 0, 0);
            sc[0] += wv[h] * fmaxf(c[0], 0.f); sc[1] += wv[h] * fmaxf(c[1], 0.f); sc[2] += wv[h] * fmaxf(c[2], 0.f); sc[3] += wv[h] * fmaxf(c[3], 0.f);
        }
        *(f32x4*)(srow + 16 * tile) = sc * 0.03125f;
        a0 = n0; a1 = n1;
    }
}

constexpr int FA_KP = 272, FA_VP = 320;
constexpr int FA_KOFF = 0, FA_VOFF = 2 * 64 * FA_KP, FA_BYTES = FA_VOFF + 2 * 64 * FA_VP;
__device__ __forceinline__ s16x4 fa_vtr(const LAS unsigned char* p) { return __builtin_bit_cast(s16x4, __builtin_amdgcn_ds_read_tr16_b64_v4i16((LAS s16x4*)p)); }
template <int MODE>
__device__ __forceinline__ void flash_unit(Frame& F, int l, int b, int g, int t0) {
    const int tid = F.tid, lane = F.lane, wave = F.wave, hh = wave & 3, qh = wave >> 2, r = lane & 31, hf = lane >> 5;
    const int qcol = (MODE == 0 ? ZC_AQ : ZC_BQ + 512 * g) + 128 * hh, kcol = MODE == 0 ? ZC_AK : ZC_BK + 128 * g, vcol = MODE == 0 ? ZC_AV : ZC_BV + 128 * g;
    const int ocol = (MODE == 0 ? 0 : 512 + 512 * g) + 128 * hh, hd = (MODE == 0 ? 0 : 4 + 4 * g) + hh;
    const int tq = t0 + 32 * qh + r; const size_t qrow = (size_t)(b * 2048 + tq);
    const LAS float* tab2 = (const LAS float*)(F.misc + MO_TAB2) + hd * 129;
    LAS unsigned char* lds = F.lds;
    bf16x8_t qf[8];
#pragma unroll
    for (int ks = 0; ks < 8; ++ks) qf[ks] = *(const bf16x8_t*)(F.Z + qrow * ZP + qcol + 16 * ks + 8 * hf);
    f32x16 oacc[4];
#pragma unroll
    for (int dt = 0; dt < 4; ++dt)
#pragma unroll
        for (int i = 0; i < 16; ++i) oacc[dt][i] = 0.f;
    float m_run = -1e30f, l_run = 0.f;
    const int tile_lo = MODE == 0 ? 0 : (t0 >= 128 ? t0 / 64 - 2 : 0), tile_hi = t0 / 64 + 1;
    const int skey = tid >> 4, sdc = tid & 15;
    v4u kreg[2], vreg[2];
    { const bf16* zr = F.Z + (size_t)(b * 2048 + 64 * tile_lo + skey) * ZP;
#pragma unroll
      for (int i = 0; i < 2; ++i) { kreg[i] = *(const v4u*)(zr + (size_t)(32 * i) * ZP + kcol + 8 * sdc); vreg[i] = *(const v4u*)(zr + (size_t)(32 * i) * ZP + vcol + 8 * sdc); } }
    const float sc2 = 0.08838834764831845f * 1.4426950408889634f;
    unsigned mwn[2] = {0xffffffffu, 0xffffffffu};
    if (MODE == 0) { mwn[0] = F.MASK[qrow * 64 + 2 * tile_lo]; mwn[1] = F.MASK[qrow * 64 + 2 * tile_lo + 1]; }
#pragma unroll 1
    for (int kt = tile_lo; kt < tile_hi; ++kt) {
        const int bf = (kt - tile_lo) & 1, s0 = 64 * kt;
        LAS unsigned char* kb = lds + FA_KOFF + bf * (64 * FA_KP); LAS unsigned char* vb = lds + FA_VOFF + bf * (64 * FA_VP);
#pragma unroll
        for (int i = 0; i < 2; ++i) { *(LAS v4u*)(kb + (skey + 32 * i) * FA_KP + 16 * sdc) = kreg[i]; *(LAS v4u*)(vb + (skey + 32 * i) * FA_VP + 16 * sdc) = vreg[i]; }
        __syncthreads();
        if (kt + 1 < tile_hi) { const bf16* zr = F.Z + (size_t)(b * 2048 + 64 * (kt + 1) + skey) * ZP;
#pragma unroll
            for (int i = 0; i < 2; ++i) { kreg[i] = *(const v4u*)(zr + (size_t)(32 * i) * ZP + kcol + 8 * sdc); vreg[i] = *(const v4u*)(zr + (size_t)(32 * i) * ZP + vcol + 8 * sdc); } }
        unsigned mw[2] = {mwn[0], mwn[1]};
        if (MODE == 0 && kt + 1 < tile_hi) { mwn[0] = F.MASK[qrow * 64 + 2 * (kt + 1)]; mwn[1] = F.MASK[qrow * 64 + 2 * (kt + 1) + 1]; }
        f32x16 sacc[2];
#pragma unroll
        for (int k2 = 0; k2 < 2; ++k2) {
#pragma unroll
            for (int i = 0; i < 16; ++i) sacc[k2][i] = 0.f;
#pragma unroll
            for (int ks = 0; ks < 8; ++ks) { const bf16x8_t kf = *(const LAS bf16x8_t*)(kb + (32 * k2 + r) * FA_KP + (16 * ks + 8 * hf) * 2);
                sacc[k2] = __builtin_amdgcn_mfma_f32_32x32x16_bf16(kf, qf[ks], sacc[k2], 0, 0, 0); }
        }
        float mx = -1e30f;
        if (MODE == 0 && s0 + 63 + 128 <= t0) {
            const float bfar = tab2[128];
#pragma unroll
            for (int k2 = 0; k2 < 2; ++k2)
#pragma unroll
                for (int i = 0; i < 16; ++i) { const int cr = (i & 3) + 8 * (i >> 2) + 4 * hf;
                    const float v = ((mw[k2] >> cr) & 1u) ? sacc[k2][i] * sc2 + bfar : -__builtin_inff();
                    sacc[k2][i] = v; mx = fmaxf(mx, v); }
        } else
#pragma unroll
        for (int k2 = 0; k2 < 2; ++k2)
#pragma unroll
            for (int i = 0; i < 16; ++i) { const int cr = (i & 3) + 8 * (i >> 2) + 4 * hf; const int dist = tq - (s0 + 32 * k2 + cr);
                bool ok; if (MODE == 0) ok = (mw[k2] >> cr) & 1u; else ok = dist >= 0 && dist < 128;
                const int di = dist < 0 ? 0 : (dist > 128 ? 128 : dist);
                float vf = sacc[k2][i] * sc2 + tab2[di];
                asm volatile("" : "+v"(vf));
                const float v = ok ? vf : -__builtin_inff();
                sacc[k2][i] = v; mx = fmaxf(mx, v); }
        { const auto sw_ = __builtin_amdgcn_permlane32_swap(__float_as_uint(mx), __float_as_uint(mx), false, false); mx = fmaxf(__uint_as_float(sw_[0]), __uint_as_float(sw_[1])); }
        const float m_new = fmaxf(m_run, mx), alpha = __builtin_amdgcn_exp2f(m_run - m_new); m_run = m_new;
        float ps = 0.f;
#pragma unroll
        for (int k2 = 0; k2 < 2; ++k2)
#pragma unroll
            for (int i = 0; i < 16; ++i) { const float p = __builtin_amdgcn_exp2f(sacc[k2][i] - m_new); sacc[k2][i] = p; ps += p; }
        l_run = l_run * alpha + ps;
        if (__ballot(alpha != 1.0f)) {
#pragma unroll
        for (int dt = 0; dt < 4; ++dt)
#pragma unroll
            for (int i = 0; i < 16; ++i) oacc[dt][i] *= alpha;
        }
#pragma unroll
        for (int k2 = 0; k2 < 2; ++k2)
#pragma unroll
            for (int s2 = 0; s2 < 2; ++s2) {
                v4u pw; pw.x = pg8::cvt_pk_bf16(sacc[k2][8 * s2 + 0], sacc[k2][8 * s2 + 1]); pw.y = pg8::cvt_pk_bf16(sacc[k2][8 * s2 + 2], sacc[k2][8 * s2 + 3]);
                pw.z = pg8::cvt_pk_bf16(sacc[k2][8 * s2 + 4], sacc[k2][8 * s2 + 5]); pw.w = pg8::cvt_pk_bf16(sacc[k2][8 * s2 + 6], sacc[k2][8 * s2 + 7]);
                const bf16x8_t pb = __builtin_bit_cast(bf16x8_t, pw);
                const int i16 = lane & 15, grp = (lane >> 4) & 1;
                const LAS unsigned char* vp = vb + (32 * k2 + 16 * s2 + 4 * hf + (i16 >> 2)) * FA_VP + (16 * grp + 4 * (i16 & 3)) * 2;
#pragma unroll
                for (int dt = 0; dt < 4; ++dt) { const s16x4 lo = fa_vtr(vp + 64 * dt), hi = fa_vtr(vp + 8 * FA_VP + 64 * dt);
                    const bf16x8_t vf = __builtin_shufflevector(lo, hi, 0, 1, 2, 3, 4, 5, 6, 7);
                    oacc[dt] = __builtin_amdgcn_mfma_f32_32x32x16_bf16(vf, pb, oacc[dt], 0, 0, 0); }
            }
    }
    float l_tot = l_run + __shfl_xor(l_run, 32);
    if (MODE == 1) l_tot += __builtin_amdgcn_exp2f(F.in[I_SINK][l * 8 + hd - 4] * 1.4426950408889634f - m_run);
    const float inv = 1.0f / l_tot;
    bf16* orow = F.OCAT + qrow * 2048 + ocol + 4 * hf;
#pragma unroll
    for (int dt = 0; dt < 4; ++dt)
#pragma unroll
        for (int gq = 0; gq < 4; ++gq) { v2u w; w.x = pk2(oacc[dt][4 * gq] * inv, oacc[dt][4 * gq + 1] * inv); w.y = pk2(oacc[dt][4 * gq + 2] * inv, oacc[dt][4 * gq + 3] * inv);
            *(v2u*)(orow + 32 * dt + 8 * gq) = w; }
    __syncthreads();
}


#define GLA_GATE_PREFIX(LDS_TOT) \
        float la[8]; \
        _Pragma("unroll") for (int i = 0; i < 8; ++i) { const v4u c0 = rc0[i], c1 = rc1[i]; float x = gb; \
            x += bflo(c0.x) * gwv[0] + bfhi(c0.x) * gwv[1] + bflo(c0.y) * gwv[2] + bfhi(c0.y) * gwv[3] + bflo(c0.z) * gwv[4] + bfhi(c0.z) * gwv[5] + bflo(c0.w) * gwv[6] + bfhi(c0.w) * gwv[7]; \
            x += bflo(c1.x) * gwv[8] + bfhi(c1.x) * gwv[9] + bflo(c1.y) * gwv[10] + bfhi(c1.y) * gwv[11] + bflo(c1.z) * gwv[12] + bfhi(c1.z) * gwv[13] + bflo(c1.w) * gwv[14] + bfhi(c1.w) * gwv[15]; \
            la[i] = (fminf(x, 0.f) - __logf(1.0f + __expf(-fabsf(x)))) * 0.0625f; } \
        _Pragma("unroll") for (int i = 1; i < 8; ++i) la[i] += la[i - 1]; \
        ((LAS float*)(L + LDS_TOT))[cg * 64 + dk] = la[7];
#define GLA_OFFSETS(LDS_TOT) \
        float off = 0.f, tot = 0.f; \
        _Pragma("unroll") for (int g2 = 0; g2 < 8; ++g2) { const float tv = ((const LAS float*)(L + LDS_TOT))[g2 * 64 + dk]; tot += tv; off += g2 < cg ? tv : 0.f; }

__device__ __forceinline__ void gla_state_phase(Frame& F, int l) {
    const int tid = F.tid, lane = F.lane, wave = F.wave, r = lane & 31, hf = lane >> 5, i16 = lane & 15, grp = (lane >> 4) & 1;
    LAS unsigned char* L = F.lds;
    constexpr int KDT = 0, VT = 9216, TOT = 29696, RP = 144, VP = 320;
    const int dk = lane, cg = wave;
    float* GCS = (float*)(F.ws + WS_GCS); float* GDEC = (float*)(F.ws + WS_GDEC);
    v4u rc0[8], rc1[8], rv[2]; unsigned short rk[8];
#define GLS_LOAD(u_) do { const int bh_ = (u_) >> 5, n_ = (u_) & 31; const size_t r0_ = (size_t)((bh_ >> 2) * 2048 + 64 * n_); const int h_ = bh_ & 3; \
        _Pragma("unroll") for (int i = 0; i < 8; ++i) { const bf16* zr = F.Z + (r0_ + 8 * cg + i) * ZP; rc0[i] = *(const v4u*)(zr + ZC_CG); rc1[i] = *(const v4u*)(zr + ZC_CG + 8); rk[i] = zr[ZC_CK + h_ * 64 + dk]; } \
        _Pragma("unroll") for (int i = 0; i < 2; ++i) rv[i] = *(const v4u*)(F.Z + (r0_ + (tid >> 4) + 32 * i) * ZP + ZC_CV + h_ * 128 + 8 * (tid & 15)); } while (0)
    int u = F.vcu;
    if (u < 2048) GLS_LOAD(u);
    for (; u < 2048; u += F.G) {
        const int h = (u >> 5) & 3;
        float gwv[16];
#pragma unroll
        for (int q = 0; q < 16; ++q) gwv[q] = F.in[I_CGW][(size_t)l * 4096 + q * 256 + h * 64 + dk];
        const float gb = F.in[I_CGB][l * 256 + h * 64 + dk];
        GLA_GATE_PREFIX(TOT)
        float kv[8];
#pragma unroll
        for (int i = 0; i < 8; ++i) kv[i] = bf1(rk[i]);
#pragma unroll
        for (int i = 0; i < 2; ++i) *(LAS v4u*)(L + VT + ((tid >> 4) + 32 * i) * VP + 16 * (tid & 15)) = rv[i];
        __syncthreads();
        GLA_OFFSETS(TOT)
        { float kd[8];
#pragma unroll
          for (int i = 0; i < 8; ++i) kd[i] = kv[i] * __expf(tot - (off + la[i]));
          v4u w; w.x = pk2(kd[0], kd[1]); w.y = pk2(kd[2], kd[3]); w.z = pk2(kd[4], kd[5]); w.w = pk2(kd[6], kd[7]); *(LAS v4u*)(L + KDT + dk * RP + 16 * cg) = w; }
        if (cg == 0) GDEC[(size_t)u * 64 + dk] = __expf(tot);
        __syncthreads();
        if (u + F.G < 2048) GLS_LOAD(u + F.G);
        { const int dkt = wave >> 2, dvt = wave & 3;
          f32x16 cs;
#pragma unroll
          for (int i = 0; i < 16; ++i) cs[i] = 0.f;
#pragma unroll
          for (int ks = 0; ks < 4; ++ks) { const bf16x8_t a = *(const LAS bf16x8_t*)(L + KDT + (32 * dkt + r) * RP + (16 * ks + 8 * hf) * 2);
              const LAS unsigned char* vp = L + VT + (16 * ks + 8 * hf + (i16 >> 2)) * VP + (32 * dvt + 16 * grp + 4 * (i16 & 3)) * 2;
              const s16x4 lo = fa_vtr(vp), hi = fa_vtr(vp + 4 * VP);
              cs = __builtin_amdgcn_mfma_f32_32x32x16_bf16(a, __builtin_shufflevector(lo, hi, 0, 1, 2, 3, 4, 5, 6, 7), cs, 0, 0, 0); }
          float* gp = GCS + (size_t)u * 8192 + (size_t)(32 * dkt + 4 * hf) * 128 + 32 * dvt + r;
#pragma unroll
          for (int i = 0; i < 16; ++i) gp[((i & 3) + 8 * (i >> 2)) * 128] = cs[i]; }
        __syncthreads();
    }
#undef GLS_LOAD
}

__device__ __forceinline__ void gla_scan_phase(Frame& F) {
    float* GCS = (float*)(F.ws + WS_GCS); const float* GDEC = (const float*)(F.ws + WS_GDEC);
    for (int gt = F.gw * 64 + F.lane; gt < 64 * 2048; gt += F.NGW * 64) {
        const int bh = gt >> 11, e4 = gt & 2047, dk = e4 >> 5;
        f32x4* p = (f32x4*)(GCS + (size_t)bh * 32 * 8192) + e4; const float* dp = GDEC + (size_t)bh * 32 * 64 + dk;
        f32x4 st = (f32x4){0.f, 0.f, 0.f, 0.f};
#pragma unroll 1
        for (int n0 = 0; n0 < 32; n0 += 8) {
            f32x4 cs[8]; float dc[8];
#pragma unroll
            for (int j = 0; j < 8; ++j) { cs[j] = p[(size_t)(n0 + j) * 2048]; dc[j] = dp[(n0 + j) * 64]; }
#pragma unroll
            for (int j = 0; j < 8; ++j) { p[(size_t)(n0 + j) * 2048] = st; st = st * dc[j] + cs[j]; }
        }
    }
}

__device__ __forceinline__ void gla_out_phase(Frame& F, int l) {
    const int tid = F.tid, lane = F.lane, wave = F.wave, r = lane & 31, hf = lane >> 5, i16 = lane & 15, grp = (lane >> 4) & 1;
    LAS unsigned char* L = F.lds;
    constexpr int QG = 0, KG = 9216, VT = 18432, PT = 38912, TOT = 59392, OT = 61440, RP = 144, VP = 320, OP = 132;
    const int dk = lane, cg = wave;
    const float* GCS = (const float*)(F.ws + WS_GCS);
    v4u rc0[8], rc1[8], rv[2]; unsigned short rq[8], rk[8]; unsigned rg[8]; f32x4 rp[4];
#define GLO_LOAD(u_) do { const int bh_ = (u_) >> 5, n_ = (u_) & 31; const size_t r0_ = (size_t)((bh_ >> 2) * 2048 + 64 * n_); const int h_ = bh_ & 3; \
        _Pragma("unroll") for (int i = 0; i < 8; ++i) { const bf16* zr = F.Z + (r0_ + 8 * cg + i) * ZP; rc0[i] = *(const v4u*)(zr + ZC_CG); rc1[i] = *(const v4u*)(zr + ZC_CG + 8); rq[i] = zr[ZC_CQ + h_ * 64 + dk]; rk[i] = zr[ZC_CK + h_ * 64 + dk]; \
            rg[i] = *(const unsigned*)(zr + ZC_CR + h_ * 128 + 2 * lane); } \
        _Pragma("unroll") for (int i = 0; i < 2; ++i) rv[i] = *(const v4u*)(F.Z + (r0_ + (tid >> 4) + 32 * i) * ZP + ZC_CV + h_ * 128 + 8 * (tid & 15)); \
        _Pragma("unroll") for (int i = 0; i < 4; ++i) rp[i] = *(const f32x4*)(GCS + (size_t)(u_) * 8192 + (size_t)(tid >> 3) * 128 + 16 * (tid & 7) + 4 * i); } while (0)
    int u = F.vcu;
    if (u < 2048) GLO_LOAD(u);
    const float g0 = F.in[I_CNG][l * 128 + 2 * lane], g1 = F.in[I_CNG][l * 128 + 2 * lane + 1];
    for (; u < 2048; u += F.G) {
        const int bh = u >> 5, n = u & 31, h = bh & 3; const size_t row0 = (size_t)((bh >> 2) * 2048 + 64 * n);
        float gwv[16];
#pragma unroll
        for (int q = 0; q < 16; ++q) gwv[q] = F.in[I_CGW][(size_t)l * 4096 + q * 256 + h * 64 + dk];
        const float gb = F.in[I_CGB][l * 256 + h * 64 + dk];
        GLA_GATE_PREFIX(TOT)
        float qv[8], kv[8]; unsigned gr[8];
#pragma unroll
        for (int i = 0; i < 8; ++i) { qv[i] = bf1(rq[i]); kv[i] = bf1(rk[i]); gr[i] = rg[i]; }
#pragma unroll
        for (int i = 0; i < 2; ++i) *(LAS v4u*)(L + VT + ((tid >> 4) + 32 * i) * VP + 16 * (tid & 15)) = rv[i];
        { v4u w0, w1; w0.x = pk2(rp[0].x, rp[0].y); w0.y = pk2(rp[0].z, rp[0].w); w0.z = pk2(rp[1].x, rp[1].y); w0.w = pk2(rp[1].z, rp[1].w);
          w1.x = pk2(rp[2].x, rp[2].y); w1.y = pk2(rp[2].z, rp[2].w); w1.z = pk2(rp[3].x, rp[3].y); w1.w = pk2(rp[3].z, rp[3].w);
          *(LAS v4u*)(L + PT + (tid >> 3) * VP + 32 * (tid & 7)) = w0; *(LAS v4u*)(L + PT + (tid >> 3) * VP + 32 * (tid & 7) + 16) = w1; }
        __syncthreads();
        GLA_OFFSETS(TOT)
#pragma unroll
        for (int i = 0; i < 8; ++i) { const float bi = off + la[i];
            *(LAS bf16*)(L + QG + (8 * cg + i) * RP + 2 * dk) = (bf16)f2bf(qv[i] * 0.125f * __expf(bi));
            *(LAS bf16*)(L + KG + (8 * cg + i) * RP + 2 * dk) = (bf16)f2bf(kv[i] * __expf(-bi)); }
        __syncthreads();
        if (u + F.G < 2048) GLO_LOAD(u + F.G);
        { const int ct = wave >> 2, dvt = wave & 3;
          f32x16 o;
#pragma unroll
          for (int i = 0; i < 16; ++i) o[i] = 0.f;
#pragma unroll
          for (int st = 0; st < 2; ++st) if (st <= ct) {
              f32x16 at;
#pragma unroll
              for (int i = 0; i < 16; ++i) at[i] = 0.f;
#pragma unroll
              for (int ks = 0; ks < 4; ++ks) { const bf16x8_t a = *(const LAS bf16x8_t*)(L + KG + (32 * st + r) * RP + (16 * ks + 8 * hf) * 2), bq = *(const LAS bf16x8_t*)(L + QG + (32 * ct + r) * RP + (16 * ks + 8 * hf) * 2);
                  at = __builtin_amdgcn_mfma_f32_32x32x16_bf16(a, bq, at, 0, 0, 0); }
              if (st == ct) {
#pragma unroll
                  for (int i = 0; i < 16; ++i) { const int cr = (i & 3) + 8 * (i >> 2) + 4 * hf; at[i] = cr <= r ? at[i] : 0.f; } }
#pragma unroll
              for (int s2 = 0; s2 < 2; ++s2) {
                  v4u pw; pw.x = pg8::cvt_pk_bf16(at[8 * s2 + 0], at[8 * s2 + 1]); pw.y = pg8::cvt_pk_bf16(at[8 * s2 + 2], at[8 * s2 + 3]); pw.z = pg8::cvt_pk_bf16(at[8 * s2 + 4], at[8 * s2 + 5]); pw.w = pg8::cvt_pk_bf16(at[8 * s2 + 6], at[8 * s2 + 7]);
                  const LAS unsigned char* vp = L + VT + (32 * st + 16 * s2 + 4 * hf + (i16 >> 2)) * VP + (32 * dvt + 16 * grp + 4 * (i16 & 3)) * 2;
                  const s16x4 lo = fa_vtr(vp), hi = fa_vtr(vp + 8 * VP);
                  o = __builtin_amdgcn_mfma_f32_32x32x16_bf16(__builtin_bit_cast(bf16x8_t, pw), __builtin_shufflevector(lo, hi, 0, 1, 2, 3, 4, 5, 6, 7), o, 0, 0, 0);
              }
          }
#pragma unroll
          for (int ks = 0; ks < 4; ++ks) { const bf16x8_t a = *(const LAS bf16x8_t*)(L + QG + (32 * ct + r) * RP + (16 * ks + 8 * hf) * 2);
              const LAS unsigned char* pp = L + PT + (16 * ks + 8 * hf + (i16 >> 2)) * VP + (32 * dvt + 16 * grp + 4 * (i16 & 3)) * 2;
              const s16x4 lo = fa_vtr(pp), hi = fa_vtr(pp + 4 * VP);
              o = __builtin_amdgcn_mfma_f32_32x32x16_bf16(a, __builtin_shufflevector(lo, hi, 0, 1, 2, 3, 4, 5, 6, 7), o, 0, 0, 0); }
          LAS float* op = (LAS float*)(L + OT) + (32 * ct + 4 * hf) * OP + 32 * dvt + r;
#pragma unroll
          for (int i = 0; i < 16; ++i) op[((i & 3) + 8 * (i >> 2)) * OP] = o[i]; }
        __syncthreads();
        { float a[8], c[8], ss[8];
#pragma unroll
          for (int i = 0; i < 8; ++i) { const LAS float* orow = (const LAS float*)(L + OT) + (8 * wave + i) * OP + 2 * lane; a[i] = orow[0]; c[i] = orow[1]; ss[i] = a[i] * a[i] + c[i] * c[i]; }
#pragma unroll
          for (int o2 = 1; o2 < 64; o2 <<= 1) {
#pragma unroll
              for (int i = 0; i < 8; ++i) ss[i] += __shfl_xor(ss[i], o2); }
#pragma unroll
          for (int i = 0; i < 8; ++i) { const float rstd = rsqrtf(ss[i] * (1.0f / 128.0f) + EPS);
              *(unsigned*)(F.OCAT + (row0 + 8 * wave + i) * 2048 + 1536 + h * 128 + 2 * lane) = pk2(a[i] * rstd * g0 * bflo(gr[i]), c[i] * rstd * g1 * bfhi(gr[i])); } }
        __syncthreads();
    }
#undef GLO_LOAD
}
#undef GLA_GATE_PREFIX
#undef GLA_OFFSETS

__device__ __forceinline__ bool in_phase(int k, int lo, int hi) { asm volatile("" : "+s"(k)); return lo <= k && k < hi; }
#define IN(k) in_phase((k), lo, hi)
#define PHASE_LANE() do { int _tz = threadIdx.x; asm volatile("" : "+v"(_tz)); F.tid = _tz; F.lane = _tz & 63; } while (0)
#define SEAM(k) do { if (IN(k) && IN((k) + 1)) xcd_barrier(bar); } while (0)
template <int l>
__device__ __forceinline__ void layer_body(Frame& F, const XcdBarrier& bar, const int lo, const int hi) {
    constexpr int pb = 1 + 11 * l;
        if (IN(pb + 0)) {
            { pg8::Gemm g{F.XN, (const bf16*)(F.ws + WS_WIN + l * WIN_L + 24 * MiB), T, 768, D}; pg8::StaticOrder S; S.init(T, 768, D, F.G, (int)blockIdx.x);
              pg8::EpiInProj<1> E{F.Z, F.ws + WS_GT, (LAS unsigned long long*)(F.misc + MO_SS), (const LAS float*)(F.misc + MO_GN) + l * 512};
              pg8::gemm_phase<pg8::EpiInProj<1>, pg8::StaticOrder, true, false>(F.lds, g, S, E); }
            { pg8::Gemm g{(const bf16*)(F.ws + WS_XN8), (const bf16*)(F.ws + WS_WIN + l * WIN_L), T, 10496, D / 2}; pg8::StaticOrder S; S.init(T, 10496, D / 2, F.G, ((int)blockIdx.x + F.G / 2) % F.G);
              pg8::EpiInProj<0> E{F.Z, F.ws + WS_GT, (LAS unsigned long long*)(F.misc + MO_SS), (const LAS float*)(F.misc + MO_GN) + l * 512};
              pg8::gemm_phase<pg8::EpiInProj<0>, pg8::StaticOrder, true, true>(F.lds, g, S, E); }
        }
        SEAM(pb + 0);
        if (IN(pb + 1)) { PHASE_LANE();
            if (F.wave & 4) convert_moe(F, l, 0, 4, 40960);
            for (int it = F.gw; it < NB * 128; it += F.NGW) {
                const int b = it >> 7, j = it & 127;
                indexer_segment(F, b, j, 0, j < 64 ? j + 1 : 64);
                if (j < 64) indexer_segment(F, b, 127 - j, 64, 128 - j);
            }
            if (!(F.wave & 4)) convert_moe(F, l, 0, 4, 40960);
            PHASE_LANE();
            gla_state_phase(F, l);
        }
        SEAM(pb + 1);
        if (IN(pb + 2)) { PHASE_LANE();
            if (F.wave & 4) convert_moe(F, l, 1, 4, 0);
            for (int row = F.gw; row < T; row += F.NGW) {
                const int t = row & 2047;
                if (t < 256) { const int nb = t + 1 - 32 * F.lane; F.MASK[(size_t)row * 64 + F.lane] = nb >= 32 ? 0xffffffffu : (nb <= 0 ? 0u : ((1u << nb) - 1u)); continue; }
                float val[32];
#pragma unroll
                for (int j = 0; j < 32; ++j) { const int s_ = 64 * j + F.lane; val[j] = F.S[(size_t)row * 2048 + (s_ < t ? s_ : t)]; }
                float vmx = -3.0e38f, vmn = 3.0e38f;
#pragma unroll
                for (int j = 0; j < 32; ++j) { const bool ok = 64 * j + F.lane <= t; val[j] = ok ? val[j] : -3.0e38f; vmx = fmaxf(vmx, val[j]); vmn = fminf(vmn, ok ? val[j] : 3.0e38f); }
#pragma unroll
                for (int o = 1; o < 64; o <<= 1) { vmx = fmaxf(vmx, __shfl_xor(vmx, o)); vmn = fminf(vmn, __shfl_xor(vmn, o)); }
                float lo = vmn, hi = vmx, thf = 0.f; bool exact = false;
#pragma unroll 1
                for (int it = 0; it < 28; ++it) { const float mid = 0.5f * (lo + hi); if (!(mid > lo && mid < hi)) break; int cnt = 0;
#pragma unroll
                    for (int j = 0; j < 32; ++j) cnt += __popcll(__ballot(val[j] >= mid));
                    if (cnt == 256) { exact = true; thf = mid; break; }
                    if (cnt > 256) lo = mid; else hi = mid; }
                unsigned th = 0u; int need = 0;
#define KEYOF(x) ({ const unsigned u_ = __float_as_uint(x); (u_ & 0x80000000u) ? ~u_ : (u_ | 0x80000000u); })
                if (!exact) {
#pragma unroll 1
                    for (int bit = 31; bit >= 0; --bit) { const unsigned cand = th | (1u << bit); int cnt = 0;
#pragma unroll
                        for (int j = 0; j < 32; ++j) cnt += __popcll(__ballot(KEYOF(val[j]) >= cand));
                        if (cnt >= 256) th = cand; }
                    int cgt = 0;
#pragma unroll
                    for (int j = 0; j < 32; ++j) cgt += __popcll(__ballot(KEYOF(val[j]) > th));
                    need = 256 - cgt;
                }
                int run = 0; unsigned myword = 0u;
#pragma unroll
                for (int j = 0; j < 32; ++j) {
                    bool sel;
                    if (exact) sel = val[j] >= thf;
                    else { const unsigned kj = KEYOF(val[j]); const bool eq = kj == th; const unsigned long long eqm = __ballot(eq);
                        const int pre = run + __popcll(eqm & ((1ull << F.lane) - 1ull)); sel = (kj > th) || (eq && pre < need); run += __popcll(eqm); sel = sel && (64 * j + F.lane <= t); }
                    const unsigned long long sm = __ballot(sel);
                    if ((F.lane >> 1) == j) myword = (F.lane & 1) ? (unsigned)(sm >> 32) : (unsigned)sm;
                }
#undef KEYOF
                F.MASK[(size_t)row * 64 + F.lane] = myword;
            }
            if (!(F.wave & 4)) convert_moe(F, l, 1, 4, 0);
            gla_scan_phase(F);
        }
        SEAM(pb + 2);
        if (IN(pb + 3)) { PHASE_LANE();
            if (F.vcu & 1) { convert_moe(F, l, 1, 2, 0); __syncthreads(); PHASE_LANE(); }
            for (int u = F.vcu; u < NB * 16; u += F.G) { const int b = u >> 4, p = u & 15; flash_unit<0>(F, l, b, 0, 64 * (31 - p)); flash_unit<0>(F, l, b, 0, 64 * p); }
            for (int u = F.vcu; u < NB * 2 * 32; u += F.G) { const int b = u >> 6, g = (u >> 5) & 1, qb = u & 31; flash_unit<1>(F, l, b, g, 64 * qb); }
            gla_out_phase(F, l);
            if (!(F.vcu & 1)) { PHASE_LANE(); convert_moe(F, l, 1, 2, 0); }
        }
        SEAM(pb + 3);
        if (IN(pb + 4)) {
            pg8::Gemm g{F.OCAT, (const bf16*)(F.ws + WS_WBR + l * WBR_L), T, D, D}; pg8::MergeOrder S; S.init(T, D, D, F.G, (int)blockIdx.x);
#ifdef PROBE_MERGE
            { pg8::EpiMergeT<PROBE_MERGE> E{F.ws + WS_GT, (bf16*)(F.ws + WS_S)}; pg8::gemm_phase<pg8::EpiMergeT<PROBE_MERGE>, pg8::MergeOrder, true>(F.lds, g, S, E); }
#endif
            pg8::EpiMerge E{F.ws + WS_GT, F.MERGED};
            pg8::gemm_phase<pg8::EpiMerge, pg8::MergeOrder, true>(F.lds, g, S, E);
        }
        SEAM(pb + 4);
        if (IN(pb + 5)) {
            pg8::Gemm g{F.MERGED, (const bf16*)(F.ws + WS_WO + l * WO_L), T, D, D}; pg8::StaticOrder S; S.init(T, D, D, F.G, (int)blockIdx.x);
            pg8::EpiResid E{(bf16*)(F.ws + WS_HB), (unsigned char*)F.XN, F.in[I_N2G] + l * D, F.lds + 3 * pg8::HTB};
            pg8::gemm_phase<pg8::EpiResid, pg8::StaticOrder, true>(F.lds, g, S, E);
        }
        SEAM(pb + 5);
        if (IN(pb + 6)) { PHASE_LANE();
            unsigned* cnt = F.ctl + CW_CNT + 64 * l;
            const int lane = F.lane, fr = lane & 15, fq = lane >> 4;
            LAS float* LG = (LAS float*)(F.lds + F.wave * 8192);
            const bf16* wrh = (const bf16*)(F.ws + WS_WRH + l * WR_L) + (size_t)fr * 2048 + 8 * fq; const bf16* wrl = (const bf16*)(F.ws + WS_WRL + l * WR_L) + (size_t)fr * 2048 + 8 * fq;
            for (int tile = F.gw; tile < T / 16; tile += F.NGW) {
                const bf16* hrow = (const bf16*)(F.ws + WS_HB) + (size_t)(16 * tile + fr) * D + 8 * fq;
                f32x4 acc[6];
#pragma unroll
                for (int nt = 0; nt < 6; ++nt) acc[nt] = (f32x4){0.f, 0.f, 0.f, 0.f};
                float ss = 0.f;
#pragma unroll 2
                for (int ks = 0; ks < 64; ++ks) {
                    const v4u hw = *(const v4u*)(hrow + 32 * ks);
                    { const float a0 = bflo(hw.x), a1 = bfhi(hw.x), a2 = bflo(hw.y), a3 = bfhi(hw.y), a4 = bflo(hw.z), a5 = bfhi(hw.z), a6 = bflo(hw.w), a7 = bfhi(hw.w);
                      ss += (a0 * a0 + a1 * a1) + (a2 * a2 + a3 * a3) + (a4 * a4 + a5 * a5) + (a6 * a6 + a7 * a7); }
                    const bf16x8_t ah = __builtin_bit_cast(bf16x8_t, hw);
#pragma unroll
                    for (int nt = 0; nt < 6; ++nt) { const bf16x8_t bh = *(const bf16x8_t*)(wrh + (size_t)(16 * nt) * 2048 + 32 * ks), bl = *(const bf16x8_t*)(wrl + (size_t)(16 * nt) * 2048 + 32 * ks);
                        acc[nt] = __builtin_amdgcn_mfma_f32_16x16x32_bf16(ah, bh, acc[nt], 0, 0, 0);
                        acc[nt] = __builtin_amdgcn_mfma_f32_16x16x32_bf16(ah, bl, acc[nt], 0, 0, 0); }
                }
                ss += __shfl_xor(ss, 16); ss += __shfl_xor(ss, 32);
                if (fq == 0) { const float rs_ = rsqrtf(ss * (1.0f / 2048.0f) + EPS); LG[1600 + fr] = rs_; ((float*)(F.ws + WS_RSTD))[16 * tile + fr] = rs_; }
#pragma unroll
                for (int nt = 0; nt < 6; ++nt)
#pragma unroll
                    for (int i = 0; i < 4; ++i) LG[(4 * fq + i) * 100 + 16 * nt + fr] = acc[nt][i];
                LDS_WAIT(); asm volatile("" ::: "memory");
                if (lane < 16) {
                    const int row = 16 * tile + lane; const float rstd = LG[1600 + lane]; const LAS float* lr = LG + lane * 100;
                    float lg[8]; int grp = 0; float gmax = -3.0e38f;
#pragma unroll
                    for (int e = 0; e < 8; ++e) { lg[e] = lr[e] * rstd + F.in[I_BRG][l * 8 + e]; if (lg[e] > gmax) { gmax = lg[e]; grp = e; } }
                    float gden = 0.f;
#pragma unroll
                    for (int e = 0; e < 8; ++e) gden += __expf(lg[e] - gmax);
                    const float gwt = 1.0f / gden;
                    int i0 = 0, i1 = 0; float m0 = -3.0e38f, m1 = -3.0e38f;
#pragma unroll
                    for (int e = 0; e < 8; ++e) { const float v = lr[8 + grp * 8 + e] * rstd + F.in[I_BRE][l * 64 + grp * 8 + e];
                        if (v > m0) { m1 = m0; i1 = i0; m0 = v; i0 = e; } else if (v > m1) { m1 = v; i1 = e; } }
                    const float e1 = __expf(m1 - m0); const float p0 = 1.0f / (1.0f + e1), p1 = e1 / (1.0f + e1);
                    const int ex0 = grp * 8 + i0, ex1 = grp * 8 + i1;
                    const unsigned r0 = atomicAdd(&cnt[ex0], 1u), r1 = atomicAdd(&cnt[ex1], 1u);
                    unsigned* rec = (unsigned*)(F.ws + WS_ROUTE) + (size_t)row * 8;
                    rec[0] = (unsigned)ex0; rec[1] = r0; rec[2] = (unsigned)ex1; rec[3] = r1; rec[4] = __float_as_uint(gwt * p0); rec[5] = __float_as_uint(gwt * p1);
                    int* liste = (int*)(F.ws + WS_LISTE); liste[(size_t)ex0 * 32768 + r0] = row; liste[(size_t)ex1 * 32768 + r1] = row;
                }
                LDS_WAIT(); asm volatile("" ::: "memory");
            }
        }
        SEAM(pb + 6);
        if (IN(pb + 7) || IN(pb + 8) || IN(pb + 9) || IN(pb + 10)) { PHASE_LANE();
            if (F.tid == 0) { const unsigned* cnt = F.ctl + CW_CNT + 64 * l; LAS int* texp = (LAS int*)(F.misc + MO_TEXP); LAS int* pst = (LAS int*)(F.misc + MO_PST); int tb = 0;
                for (int e = 0; e < NEXP; ++e) { const int c = (int)__hip_atomic_load(&cnt[e], __ATOMIC_RELAXED, __HIP_MEMORY_SCOPE_AGENT); const int nt_ = (c + 255) >> 8; pst[e] = tb * 256; ((LAS int*)(F.misc + MO_CNT))[e] = c;
                    for (int r = 0; r < nt_; ++r) texp[tb + r] = e; tb += nt_; }
                *(LAS int*)(F.misc + MO_TOT) = tb; }
            __syncthreads();
        }
        if (IN(pb + 8)) {
            pg8::Gemm g{F.XN, (const bf16*)(F.ws + WS_W13), 0, 0, D / 2};
            pg8::MoeGatherOrder S; S.total = *(const LAS int*)(F.misc + MO_TOT) * 4; S.G = F.G; S.c = F.vcu; S.NJ = 4; S.nt0 = D / 128; S.tile_exp = (const LAS int*)(F.misc + MO_TEXP);
            S.pst = (const LAS int*)(F.misc + MO_PST); S.cnt = (const LAS int*)(F.misc + MO_CNT); S.liste = (const int*)(F.ws + WS_LISTE);
            pg8::EpiGlu E{F.H, S.tile_exp, S.pst, S.cnt, S.liste, (const float*)(F.ws + WS_RSTD)};
            pg8::gemm_phase<pg8::EpiGlu, pg8::MoeGatherOrder, true, true>(F.lds, g, S, E);
        }
        SEAM(pb + 8);
        if (IN(pb + 9)) {
            pg8::Gemm g{F.H, (const bf16*)(F.ws + WS_W2), 0, 0, DEXP / 2};
            pg8::MoeOrder S{*(const LAS int*)(F.misc + MO_TOT) * 8, F.G, F.vcu, 8, DEXP / 128, (const LAS int*)(F.misc + MO_TEXP)};
            pg8::EpiY E{(unsigned char*)F.Y};
            pg8::gemm_phase<pg8::EpiY, pg8::MoeOrder, true, true>(F.lds, g, S, E);
        }
        SEAM(pb + 9);
        if (IN(pb + 10)) { PHASE_LANE();
            for (int row = F.gw; row < T; row += F.NGW) {
                const unsigned* rec = (const unsigned*)(F.ws + WS_ROUTE) + (size_t)row * 8;
                const float w0 = __uint_as_float(rec[4]) * 0.03125f, w1 = __uint_as_float(rec[5]) * 0.03125f;
                const LAS int* pst = (const LAS int*)(F.misc + MO_PST); const int p0 = pst[rec[0]] + (int)rec[1], p1 = pst[rec[2]] + (int)rec[3];
                const unsigned* y0 = (const unsigned*)((const unsigned char*)F.Y + (size_t)p0 * D) + F.lane; const unsigned* y1 = (const unsigned*)((const unsigned char*)F.Y + (size_t)p1 * D) + F.lane;
                f32x4 v[8];
                { const v2u* hr = (const v2u*)((const bf16*)(F.ws + WS_HB) + (size_t)row * D) + F.lane;
#pragma unroll
                  for (int j = 0; j < 8; ++j) { const v2u w = hr[64 * j]; v[j] = (f32x4){bflo(w.x), bfhi(w.x), bflo(w.y), bfhi(w.y)}; } }
#pragma unroll
                for (int j = 0; j < 8; ++j) { const int a = (int)y0[64 * j], c = (int)y1[64 * j];
                    const auto a01 = __builtin_amdgcn_cvt_pk_f32_fp8(a, false), a23 = __builtin_amdgcn_cvt_pk_f32_fp8(a, true), c01 = __builtin_amdgcn_cvt_pk_f32_fp8(c, false), c23 = __builtin_amdgcn_cvt_pk_f32_fp8(c, true);
                    v[j].x += w0 * a01[0] + w1 * c01[0]; v[j].y += w0 * a01[1] + w1 * c01[1]; v[j].z += w0 * a23[0] + w1 * c23[0]; v[j].w += w0 * a23[1] + w1 * c23[1]; }
                if (l + 1 < DEPTH) { v2u* hw_ = (v2u*)((bf16*)(F.ws + WS_HB) + (size_t)row * D) + F.lane;
#pragma unroll
                    for (int j = 0; j < 8; ++j) hw_[64 * j] = (v2u){pg8::cvt_pk_bf16(v[j].x, v[j].y), pg8::cvt_pk_bf16(v[j].z, v[j].w)}; }
                else { f32x4* orow = (f32x4*)(F.out + (size_t)row * D) + F.lane;
#pragma unroll
                    for (int j = 0; j < 8; ++j) orow[64 * j] = v[j]; }
                if (l + 1 < DEPTH) { const float rstd = row_rstd(v); norm_store_bf16(v, rstd, F.in[I_N1G] + (l + 1) * D, F.XN + (size_t)row * D, F.lane); norm_store_fp8(v, rstd, F.in[I_N1G] + (l + 1) * D, (unsigned char*)(F.ws + WS_XN8) + (size_t)row * D, F.lane); }
            }
        }
        SEAM(pb + 10);
    }
__global__ void __launch_bounds__(NWAVES * 64, 2) fwd_kernel(Args args) {
    extern __shared__ __attribute__((aligned(16))) unsigned char lds_raw[];
    Frame F;
    F.lds = (LAS unsigned char*)lds_raw; F.misc = F.lds + MISC_OFF;
    F.tid = threadIdx.x; F.lane = F.tid & 63; F.wave = __builtin_amdgcn_readfirstlane(F.tid >> 6);
    F.G = gridDim.x; { const int bx = blockIdx.x; F.vcu = (F.G % 8 == 0) ? (bx % 8) * (F.G / 8) + bx / 8 : bx; }
    F.gw = F.vcu * NWAVES + F.wave; F.NGW = F.G * NWAVES;
    F.in = args.in; F.out = args.out; F.ws = args.ws; F.ctl = (unsigned*)(args.ws + WS_CTL);
    F.Z = (bf16*)(args.ws + WS_Z); F.XN = (bf16*)(args.ws + WS_XN); F.OCAT = (bf16*)(args.ws + WS_OCAT); F.MERGED = (bf16*)(args.ws + WS_MERGED);
    F.XS = (bf16*)(args.ws + WS_XS); F.Y = (bf16*)(args.ws + WS_Y); F.H = (bf16*)(args.ws + WS_H);
    F.S = (float*)(args.ws + WS_S); F.GO = (float*)(args.ws + WS_GO); F.MASK = (unsigned*)(args.ws + WS_MASK);
    const int lo = args.ph_lo, hi = args.ph_hi;
    const bool use_bar = (hi - lo) > 1;
    for (int u = F.tid; u < 64; u += NWAVES * 64) ((LAS unsigned*)F.misc)[u] = 0u;
    ((LAS unsigned long long*)(F.misc + MO_SS))[F.tid] = 0ull;
    for (int i = F.tid; i < 2 * 4 * 128; i += NWAVES * 64) { const int l_ = i >> 9, k_ = (i >> 7) & 3, d_ = i & 127; ((LAS float*)(F.misc + MO_GN))[i] = F.in[k_ == 0 ? I_AQG : (k_ == 1 ? I_AKG : (k_ == 2 ? I_BQG : I_BKG))][l_ * 128 + d_]; }
    for (int i = F.tid; i < 12 * 129; i += NWAVES * 64) { const int hd = i / 129, dd = i % 129; int bk;
        if (dd < 16) bk = dd; else { bk = 16 + (int)(logf((float)dd / 16.0f) / 2.0794415416798357f * 16.0f); bk = bk > 31 ? 31 : bk; }
        ((LAS float*)(F.misc + MO_TAB2))[i] = F.in[I_RELB][bk * 12 + hd] * 1.4426950408889634f; }
    __syncthreads();
    XcdBarrier bar; bar.bar = F.ctl + CW_BAR; bar.x = 0; bar.st = nullptr;
    if (use_bar) bar = xcd_barrier_post(F.ctl + CW_BAR, (volatile LAS unsigned*)(F.misc + MO_BARW));

    if (IN(0)) { PHASE_LANE();
        LAS float* scr = (LAS float*)(F.lds + F.wave * 16384);
        constexpr int I_IN = (2048 / 64) * (D_IN / 32);
        constexpr int I_BA = (512 / 64) * (2048 / 32), I_BB = (1024 / 64) * (2048 / 32), I_BC = I_BA, I_O = (2048 / 64) * (2048 / 32);
        constexpr int PER_L = I_IN + I_BA + I_BB + I_BC + I_O;
        for (int it = F.gw; it < DEPTH * PER_L; it += F.NGW) {
            const int l = it / PER_L; int r = it % PER_L;
            bf16* win = (bf16*)(F.ws + WS_WIN + l * WIN_L); bf16* wbr = (bf16*)(F.ws + WS_WBR + l * WBR_L); bf16* wo = (bf16*)(F.ws + WS_WO + l * WO_L);
            if (r < I_IN) { const int nb_ = r % (D_IN / 32);
                const bool has8 = nb_ < 56 || (nb_ >= 58 && nb_ <= 106) || nb_ >= 122, hasb = (nb_ >= 56 && nb_ <= 58) || (nb_ >= 106 && nb_ <= 122) || nb_ == 138;
                if (has8) transpose_item_fp8(F.in[I_WIN] + (size_t)l * 2048 * D_IN, D_IN, (unsigned char*)win, 2048, 64.0f, scr, r, F.lane, MapWin8{});
                if (hasb) transpose_item(F.in[I_WIN] + (size_t)l * 2048 * D_IN, D_IN, win + (size_t)12 * 1024 * 1024, 2048, 0, scr, r, F.lane, MapWinB{});
                continue; } r -= I_IN;
            if (r < I_BA) { transpose_item(F.in[I_WBA] + (size_t)l * 512 * 2048, 2048, wbr, 2048, 0, scr, r, F.lane, MapId{0}); continue; } r -= I_BA;
            if (r < I_BB) { transpose_item(F.in[I_WBB] + (size_t)l * 1024 * 2048, 2048, wbr, 2048, 512, scr, r, F.lane, MapId{0}); continue; } r -= I_BB;
            if (r < I_BC) { transpose_item(F.in[I_WBC] + (size_t)l * 512 * 2048, 2048, wbr, 2048, 1536, scr, r, F.lane, MapId{0}); continue; } r -= I_BC;
            transpose_item(F.in[I_WO] + (size_t)l * 2048 * 2048, 2048, wo, 2048, 0, scr, r, F.lane, MapId{0});
        }
        for (int i = F.gw * 64 + F.lane; i < DEPTH * 160 * 256; i += F.NGW * 64) { const int l = i / (160 * 256), r = (i / 256) % 160, c = i % 256;
            *(v4u*)((bf16*)(F.ws + WS_WIN + l * WIN_L) + (size_t)12 * 1024 * 1024 + (size_t)(ZC_PAD - 3328 + r) * 2048 + 8 * c) = (v4u){0u, 0u, 0u, 0u}; }
        for (int i = F.gw * 64 + F.lane; i < DEPTH * 96 * 2048; i += F.NGW * 64) { const int l = i / (96 * 2048), e = (i / 2048) % 96, k = i % 2048;
            float val = 0.f; if (e < 8) val = F.in[I_WRG][(size_t)l * D * 8 + (size_t)k * 8 + e]; else if (e < 72) val = F.in[I_WRE][(size_t)l * D * 64 + (size_t)k * 64 + (e - 8)];
            val *= F.in[I_N2G][l * D + k];
            const unsigned hi = f2bf(val); const float rem = val - bf1((bf16)hi);
            ((bf16*)(F.ws + WS_WRH + l * WR_L))[e * 2048 + k] = (bf16)hi; ((bf16*)(F.ws + WS_WRL + l * WR_L))[e * 2048 + k] = (bf16)f2bf(rem); }
        for (int mrow = F.gw; mrow < T; mrow += F.NGW) { f32x4 v[8]; load_row(F.in[I_X] + (size_t)mrow * D, F.lane, v); const float rstd = row_rstd(v);
            { v2u* hw_ = (v2u*)((bf16*)(F.ws + WS_HB) + (size_t)mrow * D) + F.lane;
#pragma unroll
              for (int j = 0; j < 8; ++j) hw_[64 * j] = (v2u){pg8::cvt_pk_bf16(v[j].x, v[j].y), pg8::cvt_pk_bf16(v[j].z, v[j].w)}; }
            norm_store_bf16(v, rstd, F.in[I_N1G], F.XN + (size_t)mrow * D, F.lane); norm_store_fp8(v, rstd, F.in[I_N1G], (unsigned char*)(F.ws + WS_XN8) + (size_t)mrow * D, F.lane); }
    }
    SEAM(0);

    layer_body<0>(F, bar, lo, hi);
    layer_body<1>(F, bar, lo, hi);
}


#ifndef N_LAUNCH_MODE
#define N_LAUNCH_MODE 1
#endif
extern "C" void kernel_launch(void* const* d_in, const int* in_sizes, int n_in, void* d_out, int out_size, void* d_ws, size_t ws_size, hipStream_t stream) {
    static int grid = 0;
    if (grid == 0) {
        if (n_in != 24 || out_size != T * D || ws_size < WS_END) { fprintf(stderr, "kernel_launch: unexpected shapes (n_in %d out %d ws %zu)\n", n_in, out_size, ws_size); grid = -1; return; }
        int dev = 0, cus = 0, per_cu = 0;
        if (hipGetDevice(&dev) != hipSuccess || hipDeviceGetAttribute(&cus, hipDeviceAttributeMultiprocessorCount, dev) != hipSuccess) { grid = -1; return; }
        if (hipFuncSetAttribute((const void*)fwd_kernel, hipFuncAttributeMaxDynamicSharedMemorySize, LDS_BYTES) != hipSuccess) { fprintf(stderr, "kernel_launch: hipFuncSetAttribute failed\n"); grid = -1; return; }
        if (hipOccupancyMaxActiveBlocksPerMultiprocessor(&per_cu, (const void*)fwd_kernel, NWAVES * 64, LDS_BYTES) != hipSuccess || per_cu < 1) { fprintf(stderr, "kernel_launch: occupancy query says %d\n", per_cu); }
        (void)hipGetLastError();
        grid = cus;
    }
    if (grid < 0) return;
    (void)hipMemsetAsync((char*)d_ws + WS_CTL, 0, CTL_ZERO_BYTES, stream);
    Args a{};
    for (int i = 0; i < 24; ++i) a.in[i] = (const float*)d_in[i];
    a.out = (float*)d_out; a.ws = (unsigned char*)d_ws;
    constexpr int NPH = 1 + 11 * DEPTH;
#if N_LAUNCH_MODE == 1
    a.ph_lo = 0; a.ph_hi = NPH;
    hipLaunchKernelGGL(fwd_kernel, dim3(grid), dim3(NWAVES * 64), LDS_BYTES, stream, a);
#else
    for (int p = 0; p < NPH; ++p) { a.ph_lo = p; a.ph_hi = p + 1; hipLaunchKernelGGL(fwd_kernel, dim3(grid), dim3(NWAVES * 64), LDS_BYTES, stream, a); }
#endif
    const hipError_t le = hipPeekAtLastError();
    if (le != hipSuccess) fprintf(stderr, "kernel_launch: launch failed: %s\n", hipGetErrorName(le));
}
```

```cpp
#include <hip/hip_runtime.h>
#include <cstdio>
#include <cstdint>

__device__ __forceinline__ int lane_id() { return (int)__builtin_amdgcn_mbcnt_hi(~0u, __builtin_amdgcn_mbcnt_lo(~0u, 0u)); }
namespace pg8 {
#define PG8_LAS __attribute__((address_space(3)))
typedef unsigned short bf16_t;
typedef short bf16x8 __attribute__((ext_vector_type(8)));
typedef float f32x4 __attribute__((ext_vector_type(4)));
typedef unsigned u32x4 __attribute__((ext_vector_type(4)));
typedef unsigned u32x2 __attribute__((ext_vector_type(2)));
constexpr int BM = 256, BK = 64, HALF = 128, HTB = HALF * BK * 2  , STAGE_BYTES = 8 * HTB, NXCD = 8, WGM = 8;

__host__ __device__ __forceinline__ int lds_byte(int r, int c) { const int st = (r >> 4) * 2 + (c >> 5), rr = r & 15, cc = c & 31, ob = rr * 64 + cc * 2; return st * 1024 + (ob ^ (((ob >> 9) & 1) << 5)); }
__host__ __device__ __forceinline__ void stage_rc(int b, int& R, int& C) { const int st = b / 1024, sb = b % 1024, swz = sb ^ (((sb >> 9) & 1) << 5); R = (st >> 1) * 16 + swz / 64; C = (st & 1) * 32 + (swz % 64) / 2; }
__host__ __device__ __forceinline__ int perm32(int rho) { const int n = rho >> 4, i = rho & 15; return 8 * (i >> 2) + 4 * n + (i & 3); }

struct Unit { int pm, pn, koff, nt, seg; };
struct Gemm { const bf16_t* A; const bf16_t* Bt; int M, N, K; };

struct StaticOrder {
    static constexpr bool GATHER = false;
    int nM, nN, nwg, G, c, nt0;
    __device__ __forceinline__ int row_token(const Unit&, int) const { return 0; }
    __device__ void init(int M, int N, int K, int G_, int c_) { nM = M / BM; nN = N / BM; nwg = nM * nN; G = G_; c = c_; nt0 = K / BK; }
    __device__ bool tile(long L, Unit& u) const {
        if (L >= nwg) return false;
        int wgid = (int)L; { const int q = nwg / NXCD, r = nwg % NXCD, xcd = wgid % NXCD, off = wgid / NXCD; wgid = (xcd < r ? xcd * (q + 1) : r * (q + 1) + (xcd - r) * q) + off; }
        const int nig = WGM * nN, gid = wgid / nig, fm = gid * WGM, gsz = (nM - fm) < WGM ? (nM - fm) : WGM;
        u.pm = fm + ((wgid % nig) % gsz); u.pn = (wgid % nig) / gsz; return true;
    }
    __device__ bool next(int i, Unit& u) const { u.koff = 0; u.nt = nt0; u.seg = 0; return tile((long)i * G + c, u); }
    __device__ __forceinline__ void a_ready(const Unit&) const {}
    __device__ __forceinline__ void done(const Unit&) const {}
};
struct MergeOrder : StaticOrder {
    __device__ bool next(int i, Unit& u) const { const int rnd = i / 3, sg = i - 3 * rnd; u.seg = sg; u.koff = sg == 0 ? 0 : (sg == 1 ? 512 : 1536); u.nt = sg == 1 ? 16 : 8; return tile((long)rnd * G + c, u); }
};
struct MoeOrder {
    static constexpr bool GATHER = false;
    int total, G, c, NJ, nt0; const PG8_LAS int* tile_exp;
    __device__ bool next(int i, Unit& u) const {
        const long L = (long)i * G + c; if (L >= total) return false;
        const int R = (int)L / NJ, j = (int)L % NJ; u.pm = R; u.pn = tile_exp[R] * NJ + j; u.koff = 0; u.nt = nt0; u.seg = 0; return true;
    }
    __device__ __forceinline__ int row_token(const Unit&, int) const { return 0; }
    __device__ __forceinline__ void a_ready(const Unit&) const {}
    __device__ __forceinline__ void done(const Unit&) const {}
};
struct MoeGatherOrder : MoeOrder {
    static constexpr bool GATHER = true;
    const PG8_LAS int* pst; const PG8_LAS int* cnt; const int* liste;
    __device__ __forceinline__ int row_token(const Unit& u, int r) const {
        const int e = tile_exp[u.pm], lr = u.pm * 256 - pst[e] + r;
        return lr < cnt[e] ? liste[(size_t)e * 32768 + lr] : 0;
    }
};

typedef __bf16 bf16x2v __attribute__((ext_vector_type(2)));
typedef float f32x2v __attribute__((ext_vector_type(2)));
__device__ __forceinline__ unsigned cvt_pk_bf16(float lo, float hi) { const f32x2v v = {lo, hi}; const bf16x2v b = __builtin_convertvector(v, bf16x2v); return __builtin_bit_cast(unsigned, b); }
__device__ __forceinline__ float bflo(unsigned w) { return __uint_as_float(w << 16); }
__device__ __forceinline__ float bfhi(unsigned w) { return __uint_as_float(w & 0xffff0000u); }
__device__ __forceinline__ float sigm(float v) { return __builtin_amdgcn_rcpf(1.0f + __builtin_amdgcn_exp2f(-1.44269504f * v)); }
__device__ __forceinline__ unsigned q8x4(const f32x4 s) {
    const unsigned a = (unsigned)fminf(s[0] * 256.0f, 255.5f), b = (unsigned)fminf(s[1] * 256.0f, 255.5f), c = (unsigned)fminf(s[2] * 256.0f, 255.5f), d = (unsigned)fminf(s[3] * 256.0f, 255.5f);
    return a | (b << 8) | (c << 16) | (d << 24);
}

constexpr int ZP = 5120;
constexpr int ZC_GA = 5120, ZC_GB = 7168, ZC_GC = 9216;
constexpr size_t GT_TILE = 65536, GT_GATE = (size_t)128 * 8 * GT_TILE;

template <int PN_OFF> struct EpiInProj {
    static constexpr bool PERM = true, AFTER_DRAIN = false, CHAIN = false;
    bf16_t* O; unsigned char* GT; PG8_LAS unsigned long long* ss;
    const PG8_LAS float* gains;
    __device__ __forceinline__ void operator()(const f32x4 (&acc)[2][2][4][2], const Unit& u, int wr, int wc, int fr, int fq) const {
        const int pn = PN_OFF ? u.pn + 13 : (u.pn < 13 ? u.pn : u.pn + 3);
        int row0 = u.pm * BM + wr * 64 + fr, col0 = pn * BM + wc * 32 + 8 * fq;
        asm volatile("" : "+v"(row0), "+v"(col0));
        const int act = pn >= 20 ? 2 : (pn >= 18 ? 1 : 0);
        const bool hn = PN_OFF == 0 && pn <= 7;
        f32x4 gn0 = (f32x4){1.f, 1.f, 1.f, 1.f}, gn1 = gn0; int lr = 0;
        if (hn) {
            lr = wr * 64 + fr; asm volatile("" : "+v"(lr));
#pragma unroll
            for (int ai = 0; ai < 2; ++ai)
#pragma unroll
                for (int m = 0; m < 4; ++m)
#pragma unroll
                    for (int bj = 0; bj < 2; ++bj) { const f32x4 a = acc[ai][bj][m][0], b = acc[ai][bj][m][1];
                        float s = (a[0] * a[0] + a[1] * a[1]) + (a[2] * a[2] + a[3] * a[3]) + (b[0] * b[0] + b[1] * b[1]) + (b[2] * b[2] + b[3] * b[3]);
                        s += __shfl_xor(s, 16); s += __shfl_xor(s, 32);
                        if (fq == 0) __hip_atomic_fetch_add(ss + (ai * HALF + m * 16 + lr) * 2 + bj, (unsigned long long)(s * 1048576.0f), __ATOMIC_RELAXED, __HIP_MEMORY_SCOPE_WORKGROUP); }
            asm volatile("s_waitcnt lgkmcnt(0)" ::: "memory"); __builtin_amdgcn_s_barrier(); asm volatile("" ::: "memory");
            const PG8_LAS float* gp = gains + (pn <= 1 ? 0 : (pn == 2 ? 128 : (pn <= 6 ? 256 : 384))) + wc * 32 + 8 * fq;
            gn0 = *(const PG8_LAS f32x4*)gp; gn1 = *(const PG8_LAS f32x4*)(gp + 4);
        }
        if (act == 2) {
            int lo16 = (wr * 4 + wc) * 8192 + (fq * 16 + fr) * 16; asm volatile("" : "+v"(lo16));
            unsigned char* gp = GT + (size_t)((pn - 20) >> 3) * GT_GATE + ((size_t)u.pm * 8 + ((pn - 20) & 7)) * GT_TILE + lo16;
#pragma unroll
            for (int ai = 0; ai < 2; ++ai)
#pragma unroll
                for (int m = 0; m < 4; ++m) { u32x4 w;
#pragma unroll
                    for (int bj = 0; bj < 2; ++bj) { const f32x4 v0 = acc[ai][bj][m][0] * 0.015625f, v1 = acc[ai][bj][m][1] * 0.015625f; f32x4 s0, s1;
#pragma unroll
                        for (int j = 0; j < 4; ++j) { s0[j] = sigm(v0[j]); s1[j] = sigm(v1[j]); }
                        w[2 * bj] = q8x4(s0); w[2 * bj + 1] = q8x4(s1); }
                    *(u32x4*)(gp + (ai * 4 + m) * 1024) = w; }
            return;
        }
#pragma unroll
        for (int ai = 0; ai < 2; ++ai)
#pragma unroll
            for (int m = 0; m < 4; ++m) { bf16_t* rowp = O + (size_t)(row0 + ai * HALF + m * 16) * ZP + col0;
#pragma unroll
                for (int bj = 0; bj < 2; ++bj) { f32x4 v0 = acc[ai][bj][m][0], v1 = acc[ai][bj][m][1];
                    if (hn && !(pn == 2 && bj == 1)) { const float r = rsqrtf((float)ss[(ai * HALF + m * 16 + lr) * 2 + bj] * (0.015625f * 0.015625f / 128.0f / 1048576.0f) + 1e-6f) * 0.015625f;
                        v0 = v0 * r * gn0; v1 = v1 * r * gn1; }
                    else if (PN_OFF == 0) { v0 = v0 * 0.015625f; v1 = v1 * 0.015625f; }
                    if (act) {
#pragma unroll
                        for (int j = 0; j < 4; ++j) { v0[j] *= sigm(v0[j]); v1[j] *= sigm(v1[j]); } }
                    u32x4 w; w.x = cvt_pk_bf16(v0[0], v0[1]); w.y = cvt_pk_bf16(v0[2], v0[3]); w.z = cvt_pk_bf16(v1[0], v1[1]); w.w = cvt_pk_bf16(v1[2], v1[3]);
                    *(u32x4*)(rowp + bj * HALF) = w; } }
        if (hn) { asm volatile("s_waitcnt lgkmcnt(0)" ::: "memory"); __builtin_amdgcn_s_barrier(); asm volatile("" ::: "memory");
            ss[(wr * 4 + wc) * 64 + fq * 16 + fr] = 0ull; }
    }
};
template <int MODE = 0> struct EpiMergeT {
    static constexpr bool PERM = true, AFTER_DRAIN = false, CHAIN = true;
    const unsigned char* GT; bf16_t* O;
    __device__ __forceinline__ void operator()(f32x4 (&acc)[2][2][4][2], const Unit& u, int wr, int wc, int fr, int fq) const {
        if (MODE == 2) return;
        const int row0 = u.pm * BM + wr * 64 + fr, col0 = u.pn * BM + wc * 32 + 8 * fq;
        int lo16 = (wr * 4 + wc) * 8192 + (fq * 16 + fr) * 16; asm volatile("" : "+v"(lo16));
        const unsigned char* gp = GT + ((size_t)u.pm * 8 + u.pn) * GT_TILE + lo16;
        const size_t cn = (size_t)u.seg * GT_GATE, cd = (size_t)(u.seg == 0 ? 1 : 2) * GT_GATE;
        const bool fin = u.seg == 2;
        u32x4 gn[2][4], gd[2][4];
#pragma unroll
        for (int ai = 0; ai < 2; ++ai)
#pragma unroll
            for (int m = 0; m < 4; ++m) {
                if (MODE == 1) { gn[ai][m] = (u32x4){0x80808080u + (unsigned)u.pm, 0x80808080u, 0x80808080u, 0x80808080u}; gd[ai][m] = gn[ai][m]; } else {
                gn[ai][m] = *(const u32x4*)(gp + cn + (ai * 4 + m) * 1024); gd[ai][m] = *(const u32x4*)(gp + cd + (ai * 4 + m) * 1024); } }
#pragma unroll
        for (int ai = 0; ai < 2; ++ai)
#pragma unroll
            for (int m = 0; m < 4; ++m)
#pragma unroll
                for (int bj = 0; bj < 2; ++bj) { const size_t r = (size_t)(row0 + ai * HALF + m * 16);
#pragma unroll
                    for (int w = 0; w < 2; ++w)
#pragma unroll
                        for (int k = 0; k < 4; ++k) { const float qn = (float)((gn[ai][m][2 * bj + w] >> (8 * k)) & 0xffu) + 0.5f, qd = (float)((gd[ai][m][2 * bj + w] >> (8 * k)) & 0xffu) + 0.5f;
                            acc[ai][bj][m][w][k] *= qn * __builtin_amdgcn_rcpf(fin ? 256.0f : qd); }
                    if (fin) { const f32x4 v0 = acc[ai][bj][m][0], v1 = acc[ai][bj][m][1];
                        u32x4 w; w.x = cvt_pk_bf16(v0[0], v0[1]); w.y = cvt_pk_bf16(v0[2], v0[3]); w.z = cvt_pk_bf16(v1[0], v1[1]); w.w = cvt_pk_bf16(v1[2], v1[3]);
                        *(u32x4*)(O + r * 2048 + col0 + bj * HALF) = w; } }
    }
};
typedef EpiMergeT<0> EpiMerge;
struct EpiResid {
    static constexpr int PERM = 2; static constexpr bool AFTER_DRAIN = false, CHAIN = false;
    bf16_t* hb; unsigned char* xu; const float* gain; PG8_LAS unsigned char* stg;
    __device__ __forceinline__ void operator()(const f32x4 (&acc)[2][2][4][2], const Unit& u, int wr, int wc, int fr, int fq) const {
        int lane = fq * 16 + fr; asm volatile("" : "+v"(lane));
        PG8_LAS unsigned char* s0 = stg + (wr * 4 + wc) * 1024;
        const int r8 = lane >> 3, pc = lane & 7;
        const int offc = r8 * 128 + ((pc ^ r8) << 4);
        const int offa0 = (fr >> 3) * 8192 + (fr & 7) * 128 + ((fq ^ (fr & 7)) << 4), offa1 = (fr >> 3) * 8192 + (fr & 7) * 128 + (((4 + fq) ^ (fr & 7)) << 4);
        const int xs = 2 * (fr >> 2), offxw0 = fr * 64 + ((fq ^ xs) << 3), offxw1 = fr * 64 + (((4 + fq) ^ xs) << 3);
        const int xr = lane >> 2, xq = lane & 3, offxr = xr * 64 + (((2 * xq) ^ (2 * (xr >> 2))) << 3);
        const size_t goff = (size_t)(u.pm * BM + wr * 64 + r8) * 2048 + u.pn * BM + wc * 64 + pc * 8;
        const size_t xoff = (size_t)(u.pm * BM + wr * 64 + xr) * 2048 + u.pn * BM + wc * 64 + xq * 16;
        f32x4 gv[2][2];
#pragma unroll
        for (int bj = 0; bj < 2; ++bj)
#pragma unroll
            for (int n = 0; n < 2; ++n) gv[bj][n] = *(const f32x4*)(gain + u.pn * BM + wc * 64 + bj * 32 + 8 * fq + 4 * n);
        const f32x4 lo4 = (f32x4){-440.f, -440.f, -440.f, -440.f}, hi4 = (f32x4){440.f, 440.f, 440.f, 440.f};
#pragma unroll
        for (int ai = 0; ai < 2; ++ai) {
            u32x4 bb[4][2];
#pragma unroll
            for (int m = 0; m < 4; ++m)
#pragma unroll
                for (int j = 0; j < 2; ++j) bb[m][j] = *(const u32x4*)(hb + goff + (size_t)(ai * HALF + m * 16 + 8 * j) * 2048);
#pragma unroll
            for (int m = 0; m < 4; ++m) {
                *(PG8_LAS u32x4*)(s0 + offc) = bb[m][0]; *(PG8_LAS u32x4*)(s0 + 8192 + offc) = bb[m][1];
                asm volatile("" ::: "memory");
                const u32x4 a0 = *(const PG8_LAS u32x4*)(s0 + offa0), a1 = *(const PG8_LAS u32x4*)(s0 + offa1);
                asm volatile("" ::: "memory");
                u32x2 xw[2];
#pragma unroll
                for (int bj = 0; bj < 2; ++bj) { const u32x4 w = bj ? a1 : a0;
                    const f32x4 h0 = (f32x4){bflo(w.x), bfhi(w.x), bflo(w.y), bfhi(w.y)} + acc[ai][bj][m][0], h1 = (f32x4){bflo(w.z), bfhi(w.z), bflo(w.w), bfhi(w.w)} + acc[ai][bj][m][1];
                    u32x4 hw; hw.x = cvt_pk_bf16(h0[0], h0[1]); hw.y = cvt_pk_bf16(h0[2], h0[3]); hw.z = cvt_pk_bf16(h1[0], h1[1]); hw.w = cvt_pk_bf16(h1[2], h1[3]);
                    *(PG8_LAS u32x4*)(s0 + (bj ? offa1 : offa0)) = hw;
                    const f32x4 x0 = __builtin_elementwise_min(__builtin_elementwise_max(h0 * gv[bj][0], lo4), hi4), x1 = __builtin_elementwise_min(__builtin_elementwise_max(h1 * gv[bj][1], lo4), hi4);
                    int w0 = 0, w1 = 0;
                    w0 = __builtin_amdgcn_cvt_pk_fp8_f32(x0[0], x0[1], w0, false); w0 = __builtin_amdgcn_cvt_pk_fp8_f32(x0[2], x0[3], w0, true);
                    w1 = __builtin_amdgcn_cvt_pk_fp8_f32(x1[0], x1[1], w1, false); w1 = __builtin_amdgcn_cvt_pk_fp8_f32(x1[2], x1[3], w1, true);
                    xw[bj] = (u32x2){(unsigned)w0, (unsigned)w1}; }
                asm volatile("" ::: "memory");
                const u32x4 o0 = *(const PG8_LAS u32x4*)(s0 + offc), o1 = *(const PG8_LAS u32x4*)(s0 + 8192 + offc);
                asm volatile("" ::: "memory");
                *(PG8_LAS u32x2*)(s0 + offxw0) = xw[0]; *(PG8_LAS u32x2*)(s0 + offxw1) = xw[1];
                asm volatile("" ::: "memory");
                const u32x4 xo = *(const PG8_LAS u32x4*)(s0 + offxr);
                asm volatile("" ::: "memory");
                *(u32x4*)(hb + goff + (size_t)(ai * HALF + m * 16) * 2048) = o0; *(u32x4*)(hb + goff + (size_t)(ai * HALF + m * 16 + 8) * 2048) = o1;
                *(u32x4*)(xu + xoff + (size_t)(ai * HALF + m * 16) * 2048) = xo;
            }
        }
        asm volatile("s_waitcnt lgkmcnt(0)" ::: "memory");
    }
};
struct EpiGlu {
    static constexpr bool PERM = false, AFTER_DRAIN = false, CHAIN = false;
    bf16_t* H; const PG8_LAS int* tile_exp; const PG8_LAS int* pst; const PG8_LAS int* cnt; const int* liste; const float* rstd;
    __device__ __forceinline__ void operator()(const f32x4 (&acc)[2][2][4][2], const Unit& u, int wr, int wc, int fr, int fq) const {
        const int row0 = u.pm * BM + wr * 64 + fr, pj = u.pn & 3;
        const int e = tile_exp[u.pm], lr0 = u.pm * 256 - pst[e] + wr * 64 + fr, ce = cnt[e];
        int tok[2][4]; float rs[2][4];
#pragma unroll
        for (int ai = 0; ai < 2; ++ai)
#pragma unroll
            for (int m = 0; m < 4; ++m) { const int lr = lr0 + ai * HALF + m * 16; tok[ai][m] = lr < ce ? liste[(size_t)e * 32768 + lr] : 0; }
#pragma unroll
        for (int ai = 0; ai < 2; ++ai)
#pragma unroll
            for (int m = 0; m < 4; ++m) rs[ai][m] = rstd[tok[ai][m]] * 0.015625f;
#pragma unroll
        for (int ai = 0; ai < 2; ++ai)
#pragma unroll
            for (int m = 0; m < 4; ++m) { unsigned char* rowp = (unsigned char*)H + (size_t)(row0 + ai * HALF + m * 16) * 512; const float r = rs[ai][m];
#pragma unroll
                for (int bj = 0; bj < 2; ++bj) { const f32x4 a = acc[ai][bj][m][0] * r, b = acc[ai][bj][m][1] * r;
                    const int hc = 16 * (8 * pj + 4 * bj + wc) + 4 * fq;
                    float hv[4];
#pragma unroll
                    for (int j = 0; j < 4; ++j) hv[j] = fminf(fmaxf(a[j] * sigm(a[j]) * b[j] * 8.0f, -440.0f), 440.0f);
                    int w = 0; w = __builtin_amdgcn_cvt_pk_fp8_f32(hv[0], hv[1], w, false); w = __builtin_amdgcn_cvt_pk_fp8_f32(hv[2], hv[3], w, true);
                    *(int*)(rowp + hc) = w; } }
    }
};
struct EpiY {
    static constexpr bool PERM = true, AFTER_DRAIN = false, CHAIN = false;
    unsigned char* Y;
    __device__ __forceinline__ void operator()(const f32x4 (&acc)[2][2][4][2], const Unit& u, int wr, int wc, int fr, int fq) const {
        const int row0 = u.pm * BM + wr * 64 + fr, col0 = (u.pn & 7) * BM + wc * 32 + 8 * fq;
        const f32x4 lo4 = (f32x4){-440.f, -440.f, -440.f, -440.f}, hi4 = (f32x4){440.f, 440.f, 440.f, 440.f};
#pragma unroll
        for (int ai = 0; ai < 2; ++ai)
#pragma unroll
            for (int m = 0; m < 4; ++m) { unsigned char* rowp = Y + (size_t)(row0 + ai * HALF + m * 16) * 2048 + col0;
#pragma unroll
                for (int bj = 0; bj < 2; ++bj) {
                    const f32x4 v0 = __builtin_elementwise_min(__builtin_elementwise_max(acc[ai][bj][m][0] * 0.125f, lo4), hi4), v1 = __builtin_elementwise_min(__builtin_elementwise_max(acc[ai][bj][m][1] * 0.125f, lo4), hi4);
                    int w0 = 0, w1 = 0;
                    w0 = __builtin_amdgcn_cvt_pk_fp8_f32(v0[0], v0[1], w0, false); w0 = __builtin_amdgcn_cvt_pk_fp8_f32(v0[2], v0[3], w0, true);
                    w1 = __builtin_amdgcn_cvt_pk_fp8_f32(v1[0], v1[1], w1, false); w1 = __builtin_amdgcn_cvt_pk_fp8_f32(v1[2], v1[3], w1, true);
                    *(u32x2*)(rowp + bj * HALF) = (u32x2){(unsigned)w0, (unsigned)w1}; } }
    }
};

typedef int v4i_t __attribute__((ext_vector_type(4)));
typedef int v8i_t __attribute__((ext_vector_type(8)));
template <class Epi, class Sched, bool ALIGN_EPI = false, bool FP8 = false>
__device__ __forceinline__ void gemm_phase(PG8_LAS unsigned char* lds, const Gemm g, const Sched& S, const Epi& E) {
    int tid = threadIdx.x; asm volatile("" : "+v"(tid));
    const int wid = __builtin_amdgcn_readfirstlane(tid >> 6), lane = tid & 63, wr = wid >> 2, wc = wid & 3, fr = lane & 15, fq = lane >> 4;
    const int K = g.K;
    unsigned voffA[2], voffB[2]; int RA[2]; unsigned CA2[2];
#pragma unroll
    for (int i = 0; i < 2; ++i) { int R, C; stage_rc(tid * 16 + i * 8192, R, C); const int Rb = Epi::PERM == 2 ? ((R >> 5) * 64 + perm32(R & 31)) : (Epi::PERM ? ((R & ~31) + perm32(R & 31)) : R);
        voffA[i] = (unsigned)(R * K + C) * 2u; voffB[i] = (unsigned)(Rb * K + C) * 2u; RA[i] = R; CA2[i] = (unsigned)C * 2u; }
    unsigned gAc[2][2], gAn[2][2];
#define PG8_GOFF(dst, uu) do { _Pragma("unroll") for (int h_ = 0; h_ < 2; ++h_) _Pragma("unroll") for (int i_ = 0; i_ < 2; ++i_) dst[h_][i_] = (unsigned)S.row_token(uu, 128 * h_ + RA[i_]) * (unsigned)(K * 2) + CA2[i_]; } while (0)
#define PG8_STAGE_A(bufoff, gbase, half, garr) do { if constexpr (Sched::GATHER) PG8_STAGE(bufoff, gbase, garr); else PG8_STAGE(bufoff, (gbase) + (half) * hstep, voffA); } while (0)
    const size_t kstep = (size_t)(BK * 2);
    const size_t hstep = (size_t)HALF * K * 2;
    const size_t hstepB = Epi::PERM == 2 ? (size_t)32 * K * 2 : hstep;
    const size_t tstep = 2 * hstep;
    const unsigned ldsw = (unsigned)wid * 1024u;
    const int aoff = lds_byte(wr * 64 + fr, fq * 8), boff = lds_byte(wc * 32 + fr, fq * 8);
#define PG8_SA(b, h) (((b) * 2 + (h)) * HTB)
#define PG8_SB(b, h) ((4 + (b) * 2 + (h)) * HTB)
#define PG8_STAGE(bufoff, gbase, voff) do { _Pragma("unroll") for (int _i = 0; _i < 2; ++_i) \
        __builtin_amdgcn_global_load_lds((const unsigned*)((const char*)(gbase) + (voff)[_i]), (PG8_LAS unsigned*)(lds + (bufoff) + ldsw + _i * 8192), 16, 0, 0); } while (0)
#define PG8_LDA(dst, b, h) do { if constexpr (FP8) { _Pragma("unroll") for (int m = 0; m < 4; ++m) dst##8[m] = __builtin_shufflevector(*(const PG8_LAS v4i_t*)(lds + PG8_SA(b, h) + aoff + m * 2048), *(const PG8_LAS v4i_t*)(lds + PG8_SA(b, h) + aoff + m * 2048 + 1024), 0, 1, 2, 3, 4, 5, 6, 7); } \
        else { _Pragma("unroll") for (int m = 0; m < 4; ++m) _Pragma("unroll") for (int k = 0; k < 2; ++k) dst[m][k] = *(const PG8_LAS bf16x8*)(lds + PG8_SA(b, h) + aoff + m * 2048 + k * 1024); } } while (0)
#define PG8_LDB(dst, b, h) do { if constexpr (FP8) { _Pragma("unroll") for (int n = 0; n < 2; ++n) dst##8[n] = __builtin_shufflevector(*(const PG8_LAS v4i_t*)(lds + PG8_SB(b, h) + boff + n * 2048), *(const PG8_LAS v4i_t*)(lds + PG8_SB(b, h) + boff + n * 2048 + 1024), 0, 1, 2, 3, 4, 5, 6, 7); } \
        else { _Pragma("unroll") for (int n = 0; n < 2; ++n) _Pragma("unroll") for (int k = 0; k < 2; ++k) dst[n][k] = *(const PG8_LAS bf16x8*)(lds + PG8_SB(b, h) + boff + n * 2048 + k * 1024); } } while (0)
#define PG8_MMA(ai, bj, At, Bt) do { __builtin_amdgcn_s_setprio(1); _Pragma("unroll") for (int m = 0; m < 4; ++m) _Pragma("unroll") for (int n = 0; n < 2; ++n) { \
        if constexpr (FP8) asm volatile("v_mfma_f32_16x16x128_f8f6f4 %0, %1, %2, %0" : "+v"(acc[ai][bj][m][n]) : "v"(Bt##8[n]), "v"(At##8[m])); \
        else { _Pragma("unroll") for (int k = 0; k < 2; ++k) acc[ai][bj][m][n] = __builtin_amdgcn_mfma_f32_16x16x32_bf16(Bt[n][k], At[m][k], acc[ai][bj][m][n], 0, 0, 0); } } \
        __builtin_amdgcn_s_setprio(0); } while (0)
#define PG8_WAIT_V(n) asm volatile("s_waitcnt vmcnt(" #n ")" ::: "memory")
#define PG8_WAIT_L(n) asm volatile("s_waitcnt lgkmcnt(" #n ")" ::: "memory")
#define PG8_BAR __builtin_amdgcn_s_barrier()
#define PG8_SCHED __builtin_amdgcn_sched_barrier(0)
    Unit cur, nxt; int ui = 0;
    if (!S.next(0, cur)) return;
    f32x4 acc[2][2][4][2];
#pragma unroll
    for (int a = 0; a < 2; ++a)
#pragma unroll
        for (int b = 0; b < 2; ++b)
#pragma unroll
            for (int m = 0; m < 4; ++m)
#pragma unroll
                for (int n = 0; n < 2; ++n) acc[a][b][m][n] = (f32x4){0.f, 0.f, 0.f, 0.f};
    bf16x8 At[4][2], B0[2][2], B1[2][2]; v8i_t At8[4], B08[2], B18[2];
    const size_t tstepA = Sched::GATHER ? (size_t)0 : tstep;
    const char* cA = (const char*)g.A + (size_t)cur.pm * tstepA + (size_t)cur.koff * 2; const char* cB = (const char*)g.Bt + (size_t)cur.pn * tstep + (size_t)cur.koff * 2;
    S.a_ready(cur);
    if constexpr (Sched::GATHER) { PG8_GOFF(gAc, cur); }
    PG8_STAGE(PG8_SB(0, 0), cB, voffB); PG8_STAGE(PG8_SB(0, 1), cB + hstepB, voffB); PG8_STAGE_A(PG8_SA(0, 0), cA, 0, gAc[0]); PG8_STAGE_A(PG8_SA(0, 1), cA, 1, gAc[1]);
    if (wr == 1) PG8_BAR;
    PG8_WAIT_V(2); PG8_BAR;
    PG8_STAGE(PG8_SB(1, 0), cB + kstep, voffB); PG8_STAGE_A(PG8_SA(1, 0), cA + kstep, 0, gAc[0]); PG8_STAGE(PG8_SB(1, 1), cB + hstepB + kstep, voffB);
    PG8_WAIT_V(6); PG8_BAR;
    for (;;) {
        const bool has_next = S.next(ui + 1, nxt);
        const char* nA = has_next ? (const char*)g.A + (size_t)nxt.pm * tstepA + (size_t)nxt.koff * 2 : cA; const char* nB = has_next ? (const char*)g.Bt + (size_t)nxt.pn * tstep + (size_t)nxt.koff * 2 : cB;
        if constexpr (Sched::GATHER) { if (has_next) { PG8_GOFF(gAn, nxt); } else {
#pragma unroll
            for (int h_ = 0; h_ < 2; ++h_)
#pragma unroll
                for (int i_ = 0; i_ < 2; ++i_) gAn[h_][i_] = gAc[h_][i_]; } }
        const int nt = cur.nt;
        for (int t = 0; t < nt; t += 2) {
            const bool last = (t == nt - 2);
            const char* a1 = cA + (size_t)(t + 1) * kstep;
            const char* a2 = last ? nA : cA + (size_t)(t + 2) * kstep; const char* b2 = last ? nB : cB + (size_t)(t + 2) * kstep;
            const char* a3 = a2 + kstep; const char* b3 = b2 + kstep;
            if (last && has_next) S.a_ready(nxt);
            unsigned g2a[2][2];
            if constexpr (Sched::GATHER) {
#pragma unroll
                for (int h_ = 0; h_ < 2; ++h_)
#pragma unroll
                    for (int i_ = 0; i_ < 2; ++i_) g2a[h_][i_] = last ? gAn[h_][i_] : gAc[h_][i_]; }
            PG8_LDB(B0, 0, 0); PG8_LDB(B1, 0, 1); PG8_SCHED; PG8_LDA(At, 0, 0); PG8_STAGE_A(PG8_SA(1, 1), a1, 1, gAc[1]);
            PG8_WAIT_V(8); PG8_WAIT_L(0); PG8_BAR; PG8_MMA(0, 0, At, B0); PG8_MMA(0, 1, At, B1); PG8_BAR; PG8_SCHED;
            PG8_LDA(At, 0, 1); PG8_STAGE(PG8_SB(0, 0), b2, voffB); PG8_STAGE(PG8_SB(0, 1), b2 + hstepB, voffB); PG8_STAGE_A(PG8_SA(0, 0), a2, 0, g2a[0]);
            PG8_WAIT_V(8); PG8_WAIT_L(0); PG8_BAR; PG8_MMA(1, 0, At, B0); PG8_MMA(1, 1, At, B1); PG8_BAR; PG8_SCHED;
            PG8_LDB(B0, 1, 0); PG8_LDB(B1, 1, 1); PG8_SCHED; PG8_LDA(At, 1, 0); PG8_STAGE_A(PG8_SA(0, 1), a2, 1, g2a[1]);
            PG8_WAIT_V(8); PG8_WAIT_L(0); PG8_BAR; PG8_MMA(0, 0, At, B0); PG8_MMA(0, 1, At, B1); PG8_BAR; PG8_SCHED;
            PG8_LDA(At, 1, 1); PG8_STAGE(PG8_SB(1, 0), b3, voffB); PG8_STAGE(PG8_SB(1, 1), b3 + hstepB, voffB); PG8_STAGE_A(PG8_SA(1, 0), a3, 0, g2a[0]);
            PG8_WAIT_V(8); PG8_WAIT_L(0); PG8_BAR; PG8_MMA(1, 0, At, B0); PG8_MMA(1, 1, At, B1); PG8_BAR; PG8_SCHED;
        }
        if constexpr (ALIGN_EPI) { if (wr == 0) PG8_BAR; }
        if constexpr (FP8) asm volatile("s_nop 15\n\ts_nop 15\n\ts_nop 15\n\ts_nop 15" ::: "memory");
        E(acc, cur, wr, wc, fr, fq); S.done(cur);
        if (!has_next) break;
        if (!Epi::CHAIN || cur.seg == 2)
#pragma unroll
        for (int a = 0; a < 2; ++a)
#pragma unroll
            for (int b = 0; b < 2; ++b)
#pragma unroll
                for (int m = 0; m < 4; ++m)
#pragma unroll
                    for (int n = 0; n < 2; ++n) acc[a][b][m][n] = (f32x4){0.f, 0.f, 0.f, 0.f};
        cur = nxt; cA = nA; cB = nB; ++ui;
        if constexpr (Sched::GATHER) {
#pragma unroll
            for (int h_ = 0; h_ < 2; ++h_)
#pragma unroll
                for (int i_ = 0; i_ < 2; ++i_) gAc[h_][i_] = gAn[h_][i_]; }
        if constexpr (ALIGN_EPI) { if (wr == 1) PG8_BAR; }
    }
    PG8_WAIT_V(0);
    if constexpr (!ALIGN_EPI) { if (wr == 0) PG8_BAR; }
    PG8_BAR;
#undef PG8_SA
#undef PG8_SB
#undef PG8_STAGE_A
#undef PG8_GOFF
#undef PG8_STAGE
#undef PG8_LDA
#undef PG8_LDB
#undef PG8_MMA
#undef PG8_WAIT_V
#undef PG8_WAIT_L
#undef PG8_BAR
#undef PG8_SCHED
}
}

constexpr int NWAVES = 8;
constexpr int T = 32768, SEQ = 2048, NB = 16, D = 2048, DEPTH = 2;
constexpr int ZP = pg8::ZP;
constexpr int ZC_AQ = 0, ZC_AK = 512, ZC_AV = 640, ZC_BQ = 768, ZC_BK = 1792, ZC_BV = 2048, ZC_IQ = 2304, ZC_IK = 3328, ZC_IW = 3392, ZC_CG = 3408, ZC_PAD = 3424, ZC_CQ = 3584, ZC_CK = 3840, ZC_CV = 4096, ZC_CR = 4608;
constexpr int D_IN = 11104;
constexpr int NEXP = 64, DEXP = 512, PMAX_TILES = 320;
constexpr float EPS = 1e-6f;

constexpr size_t MiB = 1u << 20;
constexpr size_t WS_CTL = 0, CTL_ZERO_BYTES = 1 * MiB;
constexpr size_t WS_ROUTE = 2 * MiB;
constexpr size_t WS_WRH = 4 * MiB, WS_WRL = 6 * MiB, WR_L = 96 * 2048 * 2;
constexpr size_t WS_WIN = 16 * MiB, WIN_L = 44 * MiB;
constexpr size_t WS_WBR = 104 * MiB, WBR_L = 8 * MiB;
constexpr size_t WS_WO = 120 * MiB, WO_L = 8 * MiB;
constexpr size_t WS_W13 = 136 * MiB;
constexpr size_t WS_HB = 264 * MiB;
constexpr size_t WS_W2 = 392 * MiB;
constexpr size_t WS_XN = 520 * MiB;
constexpr size_t WS_OCAT = 648 * MiB;
constexpr size_t WS_MERGED = 776 * MiB;
constexpr size_t WS_Z = 904 * MiB;
constexpr size_t WS_GT = 1224 * MiB;
constexpr size_t WS_S = 1608 * MiB;
constexpr size_t WS_MASK = 1864 * MiB;
constexpr size_t WS_GO = 1872 * MiB;
constexpr size_t WS_GCS = WS_GO;
constexpr size_t WS_GDEC = 8 * MiB;
constexpr size_t WS_RSTD = 9 * MiB;
constexpr size_t WS_LISTE = 904 * MiB;
constexpr size_t WS_XS = 904 * MiB;
constexpr size_t WS_Y = 1224 * MiB;
constexpr size_t WS_H = 1544 * MiB;
constexpr size_t WS_WG8 = 1936 * MiB, WG8_L = 12 * MiB;
constexpr size_t WS_XN8 = WS_S;
constexpr size_t WS_END = 1936 * MiB;
constexpr int CW_BAR = 4096;
constexpr int CW_CNT = 16384;

constexpr int RING_BYTES = 131072, MISC_OFF = RING_BYTES, LDS_BYTES = 155648;
constexpr int MO_BARW = 32, MO_GN = 256, MO_TEXP = 8192, MO_PST = 9728, MO_TOT = 9984, MO_TAB2 = 10240, MO_CNT = 16640, MO_SS = 16896;

#define GAS __attribute__((address_space(1)))
#define LAS __attribute__((address_space(3)))
typedef unsigned short bf16;
typedef unsigned v4u __attribute__((ext_vector_type(4)));
typedef unsigned v2u __attribute__((ext_vector_type(2)));
typedef float f32x4 __attribute__((ext_vector_type(4)));
#define LDS_WAIT() asm volatile("s_waitcnt lgkmcnt(0)" ::: "memory")
__device__ __forceinline__ unsigned f2bf(float f) { unsigned u = __builtin_bit_cast(unsigned, f); return (u + 0x7fffu + ((u >> 16) & 1u)) >> 16; }
__device__ __forceinline__ unsigned pk2(float lo, float hi) { return f2bf(lo) | (f2bf(hi) << 16); }
__device__ __forceinline__ float bflo(unsigned w) { return __uint_as_float(w << 16); }
__device__ __forceinline__ float bfhi(unsigned w) { return __uint_as_float(w & 0xffff0000u); }
__device__ __forceinline__ float bf1(bf16 h) { return __uint_as_float(((unsigned)h) << 16); }

#define XB_TMO      128
#define XB_XCNT(j)  (256  + 64 * (j))
#define XB_XSUB(j)  (1280 + 64 * (j))
#define XB_XGEN(j)  (2304 + 64 * (j))
#define XB_TOP      3328
#define XB_TOPGEN   3392
#define XCD_BAR_WORDS 3456
#define XB_SPIN_CAP (1u << 18)
__device__ __forceinline__ unsigned xb_ld(unsigned* p)              { return __hip_atomic_load(p, __ATOMIC_RELAXED, __HIP_MEMORY_SCOPE_AGENT); }
__device__ __forceinline__ unsigned xb_add(unsigned* p, unsigned v) { return __hip_atomic_fetch_add(p, v, __ATOMIC_RELAXED, __HIP_MEMORY_SCOPE_AGENT); }
__device__ __forceinline__ unsigned xb_xcc_id() { return (unsigned)__builtin_amdgcn_s_getreg((3 << 11) | 20) & 0xFu; }
#define XB_SPIN(cond, bar) do { unsigned _sp = 0; while (cond) { __builtin_amdgcn_s_sleep(1); \
    if ((++_sp & 255u) == 0u) { if (xb_ld(&(bar)[XB_TMO])) break; if (_sp > XB_SPIN_CAP) { atomicAdd(&(bar)[XB_TMO], 1u); break; } } } } while (0)
struct XcdBarrier { unsigned* bar; unsigned x; volatile LAS unsigned* st; };
__device__ __forceinline__ XcdBarrier xcd_barrier_post(unsigned* bar, volatile LAS unsigned* st) {
    XcdBarrier b; b.bar = bar; b.x = xb_xcc_id(); b.st = st;
    if (threadIdx.x == 0) (void)xb_add(&bar[XB_XCNT(b.x)], 1u);
    return b;
}
__device__ __forceinline__ void xcd_barrier_complete(unsigned* bar, unsigned x, unsigned& nloc, unsigned& nx) {
    const unsigned G = gridDim.x * gridDim.y * gridDim.z;
    unsigned sum, cnt, mine, sp = 0u;
    for (;;) {
        sum = 0u; cnt = 0u; mine = 0u;
#pragma unroll
        for (unsigned j = 0; j < 16; ++j) { const unsigned c = xb_ld(&bar[XB_XCNT(j)]); sum += c; cnt += (c > 0u) ? 1u : 0u; mine = (j == x) ? c : mine; }
        if (sum == G) break;
        __builtin_amdgcn_s_sleep(1);
        if ((++sp & 255u) == 0u) { if (xb_ld(&bar[XB_TMO])) break; if (sp > XB_SPIN_CAP) { atomicAdd(&bar[XB_TMO], 1u); break; } }
    }
    nloc = mine > 0u ? mine : 1u; nx = cnt > 0u ? cnt : 1u;
}
__device__ __forceinline__ void xcd_barrier(const XcdBarrier& b) {
    asm volatile("s_waitcnt vmcnt(0)" ::: "memory");
    __syncthreads();
    if (threadIdx.x == 0) {
        unsigned* bar = b.bar;
        __builtin_amdgcn_s_waitcnt(0);
        unsigned nloc = b.st[0], nx = b.st[1];
        if (nloc == 0u) { xcd_barrier_complete(bar, b.x, nloc, nx); b.st[0] = nloc; b.st[1] = nx; }
        const unsigned old = xb_add(&bar[XB_XSUB(b.x)], 1u);
        const unsigned gen = old / nloc;
        if (old + 1u == (gen + 1u) * nloc) {
            __builtin_amdgcn_fence(__ATOMIC_RELEASE, "agent");
            asm volatile("s_waitcnt vmcnt(0)" ::: "memory");
            const unsigned og = xb_add(&bar[XB_TOP], 1u);
            const unsigned tg = og / nx;
            if (og + 1u == (tg + 1u) * nx) xb_add(&bar[XB_TOPGEN], 1u);
            else XB_SPIN(xb_ld(&bar[XB_TOPGEN]) == tg, bar);
            __builtin_amdgcn_fence(__ATOMIC_ACQUIRE, "agent");
            xb_add(&bar[XB_XGEN(b.x)], 1u);
            asm volatile("s_waitcnt vmcnt(0)" ::: "memory");
        } else {
            XB_SPIN(xb_ld(&bar[XB_XGEN(b.x)]) == gen, bar);
            __builtin_amdgcn_fence(__ATOMIC_ACQUIRE, "agent");
            asm volatile("s_waitcnt vmcnt(0)" ::: "memory");
        }
    }
    __syncthreads();
}

struct Args { const float* in[24]; float* out; unsigned char* ws; int ph_lo, ph_hi; };
enum { I_X = 0, I_RELB, I_N1G, I_WIN, I_AQG, I_AKG, I_BQG, I_BKG, I_SINK, I_CGW, I_CGB, I_CNG, I_WBA, I_WBB, I_WBC, I_WO, I_N2G, I_WRG, I_BRG, I_WRE, I_BRE, I_W1, I_W3, I_W2 };

struct Frame {
    LAS unsigned char* lds; LAS unsigned char* misc;
    unsigned* ctl;
    int tid, lane, wave, vcu, G, gw, NGW;
    const float* const* in; float* out; unsigned char* ws;
    bf16 *Z, *XN, *OCAT, *MERGED, *XS, *Y, *H;
    float *S, *GO; unsigned* MASK;
};

__device__ __forceinline__ float wave_sum(float v) {
#pragma unroll
    for (int o = 1; o < 64; o <<= 1) v += __shfl_xor(v, o);
    return v;
}
__device__ __forceinline__ float wave_max(float v) {
#pragma unroll
    for (int o = 1; o < 64; o <<= 1) v = fmaxf(v, __shfl_xor(v, o));
    return v;
}

template <class MAP>
__device__ __forceinline__ void transpose_item(const float* W, int N, bf16* WT, int dpitch, int koff, LAS float* scr, int item, int lane, const MAP& map) {
    const int nblk = N / 32, kb = item / nblk, nb = item % nblk, k0 = 64 * kb, n0 = 32 * nb;
    f32x4 v[8];
#pragma unroll
    for (int i = 0; i < 8; ++i) v[i] = *(const f32x4*)(W + (size_t)(k0 + 8 * i + (lane >> 3)) * N + n0 + 4 * (lane & 7));
#pragma unroll
    for (int i = 0; i < 8; ++i) { LAS float* d = scr + (8 * i + (lane >> 3)) * 33 + 4 * (lane & 7); d[0] = v[i].x; d[1] = v[i].y; d[2] = v[i].z; d[3] = v[i].w; }
    LDS_WAIT(); asm volatile("" ::: "memory");
    const int c = lane & 7;
#pragma unroll
    for (int j = 0; j < 4; ++j) { const int n = (lane >> 3) + 8 * j; const LAS float* s = scr + (8 * c) * 33 + n;
        v4u o; o.x = pk2(s[0 * 33], s[1 * 33]); o.y = pk2(s[2 * 33], s[3 * 33]); o.z = pk2(s[4 * 33], s[5 * 33]); o.w = pk2(s[6 * 33], s[7 * 33]);
        const int dr_ = map(n0 + n); if (dr_ >= 0) *(v4u*)(WT + (size_t)dr_ * dpitch + koff + k0 + 8 * c) = o; }
    LDS_WAIT(); asm volatile("" ::: "memory");
}
__device__ __forceinline__ float clamp8(float v) { return fminf(fmaxf(v, -440.0f), 440.0f); }
template <class MAP>
__device__ __forceinline__ void transpose_item_fp8(const float* W, int N, unsigned char* WT, int dpitch, float scale, LAS float* scr, int item, int lane, const MAP& map) {
    const int nblk = N / 32, kb = item / nblk, nb = item % nblk, k0 = 64 * kb, n0 = 32 * nb;
    f32x4 v[8];
#pragma unroll
    for (int i = 0; i < 8; ++i) v[i] = *(const f32x4*)(W + (size_t)(k0 + 8 * i + (lane >> 3)) * N + n0 + 4 * (lane & 7));
#pragma unroll
    for (int i = 0; i < 8; ++i) { LAS float* d = scr + (8 * i + (lane >> 3)) * 33 + 4 * (lane & 7); d[0] = v[i].x; d[1] = v[i].y; d[2] = v[i].z; d[3] = v[i].w; }
    LDS_WAIT(); asm volatile("" ::: "memory");
    const int c = lane & 7;
#pragma unroll
    for (int j = 0; j < 4; ++j) { const int n = (lane >> 3) + 8 * j; const LAS float* s = scr + (8 * c) * 33 + n;
        int w0 = 0, w1 = 0;
        w0 = __builtin_amdgcn_cvt_pk_fp8_f32(clamp8(s[0 * 33] * scale), clamp8(s[1 * 33] * scale), w0, false); w0 = __builtin_amdgcn_cvt_pk_fp8_f32(clamp8(s[2 * 33] * scale), clamp8(s[3 * 33] * scale), w0, true);
        w1 = __builtin_amdgcn_cvt_pk_fp8_f32(clamp8(s[4 * 33] * scale), clamp8(s[5 * 33] * scale), w1, false); w1 = __builtin_amdgcn_cvt_pk_fp8_f32(clamp8(s[6 * 33] * scale), clamp8(s[7 * 33] * scale), w1, true);
        const int dr_ = map(n0 + n); if (dr_ >= 0) *(v2u*)(WT + (size_t)dr_ * dpitch + k0 + 8 * c) = (v2u){(unsigned)w0, (unsigned)w1}; }
    LDS_WAIT(); asm volatile("" ::: "memory");
}
struct MapId { int off; __device__ __forceinline__ int operator()(int n) const { return off + n; } };
struct MapWin {
    __device__ __forceinline__ int operator()(int n) const {
        if (n < 512) return ZC_AQ + n;
        if (n < 640) return ZC_AK + (n - 512);
        if (n < 768) return ZC_AV + (n - 640);
        if (n < 1792) return ZC_IQ + (n - 768);
        if (n < 1856) return ZC_IK + (n - 1792);
        if (n < 1872) return ZC_IW + (n - 1856);
        if (n < 2896) return ZC_BQ + (n - 1872);
        if (n < 3152) return ZC_BK + (n - 2896);
        if (n < 3408) return ZC_BV + (n - 3152);
        if (n < 3664) return ZC_CQ + (n - 3408);
        if (n < 3920) return ZC_CK + (n - 3664);
        if (n < 4432) return ZC_CV + (n - 3920);
        if (n < 4448) return ZC_CG + (n - 4432);
        if (n < 4960) return ZC_CR + (n - 4448);
        return pg8::ZC_GA + (n - 4960);
    }
};
struct MapWin8 { __device__ __forceinline__ int operator()(int n) const { const int z = MapWin{}(n); return z < 3328 ? z : (z >= 4096 ? z - 768 : -1); } };
struct MapWinB { __device__ __forceinline__ int operator()(int n) const { const int z = MapWin{}(n); return (z >= 3328 && z < 4096) ? z - 3328 : -1; } };
struct MapW13 { int sel; __device__ __forceinline__ int operator()(int n) const { return 32 * (n >> 4) + 16 * sel + (n & 15); } };

__device__ __forceinline__ void load_row(const float* row, int lane, f32x4 (&v)[8]) {
    const f32x4* xr = (const f32x4*)row + lane;
#pragma unroll
    for (int j = 0; j < 8; ++j) v[j] = xr[64 * j];
}
__device__ __forceinline__ float row_rstd(const f32x4 (&v)[8]) {
    float s = 0.f;
#pragma unroll
    for (int j = 0; j < 8; ++j) s += (v[j].x * v[j].x + v[j].y * v[j].y) + (v[j].z * v[j].z + v[j].w * v[j].w);
    return rsqrtf(wave_sum(s) * (1.0f / 2048.0f) + EPS);
}
__device__ __forceinline__ void norm_store_bf16(const f32x4 (&v)[8], float rstd, const float* g, bf16* orow, int lane) {
    const f32x4* gr = (const f32x4*)g + lane; unsigned long long* o8 = (unsigned long long*)orow + lane;
#pragma unroll
    for (int j = 0; j < 8; ++j) { const f32x4 gg = gr[64 * j];
        o8[64 * j] = (unsigned long long)pk2(v[j].x * rstd * gg.x, v[j].y * rstd * gg.y) | ((unsigned long long)pk2(v[j].z * rstd * gg.z, v[j].w * rstd * gg.w) << 32); }
}

__device__ __forceinline__ void norm_store_fp8(const f32x4 (&v)[8], float rstd, const float* g, unsigned char* orow, int lane) {
    const f32x4* gr = (const f32x4*)g + lane; unsigned* o4 = (unsigned*)orow + lane;
#pragma unroll
    for (int j = 0; j < 8; ++j) { const f32x4 gg = gr[64 * j]; int w = 0;
        w = __builtin_amdgcn_cvt_pk_fp8_f32(clamp8(v[j].x * rstd * gg.x), clamp8(v[j].y * rstd * gg.y), w, false); w = __builtin_amdgcn_cvt_pk_fp8_f32(clamp8(v[j].z * rstd * gg.z), clamp8(v[j].w * rstd * gg.w), w, true);
        o4[64 * j] = (unsigned)w; }
}
__device__ __forceinline__ void convert_moe(Frame& F, int l, int part, int nparts, int lds_off) {
    LAS float* scr = (LAS float*)(F.lds + lds_off + F.wave * 8704);
    bf16* W13 = (bf16*)(F.ws + WS_W13); bf16* W2 = (bf16*)(F.ws + WS_W2);
    constexpr int I13 = (2048 / 64) * (512 / 32);
    constexpr int I2 = (512 / 64) * (2048 / 32);
    constexpr int NIT = NEXP * (2 * I13 + I2);
    const int it_lo = (int)((long)NIT * part / nparts), it_hi = (int)((long)NIT * (part + 1) / nparts);
    for (int it = it_lo + F.gw; it < it_hi; it += F.NGW) {
        const int e = it / (2 * I13 + I2); int r = it % (2 * I13 + I2);
        if (r < I13) { transpose_item_fp8(F.in[I_W1] + ((size_t)l * NEXP + e) * 2048 * 512, 512, (unsigned char*)W13 + (size_t)e * 1024 * 2048, 2048, 64.0f, scr, r, F.lane, MapW13{0}); continue; } r -= I13;
        if (r < I13) { transpose_item_fp8(F.in[I_W3] + ((size_t)l * NEXP + e) * 2048 * 512, 512, (unsigned char*)W13 + (size_t)e * 1024 * 2048, 2048, 64.0f, scr, r, F.lane, MapW13{1}); continue; } r -= I13;
        transpose_item_fp8(F.in[I_W2] + ((size_t)l * NEXP + e) * 512 * 2048, 2048, (unsigned char*)W2 + (size_t)e * 2048 * 512, 512, 32.0f, scr, r, F.lane, MapId{0});
    }
}

typedef short bf16x8_t __attribute__((ext_vector_type(8)));
typedef float f32x16 __attribute__((ext_vector_type(16)));
typedef short s16x4 __attribute__((ext_vector_type(4)));
__device__ __forceinline__ void indexer_segment(Frame& F, int b, int qb, int tlo, int thi) {
    const int lane = F.lane, n = lane & 15, kq = lane >> 4;
    const bf16* qrow = F.Z + (size_t)(b * 2048 + 16 * qb + n) * ZP;
    bf16x8_t iqf[16][2];
#pragma unroll
    for (int h = 0; h < 16; ++h)
#pragma unroll
        for (int ks = 0; ks < 2; ++ks) iqf[h][ks] = *(const bf16x8_t*)(qrow + ZC_IQ + h * 64 + 32 * ks + 8 * kq);
    float wv[16];
    { const v4u w0 = *(const v4u*)(qrow + ZC_IW), w1 = *(const v4u*)(qrow + ZC_IW + 8);
      wv[0] = bflo(w0.x); wv[1] = bfhi(w0.x); wv[2] = bflo(w0.y); wv[3] = bfhi(w0.y); wv[4] = bflo(w0.z); wv[5] = bfhi(w0.z); wv[6] = bflo(w0.w); wv[7] = bfhi(w0.w);
      wv[8] = bflo(w1.x); wv[9] = bfhi(w1.x); wv[10] = bflo(w1.y); wv[11] = bfhi(w1.y); wv[12] = bflo(w1.z); wv[13] = bfhi(w1.z); wv[14] = bflo(w1.w); wv[15] = bfhi(w1.w); }
    const bf16* kbase = F.Z + (size_t)(b * 2048 + n) * ZP + ZC_IK + 8 * kq;
    float* srow = F.S + (size_t)(b * 2048 + 16 * qb + n) * 2048 + 4 * kq;
    bf16x8_t ka[3], kb[3];
#pragma unroll
    for (int u = 0; u < 3; ++u) { const int tt = tlo + u < thi ? tlo + u : thi - 1; ka[u] = *(const bf16x8_t*)(kbase + (size_t)(16 * tt) * ZP); kb[u] = *(const bf16x8_t*)(kbase + (size_t)(16 * tt) * ZP + 32); }
#pragma unroll 1
    for (int tile = tlo; tile < thi; tile += 3) {
#pragma unroll
        for (int u = 0; u < 3; ++u) {
            const int tt = tile + u;
            if (tt < thi) {
                f32x4 sc = (f32x4){0.f, 0.f, 0.f, 0.f};
#pragma unroll
                for (int h = 0; h < 16; ++h) {
                    f32x4 c = __builtin_amdgcn_mfma_f32_16x16x32_bf16(ka[u], iqf[h][0], (f32x4){0.f, 0.f, 0.f, 0.f}, 0, 0, 0);
                    c = __builtin_amdgcn_mfma_f32_16x16x32_bf16(kb[u], iqf[h][1], c, 0, 0, 0);
                    sc[0] += wv[h] * fmaxf(c[0], 0.f); sc[1] += wv[h] * fmaxf(c[1], 0.f); sc[2] += wv[h] * fmaxf(c[2], 0.f); sc[3] += wv[h] * fmaxf(c[3], 0.f);
                }
                *(f32x4*)(srow + 16 * tt) = sc * 0.03125f;
            }
            { const int tn = tt + 3 < thi ? tt + 3 : thi - 1; ka[u] = *(const bf16x8_t*)(kbase + (size_t)(16 * tn) * ZP); kb[u] = *(const bf16x8_t*)(kbase + (size_t)(16 * tn) * ZP + 32); }
        }
    }
}

constexpr int FA_KP = 272, FA_VP = 320;
constexpr int FA_KOFF = 0, FA_VOFF = 2 * 64 * FA_KP, FA_BYTES = FA_VOFF + 2 * 64 * FA_VP;
__device__ __forceinline__ s16x4 fa_vtr(const LAS unsigned char* p) { return __builtin_bit_cast(s16x4, __builtin_amdgcn_ds_read_tr16_b64_v4i16((LAS s16x4*)p)); }
template <int MODE>
__device__ __forceinline__ void flash_unit(Frame& F, int l, int b, int g, int t0) {
    const int tid = F.tid, lane = F.lane, wave = F.wave, hh = wave & 3, qh = wave >> 2, r = lane & 31, hf = lane >> 5;
    const int qcol = (MODE == 0 ? ZC_AQ : ZC_BQ + 512 * g) + 128 * hh, kcol = MODE == 0 ? ZC_AK : ZC_BK + 128 * g, vcol = MODE == 0 ? ZC_AV : ZC_BV + 128 * g;
    const int ocol = (MODE == 0 ? 0 : 512 + 512 * g) + 128 * hh, hd = (MODE == 0 ? 0 : 4 + 4 * g) + hh;
    const int tq = t0 + 32 * qh + r; const size_t qrow = (size_t)(b * 2048 + tq);
    const LAS float* tab2 = (const LAS float*)(F.misc + MO_TAB2) + hd * 129;
    LAS unsigned char* lds = F.lds;
    bf16x8_t qf[8];
#pragma unroll
    for (int ks = 0; ks < 8; ++ks) qf[ks] = *(const bf16x8_t*)(F.Z + qrow * ZP + qcol + 16 * ks + 8 * hf);
    f32x16 oacc[4];
#pragma unroll
    for (int dt = 0; dt < 4; ++dt)
#pragma unroll
        for (int i = 0; i < 16; ++i) oacc[dt][i] = 0.f;
    float m_run = -1e30f, l_run = 0.f;
    const int tile_lo = MODE == 0 ? 0 : (t0 >= 128 ? t0 / 64 - 2 : 0), tile_hi = t0 / 64 + 1;
    const int skey = tid >> 4, sdc = tid & 15;
    v4u kreg[2], vreg[2];
    { const bf16* zr = F.Z + (size_t)(b * 2048 + 64 * tile_lo + skey) * ZP;
#pragma unroll
      for (int i = 0; i < 2; ++i) { kreg[i] = *(const v4u*)(zr + (size_t)(32 * i) * ZP + kcol + 8 * sdc); vreg[i] = *(const v4u*)(zr + (size_t)(32 * i) * ZP + vcol + 8 * sdc); } }
    const float sc2 = 0.08838834764831845f * 1.4426950408889634f;
    unsigned mwn[2] = {0xffffffffu, 0xffffffffu};
    if (MODE == 0) { mwn[0] = F.MASK[qrow * 64 + 2 * tile_lo]; mwn[1] = F.MASK[qrow * 64 + 2 * tile_lo + 1]; }
#pragma unroll 1
    for (int kt = tile_lo; kt < tile_hi; ++kt) {
        const int bf = (kt - tile_lo) & 1, s0 = 64 * kt;
        LAS unsigned char* kb = lds + FA_KOFF + bf * (64 * FA_KP); LAS unsigned char* vb = lds + FA_VOFF + bf * (64 * FA_VP);
#pragma unroll
        for (int i = 0; i < 2; ++i) { *(LAS v4u*)(kb + (skey + 32 * i) * FA_KP + 16 * sdc) = kreg[i]; *(LAS v4u*)(vb + (skey + 32 * i) * FA_VP + 16 * sdc) = vreg[i]; }
        __syncthreads();
        if (kt + 1 < tile_hi) { const bf16* zr = F.Z + (size_t)(b * 2048 + 64 * (kt + 1) + skey) * ZP;
#pragma unroll
            for (int i = 0; i < 2; ++i) { kreg[i] = *(const v4u*)(zr + (size_t)(32 * i) * ZP + kcol + 8 * sdc); vreg[i] = *(const v4u*)(zr + (size_t)(32 * i) * ZP + vcol + 8 * sdc); } }
        unsigned mw[2] = {mwn[0], mwn[1]};
        if (MODE == 0 && kt + 1 < tile_hi) { mwn[0] = F.MASK[qrow * 64 + 2 * (kt + 1)]; mwn[1] = F.MASK[qrow * 64 + 2 * (kt + 1) + 1]; }
        f32x16 sacc[2];
#pragma unroll
        for (int k2 = 0; k2 < 2; ++k2) {
#pragma unroll
            for (int i = 0; i < 16; ++i) sacc[k2][i] = 0.f;
#pragma unroll
            for (int ks = 0; ks < 8; ++ks) { const bf16x8_t kf = *(const LAS bf16x8_t*)(kb + (32 * k2 + r) * FA_KP + (16 * ks + 8 * hf) * 2);
                sacc[k2] = __builtin_amdgcn_mfma_f32_32x32x16_bf16(kf, qf[ks], sacc[k2], 0, 0, 0); }
        }
        float mx = -1e30f;
        if (MODE == 0 && s0 + 63 + 128 <= t0) {
            const float bfar = tab2[128];
#pragma unroll
            for (int k2 = 0; k2 < 2; ++k2)
#pragma unroll
                for (int i = 0; i < 16; ++i) { const int cr = (i & 3) + 8 * (i >> 2) + 4 * hf;
                    const float v = ((mw[k2] >> cr) & 1u) ? sacc[k2][i] * sc2 + bfar : -__builtin_inff();
                    sacc[k2][i] = v; mx = fmaxf(mx, v); }
        } else
#pragma unroll
        for (int k2 = 0; k2 < 2; ++k2)
#pragma unroll
            for (int i = 0; i < 16; ++i) { const int cr = (i & 3) + 8 * (i >> 2) + 4 * hf; const int dist = tq - (s0 + 32 * k2 + cr);
                bool ok; if (MODE == 0) ok = (mw[k2] >> cr) & 1u; else ok = dist >= 0 && dist < 128;
                const int di = dist < 0 ? 0 : (dist > 128 ? 128 : dist);
                float vf = sacc[k2][i] * sc2 + tab2[di];
                asm volatile("" : "+v"(vf));
                const float v = ok ? vf : -__builtin_inff();
                sacc[k2][i] = v; mx = fmaxf(mx, v); }
        { const auto sw_ = __builtin_amdgcn_permlane32_swap(__float_as_uint(mx), __float_as_uint(mx), false, false); mx = fmaxf(__uint_as_float(sw_[0]), __uint_as_float(sw_[1])); }
        const float m_new = fmaxf(m_run, mx), alpha = __builtin_amdgcn_exp2f(m_run - m_new); m_run = m_new;
        float ps = 0.f;
#pragma unroll
        for (int k2 = 0; k2 < 2; ++k2)
#pragma unroll
            for (int i = 0; i < 16; ++i) { const float p = __builtin_amdgcn_exp2f(sacc[k2][i] - m_new); sacc[k2][i] = p; ps += p; }
        l_run = l_run * alpha + ps;
        if (__ballot(alpha != 1.0f)) {
#pragma unroll
        for (int dt = 0; dt < 4; ++dt)
#pragma unroll
            for (int i = 0; i < 16; ++i) oacc[dt][i] *= alpha;
        }
#pragma unroll
        for (int k2 = 0; k2 < 2; ++k2)
#pragma unroll
            for (int s2 = 0; s2 < 2; ++s2) {
                v4u pw; pw.x = pg8::cvt_pk_bf16(sacc[k2][8 * s2 + 0], sacc[k2][8 * s2 + 1]); pw.y = pg8::cvt_pk_bf16(sacc[k2][8 * s2 + 2], sacc[k2][8 * s2 + 3]);
                pw.z = pg8::cvt_pk_bf16(sacc[k2][8 * s2 + 4], sacc[k2][8 * s2 + 5]); pw.w = pg8::cvt_pk_bf16(sacc[k2][8 * s2 + 6], sacc[k2][8 * s2 + 7]);
                const bf16x8_t pb = __builtin_bit_cast(bf16x8_t, pw);
                const int i16 = lane & 15, grp = (lane >> 4) & 1;
                const LAS unsigned char* vp = vb + (32 * k2 + 16 * s2 + 4 * hf + (i16 >> 2)) * FA_VP + (16 * grp + 4 * (i16 & 3)) * 2;
#pragma unroll
                for (int dt = 0; dt < 4; ++dt) { const s16x4 lo = fa_vtr(vp + 64 * dt), hi = fa_vtr(vp + 8 * FA_VP + 64 * dt);
                    const bf16x8_t vf = __builtin_shufflevector(lo, hi, 0, 1, 2, 3, 4, 5, 6, 7);
                    oacc[dt] = __builtin_amdgcn_mfma_f32_32x32x16_bf16(vf, pb, oacc[dt], 0, 0, 0); }
            }
    }
    float l_tot = l_run + __shfl_xor(l_run, 32);
    if (MODE == 1) l_tot += __builtin_amdgcn_exp2f(F.in[I_SINK][l * 8 + hd - 4] * 1.4426950408889634f - m_run);
    const float inv = 1.0f / l_tot;
    bf16* orow = F.OCAT + qrow * 2048 + ocol + 4 * hf;
#pragma unroll
    for (int dt = 0; dt < 4; ++dt)
#pragma unroll
        for (int gq = 0; gq < 4; ++gq) { v2u w; w.x = pk2(oacc[dt][4 * gq] * inv, oacc[dt][4 * gq + 1] * inv); w.y = pk2(oacc[dt][4 * gq + 2] * inv, oacc[dt][4 * gq + 3] * inv);
            *(v2u*)(orow + 32 * dt + 8 * gq) = w; }
    __syncthreads();
}


#define GLA_GATE_PREFIX(LDS_TOT) \
        float la[8]; \
        _Pragma("unroll") for (int i = 0; i < 8; ++i) { const v4u c0 = rc0[i], c1 = rc1[i]; float x = gb; \
            x += bflo(c0.x) * gwv[0] + bfhi(c0.x) * gwv[1] + bflo(c0.y) * gwv[2] + bfhi(c0.y) * gwv[3] + bflo(c0.z) * gwv[4] + bfhi(c0.z) * gwv[5] + bflo(c0.w) * gwv[6] + bfhi(c0.w) * gwv[7]; \
            x += bflo(c1.x) * gwv[8] + bfhi(c1.x) * gwv[9] + bflo(c1.y) * gwv[10] + bfhi(c1.y) * gwv[11] + bflo(c1.z) * gwv[12] + bfhi(c1.z) * gwv[13] + bflo(c1.w) * gwv[14] + bfhi(c1.w) * gwv[15]; \
            la[i] = (fminf(x, 0.f) - __logf(1.0f + __expf(-fabsf(x)))) * 0.0625f; } \
        _Pragma("unroll") for (int i = 1; i < 8; ++i) la[i] += la[i - 1]; \
        ((LAS float*)(L + LDS_TOT))[cg * 64 + dk] = la[7];
#define GLA_OFFSETS(LDS_TOT) \
        float off = 0.f, tot = 0.f; \
        _Pragma("unroll") for (int g2 = 0; g2 < 8; ++g2) { const float tv = ((const LAS float*)(L + LDS_TOT))[g2 * 64 + dk]; tot += tv; off += g2 < cg ? tv : 0.f; }

__device__ __forceinline__ void gla_state_phase(Frame& F, int l) {
    const int tid = F.tid, lane = F.lane, wave = F.wave, r = lane & 31, hf = lane >> 5, i16 = lane & 15, grp = (lane >> 4) & 1;
    LAS unsigned char* L = F.lds;
    constexpr int KDT = 0, VT = 9216, TOT = 29696, RP = 144, VP = 320;
    const int dk = lane, cg = wave;
    float* GCS = (float*)(F.ws + WS_GCS); float* GDEC = (float*)(F.ws + WS_GDEC);
    v4u rc0[8], rc1[8], rv[2]; unsigned short rk[8];
#define GLS_LOAD(u_) do { const int bh_ = (u_) >> 5, n_ = (u_) & 31; const size_t r0_ = (size_t)((bh_ >> 2) * 2048 + 64 * n_); const int h_ = bh_ & 3; \
        _Pragma("unroll") for (int i = 0; i < 8; ++i) { const bf16* zr = F.Z + (r0_ + 8 * cg + i) * ZP; rc0[i] = *(const v4u*)(zr + ZC_CG); rc1[i] = *(const v4u*)(zr + ZC_CG + 8); rk[i] = zr[ZC_CK + h_ * 64 + dk]; } \
        _Pragma("unroll") for (int i = 0; i < 2; ++i) rv[i] = *(const v4u*)(F.Z + (r0_ + (tid >> 4) + 32 * i) * ZP + ZC_CV + h_ * 128 + 8 * (tid & 15)); } while (0)
    int u = F.vcu;
    if (u < 2048) GLS_LOAD(u);
    for (; u < 2048; u += F.G) {
        const int h = (u >> 5) & 3;
        float gwv[16];
#pragma unroll
        for (int q = 0; q < 16; ++q) gwv[q] = F.in[I_CGW][(size_t)l * 4096 + q * 256 + h * 64 + dk];
        const float gb = F.in[I_CGB][l * 256 + h * 64 + dk];
        GLA_GATE_PREFIX(TOT)
        float kv[8];
#pragma unroll
        for (int i = 0; i < 8; ++i) kv[i] = bf1(rk[i]);
#pragma unroll
        for (int i = 0; i < 2; ++i) *(LAS v4u*)(L + VT + ((tid >> 4) + 32 * i) * VP + 16 * (tid & 15)) = rv[i];
        __syncthreads();
        GLA_OFFSETS(TOT)
        { float kd[8];
#pragma unroll
          for (int i = 0; i < 8; ++i) kd[i] = kv[i] * __expf(tot - (off + la[i]));
          v4u w; w.x = pk2(kd[0], kd[1]); w.y = pk2(kd[2], kd[3]); w.z = pk2(kd[4], kd[5]); w.w = pk2(kd[6], kd[7]); *(LAS v4u*)(L + KDT + dk * RP + 16 * cg) = w; }
        if (cg == 0) GDEC[(size_t)u * 64 + dk] = __expf(tot);
        __syncthreads();
        if (u + F.G < 2048) GLS_LOAD(u + F.G);
        { const int dkt = wave >> 2, dvt = wave & 3;
          f32x16 cs;
#pragma unroll
          for (int i = 0; i < 16; ++i) cs[i] = 0.f;
#pragma unroll
          for (int ks = 0; ks < 4; ++ks) { const bf16x8_t a = *(const LAS bf16x8_t*)(L + KDT + (32 * dkt + r) * RP + (16 * ks + 8 * hf) * 2);
              const LAS unsigned char* vp = L + VT + (16 * ks + 8 * hf + (i16 >> 2)) * VP + (32 * dvt + 16 * grp + 4 * (i16 & 3)) * 2;
              const s16x4 lo = fa_vtr(vp), hi = fa_vtr(vp + 4 * VP);
              cs = __builtin_amdgcn_mfma_f32_32x32x16_bf16(a, __builtin_shufflevector(lo, hi, 0, 1, 2, 3, 4, 5, 6, 7), cs, 0, 0, 0); }
          float* gp = GCS + (size_t)u * 8192 + (size_t)(32 * dkt + 4 * hf) * 128 + 32 * dvt + r;
#pragma unroll
          for (int i = 0; i < 16; ++i) gp[((i & 3) + 8 * (i >> 2)) * 128] = cs[i]; }
        __syncthreads();
    }
#undef GLS_LOAD
}

__device__ __forceinline__ void gla_scan_phase(Frame& F) {
    float* GCS = (float*)(F.ws + WS_GCS); const float* GDEC = (const float*)(F.ws + WS_GDEC);
    for (int gt = F.gw * 64 + F.lane; gt < 64 * 2048; gt += F.NGW * 64) {
        const int bh = gt >> 11, e4 = gt & 2047, dk = e4 >> 5;
        f32x4* p = (f32x4*)(GCS + (size_t)bh * 32 * 8192) + e4; const float* dp = GDEC + (size_t)bh * 32 * 64 + dk;
        f32x4 st = (f32x4){0.f, 0.f, 0.f, 0.f};
#pragma unroll 1
        for (int n0 = 0; n0 < 32; n0 += 8) {
            f32x4 cs[8]; float dc[8];
#pragma unroll
            for (int j = 0; j < 8; ++j) { cs[j] = p[(size_t)(n0 + j) * 2048]; dc[j] = dp[(n0 + j) * 64]; }
#pragma unroll
            for (int j = 0; j < 8; ++j) { p[(size_t)(n0 + j) * 2048] = st; st = st * dc[j] + cs[j]; }
        }
    }
}

__device__ __forceinline__ void gla_out_phase(Frame& F, int l) {
    const int tid = F.tid, lane = F.lane, wave = F.wave, r = lane & 31, hf = lane >> 5, i16 = lane & 15, grp = (lane >> 4) & 1;
    LAS unsigned char* L = F.lds;
    constexpr int QG = 0, KG = 9216, VT = 18432, PT = 38912, TOT = 59392, OT = 61440, RP = 144, VP = 320, OP = 132;
    const int dk = lane, cg = wave;
    const float* GCS = (const float*)(F.ws + WS_GCS);
    v4u rc0[8], rc1[8], rv[2]; unsigned short rq[8], rk[8]; unsigned rg[8]; f32x4 rp[4];
#define GLO_LOAD(u_) do { const int bh_ = (u_) >> 5, n_ = (u_) & 31; const size_t r0_ = (size_t)((bh_ >> 2) * 2048 + 64 * n_); const int h_ = bh_ & 3; \
        _Pragma("unroll") for (int i = 0; i < 8; ++i) { const bf16* zr = F.Z + (r0_ + 8 * cg + i) * ZP; rc0[i] = *(const v4u*)(zr + ZC_CG); rc1[i] = *(const v4u*)(zr + ZC_CG + 8); rq[i] = zr[ZC_CQ + h_ * 64 + dk]; rk[i] = zr[ZC_CK + h_ * 64 + dk]; \
            rg[i] = *(const unsigned*)(zr + ZC_CR + h_ * 128 + 2 * lane); } \
        _Pragma("unroll") for (int i = 0; i < 2; ++i) rv[i] = *(const v4u*)(F.Z + (r0_ + (tid >> 4) + 32 * i) * ZP + ZC_CV + h_ * 128 + 8 * (tid & 15)); \
        _Pragma("unroll") for (int i = 0; i < 4; ++i) rp[i] = *(const f32x4*)(GCS + (size_t)(u_) * 8192 + (size_t)(tid >> 3) * 128 + 16 * (tid & 7) + 4 * i); } while (0)
    int u = F.vcu;
    if (u < 2048) GLO_LOAD(u);
    const float g0 = F.in[I_CNG][l * 128 + 2 * lane], g1 = F.in[I_CNG][l * 128 + 2 * lane + 1];
    for (; u < 2048; u += F.G) {
        const int bh = u >> 5, n = u & 31, h = bh & 3; const size_t row0 = (size_t)((bh >> 2) * 2048 + 64 * n);
        float gwv[16];
#pragma unroll
        for (int q = 0; q < 16; ++q) gwv[q] = F.in[I_CGW][(size_t)l * 4096 + q * 256 + h * 64 + dk];
        const float gb = F.in[I_CGB][l * 256 + h * 64 + dk];
        GLA_GATE_PREFIX(TOT)
        float qv[8], kv[8]; unsigned gr[8];
#pragma unroll
        for (int i = 0; i < 8; ++i) { qv[i] = bf1(rq[i]); kv[i] = bf1(rk[i]); gr[i] = rg[i]; }
#pragma unroll
        for (int i = 0; i < 2; ++i) *(LAS v4u*)(L + VT + ((tid >> 4) + 32 * i) * VP + 16 * (tid & 15)) = rv[i];
        { v4u w0, w1; w0.x = pk2(rp[0].x, rp[0].y); w0.y = pk2(rp[0].z, rp[0].w); w0.z = pk2(rp[1].x, rp[1].y); w0.w = pk2(rp[1].z, rp[1].w);
          w1.x = pk2(rp[2].x, rp[2].y); w1.y = pk2(rp[2].z, rp[2].w); w1.z = pk2(rp[3].x, rp[3].y); w1.w = pk2(rp[3].z, rp[3].w);
          *(LAS v4u*)(L + PT + (tid >> 3) * VP + 32 * (tid & 7)) = w0; *(LAS v4u*)(L + PT + (tid >> 3) * VP + 32 * (tid & 7) + 16) = w1; }
        __syncthreads();
        GLA_OFFSETS(TOT)
#pragma unroll
        for (int i = 0; i < 8; ++i) { const float bi = off + la[i];
            *(LAS bf16*)(L + QG + (8 * cg + i) * RP + 2 * dk) = (bf16)f2bf(qv[i] * 0.125f * __expf(bi));
            *(LAS bf16*)(L + KG + (8 * cg + i) * RP + 2 * dk) = (bf16)f2bf(kv[i] * __expf(-bi)); }
        __syncthreads();
        if (u + F.G < 2048) GLO_LOAD(u + F.G);
        { const int ct = wave >> 2, dvt = wave & 3;
          f32x16 o;
#pragma unroll
          for (int i = 0; i < 16; ++i) o[i] = 0.f;
#pragma unroll
          for (int st = 0; st < 2; ++st) if (st <= ct) {
              f32x16 at;
#pragma unroll
              for (int i = 0; i < 16; ++i) at[i] = 0.f;
#pragma unroll
              for (int ks = 0; ks < 4; ++ks) { const bf16x8_t a = *(const LAS bf16x8_t*)(L + KG + (32 * st + r) * RP + (16 * ks + 8 * hf) * 2), bq = *(const LAS bf16x8_t*)(L + QG + (32 * ct + r) * RP + (16 * ks + 8 * hf) * 2);
                  at = __builtin_amdgcn_mfma_f32_32x32x16_bf16(a, bq, at, 0, 0, 0); }
              if (st == ct) {
#pragma unroll
                  for (int i = 0; i < 16; ++i) { const int cr = (i & 3) + 8 * (i >> 2) + 4 * hf; at[i] = cr <= r ? at[i] : 0.f; } }
#pragma unroll
              for (int s2 = 0; s2 < 2; ++s2) {
                  v4u pw; pw.x = pg8::cvt_pk_bf16(at[8 * s2 + 0], at[8 * s2 + 1]); pw.y = pg8::cvt_pk_bf16(at[8 * s2 + 2], at[8 * s2 + 3]); pw.z = pg8::cvt_pk_bf16(at[8 * s2 + 4], at[8 * s2 + 5]); pw.w = pg8::cvt_pk_bf16(at[8 * s2 + 6], at[8 * s2 + 7]);
                  const LAS unsigned char* vp = L + VT + (32 * st + 16 * s2 + 4 * hf + (i16 >> 2)) * VP + (32 * dvt + 16 * grp + 4 * (i16 & 3)) * 2;
                  const s16x4 lo = fa_vtr(vp), hi = fa_vtr(vp + 8 * VP);
                  o = __builtin_amdgcn_mfma_f32_32x32x16_bf16(__builtin_bit_cast(bf16x8_t, pw), __builtin_shufflevector(lo, hi, 0, 1, 2, 3, 4, 5, 6, 7), o, 0, 0, 0);
              }
          }
#pragma unroll
          for (int ks = 0; ks < 4; ++ks) { const bf16x8_t a = *(const LAS bf16x8_t*)(L + QG + (32 * ct + r) * RP + (16 * ks + 8 * hf) * 2);
              const LAS unsigned char* pp = L + PT + (16 * ks + 8 * hf + (i16 >> 2)) * VP + (32 * dvt + 16 * grp + 4 * (i16 & 3)) * 2;
              const s16x4 lo = fa_vtr(pp), hi = fa_vtr(pp + 4 * VP);
              o = __builtin_amdgcn_mfma_f32_32x32x16_bf16(a, __builtin_shufflevector(lo, hi, 0, 1, 2, 3, 4, 5, 6, 7), o, 0, 0, 0); }
          LAS float* op = (LAS float*)(L + OT) + (32 * ct + 4 * hf) * OP + 32 * dvt + r;
#pragma unroll
          for (int i = 0; i < 16; ++i) op[((i & 3) + 8 * (i >> 2)) * OP] = o[i]; }
        __syncthreads();
        { float a[8], c[8], ss[8];
#pragma unroll
          for (int i = 0; i < 8; ++i) { const LAS float* orow = (const LAS float*)(L + OT) + (8 * wave + i) * OP + 2 * lane; a[i] = orow[0]; c[i] = orow[1]; ss[i] = a[i] * a[i] + c[i] * c[i]; }
#pragma unroll
          for (int o2 = 1; o2 < 64; o2 <<= 1) {
#pragma unroll
              for (int i = 0; i < 8; ++i) ss[i] += __shfl_xor(ss[i], o2); }
#pragma unroll
          for (int i = 0; i < 8; ++i) { const float rstd = rsqrtf(ss[i] * (1.0f / 128.0f) + EPS);
              *(unsigned*)(F.OCAT + (row0 + 8 * wave + i) * 2048 + 1536 + h * 128 + 2 * lane) = pk2(a[i] * rstd * g0 * bflo(gr[i]), c[i] * rstd * g1 * bfhi(gr[i])); } }
        __syncthreads();
    }
#undef GLO_LOAD
}
#undef GLA_GATE_PREFIX
#undef GLA_OFFSETS

__device__ __forceinline__ bool in_phase(int k, int lo, int hi) { asm volatile("" : "+s"(k)); return lo <= k && k < hi; }
#define IN(k) in_phase((k), lo, hi)
#define PHASE_LANE() do { int _tz = threadIdx.x; asm volatile("" : "+v"(_tz)); F.tid = _tz; F.lane = _tz & 63; } while (0)
#define SEAM(k) do { if (IN(k) && IN((k) + 1)) xcd_barrier(bar); } while (0)
template <int l>
__device__ __forceinline__ void layer_body(Frame& F, const XcdBarrier& bar, const int lo, const int hi) {
    constexpr int pb = 1 + 11 * l;
        if (IN(pb + 0)) {
            { pg8::Gemm g{F.XN, (const bf16*)(F.ws + WS_WIN + l * WIN_L + 24 * MiB), T, 768, D}; pg8::StaticOrder S; S.init(T, 768, D, F.G, (int)blockIdx.x);
              pg8::EpiInProj<1> E{F.Z, F.ws + WS_GT, (LAS unsigned long long*)(F.misc + MO_SS), (const LAS float*)(F.misc + MO_GN) + l * 512};
              pg8::gemm_phase<pg8::EpiInProj<1>, pg8::StaticOrder, true, false>(F.lds, g, S, E); }
            { pg8::Gemm g{(const bf16*)(F.ws + WS_XN8), (const bf16*)(F.ws + WS_WIN + l * WIN_L), T, 10496, D / 2}; pg8::StaticOrder S; S.init(T, 10496, D / 2, F.G, ((int)blockIdx.x + F.G / 2) % F.G);
              pg8::EpiInProj<0> E{F.Z, F.ws + WS_GT, (LAS unsigned long long*)(F.misc + MO_SS), (const LAS float*)(F.misc + MO_GN) + l * 512};
              pg8::gemm_phase<pg8::EpiInProj<0>, pg8::StaticOrder, true, true>(F.lds, g, S, E); }
        }
        SEAM(pb + 0);
        if (IN(pb + 1)) { PHASE_LANE();
            if (F.wave & 4) convert_moe(F, l, 0, 4, 40960);
            for (int it = F.gw; it < NB * 128; it += F.NGW) {
                const int b = it >> 7, j = it & 127;
                indexer_segment(F, b, j, 0, j < 64 ? j + 1 : 64);
                if (j < 64) indexer_segment(F, b, 127 - j, 64, 128 - j);
            }
            if (!(F.wave & 4)) convert_moe(F, l, 0, 4, 40960);
            PHASE_LANE();
            gla_state_phase(F, l);
        }
        SEAM(pb + 1);
        if (IN(pb + 2)) { PHASE_LANE();
            if (F.wave & 4) convert_moe(F, l, 1, 4, 0);
            for (int row = F.gw; row < T; row += F.NGW) {
                const int t = row & 2047;
                if (t < 256) { const int nb = t + 1 - 32 * F.lane; F.MASK[(size_t)row * 64 + F.lane] = nb >= 32 ? 0xffffffffu : (nb <= 0 ? 0u : ((1u << nb) - 1u)); continue; }
                float val[32];
#pragma unroll
                for (int j = 0; j < 32; ++j) { const int s_ = 64 * j + F.lane; val[j] = F.S[(size_t)row * 2048 + (s_ < t ? s_ : t)]; }
                float vmx = -3.0e38f, vmn = 3.0e38f;
#pragma unroll
                for (int j = 0; j < 32; ++j) { const bool ok = 64 * j + F.lane <= t; val[j] = ok ? val[j] : -3.0e38f; vmx = fmaxf(vmx, val[j]); vmn = fminf(vmn, ok ? val[j] : 3.0e38f); }
#pragma unroll
                for (int o = 1; o < 64; o <<= 1) { vmx = fmaxf(vmx, __shfl_xor(vmx, o)); vmn = fminf(vmn, __shfl_xor(vmn, o)); }
                float lo = vmn, hi = vmx, thf = 0.f; bool exact = false;
#pragma unroll 1
                for (int it = 0; it < 28; ++it) { const float mid = 0.5f * (lo + hi); if (!(mid > lo && mid < hi)) break; int cnt = 0;
#pragma unroll
                    for (int j = 0; j < 32; ++j) cnt += __popcll(__ballot(val[j] >= mid));
                    if (cnt == 256) { exact = true; thf = mid; break; }
                    if (cnt > 256) lo = mid; else hi = mid; }
                unsigned th = 0u; int need = 0;
#define KEYOF(x) ({ const unsigned u_ = __float_as_uint(x); (u_ & 0x80000000u) ? ~u_ : (u_ | 0x80000000u); })
                if (!exact) {
#pragma unroll 1
                    for (int bit = 31; bit >= 0; --bit) { const unsigned cand = th | (1u << bit); int cnt = 0;
#pragma unroll
                        for (int j = 0; j < 32; ++j) cnt += __popcll(__ballot(KEYOF(val[j]) >= cand));
                        if (cnt >= 256) th = cand; }
                    int cgt = 0;
#pragma unroll
                    for (int j = 0; j < 32; ++j) cgt += __popcll(__ballot(KEYOF(val[j]) > th));
                    need = 256 - cgt;
                }
                int run = 0; unsigned myword = 0u;
#pragma unroll
                for (int j = 0; j < 32; ++j) {
                    bool sel;
                    if (exact) sel = val[j] >= thf;
                    else { const unsigned kj = KEYOF(val[j]); const bool eq = kj == th; const unsigned long long eqm = __ballot(eq);
                        const int pre = run + __popcll(eqm & ((1ull << F.lane) - 1ull)); sel = (kj > th) || (eq && pre < need); run += __popcll(eqm); sel = sel && (64 * j + F.lane <= t); }
                    const unsigned long long sm = __ballot(sel);
                    if ((F.lane >> 1) == j) myword = (F.lane & 1) ? (unsigned)(sm >> 32) : (unsigned)sm;
                }
#undef KEYOF
                F.MASK[(size_t)row * 64 + F.lane] = myword;
            }
            if (!(F.wave & 4)) convert_moe(F, l, 1, 4, 0);
            gla_scan_phase(F);
        }
        SEAM(pb + 2);
        if (IN(pb + 3)) { PHASE_LANE();
            if (F.vcu & 1) { convert_moe(F, l, 1, 2, 0); __syncthreads(); PHASE_LANE(); }
            for (int u = F.vcu; u < NB * 16; u += F.G) { const int b = u >> 4, p = u & 15; flash_unit<0>(F, l, b, 0, 64 * (31 - p)); flash_unit<0>(F, l, b, 0, 64 * p); }
            for (int u = F.vcu; u < NB * 2 * 32; u += F.G) { const int b = u >> 6, g = (u >> 5) & 1, qb = u & 31; flash_unit<1>(F, l, b, g, 64 * qb); }
            gla_out_phase(F, l);
            if (!(F.vcu & 1)) { PHASE_LANE(); convert_moe(F, l, 1, 2, 0); }
        }
        SEAM(pb + 3);
        if (IN(pb + 4)) {
            pg8::Gemm g{F.OCAT, (const bf16*)(F.ws + WS_WBR + l * WBR_L), T, D, D}; pg8::MergeOrder S; S.init(T, D, D, F.G, (int)blockIdx.x);
#ifdef PROBE_MERGE
            { pg8::EpiMergeT<PROBE_MERGE> E{F.ws + WS_GT, (bf16*)(F.ws + WS_S)}; pg8::gemm_phase<pg8::EpiMergeT<PROBE_MERGE>, pg8::MergeOrder, true>(F.lds, g, S, E); }
#endif
            pg8::EpiMerge E{F.ws + WS_GT, F.MERGED};
            pg8::gemm_phase<pg8::EpiMerge, pg8::MergeOrder, true>(F.lds, g, S, E);
        }
        SEAM(pb + 4);
        if (IN(pb + 5)) {
            pg8::Gemm g{F.MERGED, (const bf16*)(F.ws + WS_WO + l * WO_L), T, D, D}; pg8::StaticOrder S; S.init(T, D, D, F.G, (int)blockIdx.x);
            pg8::EpiResid E{(bf16*)(F.ws + WS_HB), (unsigned char*)F.XN, F.in[I_N2G] + l * D, F.lds + 3 * pg8::HTB};
            pg8::gemm_phase<pg8::EpiResid, pg8::StaticOrder, true>(F.lds, g, S, E);
        }
        SEAM(pb + 5);
        if (IN(pb + 6)) { PHASE_LANE();
            unsigned* cnt = F.ctl + CW_CNT + 64 * l;
            const int lane = F.lane, fr = lane & 15, fq = lane >> 4;
            LAS float* LG = (LAS float*)(F.lds + F.wave * 8192);
            const bf16* wrh = (const bf16*)(F.ws + WS_WRH + l * WR_L) + (size_t)fr * 2048 + 8 * fq; const bf16* wrl = (const bf16*)(F.ws + WS_WRL + l * WR_L) + (size_t)fr * 2048 + 8 * fq;
            for (int tile = F.gw; tile < T / 16; tile += F.NGW) {
                const bf16* hrow = (const bf16*)(F.ws + WS_HB) + (size_t)(16 * tile + fr) * D + 8 * fq;
                f32x4 acc[6];
#pragma unroll
                for (int nt = 0; nt < 6; ++nt) acc[nt] = (f32x4){0.f, 0.f, 0.f, 0.f};
                float ss = 0.f;
#pragma unroll 2
                for (int ks = 0; ks < 64; ++ks) {
                    const v4u hw = *(const v4u*)(hrow + 32 * ks);
                    { const float a0 = bflo(hw.x), a1 = bfhi(hw.x), a2 = bflo(hw.y), a3 = bfhi(hw.y), a4 = bflo(hw.z), a5 = bfhi(hw.z), a6 = bflo(hw.w), a7 = bfhi(hw.w);
                      ss += (a0 * a0 + a1 * a1) + (a2 * a2 + a3 * a3) + (a4 * a4 + a5 * a5) + (a6 * a6 + a7 * a7); }
                    const bf16x8_t ah = __builtin_bit_cast(bf16x8_t, hw);
#pragma unroll
                    for (int nt = 0; nt < 6; ++nt) { const bf16x8_t bh = *(const bf16x8_t*)(wrh + (size_t)(16 * nt) * 2048 + 32 * ks), bl = *(const bf16x8_t*)(wrl + (size_t)(16 * nt) * 2048 + 32 * ks);
                        acc[nt] = __builtin_amdgcn_mfma_f32_16x16x32_bf16(ah, bh, acc[nt], 0, 0, 0);
                        acc[nt] = __builtin_amdgcn_mfma_f32_16x16x32_bf16(ah, bl, acc[nt], 0, 0, 0); }
                }
                ss += __shfl_xor(ss, 16); ss += __shfl_xor(ss, 32);
                if (fq == 0) { const float rs_ = rsqrtf(ss * (1.0f / 2048.0f) + EPS); LG[1600 + fr] = rs_; ((float*)(F.ws + WS_RSTD))[16 * tile + fr] = rs_; }
#pragma unroll
                for (int nt = 0; nt < 6; ++nt)
#pragma unroll
                    for (int i = 0; i < 4; ++i) LG[(4 * fq + i) * 100 + 16 * nt + fr] = acc[nt][i];
                LDS_WAIT(); asm volatile("" ::: "memory");
                if (lane < 16) {
                    const int row = 16 * tile + lane; const float rstd = LG[1600 + lane]; const LAS float* lr = LG + lane * 100;
                    float lg[8]; int grp = 0; float gmax = -3.0e38f;
#pragma unroll
                    for (int e = 0; e < 8; ++e) { lg[e] = lr[e] * rstd + F.in[I_BRG][l * 8 + e]; if (lg[e] > gmax) { gmax = lg[e]; grp = e; } }
                    float gden = 0.f;
#pragma unroll
                    for (int e = 0; e < 8; ++e) gden += __expf(lg[e] - gmax);
                    const float gwt = 1.0f / gden;
                    int i0 = 0, i1 = 0; float m0 = -3.0e38f, m1 = -3.0e38f;
#pragma unroll
                    for (int e = 0; e < 8; ++e) { const float v = lr[8 + grp * 8 + e] * rstd + F.in[I_BRE][l * 64 + grp * 8 + e];
                        if (v > m0) { m1 = m0; i1 = i0; m0 = v; i0 = e; } else if (v > m1) { m1 = v; i1 = e; } }
                    const float e1 = __expf(m1 - m0); const float p0 = 1.0f / (1.0f + e1), p1 = e1 / (1.0f + e1);
                    const int ex0 = grp * 8 + i0, ex1 = grp * 8 + i1;
                    const unsigned r0 = atomicAdd(&cnt[ex0], 1u), r1 = atomicAdd(&cnt[ex1], 1u);
                    unsigned* rec = (unsigned*)(F.ws + WS_ROUTE) + (size_t)row * 8;
                    rec[0] = (unsigned)ex0; rec[1] = r0; rec[2] = (unsigned)ex1; rec[3] = r1; rec[4] = __float_as_uint(gwt * p0); rec[5] = __float_as_uint(gwt * p1);
                    int* liste = (int*)(F.ws + WS_LISTE); liste[(size_t)ex0 * 32768 + r0] = row; liste[(size_t)ex1 * 32768 + r1] = row;
                }
                LDS_WAIT(); asm volatile("" ::: "memory");
            }
        }
        SEAM(pb + 6);
        if (IN(pb + 7) || IN(pb + 8) || IN(pb + 9) || IN(pb + 10)) { PHASE_LANE();
            if (F.tid == 0) { const unsigned* cnt = F.ctl + CW_CNT + 64 * l; LAS int* texp = (LAS int*)(F.misc + MO_TEXP); LAS int* pst = (LAS int*)(F.misc + MO_PST); int tb = 0;
                for (int e = 0; e < NEXP; ++e) { const int c = (int)__hip_atomic_load(&cnt[e], __ATOMIC_RELAXED, __HIP_MEMORY_SCOPE_AGENT); const int nt_ = (c + 255) >> 8; pst[e] = tb * 256; ((LAS int*)(F.misc + MO_CNT))[e] = c;
                    for (int r = 0; r < nt_; ++r) texp[tb + r] = e; tb += nt_; }
                *(LAS int*)(F.misc + MO_TOT) = tb; }
            __syncthreads();
        }
        if (IN(pb + 8)) {
            pg8::Gemm g{F.XN, (const bf16*)(F.ws + WS_W13), 0, 0, D / 2};
            pg8::MoeGatherOrder S; S.total = *(const LAS int*)(F.misc + MO_TOT) * 4; S.G = F.G; S.c = F.vcu; S.NJ = 4; S.nt0 = D / 128; S.tile_exp = (const LAS int*)(F.misc + MO_TEXP);
            S.pst = (const LAS int*)(F.misc + MO_PST); S.cnt = (const LAS int*)(F.misc + MO_CNT); S.liste = (const int*)(F.ws + WS_LISTE);
            pg8::EpiGlu E{F.H, S.tile_exp, S.pst, S.cnt, S.liste, (const float*)(F.ws + WS_RSTD)};
            pg8::gemm_phase<pg8::EpiGlu, pg8::MoeGatherOrder, true, true>(F.lds, g, S, E);
        }
        SEAM(pb + 8);
        if (IN(pb + 9)) {
            pg8::Gemm g{F.H, (const bf16*)(F.ws + WS_W2), 0, 0, DEXP / 2};
            pg8::MoeOrder S{*(const LAS int*)(F.misc + MO_TOT) * 8, F.G, F.vcu, 8, DEXP / 128, (const LAS int*)(F.misc + MO_TEXP)};
            pg8::EpiY E{(unsigned char*)F.Y};
            pg8::gemm_phase<pg8::EpiY, pg8::MoeOrder, true, true>(F.lds, g, S, E);
        }
        SEAM(pb + 9);
        if (IN(pb + 10)) { PHASE_LANE();
            for (int row = F.gw; row < T; row += F.NGW) {
                const unsigned* rec = (const unsigned*)(F.ws + WS_ROUTE) + (size_t)row * 8;
                const float w0 = __uint_as_float(rec[4]) * 0.03125f, w1 = __uint_as_float(rec[5]) * 0.03125f;
                const LAS int* pst = (const LAS int*)(F.misc + MO_PST); const int p0 = pst[rec[0]] + (int)rec[1], p1 = pst[rec[2]] + (int)rec[3];
                const unsigned* y0 = (const unsigned*)((const unsigned char*)F.Y + (size_t)p0 * D) + F.lane; const unsigned* y1 = (const unsigned*)((const unsigned char*)F.Y + (size_t)p1 * D) + F.lane;
                f32x4 v[8];
                { const v2u* hr = (const v2u*)((const bf16*)(F.ws + WS_HB) + (size_t)row * D) + F.lane;
#pragma unroll
                  for (int j = 0; j < 8; ++j) { const v2u w = hr[64 * j]; v[j] = (f32x4){bflo(w.x), bfhi(w.x), bflo(w.y), bfhi(w.y)}; } }
#pragma unroll
                for (int j = 0; j < 8; ++j) { const int a = (int)y0[64 * j], c = (int)y1[64 * j];
                    const auto a01 = __builtin_amdgcn_cvt_pk_f32_fp8(a, false), a23 = __builtin_amdgcn_cvt_pk_f32_fp8(a, true), c01 = __builtin_amdgcn_cvt_pk_f32_fp8(c, false), c23 = __builtin_amdgcn_cvt_pk_f32_fp8(c, true);
                    v[j].x += w0 * a01[0] + w1 * c01[0]; v[j].y += w0 * a01[1] + w1 * c01[1]; v[j].z += w0 * a23[0] + w1 * c23[0]; v[j].w += w0 * a23[1] + w1 * c23[1]; }
                if (l + 1 < DEPTH) { v2u* hw_ = (v2u*)((bf16*)(F.ws + WS_HB) + (size_t)row * D) + F.lane;
#pragma unroll
                    for (int j = 0; j < 8; ++j) hw_[64 * j] = (v2u){pg8::cvt_pk_bf16(v[j].x, v[j].y), pg8::cvt_pk_bf16(v[j].z, v[j].w)}; }
                else { f32x4* orow = (f32x4*)(F.out + (size_t)row * D) + F.lane;
#pragma unroll
                    for (int j = 0; j < 8; ++j) orow[64 * j] = v[j]; }
                if (l + 1 < DEPTH) { const float rstd = row_rstd(v); norm_store_bf16(v, rstd, F.in[I_N1G] + (l + 1) * D, F.XN + (size_t)row * D, F.lane); norm_store_fp8(v, rstd, F.in[I_N1G] + (l + 1) * D, (unsigned char*)(F.ws + WS_XN8) + (size_t)row * D, F.lane); }
            }
        }
        SEAM(pb + 10);
    }
__global__ void __launch_bounds__(NWAVES * 64, 2) fwd_kernel(Args args) {
    extern __shared__ __attribute__((aligned(16))) unsigned char lds_raw[];
    Frame F;
    F.lds = (LAS unsigned char*)lds_raw; F.misc = F.lds + MISC_OFF;
    F.tid = threadIdx.x; F.lane = F.tid & 63; F.wave = __builtin_amdgcn_readfirstlane(F.tid >> 6);
    F.G = gridDim.x; { const int bx = blockIdx.x; F.vcu = (F.G % 8 == 0) ? (bx % 8) * (F.G / 8) + bx / 8 : bx; }
    F.gw = F.vcu * NWAVES + F.wave; F.NGW = F.G * NWAVES;
    F.in = args.in; F.out = args.out; F.ws = args.ws; F.ctl = (unsigned*)(args.ws + WS_CTL);
    F.Z = (bf16*)(args.ws + WS_Z); F.XN = (bf16*)(args.ws + WS_XN); F.OCAT = (bf16*)(args.ws + WS_OCAT); F.MERGED = (bf16*)(args.ws + WS_MERGED);
    F.XS = (bf16*)(args.ws + WS_XS); F.Y = (bf16*)(args.ws + WS_Y); F.H = (bf16*)(args.ws + WS_H);
    F.S = (float*)(args.ws + WS_S); F.GO = (float*)(args.ws + WS_GO); F.MASK = (unsigned*)(args.ws + WS_MASK);
    const int lo = args.ph_lo, hi = args.ph_hi;
    const bool use_bar = (hi - lo) > 1;
    for (int u = F.tid; u < 64; u += NWAVES * 64) ((LAS unsigned*)F.misc)[u] = 0u;
    ((LAS unsigned long long*)(F.misc + MO_SS))[F.tid] = 0ull;
    for (int i = F.tid; i < 2 * 4 * 128; i += NWAVES * 64) { const int l_ = i >> 9, k_ = (i >> 7) & 3, d_ = i & 127; ((LAS float*)(F.misc + MO_GN))[i] = F.in[k_ == 0 ? I_AQG : (k_ == 1 ? I_AKG : (k_ == 2 ? I_BQG : I_BKG))][l_ * 128 + d_]; }
    for (int i = F.tid; i < 12 * 129; i += NWAVES * 64) { const int hd = i / 129, dd = i % 129; int bk;
        if (dd < 16) bk = dd; else { bk = 16 + (int)(logf((float)dd / 16.0f) / 2.0794415416798357f * 16.0f); bk = bk > 31 ? 31 : bk; }
        ((LAS float*)(F.misc + MO_TAB2))[i] = F.in[I_RELB][bk * 12 + hd] * 1.4426950408889634f; }
    __syncthreads();
    XcdBarrier bar; bar.bar = F.ctl + CW_BAR; bar.x = 0; bar.st = nullptr;
    if (use_bar) bar = xcd_barrier_post(F.ctl + CW_BAR, (volatile LAS unsigned*)(F.misc + MO_BARW));

    if (IN(0)) { PHASE_LANE();
        LAS float* scr = (LAS float*)(F.lds + F.wave * 16384);
        constexpr int I_IN = (2048 / 64) * (D_IN / 32);
        constexpr int I_BA = (512 / 64) * (2048 / 32), I_BB = (1024 / 64) * (2048 / 32), I_BC = I_BA, I_O = (2048 / 64) * (2048 / 32);
        constexpr int PER_L = I_IN + I_BA + I_BB + I_BC + I_O;
        for (int it = F.gw; it < DEPTH * PER_L; it += F.NGW) {
            const int l = it / PER_L; int r = it % PER_L;
            bf16* win = (bf16*)(F.ws + WS_WIN + l * WIN_L); bf16* wbr = (bf16*)(F.ws + WS_WBR + l * WBR_L); bf16* wo = (bf16*)(F.ws + WS_WO + l * WO_L);
            if (r < I_IN) { const int nb_ = r % (D_IN / 32);
                const bool has8 = nb_ < 56 || (nb_ >= 58 && nb_ <= 106) || nb_ >= 122, hasb = (nb_ >= 56 && nb_ <= 58) || (nb_ >= 106 && nb_ <= 122) || nb_ == 138;
                if (has8) transpose_item_fp8(F.in[I_WIN] + (size_t)l * 2048 * D_IN, D_IN, (unsigned char*)win, 2048, 64.0f, scr, r, F.lane, MapWin8{});
                if (hasb) transpose_item(F.in[I_WIN] + (size_t)l * 2048 * D_IN, D_IN, win + (size_t)12 * 1024 * 1024, 2048, 0, scr, r, F.lane, MapWinB{});
                continue; } r -= I_IN;
            if (r < I_BA) { transpose_item(F.in[I_WBA] + (size_t)l * 512 * 2048, 2048, wbr, 2048, 0, scr, r, F.lane, MapId{0}); continue; } r -= I_BA;
            if (r < I_BB) { transpose_item(F.in[I_WBB] + (size_t)l * 1024 * 2048, 2048, wbr, 2048, 512, scr, r, F.lane, MapId{0}); continue; } r -= I_BB;
            if (r < I_BC) { transpose_item(F.in[I_WBC] + (size_t)l * 512 * 2048, 2048, wbr, 2048, 1536, scr, r, F.lane, MapId{0}); continue; } r -= I_BC;
            transpose_item(F.in[I_WO] + (size_t)l * 2048 * 2048, 2048, wo, 2048, 0, scr, r, F.lane, MapId{0});
        }
        for (int i = F.gw * 64 + F.lane; i < DEPTH * 160 * 256; i += F.NGW * 64) { const int l = i / (160 * 256), r = (i / 256) % 160, c = i % 256;
            *(v4u*)((bf16*)(F.ws + WS_WIN + l * WIN_L) + (size_t)12 * 1024 * 1024 + (size_t)(ZC_PAD - 3328 + r) * 2048 + 8 * c) = (v4u){0u, 0u, 0u, 0u}; }
        for (int i = F.gw * 64 + F.lane; i < DEPTH * 96 * 2048; i += F.NGW * 64) { const int l = i / (96 * 2048), e = (i / 2048) % 96, k = i % 2048;
            float val = 0.f; if (e < 8) val = F.in[I_WRG][(size_t)l * D * 8 + (size_t)k * 8 + e]; else if (e < 72) val = F.in[I_WRE][(size_t)l * D * 64 + (size_t)k * 64 + (e - 8)];
            val *= F.in[I_N2G][l * D + k];
            const unsigned hi = f2bf(val); const float rem = val - bf1((bf16)hi);
            ((bf16*)(F.ws + WS_WRH + l * WR_L))[e * 2048 + k] = (bf16)hi; ((bf16*)(F.ws + WS_WRL + l * WR_L))[e * 2048 + k] = (bf16)f2bf(rem); }
        for (int mrow = F.gw; mrow < T; mrow += F.NGW) { f32x4 v[8]; load_row(F.in[I_X] + (size_t)mrow * D, F.lane, v); const float rstd = row_rstd(v);
            { v2u* hw_ = (v2u*)((bf16*)(F.ws + WS_HB) + (size_t)mrow * D) + F.lane;
#pragma unroll
              for (int j = 0; j < 8; ++j) hw_[64 * j] = (v2u){pg8::cvt_pk_bf16(v[j].x, v[j].y), pg8::cvt_pk_bf16(v[j].z, v[j].w)}; }
            norm_store_bf16(v, rstd, F.in[I_N1G], F.XN + (size_t)mrow * D, F.lane); norm_store_fp8(v, rstd, F.in[I_N1G], (unsigned char*)(F.ws + WS_XN8) + (size_t)mrow * D, F.lane); }
    }
    SEAM(0);

    layer_body<0>(F, bar, lo, hi);
    layer_body<1>(F, bar, lo, hi);
}


#ifndef N_LAUNCH_MODE
#define N_LAUNCH_MODE 1
#endif
extern "C" void kernel_launch(void* const* d_in, const int* in_sizes, int n_in, void* d_out, int out_size, void* d_ws, size_t ws_size, hipStream_t stream) {
    static int grid = 0;
    if (grid == 0) {
        if (n_in != 24 || out_size != T * D || ws_size < WS_END) { fprintf(stderr, "kernel_launch: unexpected shapes (n_in %d out %d ws %zu)\n", n_in, out_size, ws_size); grid = -1; return; }
        int dev = 0, cus = 0, per_cu = 0;
        if (hipGetDevice(&dev) != hipSuccess || hipDeviceGetAttribute(&cus, hipDeviceAttributeMultiprocessorCount, dev) != hipSuccess) { grid = -1; return; }
        if (hipFuncSetAttribute((const void*)fwd_kernel, hipFuncAttributeMaxDynamicSharedMemorySize, LDS_BYTES) != hipSuccess) { fprintf(stderr, "kernel_launch: hipFuncSetAttribute failed\n"); grid = -1; return; }
        if (hipOccupancyMaxActiveBlocksPerMultiprocessor(&per_cu, (const void*)fwd_kernel, NWAVES * 64, LDS_BYTES) != hipSuccess || per_cu < 1) { fprintf(stderr, "kernel_launch: occupancy query says %d\n", per_cu); }
        (void)hipGetLastError();
        grid = cus;
    }
    if (grid < 0) return;
    (void)hipMemsetAsync((char*)d_ws + WS_CTL, 0, CTL_ZERO_BYTES, stream);
    Args a{};
    for (int i = 0; i < 24; ++i) a.in[i] = (const float*)d_in[i];
    a.out = (float*)d_out; a.ws = (unsigned char*)d_ws;
    constexpr int NPH = 1 + 11 * DEPTH;
#if N_LAUNCH_MODE == 1
    a.ph_lo = 0; a.ph_hi = NPH;
    hipLaunchKernelGGL(fwd_kernel, dim3(grid), dim3(NWAVES * 64), LDS_BYTES, stream, a);
#else
    for (int p = 0; p < NPH; ++p) { a.ph_lo = p; a.ph_hi = p + 1; hipLaunchKernelGGL(fwd_kernel, dim3(grid), dim3(NWAVES * 64), LDS_BYTES, stream, a); }
#endif
    const hipError_t le = hipPeekAtLastError();
    if (le != hipSuccess) fprintf(stderr, "kernel_launch: launch failed: %s\n", hipGetErrorName(le));
}
```

```cpp
#include <hip/hip_runtime.h>
#include <cstdio>
#include <cstdint>

__device__ __forceinline__ int lane_id() { return (int)__builtin_amdgcn_mbcnt_hi(~0u, __builtin_amdgcn_mbcnt_lo(~0u, 0u)); }
namespace pg8 {
#define PG8_LAS __attribute__((address_space(3)))
typedef unsigned short bf16_t;
typedef short bf16x8 __attribute__((ext_vector_type(8)));
typedef float f32x4 __attribute__((ext_vector_type(4)));
typedef unsigned u32x4 __attribute__((ext_vector_type(4)));
typedef unsigned u32x2 __attribute__((ext_vector_type(2)));
constexpr int BM = 256, BK = 64, HALF = 128, HTB = HALF * BK * 2  , STAGE_BYTES = 8 * HTB, NXCD = 8, WGM = 8;

__host__ __device__ __forceinline__ int lds_byte(int r, int c) { const int st = (r >> 4) * 2 + (c >> 5), rr = r & 15, cc = c & 31, ob = rr * 64 + cc * 2; return st * 1024 + (ob ^ (((ob >> 9) & 1) << 5)); }
__host__ __device__ __forceinline__ void stage_rc(int b, int& R, int& C) { const int st = b / 1024, sb = b % 1024, swz = sb ^ (((sb >> 9) & 1) << 5); R = (st >> 1) * 16 + swz / 64; C = (st & 1) * 32 + (swz % 64) / 2; }
__host__ __device__ __forceinline__ int perm32(int rho) { const int n = rho >> 4, i = rho & 15; return 8 * (i >> 2) + 4 * n + (i & 3); }

struct Unit { int pm, pn, koff, nt, seg; };
struct Gemm { const bf16_t* A; const bf16_t* Bt; int M, N, K; };

struct StaticOrder {
    static constexpr bool GATHER = false;
    int nM, nN, nwg, G, c, nt0;
    __device__ __forceinline__ int row_token(const Unit&, int) const { return 0; }
    __device__ void init(int M, int N, int K, int G_, int c_) { nM = M / BM; nN = N / BM; nwg = nM * nN; G = G_; c = c_; nt0 = K / BK; }
    __device__ bool tile(long L, Unit& u) const {
        if (L >= nwg) return false;
        int wgid = (int)L; { const int q = nwg / NXCD, r = nwg % NXCD, xcd = wgid % NXCD, off = wgid / NXCD; wgid = (xcd < r ? xcd * (q + 1) : r * (q + 1) + (xcd - r) * q) + off; }
        const int nig = WGM * nN, gid = wgid / nig, fm = gid * WGM, gsz = (nM - fm) < WGM ? (nM - fm) : WGM;
        u.pm = fm + ((wgid % nig) % gsz); u.pn = (wgid % nig) / gsz; return true;
    }
    __device__ bool next(int i, Unit& u) const { u.koff = 0; u.nt = nt0; u.seg = 0; return tile((long)i * G + c, u); }
    __device__ __forceinline__ void a_ready(const Unit&) const {}
    __device__ __forceinline__ void done(const Unit&) const {}
};
struct MergeOrder : StaticOrder {
    __device__ bool next(int i, Unit& u) const { const int rnd = i / 3, sg = i - 3 * rnd; u.seg = sg; u.koff = sg == 0 ? 0 : (sg == 1 ? 512 : 1536); u.nt = sg == 1 ? 16 : 8; return tile((long)rnd * G + c, u); }
};
struct MoeOrder {
    static constexpr bool GATHER = false;
    int total, G, c, NJ, nt0; const PG8_LAS int* tile_exp;
    __device__ bool next(int i, Unit& u) const {
        const long L = (long)i * G + c; if (L >= total) return false;
        const int R = (int)L / NJ, j = (int)L % NJ; u.pm = R; u.pn = tile_exp[R] * NJ + j; u.koff = 0; u.nt = nt0; u.seg = 0; return true;
    }
    __device__ __forceinline__ int row_token(const Unit&, int) const { return 0; }
    __device__ __forceinline__ void a_ready(const Unit&) const {}
    __device__ __forceinline__ void done(const Unit&) const {}
};
struct MoeGatherOrder : MoeOrder {
    static constexpr bool GATHER = true;
    const PG8_LAS int* pst; const PG8_LAS int* cnt; const int* liste;
    __device__ __forceinline__ int row_token(const Unit& u, int r) const {
        const int e = tile_exp[u.pm], lr = u.pm * 256 - pst[e] + r;
        return lr < cnt[e] ? liste[(size_t)e * 32768 + lr] : 0;
    }
};

typedef __bf16 bf16x2v __attribute__((ext_vector_type(2)));
typedef float f32x2v __attribute__((ext_vector_type(2)));
__device__ __forceinline__ unsigned cvt_pk_bf16(float lo, float hi) { const f32x2v v = {lo, hi}; const bf16x2v b = __builtin_convertvector(v, bf16x2v); return __builtin_bit_cast(unsigned, b); }
__device__ __forceinline__ float bflo(unsigned w) { return __uint_as_float(w << 16); }
__device__ __forceinline__ float bfhi(unsigned w) { return __uint_as_float(w & 0xffff0000u); }
__device__ __forceinline__ float sigm(float v) { return __builtin_amdgcn_rcpf(1.0f + __builtin_amdgcn_exp2f(-1.44269504f * v)); }
__device__ __forceinline__ unsigned q8x4(const f32x4 s) {
    const unsigned a = (unsigned)fminf(s[0] * 256.0f, 255.5f), b = (unsigned)fminf(s[1] * 256.0f, 255.5f), c = (unsigned)fminf(s[2] * 256.0f, 255.5f), d = (unsigned)fminf(s[3] * 256.0f, 255.5f);
    return a | (b << 8) | (c << 16) | (d << 24);
}

constexpr int ZP = 5120;
constexpr int ZC_GA = 5120, ZC_GB = 7168, ZC_GC = 9216;
constexpr size_t GT_TILE = 65536, GT_GATE = (size_t)128 * 8 * GT_TILE;

template <int PN_OFF> struct EpiInProj {
    static constexpr bool PERM = true, AFTER_DRAIN = false, CHAIN = false;
    bf16_t* O; unsigned char* GT; PG8_LAS unsigned long long* ss;
    const PG8_LAS float* gains;
    __device__ __forceinline__ void operator()(const f32x4 (&acc)[2][2][4][2], const Unit& u, int wr, int wc, int fr, int fq) const {
        const int pn = PN_OFF ? u.pn + 13 : (u.pn < 13 ? u.pn : u.pn + 3);
        int row0 = u.pm * BM + wr * 64 + fr, col0 = pn * BM + wc * 32 + 8 * fq;
        asm volatile("" : "+v"(row0), "+v"(col0));
        const int act = pn >= 20 ? 2 : (pn >= 18 ? 1 : 0);
        const bool hn = PN_OFF == 0 && pn <= 7;
        f32x4 gn0 = (f32x4){1.f, 1.f, 1.f, 1.f}, gn1 = gn0; int lr = 0;
        if (hn) {
            lr = wr * 64 + fr; asm volatile("" : "+v"(lr));
#pragma unroll
            for (int ai = 0; ai < 2; ++ai)
#pragma unroll
                for (int m = 0; m < 4; ++m)
#pragma unroll
                    for (int bj = 0; bj < 2; ++bj) { const f32x4 a = acc[ai][bj][m][0], b = acc[ai][bj][m][1];
                        float s = (a[0] * a[0] + a[1] * a[1]) + (a[2] * a[2] + a[3] * a[3]) + (b[0] * b[0] + b[1] * b[1]) + (b[2] * b[2] + b[3] * b[3]);
                        s += __shfl_xor(s, 16); s += __shfl_xor(s, 32);
                        if (fq == 0) __hip_atomic_fetch_add(ss + (ai * HALF + m * 16 + lr) * 2 + bj, (unsigned long long)(s * 1048576.0f), __ATOMIC_RELAXED, __HIP_MEMORY_SCOPE_WORKGROUP); }
            asm volatile("s_waitcnt lgkmcnt(0)" ::: "memory"); __builtin_amdgcn_s_barrier(); asm volatile("" ::: "memory");
            const PG8_LAS float* gp = gains + (pn <= 1 ? 0 : (pn == 2 ? 128 : (pn <= 6 ? 256 : 384))) + wc * 32 + 8 * fq;
            gn0 = *(const PG8_LAS f32x4*)gp; gn1 = *(const PG8_LAS f32x4*)(gp + 4);
        }
        if (act == 2) {
            int lo16 = (wr * 4 + wc) * 8192 + (fq * 16 + fr) * 16; asm volatile("" : "+v"(lo16));
            unsigned char* gp = GT + (size_t)((pn - 20) >> 3) * GT_GATE + ((size_t)u.pm * 8 + ((pn - 20) & 7)) * GT_TILE + lo16;
#pragma unroll
            for (int ai = 0; ai < 2; ++ai)
#pragma unroll
                for (int m = 0; m < 4; ++m) { u32x4 w;
#pragma unroll
                    for (int bj = 0; bj < 2; ++bj) { const f32x4 v0 = acc[ai][bj][m][0] * 0.015625f, v1 = acc[ai][bj][m][1] * 0.015625f; f32x4 s0, s1;
#pragma unroll
                        for (int j = 0; j < 4; ++j) { s0[j] = sigm(v0[j]); s1[j] = sigm(v1[j]); }
                        w[2 * bj] = q8x4(s0); w[2 * bj + 1] = q8x4(s1); }
                    *(u32x4*)(gp + (ai * 4 + m) * 1024) = w; }
            return;
        }
#pragma unroll
        for (int ai = 0; ai < 2; ++ai)
#pragma unroll
            for (int m = 0; m < 4; ++m) { bf16_t* rowp = O + (size_t)(row0 + ai * HALF + m * 16) * ZP + col0;
#pragma unroll
                for (int bj = 0; bj < 2; ++bj) { f32x4 v0 = acc[ai][bj][m][0], v1 = acc[ai][bj][m][1];
                    if (hn && !(pn == 2 && bj == 1)) { const float r = rsqrtf((float)ss[(ai * HALF + m * 16 + lr) * 2 + bj] * (0.015625f * 0.015625f / 128.0f / 1048576.0f) + 1e-6f) * 0.015625f;
                        v0 = v0 * r * gn0; v1 = v1 * r * gn1; }
                    else if (PN_OFF == 0) { v0 = v0 * 0.015625f; v1 = v1 * 0.015625f; }
                    if (act) {
#pragma unroll
                        for (int j = 0; j < 4; ++j) { v0[j] *= sigm(v0[j]); v1[j] *= sigm(v1[j]); } }
                    u32x4 w; w.x = cvt_pk_bf16(v0[0], v0[1]); w.y = cvt_pk_bf16(v0[2], v0[3]); w.z = cvt_pk_bf16(v1[0], v1[1]); w.w = cvt_pk_bf16(v1[2], v1[3]);
                    *(u32x4*)(rowp + bj * HALF) = w; } }
        if (hn) { asm volatile("s_waitcnt lgkmcnt(0)" ::: "memory"); __builtin_amdgcn_s_barrier(); asm volatile("" ::: "memory");
            ss[(wr * 4 + wc) * 64 + fq * 16 + fr] = 0ull; }
    }
};
template <int MODE = 0> struct EpiMergeT {
    static constexpr bool PERM = true, AFTER_DRAIN = false, CHAIN = true;
    const unsigned char* GT; bf16_t* O;
    __device__ __forceinline__ void operator()(f32x4 (&acc)[2][2][4][2], const Unit& u, int wr, int wc, int fr, int fq) const {
        if (MODE == 2) return;
        const int row0 = u.pm * BM + wr * 64 + fr, col0 = u.pn * BM + wc * 32 + 8 * fq;
        int lo16 = (wr * 4 + wc) * 8192 + (fq * 16 + fr) * 16; asm volatile("" : "+v"(lo16));
        const unsigned char* gp = GT + ((size_t)u.pm * 8 + u.pn) * GT_TILE + lo16;
        const size_t cn = (size_t)u.seg * GT_GATE, cd = (size_t)(u.seg == 0 ? 1 : 2) * GT_GATE;
        const bool fin = u.seg == 2;
        u32x4 gn[2][4], gd[2][4];
#pragma unroll
        for (int ai = 0; ai < 2; ++ai)
#pragma unroll
            for (int m = 0; m < 4; ++m) {
                if (MODE == 1) { gn[ai][m] = (u32x4){0x80808080u + (unsigned)u.pm, 0x80808080u, 0x80808080u, 0x80808080u}; gd[ai][m] = gn[ai][m]; } else {
                gn[ai][m] = *(const u32x4*)(gp + cn + (ai * 4 + m) * 1024); gd[ai][m] = *(const u32x4*)(gp + cd + (ai * 4 + m) * 1024); } }
#pragma unroll
        for (int ai = 0; ai < 2; ++ai)
#pragma unroll
            for (int m = 0; m < 4; ++m)
#pragma unroll
                for (int bj = 0; bj < 2; ++bj) { const size_t r = (size_t)(row0 + ai * HALF + m * 16);
#pragma unroll
                    for (int w = 0; w < 2; ++w)
#pragma unroll
                        for (int k = 0; k < 4; ++k) { const float qn = (float)((gn[ai][m][2 * bj + w] >> (8 * k)) & 0xffu) + 0.5f, qd = (float)((gd[ai][m][2 * bj + w] >> (8 * k)) & 0xffu) + 0.5f;
                            acc[ai][bj][m][w][k] *= qn * __builtin_amdgcn_rcpf(fin ? 256.0f : qd); }
                    if (fin) { const f32x4 v0 = acc[ai][bj][m][0], v1 = acc[ai][bj][m][1];
                        u32x4 w; w.x = cvt_pk_bf16(v0[0], v0[1]); w.y = cvt_pk_bf16(v0[2], v0[3]); w.z = cvt_pk_bf16(v1[0], v1[1]); w.w = cvt_pk_bf16(v1[2], v1[3]);
                        *(u32x4*)(O + r * 2048 + col0 + bj * HALF) = w; } }
    }
};
typedef EpiMergeT<0> EpiMerge;
struct EpiResid {
    static constexpr int PERM = 2; static constexpr bool AFTER_DRAIN = false, CHAIN = false;
    bf16_t* hb; unsigned char* xu; const float* gain; PG8_LAS unsigned char* stg;
    __device__ __forceinline__ void operator()(const f32x4 (&acc)[2][2][4][2], const Unit& u, int wr, int wc, int fr, int fq) const {
        int lane = fq * 16 + fr; asm volatile("" : "+v"(lane));
        PG8_LAS unsigned char* s0 = stg + (wr * 4 + wc) * 1024;
        const int r8 = lane >> 3, pc = lane & 7;
        const int offc = r8 * 128 + ((pc ^ r8) << 4);
        const int offa0 = (fr >> 3) * 8192 + (fr & 7) * 128 + ((fq ^ (fr & 7)) << 4), offa1 = (fr >> 3) * 8192 + (fr & 7) * 128 + (((4 + fq) ^ (fr & 7)) << 4);
        const int xs = 2 * (fr >> 2), offxw0 = fr * 64 + ((fq ^ xs) << 3), offxw1 = fr * 64 + (((4 + fq) ^ xs) << 3);
        const int xr = lane >> 2, xq = lane & 3, offxr = xr * 64 + (((2 * xq) ^ (2 * (xr >> 2))) << 3);
        const size_t goff = (size_t)(u.pm * BM + wr * 64 + r8) * 2048 + u.pn * BM + wc * 64 + pc * 8;
        const size_t xoff = (size_t)(u.pm * BM + wr * 64 + xr) * 2048 + u.pn * BM + wc * 64 + xq * 16;
        f32x4 gv[2][2];
#pragma unroll
        for (int bj = 0; bj < 2; ++bj)
#pragma unroll
            for (int n = 0; n < 2; ++n) gv[bj][n] = *(const f32x4*)(gain + u.pn * BM + wc * 64 + bj * 32 + 8 * fq + 4 * n);
        const f32x4 lo4 = (f32x4){-440.f, -440.f, -440.f, -440.f}, hi4 = (f32x4){440.f, 440.f, 440.f, 440.f};
#pragma unroll
        for (int ai = 0; ai < 2; ++ai) {
            u32x4 bb[4][2];
#pragma unroll
            for (int m = 0; m < 4; ++m)
#pragma unroll
                for (int j = 0; j < 2; ++j) bb[m][j] = *(const u32x4*)(hb + goff + (size_t)(ai * HALF + m * 16 + 8 * j) * 2048);
#pragma unroll
            for (int m = 0; m < 4; ++m) {
                *(PG8_LAS u32x4*)(s0 + offc) = bb[m][0]; *(PG8_LAS u32x4*)(s0 + 8192 + offc) = bb[m][1];
                asm volatile("" ::: "memory");
                const u32x4 a0 = *(const PG8_LAS u32x4*)(s0 + offa0), a1 = *(const PG8_LAS u32x4*)(s0 + offa1);
                asm volatile("" ::: "memory");
                u32x2 xw[2];
#pragma unroll
                for (int bj = 0; bj < 2; ++bj) { const u32x4 w = bj ? a1 : a0;
                    const f32x4 h0 = (f32x4){bflo(w.x), bfhi(w.x), bflo(w.y), bfhi(w.y)} + acc[ai][bj][m][0], h1 = (f32x4){bflo(w.z), bfhi(w.z), bflo(w.w), bfhi(w.w)} + acc[ai][bj][m][1];
                    u32x4 hw; hw.x = cvt_pk_bf16(h0[0], h0[1]); hw.y = cvt_pk_bf16(h0[2], h0[3]); hw.z = cvt_pk_bf16(h1[0], h1[1]); hw.w = cvt_pk_bf16(h1[2], h1[3]);
                    *(PG8_LAS u32x4*)(s0 + (bj ? offa1 : offa0)) = hw;
                    const f32x4 x0 = __builtin_elementwise_min(__builtin_elementwise_max(h0 * gv[bj][0], lo4), hi4), x1 = __builtin_elementwise_min(__builtin_elementwise_max(h1 * gv[bj][1], lo4), hi4);
                    int w0 = 0, w1 = 0;
                    w0 = __builtin_amdgcn_cvt_pk_fp8_f32(x0[0], x0[1], w0, false); w0 = __builtin_amdgcn_cvt_pk_fp8_f32(x0[2], x0[3], w0, true);
                    w1 = __builtin_amdgcn_cvt_pk_fp8_f32(x1[0], x1[1], w1, false); w1 = __builtin_amdgcn_cvt_pk_fp8_f32(x1[2], x1[3], w1, true);
                    xw[bj] = (u32x2){(unsigned)w0, (unsigned)w1}; }
                asm volatile("" ::: "memory");
                const u32x4 o0 = *(const PG8_LAS u32x4*)(s0 + offc), o1 = *(const PG8_LAS u32x4*)(s0 + 8192 + offc);
                asm volatile("" ::: "memory");
                *(PG8_LAS u32x2*)(s0 + offxw0) = xw[0]; *(PG8_LAS u32x2*)(s0 + offxw1) = xw[1];
                asm volatile("" ::: "memory");
                const u32x4 xo = *(const PG8_LAS u32x4*)(s0 + offxr);
                asm volatile("" ::: "memory");
                *(u32x4*)(hb + goff + (size_t)(ai * HALF + m * 16) * 2048) = o0; *(u32x4*)(hb + goff + (size_t)(ai * HALF + m * 16 + 8) * 2048) = o1;
                *(u32x4*)(xu + xoff + (size_t)(ai * HALF + m * 16) * 2048) = xo;
            }
        }
        asm volatile("s_waitcnt lgkmcnt(0)" ::: "memory");
    }
};
struct EpiGlu {
    static constexpr bool PERM = false, AFTER_DRAIN = false, CHAIN = false;
    bf16_t* H; const PG8_LAS int* tile_exp; const PG8_LAS int* pst; const PG8_LAS int* cnt; const int* liste; const float* rstd;
    __device__ __forceinline__ void operator()(const f32x4 (&acc)[2][2][4][2], const Unit& u, int wr, int wc, int fr, int fq) const {
        const int row0 = u.pm * BM + wr * 64 + fr, pj = u.pn & 3;
        const int e = tile_exp[u.pm], lr0 = u.pm * 256 - pst[e] + wr * 64 + fr, ce = cnt[e];
        int tok[2][4]; float rs[2][4];
#pragma unroll
        for (int ai = 0; ai < 2; ++ai)
#pragma unroll
            for (int m = 0; m < 4; ++m) { const int lr = lr0 + ai * HALF + m * 16; tok[ai][m] = lr < ce ? liste[(size_t)e * 32768 + lr] : 0; }
#pragma unroll
        for (int ai = 0; ai < 2; ++ai)
#pragma unroll
            for (int m = 0; m < 4; ++m) rs[ai][m] = rstd[tok[ai][m]] * 0.015625f;
#pragma unroll
        for (int ai = 0; ai < 2; ++ai)
#pragma unroll
            for (int m = 0; m < 4; ++m) { unsigned char* rowp = (unsigned char*)H + (size_t)(row0 + ai * HALF + m * 16) * 512; const float r = rs[ai][m];
#pragma unroll
                for (int bj = 0; bj < 2; ++bj) { const f32x4 a = acc[ai][bj][m][0] * r, b = acc[ai][bj][m][1] * r;
                    const int hc = 16 * (8 * pj + 4 * bj + wc) + 4 * fq;
                    float hv[4];
#pragma unroll
                    for (int j = 0; j < 4; ++j) hv[j] = fminf(fmaxf(a[j] * sigm(a[j]) * b[j] * 8.0f, -440.0f), 440.0f);
                    int w = 0; w = __builtin_amdgcn_cvt_pk_fp8_f32(hv[0], hv[1], w, false); w = __builtin_amdgcn_cvt_pk_fp8_f32(hv[2], hv[3], w, true);
                    *(int*)(rowp + hc) = w; } }
    }
};
struct EpiY {
    static constexpr bool PERM = true, AFTER_DRAIN = false, CHAIN = false;
    unsigned char* Y;
    __device__ __forceinline__ void operator()(const f32x4 (&acc)[2][2][4][2], const Unit& u, int wr, int wc, int fr, int fq) const {
        const int row0 = u.pm * BM + wr * 64 + fr, col0 = (u.pn & 7) * BM + wc * 32 + 8 * fq;
        const f32x4 lo4 = (f32x4){-440.f, -440.f, -440.f, -440.f}, hi4 = (f32x4){440.f, 440.f, 440.f, 440.f};
#pragma unroll
        for (int ai = 0; ai < 2; ++ai)
#pragma unroll
            for (int m = 0; m < 4; ++m) { unsigned char* rowp = Y + (size_t)(row0 + ai * HALF + m * 16) * 2048 + col0;
#pragma unroll
                for (int bj = 0; bj < 2; ++bj) {
                    const f32x4 v0 = __builtin_elementwise_min(__builtin_elementwise_max(acc[ai][bj][m][0] * 0.125f, lo4), hi4), v1 = __builtin_elementwise_min(__builtin_elementwise_max(acc[ai][bj][m][1] * 0.125f, lo4), hi4);
                    int w0 = 0, w1 = 0;
                    w0 = __builtin_amdgcn_cvt_pk_fp8_f32(v0[0], v0[1], w0, false); w0 = __builtin_amdgcn_cvt_pk_fp8_f32(v0[2], v0[3], w0, true);
                    w1 = __builtin_amdgcn_cvt_pk_fp8_f32(v1[0], v1[1], w1, false); w1 = __builtin_amdgcn_cvt_pk_fp8_f32(v1[2], v1[3], w1, true);
                    *(u32x2*)(rowp + bj * HALF) = (u32x2){(unsigned)w0, (unsigned)w1}; } }
    }
};

typedef int v4i_t __attribute__((ext_vector_type(4)));
typedef int v8i_t __attribute__((ext_vector_type(8)));
template <class Epi, class Sched, bool ALIGN_EPI = false, bool FP8 = false>
__device__ __forceinline__ void gemm_phase(PG8_LAS unsigned char* lds, const Gemm g, const Sched& S, const Epi& E) {
    int tid = threadIdx.x; asm volatile("" : "+v"(tid));
    const int wid = __builtin_amdgcn_readfirstlane(tid >> 6), lane = tid & 63, wr = wid >> 2, wc = wid & 3, fr = lane & 15, fq = lane >> 4;
    const int K = g.K;
    unsigned voffA[2], voffB[2]; int RA[2]; unsigned CA2[2];
#pragma unroll
    for (int i = 0; i < 2; ++i) { int R, C; stage_rc(tid * 16 + i * 8192, R, C); const int Rb = Epi::PERM == 2 ? ((R >> 5) * 64 + perm32(R & 31)) : (Epi::PERM ? ((R & ~31) + perm32(R & 31)) : R);
        voffA[i] = (unsigned)(R * K + C) * 2u; voffB[i] = (unsigned)(Rb * K + C) * 2u; RA[i] = R; CA2[i] = (unsigned)C * 2u; }
    unsigned gAc[2][2], gAn[2][2];
#define PG8_GOFF(dst, uu) do { _Pragma("unroll") for (int h_ = 0; h_ < 2; ++h_) _Pragma("unroll") for (int i_ = 0; i_ < 2; ++i_) dst[h_][i_] = (unsigned)S.row_token(uu, 128 * h_ + RA[i_]) * (unsigned)(K * 2) + CA2[i_]; } while (0)
#define PG8_STAGE_A(bufoff, gbase, half, garr) do { if constexpr (Sched::GATHER) PG8_STAGE(bufoff, gbase, garr); else PG8_STAGE(bufoff, (gbase) + (half) * hstep, voffA); } while (0)
    const size_t kstep = (size_t)(BK * 2);
    const size_t hstep = (size_t)HALF * K * 2;
    const size_t hstepB = Epi::PERM == 2 ? (size_t)32 * K * 2 : hstep;
    const size_t tstep = 2 * hstep;
    const unsigned ldsw = (unsigned)wid * 1024u;
    const int aoff = lds_byte(wr * 64 + fr, fq * 8), boff = lds_byte(wc * 32 + fr, fq * 8);
#define PG8_SA(b, h) (((b) * 2 + (h)) * HTB)
#define PG8_SB(b, h) ((4 + (b) * 2 + (h)) * HTB)
#define PG8_STAGE(bufoff, gbase, voff) do { _Pragma("unroll") for (int _i = 0; _i < 2; ++_i) \
        __builtin_amdgcn_global_load_lds((const unsigned*)((const char*)(gbase) + (voff)[_i]), (PG8_LAS unsigned*)(lds + (bufoff) + ldsw + _i * 8192), 16, 0, 0); } while (0)
#define PG8_LDA(dst, b, h) do { if constexpr (FP8) { _Pragma("unroll") for (int m = 0; m < 4; ++m) dst##8[m] = __builtin_shufflevector(*(const PG8_LAS v4i_t*)(lds + PG8_SA(b, h) + aoff + m * 2048), *(const PG8_LAS v4i_t*)(lds + PG8_SA(b, h) + aoff + m * 2048 + 1024), 0, 1, 2, 3, 4, 5, 6, 7); } \
        else { _Pragma("unroll") for (int m = 0; m < 4; ++m) _Pragma("unroll") for (int k = 0; k < 2; ++k) dst[m][k] = *(const PG8_LAS bf16x8*)(lds + PG8_SA(b, h) + aoff + m * 2048 + k * 1024); } } while (0)
#define PG8_LDB(dst, b, h) do { if constexpr (FP8) { _Pragma("unroll") for (int n = 0; n < 2; ++n) dst##8[n] = __builtin_shufflevector(*(const PG8_LAS v4i_t*)(lds + PG8_SB(b, h) + boff + n * 2048), *(const PG8_LAS v4i_t*)(lds + PG8_SB(b, h) + boff + n * 2048 + 1024), 0, 1, 2, 3, 4, 5, 6, 7); } \
        else { _Pragma("unroll") for (int n = 0; n < 2; ++n) _Pragma("unroll") for (int k = 0; k < 2; ++k) dst[n][k] = *(const PG8_LAS bf16x8*)(lds + PG8_SB(b, h) + boff + n * 2048 + k * 1024); } } while (0)
#define PG8_MMA(ai, bj, At, Bt) do { __builtin_amdgcn_s_setprio(1); _Pragma("unroll") for (int m = 0; m < 4; ++m) _Pragma("unroll") for (int n = 0; n < 2; ++n) { \
        if constexpr (FP8) asm volatile("v_mfma_f32_16x16x128_f8f6f4 %0, %1, %2, %0" : "+v"(acc[ai][bj][m][n]) : "v"(Bt##8[n]), "v"(At##8[m])); \
        else { _Pragma("unroll") for (int k = 0; k < 2; ++k) acc[ai][bj][m][n] = __builtin_amdgcn_mfma_f32_16x16x32_bf16(Bt[n][k], At[m][k], acc[ai][bj][m][n], 0, 0, 0); } } \
        __builtin_amdgcn_s_setprio(0); } while (0)
#define PG8_WAIT_V(n) asm volatile("s_waitcnt vmcnt(" #n ")" ::: "memory")
#define PG8_WAIT_L(n) asm volatile("s_waitcnt lgkmcnt(" #n ")" ::: "memory")
#define PG8_BAR __builtin_amdgcn_s_barrier()
#define PG8_SCHED __builtin_amdgcn_sched_barrier(0)
    Unit cur, nxt; int ui = 0;
    if (!S.next(0, cur)) return;
    f32x4 acc[2][2][4][2];
#pragma unroll
    for (int a = 0; a < 2; ++a)
#pragma unroll
        for (int b = 0; b < 2; ++b)
#pragma unroll
            for (int m = 0; m < 4; ++m)
#pragma unroll
                for (int n = 0; n < 2; ++n) acc[a][b][m][n] = (f32x4){0.f, 0.f, 0.f, 0.f};
    bf16x8 At[4][2], B0[2][2], B1[2][2]; v8i_t At8[4], B08[2], B18[2];
    const size_t tstepA = Sched::GATHER ? (size_t)0 : tstep;
    const char* cA = (const char*)g.A + (size_t)cur.pm * tstepA + (size_t)cur.koff * 2; const char* cB = (const char*)g.Bt + (size_t)cur.pn * tstep + (size_t)cur.koff * 2;
    S.a_ready(cur);
    if constexpr (Sched::GATHER) { PG8_GOFF(gAc, cur); }
    PG8_STAGE(PG8_SB(0, 0), cB, voffB); PG8_STAGE(PG8_SB(0, 1), cB + hstepB, voffB); PG8_STAGE_A(PG8_SA(0, 0), cA, 0, gAc[0]); PG8_STAGE_A(PG8_SA(0, 1), cA, 1, gAc[1]);
    if (wr == 1) PG8_BAR;
    PG8_WAIT_V(2); PG8_BAR;
    PG8_STAGE(PG8_SB(1, 0), cB + kstep, voffB); PG8_STAGE_A(PG8_SA(1, 0), cA + kstep, 0, gAc[0]); PG8_STAGE(PG8_SB(1, 1), cB + hstepB + kstep, voffB);
    PG8_WAIT_V(6); PG8_BAR;
    for (;;) {
        const bool has_next = S.next(ui + 1, nxt);
        const char* nA = has_next ? (const char*)g.A + (size_t)nxt.pm * tstepA + (size_t)nxt.koff * 2 : cA; const char* nB = has_next ? (const char*)g.Bt + (size_t)nxt.pn * tstep + (size_t)nxt.koff * 2 : cB;
        if constexpr (Sched::GATHER) { if (has_next) { PG8_GOFF(gAn, nxt); } else {
#pragma unroll
            for (int h_ = 0; h_ < 2; ++h_)
#pragma unroll
                for (int i_ = 0; i_ < 2; ++i_) gAn[h_][i_] = gAc[h_][i_]; } }
        const int nt = cur.nt;
        for (int t = 0; t < nt; t += 2) {
            const bool last = (t == nt - 2);
            const char* a1 = cA + (size_t)(t + 1) * kstep;
            const char* a2 = last ? nA : cA + (size_t)(t + 2) * kstep; const char* b2 = last ? nB : cB + (size_t)(t + 2) * kstep;
            const char* a3 = a2 + kstep; const char* b3 = b2 + kstep;
            if (last && has_next) S.a_ready(nxt);
            unsigned g2a[2][2];
            if constexpr (Sched::GATHER) {
#pragma unroll
                for (int h_ = 0; h_ < 2; ++h_)
#pragma unroll
                    for (int i_ = 0; i_ < 2; ++i_) g2a[h_][i_] = last ? gAn[h_][i_] : gAc[h_][i_]; }
            PG8_LDB(B0, 0, 0); PG8_LDB(B1, 0, 1); PG8_SCHED; PG8_LDA(At, 0, 0); PG8_STAGE_A(PG8_SA(1, 1), a1, 1, gAc[1]);
            PG8_WAIT_V(8); PG8_WAIT_L(0); PG8_BAR; PG8_MMA(0, 0, At, B0); PG8_MMA(0, 1, At, B1); PG8_BAR; PG8_SCHED;
            PG8_LDA(At, 0, 1); PG8_STAGE(PG8_SB(0, 0), b2, voffB); PG8_STAGE(PG8_SB(0, 1), b2 + hstepB, voffB); PG8_STAGE_A(PG8_SA(0, 0), a2, 0, g2a[0]);
            PG8_WAIT_V(8); PG8_WAIT_L(0); PG8_BAR; PG8_MMA(1, 0, At, B0); PG8_MMA(1, 1, At, B1); PG8_BAR; PG8_SCHED;
            PG8_LDB(B0, 1, 0); PG8_LDB(B1, 1, 1); PG8_SCHED; PG8_LDA(At, 1, 0); PG8_STAGE_A(PG8_SA(0, 1), a2, 1, g2a[1]);
            PG8_WAIT_V(8); PG8_WAIT_L(0); PG8_BAR; PG8_MMA(0, 0, At, B0); PG8_MMA(0, 1, At, B1); PG8_BAR; PG8_SCHED;
            PG8_LDA(At, 1, 1); PG8_STAGE(PG8_SB(1, 0), b3, voffB); PG8_STAGE(PG8_SB(1, 1), b3 + hstepB, voffB); PG8_STAGE_A(PG8_SA(1, 0), a3, 0, g2a[0]);
            PG8_WAIT_V(8); PG8_WAIT_L(0); PG8_BAR; PG8_MMA(1, 0, At, B0); PG8_MMA(1, 1, At, B1); PG8_BAR; PG8_SCHED;
        }
        if constexpr (ALIGN_EPI) { if (wr == 0) PG8_BAR; }
        if constexpr (FP8) asm volatile("s_nop 15\n\ts_nop 15\n\ts_nop 15\n\ts_nop 15" ::: "memory");
        E(acc, cur, wr, wc, fr, fq); S.done(cur);
        if (!has_next) break;
        if (!Epi::CHAIN || cur.seg == 2)
#pragma unroll
        for (int a = 0; a < 2; ++a)
#pragma unroll
            for (int b = 0; b < 2; ++b)
#pragma unroll
                for (int m = 0; m < 4; ++m)
#pragma unroll
                    for (int n = 0; n < 2; ++n) acc[a][b][m][n] = (f32x4){0.f, 0.f, 0.f, 0.f};
        cur = nxt; cA = nA; cB = nB; ++ui;
        if constexpr (Sched::GATHER) {
#pragma unroll
            for (int h_ = 0; h_ < 2; ++h_)
#pragma unroll
                for (int i_ = 0; i_ < 2; ++i_) gAc[h_][i_] = gAn[h_][i_]; }
        if constexpr (ALIGN_EPI) { if (wr == 1) PG8_BAR; }
    }
    PG8_WAIT_V(0);
    if constexpr (!ALIGN_EPI) { if (wr == 0) PG8_BAR; }
    PG8_BAR;
#undef PG8_SA
#undef PG8_SB
#undef PG8_STAGE_A
#undef PG8_GOFF
#undef PG8_STAGE
#undef PG8_LDA
#undef PG8_LDB
#undef PG8_MMA
#undef PG8_WAIT_V
#undef PG8_WAIT_L
#undef PG8_BAR
#undef PG8_SCHED
}
}

constexpr int NWAVES = 8;
constexpr int T = 32768, SEQ = 2048, NB = 16, D = 2048, DEPTH = 2;
constexpr int ZP = pg8::ZP;
constexpr int ZC_AQ = 0, ZC_AK = 512, ZC_AV = 640, ZC_BQ = 768, ZC_BK = 1792, ZC_BV = 2048, ZC_IQ = 2304, ZC_IK = 3328, ZC_IW = 3392, ZC_CG = 3408, ZC_PAD = 3424, ZC_CQ = 3584, ZC_CK = 3840, ZC_CV = 4096, ZC_CR = 4608;
constexpr int D_IN = 11104;
constexpr int NEXP = 64, DEXP = 512, PMAX_TILES = 320;
constexpr float EPS = 1e-6f;

constexpr size_t MiB = 1u << 20;
constexpr size_t WS_CTL = 0, CTL_ZERO_BYTES = 1 * MiB;
constexpr size_t WS_ROUTE = 2 * MiB;
constexpr size_t WS_WRH = 4 * MiB, WS_WRL = 6 * MiB, WR_L = 96 * 2048 * 2;
constexpr size_t WS_WIN = 16 * MiB, WIN_L = 44 * MiB;
constexpr size_t WS_WBR = 104 * MiB, WBR_L = 8 * MiB;
constexpr size_t WS_WO = 120 * MiB, WO_L = 8 * MiB;
constexpr size_t WS_W13 = 136 * MiB;
constexpr size_t WS_HB = 264 * MiB;
constexpr size_t WS_W2 = 392 * MiB;
constexpr size_t WS_XN = 520 * MiB;
constexpr size_t WS_OCAT = 648 * MiB;
constexpr size_t WS_MERGED = 776 * MiB;
constexpr size_t WS_Z = 904 * MiB;
constexpr size_t WS_GT = 1224 * MiB;
constexpr size_t WS_S = 1608 * MiB;
constexpr size_t WS_MASK = 1864 * MiB;
constexpr size_t WS_GO = 1872 * MiB;
constexpr size_t WS_GCS = WS_GO;
constexpr size_t WS_GDEC = 8 * MiB;
constexpr size_t WS_RSTD = 9 * MiB;
constexpr size_t WS_LISTE = 904 * MiB;
constexpr size_t WS_XS = 904 * MiB;
constexpr size_t WS_Y = 1224 * MiB;
constexpr size_t WS_H = 1544 * MiB;
constexpr size_t WS_WG8 = 1936 * MiB, WG8_L = 12 * MiB;
constexpr size_t WS_XN8 = WS_S;
constexpr size_t WS_END = 1936 * MiB;
constexpr int CW_BAR = 4096;
constexpr int CW_CNT = 16384;

constexpr int RING_BYTES = 131072, MISC_OFF = RING_BYTES, LDS_BYTES = 155648;
constexpr int MO_BARW = 32, MO_GN = 256, MO_TEXP = 8192, MO_PST = 9728, MO_TOT = 9984, MO_TAB2 = 10240, MO_CNT = 16640, MO_SS = 16896;

#define GAS __attribute__((address_space(1)))
#define LAS __attribute__((address_space(3)))
typedef unsigned short bf16;
typedef unsigned v4u __attribute__((ext_vector_type(4)));
typedef unsigned v2u __attribute__((ext_vector_type(2)));
typedef float f32x4 __attribute__((ext_vector_type(4)));
#define LDS_WAIT() asm volatile("s_waitcnt lgkmcnt(0)" ::: "memory")
__device__ __forceinline__ unsigned f2bf(float f) { unsigned u = __builtin_bit_cast(unsigned, f); return (u + 0x7fffu + ((u >> 16) & 1u)) >> 16; }
__device__ __forceinline__ unsigned pk2(float lo, float hi) { return pg8::cvt_pk_bf16(lo, hi); }
__device__ __forceinline__ float bflo(unsigned w) { return __uint_as_float(w << 16); }
__device__ __forceinline__ float bfhi(unsigned w) { return __uint_as_float(w & 0xffff0000u); }
__device__ __forceinline__ float bf1(bf16 h) { return __uint_as_float(((unsigned)h) << 16); }

#define XB_TMO      128
#define XB_XCNT(j)  (256  + 64 * (j))
#define XB_XSUB(j)  (1280 + 64 * (j))
#define XB_XGEN(j)  (2304 + 64 * (j))
#define XB_TOP      3328
#define XB_TOPGEN   3392
#define XCD_BAR_WORDS 3456
#define XB_SPIN_CAP (1u << 18)
__device__ __forceinline__ unsigned xb_ld(unsigned* p)              { return __hip_atomic_load(p, __ATOMIC_RELAXED, __HIP_MEMORY_SCOPE_AGENT); }
__device__ __forceinline__ unsigned xb_add(unsigned* p, unsigned v) { return __hip_atomic_fetch_add(p, v, __ATOMIC_RELAXED, __HIP_MEMORY_SCOPE_AGENT); }
__device__ __forceinline__ unsigned xb_xcc_id() { return (unsigned)__builtin_amdgcn_s_getreg((3 << 11) | 20) & 0xFu; }
#define XB_SPIN(cond, bar) do { unsigned _sp = 0; while (cond) { __builtin_amdgcn_s_sleep(1); \
    if ((++_sp & 255u) == 0u) { if (xb_ld(&(bar)[XB_TMO])) break; if (_sp > XB_SPIN_CAP) { atomicAdd(&(bar)[XB_TMO], 1u); break; } } } } while (0)
struct XcdBarrier { unsigned* bar; unsigned x; volatile LAS unsigned* st; };
__device__ __forceinline__ XcdBarrier xcd_barrier_post(unsigned* bar, volatile LAS unsigned* st) {
    XcdBarrier b; b.bar = bar; b.x = xb_xcc_id(); b.st = st;
    if (threadIdx.x == 0) (void)xb_add(&bar[XB_XCNT(b.x)], 1u);
    return b;
}
__device__ __forceinline__ void xcd_barrier_complete(unsigned* bar, unsigned x, unsigned& nloc, unsigned& nx) {
    const unsigned G = gridDim.x * gridDim.y * gridDim.z;
    unsigned sum, cnt, mine, sp = 0u;
    for (;;) {
        sum = 0u; cnt = 0u; mine = 0u;
#pragma unroll
        for (unsigned j = 0; j < 16; ++j) { const unsigned c = xb_ld(&bar[XB_XCNT(j)]); sum += c; cnt += (c > 0u) ? 1u : 0u; mine = (j == x) ? c : mine; }
        if (sum == G) break;
        __builtin_amdgcn_s_sleep(1);
        if ((++sp & 255u) == 0u) { if (xb_ld(&bar[XB_TMO])) break; if (sp > XB_SPIN_CAP) { atomicAdd(&bar[XB_TMO], 1u); break; } }
    }
    nloc = mine > 0u ? mine : 1u; nx = cnt > 0u ? cnt : 1u;
}
__device__ __forceinline__ void xcd_barrier(const XcdBarrier& b) {
    asm volatile("s_waitcnt vmcnt(0)" ::: "memory");
    __syncthreads();
    if (threadIdx.x == 0) {
        unsigned* bar = b.bar;
        __builtin_amdgcn_s_waitcnt(0);
        unsigned nloc = b.st[0], nx = b.st[1];
        if (nloc == 0u) { xcd_barrier_complete(bar, b.x, nloc, nx); b.st[0] = nloc; b.st[1] = nx; }
        const unsigned old = xb_add(&bar[XB_XSUB(b.x)], 1u);
        const unsigned gen = old / nloc;
        if (old + 1u == (gen + 1u) * nloc) {
            __builtin_amdgcn_fence(__ATOMIC_RELEASE, "agent");
            asm volatile("s_waitcnt vmcnt(0)" ::: "memory");
            const unsigned og = xb_add(&bar[XB_TOP], 1u);
            const unsigned tg = og / nx;
            if (og + 1u == (tg + 1u) * nx) xb_add(&bar[XB_TOPGEN], 1u);
            else XB_SPIN(xb_ld(&bar[XB_TOPGEN]) == tg, bar);
            __builtin_amdgcn_fence(__ATOMIC_ACQUIRE, "agent");
            xb_add(&bar[XB_XGEN(b.x)], 1u);
            asm volatile("s_waitcnt vmcnt(0)" ::: "memory");
        } else {
            XB_SPIN(xb_ld(&bar[XB_XGEN(b.x)]) == gen, bar);
            __builtin_amdgcn_fence(__ATOMIC_ACQUIRE, "agent");
            asm volatile("s_waitcnt vmcnt(0)" ::: "memory");
        }
    }
    __syncthreads();
}

struct Args { const float* in[24]; float* out; unsigned char* ws; int ph_lo, ph_hi; };
enum { I_X = 0, I_RELB, I_N1G, I_WIN, I_AQG, I_AKG, I_BQG, I_BKG, I_SINK, I_CGW, I_CGB, I_CNG, I_WBA, I_WBB, I_WBC, I_WO, I_N2G, I_WRG, I_BRG, I_WRE, I_BRE, I_W1, I_W3, I_W2 };

struct Frame {
    LAS unsigned char* lds; LAS unsigned char* misc;
    unsigned* ctl;
    int tid, lane, wave, vcu, G, gw, NGW;
    const float* const* in; float* out; unsigned char* ws;
    bf16 *Z, *XN, *OCAT, *MERGED, *XS, *Y, *H;
    float *S, *GO; unsigned* MASK;
};

__device__ __forceinline__ float wave_sum(float v) {
#pragma unroll
    for (int o = 1; o < 64; o <<= 1) v += __shfl_xor(v, o);
    return v;
}
__device__ __forceinline__ float wave_max(float v) {
#pragma unroll
    for (int o = 1; o < 64; o <<= 1) v = fmaxf(v, __shfl_xor(v, o));
    return v;
}

template <class MAP>
__device__ __forceinline__ void transpose_item(const float* W, int N, bf16* WT, int dpitch, int koff, LAS float* scr, int item, int lane, const MAP& map) {
    const int nblk = N / 32, kb = item / nblk, nb = item % nblk, k0 = 64 * kb, n0 = 32 * nb;
    f32x4 v[8];
#pragma unroll
    for (int i = 0; i < 8; ++i) v[i] = *(const f32x4*)(W + (size_t)(k0 + 8 * i + (lane >> 3)) * N + n0 + 4 * (lane & 7));
#pragma unroll
    for (int i = 0; i < 8; ++i) { LAS float* d = scr + (8 * i + (lane >> 3)) * 33 + 4 * (lane & 7); d[0] = v[i].x; d[1] = v[i].y; d[2] = v[i].z; d[3] = v[i].w; }
    LDS_WAIT(); asm volatile("" ::: "memory");
    const int c = lane & 7;
#pragma unroll
    for (int j = 0; j < 4; ++j) { const int n = (lane >> 3) + 8 * j; const LAS float* s = scr + (8 * c) * 33 + n;
        v4u o; o.x = pk2(s[0 * 33], s[1 * 33]); o.y = pk2(s[2 * 33], s[3 * 33]); o.z = pk2(s[4 * 33], s[5 * 33]); o.w = pk2(s[6 * 33], s[7 * 33]);
        const int dr_ = map(n0 + n); if (dr_ >= 0) *(v4u*)(WT + (size_t)dr_ * dpitch + koff + k0 + 8 * c) = o; }
    LDS_WAIT(); asm volatile("" ::: "memory");
}
__device__ __forceinline__ float clamp8(float v) { return fminf(fmaxf(v, -440.0f), 440.0f); }
template <class MAP>
__device__ __forceinline__ void transpose_item_fp8(const float* W, int N, unsigned char* WT, int dpitch, float scale, LAS float* scr, int item, int lane, const MAP& map) {
    const int nblk = N / 32, kb = item / nblk, nb = item % nblk, k0 = 64 * kb, n0 = 32 * nb;
    f32x4 v[8];
#pragma unroll
    for (int i = 0; i < 8; ++i) v[i] = *(const f32x4*)(W + (size_t)(k0 + 8 * i + (lane >> 3)) * N + n0 + 4 * (lane & 7));
#pragma unroll
    for (int i = 0; i < 8; ++i) { LAS float* d = scr + (8 * i + (lane >> 3)) * 33 + 4 * (lane & 7); d[0] = v[i].x; d[1] = v[i].y; d[2] = v[i].z; d[3] = v[i].w; }
    LDS_WAIT(); asm volatile("" ::: "memory");
    const int c = lane & 7;
#pragma unroll
    for (int j = 0; j < 4; ++j) { const int n = (lane >> 3) + 8 * j; const LAS float* s = scr + (8 * c) * 33 + n;
        int w0 = 0, w1 = 0;
        w0 = __builtin_amdgcn_cvt_pk_fp8_f32(clamp8(s[0 * 33] * scale), clamp8(s[1 * 33] * scale), w0, false); w0 = __builtin_amdgcn_cvt_pk_fp8_f32(clamp8(s[2 * 33] * scale), clamp8(s[3 * 33] * scale), w0, true);
        w1 = __builtin_amdgcn_cvt_pk_fp8_f32(clamp8(s[4 * 33] * scale), clamp8(s[5 * 33] * scale), w1, false); w1 = __builtin_amdgcn_cvt_pk_fp8_f32(clamp8(s[6 * 33] * scale), clamp8(s[7 * 33] * scale), w1, true);
        const int dr_ = map(n0 + n); if (dr_ >= 0) *(v2u*)(WT + (size_t)dr_ * dpitch + k0 + 8 * c) = (v2u){(unsigned)w0, (unsigned)w1}; }
    LDS_WAIT(); asm volatile("" ::: "memory");
}
struct MapId { int off; __device__ __forceinline__ int operator()(int n) const { return off + n; } };
struct MapWin {
    __device__ __forceinline__ int operator()(int n) const {
        if (n < 512) return ZC_AQ + n;
        if (n < 640) return ZC_AK + (n - 512);
        if (n < 768) return ZC_AV + (n - 640);
        if (n < 1792) return ZC_IQ + (n - 768);
        if (n < 1856) return ZC_IK + (n - 1792);
        if (n < 1872) return ZC_IW + (n - 1856);
        if (n < 2896) return ZC_BQ + (n - 1872);
        if (n < 3152) return ZC_BK + (n - 2896);
        if (n < 3408) return ZC_BV + (n - 3152);
        if (n < 3664) return ZC_CQ + (n - 3408);
        if (n < 3920) return ZC_CK + (n - 3664);
        if (n < 4432) return ZC_CV + (n - 3920);
        if (n < 4448) return ZC_CG + (n - 4432);
        if (n < 4960) return ZC_CR + (n - 4448);
        return pg8::ZC_GA + (n - 4960);
    }
};
struct MapWin8 { __device__ __forceinline__ int operator()(int n) const { const int z = MapWin{}(n); return z < 3328 ? z : (z >= 4096 ? z - 768 : -1); } };
struct MapWinB { __device__ __forceinline__ int operator()(int n) const { const int z = MapWin{}(n); return (z >= 3328 && z < 4096) ? z - 3328 : -1; } };
struct MapW13 { int sel; __device__ __forceinline__ int operator()(int n) const { return 32 * (n >> 4) + 16 * sel + (n & 15); } };

__device__ __forceinline__ void load_row(const float* row, int lane, f32x4 (&v)[8]) {
    const f32x4* xr = (const f32x4*)row + lane;
#pragma unroll
    for (int j = 0; j < 8; ++j) v[j] = xr[64 * j];
}
__device__ __forceinline__ float row_rstd(const f32x4 (&v)[8]) {
    float s = 0.f;
#pragma unroll
    for (int j = 0; j < 8; ++j) s += (v[j].x * v[j].x + v[j].y * v[j].y) + (v[j].z * v[j].z + v[j].w * v[j].w);
    return rsqrtf(wave_sum(s) * (1.0f / 2048.0f) + EPS);
}
__device__ __forceinline__ void norm_store_bf16(const f32x4 (&v)[8], float rstd, const float* g, bf16* orow, int lane) {
    const f32x4* gr = (const f32x4*)g + lane; unsigned long long* o8 = (unsigned long long*)orow + lane;
#pragma unroll
    for (int j = 0; j < 8; ++j) { const f32x4 gg = gr[64 * j];
        o8[64 * j] = (unsigned long long)pk2(v[j].x * rstd * gg.x, v[j].y * rstd * gg.y) | ((unsigned long long)pk2(v[j].z * rstd * gg.z, v[j].w * rstd * gg.w) << 32); }
}

__device__ __forceinline__ void norm_store_fp8(const f32x4 (&v)[8], float rstd, const float* g, unsigned char* orow, int lane) {
    const f32x4* gr = (const f32x4*)g + lane; unsigned* o4 = (unsigned*)orow + lane;
#pragma unroll
    for (int j = 0; j < 8; ++j) { const f32x4 gg = gr[64 * j]; int w = 0;
        w = __builtin_amdgcn_cvt_pk_fp8_f32(clamp8(v[j].x * rstd * gg.x), clamp8(v[j].y * rstd * gg.y), w, false); w = __builtin_amdgcn_cvt_pk_fp8_f32(clamp8(v[j].z * rstd * gg.z), clamp8(v[j].w * rstd * gg.w), w, true);
        o4[64 * j] = (unsigned)w; }
}
__device__ __forceinline__ void convert_moe(Frame& F, int l, int part, int nparts, int lds_off) {
    LAS float* scr = (LAS float*)(F.lds + lds_off + F.wave * 8704);
    bf16* W13 = (bf16*)(F.ws + WS_W13); bf16* W2 = (bf16*)(F.ws + WS_W2);
    constexpr int I13 = (2048 / 64) * (512 / 32);
    constexpr int I2 = (512 / 64) * (2048 / 32);
    constexpr int NIT = NEXP * (2 * I13 + I2);
    const int it_lo = (int)((long)NIT * part / nparts), it_hi = (int)((long)NIT * (part + 1) / nparts);
    for (int it = it_lo + F.gw; it < it_hi; it += F.NGW) {
        const int e = it / (2 * I13 + I2); int r = it % (2 * I13 + I2);
        if (r < I13) { transpose_item_fp8(F.in[I_W1] + ((size_t)l * NEXP + e) * 2048 * 512, 512, (unsigned char*)W13 + (size_t)e * 1024 * 2048, 2048, 64.0f, scr, r, F.lane, MapW13{0}); continue; } r -= I13;
        if (r < I13) { transpose_item_fp8(F.in[I_W3] + ((size_t)l * NEXP + e) * 2048 * 512, 512, (unsigned char*)W13 + (size_t)e * 1024 * 2048, 2048, 64.0f, scr, r, F.lane, MapW13{1}); continue; } r -= I13;
        transpose_item_fp8(F.in[I_W2] + ((size_t)l * NEXP + e) * 512 * 2048, 2048, (unsigned char*)W2 + (size_t)e * 2048 * 512, 512, 32.0f, scr, r, F.lane, MapId{0});
    }
}

typedef short bf16x8_t __attribute__((ext_vector_type(8)));
typedef float f32x16 __attribute__((ext_vector_type(16)));
typedef short s16x4 __attribute__((ext_vector_type(4)));
__device__ __forceinline__ void indexer_segment(Frame& F, int b, int qb, int tlo, int thi) {
    const int lane = F.lane, n = lane & 15, kq = lane >> 4;
    const bf16* qrow = F.Z + (size_t)(b * 2048 + 16 * qb + n) * ZP;
    bf16x8_t iqf[16][2];
#pragma unroll
    for (int h = 0; h < 16; ++h)
#pragma unroll
        for (int ks = 0; ks < 2; ++ks) iqf[h][ks] = *(const bf16x8_t*)(qrow + ZC_IQ + h * 64 + 32 * ks + 8 * kq);
    float wv[16];
    { const v4u w0 = *(const v4u*)(qrow + ZC_IW), w1 = *(const v4u*)(qrow + ZC_IW + 8);
      wv[0] = bflo(w0.x); wv[1] = bfhi(w0.x); wv[2] = bflo(w0.y); wv[3] = bfhi(w0.y); wv[4] = bflo(w0.z); wv[5] = bfhi(w0.z); wv[6] = bflo(w0.w); wv[7] = bfhi(w0.w);
      wv[8] = bflo(w1.x); wv[9] = bfhi(w1.x); wv[10] = bflo(w1.y); wv[11] = bfhi(w1.y); wv[12] = bflo(w1.z); wv[13] = bfhi(w1.z); wv[14] = bflo(w1.w); wv[15] = bfhi(w1.w); }
    const bf16* kbase = F.Z + (size_t)(b * 2048 + n) * ZP + ZC_IK + 8 * kq;
    float* srow = F.S + (size_t)(b * 2048 + 16 * qb + n) * 2048 + 4 * kq;
    bf16x8_t ka[3], kb[3];
#pragma unroll
    for (int u = 0; u < 3; ++u) { const int tt = tlo + u < thi ? tlo + u : thi - 1; ka[u] = *(const bf16x8_t*)(kbase + (size_t)(16 * tt) * ZP); kb[u] = *(const bf16x8_t*)(kbase + (size_t)(16 * tt) * ZP + 32); }
#pragma unroll 1
    for (int tile = tlo; tile < thi; tile += 3) {
#pragma unroll
        for (int u = 0; u < 3; ++u) {
            const int tt = tile + u;
            if (tt < thi) {
                f32x4 sc = (f32x4){0.f, 0.f, 0.f, 0.f};
#pragma unroll
                for (int h = 0; h < 16; ++h) {
                    f32x4 c = __builtin_amdgcn_mfma_f32_16x16x32_bf16(ka[u], iqf[h][0], (f32x4){0.f, 0.f, 0.f, 0.f}, 0, 0, 0);
                    c = __builtin_amdgcn_mfma_f32_16x16x32_bf16(kb[u], iqf[h][1], c, 0, 0, 0);
                    sc[0] += wv[h] * fmaxf(c[0], 0.f); sc[1] += wv[h] * fmaxf(c[1], 0.f); sc[2] += wv[h] * fmaxf(c[2], 0.f); sc[3] += wv[h] * fmaxf(c[3], 0.f);
                }
                *(f32x4*)(srow + 16 * tt) = sc * 0.03125f;
            }
            { const int tn = tt + 3 < thi ? tt + 3 : thi - 1; ka[u] = *(const bf16x8_t*)(kbase + (size_t)(16 * tn) * ZP); kb[u] = *(const bf16x8_t*)(kbase + (size_t)(16 * tn) * ZP + 32); }
        }
    }
}

constexpr int FA_KP = 272, FA_VP = 320;
constexpr int FA_KOFF = 0, FA_VOFF = 2 * 64 * FA_KP, FA_BYTES = FA_VOFF + 2 * 64 * FA_VP;
__device__ __forceinline__ s16x4 fa_vtr(const LAS unsigned char* p) { return __builtin_bit_cast(s16x4, __builtin_amdgcn_ds_read_tr16_b64_v4i16((LAS s16x4*)p)); }
template <int MODE>
__device__ __forceinline__ void flash_unit(Frame& F, int l, int b, int g, int t0) {
    const int tid = F.tid, lane = F.lane, wave = F.wave, hh = wave & 3, qh = wave >> 2, r = lane & 31, hf = lane >> 5;
    const int qcol = (MODE == 0 ? ZC_AQ : ZC_BQ + 512 * g) + 128 * hh, kcol = MODE == 0 ? ZC_AK : ZC_BK + 128 * g, vcol = MODE == 0 ? ZC_AV : ZC_BV + 128 * g;
    const int ocol = (MODE == 0 ? 0 : 512 + 512 * g) + 128 * hh, hd = (MODE == 0 ? 0 : 4 + 4 * g) + hh;
    const int tq = t0 + 32 * qh + r; const size_t qrow = (size_t)(b * 2048 + tq);
    const LAS float* tab2 = (const LAS float*)(F.misc + MO_TAB2) + hd * 129;
    LAS unsigned char* lds = F.lds;
    bf16x8_t qf[8];
#pragma unroll
    for (int ks = 0; ks < 8; ++ks) qf[ks] = *(const bf16x8_t*)(F.Z + qrow * ZP + qcol + 16 * ks + 8 * hf);
    f32x16 oacc[4];
#pragma unroll
    for (int dt = 0; dt < 4; ++dt)
#pragma unroll
        for (int i = 0; i < 16; ++i) oacc[dt][i] = 0.f;
    float m_run = -1e30f, l_run = 0.f;
    const int tile_lo = MODE == 0 ? 0 : (t0 >= 128 ? t0 / 64 - 2 : 0), tile_hi = t0 / 64 + 1;
    const int skey = tid >> 4, sdc = tid & 15;
    v4u kreg[2], vreg[2];
    { const bf16* zr = F.Z + (size_t)(b * 2048 + 64 * tile_lo + skey) * ZP;
#pragma unroll
      for (int i = 0; i < 2; ++i) { kreg[i] = *(const v4u*)(zr + (size_t)(32 * i) * ZP + kcol + 8 * sdc); vreg[i] = *(const v4u*)(zr + (size_t)(32 * i) * ZP + vcol + 8 * sdc); } }
    const float sc2 = 0.08838834764831845f * 1.4426950408889634f;
    unsigned mwn[2] = {0xffffffffu, 0xffffffffu};
    if (MODE == 0) { mwn[0] = F.MASK[qrow * 64 + 2 * tile_lo]; mwn[1] = F.MASK[qrow * 64 + 2 * tile_lo + 1]; }
#pragma unroll 1
    for (int kt = tile_lo; kt < tile_hi; ++kt) {
        const int bf = (kt - tile_lo) & 1, s0 = 64 * kt;
        LAS unsigned char* kb = lds + FA_KOFF + bf * (64 * FA_KP); LAS unsigned char* vb = lds + FA_VOFF + bf * (64 * FA_VP);
#pragma unroll
        for (int i = 0; i < 2; ++i) { *(LAS v4u*)(kb + (skey + 32 * i) * FA_KP + 16 * sdc) = kreg[i]; *(LAS v4u*)(vb + (skey + 32 * i) * FA_VP + 16 * sdc) = vreg[i]; }
        __syncthreads();
        if (kt + 1 < tile_hi) { const bf16* zr = F.Z + (size_t)(b * 2048 + 64 * (kt + 1) + skey) * ZP;
#pragma unroll
            for (int i = 0; i < 2; ++i) { kreg[i] = *(const v4u*)(zr + (size_t)(32 * i) * ZP + kcol + 8 * sdc); vreg[i] = *(const v4u*)(zr + (size_t)(32 * i) * ZP + vcol + 8 * sdc); } }
        unsigned mw[2] = {mwn[0], mwn[1]};
        if (MODE == 0 && kt + 1 < tile_hi) { mwn[0] = F.MASK[qrow * 64 + 2 * (kt + 1)]; mwn[1] = F.MASK[qrow * 64 + 2 * (kt + 1) + 1]; }
        f32x16 sacc[2];
#pragma unroll
        for (int k2 = 0; k2 < 2; ++k2) {
#pragma unroll
            for (int i = 0; i < 16; ++i) sacc[k2][i] = 0.f;
#pragma unroll
            for (int ks = 0; ks < 8; ++ks) { const bf16x8_t kf = *(const LAS bf16x8_t*)(kb + (32 * k2 + r) * FA_KP + (16 * ks + 8 * hf) * 2);
                sacc[k2] = __builtin_amdgcn_mfma_f32_32x32x16_bf16(kf, qf[ks], sacc[k2], 0, 0, 0); }
        }
        float mx = -1e30f;
        if (MODE == 0 && s0 + 63 + 128 <= t0) {
            const float bfar = tab2[128];
#pragma unroll
            for (int k2 = 0; k2 < 2; ++k2)
#pragma unroll
                for (int i = 0; i < 16; ++i) { const int cr = (i & 3) + 8 * (i >> 2) + 4 * hf;
                    const float v = ((mw[k2] >> cr) & 1u) ? sacc[k2][i] * sc2 + bfar : -__builtin_inff();
                    sacc[k2][i] = v; mx = fmaxf(mx, v); }
        } else
#pragma unroll
        for (int k2 = 0; k2 < 2; ++k2)
#pragma unroll
            for (int i = 0; i < 16; ++i) { const int cr = (i & 3) + 8 * (i >> 2) + 4 * hf; const int dist = tq - (s0 + 32 * k2 + cr);
                bool ok; if (MODE == 0) ok = (mw[k2] >> cr) & 1u; else ok = dist >= 0 && dist < 128;
                const int di = dist < 0 ? 0 : (dist > 128 ? 128 : dist);
                float vf = sacc[k2][i] * sc2 + tab2[di];
                asm volatile("" : "+v"(vf));
                const float v = ok ? vf : -__builtin_inff();
                sacc[k2][i] = v; mx = fmaxf(mx, v); }
        { const auto sw_ = __builtin_amdgcn_permlane32_swap(__float_as_uint(mx), __float_as_uint(mx), false, false); mx = fmaxf(__uint_as_float(sw_[0]), __uint_as_float(sw_[1])); }
        const float m_new = fmaxf(m_run, mx), alpha = __builtin_amdgcn_exp2f(m_run - m_new); m_run = m_new;
        float ps = 0.f;
#pragma unroll
        for (int k2 = 0; k2 < 2; ++k2)
#pragma unroll
            for (int i = 0; i < 16; ++i) { const float p = __builtin_amdgcn_exp2f(sacc[k2][i] - m_new); sacc[k2][i] = p; ps += p; }
        l_run = l_run * alpha + ps;
        if (__ballot(alpha != 1.0f)) {
#pragma unroll
        for (int dt = 0; dt < 4; ++dt)
#pragma unroll
            for (int i = 0; i < 16; ++i) oacc[dt][i] *= alpha;
        }
#pragma unroll
        for (int k2 = 0; k2 < 2; ++k2)
#pragma unroll
            for (int s2 = 0; s2 < 2; ++s2) {
                v4u pw; pw.x = pg8::cvt_pk_bf16(sacc[k2][8 * s2 + 0], sacc[k2][8 * s2 + 1]); pw.y = pg8::cvt_pk_bf16(sacc[k2][8 * s2 + 2], sacc[k2][8 * s2 + 3]);
                pw.z = pg8::cvt_pk_bf16(sacc[k2][8 * s2 + 4], sacc[k2][8 * s2 + 5]); pw.w = pg8::cvt_pk_bf16(sacc[k2][8 * s2 + 6], sacc[k2][8 * s2 + 7]);
                const bf16x8_t pb = __builtin_bit_cast(bf16x8_t, pw);
                const int i16 = lane & 15, grp = (lane >> 4) & 1;
                const LAS unsigned char* vp = vb + (32 * k2 + 16 * s2 + 4 * hf + (i16 >> 2)) * FA_VP + (16 * grp + 4 * (i16 & 3)) * 2;
#pragma unroll
                for (int dt = 0; dt < 4; ++dt) { const s16x4 lo = fa_vtr(vp + 64 * dt), hi = fa_vtr(vp + 8 * FA_VP + 64 * dt);
                    const bf16x8_t vf = __builtin_shufflevector(lo, hi, 0, 1, 2, 3, 4, 5, 6, 7);
                    oacc[dt] = __builtin_amdgcn_mfma_f32_32x32x16_bf16(vf, pb, oacc[dt], 0, 0, 0); }
            }
    }
    float l_tot = l_run + __shfl_xor(l_run, 32);
    if (MODE == 1) l_tot += __builtin_amdgcn_exp2f(F.in[I_SINK][l * 8 + hd - 4] * 1.4426950408889634f - m_run);
    const float inv = 1.0f / l_tot;
    bf16* orow = F.OCAT + qrow * 2048 + ocol + 4 * hf;
#pragma unroll
    for (int dt = 0; dt < 4; ++dt)
#pragma unroll
        for (int gq = 0; gq < 4; ++gq) { v2u w; w.x = pk2(oacc[dt][4 * gq] * inv, oacc[dt][4 * gq + 1] * inv); w.y = pk2(oacc[dt][4 * gq + 2] * inv, oacc[dt][4 * gq + 3] * inv);
            *(v2u*)(orow + 32 * dt + 8 * gq) = w; }
    __syncthreads();
}


#define GLA_GATE_PREFIX(LDS_TOT) \
        float la[8]; \
        _Pragma("unroll") for (int i = 0; i < 8; ++i) { const v4u c0 = rc0[i], c1 = rc1[i]; float x = gb; \
            x += bflo(c0.x) * gwv[0] + bfhi(c0.x) * gwv[1] + bflo(c0.y) * gwv[2] + bfhi(c0.y) * gwv[3] + bflo(c0.z) * gwv[4] + bfhi(c0.z) * gwv[5] + bflo(c0.w) * gwv[6] + bfhi(c0.w) * gwv[7]; \
            x += bflo(c1.x) * gwv[8] + bfhi(c1.x) * gwv[9] + bflo(c1.y) * gwv[10] + bfhi(c1.y) * gwv[11] + bflo(c1.z) * gwv[12] + bfhi(c1.z) * gwv[13] + bflo(c1.w) * gwv[14] + bfhi(c1.w) * gwv[15]; \
            la[i] = (fminf(x, 0.f) - __logf(1.0f + __expf(-fabsf(x)))) * 0.0625f; } \
        _Pragma("unroll") for (int i = 1; i < 8; ++i) la[i] += la[i - 1]; \
        ((LAS float*)(L + LDS_TOT))[cg * 64 + dk] = la[7];
#define GLA_OFFSETS(LDS_TOT) \
        float off = 0.f, tot = 0.f; \
        _Pragma("unroll") for (int g2 = 0; g2 < 8; ++g2) { const float tv = ((const LAS float*)(L + LDS_TOT))[g2 * 64 + dk]; tot += tv; off += g2 < cg ? tv : 0.f; }

__device__ __forceinline__ void gla_state_phase(Frame& F, int l) {
    const int tid = F.tid, lane = F.lane, wave = F.wave, r = lane & 31, hf = lane >> 5, i16 = lane & 15, grp = (lane >> 4) & 1;
    LAS unsigned char* L = F.lds;
    constexpr int KDT = 0, VT = 9216, TOT = 29696, RP = 144, VP = 320;
    const int dk = lane, cg = wave;
    float* GCS = (float*)(F.ws + WS_GCS); float* GDEC = (float*)(F.ws + WS_GDEC);
    v4u rc0[8], rc1[8], rv[2]; unsigned short rk[8];
#define GLS_LOAD(u_) do { const int bh_ = (u_) >> 5, n_ = (u_) & 31; const size_t r0_ = (size_t)((bh_ >> 2) * 2048 + 64 * n_); const int h_ = bh_ & 3; \
        _Pragma("unroll") for (int i = 0; i < 8; ++i) { const bf16* zr = F.Z + (r0_ + 8 * cg + i) * ZP; rc0[i] = *(const v4u*)(zr + ZC_CG); rc1[i] = *(const v4u*)(zr + ZC_CG + 8); rk[i] = zr[ZC_CK + h_ * 64 + dk]; } \
        _Pragma("unroll") for (int i = 0; i < 2; ++i) rv[i] = *(const v4u*)(F.Z + (r0_ + (tid >> 4) + 32 * i) * ZP + ZC_CV + h_ * 128 + 8 * (tid & 15)); } while (0)
    int u = F.vcu;
    if (u < 2048) GLS_LOAD(u);
    for (; u < 2048; u += F.G) {
        const int h = (u >> 5) & 3;
        float gwv[16];
#pragma unroll
        for (int q = 0; q < 16; ++q) gwv[q] = F.in[I_CGW][(size_t)l * 4096 + q * 256 + h * 64 + dk];
        const float gb = F.in[I_CGB][l * 256 + h * 64 + dk];
        GLA_GATE_PREFIX(TOT)
        float kv[8];
#pragma unroll
        for (int i = 0; i < 8; ++i) kv[i] = bf1(rk[i]);
#pragma unroll
        for (int i = 0; i < 2; ++i) *(LAS v4u*)(L + VT + ((tid >> 4) + 32 * i) * VP + 16 * (tid & 15)) = rv[i];
        __syncthreads();
        GLA_OFFSETS(TOT)
        { float kd[8];
#pragma unroll
          for (int i = 0; i < 8; ++i) kd[i] = kv[i] * __expf(tot - (off + la[i]));
          v4u w; w.x = pk2(kd[0], kd[1]); w.y = pk2(kd[2], kd[3]); w.z = pk2(kd[4], kd[5]); w.w = pk2(kd[6], kd[7]); *(LAS v4u*)(L + KDT + dk * RP + 16 * cg) = w; }
        if (cg == 0) GDEC[(size_t)u * 64 + dk] = __expf(tot);
        __syncthreads();
        if (u + F.G < 2048) GLS_LOAD(u + F.G);
        { const int dkt = wave >> 2, dvt = wave & 3;
          f32x16 cs;
#pragma unroll
          for (int i = 0; i < 16; ++i) cs[i] = 0.f;
#pragma unroll
          for (int ks = 0; ks < 4; ++ks) { const bf16x8_t a = *(const LAS bf16x8_t*)(L + KDT + (32 * dkt + r) * RP + (16 * ks + 8 * hf) * 2);
              const LAS unsigned char* vp = L + VT + (16 * ks + 8 * hf + (i16 >> 2)) * VP + (32 * dvt + 16 * grp + 4 * (i16 & 3)) * 2;
              const s16x4 lo = fa_vtr(vp), hi = fa_vtr(vp + 4 * VP);
              cs = __builtin_amdgcn_mfma_f32_32x32x16_bf16(a, __builtin_shufflevector(lo, hi, 0, 1, 2, 3, 4, 5, 6, 7), cs, 0, 0, 0); }
          float* gp = GCS + (size_t)u * 8192 + (size_t)(32 * dkt + 4 * hf) * 128 + 32 * dvt + r;
#pragma unroll
          for (int i = 0; i < 16; ++i) gp[((i & 3) + 8 * (i >> 2)) * 128] = cs[i]; }
        __syncthreads();
    }
#undef GLS_LOAD
}

__device__ __forceinline__ void gla_scan_phase(Frame& F) {
    float* GCS = (float*)(F.ws + WS_GCS); const float* GDEC = (const float*)(F.ws + WS_GDEC);
    for (int gt = F.gw * 64 + F.lane; gt < 64 * 2048; gt += F.NGW * 64) {
        const int bh = gt >> 11, e4 = gt & 2047, dk = e4 >> 5;
        f32x4* p = (f32x4*)(GCS + (size_t)bh * 32 * 8192) + e4; const float* dp = GDEC + (size_t)bh * 32 * 64 + dk;
        f32x4 st = (f32x4){0.f, 0.f, 0.f, 0.f};
#pragma unroll 1
        for (int n0 = 0; n0 < 32; n0 += 8) {
            f32x4 cs[8]; float dc[8];
#pragma unroll
            for (int j = 0; j < 8; ++j) { cs[j] = p[(size_t)(n0 + j) * 2048]; dc[j] = dp[(n0 + j) * 64]; }
#pragma unroll
            for (int j = 0; j < 8; ++j) { p[(size_t)(n0 + j) * 2048] = st; st = st * dc[j] + cs[j]; }
        }
    }
}

__device__ __forceinline__ void gla_out_phase(Frame& F, int l) {
    const int tid = F.tid, lane = F.lane, wave = F.wave, r = lane & 31, hf = lane >> 5, i16 = lane & 15, grp = (lane >> 4) & 1;
    LAS unsigned char* L = F.lds;
    constexpr int QG = 0, KG = 9216, VT = 18432, PT = 38912, TOT = 59392, OT = 61440, RP = 144, VP = 320, OP = 132;
    const int dk = lane, cg = wave;
    const float* GCS = (const float*)(F.ws + WS_GCS);
    v4u rc0[8], rc1[8], rv[2]; unsigned short rq[8], rk[8]; unsigned rg[8]; f32x4 rp[4];
#define GLO_LOAD(u_) do { const int bh_ = (u_) >> 5, n_ = (u_) & 31; const size_t r0_ = (size_t)((bh_ >> 2) * 2048 + 64 * n_); const int h_ = bh_ & 3; \
        _Pragma("unroll") for (int i = 0; i < 8; ++i) { const bf16* zr = F.Z + (r0_ + 8 * cg + i) * ZP; rc0[i] = *(const v4u*)(zr + ZC_CG); rc1[i] = *(const v4u*)(zr + ZC_CG + 8); rq[i] = zr[ZC_CQ + h_ * 64 + dk]; rk[i] = zr[ZC_CK + h_ * 64 + dk]; \
            rg[i] = *(const unsigned*)(zr + ZC_CR + h_ * 128 + 2 * lane); } \
        _Pragma("unroll") for (int i = 0; i < 2; ++i) rv[i] = *(const v4u*)(F.Z + (r0_ + (tid >> 4) + 32 * i) * ZP + ZC_CV + h_ * 128 + 8 * (tid & 15)); \
        _Pragma("unroll") for (int i = 0; i < 4; ++i) rp[i] = *(const f32x4*)(GCS + (size_t)(u_) * 8192 + (size_t)(tid >> 3) * 128 + 16 * (tid & 7) + 4 * i); } while (0)
    int u = F.vcu;
    if (u < 2048) GLO_LOAD(u);
    const float g0 = F.in[I_CNG][l * 128 + 2 * lane], g1 = F.in[I_CNG][l * 128 + 2 * lane + 1];
    for (; u < 2048; u += F.G) {
        const int bh = u >> 5, n = u & 31, h = bh & 3; const size_t row0 = (size_t)((bh >> 2) * 2048 + 64 * n);
        float gwv[16];
#pragma unroll
        for (int q = 0; q < 16; ++q) gwv[q] = F.in[I_CGW][(size_t)l * 4096 + q * 256 + h * 64 + dk];
        const float gb = F.in[I_CGB][l * 256 + h * 64 + dk];
        GLA_GATE_PREFIX(TOT)
        float qv[8], kv[8]; unsigned gr[8];
#pragma unroll
        for (int i = 0; i < 8; ++i) { qv[i] = bf1(rq[i]); kv[i] = bf1(rk[i]); gr[i] = rg[i]; }
#pragma unroll
        for (int i = 0; i < 2; ++i) *(LAS v4u*)(L + VT + ((tid >> 4) + 32 * i) * VP + 16 * (tid & 15)) = rv[i];
        { v4u w0, w1; w0.x = pk2(rp[0].x, rp[0].y); w0.y = pk2(rp[0].z, rp[0].w); w0.z = pk2(rp[1].x, rp[1].y); w0.w = pk2(rp[1].z, rp[1].w);
          w1.x = pk2(rp[2].x, rp[2].y); w1.y = pk2(rp[2].z, rp[2].w); w1.z = pk2(rp[3].x, rp[3].y); w1.w = pk2(rp[3].z, rp[3].w);
          *(LAS v4u*)(L + PT + (tid >> 3) * VP + 32 * (tid & 7)) = w0; *(LAS v4u*)(L + PT + (tid >> 3) * VP + 32 * (tid & 7) + 16) = w1; }
        __syncthreads();
        GLA_OFFSETS(TOT)
#pragma unroll
        for (int i = 0; i < 8; ++i) { const float bi = off + la[i];
            *(LAS bf16*)(L + QG + (8 * cg + i) * RP + 2 * dk) = (bf16)f2bf(qv[i] * 0.125f * __expf(bi));
            *(LAS bf16*)(L + KG + (8 * cg + i) * RP + 2 * dk) = (bf16)f2bf(kv[i] * __expf(-bi)); }
        __syncthreads();
        if (u + F.G < 2048) GLO_LOAD(u + F.G);
        { const int ct = wave >> 2, dvt = wave & 3;
          f32x16 o;
#pragma unroll
          for (int i = 0; i < 16; ++i) o[i] = 0.f;
#pragma unroll
          for (int st = 0; st < 2; ++st) if (st <= ct) {
              f32x16 at;
#pragma unroll
              for (int i = 0; i < 16; ++i) at[i] = 0.f;
#pragma unroll
              for (int ks = 0; ks < 4; ++ks) { const bf16x8_t a = *(const LAS bf16x8_t*)(L + KG + (32 * st + r) * RP + (16 * ks + 8 * hf) * 2), bq = *(const LAS bf16x8_t*)(L + QG + (32 * ct + r) * RP + (16 * ks + 8 * hf) * 2);
                  at = __builtin_amdgcn_mfma_f32_32x32x16_bf16(a, bq, at, 0, 0, 0); }
              if (st == ct) {
#pragma unroll
                  for (int i = 0; i < 16; ++i) { const int cr = (i & 3) + 8 * (i >> 2) + 4 * hf; at[i] = cr <= r ? at[i] : 0.f; } }
#pragma unroll
              for (int s2 = 0; s2 < 2; ++s2) {
                  v4u pw; pw.x = pg8::cvt_pk_bf16(at[8 * s2 + 0], at[8 * s2 + 1]); pw.y = pg8::cvt_pk_bf16(at[8 * s2 + 2], at[8 * s2 + 3]); pw.z = pg8::cvt_pk_bf16(at[8 * s2 + 4], at[8 * s2 + 5]); pw.w = pg8::cvt_pk_bf16(at[8 * s2 + 6], at[8 * s2 + 7]);
                  const LAS unsigned char* vp = L + VT + (32 * st + 16 * s2 + 4 * hf + (i16 >> 2)) * VP + (32 * dvt + 16 * grp + 4 * (i16 & 3)) * 2;
                  const s16x4 lo = fa_vtr(vp), hi = fa_vtr(vp + 8 * VP);
                  o = __builtin_amdgcn_mfma_f32_32x32x16_bf16(__builtin_bit_cast(bf16x8_t, pw), __builtin_shufflevector(lo, hi, 0, 1, 2, 3, 4, 5, 6, 7), o, 0, 0, 0);
              }
          }
#pragma unroll
          for (int ks = 0; ks < 4; ++ks) { const bf16x8_t a = *(const LAS bf16x8_t*)(L + QG + (32 * ct + r) * RP + (16 * ks + 8 * hf) * 2);
              const LAS unsigned char* pp = L + PT + (16 * ks + 8 * hf + (i16 >> 2)) * VP + (32 * dvt + 16 * grp + 4 * (i16 & 3)) * 2;
              const s16x4 lo = fa_vtr(pp), hi = fa_vtr(pp + 4 * VP);
              o = __builtin_amdgcn_mfma_f32_32x32x16_bf16(a, __builtin_shufflevector(lo, hi, 0, 1, 2, 3, 4, 5, 6, 7), o, 0, 0, 0); }
          LAS float* op = (LAS float*)(L + OT) + (32 * ct + 4 * hf) * OP + 32 * dvt + r;
#pragma unroll
          for (int i = 0; i < 16; ++i) op[((i & 3) + 8 * (i >> 2)) * OP] = o[i]; }
        __syncthreads();
        { float a[8], c[8], ss[8];
#pragma unroll
          for (int i = 0; i < 8; ++i) { const LAS float* orow = (const LAS float*)(L + OT) + (8 * wave + i) * OP + 2 * lane; a[i] = orow[0]; c[i] = orow[1]; ss[i] = a[i] * a[i] + c[i] * c[i]; }
#pragma unroll
          for (int o2 = 1; o2 < 64; o2 <<= 1) {
#pragma unroll
              for (int i = 0; i < 8; ++i) ss[i] += __shfl_xor(ss[i], o2); }
#pragma unroll
          for (int i = 0; i < 8; ++i) { const float rstd = rsqrtf(ss[i] * (1.0f / 128.0f) + EPS);
              *(unsigned*)(F.OCAT + (row0 + 8 * wave + i) * 2048 + 1536 + h * 128 + 2 * lane) = pk2(a[i] * rstd * g0 * bflo(gr[i]), c[i] * rstd * g1 * bfhi(gr[i])); } }
        __syncthreads();
    }
#undef GLO_LOAD
}
#undef GLA_GATE_PREFIX
#undef GLA_OFFSETS

__device__ __forceinline__ bool in_phase(int k, int lo, int hi) { asm volatile("" : "+s"(k)); return lo <= k && k < hi; }
#define IN(k) in_phase((k), lo, hi)
#define PHASE_LANE() do { int _tz = threadIdx.x; asm volatile("" : "+v"(_tz)); F.tid = _tz; F.lane = _tz & 63; } while (0)
#define SEAM(k) do { if (IN(k) && IN((k) + 1)) xcd_barrier(bar); } while (0)
template <int l>
__device__ __forceinline__ void layer_body(Frame& F, const XcdBarrier& bar, const int lo, const int hi) {
    constexpr int pb = 1 + 11 * l;
        if (IN(pb + 0)) {
            { pg8::Gemm g{F.XN, (const bf16*)(F.ws + WS_WIN + l * WIN_L + 24 * MiB), T, 768, D}; pg8::StaticOrder S; S.init(T, 768, D, F.G, (int)blockIdx.x);
              pg8::EpiInProj<1> E{F.Z, F.ws + WS_GT, (LAS unsigned long long*)(F.misc + MO_SS), (const LAS float*)(F.misc + MO_GN) + l * 512};
              pg8::gemm_phase<pg8::EpiInProj<1>, pg8::StaticOrder, true, false>(F.lds, g, S, E); }
            { pg8::Gemm g{(const bf16*)(F.ws + WS_XN8), (const bf16*)(F.ws + WS_WIN + l * WIN_L), T, 10496, D / 2}; pg8::StaticOrder S; S.init(T, 10496, D / 2, F.G, ((int)blockIdx.x + F.G / 2) % F.G);
              pg8::EpiInProj<0> E{F.Z, F.ws + WS_GT, (LAS unsigned long long*)(F.misc + MO_SS), (const LAS float*)(F.misc + MO_GN) + l * 512};
              pg8::gemm_phase<pg8::EpiInProj<0>, pg8::StaticOrder, true, true>(F.lds, g, S, E); }
        }
        SEAM(pb + 0);
        if (IN(pb + 1)) { PHASE_LANE();
            if (F.wave & 4) convert_moe(F, l, 0, 4, 40960);
            for (int it = F.gw; it < NB * 128; it += F.NGW) {
                const int b = it >> 7, j = it & 127;
                indexer_segment(F, b, j, 0, j < 64 ? j + 1 : 64);
                if (j < 64) indexer_segment(F, b, 127 - j, 64, 128 - j);
            }
            if (!(F.wave & 4)) convert_moe(F, l, 0, 4, 40960);
            PHASE_LANE();
            gla_state_phase(F, l);
        }
        SEAM(pb + 1);
        if (IN(pb + 2)) { PHASE_LANE();
            if (F.wave & 4) convert_moe(F, l, 1, 4, 0);
            for (int row = F.gw; row < T; row += F.NGW) {
                const int t = row & 2047;
                if (t < 256) { const int nb = t + 1 - 32 * F.lane; F.MASK[(size_t)row * 64 + F.lane] = nb >= 32 ? 0xffffffffu : (nb <= 0 ? 0u : ((1u << nb) - 1u)); continue; }
                float val[32];
#pragma unroll
                for (int j = 0; j < 32; ++j) { const int s_ = 64 * j + F.lane; val[j] = F.S[(size_t)row * 2048 + (s_ < t ? s_ : t)]; }
                float vmx = -3.0e38f, vmn = 3.0e38f;
#pragma unroll
                for (int j = 0; j < 32; ++j) { const bool ok = 64 * j + F.lane <= t; val[j] = ok ? val[j] : -3.0e38f; vmx = fmaxf(vmx, val[j]); vmn = fminf(vmn, ok ? val[j] : 3.0e38f); }
#pragma unroll
                for (int o = 1; o < 64; o <<= 1) { vmx = fmaxf(vmx, __shfl_xor(vmx, o)); vmn = fminf(vmn, __shfl_xor(vmn, o)); }
                float lo = vmn, hi = vmx, thf = 0.f; bool exact = false;
#pragma unroll 1
                for (int it = 0; it < 28; ++it) { const float mid = 0.5f * (lo + hi); if (!(mid > lo && mid < hi)) break; int cnt = 0;
#pragma unroll
                    for (int j = 0; j < 32; ++j) cnt += __popcll(__ballot(val[j] >= mid));
                    if (cnt == 256) { exact = true; thf = mid; break; }
                    if (cnt > 256) lo = mid; else hi = mid; }
                unsigned th = 0u; int need = 0;
#define KEYOF(x) ({ const unsigned u_ = __float_as_uint(x); (u_ & 0x80000000u) ? ~u_ : (u_ | 0x80000000u); })
                if (!exact) {
#pragma unroll 1
                    for (int bit = 31; bit >= 0; --bit) { const unsigned cand = th | (1u << bit); int cnt = 0;
#pragma unroll
                        for (int j = 0; j < 32; ++j) cnt += __popcll(__ballot(KEYOF(val[j]) >= cand));
                        if (cnt >= 256) th = cand; }
                    int cgt = 0;
#pragma unroll
                    for (int j = 0; j < 32; ++j) cgt += __popcll(__ballot(KEYOF(val[j]) > th));
                    need = 256 - cgt;
                }
                int run = 0; unsigned myword = 0u;
#pragma unroll
                for (int j = 0; j < 32; ++j) {
                    bool sel;
                    if (exact) sel = val[j] >= thf;
                    else { const unsigned kj = KEYOF(val[j]); const bool eq = kj == th; const unsigned long long eqm = __ballot(eq);
                        const int pre = run + __popcll(eqm & ((1ull << F.lane) - 1ull)); sel = (kj > th) || (eq && pre < need); run += __popcll(eqm); sel = sel && (64 * j + F.lane <= t); }
                    const unsigned long long sm = __ballot(sel);
                    if ((F.lane >> 1) == j) myword = (F.lane & 1) ? (unsigned)(sm >> 32) : (unsigned)sm;
                }
#undef KEYOF
                F.MASK[(size_t)row * 64 + F.lane] = myword;
            }
            if (!(F.wave & 4)) convert_moe(F, l, 1, 4, 0);
            gla_scan_phase(F);
        }
        SEAM(pb + 2);
        if (IN(pb + 3)) { PHASE_LANE();
            if (F.vcu & 1) { convert_moe(F, l, 1, 2, 0); __syncthreads(); PHASE_LANE(); }
            for (int u = F.vcu; u < NB * 16; u += F.G) { const int b = u >> 4, p = u & 15; flash_unit<0>(F, l, b, 0, 64 * (31 - p)); flash_unit<0>(F, l, b, 0, 64 * p); }
            for (int u = F.vcu; u < NB * 2 * 32; u += F.G) { const int b = u >> 6, g = (u >> 5) & 1, qb = u & 31; flash_unit<1>(F, l, b, g, 64 * qb); }
            gla_out_phase(F, l);
            if (!(F.vcu & 1)) { PHASE_LANE(); convert_moe(F, l, 1, 2, 0); }
        }
        SEAM(pb + 3);
        if (IN(pb + 4)) {
            pg8::Gemm g{F.OCAT, (const bf16*)(F.ws + WS_WBR + l * WBR_L), T, D, D}; pg8::MergeOrder S; S.init(T, D, D, F.G, (int)blockIdx.x);
#ifdef PROBE_MERGE
            { pg8::EpiMergeT<PROBE_MERGE> E{F.ws + WS_GT, (bf16*)(F.ws + WS_S)}; pg8::gemm_phase<pg8::EpiMergeT<PROBE_MERGE>, pg8::MergeOrder, true>(F.lds, g, S, E); }
#endif
            pg8::EpiMerge E{F.ws + WS_GT, F.MERGED};
            pg8::gemm_phase<pg8::EpiMerge, pg8::MergeOrder, true>(F.lds, g, S, E);
        }
        SEAM(pb + 4);
        if (IN(pb + 5)) {
            pg8::Gemm g{F.MERGED, (const bf16*)(F.ws + WS_WO + l * WO_L), T, D, D}; pg8::StaticOrder S; S.init(T, D, D, F.G, (int)blockIdx.x);
            pg8::EpiResid E{(bf16*)(F.ws + WS_HB), (unsigned char*)F.XN, F.in[I_N2G] + l * D, F.lds + 3 * pg8::HTB};
            pg8::gemm_phase<pg8::EpiResid, pg8::StaticOrder, true>(F.lds, g, S, E);
        }
        SEAM(pb + 5);
        if (IN(pb + 6)) { PHASE_LANE();
            unsigned* cnt = F.ctl + CW_CNT + 64 * l;
            const int lane = F.lane, fr = lane & 15, fq = lane >> 4;
            LAS float* LG = (LAS float*)(F.lds + F.wave * 8192);
            const bf16* wrh = (const bf16*)(F.ws + WS_WRH + l * WR_L) + (size_t)fr * 2048 + 8 * fq; const bf16* wrl = (const bf16*)(F.ws + WS_WRL + l * WR_L) + (size_t)fr * 2048 + 8 * fq;
            for (int tile = F.gw; tile < T / 16; tile += F.NGW) {
                const bf16* hrow = (const bf16*)(F.ws + WS_HB) + (size_t)(16 * tile + fr) * D + 8 * fq;
                f32x4 acc[6];
#pragma unroll
                for (int nt = 0; nt < 6; ++nt) acc[nt] = (f32x4){0.f, 0.f, 0.f, 0.f};
                float ss = 0.f;
#pragma unroll 2
                for (int ks = 0; ks < 64; ++ks) {
                    const v4u hw = *(const v4u*)(hrow + 32 * ks);
                    { const float a0 = bflo(hw.x), a1 = bfhi(hw.x), a2 = bflo(hw.y), a3 = bfhi(hw.y), a4 = bflo(hw.z), a5 = bfhi(hw.z), a6 = bflo(hw.w), a7 = bfhi(hw.w);
                      ss += (a0 * a0 + a1 * a1) + (a2 * a2 + a3 * a3) + (a4 * a4 + a5 * a5) + (a6 * a6 + a7 * a7); }
                    const bf16x8_t ah = __builtin_bit_cast(bf16x8_t, hw);
#pragma unroll
                    for (int nt = 0; nt < 6; ++nt) { const bf16x8_t bh = *(const bf16x8_t*)(wrh + (size_t)(16 * nt) * 2048 + 32 * ks), bl = *(const bf16x8_t*)(wrl + (size_t)(16 * nt) * 2048 + 32 * ks);
                        acc[nt] = __builtin_amdgcn_mfma_f32_16x16x32_bf16(ah, bh, acc[nt], 0, 0, 0);
                        acc[nt] = __builtin_amdgcn_mfma_f32_16x16x32_bf16(ah, bl, acc[nt], 0, 0, 0); }
                }
                ss += __shfl_xor(ss, 16); ss += __shfl_xor(ss, 32);
                if (fq == 0) { const float rs_ = rsqrtf(ss * (1.0f / 2048.0f) + EPS); LG[1600 + fr] = rs_; ((float*)(F.ws + WS_RSTD))[16 * tile + fr] = rs_; }
#pragma unroll
                for (int nt = 0; nt < 6; ++nt)
#pragma unroll
                    for (int i = 0; i < 4; ++i) LG[(4 * fq + i) * 100 + 16 * nt + fr] = acc[nt][i];
                LDS_WAIT(); asm volatile("" ::: "memory");
                if (lane < 16) {
                    const int row = 16 * tile + lane; const float rstd = LG[1600 + lane]; const LAS float* lr = LG + lane * 100;
                    float lg[8]; int grp = 0; float gmax = -3.0e38f;
#pragma unroll
                    for (int e = 0; e < 8; ++e) { lg[e] = lr[e] * rstd + F.in[I_BRG][l * 8 + e]; if (lg[e] > gmax) { gmax = lg[e]; grp = e; } }
                    float gden = 0.f;
#pragma unroll
                    for (int e = 0; e < 8; ++e) gden += __expf(lg[e] - gmax);
                    const float gwt = 1.0f / gden;
                    int i0 = 0, i1 = 0; float m0 = -3.0e38f, m1 = -3.0e38f;
#pragma unroll
                    for (int e = 0; e < 8; ++e) { const float v = lr[8 + grp * 8 + e] * rstd + F.in[I_BRE][l * 64 + grp * 8 + e];
                        if (v > m0) { m1 = m0; i1 = i0; m0 = v; i0 = e; } else if (v > m1) { m1 = v; i1 = e; } }
                    const float e1 = __expf(m1 - m0); const float p0 = 1.0f / (1.0f + e1), p1 = e1 / (1.0f + e1);
                    const int ex0 = grp * 8 + i0, ex1 = grp * 8 + i1;
                    const unsigned r0 = atomicAdd(&cnt[ex0], 1u), r1 = atomicAdd(&cnt[ex1], 1u);
                    unsigned* rec = (unsigned*)(F.ws + WS_ROUTE) + (size_t)row * 8;
                    rec[0] = (unsigned)ex0; rec[1] = r0; rec[2] = (unsigned)ex1; rec[3] = r1; rec[4] = __float_as_uint(gwt * p0); rec[5] = __float_as_uint(gwt * p1);
                    int* liste = (int*)(F.ws + WS_LISTE); liste[(size_t)ex0 * 32768 + r0] = row; liste[(size_t)ex1 * 32768 + r1] = row;
                }
                LDS_WAIT(); asm volatile("" ::: "memory");
            }
        }
        SEAM(pb + 6);
        if (IN(pb + 7) || IN(pb + 8) || IN(pb + 9) || IN(pb + 10)) { PHASE_LANE();
            if (F.tid == 0) { const unsigned* cnt = F.ctl + CW_CNT + 64 * l; LAS int* texp = (LAS int*)(F.misc + MO_TEXP); LAS int* pst = (LAS int*)(F.misc + MO_PST); int tb = 0;
                for (int e = 0; e < NEXP; ++e) { const int c = (int)__hip_atomic_load(&cnt[e], __ATOMIC_RELAXED, __HIP_MEMORY_SCOPE_AGENT); const int nt_ = (c + 255) >> 8; pst[e] = tb * 256; ((LAS int*)(F.misc + MO_CNT))[e] = c;
                    for (int r = 0; r < nt_; ++r) texp[tb + r] = e; tb += nt_; }
                *(LAS int*)(F.misc + MO_TOT) = tb; }
            __syncthreads();
        }
        if (IN(pb + 8)) {
            pg8::Gemm g{F.XN, (const bf16*)(F.ws + WS_W13), 0, 0, D / 2};
            pg8::MoeGatherOrder S; S.total = *(const LAS int*)(F.misc + MO_TOT) * 4; S.G = F.G; S.c = F.vcu; S.NJ = 4; S.nt0 = D / 128; S.tile_exp = (const LAS int*)(F.misc + MO_TEXP);
            S.pst = (const LAS int*)(F.misc + MO_PST); S.cnt = (const LAS int*)(F.misc + MO_CNT); S.liste = (const int*)(F.ws + WS_LISTE);
            pg8::EpiGlu E{F.H, S.tile_exp, S.pst, S.cnt, S.liste, (const float*)(F.ws + WS_RSTD)};
            pg8::gemm_phase<pg8::EpiGlu, pg8::MoeGatherOrder, true, true>(F.lds, g, S, E);
        }
        SEAM(pb + 8);
        if (IN(pb + 9)) {
            pg8::Gemm g{F.H, (const bf16*)(F.ws + WS_W2), 0, 0, DEXP / 2};
            pg8::MoeOrder S{*(const LAS int*)(F.misc + MO_TOT) * 8, F.G, F.vcu, 8, DEXP / 128, (const LAS int*)(F.misc + MO_TEXP)};
            pg8::EpiY E{(unsigned char*)F.Y};
            pg8::gemm_phase<pg8::EpiY, pg8::MoeOrder, true, true>(F.lds, g, S, E);
        }
        SEAM(pb + 9);
        if (IN(pb + 10)) { PHASE_LANE();
            for (int row = F.gw; row < T; row += F.NGW) {
                const unsigned* rec = (const unsigned*)(F.ws + WS_ROUTE) + (size_t)row * 8;
                const float w0 = __uint_as_float(rec[4]) * 0.03125f, w1 = __uint_as_float(rec[5]) * 0.03125f;
                const LAS int* pst = (const LAS int*)(F.misc + MO_PST); const int p0 = pst[rec[0]] + (int)rec[1], p1 = pst[rec[2]] + (int)rec[3];
                const unsigned* y0 = (const unsigned*)((const unsigned char*)F.Y + (size_t)p0 * D) + F.lane; const unsigned* y1 = (const unsigned*)((const unsigned char*)F.Y + (size_t)p1 * D) + F.lane;
                f32x4 v[8];
                { const v2u* hr = (const v2u*)((const bf16*)(F.ws + WS_HB) + (size_t)row * D) + F.lane;
#pragma unroll
                  for (int j = 0; j < 8; ++j) { const v2u w = hr[64 * j]; v[j] = (f32x4){bflo(w.x), bfhi(w.x), bflo(w.y), bfhi(w.y)}; } }
#pragma unroll
                for (int j = 0; j < 8; ++j) { const int a = (int)y0[64 * j], c = (int)y1[64 * j];
                    const auto a01 = __builtin_amdgcn_cvt_pk_f32_fp8(a, false), a23 = __builtin_amdgcn_cvt_pk_f32_fp8(a, true), c01 = __builtin_amdgcn_cvt_pk_f32_fp8(c, false), c23 = __builtin_amdgcn_cvt_pk_f32_fp8(c, true);
                    v[j].x += w0 * a01[0] + w1 * c01[0]; v[j].y += w0 * a01[1] + w1 * c01[1]; v[j].z += w0 * a23[0] + w1 * c23[0]; v[j].w += w0 * a23[1] + w1 * c23[1]; }
                if (l + 1 < DEPTH) { v2u* hw_ = (v2u*)((bf16*)(F.ws + WS_HB) + (size_t)row * D) + F.lane;
#pragma unroll
                    for (int j = 0; j < 8; ++j) hw_[64 * j] = (v2u){pg8::cvt_pk_bf16(v[j].x, v[j].y), pg8::cvt_pk_bf16(v[j].z, v[j].w)}; }
                else { f32x4* orow = (f32x4*)(F.out + (size_t)row * D) + F.lane;
#pragma unroll
                    for (int j = 0; j < 8; ++j) orow[64 * j] = v[j]; }
                if (l + 1 < DEPTH) { const float rstd = row_rstd(v); norm_store_bf16(v, rstd, F.in[I_N1G] + (l + 1) * D, F.XN + (size_t)row * D, F.lane); norm_store_fp8(v, rstd, F.in[I_N1G] + (l + 1) * D, (unsigned char*)(F.ws + WS_XN8) + (size_t)row * D, F.lane); }
            }
        }
        SEAM(pb + 10);
    }
__global__ void __launch_bounds__(NWAVES * 64, 2) fwd_kernel(Args args) {
    extern __shared__ __attribute__((aligned(16))) unsigned char lds_raw[];
    Frame F;
    F.lds = (LAS unsigned char*)lds_raw; F.misc = F.lds + MISC_OFF;
    F.tid = threadIdx.x; F.lane = F.tid & 63; F.wave = __builtin_amdgcn_readfirstlane(F.tid >> 6);
    F.G = gridDim.x; { const int bx = blockIdx.x; F.vcu = (F.G % 8 == 0) ? (bx % 8) * (F.G / 8) + bx / 8 : bx; }
    F.gw = F.vcu * NWAVES + F.wave; F.NGW = F.G * NWAVES;
    F.in = args.in; F.out = args.out; F.ws = args.ws; F.ctl = (unsigned*)(args.ws + WS_CTL);
    F.Z = (bf16*)(args.ws + WS_Z); F.XN = (bf16*)(args.ws + WS_XN); F.OCAT = (bf16*)(args.ws + WS_OCAT); F.MERGED = (bf16*)(args.ws + WS_MERGED);
    F.XS = (bf16*)(args.ws + WS_XS); F.Y = (bf16*)(args.ws + WS_Y); F.H = (bf16*)(args.ws + WS_H);
    F.S = (float*)(args.ws + WS_S); F.GO = (float*)(args.ws + WS_GO); F.MASK = (unsigned*)(args.ws + WS_MASK);
    const int lo = args.ph_lo, hi = args.ph_hi;
    const bool use_bar = (hi - lo) > 1;
    for (int u = F.tid; u < 64; u += NWAVES * 64) ((LAS unsigned*)F.misc)[u] = 0u;
    ((LAS unsigned long long*)(F.misc + MO_SS))[F.tid] = 0ull;
    for (int i = F.tid; i < 2 * 4 * 128; i += NWAVES * 64) { const int l_ = i >> 9, k_ = (i >> 7) & 3, d_ = i & 127; ((LAS float*)(F.misc + MO_GN))[i] = F.in[k_ == 0 ? I_AQG : (k_ == 1 ? I_AKG : (k_ == 2 ? I_BQG : I_BKG))][l_ * 128 + d_]; }
    for (int i = F.tid; i < 12 * 129; i += NWAVES * 64) { const int hd = i / 129, dd = i % 129; int bk;
        if (dd < 16) bk = dd; else { bk = 16 + (int)(logf((float)dd / 16.0f) / 2.0794415416798357f * 16.0f); bk = bk > 31 ? 31 : bk; }
        ((LAS float*)(F.misc + MO_TAB2))[i] = F.in[I_RELB][bk * 12 + hd] * 1.4426950408889634f; }
    __syncthreads();
    XcdBarrier bar; bar.bar = F.ctl + CW_BAR; bar.x = 0; bar.st = nullptr;
    if (use_bar) bar = xcd_barrier_post(F.ctl + CW_BAR, (volatile LAS unsigned*)(F.misc + MO_BARW));

    if (IN(0)) { PHASE_LANE();
        LAS float* scr = (LAS float*)(F.lds + F.wave * 16384);
        constexpr int I_IN = (2048 / 64) * (D_IN / 32);
        constexpr int I_BA = (512 / 64) * (2048 / 32), I_BB = (1024 / 64) * (2048 / 32), I_BC = I_BA, I_O = (2048 / 64) * (2048 / 32);
        constexpr int PER_L = I_IN + I_BA + I_BB + I_BC + I_O;
        for (int it = F.gw; it < DEPTH * PER_L; it += F.NGW) {
            const int l = it / PER_L; int r = it % PER_L;
            bf16* win = (bf16*)(F.ws + WS_WIN + l * WIN_L); bf16* wbr = (bf16*)(F.ws + WS_WBR + l * WBR_L); bf16* wo = (bf16*)(F.ws + WS_WO + l * WO_L);
            if (r < I_IN) { const int nb_ = r % (D_IN / 32);
                const bool has8 = nb_ < 56 || (nb_ >= 58 && nb_ <= 106) || nb_ >= 122, hasb = (nb_ >= 56 && nb_ <= 58) || (nb_ >= 106 && nb_ <= 122) || nb_ == 138;
                if (has8) transpose_item_fp8(F.in[I_WIN] + (size_t)l * 2048 * D_IN, D_IN, (unsigned char*)win, 2048, 64.0f, scr, r, F.lane, MapWin8{});
                if (hasb) transpose_item(F.in[I_WIN] + (size_t)l * 2048 * D_IN, D_IN, win + (size_t)12 * 1024 * 1024, 2048, 0, scr, r, F.lane, MapWinB{});
                continue; } r -= I_IN;
            if (r < I_BA) { transpose_item(F.in[I_WBA] + (size_t)l * 512 * 2048, 2048, wbr, 2048, 0, scr, r, F.lane, MapId{0}); continue; } r -= I_BA;
            if (r < I_BB) { transpose_item(F.in[I_WBB] + (size_t)l * 1024 * 2048, 2048, wbr, 2048, 512, scr, r, F.lane, MapId{0}); continue; } r -= I_BB;
            if (r < I_BC) { transpose_item(F.in[I_WBC] + (size_t)l * 512 * 2048, 2048, wbr, 2048, 1536, scr, r, F.lane, MapId{0}); continue; } r -= I_BC;
            transpose_item(F.in[I_WO] + (size_t)l * 2048 * 2048, 2048, wo, 2048, 0, scr, r, F.lane, MapId{0});
        }
        for (int i = F.gw * 64 + F.lane; i < DEPTH * 160 * 256; i += F.NGW * 64) { const int l = i / (160 * 256), r = (i / 256) % 160, c = i % 256;
            *(v4u*)((bf16*)(F.ws + WS_WIN + l * WIN_L) + (size_t)12 * 1024 * 1024 + (size_t)(ZC_PAD - 3328 + r) * 2048 + 8 * c) = (v4u){0u, 0u, 0u, 0u}; }
        for (int i = F.gw * 64 + F.lane; i < DEPTH * 96 * 2048; i += F.NGW * 64) { const int l = i / (96 * 2048), e = (i / 2048) % 96, k = i % 2048;
            float val = 0.f; if (e < 8) val = F.in[I_WRG][(size_t)l * D * 8 + (size_t)k * 8 + e]; else if (e < 72) val = F.in[I_WRE][(size_t)l * D * 64 + (size_t)k * 64 + (e - 8)];
            val *= F.in[I_N2G][l * D + k];
            const unsigned hi = f2bf(val); const float rem = val - bf1((bf16)hi);
            ((bf16*)(F.ws + WS_WRH + l * WR_L))[e * 2048 + k] = (bf16)hi; ((bf16*)(F.ws + WS_WRL + l * WR_L))[e * 2048 + k] = (bf16)f2bf(rem); }
        for (int mrow = F.gw; mrow < T; mrow += F.NGW) { f32x4 v[8]; load_row(F.in[I_X] + (size_t)mrow * D, F.lane, v); const float rstd = row_rstd(v);
            { v2u* hw_ = (v2u*)((bf16*)(F.ws + WS_HB) + (size_t)mrow * D) + F.lane;
#pragma unroll
              for (int j = 0; j < 8; ++j) hw_[64 * j] = (v2u){pg8::cvt_pk_bf16(v[j].x, v[j].y), pg8::cvt_pk_bf16(v[j].z, v[j].w)}; }
            norm_store_bf16(v, rstd, F.in[I_N1G], F.XN + (size_t)mrow * D, F.lane); norm_store_fp8(v, rstd, F.in[I_N1G], (unsigned char*)(F.ws + WS_XN8) + (size_t)mrow * D, F.lane); }
    }
    SEAM(0);

    layer_body<0>(F, bar, lo, hi);
    layer_body<1>(F, bar, lo, hi);
}


#ifndef N_LAUNCH_MODE
#define N_LAUNCH_MODE 1
#endif
extern "C" void kernel_launch(void* const* d_in, const int* in_sizes, int n_in, void* d_out, int out_size, void* d_ws, size_t ws_size, hipStream_t stream) {
    static int grid = 0;
    if (grid == 0) {
        if (n_in != 24 || out_size != T * D || ws_size < WS_END) { fprintf(stderr, "kernel_launch: unexpected shapes (n_in %d out %d ws %zu)\n", n_in, out_size, ws_size); grid = -1; return; }
        int dev = 0, cus = 0, per_cu = 0;
        if (hipGetDevice(&dev) != hipSuccess || hipDeviceGetAttribute(&cus, hipDeviceAttributeMultiprocessorCount, dev) != hipSuccess) { grid = -1; return; }
        if (hipFuncSetAttribute((const void*)fwd_kernel, hipFuncAttributeMaxDynamicSharedMemorySize, LDS_BYTES) != hipSuccess) { fprintf(stderr, "kernel_launch: hipFuncSetAttribute failed\n"); grid = -1; return; }
        if (hipOccupancyMaxActiveBlocksPerMultiprocessor(&per_cu, (const void*)fwd_kernel, NWAVES * 64, LDS_BYTES) != hipSuccess || per_cu < 1) { fprintf(stderr, "kernel_launch: occupancy query says %d\n", per_cu); }
        (void)hipGetLastError();
        grid = cus;
    }
    if (grid < 0) return;
    (void)hipMemsetAsync((char*)d_ws + WS_CTL, 0, CTL_ZERO_BYTES, stream);
    Args a{};
    for (int i = 0; i < 24; ++i) a.in[i] = (const float*)d_in[i];
    a.out = (float*)d_out; a.ws = (unsigned char*)d_ws;
    constexpr int NPH = 1 + 11 * DEPTH;
#if N_LAUNCH_MODE == 1
    a.ph_lo = 0; a.ph_hi = NPH;
    hipLaunchKernelGGL(fwd_kernel, dim3(grid), dim3(NWAVES * 64), LDS_BYTES, stream, a);
#else
    for (int p = 0; p < NPH; ++p) { a.ph_lo = p; a.ph_hi = p + 1; hipLaunchKernelGGL(fwd_kernel, dim3(grid), dim3(NWAVES * 64), LDS_BYTES, stream, a); }
#endif
    const hipError_t le = hipPeekAtLastError();
    if (le != hipSuccess) fprintf(stderr, "kernel_launch: launch failed: %s\n", hipGetErrorName(le));
}
```

```cpp
#include <hip/hip_runtime.h>
#include <cstdio>
#include <cstdint>

__device__ __forceinline__ int lane_id() { return (int)__builtin_amdgcn_mbcnt_hi(~0u, __builtin_amdgcn_mbcnt_lo(~0u, 0u)); }
namespace pg8 {
#define PG8_LAS __attribute__((address_space(3)))
typedef unsigned short bf16_t;
typedef short bf16x8 __attribute__((ext_vector_type(8)));
typedef float f32x4 __attribute__((ext_vector_type(4)));
typedef unsigned u32x4 __attribute__((ext_vector_type(4)));
typedef unsigned u32x2 __attribute__((ext_vector_type(2)));
constexpr int BM = 256, BK = 64, HALF = 128, HTB = HALF * BK * 2  , STAGE_BYTES = 8 * HTB, NXCD = 8, WGM = 8;

__host__ __device__ __forceinline__ int lds_byte(int r, int c) { const int st = (r >> 4) * 2 + (c >> 5), rr = r & 15, cc = c & 31, ob = rr * 64 + cc * 2; return st * 1024 + (ob ^ (((ob >> 9) & 1) << 5)); }
__host__ __device__ __forceinline__ void stage_rc(int b, int& R, int& C) { const int st = b / 1024, sb = b % 1024, swz = sb ^ (((sb >> 9) & 1) << 5); R = (st >> 1) * 16 + swz / 64; C = (st & 1) * 32 + (swz % 64) / 2; }
__host__ __device__ __forceinline__ int perm32(int rho) { const int n = rho >> 4, i = rho & 15; return 8 * (i >> 2) + 4 * n + (i & 3); }

struct Unit { int pm, pn, koff, nt, seg; };
struct Gemm { const bf16_t* A; const bf16_t* Bt; int M, N, K; };

struct StaticOrder {
    static constexpr bool GATHER = false;
    int nM, nN, nwg, G, c, nt0;
    __device__ __forceinline__ int row_token(const Unit&, int) const { return 0; }
    __device__ void init(int M, int N, int K, int G_, int c_) { nM = M / BM; nN = N / BM; nwg = nM * nN; G = G_; c = c_; nt0 = K / BK; }
    __device__ bool tile(long L, Unit& u) const {
        if (L >= nwg) return false;
        int wgid = (int)L; { const int q = nwg / NXCD, r = nwg % NXCD, xcd = wgid % NXCD, off = wgid / NXCD; wgid = (xcd < r ? xcd * (q + 1) : r * (q + 1) + (xcd - r) * q) + off; }
        const int nig = WGM * nN, gid = wgid / nig, fm = gid * WGM, gsz = (nM - fm) < WGM ? (nM - fm) : WGM;
        u.pm = fm + ((wgid % nig) % gsz); u.pn = (wgid % nig) / gsz; return true;
    }
    __device__ bool next(int i, Unit& u) const { u.koff = 0; u.nt = nt0; u.seg = 0; return tile((long)i * G + c, u); }
    __device__ __forceinline__ void a_ready(const Unit&) const {}
    __device__ __forceinline__ void done(const Unit&) const {}
};
struct MergeOrder : StaticOrder {
    __device__ bool next(int i, Unit& u) const { const int rnd = i / 3, sg = i - 3 * rnd; u.seg = sg; u.koff = sg == 0 ? 0 : (sg == 1 ? 512 : 1536); u.nt = sg == 1 ? 16 : 8; return tile((long)rnd * G + c, u); }
};
struct MoeOrder {
    static constexpr bool GATHER = false;
    int total, G, c, NJ, nt0; const PG8_LAS int* tile_exp;
    __device__ bool next(int i, Unit& u) const {
        const long L = (long)i * G + c; if (L >= total) return false;
        const int R = (int)L / NJ, j = (int)L % NJ; u.pm = R; u.pn = tile_exp[R] * NJ + j; u.koff = 0; u.nt = nt0; u.seg = 0; return true;
    }
    __device__ __forceinline__ int row_token(const Unit&, int) const { return 0; }
    __device__ __forceinline__ void a_ready(const Unit&) const {}
    __device__ __forceinline__ void done(const Unit&) const {}
};
struct MoeGatherOrder : MoeOrder {
    static constexpr bool GATHER = true;
    const PG8_LAS int* pst; const PG8_LAS int* cnt; const int* liste;
    __device__ __forceinline__ int row_token(const Unit& u, int r) const {
        const int e = tile_exp[u.pm], lr = u.pm * 256 - pst[e] + r;
        return lr < cnt[e] ? liste[(size_t)e * 32768 + lr] : 0;
    }
};

typedef __bf16 bf16x2v __attribute__((ext_vector_type(2)));
typedef float f32x2v __attribute__((ext_vector_type(2)));
__device__ __forceinline__ unsigned cvt_pk_bf16(float lo, float hi) { const f32x2v v = {lo, hi}; const bf16x2v b = __builtin_convertvector(v, bf16x2v); return __builtin_bit_cast(unsigned, b); }
__device__ __forceinline__ float bflo(unsigned w) { return __uint_as_float(w << 16); }
__device__ __forceinline__ float bfhi(unsigned w) { return __uint_as_float(w & 0xffff0000u); }
__device__ __forceinline__ float sigm(float v) { return __builtin_amdgcn_rcpf(1.0f + __builtin_amdgcn_exp2f(-1.44269504f * v)); }
__device__ __forceinline__ unsigned q8x4(const f32x4 s) {
    const unsigned a = (unsigned)fminf(s[0], 255.5f), b = (unsigned)fminf(s[1], 255.5f), c = (unsigned)fminf(s[2], 255.5f), d = (unsigned)fminf(s[3], 255.5f);
    return a | (b << 8) | (c << 16) | (d << 24);
}

constexpr int ZP = 5120;
constexpr int ZC_GA = 5120, ZC_GB = 7168, ZC_GC = 9216;
constexpr size_t GT_TILE = 65536, GT_GATE = (size_t)128 * 8 * GT_TILE;

template <int PN_OFF> struct EpiInProj {
    static constexpr bool PERM = true, AFTER_DRAIN = false, CHAIN = false;
    bf16_t* O; unsigned char* GT; PG8_LAS unsigned long long* ss;
    const PG8_LAS float* gains;
    __device__ __forceinline__ void operator()(const f32x4 (&acc)[2][2][4][2], const Unit& u, int wr, int wc, int fr, int fq) const {
        const int pn = PN_OFF ? u.pn + 13 : (u.pn < 13 ? u.pn : u.pn + 3);
        int row0 = u.pm * BM + wr * 64 + fr, col0 = pn * BM + wc * 32 + 8 * fq;
        asm volatile("" : "+v"(row0), "+v"(col0));
        const int act = pn >= 20 ? 2 : (pn >= 18 ? 1 : 0);
        const bool hn = PN_OFF == 0 && pn <= 7;
        f32x4 gn0 = (f32x4){1.f, 1.f, 1.f, 1.f}, gn1 = gn0; int lr = 0;
        if (hn) {
            lr = wr * 64 + fr; asm volatile("" : "+v"(lr));
#pragma unroll
            for (int ai = 0; ai < 2; ++ai)
#pragma unroll
                for (int m = 0; m < 4; ++m)
#pragma unroll
                    for (int bj = 0; bj < 2; ++bj) { const f32x4 a = acc[ai][bj][m][0], b = acc[ai][bj][m][1];
                        float s = (a[0] * a[0] + a[1] * a[1]) + (a[2] * a[2] + a[3] * a[3]) + (b[0] * b[0] + b[1] * b[1]) + (b[2] * b[2] + b[3] * b[3]);
                        s += __shfl_xor(s, 16); s += __shfl_xor(s, 32);
                        if (fq == 0) __hip_atomic_fetch_add(ss + (ai * HALF + m * 16 + lr) * 2 + bj, (unsigned long long)(s * 1048576.0f), __ATOMIC_RELAXED, __HIP_MEMORY_SCOPE_WORKGROUP); }
            asm volatile("s_waitcnt lgkmcnt(0)" ::: "memory"); __builtin_amdgcn_s_barrier(); asm volatile("" ::: "memory");
            const PG8_LAS float* gp = gains + (pn <= 1 ? 0 : (pn == 2 ? 128 : (pn <= 6 ? 256 : 384))) + wc * 32 + 8 * fq;
            gn0 = *(const PG8_LAS f32x4*)gp; gn1 = *(const PG8_LAS f32x4*)(gp + 4);
        }
        if (act == 2) {
            int lo16 = (wr * 4 + wc) * 8192 + (fq * 16 + fr) * 16; asm volatile("" : "+v"(lo16));
            unsigned char* gp = GT + (size_t)((pn - 20) >> 3) * GT_GATE + ((size_t)u.pm * 8 + ((pn - 20) & 7)) * GT_TILE + lo16;
#pragma unroll
            for (int ai = 0; ai < 2; ++ai)
#pragma unroll
                for (int m = 0; m < 4; ++m) { u32x4 w;
#pragma unroll
                    for (int bj = 0; bj < 2; ++bj) { const f32x4 v0 = acc[ai][bj][m][0] * (-1.44269504f * 0.015625f), v1 = acc[ai][bj][m][1] * (-1.44269504f * 0.015625f); f32x4 s0, s1;
#pragma unroll
                        for (int j = 0; j < 4; ++j) { s0[j] = __builtin_amdgcn_exp2f(v0[j]); s1[j] = __builtin_amdgcn_exp2f(v1[j]); }
                        s0 = s0 * 0.00390625f + 0.00390625f; s1 = s1 * 0.00390625f + 0.00390625f;
#pragma unroll
                        for (int j = 0; j < 4; ++j) { s0[j] = __builtin_amdgcn_rcpf(s0[j]); s1[j] = __builtin_amdgcn_rcpf(s1[j]); }
                        w[2 * bj] = q8x4(s0); w[2 * bj + 1] = q8x4(s1); }
                    *(u32x4*)(gp + (ai * 4 + m) * 1024) = w; }
            return;
        }
#pragma unroll
        for (int ai = 0; ai < 2; ++ai)
#pragma unroll
            for (int m = 0; m < 4; ++m) { bf16_t* rowp = O + (size_t)(row0 + ai * HALF + m * 16) * ZP + col0;
#pragma unroll
                for (int bj = 0; bj < 2; ++bj) { f32x4 v0 = acc[ai][bj][m][0], v1 = acc[ai][bj][m][1];
                    if (hn && !(pn == 2 && bj == 1)) { const float r = rsqrtf((float)ss[(ai * HALF + m * 16 + lr) * 2 + bj] * (0.015625f * 0.015625f / 128.0f / 1048576.0f) + 1e-6f) * 0.015625f;
                        v0 = v0 * r * gn0; v1 = v1 * r * gn1; }
                    else if (PN_OFF == 0) { v0 = v0 * 0.015625f; v1 = v1 * 0.015625f; }
                    if (act) {
#pragma unroll
                        for (int j = 0; j < 4; ++j) { v0[j] *= sigm(v0[j]); v1[j] *= sigm(v1[j]); } }
                    u32x4 w; w.x = cvt_pk_bf16(v0[0], v0[1]); w.y = cvt_pk_bf16(v0[2], v0[3]); w.z = cvt_pk_bf16(v1[0], v1[1]); w.w = cvt_pk_bf16(v1[2], v1[3]);
                    *(u32x4*)(rowp + bj * HALF) = w; } }
        if (hn) { asm volatile("s_waitcnt lgkmcnt(0)" ::: "memory"); __builtin_amdgcn_s_barrier(); asm volatile("" ::: "memory");
            ss[(wr * 4 + wc) * 64 + fq * 16 + fr] = 0ull; }
    }
};
template <int MODE = 0> struct EpiMergeT {
    static constexpr bool PERM = true, AFTER_DRAIN = false, CHAIN = true;
    const unsigned char* GT; bf16_t* O;
    __device__ __forceinline__ void operator()(f32x4 (&acc)[2][2][4][2], const Unit& u, int wr, int wc, int fr, int fq) const {
        if (MODE == 2) return;
        const int row0 = u.pm * BM + wr * 64 + fr, col0 = u.pn * BM + wc * 32 + 8 * fq;
        int lo16 = (wr * 4 + wc) * 8192 + (fq * 16 + fr) * 16; asm volatile("" : "+v"(lo16));
        const unsigned char* gp = GT + ((size_t)u.pm * 8 + u.pn) * GT_TILE + lo16;
        const size_t cn = (size_t)u.seg * GT_GATE, cd = (size_t)(u.seg == 0 ? 1 : 2) * GT_GATE;
        const bool fin = u.seg == 2;
        u32x4 gn[2][4], gd[2][4];
#pragma unroll
        for (int ai = 0; ai < 2; ++ai)
#pragma unroll
            for (int m = 0; m < 4; ++m) {
                if (MODE == 1) { gn[ai][m] = (u32x4){0x80808080u + (unsigned)u.pm, 0x80808080u, 0x80808080u, 0x80808080u}; gd[ai][m] = gn[ai][m]; } else {
                gn[ai][m] = *(const u32x4*)(gp + cn + (ai * 4 + m) * 1024); gd[ai][m] = *(const u32x4*)(gp + cd + (ai * 4 + m) * 1024); } }
#pragma unroll
        for (int ai = 0; ai < 2; ++ai)
#pragma unroll
            for (int m = 0; m < 4; ++m)
#pragma unroll
                for (int bj = 0; bj < 2; ++bj) { const size_t r = (size_t)(row0 + ai * HALF + m * 16);
#pragma unroll
                    for (int w = 0; w < 2; ++w)
#pragma unroll
                        for (int k = 0; k < 4; ++k) { const float qn = (float)((gn[ai][m][2 * bj + w] >> (8 * k)) & 0xffu) + 0.5f, qd = (float)((gd[ai][m][2 * bj + w] >> (8 * k)) & 0xffu) + 0.5f;
                            acc[ai][bj][m][w][k] *= qn * __builtin_amdgcn_rcpf(fin ? 256.0f : qd); }
                    if (fin) { const f32x4 v0 = acc[ai][bj][m][0], v1 = acc[ai][bj][m][1];
                        u32x4 w; w.x = cvt_pk_bf16(v0[0], v0[1]); w.y = cvt_pk_bf16(v0[2], v0[3]); w.z = cvt_pk_bf16(v1[0], v1[1]); w.w = cvt_pk_bf16(v1[2], v1[3]);
                        *(u32x4*)(O + r * 2048 + col0 + bj * HALF) = w; } }
    }
};
typedef EpiMergeT<0> EpiMerge;
struct EpiResid {
    static constexpr int PERM = 2; static constexpr bool AFTER_DRAIN = false, CHAIN = false;
    bf16_t* hb; unsigned char* xu; const float* gain; PG8_LAS unsigned char* stg;
    __device__ __forceinline__ void operator()(const f32x4 (&acc)[2][2][4][2], const Unit& u, int wr, int wc, int fr, int fq) const {
        int lane = fq * 16 + fr; asm volatile("" : "+v"(lane));
        PG8_LAS unsigned char* s0 = stg + (wr * 4 + wc) * 1024;
        const int r8 = lane >> 3, pc = lane & 7;
        const int offc = r8 * 128 + ((pc ^ r8) << 4);
        const int offa0 = (fr >> 3) * 8192 + (fr & 7) * 128 + ((fq ^ (fr & 7)) << 4), offa1 = (fr >> 3) * 8192 + (fr & 7) * 128 + (((4 + fq) ^ (fr & 7)) << 4);
        const int xs = 2 * (fr >> 2), offxw0 = fr * 64 + ((fq ^ xs) << 3), offxw1 = fr * 64 + (((4 + fq) ^ xs) << 3);
        const int xr = lane >> 2, xq = lane & 3, offxr = xr * 64 + (((2 * xq) ^ (2 * (xr >> 2))) << 3);
        const size_t goff = (size_t)(u.pm * BM + wr * 64 + r8) * 2048 + u.pn * BM + wc * 64 + pc * 8;
        const size_t xoff = (size_t)(u.pm * BM + wr * 64 + xr) * 2048 + u.pn * BM + wc * 64 + xq * 16;
        f32x4 gv[2][2];
#pragma unroll
        for (int bj = 0; bj < 2; ++bj)
#pragma unroll
            for (int n = 0; n < 2; ++n) gv[bj][n] = *(const f32x4*)(gain + u.pn * BM + wc * 64 + bj * 32 + 8 * fq + 4 * n);
        const f32x4 lo4 = (f32x4){-440.f, -440.f, -440.f, -440.f}, hi4 = (f32x4){440.f, 440.f, 440.f, 440.f};
#pragma unroll
        for (int ai = 0; ai < 2; ++ai) {
            u32x4 bb[4][2];
#pragma unroll
            for (int m = 0; m < 4; ++m)
#pragma unroll
                for (int j = 0; j < 2; ++j) bb[m][j] = *(const u32x4*)(hb + goff + (size_t)(ai * HALF + m * 16 + 8 * j) * 2048);
#pragma unroll
            for (int m = 0; m < 4; ++m) {
                *(PG8_LAS u32x4*)(s0 + offc) = bb[m][0]; *(PG8_LAS u32x4*)(s0 + 8192 + offc) = bb[m][1];
                asm volatile("" ::: "memory");
                const u32x4 a0 = *(const PG8_LAS u32x4*)(s0 + offa0), a1 = *(const PG8_LAS u32x4*)(s0 + offa1);
                asm volatile("" ::: "memory");
                u32x2 xw[2];
#pragma unroll
                for (int bj = 0; bj < 2; ++bj) { const u32x4 w = bj ? a1 : a0;
                    const f32x4 h0 = (f32x4){bflo(w.x), bfhi(w.x), bflo(w.y), bfhi(w.y)} + acc[ai][bj][m][0], h1 = (f32x4){bflo(w.z), bfhi(w.z), bflo(w.w), bfhi(w.w)} + acc[ai][bj][m][1];
                    u32x4 hw; hw.x = cvt_pk_bf16(h0[0], h0[1]); hw.y = cvt_pk_bf16(h0[2], h0[3]); hw.z = cvt_pk_bf16(h1[0], h1[1]); hw.w = cvt_pk_bf16(h1[2], h1[3]);
                    *(PG8_LAS u32x4*)(s0 + (bj ? offa1 : offa0)) = hw;
                    const f32x4 x0 = __builtin_elementwise_min(__builtin_elementwise_max(h0 * gv[bj][0], lo4), hi4), x1 = __builtin_elementwise_min(__builtin_elementwise_max(h1 * gv[bj][1], lo4), hi4);
                    int w0 = 0, w1 = 0;
                    w0 = __builtin_amdgcn_cvt_pk_fp8_f32(x0[0], x0[1], w0, false); w0 = __builtin_amdgcn_cvt_pk_fp8_f32(x0[2], x0[3], w0, true);
                    w1 = __builtin_amdgcn_cvt_pk_fp8_f32(x1[0], x1[1], w1, false); w1 = __builtin_amdgcn_cvt_pk_fp8_f32(x1[2], x1[3], w1, true);
                    xw[bj] = (u32x2){(unsigned)w0, (unsigned)w1}; }
                asm volatile("" ::: "memory");
                const u32x4 o0 = *(const PG8_LAS u32x4*)(s0 + offc), o1 = *(const PG8_LAS u32x4*)(s0 + 8192 + offc);
                asm volatile("" ::: "memory");
                *(PG8_LAS u32x2*)(s0 + offxw0) = xw[0]; *(PG8_LAS u32x2*)(s0 + offxw1) = xw[1];
                asm volatile("" ::: "memory");
                const u32x4 xo = *(const PG8_LAS u32x4*)(s0 + offxr);
                asm volatile("" ::: "memory");
                *(u32x4*)(hb + goff + (size_t)(ai * HALF + m * 16) * 2048) = o0; *(u32x4*)(hb + goff + (size_t)(ai * HALF + m * 16 + 8) * 2048) = o1;
                *(u32x4*)(xu + xoff + (size_t)(ai * HALF + m * 16) * 2048) = xo;
            }
        }
        asm volatile("s_waitcnt lgkmcnt(0)" ::: "memory");
    }
};
struct EpiGlu {
    static constexpr bool PERM = false, AFTER_DRAIN = false, CHAIN = false;
    bf16_t* H; const PG8_LAS int* tile_exp; const PG8_LAS int* pst; const PG8_LAS int* cnt; const int* liste; const float* rstd;
    __device__ __forceinline__ void operator()(const f32x4 (&acc)[2][2][4][2], const Unit& u, int wr, int wc, int fr, int fq) const {
        const int row0 = u.pm * BM + wr * 64 + fr, pj = u.pn & 3;
        const int e = tile_exp[u.pm], lr0 = u.pm * 256 - pst[e] + wr * 64 + fr, ce = cnt[e];
        int tok[2][4]; float rs[2][4];
#pragma unroll
        for (int ai = 0; ai < 2; ++ai)
#pragma unroll
            for (int m = 0; m < 4; ++m) { const int lr = lr0 + ai * HALF + m * 16; tok[ai][m] = lr < ce ? liste[(size_t)e * 32768 + lr] : 0; }
#pragma unroll
        for (int ai = 0; ai < 2; ++ai)
#pragma unroll
            for (int m = 0; m < 4; ++m) rs[ai][m] = rstd[tok[ai][m]] * 0.015625f;
#pragma unroll
        for (int ai = 0; ai < 2; ++ai)
#pragma unroll
            for (int m = 0; m < 4; ++m) { unsigned char* rowp = (unsigned char*)H + (size_t)(row0 + ai * HALF + m * 16) * 512; const float r = rs[ai][m];
#pragma unroll
                for (int bj = 0; bj < 2; ++bj) { const f32x4 a = acc[ai][bj][m][0] * r, b = acc[ai][bj][m][1] * r;
                    const int hc = 16 * (8 * pj + 4 * bj + wc) + 4 * fq;
                    float hv[4];
#pragma unroll
                    for (int j = 0; j < 4; ++j) hv[j] = fminf(fmaxf(a[j] * sigm(a[j]) * b[j] * 8.0f, -440.0f), 440.0f);
                    int w = 0; w = __builtin_amdgcn_cvt_pk_fp8_f32(hv[0], hv[1], w, false); w = __builtin_amdgcn_cvt_pk_fp8_f32(hv[2], hv[3], w, true);
                    *(int*)(rowp + hc) = w; } }
    }
};
struct EpiY {
    static constexpr bool PERM = true, AFTER_DRAIN = false, CHAIN = false;
    unsigned char* Y;
    __device__ __forceinline__ void operator()(const f32x4 (&acc)[2][2][4][2], const Unit& u, int wr, int wc, int fr, int fq) const {
        const int row0 = u.pm * BM + wr * 64 + fr, col0 = (u.pn & 7) * BM + wc * 32 + 8 * fq;
        const f32x4 lo4 = (f32x4){-440.f, -440.f, -440.f, -440.f}, hi4 = (f32x4){440.f, 440.f, 440.f, 440.f};
#pragma unroll
        for (int ai = 0; ai < 2; ++ai)
#pragma unroll
            for (int m = 0; m < 4; ++m) { unsigned char* rowp = Y + (size_t)(row0 + ai * HALF + m * 16) * 2048 + col0;
#pragma unroll
                for (int bj = 0; bj < 2; ++bj) {
                    const f32x4 v0 = __builtin_elementwise_min(__builtin_elementwise_max(acc[ai][bj][m][0] * 0.125f, lo4), hi4), v1 = __builtin_elementwise_min(__builtin_elementwise_max(acc[ai][bj][m][1] * 0.125f, lo4), hi4);
                    int w0 = 0, w1 = 0;
                    w0 = __builtin_amdgcn_cvt_pk_fp8_f32(v0[0], v0[1], w0, false); w0 = __builtin_amdgcn_cvt_pk_fp8_f32(v0[2], v0[3], w0, true);
                    w1 = __builtin_amdgcn_cvt_pk_fp8_f32(v1[0], v1[1], w1, false); w1 = __builtin_amdgcn_cvt_pk_fp8_f32(v1[2], v1[3], w1, true);
                    *(u32x2*)(rowp + bj * HALF) = (u32x2){(unsigned)w0, (unsigned)w1}; } }
    }
};

typedef int v4i_t __attribute__((ext_vector_type(4)));
typedef int v8i_t __attribute__((ext_vector_type(8)));
template <class Epi, class Sched, bool ALIGN_EPI = false, bool FP8 = false>
__device__ __forceinline__ void gemm_phase(PG8_LAS unsigned char* lds, const Gemm g, const Sched& S, const Epi& E) {
    int tid = threadIdx.x; asm volatile("" : "+v"(tid));
    const int wid = __builtin_amdgcn_readfirstlane(tid >> 6), lane = tid & 63, wr = wid >> 2, wc = wid & 3, fr = lane & 15, fq = lane >> 4;
    const int K = g.K;
    unsigned voffA[2], voffB[2]; int RA[2]; unsigned CA2[2];
#pragma unroll
    for (int i = 0; i < 2; ++i) { int R, C; stage_rc(tid * 16 + i * 8192, R, C); const int Rb = Epi::PERM == 2 ? ((R >> 5) * 64 + perm32(R & 31)) : (Epi::PERM ? ((R & ~31) + perm32(R & 31)) : R);
        voffA[i] = (unsigned)(R * K + C) * 2u; voffB[i] = (unsigned)(Rb * K + C) * 2u; RA[i] = R; CA2[i] = (unsigned)C * 2u; }
    unsigned gAc[2][2], gAn[2][2];
#define PG8_GOFF(dst, uu) do { _Pragma("unroll") for (int h_ = 0; h_ < 2; ++h_) _Pragma("unroll") for (int i_ = 0; i_ < 2; ++i_) dst[h_][i_] = (unsigned)S.row_token(uu, 128 * h_ + RA[i_]) * (unsigned)(K * 2) + CA2[i_]; } while (0)
#define PG8_STAGE_A(bufoff, gbase, half, garr) do { if constexpr (Sched::GATHER) PG8_STAGE(bufoff, gbase, garr); else PG8_STAGE(bufoff, (gbase) + (half) * hstep, voffA); } while (0)
    const size_t kstep = (size_t)(BK * 2);
    const size_t hstep = (size_t)HALF * K * 2;
    const size_t hstepB = Epi::PERM == 2 ? (size_t)32 * K * 2 : hstep;
    const size_t tstep = 2 * hstep;
    const unsigned ldsw = (unsigned)wid * 1024u;
    const int aoff = lds_byte(wr * 64 + fr, fq * 8), boff = lds_byte(wc * 32 + fr, fq * 8);
#define PG8_SA(b, h) (((b) * 2 + (h)) * HTB)
#define PG8_SB(b, h) ((4 + (b) * 2 + (h)) * HTB)
#define PG8_STAGE(bufoff, gbase, voff) do { _Pragma("unroll") for (int _i = 0; _i < 2; ++_i) \
        __builtin_amdgcn_global_load_lds((const unsigned*)((const char*)(gbase) + (voff)[_i]), (PG8_LAS unsigned*)(lds + (bufoff) + ldsw + _i * 8192), 16, 0, 0); } while (0)
#define PG8_LDA(dst, b, h) do { if constexpr (FP8) { _Pragma("unroll") for (int m = 0; m < 4; ++m) dst##8[m] = __builtin_shufflevector(*(const PG8_LAS v4i_t*)(lds + PG8_SA(b, h) + aoff + m * 2048), *(const PG8_LAS v4i_t*)(lds + PG8_SA(b, h) + aoff + m * 2048 + 1024), 0, 1, 2, 3, 4, 5, 6, 7); } \
        else { _Pragma("unroll") for (int m = 0; m < 4; ++m) _Pragma("unroll") for (int k = 0; k < 2; ++k) dst[m][k] = *(const PG8_LAS bf16x8*)(lds + PG8_SA(b, h) + aoff + m * 2048 + k * 1024); } } while (0)
#define PG8_LDB(dst, b, h) do { if constexpr (FP8) { _Pragma("unroll") for (int n = 0; n < 2; ++n) dst##8[n] = __builtin_shufflevector(*(const PG8_LAS v4i_t*)(lds + PG8_SB(b, h) + boff + n * 2048), *(const PG8_LAS v4i_t*)(lds + PG8_SB(b, h) + boff + n * 2048 + 1024), 0, 1, 2, 3, 4, 5, 6, 7); } \
        else { _Pragma("unroll") for (int n = 0; n < 2; ++n) _Pragma("unroll") for (int k = 0; k < 2; ++k) dst[n][k] = *(const PG8_LAS bf16x8*)(lds + PG8_SB(b, h) + boff + n * 2048 + k * 1024); } } while (0)
#define PG8_MMA(ai, bj, At, Bt) do { __builtin_amdgcn_s_setprio(1); _Pragma("unroll") for (int m = 0; m < 4; ++m) _Pragma("unroll") for (int n = 0; n < 2; ++n) { \
        if constexpr (FP8) asm volatile("v_mfma_f32_16x16x128_f8f6f4 %0, %1, %2, %0" : "+v"(acc[ai][bj][m][n]) : "v"(Bt##8[n]), "v"(At##8[m])); \
        else { _Pragma("unroll") for (int k = 0; k < 2; ++k) acc[ai][bj][m][n] = __builtin_amdgcn_mfma_f32_16x16x32_bf16(Bt[n][k], At[m][k], acc[ai][bj][m][n], 0, 0, 0); } } \
        __builtin_amdgcn_s_setprio(0); } while (0)
#define PG8_WAIT_V(n) asm volatile("s_waitcnt vmcnt(" #n ")" ::: "memory")
#define PG8_WAIT_L(n) asm volatile("s_waitcnt lgkmcnt(" #n ")" ::: "memory")
#define PG8_BAR __builtin_amdgcn_s_barrier()
#define PG8_SCHED __builtin_amdgcn_sched_barrier(0)
    Unit cur, nxt; int ui = 0;
    if (!S.next(0, cur)) return;
    f32x4 acc[2][2][4][2];
#pragma unroll
    for (int a = 0; a < 2; ++a)
#pragma unroll
        for (int b = 0; b < 2; ++b)
#pragma unroll
            for (int m = 0; m < 4; ++m)
#pragma unroll
                for (int n = 0; n < 2; ++n) acc[a][b][m][n] = (f32x4){0.f, 0.f, 0.f, 0.f};
    bf16x8 At[4][2], B0[2][2], B1[2][2]; v8i_t At8[4], B08[2], B18[2];
    const size_t tstepA = Sched::GATHER ? (size_t)0 : tstep;
    const char* cA = (const char*)g.A + (size_t)cur.pm * tstepA + (size_t)cur.koff * 2; const char* cB = (const char*)g.Bt + (size_t)cur.pn * tstep + (size_t)cur.koff * 2;
    S.a_ready(cur);
    if constexpr (Sched::GATHER) { PG8_GOFF(gAc, cur); }
    PG8_STAGE(PG8_SB(0, 0), cB, voffB); PG8_STAGE(PG8_SB(0, 1), cB + hstepB, voffB); PG8_STAGE_A(PG8_SA(0, 0), cA, 0, gAc[0]); PG8_STAGE_A(PG8_SA(0, 1), cA, 1, gAc[1]);
    if (wr == 1) PG8_BAR;
    PG8_WAIT_V(2); PG8_BAR;
    PG8_STAGE(PG8_SB(1, 0), cB + kstep, voffB); PG8_STAGE_A(PG8_SA(1, 0), cA + kstep, 0, gAc[0]); PG8_STAGE(PG8_SB(1, 1), cB + hstepB + kstep, voffB);
    PG8_WAIT_V(6); PG8_BAR;
    for (;;) {
        const bool has_next = S.next(ui + 1, nxt);
        const char* nA = has_next ? (const char*)g.A + (size_t)nxt.pm * tstepA + (size_t)nxt.koff * 2 : cA; const char* nB = has_next ? (const char*)g.Bt + (size_t)nxt.pn * tstep + (size_t)nxt.koff * 2 : cB;
        if constexpr (Sched::GATHER) { if (has_next) { PG8_GOFF(gAn, nxt); } else {
#pragma unroll
            for (int h_ = 0; h_ < 2; ++h_)
#pragma unroll
                for (int i_ = 0; i_ < 2; ++i_) gAn[h_][i_] = gAc[h_][i_]; } }
        const int nt = cur.nt;
        for (int t = 0; t < nt; t += 2) {
            const bool last = (t == nt - 2);
            const char* a1 = cA + (size_t)(t + 1) * kstep;
            const char* a2 = last ? nA : cA + (size_t)(t + 2) * kstep; const char* b2 = last ? nB : cB + (size_t)(t + 2) * kstep;
            const char* a3 = a2 + kstep; const char* b3 = b2 + kstep;
            if (last && has_next) S.a_ready(nxt);
            unsigned g2a[2][2];
            if constexpr (Sched::GATHER) {
#pragma unroll
                for (int h_ = 0; h_ < 2; ++h_)
#pragma unroll
                    for (int i_ = 0; i_ < 2; ++i_) g2a[h_][i_] = last ? gAn[h_][i_] : gAc[h_][i_]; }
            PG8_LDB(B0, 0, 0); PG8_LDB(B1, 0, 1); PG8_SCHED; PG8_LDA(At, 0, 0); PG8_STAGE_A(PG8_SA(1, 1), a1, 1, gAc[1]);
            PG8_WAIT_V(8); PG8_WAIT_L(0); PG8_BAR; PG8_MMA(0, 0, At, B0); PG8_MMA(0, 1, At, B1); PG8_BAR; PG8_SCHED;
            PG8_LDA(At, 0, 1); PG8_STAGE(PG8_SB(0, 0), b2, voffB); PG8_STAGE(PG8_SB(0, 1), b2 + hstepB, voffB); PG8_STAGE_A(PG8_SA(0, 0), a2, 0, g2a[0]);
            PG8_WAIT_V(8); PG8_WAIT_L(0); PG8_BAR; PG8_MMA(1, 0, At, B0); PG8_MMA(1, 1, At, B1); PG8_BAR; PG8_SCHED;
            PG8_LDB(B0, 1, 0); PG8_LDB(B1, 1, 1); PG8_SCHED; PG8_LDA(At, 1, 0); PG8_STAGE_A(PG8_SA(0, 1), a2, 1, g2a[1]);
            PG8_WAIT_V(8); PG8_WAIT_L(0); PG8_BAR; PG8_MMA(0, 0, At, B0); PG8_MMA(0, 1, At, B1); PG8_BAR; PG8_SCHED;
            PG8_LDA(At, 1, 1); PG8_STAGE(PG8_SB(1, 0), b3, voffB); PG8_STAGE(PG8_SB(1, 1), b3 + hstepB, voffB); PG8_STAGE_A(PG8_SA(1, 0), a3, 0, g2a[0]);
            PG8_WAIT_V(8); PG8_WAIT_L(0); PG8_BAR; PG8_MMA(1, 0, At, B0); PG8_MMA(1, 1, At, B1); PG8_BAR; PG8_SCHED;
        }
        if constexpr (ALIGN_EPI) { if (wr == 0) PG8_BAR; }
        if constexpr (FP8) asm volatile("s_nop 15\n\ts_nop 15\n\ts_nop 15\n\ts_nop 15" ::: "memory");
        E(acc, cur, wr, wc, fr, fq); S.done(cur);
        if (!has_next) break;
        if (!Epi::CHAIN || cur.seg == 2)
#pragma unroll
        for (int a = 0; a < 2; ++a)
#pragma unroll
            for (int b = 0; b < 2; ++b)
#pragma unroll
                for (int m = 0; m < 4; ++m)
#pragma unroll
                    for (int n = 0; n < 2; ++n) acc[a][b][m][n] = (f32x4){0.f, 0.f, 0.f, 0.f};
        cur = nxt; cA = nA; cB = nB; ++ui;
        if constexpr (Sched::GATHER) {
#pragma unroll
            for (int h_ = 0; h_ < 2; ++h_)
#pragma unroll
                for (int i_ = 0; i_ < 2; ++i_) gAc[h_][i_] = gAn[h_][i_]; }
        if constexpr (ALIGN_EPI) { if (wr == 1) PG8_BAR; }
    }
    PG8_WAIT_V(0);
    if constexpr (!ALIGN_EPI) { if (wr == 0) PG8_BAR; }
    PG8_BAR;
#undef PG8_SA
#undef PG8_SB
#undef PG8_STAGE_A
#undef PG8_GOFF
#undef PG8_STAGE
#undef PG8_LDA
#undef PG8_LDB
#undef PG8_MMA
#undef PG8_WAIT_V
#undef PG8_WAIT_L
#undef PG8_BAR
#undef PG8_SCHED
}
}

constexpr int NWAVES = 8;
constexpr int T = 32768, SEQ = 2048, NB = 16, D = 2048, DEPTH = 2;
constexpr int ZP = pg8::ZP;
constexpr int ZC_AQ = 0, ZC_AK = 512, ZC_AV = 640, ZC_BQ = 768, ZC_BK = 1792, ZC_BV = 2048, ZC_IQ = 2304, ZC_IK = 3328, ZC_IW = 3392, ZC_CG = 3408, ZC_PAD = 3424, ZC_CQ = 3584, ZC_CK = 3840, ZC_CV = 4096, ZC_CR = 4608;
constexpr int D_IN = 11104;
constexpr int NEXP = 64, DEXP = 512, PMAX_TILES = 320;
constexpr float EPS = 1e-6f;

constexpr size_t MiB = 1u << 20;
constexpr size_t WS_CTL = 0, CTL_ZERO_BYTES = 1 * MiB;
constexpr size_t WS_ROUTE = 2 * MiB;
constexpr size_t WS_WRH = 4 * MiB, WS_WRL = 6 * MiB, WR_L = 96 * 2048 * 2;
constexpr size_t WS_WIN = 16 * MiB, WIN_L = 44 * MiB;
constexpr size_t WS_WBR = 104 * MiB, WBR_L = 8 * MiB;
constexpr size_t WS_WO = 120 * MiB, WO_L = 8 * MiB;
constexpr size_t WS_W13 = 136 * MiB;
constexpr size_t WS_HB = 264 * MiB;
constexpr size_t WS_W2 = 392 * MiB;
constexpr size_t WS_XN = 520 * MiB;
constexpr size_t WS_OCAT = 648 * MiB;
constexpr size_t WS_MERGED = 776 * MiB;
constexpr size_t WS_Z = 904 * MiB;
constexpr size_t WS_GT = 1224 * MiB;
constexpr size_t WS_S = 1608 * MiB;
constexpr size_t WS_MASK = 1864 * MiB;
constexpr size_t WS_GO = 1872 * MiB;
constexpr size_t WS_GCS = WS_GO;
constexpr size_t WS_GDEC = 8 * MiB;
constexpr size_t WS_RSTD = 9 * MiB;
constexpr size_t WS_LISTE = 904 * MiB;
constexpr size_t WS_XS = 904 * MiB;
constexpr size_t WS_Y = 1224 * MiB;
constexpr size_t WS_H = 1544 * MiB;
constexpr size_t WS_WG8 = 1936 * MiB, WG8_L = 12 * MiB;
constexpr size_t WS_XN8 = WS_S;
constexpr size_t WS_END = 1936 * MiB;
constexpr int CW_BAR = 4096;
constexpr int CW_CNT = 16384;

constexpr int RING_BYTES = 131072, MISC_OFF = RING_BYTES, LDS_BYTES = 155648;
constexpr int MO_BARW = 32, MO_GN = 256, MO_TEXP = 8192, MO_PST = 9728, MO_TOT = 9984, MO_TAB2 = 10240, MO_CNT = 16640, MO_SS = 16896;

#define GAS __attribute__((address_space(1)))
#define LAS __attribute__((address_space(3)))
typedef unsigned short bf16;
typedef unsigned v4u __attribute__((ext_vector_type(4)));
typedef unsigned v2u __attribute__((ext_vector_type(2)));
typedef float f32x4 __attribute__((ext_vector_type(4)));
#define LDS_WAIT() asm volatile("s_waitcnt lgkmcnt(0)" ::: "memory")
__device__ __forceinline__ unsigned f2bf(float f) { unsigned u = __builtin_bit_cast(unsigned, f); return (u + 0x7fffu + ((u >> 16) & 1u)) >> 16; }
__device__ __forceinline__ unsigned pk2(float lo, float hi) { return pg8::cvt_pk_bf16(lo, hi); }
__device__ __forceinline__ float bflo(unsigned w) { return __uint_as_float(w << 16); }
__device__ __forceinline__ float bfhi(unsigned w) { return __uint_as_float(w & 0xffff0000u); }
__device__ __forceinline__ float bf1(bf16 h) { return __uint_as_float(((unsigned)h) << 16); }

#define XB_TMO      128
#define XB_XCNT(j)  (256  + 64 * (j))
#define XB_XSUB(j)  (1280 + 64 * (j))
#define XB_XGEN(j)  (2304 + 64 * (j))
#define XB_TOP      3328
#define XB_TOPGEN   3392
#define XCD_BAR_WORDS 3456
#define XB_SPIN_CAP (1u << 18)
__device__ __forceinline__ unsigned xb_ld(unsigned* p)              { return __hip_atomic_load(p, __ATOMIC_RELAXED, __HIP_MEMORY_SCOPE_AGENT); }
__device__ __forceinline__ unsigned xb_add(unsigned* p, unsigned v) { return __hip_atomic_fetch_add(p, v, __ATOMIC_RELAXED, __HIP_MEMORY_SCOPE_AGENT); }
__device__ __forceinline__ unsigned xb_xcc_id() { return (unsigned)__builtin_amdgcn_s_getreg((3 << 11) | 20) & 0xFu; }
#define XB_SPIN(cond, bar) do { unsigned _sp = 0; while (cond) { __builtin_amdgcn_s_sleep(1); \
    if ((++_sp & 255u) == 0u) { if (xb_ld(&(bar)[XB_TMO])) break; if (_sp > XB_SPIN_CAP) { atomicAdd(&(bar)[XB_TMO], 1u); break; } } } } while (0)
struct XcdBarrier { unsigned* bar; unsigned x; volatile LAS unsigned* st; };
__device__ __forceinline__ XcdBarrier xcd_barrier_post(unsigned* bar, volatile LAS unsigned* st) {
    XcdBarrier b; b.bar = bar; b.x = xb_xcc_id(); b.st = st;
    if (threadIdx.x == 0) (void)xb_add(&bar[XB_XCNT(b.x)], 1u);
    return b;
}
__device__ __forceinline__ void xcd_barrier_complete(unsigned* bar, unsigned x, unsigned& nloc, unsigned& nx) {
    const unsigned G = gridDim.x * gridDim.y * gridDim.z;
    unsigned sum, cnt, mine, sp = 0u;
    for (;;) {
        sum = 0u; cnt = 0u; mine = 0u;
#pragma unroll
        for (unsigned j = 0; j < 16; ++j) { const unsigned c = xb_ld(&bar[XB_XCNT(j)]); sum += c; cnt += (c > 0u) ? 1u : 0u; mine = (j == x) ? c : mine; }
        if (sum == G) break;
        __builtin_amdgcn_s_sleep(1);
        if ((++sp & 255u) == 0u) { if (xb_ld(&bar[XB_TMO])) break; if (sp > XB_SPIN_CAP) { atomicAdd(&bar[XB_TMO], 1u); break; } }
    }
    nloc = mine > 0u ? mine : 1u; nx = cnt > 0u ? cnt : 1u;
}
__device__ __forceinline__ void xcd_barrier(const XcdBarrier& b) {
    asm volatile("s_waitcnt vmcnt(0)" ::: "memory");
    __syncthreads();
    if (threadIdx.x == 0) {
        unsigned* bar = b.bar;
        __builtin_amdgcn_s_waitcnt(0);
        unsigned nloc = b.st[0], nx = b.st[1];
        if (nloc == 0u) { xcd_barrier_complete(bar, b.x, nloc, nx); b.st[0] = nloc; b.st[1] = nx; }
        const unsigned old = xb_add(&bar[XB_XSUB(b.x)], 1u);
        const unsigned gen = old / nloc;
        if (old + 1u == (gen + 1u) * nloc) {
            __builtin_amdgcn_fence(__ATOMIC_RELEASE, "agent");
            asm volatile("s_waitcnt vmcnt(0)" ::: "memory");
            const unsigned og = xb_add(&bar[XB_TOP], 1u);
            const unsigned tg = og / nx;
            if (og + 1u == (tg + 1u) * nx) xb_add(&bar[XB_TOPGEN], 1u);
            else XB_SPIN(xb_ld(&bar[XB_TOPGEN]) == tg, bar);
            __builtin_amdgcn_fence(__ATOMIC_ACQUIRE, "agent");
            xb_add(&bar[XB_XGEN(b.x)], 1u);
            asm volatile("s_waitcnt vmcnt(0)" ::: "memory");
        } else {
            XB_SPIN(xb_ld(&bar[XB_XGEN(b.x)]) == gen, bar);
            __builtin_amdgcn_fence(__ATOMIC_ACQUIRE, "agent");
            asm volatile("s_waitcnt vmcnt(0)" ::: "memory");
        }
    }
    __syncthreads();
}

struct Args { const float* in[24]; float* out; unsigned char* ws; int ph_lo, ph_hi; };
enum { I_X = 0, I_RELB, I_N1G, I_WIN, I_AQG, I_AKG, I_BQG, I_BKG, I_SINK, I_CGW, I_CGB, I_CNG, I_WBA, I_WBB, I_WBC, I_WO, I_N2G, I_WRG, I_BRG, I_WRE, I_BRE, I_W1, I_W3, I_W2 };

struct Frame {
    LAS unsigned char* lds; LAS unsigned char* misc;
    unsigned* ctl;
    int tid, lane, wave, vcu, G, gw, NGW;
    const float* const* in; float* out; unsigned char* ws;
    bf16 *Z, *XN, *OCAT, *MERGED, *XS, *Y, *H;
    float *S, *GO; unsigned* MASK;
};

__device__ __forceinline__ float wave_sum(float v) {
#pragma unroll
    for (int o = 1; o < 64; o <<= 1) v += __shfl_xor(v, o);
    return v;
}
__device__ __forceinline__ float wave_max(float v) {
#pragma unroll
    for (int o = 1; o < 64; o <<= 1) v = fmaxf(v, __shfl_xor(v, o));
    return v;
}

template <class MAP>
__device__ __forceinline__ void transpose_item(const float* W, int N, bf16* WT, int dpitch, int koff, LAS float* scr, int item, int lane, const MAP& map) {
    const int nblk = N / 32, kb = item / nblk, nb = item % nblk, k0 = 64 * kb, n0 = 32 * nb;
    f32x4 v[8];
#pragma unroll
    for (int i = 0; i < 8; ++i) v[i] = *(const f32x4*)(W + (size_t)(k0 + 8 * i + (lane >> 3)) * N + n0 + 4 * (lane & 7));
#pragma unroll
    for (int i = 0; i < 8; ++i) { LAS float* d = scr + (8 * i + (lane >> 3)) * 33 + 4 * (lane & 7); d[0] = v[i].x; d[1] = v[i].y; d[2] = v[i].z; d[3] = v[i].w; }
    LDS_WAIT(); asm volatile("" ::: "memory");
    const int c = lane & 7;
#pragma unroll
    for (int j = 0; j < 4; ++j) { const int n = (lane >> 3) + 8 * j; const LAS float* s = scr + (8 * c) * 33 + n;
        v4u o; o.x = pk2(s[0 * 33], s[1 * 33]); o.y = pk2(s[2 * 33], s[3 * 33]); o.z = pk2(s[4 * 33], s[5 * 33]); o.w = pk2(s[6 * 33], s[7 * 33]);
        const int dr_ = map(n0 + n); if (dr_ >= 0) *(v4u*)(WT + (size_t)dr_ * dpitch + koff + k0 + 8 * c) = o; }
    LDS_WAIT(); asm volatile("" ::: "memory");
}
__device__ __forceinline__ float clamp8(float v) { return fminf(fmaxf(v, -440.0f), 440.0f); }
template <class MAP>
__device__ __forceinline__ void transpose_item_fp8(const float* W, int N, unsigned char* WT, int dpitch, float scale, LAS float* scr, int item, int lane, const MAP& map) {
    const int nblk = N / 32, kb = item / nblk, nb = item % nblk, k0 = 64 * kb, n0 = 32 * nb;
    f32x4 v[8];
#pragma unroll
    for (int i = 0; i < 8; ++i) v[i] = *(const f32x4*)(W + (size_t)(k0 + 8 * i + (lane >> 3)) * N + n0 + 4 * (lane & 7));
#pragma unroll
    for (int i = 0; i < 8; ++i) { LAS float* d = scr + (8 * i + (lane >> 3)) * 33 + 4 * (lane & 7); d[0] = v[i].x; d[1] = v[i].y; d[2] = v[i].z; d[3] = v[i].w; }
    LDS_WAIT(); asm volatile("" ::: "memory");
    const int c = lane & 7;
#pragma unroll
    for (int j = 0; j < 4; ++j) { const int n = (lane >> 3) + 8 * j; const LAS float* s = scr + (8 * c) * 33 + n;
        int w0 = 0, w1 = 0;
        w0 = __builtin_amdgcn_cvt_pk_fp8_f32(clamp8(s[0 * 33] * scale), clamp8(s[1 * 33] * scale), w0, false); w0 = __builtin_amdgcn_cvt_pk_fp8_f32(clamp8(s[2 * 33] * scale), clamp8(s[3 * 33] * scale), w0, true);
        w1 = __builtin_amdgcn_cvt_pk_fp8_f32(clamp8(s[4 * 33] * scale), clamp8(s[5 * 33] * scale), w1, false); w1 = __builtin_amdgcn_cvt_pk_fp8_f32(clamp8(s[6 * 33] * scale), clamp8(s[7 * 33] * scale), w1, true);
        const int dr_ = map(n0 + n); if (dr_ >= 0) *(v2u*)(WT + (size_t)dr_ * dpitch + k0 + 8 * c) = (v2u){(unsigned)w0, (unsigned)w1}; }
    LDS_WAIT(); asm volatile("" ::: "memory");
}
struct MapId { int off; __device__ __forceinline__ int operator()(int n) const { return off + n; } };
struct MapWin {
    __device__ __forceinline__ int operator()(int n) const {
        if (n < 512) return ZC_AQ + n;
        if (n < 640) return ZC_AK + (n - 512);
        if (n < 768) return ZC_AV + (n - 640);
        if (n < 1792) return ZC_IQ + (n - 768);
        if (n < 1856) return ZC_IK + (n - 1792);
        if (n < 1872) return ZC_IW + (n - 1856);
        if (n < 2896) return ZC_BQ + (n - 1872);
        if (n < 3152) return ZC_BK + (n - 2896);
        if (n < 3408) return ZC_BV + (n - 3152);
        if (n < 3664) return ZC_CQ + (n - 3408);
        if (n < 3920) return ZC_CK + (n - 3664);
        if (n < 4432) return ZC_CV + (n - 3920);
        if (n < 4448) return ZC_CG + (n - 4432);
        if (n < 4960) return ZC_CR + (n - 4448);
        return pg8::ZC_GA + (n - 4960);
    }
};
struct MapWin8 { __device__ __forceinline__ int operator()(int n) const { const int z = MapWin{}(n); return z < 3328 ? z : (z >= 4096 ? z - 768 : -1); } };
struct MapWinB { __device__ __forceinline__ int operator()(int n) const { const int z = MapWin{}(n); return (z >= 3328 && z < 4096) ? z - 3328 : -1; } };
struct MapW13 { int sel; __device__ __forceinline__ int operator()(int n) const { return 32 * (n >> 4) + 16 * sel + (n & 15); } };

__device__ __forceinline__ void load_row(const float* row, int lane, f32x4 (&v)[8]) {
    const f32x4* xr = (const f32x4*)row + lane;
#pragma unroll
    for (int j = 0; j < 8; ++j) v[j] = xr[64 * j];
}
__device__ __forceinline__ float row_rstd(const f32x4 (&v)[8]) {
    float s = 0.f;
#pragma unroll
    for (int j = 0; j < 8; ++j) s += (v[j].x * v[j].x + v[j].y * v[j].y) + (v[j].z * v[j].z + v[j].w * v[j].w);
    return rsqrtf(wave_sum(s) * (1.0f / 2048.0f) + EPS);
}
__device__ __forceinline__ void norm_store_bf16(const f32x4 (&v)[8], float rstd, const float* g, bf16* orow, int lane) {
    const f32x4* gr = (const f32x4*)g + lane; unsigned long long* o8 = (unsigned long long*)orow + lane;
#pragma unroll
    for (int j = 0; j < 8; ++j) { const f32x4 gg = gr[64 * j];
        o8[64 * j] = (unsigned long long)pk2(v[j].x * rstd * gg.x, v[j].y * rstd * gg.y) | ((unsigned long long)pk2(v[j].z * rstd * gg.z, v[j].w * rstd * gg.w) << 32); }
}

__device__ __forceinline__ void norm_store_fp8(const f32x4 (&v)[8], float rstd, const float* g, unsigned char* orow, int lane) {
    const f32x4* gr = (const f32x4*)g + lane; unsigned* o4 = (unsigned*)orow + lane;
#pragma unroll
    for (int j = 0; j < 8; ++j) { const f32x4 gg = gr[64 * j]; int w = 0;
        w = __builtin_amdgcn_cvt_pk_fp8_f32(clamp8(v[j].x * rstd * gg.x), clamp8(v[j].y * rstd * gg.y), w, false); w = __builtin_amdgcn_cvt_pk_fp8_f32(clamp8(v[j].z * rstd * gg.z), clamp8(v[j].w * rstd * gg.w), w, true);
        o4[64 * j] = (unsigned)w; }
}
__device__ __forceinline__ void convert_moe(Frame& F, int l, int part, int nparts, int lds_off) {
    LAS float* scr = (LAS float*)(F.lds + lds_off + F.wave * 8704);
    bf16* W13 = (bf16*)(F.ws + WS_W13); bf16* W2 = (bf16*)(F.ws + WS_W2);
    constexpr int I13 = (2048 / 64) * (512 / 32);
    constexpr int I2 = (512 / 64) * (2048 / 32);
    constexpr int NIT = NEXP * (2 * I13 + I2);
    const int it_lo = (int)((long)NIT * part / nparts), it_hi = (int)((long)NIT * (part + 1) / nparts);
    for (int it = it_lo + F.gw; it < it_hi; it += F.NGW) {
        const int e = it / (2 * I13 + I2); int r = it % (2 * I13 + I2);
        if (r < I13) { transpose_item_fp8(F.in[I_W1] + ((size_t)l * NEXP + e) * 2048 * 512, 512, (unsigned char*)W13 + (size_t)e * 1024 * 2048, 2048, 64.0f, scr, r, F.lane, MapW13{0}); continue; } r -= I13;
        if (r < I13) { transpose_item_fp8(F.in[I_W3] + ((size_t)l * NEXP + e) * 2048 * 512, 512, (unsigned char*)W13 + (size_t)e * 1024 * 2048, 2048, 64.0f, scr, r, F.lane, MapW13{1}); continue; } r -= I13;
        transpose_item_fp8(F.in[I_W2] + ((size_t)l * NEXP + e) * 512 * 2048, 2048, (unsigned char*)W2 + (size_t)e * 2048 * 512, 512, 32.0f, scr, r, F.lane, MapId{0});
    }
}

typedef short bf16x8_t __attribute__((ext_vector_type(8)));
typedef float f32x16 __attribute__((ext_vector_type(16)));
typedef short s16x4 __attribute__((ext_vector_type(4)));
__device__ __forceinline__ void indexer_segment(Frame& F, int b, int qb, int tlo, int thi) {
    const int lane = F.lane, n = lane & 15, kq = lane >> 4;
    const bf16* qrow = F.Z + (size_t)(b * 2048 + 16 * qb + n) * ZP;
    bf16x8_t iqf[16][2];
#pragma unroll
    for (int h = 0; h < 16; ++h)
#pragma unroll
        for (int ks = 0; ks < 2; ++ks) iqf[h][ks] = *(const bf16x8_t*)(qrow + ZC_IQ + h * 64 + 32 * ks + 8 * kq);
    float wv[16];
    { const v4u w0 = *(const v4u*)(qrow + ZC_IW), w1 = *(const v4u*)(qrow + ZC_IW + 8);
      wv[0] = bflo(w0.x); wv[1] = bfhi(w0.x); wv[2] = bflo(w0.y); wv[3] = bfhi(w0.y); wv[4] = bflo(w0.z); wv[5] = bfhi(w0.z); wv[6] = bflo(w0.w); wv[7] = bfhi(w0.w);
      wv[8] = bflo(w1.x); wv[9] = bfhi(w1.x); wv[10] = bflo(w1.y); wv[11] = bfhi(w1.y); wv[12] = bflo(w1.z); wv[13] = bfhi(w1.z); wv[14] = bflo(w1.w); wv[15] = bfhi(w1.w); }
    const bf16* kbase = F.Z + (size_t)(b * 2048 + n) * ZP + ZC_IK + 8 * kq;
    float* srow = F.S + (size_t)(b * 2048 + 16 * qb + n) * 2048 + 4 * kq;
    bf16x8_t ka[3], kb[3];
#pragma unroll
    for (int u = 0; u < 3; ++u) { const int tt = tlo + u < thi ? tlo + u : thi - 1; ka[u] = *(const bf16x8_t*)(kbase + (size_t)(16 * tt) * ZP); kb[u] = *(const bf16x8_t*)(kbase + (size_t)(16 * tt) * ZP + 32); }
#pragma unroll 1
    for (int tile = tlo; tile < thi; tile += 3) {
#pragma unroll
        for (int u = 0; u < 3; ++u) {
            const int tt = tile + u;
            if (tt < thi) {
                f32x4 sc = (f32x4){0.f, 0.f, 0.f, 0.f};
#pragma unroll
                for (int h = 0; h < 16; ++h) {
                    f32x4 c = __builtin_amdgcn_mfma_f32_16x16x32_bf16(ka[u], iqf[h][0], (f32x4){0.f, 0.f, 0.f, 0.f}, 0, 0, 0);
                    c = __builtin_amdgcn_mfma_f32_16x16x32_bf16(kb[u], iqf[h][1], c, 0, 0, 0);
                    sc[0] += wv[h] * fmaxf(c[0], 0.f); sc[1] += wv[h] * fmaxf(c[1], 0.f); sc[2] += wv[h] * fmaxf(c[2], 0.f); sc[3] += wv[h] * fmaxf(c[3], 0.f);
                }
                *(f32x4*)(srow + 16 * tt) = sc * 0.03125f;
            }
            { const int tn = tt + 3 < thi ? tt + 3 : thi - 1; ka[u] = *(const bf16x8_t*)(kbase + (size_t)(16 * tn) * ZP); kb[u] = *(const bf16x8_t*)(kbase + (size_t)(16 * tn) * ZP + 32); }
        }
    }
}

constexpr int FA_KP = 272, FA_VP = 320;
constexpr int FA_KOFF = 0, FA_VOFF = 2 * 64 * FA_KP, FA_BYTES = FA_VOFF + 2 * 64 * FA_VP;
__device__ __forceinline__ s16x4 fa_vtr(const LAS unsigned char* p) { return __builtin_bit_cast(s16x4, __builtin_amdgcn_ds_read_tr16_b64_v4i16((LAS s16x4*)p)); }
template <int MODE>
__device__ __forceinline__ void flash_unit(Frame& F, int l, int b, int g, int t0) {
    const int tid = F.tid, lane = F.lane, wave = F.wave, hh = wave & 3, qh = wave >> 2, r = lane & 31, hf = lane >> 5;
    const int qcol = (MODE == 0 ? ZC_AQ : ZC_BQ + 512 * g) + 128 * hh, kcol = MODE == 0 ? ZC_AK : ZC_BK + 128 * g, vcol = MODE == 0 ? ZC_AV : ZC_BV + 128 * g;
    const int ocol = (MODE == 0 ? 0 : 512 + 512 * g) + 128 * hh, hd = (MODE == 0 ? 0 : 4 + 4 * g) + hh;
    const int tq = t0 + 32 * qh + r; const size_t qrow = (size_t)(b * 2048 + tq);
    const LAS float* tab2 = (const LAS float*)(F.misc + MO_TAB2) + hd * 129;
    LAS unsigned char* lds = F.lds;
    bf16x8_t qf[8];
#pragma unroll
    for (int ks = 0; ks < 8; ++ks) qf[ks] = *(const bf16x8_t*)(F.Z + qrow * ZP + qcol + 16 * ks + 8 * hf);
    f32x16 oacc[4];
#pragma unroll
    for (int dt = 0; dt < 4; ++dt)
#pragma unroll
        for (int i = 0; i < 16; ++i) oacc[dt][i] = 0.f;
    float m_run = -1e30f, l_run = 0.f;
    const int tile_lo = MODE == 0 ? 0 : (t0 >= 128 ? t0 / 64 - 2 : 0), tile_hi = t0 / 64 + 1;
    const int skey = tid >> 4, sdc = tid & 15;
    v4u kreg[2], vreg[2];
    { const bf16* zr = F.Z + (size_t)(b * 2048 + 64 * tile_lo + skey) * ZP;
#pragma unroll
      for (int i = 0; i < 2; ++i) { kreg[i] = *(const v4u*)(zr + (size_t)(32 * i) * ZP + kcol + 8 * sdc); vreg[i] = *(const v4u*)(zr + (size_t)(32 * i) * ZP + vcol + 8 * sdc); } }
    const float sc2 = 0.08838834764831845f * 1.4426950408889634f;
    unsigned mwn[2] = {0xffffffffu, 0xffffffffu};
    if (MODE == 0) { mwn[0] = F.MASK[qrow * 64 + 2 * tile_lo]; mwn[1] = F.MASK[qrow * 64 + 2 * tile_lo + 1]; }
#pragma unroll 1
    for (int kt = tile_lo; kt < tile_hi; ++kt) {
        const int bf = (kt - tile_lo) & 1, s0 = 64 * kt;
        LAS unsigned char* kb = lds + FA_KOFF + bf * (64 * FA_KP); LAS unsigned char* vb = lds + FA_VOFF + bf * (64 * FA_VP);
#pragma unroll
        for (int i = 0; i < 2; ++i) { *(LAS v4u*)(kb + (skey + 32 * i) * FA_KP + 16 * sdc) = kreg[i]; *(LAS v4u*)(vb + (skey + 32 * i) * FA_VP + 16 * sdc) = vreg[i]; }
        __syncthreads();
        if (kt + 1 < tile_hi) { const bf16* zr = F.Z + (size_t)(b * 2048 + 64 * (kt + 1) + skey) * ZP;
#pragma unroll
            for (int i = 0; i < 2; ++i) { kreg[i] = *(const v4u*)(zr + (size_t)(32 * i) * ZP + kcol + 8 * sdc); vreg[i] = *(const v4u*)(zr + (size_t)(32 * i) * ZP + vcol + 8 * sdc); } }
        unsigned mw[2] = {mwn[0], mwn[1]};
        if (MODE == 0 && kt + 1 < tile_hi) { mwn[0] = F.MASK[qrow * 64 + 2 * (kt + 1)]; mwn[1] = F.MASK[qrow * 64 + 2 * (kt + 1) + 1]; }
        f32x16 sacc[2];
#pragma unroll
        for (int k2 = 0; k2 < 2; ++k2) {
#pragma unroll
            for (int i = 0; i < 16; ++i) sacc[k2][i] = 0.f;
#pragma unroll
            for (int ks = 0; ks < 8; ++ks) { const bf16x8_t kf = *(const LAS bf16x8_t*)(kb + (32 * k2 + r) * FA_KP + (16 * ks + 8 * hf) * 2);
                sacc[k2] = __builtin_amdgcn_mfma_f32_32x32x16_bf16(kf, qf[ks], sacc[k2], 0, 0, 0); }
        }
        float mx = -1e30f;
        if (MODE == 0 && s0 + 63 + 128 <= t0) {
            const float bfar = tab2[128];
#pragma unroll
            for (int k2 = 0; k2 < 2; ++k2)
#pragma unroll
                for (int i = 0; i < 16; ++i) { const int cr = (i & 3) + 8 * (i >> 2) + 4 * hf;
                    const float v = ((mw[k2] >> cr) & 1u) ? sacc[k2][i] * sc2 + bfar : -__builtin_inff();
                    sacc[k2][i] = v; mx = fmaxf(mx, v); }
        } else
#pragma unroll
        for (int k2 = 0; k2 < 2; ++k2)
#pragma unroll
            for (int i = 0; i < 16; ++i) { const int cr = (i & 3) + 8 * (i >> 2) + 4 * hf; const int dist = tq - (s0 + 32 * k2 + cr);
                bool ok; if (MODE == 0) ok = (mw[k2] >> cr) & 1u; else ok = dist >= 0 && dist < 128;
                const int di = dist < 0 ? 0 : (dist > 128 ? 128 : dist);
                float vf = sacc[k2][i] * sc2 + tab2[di];
                asm volatile("" : "+v"(vf));
                const float v = ok ? vf : -__builtin_inff();
                sacc[k2][i] = v; mx = fmaxf(mx, v); }
        { const auto sw_ = __builtin_amdgcn_permlane32_swap(__float_as_uint(mx), __float_as_uint(mx), false, false); mx = fmaxf(__uint_as_float(sw_[0]), __uint_as_float(sw_[1])); }
        const float m_new = fmaxf(m_run, mx), alpha = __builtin_amdgcn_exp2f(m_run - m_new); m_run = m_new;
        float ps = 0.f;
#pragma unroll
        for (int k2 = 0; k2 < 2; ++k2)
#pragma unroll
            for (int i = 0; i < 16; ++i) { const float p = __builtin_amdgcn_exp2f(sacc[k2][i] - m_new); sacc[k2][i] = p; ps += p; }
        l_run = l_run * alpha + ps;
        if (__ballot(alpha != 1.0f)) {
#pragma unroll
        for (int dt = 0; dt < 4; ++dt)
#pragma unroll
            for (int i = 0; i < 16; ++i) oacc[dt][i] *= alpha;
        }
#pragma unroll
        for (int k2 = 0; k2 < 2; ++k2)
#pragma unroll
            for (int s2 = 0; s2 < 2; ++s2) {
                v4u pw; pw.x = pg8::cvt_pk_bf16(sacc[k2][8 * s2 + 0], sacc[k2][8 * s2 + 1]); pw.y = pg8::cvt_pk_bf16(sacc[k2][8 * s2 + 2], sacc[k2][8 * s2 + 3]);
                pw.z = pg8::cvt_pk_bf16(sacc[k2][8 * s2 + 4], sacc[k2][8 * s2 + 5]); pw.w = pg8::cvt_pk_bf16(sacc[k2][8 * s2 + 6], sacc[k2][8 * s2 + 7]);
                const bf16x8_t pb = __builtin_bit_cast(bf16x8_t, pw);
                const int i16 = lane & 15, grp = (lane >> 4) & 1;
                const LAS unsigned char* vp = vb + (32 * k2 + 16 * s2 + 4 * hf + (i16 >> 2)) * FA_VP + (16 * grp + 4 * (i16 & 3)) * 2;
#pragma unroll
                for (int dt = 0; dt < 4; ++dt) { const s16x4 lo = fa_vtr(vp + 64 * dt), hi = fa_vtr(vp + 8 * FA_VP + 64 * dt);
                    const bf16x8_t vf = __builtin_shufflevector(lo, hi, 0, 1, 2, 3, 4, 5, 6, 7);
                    oacc[dt] = __builtin_amdgcn_mfma_f32_32x32x16_bf16(vf, pb, oacc[dt], 0, 0, 0); }
            }
    }
    float l_tot = l_run + __shfl_xor(l_run, 32);
    if (MODE == 1) l_tot += __builtin_amdgcn_exp2f(F.in[I_SINK][l * 8 + hd - 4] * 1.4426950408889634f - m_run);
    const float inv = 1.0f / l_tot;
    bf16* orow = F.OCAT + qrow * 2048 + ocol + 4 * hf;
#pragma unroll
    for (int dt = 0; dt < 4; ++dt)
#pragma unroll
        for (int gq = 0; gq < 4; ++gq) { v2u w; w.x = pk2(oacc[dt][4 * gq] * inv, oacc[dt][4 * gq + 1] * inv); w.y = pk2(oacc[dt][4 * gq + 2] * inv, oacc[dt][4 * gq + 3] * inv);
            *(v2u*)(orow + 32 * dt + 8 * gq) = w; }
    __syncthreads();
}


#define GLA_GATE_PREFIX(LDS_TOT) \
        float la[8]; \
        _Pragma("unroll") for (int i = 0; i < 8; ++i) { const v4u c0 = rc0[i], c1 = rc1[i]; float x = gb; \
            x += bflo(c0.x) * gwv[0] + bfhi(c0.x) * gwv[1] + bflo(c0.y) * gwv[2] + bfhi(c0.y) * gwv[3] + bflo(c0.z) * gwv[4] + bfhi(c0.z) * gwv[5] + bflo(c0.w) * gwv[6] + bfhi(c0.w) * gwv[7]; \
            x += bflo(c1.x) * gwv[8] + bfhi(c1.x) * gwv[9] + bflo(c1.y) * gwv[10] + bfhi(c1.y) * gwv[11] + bflo(c1.z) * gwv[12] + bfhi(c1.z) * gwv[13] + bflo(c1.w) * gwv[14] + bfhi(c1.w) * gwv[15]; \
            la[i] = (fminf(x, 0.f) - __logf(1.0f + __expf(-fabsf(x)))) * 0.0625f; } \
        _Pragma("unroll") for (int i = 1; i < 8; ++i) la[i] += la[i - 1]; \
        ((LAS float*)(L + LDS_TOT))[cg * 64 + dk] = la[7];
#define GLA_OFFSETS(LDS_TOT) \
        float off = 0.f, tot = 0.f; \
        _Pragma("unroll") for (int g2 = 0; g2 < 8; ++g2) { const float tv = ((const LAS float*)(L + LDS_TOT))[g2 * 64 + dk]; tot += tv; off += g2 < cg ? tv : 0.f; }

__device__ __forceinline__ void gla_state_phase(Frame& F, int l) {
    const int tid = F.tid, lane = F.lane, wave = F.wave, r = lane & 31, hf = lane >> 5, i16 = lane & 15, grp = (lane >> 4) & 1;
    LAS unsigned char* L = F.lds;
    constexpr int KDT = 0, VT = 9216, TOT = 29696, RP = 144, VP = 320;
    const int dk = lane, cg = wave;
    float* GCS = (float*)(F.ws + WS_GCS); float* GDEC = (float*)(F.ws + WS_GDEC);
    v4u rc0[8], rc1[8], rv[2]; unsigned short rk[8];
#define GLS_LOAD(u_) do { const int bh_ = (u_) >> 5, n_ = (u_) & 31; const size_t r0_ = (size_t)((bh_ >> 2) * 2048 + 64 * n_); const int h_ = bh_ & 3; \
        _Pragma("unroll") for (int i = 0; i < 8; ++i) { const bf16* zr = F.Z + (r0_ + 8 * cg + i) * ZP; rc0[i] = *(const v4u*)(zr + ZC_CG); rc1[i] = *(const v4u*)(zr + ZC_CG + 8); rk[i] = zr[ZC_CK + h_ * 64 + dk]; } \
        _Pragma("unroll") for (int i = 0; i < 2; ++i) rv[i] = *(const v4u*)(F.Z + (r0_ + (tid >> 4) + 32 * i) * ZP + ZC_CV + h_ * 128 + 8 * (tid & 15)); } while (0)
    int u = F.vcu;
    if (u < 2048) GLS_LOAD(u);
    for (; u < 2048; u += F.G) {
        const int h = (u >> 5) & 3;
        float gwv[16];
#pragma unroll
        for (int q = 0; q < 16; ++q) gwv[q] = F.in[I_CGW][(size_t)l * 4096 + q * 256 + h * 64 + dk];
        const float gb = F.in[I_CGB][l * 256 + h * 64 + dk];
        GLA_GATE_PREFIX(TOT)
        float kv[8];
#pragma unroll
        for (int i = 0; i < 8; ++i) kv[i] = bf1(rk[i]);
#pragma unroll
        for (int i = 0; i < 2; ++i) *(LAS v4u*)(L + VT + ((tid >> 4) + 32 * i) * VP + 16 * (tid & 15)) = rv[i];
        __syncthreads();
        GLA_OFFSETS(TOT)
        { float kd[8];
#pragma unroll
          for (int i = 0; i < 8; ++i) kd[i] = kv[i] * __expf(tot - (off + la[i]));
          v4u w; w.x = pk2(kd[0], kd[1]); w.y = pk2(kd[2], kd[3]); w.z = pk2(kd[4], kd[5]); w.w = pk2(kd[6], kd[7]); *(LAS v4u*)(L + KDT + dk * RP + 16 * cg) = w; }
        if (cg == 0) GDEC[(size_t)u * 64 + dk] = __expf(tot);
        __syncthreads();
        if (u + F.G < 2048) GLS_LOAD(u + F.G);
        { const int dkt = wave >> 2, dvt = wave & 3;
          f32x16 cs;
#pragma unroll
          for (int i = 0; i < 16; ++i) cs[i] = 0.f;
#pragma unroll
          for (int ks = 0; ks < 4; ++ks) { const bf16x8_t a = *(const LAS bf16x8_t*)(L + KDT + (32 * dkt + r) * RP + (16 * ks + 8 * hf) * 2);
              const LAS unsigned char* vp = L + VT + (16 * ks + 8 * hf + (i16 >> 2)) * VP + (32 * dvt + 16 * grp + 4 * (i16 & 3)) * 2;
              const s16x4 lo = fa_vtr(vp), hi = fa_vtr(vp + 4 * VP);
              cs = __builtin_amdgcn_mfma_f32_32x32x16_bf16(a, __builtin_shufflevector(lo, hi, 0, 1, 2, 3, 4, 5, 6, 7), cs, 0, 0, 0); }
          float* gp = GCS + (size_t)u * 8192 + (size_t)(32 * dkt + 4 * hf) * 128 + 32 * dvt + r;
#pragma unroll
          for (int i = 0; i < 16; ++i) gp[((i & 3) + 8 * (i >> 2)) * 128] = cs[i]; }
        __syncthreads();
    }
#undef GLS_LOAD
}

__device__ __forceinline__ void gla_scan_phase(Frame& F) {
    float* GCS = (float*)(F.ws + WS_GCS); const float* GDEC = (const float*)(F.ws + WS_GDEC);
    for (int gt = F.gw * 64 + F.lane; gt < 64 * 2048; gt += F.NGW * 64) {
        const int bh = gt >> 11, e4 = gt & 2047, dk = e4 >> 5;
        f32x4* p = (f32x4*)(GCS + (size_t)bh * 32 * 8192) + e4; const float* dp = GDEC + (size_t)bh * 32 * 64 + dk;
        f32x4 st = (f32x4){0.f, 0.f, 0.f, 0.f};
#pragma unroll 1
        for (int n0 = 0; n0 < 32; n0 += 8) {
            f32x4 cs[8]; float dc[8];
#pragma unroll
            for (int j = 0; j < 8; ++j) { cs[j] = p[(size_t)(n0 + j) * 2048]; dc[j] = dp[(n0 + j) * 64]; }
#pragma unroll
            for (int j = 0; j < 8; ++j) { p[(size_t)(n0 + j) * 2048] = st; st = st * dc[j] + cs[j]; }
        }
    }
}

__device__ __forceinline__ void gla_out_phase(Frame& F, int l) {
    const int tid = F.tid, lane = F.lane, wave = F.wave, r = lane & 31, hf = lane >> 5, i16 = lane & 15, grp = (lane >> 4) & 1;
    LAS unsigned char* L = F.lds;
    constexpr int QG = 0, KG = 9216, VT = 18432, PT = 38912, TOT = 59392, OT = 61440, RP = 144, VP = 320, OP = 132;
    const int dk = lane, cg = wave;
    const float* GCS = (const float*)(F.ws + WS_GCS);
    v4u rc0[8], rc1[8], rv[2]; unsigned short rq[8], rk[8]; unsigned rg[8]; f32x4 rp[4];
#define GLO_LOAD(u_) do { const int bh_ = (u_) >> 5, n_ = (u_) & 31; const size_t r0_ = (size_t)((bh_ >> 2) * 2048 + 64 * n_); const int h_ = bh_ & 3; \
        _Pragma("unroll") for (int i = 0; i < 8; ++i) { const bf16* zr = F.Z + (r0_ + 8 * cg + i) * ZP; rc0[i] = *(const v4u*)(zr + ZC_CG); rc1[i] = *(const v4u*)(zr + ZC_CG + 8); rq[i] = zr[ZC_CQ + h_ * 64 + dk]; rk[i] = zr[ZC_CK + h_ * 64 + dk]; \
            rg[i] = *(const unsigned*)(zr + ZC_CR + h_ * 128 + 2 * lane); } \
        _Pragma("unroll") for (int i = 0; i < 2; ++i) rv[i] = *(const v4u*)(F.Z + (r0_ + (tid >> 4) + 32 * i) * ZP + ZC_CV + h_ * 128 + 8 * (tid & 15)); \
        _Pragma("unroll") for (int i = 0; i < 4; ++i) rp[i] = *(const f32x4*)(GCS + (size_t)(u_) * 8192 + (size_t)(tid >> 3) * 128 + 16 * (tid & 7) + 4 * i); } while (0)
    int u = F.vcu;
    if (u < 2048) GLO_LOAD(u);
    const float g0 = F.in[I_CNG][l * 128 + 2 * lane], g1 = F.in[I_CNG][l * 128 + 2 * lane + 1];
    for (; u < 2048; u += F.G) {
        const int bh = u >> 5, n = u & 31, h = bh & 3; const size_t row0 = (size_t)((bh >> 2) * 2048 + 64 * n);
        float gwv[16];
#pragma unroll
        for (int q = 0; q < 16; ++q) gwv[q] = F.in[I_CGW][(size_t)l * 4096 + q * 256 + h * 64 + dk];
        const float gb = F.in[I_CGB][l * 256 + h * 64 + dk];
        GLA_GATE_PREFIX(TOT)
        float qv[8], kv[8]; unsigned gr[8];
#pragma unroll
        for (int i = 0; i < 8; ++i) { qv[i] = bf1(rq[i]); kv[i] = bf1(rk[i]); gr[i] = rg[i]; }
#pragma unroll
        for (int i = 0; i < 2; ++i) *(LAS v4u*)(L + VT + ((tid >> 4) + 32 * i) * VP + 16 * (tid & 15)) = rv[i];
        { v4u w0, w1; w0.x = pk2(rp[0].x, rp[0].y); w0.y = pk2(rp[0].z, rp[0].w); w0.z = pk2(rp[1].x, rp[1].y); w0.w = pk2(rp[1].z, rp[1].w);
          w1.x = pk2(rp[2].x, rp[2].y); w1.y = pk2(rp[2].z, rp[2].w); w1.z = pk2(rp[3].x, rp[3].y); w1.w = pk2(rp[3].z, rp[3].w);
          *(LAS v4u*)(L + PT + (tid >> 3) * VP + 32 * (tid & 7)) = w0; *(LAS v4u*)(L + PT + (tid >> 3) * VP + 32 * (tid & 7) + 16) = w1; }
        __syncthreads();
        GLA_OFFSETS(TOT)
#pragma unroll
        for (int i = 0; i < 8; ++i) { const float bi = off + la[i];
            *(LAS bf16*)(L + QG + (8 * cg + i) * RP + 2 * dk) = (bf16)f2bf(qv[i] * 0.125f * __expf(bi));
            *(LAS bf16*)(L + KG + (8 * cg + i) * RP + 2 * dk) = (bf16)f2bf(kv[i] * __expf(-bi)); }
        __syncthreads();
        if (u + F.G < 2048) GLO_LOAD(u + F.G);
        { const int ct = wave >> 2, dvt = wave & 3;
          f32x16 o;
#pragma unroll
          for (int i = 0; i < 16; ++i) o[i] = 0.f;
#pragma unroll
          for (int st = 0; st < 2; ++st) if (st <= ct) {
              f32x16 at;
#pragma unroll
              for (int i = 0; i < 16; ++i) at[i] = 0.f;
#pragma unroll
              for (int ks = 0; ks < 4; ++ks) { const bf16x8_t a = *(const LAS bf16x8_t*)(L + KG + (32 * st + r) * RP + (16 * ks + 8 * hf) * 2), bq = *(const LAS bf16x8_t*)(L + QG + (32 * ct + r) * RP + (16 * ks + 8 * hf) * 2);
                  at = __builtin_amdgcn_mfma_f32_32x32x16_bf16(a, bq, at, 0, 0, 0); }
              if (st == ct) {
#pragma unroll
                  for (int i = 0; i < 16; ++i) { const int cr = (i & 3) + 8 * (i >> 2) + 4 * hf; at[i] = cr <= r ? at[i] : 0.f; } }
#pragma unroll
              for (int s2 = 0; s2 < 2; ++s2) {
                  v4u pw; pw.x = pg8::cvt_pk_bf16(at[8 * s2 + 0], at[8 * s2 + 1]); pw.y = pg8::cvt_pk_bf16(at[8 * s2 + 2], at[8 * s2 + 3]); pw.z = pg8::cvt_pk_bf16(at[8 * s2 + 4], at[8 * s2 + 5]); pw.w = pg8::cvt_pk_bf16(at[8 * s2 + 6], at[8 * s2 + 7]);
                  const LAS unsigned char* vp = L + VT + (32 * st + 16 * s2 + 4 * hf + (i16 >> 2)) * VP + (32 * dvt + 16 * grp + 4 * (i16 & 3)) * 2;
                  const s16x4 lo = fa_vtr(vp), hi = fa_vtr(vp + 8 * VP);
                  o = __builtin_amdgcn_mfma_f32_32x32x16_bf16(__builtin_bit_cast(bf16x8_t, pw), __builtin_shufflevector(lo, hi, 0, 1, 2, 3, 4, 5, 6, 7), o, 0, 0, 0);
              }
          }
#pragma unroll
          for (int ks = 0; ks < 4; ++ks) { const bf16x8_t a = *(const LAS bf16x8_t*)(L + QG + (32 * ct + r) * RP + (16 * ks + 8 * hf) * 2);
              const LAS unsigned char* pp = L + PT + (16 * ks + 8 * hf + (i16 >> 2)) * VP + (32 * dvt + 16 * grp + 4 * (i16 & 3)) * 2;
              const s16x4 lo = fa_vtr(pp), hi = fa_vtr(pp + 4 * VP);
              o = __builtin_amdgcn_mfma_f32_32x32x16_bf16(a, __builtin_shufflevector(lo, hi, 0, 1, 2, 3, 4, 5, 6, 7), o, 0, 0, 0); }
          LAS float* op = (LAS float*)(L + OT) + (32 * ct + 4 * hf) * OP + 32 * dvt + r;
#pragma unroll
          for (int i = 0; i < 16; ++i) op[((i & 3) + 8 * (i >> 2)) * OP] = o[i]; }
        __syncthreads();
        { float a[8], c[8], ss[8];
#pragma unroll
          for (int i = 0; i < 8; ++i) { const LAS float* orow = (const LAS float*)(L + OT) + (8 * wave + i) * OP + 2 * lane; a[i] = orow[0]; c[i] = orow[1]; ss[i] = a[i] * a[i] + c[i] * c[i]; }
#pragma unroll
          for (int o2 = 1; o2 < 64; o2 <<= 1) {
#pragma unroll
              for (int i = 0; i < 8; ++i) ss[i] += __shfl_xor(ss[i], o2); }
#pragma unroll
          for (int i = 0; i < 8; ++i) { const float rstd = rsqrtf(ss[i] * (1.0f / 128.0f) + EPS);
              *(unsigned*)(F.OCAT + (row0 + 8 * wave + i) * 2048 + 1536 + h * 128 + 2 * lane) = pk2(a[i] * rstd * g0 * bflo(gr[i]), c[i] * rstd * g1 * bfhi(gr[i])); } }
        __syncthreads();
    }
#undef GLO_LOAD
}
#undef GLA_GATE_PREFIX
#undef GLA_OFFSETS

__device__ __forceinline__ bool in_phase(int k, int lo, int hi) { asm volatile("" : "+s"(k)); return lo <= k && k < hi; }
#define IN(k) in_phase((k), lo, hi)
#define PHASE_LANE() do { int _tz = threadIdx.x; asm volatile("" : "+v"(_tz)); F.tid = _tz; F.lane = _tz & 63; } while (0)
#define SEAM(k) do { if (IN(k) && IN((k) + 1)) xcd_barrier(bar); } while (0)
template <int l>
__device__ __forceinline__ void layer_body(Frame& F, const XcdBarrier& bar, const int lo, const int hi) {
    constexpr int pb = 1 + 11 * l;
        if (IN(pb + 0)) {
            { pg8::Gemm g{F.XN, (const bf16*)(F.ws + WS_WIN + l * WIN_L + 24 * MiB), T, 768, D}; pg8::StaticOrder S; S.init(T, 768, D, F.G, (int)blockIdx.x);
              pg8::EpiInProj<1> E{F.Z, F.ws + WS_GT, (LAS unsigned long long*)(F.misc + MO_SS), (const LAS float*)(F.misc + MO_GN) + l * 512};
              pg8::gemm_phase<pg8::EpiInProj<1>, pg8::StaticOrder, true, false>(F.lds, g, S, E); }
            { pg8::Gemm g{(const bf16*)(F.ws + WS_XN8), (const bf16*)(F.ws + WS_WIN + l * WIN_L), T, 10496, D / 2}; pg8::StaticOrder S; S.init(T, 10496, D / 2, F.G, ((int)blockIdx.x + F.G / 2) % F.G);
              pg8::EpiInProj<0> E{F.Z, F.ws + WS_GT, (LAS unsigned long long*)(F.misc + MO_SS), (const LAS float*)(F.misc + MO_GN) + l * 512};
              pg8::gemm_phase<pg8::EpiInProj<0>, pg8::StaticOrder, true, true>(F.lds, g, S, E); }
        }
        SEAM(pb + 0);
        if (IN(pb + 1)) { PHASE_LANE();
            if (F.wave & 4) convert_moe(F, l, 0, 4, 40960);
            for (int it = F.gw; it < NB * 128; it += F.NGW) {
                const int b = it >> 7, j = it & 127;
                indexer_segment(F, b, j, 0, j < 64 ? j + 1 : 64);
                if (j < 64) indexer_segment(F, b, 127 - j, 64, 128 - j);
            }
            if (!(F.wave & 4)) convert_moe(F, l, 0, 4, 40960);
            PHASE_LANE();
            gla_state_phase(F, l);
        }
        SEAM(pb + 1);
        if (IN(pb + 2)) { PHASE_LANE();
            if (F.wave & 4) convert_moe(F, l, 1, 4, 0);
            for (int row = F.gw; row < T; row += F.NGW) {
                const int t = row & 2047;
                if (t < 256) { const int nb = t + 1 - 32 * F.lane; F.MASK[(size_t)row * 64 + F.lane] = nb >= 32 ? 0xffffffffu : (nb <= 0 ? 0u : ((1u << nb) - 1u)); continue; }
                float val[32];
#pragma unroll
                for (int j = 0; j < 32; ++j) { const int s_ = 64 * j + F.lane; val[j] = F.S[(size_t)row * 2048 + (s_ < t ? s_ : t)]; }
                float vmx = -3.0e38f, vmn = 3.0e38f;
#pragma unroll
                for (int j = 0; j < 32; ++j) { const bool ok = 64 * j + F.lane <= t; val[j] = ok ? val[j] : -3.0e38f; vmx = fmaxf(vmx, val[j]); vmn = fminf(vmn, ok ? val[j] : 3.0e38f); }
#pragma unroll
                for (int o = 1; o < 64; o <<= 1) { vmx = fmaxf(vmx, __shfl_xor(vmx, o)); vmn = fminf(vmn, __shfl_xor(vmn, o)); }
                float lo = vmn, hi = vmx, thf = 0.f; bool exact = false;
#pragma unroll 1
                for (int it = 0; it < 28; ++it) { const float mid = 0.5f * (lo + hi); if (!(mid > lo && mid < hi)) break; int cnt = 0;
#pragma unroll
                    for (int j = 0; j < 32; ++j) cnt += __popcll(__ballot(val[j] >= mid));
                    if (cnt == 256) { exact = true; thf = mid; break; }
                    if (cnt > 256) lo = mid; else hi = mid; }
                unsigned th = 0u; int need = 0;
#define KEYOF(x) ({ const unsigned u_ = __float_as_uint(x); (u_ & 0x80000000u) ? ~u_ : (u_ | 0x80000000u); })
                if (!exact) {
#pragma unroll 1
                    for (int bit = 31; bit >= 0; --bit) { const unsigned cand = th | (1u << bit); int cnt = 0;
#pragma unroll
                        for (int j = 0; j < 32; ++j) cnt += __popcll(__ballot(KEYOF(val[j]) >= cand));
                        if (cnt >= 256) th = cand; }
                    int cgt = 0;
#pragma unroll
                    for (int j = 0; j < 32; ++j) cgt += __popcll(__ballot(KEYOF(val[j]) > th));
                    need = 256 - cgt;
                }
                int run = 0; unsigned myword = 0u;
#pragma unroll
                for (int j = 0; j < 32; ++j) {
                    bool sel;
                    if (exact) sel = val[j] >= thf;
                    else { const unsigned kj = KEYOF(val[j]); const bool eq = kj == th; const unsigned long long eqm = __ballot(eq);
                        const int pre = run + __popcll(eqm & ((1ull << F.lane) - 1ull)); sel = (kj > th) || (eq && pre < need); run += __popcll(eqm); sel = sel && (64 * j + F.lane <= t); }
                    const unsigned long long sm = __ballot(sel);
                    if ((F.lane >> 1) == j) myword = (F.lane & 1) ? (unsigned)(sm >> 32) : (unsigned)sm;
                }
#undef KEYOF
                F.MASK[(size_t)row * 64 + F.lane] = myword;
            }
            if (!(F.wave & 4)) convert_moe(F, l, 1, 4, 0);
            gla_scan_phase(F);
        }
        SEAM(pb + 2);
        if (IN(pb + 3)) { PHASE_LANE();
            if (F.vcu & 1) { convert_moe(F, l, 1, 2, 0); __syncthreads(); PHASE_LANE(); }
            for (int u = F.vcu; u < NB * 16; u += F.G) { const int b = u >> 4, p = u & 15; flash_unit<0>(F, l, b, 0, 64 * (31 - p)); flash_unit<0>(F, l, b, 0, 64 * p); }
            for (int u = F.vcu; u < NB * 2 * 32; u += F.G) { const int b = u >> 6, g = (u >> 5) & 1, qb = u & 31; flash_unit<1>(F, l, b, g, 64 * qb); }
            gla_out_phase(F, l);
            if (!(F.vcu & 1)) { PHASE_LANE(); convert_moe(F, l, 1, 2, 0); }
        }
        SEAM(pb + 3);
        if (IN(pb + 4)) {
            pg8::Gemm g{F.OCAT, (const bf16*)(F.ws + WS_WBR + l * WBR_L), T, D, D}; pg8::MergeOrder S; S.init(T, D, D, F.G, (int)blockIdx.x);
#ifdef PROBE_MERGE
            { pg8::EpiMergeT<PROBE_MERGE> E{F.ws + WS_GT, (bf16*)(F.ws + WS_S)}; pg8::gemm_phase<pg8::EpiMergeT<PROBE_MERGE>, pg8::MergeOrder, true>(F.lds, g, S, E); }
#endif
            pg8::EpiMerge E{F.ws + WS_GT, F.MERGED};
            pg8::gemm_phase<pg8::EpiMerge, pg8::MergeOrder, true>(F.lds, g, S, E);
        }
        SEAM(pb + 4);
        if (IN(pb + 5)) {
            pg8::Gemm g{F.MERGED, (const bf16*)(F.ws + WS_WO + l * WO_L), T, D, D}; pg8::StaticOrder S; S.init(T, D, D, F.G, (int)blockIdx.x);
            pg8::EpiResid E{(bf16*)(F.ws + WS_HB), (unsigned char*)F.XN, F.in[I_N2G] + l * D, F.lds + 3 * pg8::HTB};
            pg8::gemm_phase<pg8::EpiResid, pg8::StaticOrder, true>(F.lds, g, S, E);
        }
        SEAM(pb + 5);
        if (IN(pb + 6)) { PHASE_LANE();
            unsigned* cnt = F.ctl + CW_CNT + 64 * l;
            const int lane = F.lane, fr = lane & 15, fq = lane >> 4;
            LAS float* LG = (LAS float*)(F.lds + F.wave * 8192);
            const bf16* wrh = (const bf16*)(F.ws + WS_WRH + l * WR_L) + (size_t)fr * 2048 + 8 * fq; const bf16* wrl = (const bf16*)(F.ws + WS_WRL + l * WR_L) + (size_t)fr * 2048 + 8 * fq;
            for (int tile = F.gw; tile < T / 16; tile += F.NGW) {
                const bf16* hrow = (const bf16*)(F.ws + WS_HB) + (size_t)(16 * tile + fr) * D + 8 * fq;
                f32x4 acc[6];
#pragma unroll
                for (int nt = 0; nt < 6; ++nt) acc[nt] = (f32x4){0.f, 0.f, 0.f, 0.f};
                float ss = 0.f;
#pragma unroll 2
                for (int ks = 0; ks < 64; ++ks) {
                    const v4u hw = *(const v4u*)(hrow + 32 * ks);
                    { const float a0 = bflo(hw.x), a1 = bfhi(hw.x), a2 = bflo(hw.y), a3 = bfhi(hw.y), a4 = bflo(hw.z), a5 = bfhi(hw.z), a6 = bflo(hw.w), a7 = bfhi(hw.w);
                      ss += (a0 * a0 + a1 * a1) + (a2 * a2 + a3 * a3) + (a4 * a4 + a5 * a5) + (a6 * a6 + a7 * a7); }
                    const bf16x8_t ah = __builtin_bit_cast(bf16x8_t, hw);
#pragma unroll
                    for (int nt = 0; nt < 6; ++nt) { const bf16x8_t bh = *(const bf16x8_t*)(wrh + (size_t)(16 * nt) * 2048 + 32 * ks), bl = *(const bf16x8_t*)(wrl + (size_t)(16 * nt) * 2048 + 32 * ks);
                        acc[nt] = __builtin_amdgcn_mfma_f32_16x16x32_bf16(ah, bh, acc[nt], 0, 0, 0);
                        acc[nt] = __builtin_amdgcn_mfma_f32_16x16x32_bf16(ah, bl, acc[nt], 0, 0, 0); }
                }
                ss += __shfl_xor(ss, 16); ss += __shfl_xor(ss, 32);
                if (fq == 0) { const float rs_ = rsqrtf(ss * (1.0f / 2048.0f) + EPS); LG[1600 + fr] = rs_; ((float*)(F.ws + WS_RSTD))[16 * tile + fr] = rs_; }
#pragma unroll
                for (int nt = 0; nt < 6; ++nt)
#pragma unroll
                    for (int i = 0; i < 4; ++i) LG[(4 * fq + i) * 100 + 16 * nt + fr] = acc[nt][i];
                LDS_WAIT(); asm volatile("" ::: "memory");
                if (lane < 16) {
                    const int row = 16 * tile + lane; const float rstd = LG[1600 + lane]; const LAS float* lr = LG + lane * 100;
                    float lg[8]; int grp = 0; float gmax = -3.0e38f;
#pragma unroll
                    for (int e = 0; e < 8; ++e) { lg[e] = lr[e] * rstd + F.in[I_BRG][l * 8 + e]; if (lg[e] > gmax) { gmax = lg[e]; grp = e; } }
                    float gden = 0.f;
#pragma unroll
                    for (int e = 0; e < 8; ++e) gden += __expf(lg[e] - gmax);
                    const float gwt = 1.0f / gden;
                    int i0 = 0, i1 = 0; float m0 = -3.0e38f, m1 = -3.0e38f;
#pragma unroll
                    for (int e = 0; e < 8; ++e) { const float v = lr[8 + grp * 8 + e] * rstd + F.in[I_BRE][l * 64 + grp * 8 + e];
                        if (v > m0) { m1 = m0; i1 = i0; m0 = v; i0 = e; } else if (v > m1) { m1 = v; i1 = e; } }
                    const float e1 = __expf(m1 - m0); const float p0 = 1.0f / (1.0f + e1), p1 = e1 / (1.0f + e1);
                    const int ex0 = grp * 8 + i0, ex1 = grp * 8 + i1;
                    const unsigned r0 = atomicAdd(&cnt[ex0], 1u), r1 = atomicAdd(&cnt[ex1], 1u);
                    unsigned* rec = (unsigned*)(F.ws + WS_ROUTE) + (size_t)row * 8;
                    rec[0] = (unsigned)ex0; rec[1] = r0; rec[2] = (unsigned)ex1; rec[3] = r1; rec[4] = __float_as_uint(gwt * p0); rec[5] = __float_as_uint(gwt * p1);
                    int* liste = (int*)(F.ws + WS_LISTE); liste[(size_t)ex0 * 32768 + r0] = row; liste[(size_t)ex1 * 32768 + r1] = row;
                }
                LDS_WAIT(); asm volatile("" ::: "memory");
            }
        }
        SEAM(pb + 6);
        if (IN(pb + 7) || IN(pb + 8) || IN(pb + 9) || IN(pb + 10)) { PHASE_LANE();
            if (F.tid == 0) { const unsigned* cnt = F.ctl + CW_CNT + 64 * l; LAS int* texp = (LAS int*)(F.misc + MO_TEXP); LAS int* pst = (LAS int*)(F.misc + MO_PST); int tb = 0;
                for (int e = 0; e < NEXP; ++e) { const int c = (int)__hip_atomic_load(&cnt[e], __ATOMIC_RELAXED, __HIP_MEMORY_SCOPE_AGENT); const int nt_ = (c + 255) >> 8; pst[e] = tb * 256; ((LAS int*)(F.misc + MO_CNT))[e] = c;
                    for (int r = 0; r < nt_; ++r) texp[tb + r] = e; tb += nt_; }
                *(LAS int*)(F.misc + MO_TOT) = tb; }
            __syncthreads();
        }
        if (IN(pb + 8)) {
            pg8::Gemm g{F.XN, (const bf16*)(F.ws + WS_W13), 0, 0, D / 2};
            pg8::MoeGatherOrder S; S.total = *(const LAS int*)(F.misc + MO_TOT) * 4; S.G = F.G; S.c = F.vcu; S.NJ = 4; S.nt0 = D / 128; S.tile_exp = (const LAS int*)(F.misc + MO_TEXP);
            S.pst = (const LAS int*)(F.misc + MO_PST); S.cnt = (const LAS int*)(F.misc + MO_CNT); S.liste = (const int*)(F.ws + WS_LISTE);
            pg8::EpiGlu E{F.H, S.tile_exp, S.pst, S.cnt, S.liste, (const float*)(F.ws + WS_RSTD)};
            pg8::gemm_phase<pg8::EpiGlu, pg8::MoeGatherOrder, true, true>(F.lds, g, S, E);
        }
        SEAM(pb + 8);
        if (IN(pb + 9)) {
            pg8::Gemm g{F.H, (const bf16*)(F.ws + WS_W2), 0, 0, DEXP / 2};
            pg8::MoeOrder S{*(const LAS int*)(F.misc + MO_TOT) * 8, F.G, F.vcu, 8, DEXP / 128, (const LAS int*)(F.misc + MO_TEXP)};
            pg8::EpiY E{(unsigned char*)F.Y};
            pg8::gemm_phase<pg8::EpiY, pg8::MoeOrder, true, true>(F.lds, g, S, E);
        }
        SEAM(pb + 9);
        if (IN(pb + 10)) { PHASE_LANE();
            for (int row = F.gw; row < T; row += F.NGW) {
                const unsigned* rec = (const unsigned*)(F.ws + WS_ROUTE) + (size_t)row * 8;
                const float w0 = __uint_as_float(rec[4]) * 0.03125f, w1 = __uint_as_float(rec[5]) * 0.03125f;
                const LAS int* pst = (const LAS int*)(F.misc + MO_PST); const int p0 = pst[rec[0]] + (int)rec[1], p1 = pst[rec[2]] + (int)rec[3];
                const unsigned* y0 = (const unsigned*)((const unsigned char*)F.Y + (size_t)p0 * D) + F.lane; const unsigned* y1 = (const unsigned*)((const unsigned char*)F.Y + (size_t)p1 * D) + F.lane;
                f32x4 v[8];
                { const v2u* hr = (const v2u*)((const bf16*)(F.ws + WS_HB) + (size_t)row * D) + F.lane;
#pragma unroll
                  for (int j = 0; j < 8; ++j) { const v2u w = hr[64 * j]; v[j] = (f32x4){bflo(w.x), bfhi(w.x), bflo(w.y), bfhi(w.y)}; } }
#pragma unroll
                for (int j = 0; j < 8; ++j) { const int a = (int)y0[64 * j], c = (int)y1[64 * j];
                    const auto a01 = __builtin_amdgcn_cvt_pk_f32_fp8(a, false), a23 = __builtin_amdgcn_cvt_pk_f32_fp8(a, true), c01 = __builtin_amdgcn_cvt_pk_f32_fp8(c, false), c23 = __builtin_amdgcn_cvt_pk_f32_fp8(c, true);
                    v[j].x += w0 * a01[0] + w1 * c01[0]; v[j].y += w0 * a01[1] + w1 * c01[1]; v[j].z += w0 * a23[0] + w1 * c23[0]; v[j].w += w0 * a23[1] + w1 * c23[1]; }
                if (l + 1 < DEPTH) { v2u* hw_ = (v2u*)((bf16*)(F.ws + WS_HB) + (size_t)row * D) + F.lane;
#pragma unroll
                    for (int j = 0; j < 8; ++j) hw_[64 * j] = (v2u){pg8::cvt_pk_bf16(v[j].x, v[j].y), pg8::cvt_pk_bf16(v[j].z, v[j].w)}; }
                else { f32x4* orow = (f32x4*)(F.out + (size_t)row * D) + F.lane;
#pragma unroll
                    for (int j = 0; j < 8; ++j) orow[64 * j] = v[j]; }
                if (l + 1 < DEPTH) { const float rstd = row_rstd(v); norm_store_bf16(v, rstd, F.in[I_N1G] + (l + 1) * D, F.XN + (size_t)row * D, F.lane); norm_store_fp8(v, rstd, F.in[I_N1G] + (l + 1) * D, (unsigned char*)(F.ws + WS_XN8) + (size_t)row * D, F.lane); }
            }
        }
        SEAM(pb + 10);
    }
__global__ void __launch_bounds__(NWAVES * 64, 2) fwd_kernel(Args args) {
    extern __shared__ __attribute__((aligned(16))) unsigned char lds_raw[];
    Frame F;
    F.lds = (LAS unsigned char*)lds_raw; F.misc = F.lds + MISC_OFF;
    F.tid = threadIdx.x; F.lane = F.tid & 63; F.wave = __builtin_amdgcn_readfirstlane(F.tid >> 6);
    F.G = gridDim.x; { const int bx = blockIdx.x; F.vcu = (F.G % 8 == 0) ? (bx % 8) * (F.G / 8) + bx / 8 : bx; }
    F.gw = F.vcu * NWAVES + F.wave; F.NGW = F.G * NWAVES;
    F.in = args.in; F.out = args.out; F.ws = args.ws; F.ctl = (unsigned*)(args.ws + WS_CTL);
    F.Z = (bf16*)(args.ws + WS_Z); F.XN = (bf16*)(args.ws + WS_XN); F.OCAT = (bf16*)(args.ws + WS_OCAT); F.MERGED = (bf16*)(args.ws + WS_MERGED);
    F.XS = (bf16*)(args.ws + WS_XS); F.Y = (bf16*)(args.ws + WS_Y); F.H = (bf16*)(args.ws + WS_H);
    F.S = (float*)(args.ws + WS_S); F.GO = (float*)(args.ws + WS_GO); F.MASK = (unsigned*)(args.ws + WS_MASK);
    const int lo = args.ph_lo, hi = args.ph_hi;
    const bool use_bar = (hi - lo) > 1;
    for (int u = F.tid; u < 64; u += NWAVES * 64) ((LAS unsigned*)F.misc)[u] = 0u;
    ((LAS unsigned long long*)(F.misc + MO_SS))[F.tid] = 0ull;
    for (int i = F.tid; i < 2 * 4 * 128; i += NWAVES * 64) { const int l_ = i >> 9, k_ = (i >> 7) & 3, d_ = i & 127; ((LAS float*)(F.misc + MO_GN))[i] = F.in[k_ == 0 ? I_AQG : (k_ == 1 ? I_AKG : (k_ == 2 ? I_BQG : I_BKG))][l_ * 128 + d_]; }
    for (int i = F.tid; i < 12 * 129; i += NWAVES * 64) { const int hd = i / 129, dd = i % 129; int bk;
        if (dd < 16) bk = dd; else { bk = 16 + (int)(logf((float)dd / 16.0f) / 2.0794415416798357f * 16.0f); bk = bk > 31 ? 31 : bk; }
        ((LAS float*)(F.misc + MO_TAB2))[i] = F.in[I_RELB][bk * 12 + hd] * 1.4426950408889634f; }
    __syncthreads();
    XcdBarrier bar; bar.bar = F.ctl + CW_BAR; bar.x = 0; bar.st = nullptr;
    if (use_bar) bar = xcd_barrier_post(F.ctl + CW_BAR, (volatile LAS unsigned*)(F.misc + MO_BARW));

    if (IN(0)) { PHASE_LANE();
        LAS float* scr = (LAS float*)(F.lds + F.wave * 16384);
        constexpr int I_IN = (2048 / 64) * (D_IN / 32);
        constexpr int I_BA = (512 / 64) * (2048 / 32), I_BB = (1024 / 64) * (2048 / 32), I_BC = I_BA, I_O = (2048 / 64) * (2048 / 32);
        constexpr int PER_L = I_IN + I_BA + I_BB + I_BC + I_O;
        for (int it = F.gw; it < DEPTH * PER_L; it += F.NGW) {
            const int l = it / PER_L; int r = it % PER_L;
            bf16* win = (bf16*)(F.ws + WS_WIN + l * WIN_L); bf16* wbr = (bf16*)(F.ws + WS_WBR + l * WBR_L); bf16* wo = (bf16*)(F.ws + WS_WO + l * WO_L);
            if (r < I_IN) { const int nb_ = r % (D_IN / 32);
                const bool has8 = nb_ < 56 || (nb_ >= 58 && nb_ <= 106) || nb_ >= 122, hasb = (nb_ >= 56 && nb_ <= 58) || (nb_ >= 106 && nb_ <= 122) || nb_ == 138;
                if (has8) transpose_item_fp8(F.in[I_WIN] + (size_t)l * 2048 * D_IN, D_IN, (unsigned char*)win, 2048, 64.0f, scr, r, F.lane, MapWin8{});
                if (hasb) transpose_item(F.in[I_WIN] + (size_t)l * 2048 * D_IN, D_IN, win + (size_t)12 * 1024 * 1024, 2048, 0, scr, r, F.lane, MapWinB{});
                continue; } r -= I_IN;
            if (r < I_BA) { transpose_item(F.in[I_WBA] + (size_t)l * 512 * 2048, 2048, wbr, 2048, 0, scr, r, F.lane, MapId{0}); continue; } r -= I_BA;
            if (r < I_BB) { transpose_item(F.in[I_WBB] + (size_t)l * 1024 * 2048, 2048, wbr, 2048, 512, scr, r, F.lane, MapId{0}); continue; } r -= I_BB;
            if (r < I_BC) { transpose_item(F.in[I_WBC] + (size_t)l * 512 * 2048, 2048, wbr, 2048, 1536, scr, r, F.lane, MapId{0}); continue; } r -= I_BC;
            transpose_item(F.in[I_WO] + (size_t)l * 2048 * 2048, 2048, wo, 2048, 0, scr, r, F.lane, MapId{0});
        }
        for (int i = F.gw * 64 + F.lane; i < DEPTH * 160 * 256; i += F.NGW * 64) { const int l = i / (160 * 256), r = (i / 256) % 160, c = i % 256;
            *(v4u*)((bf16*)(F.ws + WS_WIN + l * WIN_L) + (size_t)12 * 1024 * 1024 + (size_t)(ZC_PAD - 3328 + r) * 2048 + 8 * c) = (v4u){0u, 0u, 0u, 0u}; }
        for (int i = F.gw * 64 + F.lane; i < DEPTH * 96 * 2048; i += F.NGW * 64) { const int l = i / (96 * 2048), e = (i / 2048) % 96, k = i % 2048;
            float val = 0.f; if (e < 8) val = F.in[I_WRG][(size_t)l * D * 8 + (size_t)k * 8 + e]; else if (e < 72) val = F.in[I_WRE][(size_t)l * D * 64 + (size_t)k * 64 + (e - 8)];
            val *= F.in[I_N2G][l * D + k];
            const unsigned hi = f2bf(val); const float rem = val - bf1((bf16)hi);
            ((bf16*)(F.ws + WS_WRH + l * WR_L))[e * 2048 + k] = (bf16)hi; ((bf16*)(F.ws + WS_WRL + l * WR_L))[e * 2048 + k] = (bf16)f2bf(rem); }
        for (int mrow = F.gw; mrow < T; mrow += F.NGW) { f32x4 v[8]; load_row(F.in[I_X] + (size_t)mrow * D, F.lane, v); const float rstd = row_rstd(v);
            { v2u* hw_ = (v2u*)((bf16*)(F.ws + WS_HB) + (size_t)mrow * D) + F.lane;
#pragma unroll
              for (int j = 0; j < 8; ++j) hw_[64 * j] = (v2u){pg8::cvt_pk_bf16(v[j].x, v[j].y), pg8::cvt_pk_bf16(v[j].z, v[j].w)}; }
            norm_store_bf16(v, rstd, F.in[I_N1G], F.XN + (size_t)mrow * D, F.lane); norm_store_fp8(v, rstd, F.in[I_N1G], (unsigned char*)(F.ws + WS_XN8) + (size_t)mrow * D, F.lane); }
    }
    SEAM(0);

    layer_body<0>(F, bar, lo, hi);
    layer_body<1>(F, bar, lo, hi);
}


#ifndef N_LAUNCH_MODE
#define N_LAUNCH_MODE 1
#endif
extern "C" void kernel_launch(void* const* d_in, const int* in_sizes, int n_in, void* d_out, int out_size, void* d_ws, size_t ws_size, hipStream_t stream) {
    static int grid = 0;
    if (grid == 0) {
        if (n_in != 24 || out_size != T * D || ws_size < WS_END) { fprintf(stderr, "kernel_launch: unexpected shapes (n_in %d out %d ws %zu)\n", n_in, out_size, ws_size); grid = -1; return; }
        int dev = 0, cus = 0, per_cu = 0;
        if (hipGetDevice(&dev) != hipSuccess || hipDeviceGetAttribute(&cus, hipDeviceAttributeMultiprocessorCount, dev) != hipSuccess) { grid = -1; return; }
        if (hipFuncSetAttribute((const void*)fwd_kernel, hipFuncAttributeMaxDynamicSharedMemorySize, LDS_BYTES) != hipSuccess) { fprintf(stderr, "kernel_launch: hipFuncSetAttribute failed\n"); grid = -1; return; }
        if (hipOccupancyMaxActiveBlocksPerMultiprocessor(&per_cu, (const void*)fwd_kernel, NWAVES * 64, LDS_BYTES) != hipSuccess || per_cu < 1) { fprintf(stderr, "kernel_launch: occupancy query says %d\n", per_cu); }
        (void)hipGetLastError();
        grid = cus;
    }
    if (grid < 0) return;
    (void)hipMemsetAsync((char*)d_ws + WS_CTL, 0, CTL_ZERO_BYTES, stream);
    Args a{};
    for (int i = 0; i < 24; ++i) a.in[i] = (const float*)d_in[i];
    a.out = (float*)d_out; a.ws = (unsigned char*)d_ws;
    constexpr int NPH = 1 + 11 * DEPTH;
#if N_LAUNCH_MODE == 1
    a.ph_lo = 0; a.ph_hi = NPH;
    hipLaunchKernelGGL(fwd_kernel, dim3(grid), dim3(NWAVES * 64), LDS_BYTES, stream, a);
#else
    for (int p = 0; p < NPH; ++p) { a.ph_lo = p; a.ph_hi = p + 1; hipLaunchKernelGGL(fwd_kernel, dim3(grid), dim3(NWAVES * 64), LDS_BYTES, stream, a); }
#endif
    const hipError_t le = hipPeekAtLastError();
    if (le != hipSuccess) fprintf(stderr, "kernel_launch: launch failed: %s\n", hipGetErrorName(le));
}
```

```cpp
#include <hip/hip_runtime.h>
#include <cstdio>
#include <cstdint>

__device__ __forceinline__ int lane_id() { return (int)__builtin_amdgcn_mbcnt_hi(~0u, __builtin_amdgcn_mbcnt_lo(~0u, 0u)); }
namespace pg8 {
#define PG8_LAS __attribute__((address_space(3)))
typedef unsigned short bf16_t;
typedef short bf16x8 __attribute__((ext_vector_type(8)));
typedef float f32x4 __attribute__((ext_vector_type(4)));
typedef unsigned u32x4 __attribute__((ext_vector_type(4)));
typedef unsigned u32x2 __attribute__((ext_vector_type(2)));
constexpr int BM = 256, BK = 64, HALF = 128, HTB = HALF * BK * 2  , STAGE_BYTES = 8 * HTB, NXCD = 8, WGM = 8;

__host__ __device__ __forceinline__ int lds_byte(int r, int c) { const int st = (r >> 4) * 2 + (c >> 5), rr = r & 15, cc = c & 31, ob = rr * 64 + cc * 2; return st * 1024 + (ob ^ (((ob >> 9) & 1) << 5)); }
__host__ __device__ __forceinline__ void stage_rc(int b, int& R, int& C) { const int st = b / 1024, sb = b % 1024, swz = sb ^ (((sb >> 9) & 1) << 5); R = (st >> 1) * 16 + swz / 64; C = (st & 1) * 32 + (swz % 64) / 2; }
__host__ __device__ __forceinline__ int perm32(int rho) { const int n = rho >> 4, i = rho & 15; return 8 * (i >> 2) + 4 * n + (i & 3); }

struct Unit { int pm, pn, koff, nt, seg; };
struct Gemm { const bf16_t* A; const bf16_t* Bt; int M, N, K; };

struct StaticOrder {
    static constexpr bool GATHER = false;
    int nM, nN, nwg, G, c, nt0;
    __device__ __forceinline__ int row_token(const Unit&, int) const { return 0; }
    __device__ void init(int M, int N, int K, int G_, int c_) { nM = M / BM; nN = N / BM; nwg = nM * nN; G = G_; c = c_; nt0 = K / BK; }
    __device__ bool tile(long L, Unit& u) const {
        if (L >= nwg) return false;
        int wgid = (int)L; { const int q = nwg / NXCD, r = nwg % NXCD, xcd = wgid % NXCD, off = wgid / NXCD; wgid = (xcd < r ? xcd * (q + 1) : r * (q + 1) + (xcd - r) * q) + off; }
        const int nig = WGM * nN, gid = wgid / nig, fm = gid * WGM, gsz = (nM - fm) < WGM ? (nM - fm) : WGM;
        u.pm = fm + ((wgid % nig) % gsz); u.pn = (wgid % nig) / gsz; return true;
    }
    __device__ bool next(int i, Unit& u) const { u.koff = 0; u.nt = nt0; u.seg = 0; return tile((long)i * G + c, u); }
    __device__ __forceinline__ void a_ready(const Unit&) const {}
    __device__ __forceinline__ void done(const Unit&) const {}
};
struct MergeOrder : StaticOrder {
    __device__ bool next(int i, Unit& u) const { const int rnd = i / 3, sg = i - 3 * rnd; u.seg = sg; u.koff = sg == 0 ? 0 : (sg == 1 ? 512 : 1536); u.nt = sg == 1 ? 16 : 8; return tile((long)rnd * G + c, u); }
};
struct MoeOrder {
    static constexpr bool GATHER = false;
    int total, G, c, NJ, nt0; const PG8_LAS int* tile_exp;
    __device__ bool next(int i, Unit& u) const {
        const long L = (long)i * G + c; if (L >= total) return false;
        const int R = (int)L / NJ, j = (int)L % NJ; u.pm = R; u.pn = tile_exp[R] * NJ + j; u.koff = 0; u.nt = nt0; u.seg = 0; return true;
    }
    __device__ __forceinline__ int row_token(const Unit&, int) const { return 0; }
    __device__ __forceinline__ void a_ready(const Unit&) const {}
    __device__ __forceinline__ void done(const Unit&) const {}
};
struct MoeGatherOrder : MoeOrder {
    static constexpr bool GATHER = true;
    const PG8_LAS int* pst; const PG8_LAS int* cnt; const int* liste;
    __device__ __forceinline__ int row_token(const Unit& u, int r) const {
        const int e = tile_exp[u.pm], lr = u.pm * 256 - pst[e] + r;
        return lr < cnt[e] ? liste[(size_t)e * 32768 + lr] : 0;
    }
};

typedef __bf16 bf16x2v __attribute__((ext_vector_type(2)));
typedef float f32x2v __attribute__((ext_vector_type(2)));
__device__ __forceinline__ unsigned cvt_pk_bf16(float lo, float hi) { const f32x2v v = {lo, hi}; const bf16x2v b = __builtin_convertvector(v, bf16x2v); return __builtin_bit_cast(unsigned, b); }
__device__ __forceinline__ float bflo(unsigned w) { return __uint_as_float(w << 16); }
__device__ __forceinline__ float bfhi(unsigned w) { return __uint_as_float(w & 0xffff0000u); }
__device__ __forceinline__ float sigm(float v) { return __builtin_amdgcn_rcpf(1.0f + __builtin_amdgcn_exp2f(-1.44269504f * v)); }
__device__ __forceinline__ unsigned q8x4(const f32x4 s) {
    const unsigned a = (unsigned)fminf(s[0], 255.5f), b = (unsigned)fminf(s[1], 255.5f), c = (unsigned)fminf(s[2], 255.5f), d = (unsigned)fminf(s[3], 255.5f);
    return a | (b << 8) | (c << 16) | (d << 24);
}

constexpr int ZP = 5120;
constexpr int ZC_GA = 5120, ZC_GB = 7168, ZC_GC = 9216;
constexpr size_t GT_TILE = 65536, GT_GATE = (size_t)128 * 8 * GT_TILE;

template <int PN_OFF> struct EpiInProj {
    static constexpr bool PERM = true, AFTER_DRAIN = false, CHAIN = false;
    bf16_t* O; unsigned char* GT; PG8_LAS unsigned long long* ss;
    const PG8_LAS float* gains;
    const float* rstd;
    __device__ __forceinline__ void operator()(const f32x4 (&acc)[2][2][4][2], const Unit& u, int wr, int wc, int fr, int fq) const {
        const int pn = PN_OFF ? u.pn + 13 : (u.pn < 13 ? u.pn : u.pn + 3);
        int row0 = u.pm * BM + wr * 64 + fr, col0 = pn * BM + wc * 32 + 8 * fq;
        asm volatile("" : "+v"(row0), "+v"(col0));
        const int act = pn >= 20 ? 2 : (pn >= 18 ? 1 : 0);
        const bool hn = PN_OFF == 0 && pn <= 7;
        f32x4 gn0 = (f32x4){1.f, 1.f, 1.f, 1.f}, gn1 = gn0; int lr = 0;
        if (hn) {
            lr = wr * 64 + fr; asm volatile("" : "+v"(lr));
#pragma unroll
            for (int ai = 0; ai < 2; ++ai)
#pragma unroll
                for (int m = 0; m < 4; ++m)
#pragma unroll
                    for (int bj = 0; bj < 2; ++bj) { const f32x4 a = acc[ai][bj][m][0], b = acc[ai][bj][m][1];
                        float s = (a[0] * a[0] + a[1] * a[1]) + (a[2] * a[2] + a[3] * a[3]) + (b[0] * b[0] + b[1] * b[1]) + (b[2] * b[2] + b[3] * b[3]);
                        s += __shfl_xor(s, 16); s += __shfl_xor(s, 32);
                        if (fq == 0) __hip_atomic_fetch_add(ss + (ai * HALF + m * 16 + lr) * 2 + bj, (unsigned long long)(s * 1048576.0f), __ATOMIC_RELAXED, __HIP_MEMORY_SCOPE_WORKGROUP); }
            asm volatile("s_waitcnt lgkmcnt(0)" ::: "memory"); __builtin_amdgcn_s_barrier(); asm volatile("" ::: "memory");
            const PG8_LAS float* gp = gains + (pn <= 1 ? 0 : (pn == 2 ? 128 : (pn <= 6 ? 256 : 384))) + wc * 32 + 8 * fq;
            gn0 = *(const PG8_LAS f32x4*)gp; gn1 = *(const PG8_LAS f32x4*)(gp + 4);
        }
        if (act == 2) {
            int lo16 = (wr * 4 + wc) * 8192 + (fq * 16 + fr) * 16; asm volatile("" : "+v"(lo16));
            unsigned char* gp = GT + (size_t)((pn - 20) >> 3) * GT_GATE + ((size_t)u.pm * 8 + ((pn - 20) & 7)) * GT_TILE + lo16;
#pragma unroll
            for (int ai = 0; ai < 2; ++ai)
#pragma unroll
                for (int m = 0; m < 4; ++m) { u32x4 w;
#pragma unroll
                    for (int bj = 0; bj < 2; ++bj) { const f32x4 v0 = acc[ai][bj][m][0] * (-1.44269504f * 0.015625f), v1 = acc[ai][bj][m][1] * (-1.44269504f * 0.015625f); f32x4 s0, s1;
#pragma unroll
                        for (int j = 0; j < 4; ++j) { s0[j] = __builtin_amdgcn_exp2f(v0[j]); s1[j] = __builtin_amdgcn_exp2f(v1[j]); }
                        s0 = s0 * 0.00390625f + 0.00390625f; s1 = s1 * 0.00390625f + 0.00390625f;
#pragma unroll
                        for (int j = 0; j < 4; ++j) { s0[j] = __builtin_amdgcn_rcpf(s0[j]); s1[j] = __builtin_amdgcn_rcpf(s1[j]); }
                        w[2 * bj] = q8x4(s0); w[2 * bj + 1] = q8x4(s1); }
                    *(u32x4*)(gp + (ai * 4 + m) * 1024) = w; }
            return;
        }
#pragma unroll
        for (int ai = 0; ai < 2; ++ai)
#pragma unroll
            for (int m = 0; m < 4; ++m) { bf16_t* rowp = O + (size_t)(row0 + ai * HALF + m * 16) * ZP + col0; const float rs = PN_OFF ? rstd[row0 + ai * HALF + m * 16] : 1.0f;
#pragma unroll
                for (int bj = 0; bj < 2; ++bj) { f32x4 v0 = acc[ai][bj][m][0], v1 = acc[ai][bj][m][1];
                    if (hn && !(pn == 2 && bj == 1)) { const float r = rsqrtf((float)ss[(ai * HALF + m * 16 + lr) * 2 + bj] * (0.015625f * 0.015625f / 128.0f / 1048576.0f) + 1e-6f) * 0.015625f;
                        v0 = v0 * r * gn0; v1 = v1 * r * gn1; }
                    else if (PN_OFF == 0) { v0 = v0 * 0.015625f; v1 = v1 * 0.015625f; }
                    else { v0 = v0 * rs; v1 = v1 * rs; }
                    if (act) {
#pragma unroll
                        for (int j = 0; j < 4; ++j) { v0[j] *= sigm(v0[j]); v1[j] *= sigm(v1[j]); } }
                    u32x4 w; w.x = cvt_pk_bf16(v0[0], v0[1]); w.y = cvt_pk_bf16(v0[2], v0[3]); w.z = cvt_pk_bf16(v1[0], v1[1]); w.w = cvt_pk_bf16(v1[2], v1[3]);
                    *(u32x4*)(rowp + bj * HALF) = w; } }
        if (hn) { asm volatile("s_waitcnt lgkmcnt(0)" ::: "memory"); __builtin_amdgcn_s_barrier(); asm volatile("" ::: "memory");
            ss[(wr * 4 + wc) * 64 + fq * 16 + fr] = 0ull; }
    }
};
template <int MODE = 0> struct EpiMergeT {
    static constexpr bool PERM = true, AFTER_DRAIN = false, CHAIN = true;
    const unsigned char* GT; bf16_t* O;
    __device__ __forceinline__ void operator()(f32x4 (&acc)[2][2][4][2], const Unit& u, int wr, int wc, int fr, int fq) const {
        if (MODE == 2) return;
        const int row0 = u.pm * BM + wr * 64 + fr, col0 = u.pn * BM + wc * 32 + 8 * fq;
        int lo16 = (wr * 4 + wc) * 8192 + (fq * 16 + fr) * 16; asm volatile("" : "+v"(lo16));
        const unsigned char* gp = GT + ((size_t)u.pm * 8 + u.pn) * GT_TILE + lo16;
        const size_t cn = (size_t)u.seg * GT_GATE, cd = (size_t)(u.seg == 0 ? 1 : 2) * GT_GATE;
        const bool fin = u.seg == 2;
        u32x4 gn[2][4], gd[2][4];
#pragma unroll
        for (int ai = 0; ai < 2; ++ai)
#pragma unroll
            for (int m = 0; m < 4; ++m) {
                if (MODE == 1) { gn[ai][m] = (u32x4){0x80808080u + (unsigned)u.pm, 0x80808080u, 0x80808080u, 0x80808080u}; gd[ai][m] = gn[ai][m]; } else {
                gn[ai][m] = *(const u32x4*)(gp + cn + (ai * 4 + m) * 1024); gd[ai][m] = *(const u32x4*)(gp + cd + (ai * 4 + m) * 1024); } }
#pragma unroll
        for (int ai = 0; ai < 2; ++ai)
#pragma unroll
            for (int m = 0; m < 4; ++m)
#pragma unroll
                for (int bj = 0; bj < 2; ++bj) { const size_t r = (size_t)(row0 + ai * HALF + m * 16);
#pragma unroll
                    for (int w = 0; w < 2; ++w)
#pragma unroll
                        for (int k = 0; k < 4; ++k) { const float qn = (float)((gn[ai][m][2 * bj + w] >> (8 * k)) & 0xffu) + 0.5f, qd = (float)((gd[ai][m][2 * bj + w] >> (8 * k)) & 0xffu) + 0.5f;
                            acc[ai][bj][m][w][k] *= qn * __builtin_amdgcn_rcpf(fin ? 256.0f : qd); }
                    if (fin) { const f32x4 v0 = acc[ai][bj][m][0], v1 = acc[ai][bj][m][1];
                        u32x4 w; w.x = cvt_pk_bf16(v0[0], v0[1]); w.y = cvt_pk_bf16(v0[2], v0[3]); w.z = cvt_pk_bf16(v1[0], v1[1]); w.w = cvt_pk_bf16(v1[2], v1[3]);
                        *(u32x4*)(O + r * 2048 + col0 + bj * HALF) = w; } }
    }
};
typedef EpiMergeT<0> EpiMerge;
struct EpiResid {
    static constexpr int PERM = 2; static constexpr bool AFTER_DRAIN = false, CHAIN = false;
    bf16_t* hb; unsigned char* xu; const float* gain; PG8_LAS unsigned char* stg;
    __device__ __forceinline__ void operator()(const f32x4 (&acc)[2][2][4][2], const Unit& u, int wr, int wc, int fr, int fq) const {
        int lane = fq * 16 + fr; asm volatile("" : "+v"(lane));
        PG8_LAS unsigned char* s0 = stg + (wr * 4 + wc) * 1024;
        const int r8 = lane >> 3, pc = lane & 7;
        const int offc = r8 * 128 + ((pc ^ r8) << 4);
        const int offa0 = (fr >> 3) * 8192 + (fr & 7) * 128 + ((fq ^ (fr & 7)) << 4), offa1 = (fr >> 3) * 8192 + (fr & 7) * 128 + (((4 + fq) ^ (fr & 7)) << 4);
        const int xs = 2 * (fr >> 2), offxw0 = fr * 64 + ((fq ^ xs) << 3), offxw1 = fr * 64 + (((4 + fq) ^ xs) << 3);
        const int xr = lane >> 2, xq = lane & 3, offxr = xr * 64 + (((2 * xq) ^ (2 * (xr >> 2))) << 3);
        const size_t goff = (size_t)(u.pm * BM + wr * 64 + r8) * 2048 + u.pn * BM + wc * 64 + pc * 8;
        const size_t xoff = (size_t)(u.pm * BM + wr * 64 + xr) * 2048 + u.pn * BM + wc * 64 + xq * 16;
        f32x4 gv[2][2];
#pragma unroll
        for (int bj = 0; bj < 2; ++bj)
#pragma unroll
            for (int n = 0; n < 2; ++n) gv[bj][n] = *(const f32x4*)(gain + u.pn * BM + wc * 64 + bj * 32 + 8 * fq + 4 * n);
        const f32x4 lo4 = (f32x4){-440.f, -440.f, -440.f, -440.f}, hi4 = (f32x4){440.f, 440.f, 440.f, 440.f};
#pragma unroll
        for (int ai = 0; ai < 2; ++ai) {
            u32x4 bb[4][2];
#pragma unroll
            for (int m = 0; m < 4; ++m)
#pragma unroll
                for (int j = 0; j < 2; ++j) bb[m][j] = *(const u32x4*)(hb + goff + (size_t)(ai * HALF + m * 16 + 8 * j) * 2048);
#pragma unroll
            for (int m = 0; m < 4; ++m) {
                *(PG8_LAS u32x4*)(s0 + offc) = bb[m][0]; *(PG8_LAS u32x4*)(s0 + 8192 + offc) = bb[m][1];
                asm volatile("" ::: "memory");
                const u32x4 a0 = *(const PG8_LAS u32x4*)(s0 + offa0), a1 = *(const PG8_LAS u32x4*)(s0 + offa1);
                asm volatile("" ::: "memory");
                u32x2 xw[2];
#pragma unroll
                for (int bj = 0; bj < 2; ++bj) { const u32x4 w = bj ? a1 : a0;
                    const f32x4 h0 = (f32x4){bflo(w.x), bfhi(w.x), bflo(w.y), bfhi(w.y)} + acc[ai][bj][m][0], h1 = (f32x4){bflo(w.z), bfhi(w.z), bflo(w.w), bfhi(w.w)} + acc[ai][bj][m][1];
                    u32x4 hw; hw.x = cvt_pk_bf16(h0[0], h0[1]); hw.y = cvt_pk_bf16(h0[2], h0[3]); hw.z = cvt_pk_bf16(h1[0], h1[1]); hw.w = cvt_pk_bf16(h1[2], h1[3]);
                    *(PG8_LAS u32x4*)(s0 + (bj ? offa1 : offa0)) = hw;
                    const f32x4 x0 = __builtin_elementwise_min(__builtin_elementwise_max(h0 * gv[bj][0], lo4), hi4), x1 = __builtin_elementwise_min(__builtin_elementwise_max(h1 * gv[bj][1], lo4), hi4);
                    int w0 = 0, w1 = 0;
                    w0 = __builtin_amdgcn_cvt_pk_fp8_f32(x0[0], x0[1], w0, false); w0 = __builtin_amdgcn_cvt_pk_fp8_f32(x0[2], x0[3], w0, true);
                    w1 = __builtin_amdgcn_cvt_pk_fp8_f32(x1[0], x1[1], w1, false); w1 = __builtin_amdgcn_cvt_pk_fp8_f32(x1[2], x1[3], w1, true);
                    xw[bj] = (u32x2){(unsigned)w0, (unsigned)w1}; }
                asm volatile("" ::: "memory");
                const u32x4 o0 = *(const PG8_LAS u32x4*)(s0 + offc), o1 = *(const PG8_LAS u32x4*)(s0 + 8192 + offc);
                asm volatile("" ::: "memory");
                *(PG8_LAS u32x2*)(s0 + offxw0) = xw[0]; *(PG8_LAS u32x2*)(s0 + offxw1) = xw[1];
                asm volatile("" ::: "memory");
                const u32x4 xo = *(const PG8_LAS u32x4*)(s0 + offxr);
                asm volatile("" ::: "memory");
                *(u32x4*)(hb + goff + (size_t)(ai * HALF + m * 16) * 2048) = o0; *(u32x4*)(hb + goff + (size_t)(ai * HALF + m * 16 + 8) * 2048) = o1;
                *(u32x4*)(xu + xoff + (size_t)(ai * HALF + m * 16) * 2048) = xo;
            }
        }
        asm volatile("s_waitcnt lgkmcnt(0)" ::: "memory");
    }
};
struct EpiGlu {
    static constexpr bool PERM = false, AFTER_DRAIN = false, CHAIN = false;
    bf16_t* H; const PG8_LAS int* tile_exp; const PG8_LAS int* pst; const PG8_LAS int* cnt; const int* liste; const float* rstd;
    __device__ __forceinline__ void operator()(const f32x4 (&acc)[2][2][4][2], const Unit& u, int wr, int wc, int fr, int fq) const {
        const int row0 = u.pm * BM + wr * 64 + fr, pj = u.pn & 3;
        const int e = tile_exp[u.pm], lr0 = u.pm * 256 - pst[e] + wr * 64 + fr, ce = cnt[e];
        int tok[2][4]; float rs[2][4];
#pragma unroll
        for (int ai = 0; ai < 2; ++ai)
#pragma unroll
            for (int m = 0; m < 4; ++m) { const int lr = lr0 + ai * HALF + m * 16; tok[ai][m] = lr < ce ? liste[(size_t)e * 32768 + lr] : 0; }
#pragma unroll
        for (int ai = 0; ai < 2; ++ai)
#pragma unroll
            for (int m = 0; m < 4; ++m) rs[ai][m] = rstd[tok[ai][m]] * 0.015625f;
#pragma unroll
        for (int ai = 0; ai < 2; ++ai)
#pragma unroll
            for (int m = 0; m < 4; ++m) { unsigned char* rowp = (unsigned char*)H + (size_t)(row0 + ai * HALF + m * 16) * 512; const float r = rs[ai][m];
#pragma unroll
                for (int bj = 0; bj < 2; ++bj) { const f32x4 a = acc[ai][bj][m][0] * r, b = acc[ai][bj][m][1] * r;
                    const int hc = 16 * (8 * pj + 4 * bj + wc) + 4 * fq;
                    float hv[4];
#pragma unroll
                    for (int j = 0; j < 4; ++j) hv[j] = fminf(fmaxf(a[j] * sigm(a[j]) * b[j] * 8.0f, -440.0f), 440.0f);
                    int w = 0; w = __builtin_amdgcn_cvt_pk_fp8_f32(hv[0], hv[1], w, false); w = __builtin_amdgcn_cvt_pk_fp8_f32(hv[2], hv[3], w, true);
                    *(int*)(rowp + hc) = w; } }
    }
};
struct EpiY {
    static constexpr bool PERM = true, AFTER_DRAIN = false, CHAIN = false;
    unsigned char* Y;
    __device__ __forceinline__ void operator()(const f32x4 (&acc)[2][2][4][2], const Unit& u, int wr, int wc, int fr, int fq) const {
        const int row0 = u.pm * BM + wr * 64 + fr, col0 = (u.pn & 7) * BM + wc * 32 + 8 * fq;
        const f32x4 lo4 = (f32x4){-440.f, -440.f, -440.f, -440.f}, hi4 = (f32x4){440.f, 440.f, 440.f, 440.f};
#pragma unroll
        for (int ai = 0; ai < 2; ++ai)
#pragma unroll
            for (int m = 0; m < 4; ++m) { unsigned char* rowp = Y + (size_t)(row0 + ai * HALF + m * 16) * 2048 + col0;
#pragma unroll
                for (int bj = 0; bj < 2; ++bj) {
                    const f32x4 v0 = __builtin_elementwise_min(__builtin_elementwise_max(acc[ai][bj][m][0] * 0.125f, lo4), hi4), v1 = __builtin_elementwise_min(__builtin_elementwise_max(acc[ai][bj][m][1] * 0.125f, lo4), hi4);
                    int w0 = 0, w1 = 0;
                    w0 = __builtin_amdgcn_cvt_pk_fp8_f32(v0[0], v0[1], w0, false); w0 = __builtin_amdgcn_cvt_pk_fp8_f32(v0[2], v0[3], w0, true);
                    w1 = __builtin_amdgcn_cvt_pk_fp8_f32(v1[0], v1[1], w1, false); w1 = __builtin_amdgcn_cvt_pk_fp8_f32(v1[2], v1[3], w1, true);
                    *(u32x2*)(rowp + bj * HALF) = (u32x2){(unsigned)w0, (unsigned)w1}; } }
    }
};

typedef int v4i_t __attribute__((ext_vector_type(4)));
typedef int v8i_t __attribute__((ext_vector_type(8)));
template <class Epi, class Sched, bool ALIGN_EPI = false, bool FP8 = false>
__device__ __forceinline__ void gemm_phase(PG8_LAS unsigned char* lds, const Gemm g, const Sched& S, const Epi& E) {
    int tid = threadIdx.x; asm volatile("" : "+v"(tid));
    const int wid = __builtin_amdgcn_readfirstlane(tid >> 6), lane = tid & 63, wr = wid >> 2, wc = wid & 3, fr = lane & 15, fq = lane >> 4;
    const int K = g.K;
    unsigned voffA[2], voffB[2]; int RA[2]; unsigned CA2[2];
#pragma unroll
    for (int i = 0; i < 2; ++i) { int R, C; stage_rc(tid * 16 + i * 8192, R, C); const int Rb = Epi::PERM == 2 ? ((R >> 5) * 64 + perm32(R & 31)) : (Epi::PERM ? ((R & ~31) + perm32(R & 31)) : R);
        voffA[i] = (unsigned)(R * K + C) * 2u; voffB[i] = (unsigned)(Rb * K + C) * 2u; RA[i] = R; CA2[i] = (unsigned)C * 2u; }
    unsigned gAc[2][2], gAn[2][2];
#define PG8_GOFF(dst, uu) do { _Pragma("unroll") for (int h_ = 0; h_ < 2; ++h_) _Pragma("unroll") for (int i_ = 0; i_ < 2; ++i_) dst[h_][i_] = (unsigned)S.row_token(uu, 128 * h_ + RA[i_]) * (unsigned)(K * 2) + CA2[i_]; } while (0)
#define PG8_STAGE_A(bufoff, gbase, half, garr) do { if constexpr (Sched::GATHER) PG8_STAGE(bufoff, gbase, garr); else PG8_STAGE(bufoff, (gbase) + (half) * hstep, voffA); } while (0)
    const size_t kstep = (size_t)(BK * 2);
    const size_t hstep = (size_t)HALF * K * 2;
    const size_t hstepB = Epi::PERM == 2 ? (size_t)32 * K * 2 : hstep;
    const size_t tstep = 2 * hstep;
    const unsigned ldsw = (unsigned)wid * 1024u;
    const int aoff = lds_byte(wr * 64 + fr, fq * 8), boff = lds_byte(wc * 32 + fr, fq * 8);
#define PG8_SA(b, h) (((b) * 2 + (h)) * HTB)
#define PG8_SB(b, h) ((4 + (b) * 2 + (h)) * HTB)
#define PG8_STAGE(bufoff, gbase, voff) do { _Pragma("unroll") for (int _i = 0; _i < 2; ++_i) \
        __builtin_amdgcn_global_load_lds((const unsigned*)((const char*)(gbase) + (voff)[_i]), (PG8_LAS unsigned*)(lds + (bufoff) + ldsw + _i * 8192), 16, 0, 0); } while (0)
#define PG8_LDA(dst, b, h) do { if constexpr (FP8) { _Pragma("unroll") for (int m = 0; m < 4; ++m) dst##8[m] = __builtin_shufflevector(*(const PG8_LAS v4i_t*)(lds + PG8_SA(b, h) + aoff + m * 2048), *(const PG8_LAS v4i_t*)(lds + PG8_SA(b, h) + aoff + m * 2048 + 1024), 0, 1, 2, 3, 4, 5, 6, 7); } \
        else { _Pragma("unroll") for (int m = 0; m < 4; ++m) _Pragma("unroll") for (int k = 0; k < 2; ++k) dst[m][k] = *(const PG8_LAS bf16x8*)(lds + PG8_SA(b, h) + aoff + m * 2048 + k * 1024); } } while (0)
#define PG8_LDB(dst, b, h) do { if constexpr (FP8) { _Pragma("unroll") for (int n = 0; n < 2; ++n) dst##8[n] = __builtin_shufflevector(*(const PG8_LAS v4i_t*)(lds + PG8_SB(b, h) + boff + n * 2048), *(const PG8_LAS v4i_t*)(lds + PG8_SB(b, h) + boff + n * 2048 + 1024), 0, 1, 2, 3, 4, 5, 6, 7); } \
        else { _Pragma("unroll") for (int n = 0; n < 2; ++n) _Pragma("unroll") for (int k = 0; k < 2; ++k) dst[n][k] = *(const PG8_LAS bf16x8*)(lds + PG8_SB(b, h) + boff + n * 2048 + k * 1024); } } while (0)
#define PG8_MMA(ai, bj, At, Bt) do { __builtin_amdgcn_s_setprio(1); _Pragma("unroll") for (int m = 0; m < 4; ++m) _Pragma("unroll") for (int n = 0; n < 2; ++n) { \
        if constexpr (FP8) asm volatile("v_mfma_f32_16x16x128_f8f6f4 %0, %1, %2, %0" : "+v"(acc[ai][bj][m][n]) : "v"(Bt##8[n]), "v"(At##8[m])); \
        else { _Pragma("unroll") for (int k = 0; k < 2; ++k) acc[ai][bj][m][n] = __builtin_amdgcn_mfma_f32_16x16x32_bf16(Bt[n][k], At[m][k], acc[ai][bj][m][n], 0, 0, 0); } } \
        __builtin_amdgcn_s_setprio(0); } while (0)
#define PG8_WAIT_V(n) asm volatile("s_waitcnt vmcnt(" #n ")" ::: "memory")
#define PG8_WAIT_L(n) asm volatile("s_waitcnt lgkmcnt(" #n ")" ::: "memory")
#define PG8_BAR __builtin_amdgcn_s_barrier()
#define PG8_SCHED __builtin_amdgcn_sched_barrier(0)
    Unit cur, nxt; int ui = 0;
    if (!S.next(0, cur)) return;
    f32x4 acc[2][2][4][2];
#pragma unroll
    for (int a = 0; a < 2; ++a)
#pragma unroll
        for (int b = 0; b < 2; ++b)
#pragma unroll
            for (int m = 0; m < 4; ++m)
#pragma unroll
                for (int n = 0; n < 2; ++n) acc[a][b][m][n] = (f32x4){0.f, 0.f, 0.f, 0.f};
    bf16x8 At[4][2], B0[2][2], B1[2][2]; v8i_t At8[4], B08[2], B18[2];
    const size_t tstepA = Sched::GATHER ? (size_t)0 : tstep;
    const char* cA = (const char*)g.A + (size_t)cur.pm * tstepA + (size_t)cur.koff * 2; const char* cB = (const char*)g.Bt + (size_t)cur.pn * tstep + (size_t)cur.koff * 2;
    S.a_ready(cur);
    if constexpr (Sched::GATHER) { PG8_GOFF(gAc, cur); }
    PG8_STAGE(PG8_SB(0, 0), cB, voffB); PG8_STAGE(PG8_SB(0, 1), cB + hstepB, voffB); PG8_STAGE_A(PG8_SA(0, 0), cA, 0, gAc[0]); PG8_STAGE_A(PG8_SA(0, 1), cA, 1, gAc[1]);
    if (wr == 1) PG8_BAR;
    PG8_WAIT_V(2); PG8_BAR;
    PG8_STAGE(PG8_SB(1, 0), cB + kstep, voffB); PG8_STAGE_A(PG8_SA(1, 0), cA + kstep, 0, gAc[0]); PG8_STAGE(PG8_SB(1, 1), cB + hstepB + kstep, voffB);
    PG8_WAIT_V(6); PG8_BAR;
    for (;;) {
        const bool has_next = S.next(ui + 1, nxt);
        const char* nA = has_next ? (const char*)g.A + (size_t)nxt.pm * tstepA + (size_t)nxt.koff * 2 : cA; const char* nB = has_next ? (const char*)g.Bt + (size_t)nxt.pn * tstep + (size_t)nxt.koff * 2 : cB;
        if constexpr (Sched::GATHER) { if (has_next) { PG8_GOFF(gAn, nxt); } else {
#pragma unroll
            for (int h_ = 0; h_ < 2; ++h_)
#pragma unroll
                for (int i_ = 0; i_ < 2; ++i_) gAn[h_][i_] = gAc[h_][i_]; } }
        const int nt = cur.nt;
        for (int t = 0; t < nt; t += 2) {
            const bool last = (t == nt - 2);
            const char* a1 = cA + (size_t)(t + 1) * kstep;
            const char* a2 = last ? nA : cA + (size_t)(t + 2) * kstep; const char* b2 = last ? nB : cB + (size_t)(t + 2) * kstep;
            const char* a3 = a2 + kstep; const char* b3 = b2 + kstep;
            if (last && has_next) S.a_ready(nxt);
            unsigned g2a[2][2];
            if constexpr (Sched::GATHER) {
#pragma unroll
                for (int h_ = 0; h_ < 2; ++h_)
#pragma unroll
                    for (int i_ = 0; i_ < 2; ++i_) g2a[h_][i_] = last ? gAn[h_][i_] : gAc[h_][i_]; }
            PG8_LDB(B0, 0, 0); PG8_LDB(B1, 0, 1); PG8_SCHED; PG8_LDA(At, 0, 0); PG8_STAGE_A(PG8_SA(1, 1), a1, 1, gAc[1]);
            PG8_WAIT_V(8); PG8_WAIT_L(0); PG8_BAR; PG8_MMA(0, 0, At, B0); PG8_MMA(0, 1, At, B1); PG8_BAR; PG8_SCHED;
            PG8_LDA(At, 0, 1); PG8_STAGE(PG8_SB(0, 0), b2, voffB); PG8_STAGE(PG8_SB(0, 1), b2 + hstepB, voffB); PG8_STAGE_A(PG8_SA(0, 0), a2, 0, g2a[0]);
            PG8_WAIT_V(8); PG8_WAIT_L(0); PG8_BAR; PG8_MMA(1, 0, At, B0); PG8_MMA(1, 1, At, B1); PG8_BAR; PG8_SCHED;
            PG8_LDB(B0, 1, 0); PG8_LDB(B1, 1, 1); PG8_SCHED; PG8_LDA(At, 1, 0); PG8_STAGE_A(PG8_SA(0, 1), a2, 1, g2a[1]);
            PG8_WAIT_V(8); PG8_WAIT_L(0); PG8_BAR; PG8_MMA(0, 0, At, B0); PG8_MMA(0, 1, At, B1); PG8_BAR; PG8_SCHED;
            PG8_LDA(At, 1, 1); PG8_STAGE(PG8_SB(1, 0), b3, voffB); PG8_STAGE(PG8_SB(1, 1), b3 + hstepB, voffB); PG8_STAGE_A(PG8_SA(1, 0), a3, 0, g2a[0]);
            PG8_WAIT_V(8); PG8_WAIT_L(0); PG8_BAR; PG8_MMA(1, 0, At, B0); PG8_MMA(1, 1, At, B1); PG8_BAR; PG8_SCHED;
        }
        if constexpr (ALIGN_EPI) { if (wr == 0) PG8_BAR; }
        if constexpr (FP8) asm volatile("s_nop 15\n\ts_nop 15\n\ts_nop 15\n\ts_nop 15" ::: "memory");
        E(acc, cur, wr, wc, fr, fq); S.done(cur);
        if (!has_next) break;
        if (!Epi::CHAIN || cur.seg == 2)
#pragma unroll
        for (int a = 0; a < 2; ++a)
#pragma unroll
            for (int b = 0; b < 2; ++b)
#pragma unroll
                for (int m = 0; m < 4; ++m)
#pragma unroll
                    for (int n = 0; n < 2; ++n) acc[a][b][m][n] = (f32x4){0.f, 0.f, 0.f, 0.f};
        cur = nxt; cA = nA; cB = nB; ++ui;
        if constexpr (Sched::GATHER) {
#pragma unroll
            for (int h_ = 0; h_ < 2; ++h_)
#pragma unroll
                for (int i_ = 0; i_ < 2; ++i_) gAc[h_][i_] = gAn[h_][i_]; }
        if constexpr (ALIGN_EPI) { if (wr == 1) PG8_BAR; }
    }
    PG8_WAIT_V(0);
    if constexpr (!ALIGN_EPI) { if (wr == 0) PG8_BAR; }
    PG8_BAR;
#undef PG8_SA
#undef PG8_SB
#undef PG8_STAGE_A
#undef PG8_GOFF
#undef PG8_STAGE
#undef PG8_LDA
#undef PG8_LDB
#undef PG8_MMA
#undef PG8_WAIT_V
#undef PG8_WAIT_L
#undef PG8_BAR
#undef PG8_SCHED
}
}

constexpr int NWAVES = 8;
constexpr int T = 32768, SEQ = 2048, NB = 16, D = 2048, DEPTH = 2;
constexpr int ZP = pg8::ZP;
constexpr int ZC_AQ = 0, ZC_AK = 512, ZC_AV = 640, ZC_BQ = 768, ZC_BK = 1792, ZC_BV = 2048, ZC_IQ = 2304, ZC_IK = 3328, ZC_IW = 3392, ZC_CG = 3408, ZC_PAD = 3424, ZC_CQ = 3584, ZC_CK = 3840, ZC_CV = 4096, ZC_CR = 4608;
constexpr int D_IN = 11104;
constexpr int NEXP = 64, DEXP = 512, PMAX_TILES = 320;
constexpr float EPS = 1e-6f;

constexpr size_t MiB = 1u << 20;
constexpr size_t WS_CTL = 0, CTL_ZERO_BYTES = 1 * MiB;
constexpr size_t WS_ROUTE = 2 * MiB;
constexpr size_t WS_WRH = 4 * MiB, WS_WRL = 6 * MiB, WR_L = 96 * 2048 * 2;
constexpr size_t WS_WIN = 16 * MiB, WIN_L = 44 * MiB;
constexpr size_t WS_WBR = 104 * MiB, WBR_L = 8 * MiB;
constexpr size_t WS_WO = 120 * MiB, WO_L = 8 * MiB;
constexpr size_t WS_W13 = 136 * MiB;
constexpr size_t WS_HB = 264 * MiB;
constexpr size_t WS_W2 = 392 * MiB;
constexpr size_t WS_XN = 520 * MiB;
constexpr size_t WS_OCAT = 648 * MiB;
constexpr size_t WS_MERGED = 776 * MiB;
constexpr size_t WS_Z = 904 * MiB;
constexpr size_t WS_GT = 1224 * MiB;
constexpr size_t WS_S = 1608 * MiB;
constexpr size_t WS_MASK = 1864 * MiB;
constexpr size_t WS_GO = 1872 * MiB;
constexpr size_t WS_GCS = WS_GO;
constexpr size_t WS_GDEC = 8 * MiB;
constexpr size_t WS_RSTD1 = 10 * MiB;
constexpr size_t WS_RSTD = 9 * MiB;
constexpr size_t WS_LISTE = 904 * MiB;
constexpr size_t WS_XS = 904 * MiB;
constexpr size_t WS_Y = 1224 * MiB;
constexpr size_t WS_H = 1544 * MiB;
constexpr size_t WS_WG8 = 1936 * MiB, WG8_L = 12 * MiB;
constexpr size_t WS_XN8 = WS_S;
constexpr size_t WS_END = 1936 * MiB;
constexpr int CW_BAR = 4096;
constexpr int CW_CNT = 16384;

constexpr int RING_BYTES = 131072, MISC_OFF = RING_BYTES, LDS_BYTES = 155648;
constexpr int MO_BARW = 32, MO_GN = 256, MO_TEXP = 8192, MO_PST = 9728, MO_TOT = 9984, MO_TAB2 = 10240, MO_CNT = 16640, MO_SS = 16896;

#define GAS __attribute__((address_space(1)))
#define LAS __attribute__((address_space(3)))
typedef unsigned short bf16;
typedef unsigned v4u __attribute__((ext_vector_type(4)));
typedef unsigned v2u __attribute__((ext_vector_type(2)));
typedef float f32x4 __attribute__((ext_vector_type(4)));
#define LDS_WAIT() asm volatile("s_waitcnt lgkmcnt(0)" ::: "memory")
__device__ __forceinline__ unsigned f2bf(float f) { unsigned u = __builtin_bit_cast(unsigned, f); return (u + 0x7fffu + ((u >> 16) & 1u)) >> 16; }
__device__ __forceinline__ unsigned pk2(float lo, float hi) { return pg8::cvt_pk_bf16(lo, hi); }
__device__ __forceinline__ float bflo(unsigned w) { return __uint_as_float(w << 16); }
__device__ __forceinline__ float bfhi(unsigned w) { return __uint_as_float(w & 0xffff0000u); }
__device__ __forceinline__ float bf1(bf16 h) { return __uint_as_float(((unsigned)h) << 16); }

#define XB_TMO      128
#define XB_XCNT(j)  (256  + 64 * (j))
#define XB_XSUB(j)  (1280 + 64 * (j))
#define XB_XGEN(j)  (2304 + 64 * (j))
#define XB_TOP      3328
#define XB_TOPGEN   3392
#define XCD_BAR_WORDS 3456
#define XB_SPIN_CAP (1u << 18)
__device__ __forceinline__ unsigned xb_ld(unsigned* p)              { return __hip_atomic_load(p, __ATOMIC_RELAXED, __HIP_MEMORY_SCOPE_AGENT); }
__device__ __forceinline__ unsigned xb_add(unsigned* p, unsigned v) { return __hip_atomic_fetch_add(p, v, __ATOMIC_RELAXED, __HIP_MEMORY_SCOPE_AGENT); }
__device__ __forceinline__ unsigned xb_xcc_id() { return (unsigned)__builtin_amdgcn_s_getreg((3 << 11) | 20) & 0xFu; }
#define XB_SPIN(cond, bar) do { unsigned _sp = 0; while (cond) { __builtin_amdgcn_s_sleep(1); \
    if ((++_sp & 255u) == 0u) { if (xb_ld(&(bar)[XB_TMO])) break; if (_sp > XB_SPIN_CAP) { atomicAdd(&(bar)[XB_TMO], 1u); break; } } } } while (0)
struct XcdBarrier { unsigned* bar; unsigned x; volatile LAS unsigned* st; };
__device__ __forceinline__ XcdBarrier xcd_barrier_post(unsigned* bar, volatile LAS unsigned* st) {
    XcdBarrier b; b.bar = bar; b.x = xb_xcc_id(); b.st = st;
    if (threadIdx.x == 0) (void)xb_add(&bar[XB_XCNT(b.x)], 1u);
    return b;
}
__device__ __forceinline__ void xcd_barrier_complete(unsigned* bar, unsigned x, unsigned& nloc, unsigned& nx) {
    const unsigned G = gridDim.x * gridDim.y * gridDim.z;
    unsigned sum, cnt, mine, sp = 0u;
    for (;;) {
        sum = 0u; cnt = 0u; mine = 0u;
#pragma unroll
        for (unsigned j = 0; j < 16; ++j) { const unsigned c = xb_ld(&bar[XB_XCNT(j)]); sum += c; cnt += (c > 0u) ? 1u : 0u; mine = (j == x) ? c : mine; }
        if (sum == G) break;
        __builtin_amdgcn_s_sleep(1);
        if ((++sp & 255u) == 0u) { if (xb_ld(&bar[XB_TMO])) break; if (sp > XB_SPIN_CAP) { atomicAdd(&bar[XB_TMO], 1u); break; } }
    }
    nloc = mine > 0u ? mine : 1u; nx = cnt > 0u ? cnt : 1u;
}
__device__ __forceinline__ void xcd_barrier(const XcdBarrier& b) {
    asm volatile("s_waitcnt vmcnt(0)" ::: "memory");
    __syncthreads();
    if (threadIdx.x == 0) {
        unsigned* bar = b.bar;
        __builtin_amdgcn_s_waitcnt(0);
        unsigned nloc = b.st[0], nx = b.st[1];
        if (nloc == 0u) { xcd_barrier_complete(bar, b.x, nloc, nx); b.st[0] = nloc; b.st[1] = nx; }
        const unsigned old = xb_add(&bar[XB_XSUB(b.x)], 1u);
        const unsigned gen = old / nloc;
        if (old + 1u == (gen + 1u) * nloc) {
            __builtin_amdgcn_fence(__ATOMIC_RELEASE, "agent");
            asm volatile("s_waitcnt vmcnt(0)" ::: "memory");
            const unsigned og = xb_add(&bar[XB_TOP], 1u);
            const unsigned tg = og / nx;
            if (og + 1u == (tg + 1u) * nx) xb_add(&bar[XB_TOPGEN], 1u);
            else XB_SPIN(xb_ld(&bar[XB_TOPGEN]) == tg, bar);
            __builtin_amdgcn_fence(__ATOMIC_ACQUIRE, "agent");
            xb_add(&bar[XB_XGEN(b.x)], 1u);
            asm volatile("s_waitcnt vmcnt(0)" ::: "memory");
        } else {
            XB_SPIN(xb_ld(&bar[XB_XGEN(b.x)]) == gen, bar);
            __builtin_amdgcn_fence(__ATOMIC_ACQUIRE, "agent");
            asm volatile("s_waitcnt vmcnt(0)" ::: "memory");
        }
    }
    __syncthreads();
}

struct Args { const float* in[24]; float* out; unsigned char* ws; int ph_lo, ph_hi; };
enum { I_X = 0, I_RELB, I_N1G, I_WIN, I_AQG, I_AKG, I_BQG, I_BKG, I_SINK, I_CGW, I_CGB, I_CNG, I_WBA, I_WBB, I_WBC, I_WO, I_N2G, I_WRG, I_BRG, I_WRE, I_BRE, I_W1, I_W3, I_W2 };

struct Frame {
    LAS unsigned char* lds; LAS unsigned char* misc;
    unsigned* ctl;
    int tid, lane, wave, vcu, G, gw, NGW;
    const float* const* in; float* out; unsigned char* ws;
    bf16 *Z, *XN, *OCAT, *MERGED, *XS, *Y, *H;
    float *S, *GO; unsigned* MASK;
};

__device__ __forceinline__ float wave_sum(float v) {
#pragma unroll
    for (int o = 1; o < 64; o <<= 1) v += __shfl_xor(v, o);
    return v;
}
__device__ __forceinline__ float wave_max(float v) {
#pragma unroll
    for (int o = 1; o < 64; o <<= 1) v = fmaxf(v, __shfl_xor(v, o));
    return v;
}

template <class MAP>
__device__ __forceinline__ void transpose_item(const float* W, int N, bf16* WT, int dpitch, int koff, LAS float* scr, int item, int lane, const MAP& map, const float* kgain = nullptr) {
    const int nblk = N / 32, kb = item / nblk, nb = item % nblk, k0 = 64 * kb, n0 = 32 * nb;
    f32x4 v[8];
#pragma unroll
    for (int i = 0; i < 8; ++i) v[i] = *(const f32x4*)(W + (size_t)(k0 + 8 * i + (lane >> 3)) * N + n0 + 4 * (lane & 7));
    if (kgain) {
#pragma unroll
        for (int i = 0; i < 8; ++i) v[i] = v[i] * kgain[k0 + 8 * i + (lane >> 3)]; }
#pragma unroll
    for (int i = 0; i < 8; ++i) { LAS float* d = scr + (8 * i + (lane >> 3)) * 33 + 4 * (lane & 7); d[0] = v[i].x; d[1] = v[i].y; d[2] = v[i].z; d[3] = v[i].w; }
    LDS_WAIT(); asm volatile("" ::: "memory");
    const int c = lane & 7;
#pragma unroll
    for (int j = 0; j < 4; ++j) { const int n = (lane >> 3) + 8 * j; const LAS float* s = scr + (8 * c) * 33 + n;
        v4u o; o.x = pk2(s[0 * 33], s[1 * 33]); o.y = pk2(s[2 * 33], s[3 * 33]); o.z = pk2(s[4 * 33], s[5 * 33]); o.w = pk2(s[6 * 33], s[7 * 33]);
        const int dr_ = map(n0 + n); if (dr_ >= 0) *(v4u*)(WT + (size_t)dr_ * dpitch + koff + k0 + 8 * c) = o; }
    LDS_WAIT(); asm volatile("" ::: "memory");
}
__device__ __forceinline__ float clamp8(float v) { return fminf(fmaxf(v, -440.0f), 440.0f); }
template <class MAP>
__device__ __forceinline__ void transpose_item_fp8(const float* W, int N, unsigned char* WT, int dpitch, float scale, LAS float* scr, int item, int lane, const MAP& map) {
    const int nblk = N / 32, kb = item / nblk, nb = item % nblk, k0 = 64 * kb, n0 = 32 * nb;
    f32x4 v[8];
#pragma unroll
    for (int i = 0; i < 8; ++i) v[i] = *(const f32x4*)(W + (size_t)(k0 + 8 * i + (lane >> 3)) * N + n0 + 4 * (lane & 7));
#pragma unroll
    for (int i = 0; i < 8; ++i) { LAS float* d = scr + (8 * i + (lane >> 3)) * 33 + 4 * (lane & 7); d[0] = v[i].x; d[1] = v[i].y; d[2] = v[i].z; d[3] = v[i].w; }
    LDS_WAIT(); asm volatile("" ::: "memory");
    const int c = lane & 7;
#pragma unroll
    for (int j = 0; j < 4; ++j) { const int n = (lane >> 3) + 8 * j; const LAS float* s = scr + (8 * c) * 33 + n;
        int w0 = 0, w1 = 0;
        w0 = __builtin_amdgcn_cvt_pk_fp8_f32(clamp8(s[0 * 33] * scale), clamp8(s[1 * 33] * scale), w0, false); w0 = __builtin_amdgcn_cvt_pk_fp8_f32(clamp8(s[2 * 33] * scale), clamp8(s[3 * 33] * scale), w0, true);
        w1 = __builtin_amdgcn_cvt_pk_fp8_f32(clamp8(s[4 * 33] * scale), clamp8(s[5 * 33] * scale), w1, false); w1 = __builtin_amdgcn_cvt_pk_fp8_f32(clamp8(s[6 * 33] * scale), clamp8(s[7 * 33] * scale), w1, true);
        const int dr_ = map(n0 + n); if (dr_ >= 0) *(v2u*)(WT + (size_t)dr_ * dpitch + k0 + 8 * c) = (v2u){(unsigned)w0, (unsigned)w1}; }
    LDS_WAIT(); asm volatile("" ::: "memory");
}
struct MapId { int off; __device__ __forceinline__ int operator()(int n) const { return off + n; } };
struct MapWin {
    __device__ __forceinline__ int operator()(int n) const {
        if (n < 512) return ZC_AQ + n;
        if (n < 640) return ZC_AK + (n - 512);
        if (n < 768) return ZC_AV + (n - 640);
        if (n < 1792) return ZC_IQ + (n - 768);
        if (n < 1856) return ZC_IK + (n - 1792);
        if (n < 1872) return ZC_IW + (n - 1856);
        if (n < 2896) return ZC_BQ + (n - 1872);
        if (n < 3152) return ZC_BK + (n - 2896);
        if (n < 3408) return ZC_BV + (n - 3152);
        if (n < 3664) return ZC_CQ + (n - 3408);
        if (n < 3920) return ZC_CK + (n - 3664);
        if (n < 4432) return ZC_CV + (n - 3920);
        if (n < 4448) return ZC_CG + (n - 4432);
        if (n < 4960) return ZC_CR + (n - 4448);
        return pg8::ZC_GA + (n - 4960);
    }
};
struct MapWin8 { __device__ __forceinline__ int operator()(int n) const { const int z = MapWin{}(n); return z < 3328 ? z : (z >= 4096 ? z - 768 : -1); } };
struct MapWinB { __device__ __forceinline__ int operator()(int n) const { const int z = MapWin{}(n); return (z >= 3328 && z < 4096) ? z - 3328 : -1; } };
struct MapW13 { int sel; __device__ __forceinline__ int operator()(int n) const { return 32 * (n >> 4) + 16 * sel + (n & 15); } };

__device__ __forceinline__ void load_row(const float* row, int lane, f32x4 (&v)[8]) {
    const f32x4* xr = (const f32x4*)row + lane;
#pragma unroll
    for (int j = 0; j < 8; ++j) v[j] = xr[64 * j];
}
__device__ __forceinline__ float row_rstd(const f32x4 (&v)[8]) {
    float s = 0.f;
#pragma unroll
    for (int j = 0; j < 8; ++j) s += (v[j].x * v[j].x + v[j].y * v[j].y) + (v[j].z * v[j].z + v[j].w * v[j].w);
    return rsqrtf(wave_sum(s) * (1.0f / 2048.0f) + EPS);
}
__device__ __forceinline__ void norm_store_bf16(const f32x4 (&v)[8], float rstd, const float* g, bf16* orow, int lane) {
    const f32x4* gr = (const f32x4*)g + lane; unsigned long long* o8 = (unsigned long long*)orow + lane;
#pragma unroll
    for (int j = 0; j < 8; ++j) { const f32x4 gg = gr[64 * j];
        o8[64 * j] = (unsigned long long)pk2(v[j].x * rstd * gg.x, v[j].y * rstd * gg.y) | ((unsigned long long)pk2(v[j].z * rstd * gg.z, v[j].w * rstd * gg.w) << 32); }
}

__device__ __forceinline__ void norm_store_fp8(const f32x4 (&v)[8], float rstd, const float* g, unsigned char* orow, int lane) {
    const f32x4* gr = (const f32x4*)g + lane; unsigned* o4 = (unsigned*)orow + lane;
#pragma unroll
    for (int j = 0; j < 8; ++j) { const f32x4 gg = gr[64 * j]; int w = 0;
        w = __builtin_amdgcn_cvt_pk_fp8_f32(clamp8(v[j].x * rstd * gg.x), clamp8(v[j].y * rstd * gg.y), w, false); w = __builtin_amdgcn_cvt_pk_fp8_f32(clamp8(v[j].z * rstd * gg.z), clamp8(v[j].w * rstd * gg.w), w, true);
        o4[64 * j] = (unsigned)w; }
}
__device__ __forceinline__ void convert_moe(Frame& F, int l, int part, int nparts, int lds_off) {
    LAS float* scr = (LAS float*)(F.lds + lds_off + F.wave * 8704);
    bf16* W13 = (bf16*)(F.ws + WS_W13); bf16* W2 = (bf16*)(F.ws + WS_W2);
    constexpr int I13 = (2048 / 64) * (512 / 32);
    constexpr int I2 = (512 / 64) * (2048 / 32);
    constexpr int NIT = NEXP * (2 * I13 + I2);
    const int it_lo = (int)((long)NIT * part / nparts), it_hi = (int)((long)NIT * (part + 1) / nparts);
    for (int it = it_lo + F.gw; it < it_hi; it += F.NGW) {
        const int e = it / (2 * I13 + I2); int r = it % (2 * I13 + I2);
        if (r < I13) { transpose_item_fp8(F.in[I_W1] + ((size_t)l * NEXP + e) * 2048 * 512, 512, (unsigned char*)W13 + (size_t)e * 1024 * 2048, 2048, 64.0f, scr, r, F.lane, MapW13{0}); continue; } r -= I13;
        if (r < I13) { transpose_item_fp8(F.in[I_W3] + ((size_t)l * NEXP + e) * 2048 * 512, 512, (unsigned char*)W13 + (size_t)e * 1024 * 2048, 2048, 64.0f, scr, r, F.lane, MapW13{1}); continue; } r -= I13;
        transpose_item_fp8(F.in[I_W2] + ((size_t)l * NEXP + e) * 512 * 2048, 2048, (unsigned char*)W2 + (size_t)e * 2048 * 512, 512, 32.0f, scr, r, F.lane, MapId{0});
    }
}

typedef short bf16x8_t __attribute__((ext_vector_type(8)));
typedef float f32x16 __attribute__((ext_vector_type(16)));
typedef short s16x4 __attribute__((ext_vector_type(4)));
__device__ __forceinline__ void indexer_segment(Frame& F, int b, int qb, int tlo, int thi) {
    const int lane = F.lane, n = lane & 15, kq = lane >> 4;
    const bf16* qrow = F.Z + (size_t)(b * 2048 + 16 * qb + n) * ZP;
    bf16x8_t iqf[16][2];
#pragma unroll
    for (int h = 0; h < 16; ++h)
#pragma unroll
        for (int ks = 0; ks < 2; ++ks) iqf[h][ks] = *(const bf16x8_t*)(qrow + ZC_IQ + h * 64 + 32 * ks + 8 * kq);
    float wv[16];
    { const v4u w0 = *(const v4u*)(qrow + ZC_IW), w1 = *(const v4u*)(qrow + ZC_IW + 8);
      wv[0] = bflo(w0.x); wv[1] = bfhi(w0.x); wv[2] = bflo(w0.y); wv[3] = bfhi(w0.y); wv[4] = bflo(w0.z); wv[5] = bfhi(w0.z); wv[6] = bflo(w0.w); wv[7] = bfhi(w0.w);
      wv[8] = bflo(w1.x); wv[9] = bfhi(w1.x); wv[10] = bflo(w1.y); wv[11] = bfhi(w1.y); wv[12] = bflo(w1.z); wv[13] = bfhi(w1.z); wv[14] = bflo(w1.w); wv[15] = bfhi(w1.w); }
    const bf16* kbase = F.Z + (size_t)(b * 2048 + n) * ZP + ZC_IK + 8 * kq;
    float* srow = F.S + (size_t)(b * 2048 + 16 * qb + n) * 2048 + 4 * kq;
    bf16x8_t ka[3], kb[3];
#pragma unroll
    for (int u = 0; u < 3; ++u) { const int tt = tlo + u < thi ? tlo + u : thi - 1; ka[u] = *(const bf16x8_t*)(kbase + (size_t)(16 * tt) * ZP); kb[u] = *(const bf16x8_t*)(kbase + (size_t)(16 * tt) * ZP + 32); }
#pragma unroll 1
    for (int tile = tlo; tile < thi; tile += 3) {
#pragma unroll
        for (int u = 0; u < 3; ++u) {
            const int tt = tile + u;
            if (tt < thi) {
                f32x4 sc = (f32x4){0.f, 0.f, 0.f, 0.f};
#pragma unroll
                for (int h = 0; h < 16; ++h) {
                    f32x4 c = __builtin_amdgcn_mfma_f32_16x16x32_bf16(ka[u], iqf[h][0], (f32x4){0.f, 0.f, 0.f, 0.f}, 0, 0, 0);
                    c = __builtin_amdgcn_mfma_f32_16x16x32_bf16(kb[u], iqf[h][1], c, 0, 0, 0);
                    sc[0] += wv[h] * fmaxf(c[0], 0.f); sc[1] += wv[h] * fmaxf(c[1], 0.f); sc[2] += wv[h] * fmaxf(c[2], 0.f); sc[3] += wv[h] * fmaxf(c[3], 0.f);
                }
                *(f32x4*)(srow + 16 * tt) = sc * 0.03125f;
            }
            { const int tn = tt + 3 < thi ? tt + 3 : thi - 1; ka[u] = *(const bf16x8_t*)(kbase + (size_t)(16 * tn) * ZP); kb[u] = *(const bf16x8_t*)(kbase + (size_t)(16 * tn) * ZP + 32); }
        }
    }
}

constexpr int FA_KP = 272, FA_VP = 320;
constexpr int FA_KOFF = 0, FA_VOFF = 2 * 64 * FA_KP, FA_BYTES = FA_VOFF + 2 * 64 * FA_VP;
__device__ __forceinline__ s16x4 fa_vtr(const LAS unsigned char* p) { return __builtin_bit_cast(s16x4, __builtin_amdgcn_ds_read_tr16_b64_v4i16((LAS s16x4*)p)); }
template <int MODE>
__device__ __forceinline__ void flash_unit(Frame& F, int l, int b, int g, int t0) {
    const int tid = F.tid, lane = F.lane, wave = F.wave, hh = wave & 3, qh = wave >> 2, r = lane & 31, hf = lane >> 5;
    const int qcol = (MODE == 0 ? ZC_AQ : ZC_BQ + 512 * g) + 128 * hh, kcol = MODE == 0 ? ZC_AK : ZC_BK + 128 * g, vcol = MODE == 0 ? ZC_AV : ZC_BV + 128 * g;
    const int ocol = (MODE == 0 ? 0 : 512 + 512 * g) + 128 * hh, hd = (MODE == 0 ? 0 : 4 + 4 * g) + hh;
    const int tq = t0 + 32 * qh + r; const size_t qrow = (size_t)(b * 2048 + tq);
    const LAS float* tab2 = (const LAS float*)(F.misc + MO_TAB2) + hd * 129;
    LAS unsigned char* lds = F.lds;
    bf16x8_t qf[8];
#pragma unroll
    for (int ks = 0; ks < 8; ++ks) qf[ks] = *(const bf16x8_t*)(F.Z + qrow * ZP + qcol + 16 * ks + 8 * hf);
    f32x16 oacc[4];
#pragma unroll
    for (int dt = 0; dt < 4; ++dt)
#pragma unroll
        for (int i = 0; i < 16; ++i) oacc[dt][i] = 0.f;
    float m_run = -1e30f, l_run = 0.f;
    const int tile_lo = MODE == 0 ? 0 : (t0 >= 128 ? t0 / 64 - 2 : 0), tile_hi = t0 / 64 + 1;
    const int skey = tid >> 4, sdc = tid & 15;
    v4u kreg[2], vreg[2];
    { const bf16* zr = F.Z + (size_t)(b * 2048 + 64 * tile_lo + skey) * ZP;
#pragma unroll
      for (int i = 0; i < 2; ++i) { kreg[i] = *(const v4u*)(zr + (size_t)(32 * i) * ZP + kcol + 8 * sdc); vreg[i] = *(const v4u*)(zr + (size_t)(32 * i) * ZP + vcol + 8 * sdc); } }
    const float sc2 = 0.08838834764831845f * 1.4426950408889634f;
    unsigned mwn[2] = {0xffffffffu, 0xffffffffu};
    if (MODE == 0) { mwn[0] = F.MASK[qrow * 64 + 2 * tile_lo]; mwn[1] = F.MASK[qrow * 64 + 2 * tile_lo + 1]; }
#pragma unroll 1
    for (int kt = tile_lo; kt < tile_hi; ++kt) {
        const int bf = (kt - tile_lo) & 1, s0 = 64 * kt;
        LAS unsigned char* kb = lds + FA_KOFF + bf * (64 * FA_KP); LAS unsigned char* vb = lds + FA_VOFF + bf * (64 * FA_VP);
#pragma unroll
        for (int i = 0; i < 2; ++i) { *(LAS v4u*)(kb + (skey + 32 * i) * FA_KP + 16 * sdc) = kreg[i]; *(LAS v4u*)(vb + (skey + 32 * i) * FA_VP + 16 * sdc) = vreg[i]; }
        __syncthreads();
        if (kt + 1 < tile_hi) { const bf16* zr = F.Z + (size_t)(b * 2048 + 64 * (kt + 1) + skey) * ZP;
#pragma unroll
            for (int i = 0; i < 2; ++i) { kreg[i] = *(const v4u*)(zr + (size_t)(32 * i) * ZP + kcol + 8 * sdc); vreg[i] = *(const v4u*)(zr + (size_t)(32 * i) * ZP + vcol + 8 * sdc); } }
        unsigned mw[2] = {mwn[0], mwn[1]};
        if (MODE == 0 && kt + 1 < tile_hi) { mwn[0] = F.MASK[qrow * 64 + 2 * (kt + 1)]; mwn[1] = F.MASK[qrow * 64 + 2 * (kt + 1) + 1]; }
        f32x16 sacc[2];
#pragma unroll
        for (int k2 = 0; k2 < 2; ++k2) {
#pragma unroll
            for (int i = 0; i < 16; ++i) sacc[k2][i] = 0.f;
#pragma unroll
            for (int ks = 0; ks < 8; ++ks) { const bf16x8_t kf = *(const LAS bf16x8_t*)(kb + (32 * k2 + r) * FA_KP + (16 * ks + 8 * hf) * 2);
                sacc[k2] = __builtin_amdgcn_mfma_f32_32x32x16_bf16(kf, qf[ks], sacc[k2], 0, 0, 0); }
        }
        float mx = -1e30f;
        if (MODE == 0 && s0 + 63 + 128 <= t0) {
            const float bfar = tab2[128];
#pragma unroll
            for (int k2 = 0; k2 < 2; ++k2)
#pragma unroll
                for (int i = 0; i < 16; ++i) { const int cr = (i & 3) + 8 * (i >> 2) + 4 * hf;
                    const float v = ((mw[k2] >> cr) & 1u) ? sacc[k2][i] * sc2 + bfar : -__builtin_inff();
                    sacc[k2][i] = v; mx = fmaxf(mx, v); }
        } else
#pragma unroll
        for (int k2 = 0; k2 < 2; ++k2)
#pragma unroll
            for (int i = 0; i < 16; ++i) { const int cr = (i & 3) + 8 * (i >> 2) + 4 * hf; const int dist = tq - (s0 + 32 * k2 + cr);
                bool ok; if (MODE == 0) ok = (mw[k2] >> cr) & 1u; else ok = dist >= 0 && dist < 128;
                const int di = dist < 0 ? 0 : (dist > 128 ? 128 : dist);
                float vf = sacc[k2][i] * sc2 + tab2[di];
                asm volatile("" : "+v"(vf));
                const float v = ok ? vf : -__builtin_inff();
                sacc[k2][i] = v; mx = fmaxf(mx, v); }
        { const auto sw_ = __builtin_amdgcn_permlane32_swap(__float_as_uint(mx), __float_as_uint(mx), false, false); mx = fmaxf(__uint_as_float(sw_[0]), __uint_as_float(sw_[1])); }
        const float m_new = fmaxf(m_run, mx), alpha = __builtin_amdgcn_exp2f(m_run - m_new); m_run = m_new;
        float ps = 0.f;
#pragma unroll
        for (int k2 = 0; k2 < 2; ++k2)
#pragma unroll
            for (int i = 0; i < 16; ++i) { const float p = __builtin_amdgcn_exp2f(sacc[k2][i] - m_new); sacc[k2][i] = p; ps += p; }
        l_run = l_run * alpha + ps;
        if (__ballot(alpha != 1.0f)) {
#pragma unroll
        for (int dt = 0; dt < 4; ++dt)
#pragma unroll
            for (int i = 0; i < 16; ++i) oacc[dt][i] *= alpha;
        }
#pragma unroll
        for (int k2 = 0; k2 < 2; ++k2)
#pragma unroll
            for (int s2 = 0; s2 < 2; ++s2) {
                v4u pw; pw.x = pg8::cvt_pk_bf16(sacc[k2][8 * s2 + 0], sacc[k2][8 * s2 + 1]); pw.y = pg8::cvt_pk_bf16(sacc[k2][8 * s2 + 2], sacc[k2][8 * s2 + 3]);
                pw.z = pg8::cvt_pk_bf16(sacc[k2][8 * s2 + 4], sacc[k2][8 * s2 + 5]); pw.w = pg8::cvt_pk_bf16(sacc[k2][8 * s2 + 6], sacc[k2][8 * s2 + 7]);
                const bf16x8_t pb = __builtin_bit_cast(bf16x8_t, pw);
                const int i16 = lane & 15, grp = (lane >> 4) & 1;
                const LAS unsigned char* vp = vb + (32 * k2 + 16 * s2 + 4 * hf + (i16 >> 2)) * FA_VP + (16 * grp + 4 * (i16 & 3)) * 2;
#pragma unroll
                for (int dt = 0; dt < 4; ++dt) { const s16x4 lo = fa_vtr(vp + 64 * dt), hi = fa_vtr(vp + 8 * FA_VP + 64 * dt);
                    const bf16x8_t vf = __builtin_shufflevector(lo, hi, 0, 1, 2, 3, 4, 5, 6, 7);
                    oacc[dt] = __builtin_amdgcn_mfma_f32_32x32x16_bf16(vf, pb, oacc[dt], 0, 0, 0); }
            }
    }
    float l_tot = l_run + __shfl_xor(l_run, 32);
    if (MODE == 1) l_tot += __builtin_amdgcn_exp2f(F.in[I_SINK][l * 8 + hd - 4] * 1.4426950408889634f - m_run);
    const float inv = 1.0f / l_tot;
    bf16* orow = F.OCAT + qrow * 2048 + ocol + 4 * hf;
#pragma unroll
    for (int dt = 0; dt < 4; ++dt)
#pragma unroll
        for (int gq = 0; gq < 4; ++gq) { v2u w; w.x = pk2(oacc[dt][4 * gq] * inv, oacc[dt][4 * gq + 1] * inv); w.y = pk2(oacc[dt][4 * gq + 2] * inv, oacc[dt][4 * gq + 3] * inv);
            *(v2u*)(orow + 32 * dt + 8 * gq) = w; }
    __syncthreads();
}


#define GLA_GATE_PREFIX(LDS_TOT) \
        float la[8]; \
        _Pragma("unroll") for (int i = 0; i < 8; ++i) { const v4u c0 = rc0[i], c1 = rc1[i]; float x = gb; \
            x += bflo(c0.x) * gwv[0] + bfhi(c0.x) * gwv[1] + bflo(c0.y) * gwv[2] + bfhi(c0.y) * gwv[3] + bflo(c0.z) * gwv[4] + bfhi(c0.z) * gwv[5] + bflo(c0.w) * gwv[6] + bfhi(c0.w) * gwv[7]; \
            x += bflo(c1.x) * gwv[8] + bfhi(c1.x) * gwv[9] + bflo(c1.y) * gwv[10] + bfhi(c1.y) * gwv[11] + bflo(c1.z) * gwv[12] + bfhi(c1.z) * gwv[13] + bflo(c1.w) * gwv[14] + bfhi(c1.w) * gwv[15]; \
            la[i] = (fminf(x, 0.f) - __logf(1.0f + __expf(-fabsf(x)))) * 0.0625f; } \
        _Pragma("unroll") for (int i = 1; i < 8; ++i) la[i] += la[i - 1]; \
        ((LAS float*)(L + LDS_TOT))[cg * 64 + dk] = la[7];
#define GLA_OFFSETS(LDS_TOT) \
        float off = 0.f, tot = 0.f; \
        _Pragma("unroll") for (int g2 = 0; g2 < 8; ++g2) { const float tv = ((const LAS float*)(L + LDS_TOT))[g2 * 64 + dk]; tot += tv; off += g2 < cg ? tv : 0.f; }

__device__ __forceinline__ void gla_state_phase(Frame& F, int l) {
    const int tid = F.tid, lane = F.lane, wave = F.wave, r = lane & 31, hf = lane >> 5, i16 = lane & 15, grp = (lane >> 4) & 1;
    LAS unsigned char* L = F.lds;
    constexpr int KDT = 0, VT = 9216, TOT = 29696, RP = 144, VP = 320;
    const int dk = lane, cg = wave;
    float* GCS = (float*)(F.ws + WS_GCS); float* GDEC = (float*)(F.ws + WS_GDEC);
    v4u rc0[8], rc1[8], rv[2]; unsigned short rk[8];
#define GLS_LOAD(u_) do { const int bh_ = (u_) >> 5, n_ = (u_) & 31; const size_t r0_ = (size_t)((bh_ >> 2) * 2048 + 64 * n_); const int h_ = bh_ & 3; \
        _Pragma("unroll") for (int i = 0; i < 8; ++i) { const bf16* zr = F.Z + (r0_ + 8 * cg + i) * ZP; rc0[i] = *(const v4u*)(zr + ZC_CG); rc1[i] = *(const v4u*)(zr + ZC_CG + 8); rk[i] = zr[ZC_CK + h_ * 64 + dk]; } \
        _Pragma("unroll") for (int i = 0; i < 2; ++i) rv[i] = *(const v4u*)(F.Z + (r0_ + (tid >> 4) + 32 * i) * ZP + ZC_CV + h_ * 128 + 8 * (tid & 15)); } while (0)
    int u = F.vcu;
    if (u < 2048) GLS_LOAD(u);
    for (; u < 2048; u += F.G) {
        const int h = (u >> 5) & 3;
        float gwv[16];
#pragma unroll
        for (int q = 0; q < 16; ++q) gwv[q] = F.in[I_CGW][(size_t)l * 4096 + q * 256 + h * 64 + dk];
        const float gb = F.in[I_CGB][l * 256 + h * 64 + dk];
        GLA_GATE_PREFIX(TOT)
        float kv[8];
#pragma unroll
        for (int i = 0; i < 8; ++i) kv[i] = bf1(rk[i]);
#pragma unroll
        for (int i = 0; i < 2; ++i) *(LAS v4u*)(L + VT + ((tid >> 4) + 32 * i) * VP + 16 * (tid & 15)) = rv[i];
        __syncthreads();
        GLA_OFFSETS(TOT)
        { float kd[8];
#pragma unroll
          for (int i = 0; i < 8; ++i) kd[i] = kv[i] * __expf(tot - (off + la[i]));
          v4u w; w.x = pk2(kd[0], kd[1]); w.y = pk2(kd[2], kd[3]); w.z = pk2(kd[4], kd[5]); w.w = pk2(kd[6], kd[7]); *(LAS v4u*)(L + KDT + dk * RP + 16 * cg) = w; }
        if (cg == 0) GDEC[(size_t)u * 64 + dk] = __expf(tot);
        __syncthreads();
        if (u + F.G < 2048) GLS_LOAD(u + F.G);
        { const int dkt = wave >> 2, dvt = wave & 3;
          f32x16 cs;
#pragma unroll
          for (int i = 0; i < 16; ++i) cs[i] = 0.f;
#pragma unroll
          for (int ks = 0; ks < 4; ++ks) { const bf16x8_t a = *(const LAS bf16x8_t*)(L + KDT + (32 * dkt + r) * RP + (16 * ks + 8 * hf) * 2);
              const LAS unsigned char* vp = L + VT + (16 * ks + 8 * hf + (i16 >> 2)) * VP + (32 * dvt + 16 * grp + 4 * (i16 & 3)) * 2;
              const s16x4 lo = fa_vtr(vp), hi = fa_vtr(vp + 4 * VP);
              cs = __builtin_amdgcn_mfma_f32_32x32x16_bf16(a, __builtin_shufflevector(lo, hi, 0, 1, 2, 3, 4, 5, 6, 7), cs, 0, 0, 0); }
          float* gp = GCS + (size_t)u * 8192 + (size_t)(32 * dkt + 4 * hf) * 128 + 32 * dvt + r;
#pragma unroll
          for (int i = 0; i < 16; ++i) gp[((i & 3) + 8 * (i >> 2)) * 128] = cs[i]; }
        __syncthreads();
    }
#undef GLS_LOAD
}

__device__ __forceinline__ void gla_scan_phase(Frame& F) {
    float* GCS = (float*)(F.ws + WS_GCS); const float* GDEC = (const float*)(F.ws + WS_GDEC);
    for (int gt = F.gw * 64 + F.lane; gt < 64 * 2048; gt += F.NGW * 64) {
        const int bh = gt >> 11, e4 = gt & 2047, dk = e4 >> 5;
        f32x4* p = (f32x4*)(GCS + (size_t)bh * 32 * 8192) + e4; const float* dp = GDEC + (size_t)bh * 32 * 64 + dk;
        f32x4 st = (f32x4){0.f, 0.f, 0.f, 0.f};
#pragma unroll 1
        for (int n0 = 0; n0 < 32; n0 += 8) {
            f32x4 cs[8]; float dc[8];
#pragma unroll
            for (int j = 0; j < 8; ++j) { cs[j] = p[(size_t)(n0 + j) * 2048]; dc[j] = dp[(n0 + j) * 64]; }
#pragma unroll
            for (int j = 0; j < 8; ++j) { p[(size_t)(n0 + j) * 2048] = st; st = st * dc[j] + cs[j]; }
        }
    }
}

__device__ __forceinline__ void gla_out_phase(Frame& F, int l) {
    const int tid = F.tid, lane = F.lane, wave = F.wave, r = lane & 31, hf = lane >> 5, i16 = lane & 15, grp = (lane >> 4) & 1;
    LAS unsigned char* L = F.lds;
    constexpr int QG = 0, KG = 9216, VT = 18432, PT = 38912, TOT = 59392, OT = 61440, RP = 144, VP = 320, OP = 132;
    const int dk = lane, cg = wave;
    const float* GCS = (const float*)(F.ws + WS_GCS);
    v4u rc0[8], rc1[8], rv[2]; unsigned short rq[8], rk[8]; unsigned rg[8]; f32x4 rp[4];
#define GLO_LOAD(u_) do { const int bh_ = (u_) >> 5, n_ = (u_) & 31; const size_t r0_ = (size_t)((bh_ >> 2) * 2048 + 64 * n_); const int h_ = bh_ & 3; \
        _Pragma("unroll") for (int i = 0; i < 8; ++i) { const bf16* zr = F.Z + (r0_ + 8 * cg + i) * ZP; rc0[i] = *(const v4u*)(zr + ZC_CG); rc1[i] = *(const v4u*)(zr + ZC_CG + 8); rq[i] = zr[ZC_CQ + h_ * 64 + dk]; rk[i] = zr[ZC_CK + h_ * 64 + dk]; \
            rg[i] = *(const unsigned*)(zr + ZC_CR + h_ * 128 + 2 * lane); } \
        _Pragma("unroll") for (int i = 0; i < 2; ++i) rv[i] = *(const v4u*)(F.Z + (r0_ + (tid >> 4) + 32 * i) * ZP + ZC_CV + h_ * 128 + 8 * (tid & 15)); \
        _Pragma("unroll") for (int i = 0; i < 4; ++i) rp[i] = *(const f32x4*)(GCS + (size_t)(u_) * 8192 + (size_t)(tid >> 3) * 128 + 16 * (tid & 7) + 4 * i); } while (0)
    int u = F.vcu;
    if (u < 2048) GLO_LOAD(u);
    const float g0 = F.in[I_CNG][l * 128 + 2 * lane], g1 = F.in[I_CNG][l * 128 + 2 * lane + 1];
    for (; u < 2048; u += F.G) {
        const int bh = u >> 5, n = u & 31, h = bh & 3; const size_t row0 = (size_t)((bh >> 2) * 2048 + 64 * n);
        float gwv[16];
#pragma unroll
        for (int q = 0; q < 16; ++q) gwv[q] = F.in[I_CGW][(size_t)l * 4096 + q * 256 + h * 64 + dk];
        const float gb = F.in[I_CGB][l * 256 + h * 64 + dk];
        GLA_GATE_PREFIX(TOT)
        float qv[8], kv[8]; unsigned gr[8];
#pragma unroll
        for (int i = 0; i < 8; ++i) { qv[i] = bf1(rq[i]); kv[i] = bf1(rk[i]); gr[i] = rg[i]; }
#pragma unroll
        for (int i = 0; i < 2; ++i) *(LAS v4u*)(L + VT + ((tid >> 4) + 32 * i) * VP + 16 * (tid & 15)) = rv[i];
        { v4u w0, w1; w0.x = pk2(rp[0].x, rp[0].y); w0.y = pk2(rp[0].z, rp[0].w); w0.z = pk2(rp[1].x, rp[1].y); w0.w = pk2(rp[1].z, rp[1].w);
          w1.x = pk2(rp[2].x, rp[2].y); w1.y = pk2(rp[2].z, rp[2].w); w1.z = pk2(rp[3].x, rp[3].y); w1.w = pk2(rp[3].z, rp[3].w);
          *(LAS v4u*)(L + PT + (tid >> 3) * VP + 32 * (tid & 7)) = w0; *(LAS v4u*)(L + PT + (tid >> 3) * VP + 32 * (tid & 7) + 16) = w1; }
        __syncthreads();
        GLA_OFFSETS(TOT)
#pragma unroll
        for (int i = 0; i < 8; ++i) { const float bi = off + la[i];
            *(LAS bf16*)(L + QG + (8 * cg + i) * RP + 2 * dk) = (bf16)f2bf(qv[i] * 0.125f * __expf(bi));
            *(LAS bf16*)(L + KG + (8 * cg + i) * RP + 2 * dk) = (bf16)f2bf(kv[i] * __expf(-bi)); }
        __syncthreads();
        if (u + F.G < 2048) GLO_LOAD(u + F.G);
        { const int ct = wave >> 2, dvt = wave & 3;
          f32x16 o;
#pragma unroll
          for (int i = 0; i < 16; ++i) o[i] = 0.f;
#pragma unroll
          for (int st = 0; st < 2; ++st) if (st <= ct) {
              f32x16 at;
#pragma unroll
              for (int i = 0; i < 16; ++i) at[i] = 0.f;
#pragma unroll
              for (int ks = 0; ks < 4; ++ks) { const bf16x8_t a = *(const LAS bf16x8_t*)(L + KG + (32 * st + r) * RP + (16 * ks + 8 * hf) * 2), bq = *(const LAS bf16x8_t*)(L + QG + (32 * ct + r) * RP + (16 * ks + 8 * hf) * 2);
                  at = __builtin_amdgcn_mfma_f32_32x32x16_bf16(a, bq, at, 0, 0, 0); }
              if (st == ct) {
#pragma unroll
                  for (int i = 0; i < 16; ++i) { const int cr = (i & 3) + 8 * (i >> 2) + 4 * hf; at[i] = cr <= r ? at[i] : 0.f; } }
#pragma unroll
              for (int s2 = 0; s2 < 2; ++s2) {
                  v4u pw; pw.x = pg8::cvt_pk_bf16(at[8 * s2 + 0], at[8 * s2 + 1]); pw.y = pg8::cvt_pk_bf16(at[8 * s2 + 2], at[8 * s2 + 3]); pw.z = pg8::cvt_pk_bf16(at[8 * s2 + 4], at[8 * s2 + 5]); pw.w = pg8::cvt_pk_bf16(at[8 * s2 + 6], at[8 * s2 + 7]);
                  const LAS unsigned char* vp = L + VT + (32 * st + 16 * s2 + 4 * hf + (i16 >> 2)) * VP + (32 * dvt + 16 * grp + 4 * (i16 & 3)) * 2;
                  const s16x4 lo = fa_vtr(vp), hi = fa_vtr(vp + 8 * VP);
                  o = __builtin_amdgcn_mfma_f32_32x32x16_bf16(__builtin_bit_cast(bf16x8_t, pw), __builtin_shufflevector(lo, hi, 0, 1, 2, 3, 4, 5, 6, 7), o, 0, 0, 0);
              }
          }
#pragma unroll
          for (int ks = 0; ks < 4; ++ks) { const bf16x8_t a = *(const LAS bf16x8_t*)(L + QG + (32 * ct + r) * RP + (16 * ks + 8 * hf) * 2);
              const LAS unsigned char* pp = L + PT + (16 * ks + 8 * hf + (i16 >> 2)) * VP + (32 * dvt + 16 * grp + 4 * (i16 & 3)) * 2;
              const s16x4 lo = fa_vtr(pp), hi = fa_vtr(pp + 4 * VP);
              o = __builtin_amdgcn_mfma_f32_32x32x16_bf16(a, __builtin_shufflevector(lo, hi, 0, 1, 2, 3, 4, 5, 6, 7), o, 0, 0, 0); }
          LAS float* op = (LAS float*)(L + OT) + (32 * ct + 4 * hf) * OP + 32 * dvt + r;
#pragma unroll
          for (int i = 0; i < 16; ++i) op[((i & 3) + 8 * (i >> 2)) * OP] = o[i]; }
        __syncthreads();
        { float a[8], c[8], ss[8];
#pragma unroll
          for (int i = 0; i < 8; ++i) { const LAS float* orow = (const LAS float*)(L + OT) + (8 * wave + i) * OP + 2 * lane; a[i] = orow[0]; c[i] = orow[1]; ss[i] = a[i] * a[i] + c[i] * c[i]; }
#pragma unroll
          for (int o2 = 1; o2 < 64; o2 <<= 1) {
#pragma unroll
              for (int i = 0; i < 8; ++i) ss[i] += __shfl_xor(ss[i], o2); }
#pragma unroll
          for (int i = 0; i < 8; ++i) { const float rstd = rsqrtf(ss[i] * (1.0f / 128.0f) + EPS);
              *(unsigned*)(F.OCAT + (row0 + 8 * wave + i) * 2048 + 1536 + h * 128 + 2 * lane) = pk2(a[i] * rstd * g0 * bflo(gr[i]), c[i] * rstd * g1 * bfhi(gr[i])); } }
        __syncthreads();
    }
#undef GLO_LOAD
}
#undef GLA_GATE_PREFIX
#undef GLA_OFFSETS

__device__ __forceinline__ bool in_phase(int k, int lo, int hi) { asm volatile("" : "+s"(k)); return lo <= k && k < hi; }
#define IN(k) in_phase((k), lo, hi)
#define PHASE_LANE() do { int _tz = threadIdx.x; asm volatile("" : "+v"(_tz)); F.tid = _tz; F.lane = _tz & 63; } while (0)
#define SEAM(k) do { if (IN(k) && IN((k) + 1)) xcd_barrier(bar); } while (0)
template <int l>
__device__ __forceinline__ void layer_body(Frame& F, const XcdBarrier& bar, const int lo, const int hi) {
    constexpr int pb = 1 + 11 * l;
        if (IN(pb + 0)) {
            { pg8::Gemm g{(const bf16*)(F.ws + WS_HB), (const bf16*)(F.ws + WS_WIN + l * WIN_L + 24 * MiB), T, 768, D}; pg8::StaticOrder S; S.init(T, 768, D, F.G, (int)blockIdx.x);
              pg8::EpiInProj<1> E{F.Z, F.ws + WS_GT, (LAS unsigned long long*)(F.misc + MO_SS), (const LAS float*)(F.misc + MO_GN) + l * 512, (const float*)(F.ws + WS_RSTD1)};
              pg8::gemm_phase<pg8::EpiInProj<1>, pg8::StaticOrder, true, false>(F.lds, g, S, E); }
            { pg8::Gemm g{(const bf16*)(F.ws + WS_XN8), (const bf16*)(F.ws + WS_WIN + l * WIN_L), T, 10496, D / 2}; pg8::StaticOrder S; S.init(T, 10496, D / 2, F.G, ((int)blockIdx.x + F.G / 2) % F.G);
              pg8::EpiInProj<0> E{F.Z, F.ws + WS_GT, (LAS unsigned long long*)(F.misc + MO_SS), (const LAS float*)(F.misc + MO_GN) + l * 512, (const float*)(F.ws + WS_RSTD1)};
              pg8::gemm_phase<pg8::EpiInProj<0>, pg8::StaticOrder, true, true>(F.lds, g, S, E); }
        }
        SEAM(pb + 0);
        if (IN(pb + 1)) { PHASE_LANE();
            if (F.wave & 4) convert_moe(F, l, 0, 4, 40960);
            for (int it = F.gw; it < NB * 128; it += F.NGW) {
                const int b = it >> 7, j = it & 127;
                indexer_segment(F, b, j, 0, j < 64 ? j + 1 : 64);
                if (j < 64) indexer_segment(F, b, 127 - j, 64, 128 - j);
            }
            if (!(F.wave & 4)) convert_moe(F, l, 0, 4, 40960);
            PHASE_LANE();
            gla_state_phase(F, l);
        }
        SEAM(pb + 1);
        if (IN(pb + 2)) { PHASE_LANE();
            if (F.wave & 4) convert_moe(F, l, 1, 4, 0);
            for (int row = F.gw; row < T; row += F.NGW) {
                const int t = row & 2047;
                if (t < 256) { const int nb = t + 1 - 32 * F.lane; F.MASK[(size_t)row * 64 + F.lane] = nb >= 32 ? 0xffffffffu : (nb <= 0 ? 0u : ((1u << nb) - 1u)); continue; }
                float val[32];
#pragma unroll
                for (int j = 0; j < 32; ++j) { const int s_ = 64 * j + F.lane; val[j] = F.S[(size_t)row * 2048 + (s_ < t ? s_ : t)]; }
                float vmx = -3.0e38f, vmn = 3.0e38f;
#pragma unroll
                for (int j = 0; j < 32; ++j) { const bool ok = 64 * j + F.lane <= t; val[j] = ok ? val[j] : -3.0e38f; vmx = fmaxf(vmx, val[j]); vmn = fminf(vmn, ok ? val[j] : 3.0e38f); }
#pragma unroll
                for (int o = 1; o < 64; o <<= 1) { vmx = fmaxf(vmx, __shfl_xor(vmx, o)); vmn = fminf(vmn, __shfl_xor(vmn, o)); }
                float lo = vmn, hi = vmx, thf = 0.f; bool exact = false;
#pragma unroll 1
                for (int it = 0; it < 28; ++it) { const float mid = 0.5f * (lo + hi); if (!(mid > lo && mid < hi)) break; int cnt = 0;
#pragma unroll
                    for (int j = 0; j < 32; ++j) cnt += __popcll(__ballot(val[j] >= mid));
                    if (cnt == 256) { exact = true; thf = mid; break; }
                    if (cnt > 256) lo = mid; else hi = mid; }
                unsigned th = 0u; int need = 0;
#define KEYOF(x) ({ const unsigned u_ = __float_as_uint(x); (u_ & 0x80000000u) ? ~u_ : (u_ | 0x80000000u); })
                if (!exact) {
#pragma unroll 1
                    for (int bit = 31; bit >= 0; --bit) { const unsigned cand = th | (1u << bit); int cnt = 0;
#pragma unroll
                        for (int j = 0; j < 32; ++j) cnt += __popcll(__ballot(KEYOF(val[j]) >= cand));
                        if (cnt >= 256) th = cand; }
                    int cgt = 0;
#pragma unroll
                    for (int j = 0; j < 32; ++j) cgt += __popcll(__ballot(KEYOF(val[j]) > th));
                    need = 256 - cgt;
                }
                int run = 0; unsigned myword = 0u;
#pragma unroll
                for (int j = 0; j < 32; ++j) {
                    bool sel;
                    if (exact) sel = val[j] >= thf;
                    else { const unsigned kj = KEYOF(val[j]); const bool eq = kj == th; const unsigned long long eqm = __ballot(eq);
                        const int pre = run + __popcll(eqm & ((1ull << F.lane) - 1ull)); sel = (kj > th) || (eq && pre < need); run += __popcll(eqm); sel = sel && (64 * j + F.lane <= t); }
                    const unsigned long long sm = __ballot(sel);
                    if ((F.lane >> 1) == j) myword = (F.lane & 1) ? (unsigned)(sm >> 32) : (unsigned)sm;
                }
#undef KEYOF
                F.MASK[(size_t)row * 64 + F.lane] = myword;
            }
            if (!(F.wave & 4)) convert_moe(F, l, 1, 4, 0);
            gla_scan_phase(F);
        }
        SEAM(pb + 2);
        if (IN(pb + 3)) { PHASE_LANE();
            if (F.vcu & 1) { convert_moe(F, l, 1, 2, 0); __syncthreads(); PHASE_LANE(); }
            for (int u = F.vcu; u < NB * 16; u += F.G) { const int b = u >> 4, p = u & 15; flash_unit<0>(F, l, b, 0, 64 * (31 - p)); flash_unit<0>(F, l, b, 0, 64 * p); }
            for (int u = F.vcu; u < NB * 2 * 32; u += F.G) { const int b = u >> 6, g = (u >> 5) & 1, qb = u & 31; flash_unit<1>(F, l, b, g, 64 * qb); }
            gla_out_phase(F, l);
            if (!(F.vcu & 1)) { PHASE_LANE(); convert_moe(F, l, 1, 2, 0); }
        }
        SEAM(pb + 3);
        if (IN(pb + 4)) {
            pg8::Gemm g{F.OCAT, (const bf16*)(F.ws + WS_WBR + l * WBR_L), T, D, D}; pg8::MergeOrder S; S.init(T, D, D, F.G, (int)blockIdx.x);
#ifdef PROBE_MERGE
            { pg8::EpiMergeT<PROBE_MERGE> E{F.ws + WS_GT, (bf16*)(F.ws + WS_S)}; pg8::gemm_phase<pg8::EpiMergeT<PROBE_MERGE>, pg8::MergeOrder, true>(F.lds, g, S, E); }
#endif
            pg8::EpiMerge E{F.ws + WS_GT, F.MERGED};
            pg8::gemm_phase<pg8::EpiMerge, pg8::MergeOrder, true>(F.lds, g, S, E);
        }
        SEAM(pb + 4);
        if (IN(pb + 5)) {
            pg8::Gemm g{F.MERGED, (const bf16*)(F.ws + WS_WO + l * WO_L), T, D, D}; pg8::StaticOrder S; S.init(T, D, D, F.G, (int)blockIdx.x);
            pg8::EpiResid E{(bf16*)(F.ws + WS_HB), (unsigned char*)F.XN, F.in[I_N2G] + l * D, F.lds + 3 * pg8::HTB};
            pg8::gemm_phase<pg8::EpiResid, pg8::StaticOrder, true>(F.lds, g, S, E);
        }
        SEAM(pb + 5);
        if (IN(pb + 6)) { PHASE_LANE();
            unsigned* cnt = F.ctl + CW_CNT + 64 * l;
            const int lane = F.lane, fr = lane & 15, fq = lane >> 4;
            LAS float* LG = (LAS float*)(F.lds + F.wave * 8192);
            const bf16* wrh = (const bf16*)(F.ws + WS_WRH + l * WR_L) + (size_t)fr * 2048 + 8 * fq; const bf16* wrl = (const bf16*)(F.ws + WS_WRL + l * WR_L) + (size_t)fr * 2048 + 8 * fq;
            for (int tile = F.gw; tile < T / 16; tile += F.NGW) {
                const bf16* hrow = (const bf16*)(F.ws + WS_HB) + (size_t)(16 * tile + fr) * D + 8 * fq;
                f32x4 acc[6];
#pragma unroll
                for (int nt = 0; nt < 6; ++nt) acc[nt] = (f32x4){0.f, 0.f, 0.f, 0.f};
                float ss = 0.f;
#pragma unroll 2
                for (int ks = 0; ks < 64; ++ks) {
                    const v4u hw = *(const v4u*)(hrow + 32 * ks);
                    { const float a0 = bflo(hw.x), a1 = bfhi(hw.x), a2 = bflo(hw.y), a3 = bfhi(hw.y), a4 = bflo(hw.z), a5 = bfhi(hw.z), a6 = bflo(hw.w), a7 = bfhi(hw.w);
                      ss += (a0 * a0 + a1 * a1) + (a2 * a2 + a3 * a3) + (a4 * a4 + a5 * a5) + (a6 * a6 + a7 * a7); }
                    const bf16x8_t ah = __builtin_bit_cast(bf16x8_t, hw);
#pragma unroll
                    for (int nt = 0; nt < 6; ++nt) { const bf16x8_t bh = *(const bf16x8_t*)(wrh + (size_t)(16 * nt) * 2048 + 32 * ks), bl = *(const bf16x8_t*)(wrl + (size_t)(16 * nt) * 2048 + 32 * ks);
                        acc[nt] = __builtin_amdgcn_mfma_f32_16x16x32_bf16(ah, bh, acc[nt], 0, 0, 0);
                        acc[nt] = __builtin_amdgcn_mfma_f32_16x16x32_bf16(ah, bl, acc[nt], 0, 0, 0); }
                }
                ss += __shfl_xor(ss, 16); ss += __shfl_xor(ss, 32);
                if (fq == 0) { const float rs_ = rsqrtf(ss * (1.0f / 2048.0f) + EPS); LG[1600 + fr] = rs_; ((float*)(F.ws + WS_RSTD))[16 * tile + fr] = rs_; }
#pragma unroll
                for (int nt = 0; nt < 6; ++nt)
#pragma unroll
                    for (int i = 0; i < 4; ++i) LG[(4 * fq + i) * 100 + 16 * nt + fr] = acc[nt][i];
                LDS_WAIT(); asm volatile("" ::: "memory");
                if (lane < 16) {
                    const int row = 16 * tile + lane; const float rstd = LG[1600 + lane]; const LAS float* lr = LG + lane * 100;
                    float lg[8]; int grp = 0; float gmax = -3.0e38f;
#pragma unroll
                    for (int e = 0; e < 8; ++e) { lg[e] = lr[e] * rstd + F.in[I_BRG][l * 8 + e]; if (lg[e] > gmax) { gmax = lg[e]; grp = e; } }
                    float gden = 0.f;
#pragma unroll
                    for (int e = 0; e < 8; ++e) gden += __expf(lg[e] - gmax);
                    const float gwt = 1.0f / gden;
                    int i0 = 0, i1 = 0; float m0 = -3.0e38f, m1 = -3.0e38f;
#pragma unroll
                    for (int e = 0; e < 8; ++e) { const float v = lr[8 + grp * 8 + e] * rstd + F.in[I_BRE][l * 64 + grp * 8 + e];
                        if (v > m0) { m1 = m0; i1 = i0; m0 = v; i0 = e; } else if (v > m1) { m1 = v; i1 = e; } }
                    const float e1 = __expf(m1 - m0); const float p0 = 1.0f / (1.0f + e1), p1 = e1 / (1.0f + e1);
                    const int ex0 = grp * 8 + i0, ex1 = grp * 8 + i1;
                    const unsigned r0 = atomicAdd(&cnt[ex0], 1u), r1 = atomicAdd(&cnt[ex1], 1u);
                    unsigned* rec = (unsigned*)(F.ws + WS_ROUTE) + (size_t)row * 8;
                    rec[0] = (unsigned)ex0; rec[1] = r0; rec[2] = (unsigned)ex1; rec[3] = r1; rec[4] = __float_as_uint(gwt * p0); rec[5] = __float_as_uint(gwt * p1);
                    int* liste = (int*)(F.ws + WS_LISTE); liste[(size_t)ex0 * 32768 + r0] = row; liste[(size_t)ex1 * 32768 + r1] = row;
                }
                LDS_WAIT(); asm volatile("" ::: "memory");
            }
        }
        SEAM(pb + 6);
        if (IN(pb + 7) || IN(pb + 8) || IN(pb + 9) || IN(pb + 10)) { PHASE_LANE();
            if (F.tid == 0) { const unsigned* cnt = F.ctl + CW_CNT + 64 * l; LAS int* texp = (LAS int*)(F.misc + MO_TEXP); LAS int* pst = (LAS int*)(F.misc + MO_PST); int tb = 0;
                for (int e = 0; e < NEXP; ++e) { const int c = (int)__hip_atomic_load(&cnt[e], __ATOMIC_RELAXED, __HIP_MEMORY_SCOPE_AGENT); const int nt_ = (c + 255) >> 8; pst[e] = tb * 256; ((LAS int*)(F.misc + MO_CNT))[e] = c;
                    for (int r = 0; r < nt_; ++r) texp[tb + r] = e; tb += nt_; }
                *(LAS int*)(F.misc + MO_TOT) = tb; }
            __syncthreads();
        }
        if (IN(pb + 8)) {
            pg8::Gemm g{F.XN, (const bf16*)(F.ws + WS_W13), 0, 0, D / 2};
            pg8::MoeGatherOrder S; S.total = *(const LAS int*)(F.misc + MO_TOT) * 4; S.G = F.G; S.c = F.vcu; S.NJ = 4; S.nt0 = D / 128; S.tile_exp = (const LAS int*)(F.misc + MO_TEXP);
            S.pst = (const LAS int*)(F.misc + MO_PST); S.cnt = (const LAS int*)(F.misc + MO_CNT); S.liste = (const int*)(F.ws + WS_LISTE);
            pg8::EpiGlu E{F.H, S.tile_exp, S.pst, S.cnt, S.liste, (const float*)(F.ws + WS_RSTD)};
            pg8::gemm_phase<pg8::EpiGlu, pg8::MoeGatherOrder, true, true>(F.lds, g, S, E);
        }
        SEAM(pb + 8);
        if (IN(pb + 9)) {
            pg8::Gemm g{F.H, (const bf16*)(F.ws + WS_W2), 0, 0, DEXP / 2};
            pg8::MoeOrder S{*(const LAS int*)(F.misc + MO_TOT) * 8, F.G, F.vcu, 8, DEXP / 128, (const LAS int*)(F.misc + MO_TEXP)};
            pg8::EpiY E{(unsigned char*)F.Y};
            pg8::gemm_phase<pg8::EpiY, pg8::MoeOrder, true, true>(F.lds, g, S, E);
        }
        SEAM(pb + 9);
        if (IN(pb + 10)) { PHASE_LANE();
            for (int row = F.gw; row < T; row += F.NGW) {
                const unsigned* rec = (const unsigned*)(F.ws + WS_ROUTE) + (size_t)row * 8;
                const float w0 = __uint_as_float(rec[4]) * 0.03125f, w1 = __uint_as_float(rec[5]) * 0.03125f;
                const LAS int* pst = (const LAS int*)(F.misc + MO_PST); const int p0 = pst[rec[0]] + (int)rec[1], p1 = pst[rec[2]] + (int)rec[3];
                const unsigned* y0 = (const unsigned*)((const unsigned char*)F.Y + (size_t)p0 * D) + F.lane; const unsigned* y1 = (const unsigned*)((const unsigned char*)F.Y + (size_t)p1 * D) + F.lane;
                f32x4 v[8];
                { const v2u* hr = (const v2u*)((const bf16*)(F.ws + WS_HB) + (size_t)row * D) + F.lane;
#pragma unroll
                  for (int j = 0; j < 8; ++j) { const v2u w = hr[64 * j]; v[j] = (f32x4){bflo(w.x), bfhi(w.x), bflo(w.y), bfhi(w.y)}; } }
#pragma unroll
                for (int j = 0; j < 8; ++j) { const int a = (int)y0[64 * j], c = (int)y1[64 * j];
                    const auto a01 = __builtin_amdgcn_cvt_pk_f32_fp8(a, false), a23 = __builtin_amdgcn_cvt_pk_f32_fp8(a, true), c01 = __builtin_amdgcn_cvt_pk_f32_fp8(c, false), c23 = __builtin_amdgcn_cvt_pk_f32_fp8(c, true);
                    v[j].x += w0 * a01[0] + w1 * c01[0]; v[j].y += w0 * a01[1] + w1 * c01[1]; v[j].z += w0 * a23[0] + w1 * c23[0]; v[j].w += w0 * a23[1] + w1 * c23[1]; }
                if (l + 1 < DEPTH) { v2u* hw_ = (v2u*)((bf16*)(F.ws + WS_HB) + (size_t)row * D) + F.lane;
#pragma unroll
                    for (int j = 0; j < 8; ++j) hw_[64 * j] = (v2u){pg8::cvt_pk_bf16(v[j].x, v[j].y), pg8::cvt_pk_bf16(v[j].z, v[j].w)}; }
                else { f32x4* orow = (f32x4*)(F.out + (size_t)row * D) + F.lane;
#pragma unroll
                    for (int j = 0; j < 8; ++j) orow[64 * j] = v[j]; }
                if (l + 1 < DEPTH) { const float rstd = row_rstd(v); if (F.lane == 0) ((float*)(F.ws + WS_RSTD1))[row] = rstd; norm_store_fp8(v, rstd, F.in[I_N1G] + (l + 1) * D, (unsigned char*)(F.ws + WS_XN8) + (size_t)row * D, F.lane); }
            }
        }
        SEAM(pb + 10);
    }
__global__ void __launch_bounds__(NWAVES * 64, 2) fwd_kernel(Args args) {
    extern __shared__ __attribute__((aligned(16))) unsigned char lds_raw[];
    Frame F;
    F.lds = (LAS unsigned char*)lds_raw; F.misc = F.lds + MISC_OFF;
    F.tid = threadIdx.x; F.lane = F.tid & 63; F.wave = __builtin_amdgcn_readfirstlane(F.tid >> 6);
    F.G = gridDim.x; { const int bx = blockIdx.x; F.vcu = (F.G % 8 == 0) ? (bx % 8) * (F.G / 8) + bx / 8 : bx; }
    F.gw = F.vcu * NWAVES + F.wave; F.NGW = F.G * NWAVES;
    F.in = args.in; F.out = args.out; F.ws = args.ws; F.ctl = (unsigned*)(args.ws + WS_CTL);
    F.Z = (bf16*)(args.ws + WS_Z); F.XN = (bf16*)(args.ws + WS_XN); F.OCAT = (bf16*)(args.ws + WS_OCAT); F.MERGED = (bf16*)(args.ws + WS_MERGED);
    F.XS = (bf16*)(args.ws + WS_XS); F.Y = (bf16*)(args.ws + WS_Y); F.H = (bf16*)(args.ws + WS_H);
    F.S = (float*)(args.ws + WS_S); F.GO = (float*)(args.ws + WS_GO); F.MASK = (unsigned*)(args.ws + WS_MASK);
    const int lo = args.ph_lo, hi = args.ph_hi;
    const bool use_bar = (hi - lo) > 1;
    for (int u = F.tid; u < 64; u += NWAVES * 64) ((LAS unsigned*)F.misc)[u] = 0u;
    ((LAS unsigned long long*)(F.misc + MO_SS))[F.tid] = 0ull;
    for (int i = F.tid; i < 2 * 4 * 128; i += NWAVES * 64) { const int l_ = i >> 9, k_ = (i >> 7) & 3, d_ = i & 127; ((LAS float*)(F.misc + MO_GN))[i] = F.in[k_ == 0 ? I_AQG : (k_ == 1 ? I_AKG : (k_ == 2 ? I_BQG : I_BKG))][l_ * 128 + d_]; }
    for (int i = F.tid; i < 12 * 129; i += NWAVES * 64) { const int hd = i / 129, dd = i % 129; int bk;
        if (dd < 16) bk = dd; else { bk = 16 + (int)(logf((float)dd / 16.0f) / 2.0794415416798357f * 16.0f); bk = bk > 31 ? 31 : bk; }
        ((LAS float*)(F.misc + MO_TAB2))[i] = F.in[I_RELB][bk * 12 + hd] * 1.4426950408889634f; }
    __syncthreads();
    XcdBarrier bar; bar.bar = F.ctl + CW_BAR; bar.x = 0; bar.st = nullptr;
    if (use_bar) bar = xcd_barrier_post(F.ctl + CW_BAR, (volatile LAS unsigned*)(F.misc + MO_BARW));

    if (IN(0)) { PHASE_LANE();
        LAS float* scr = (LAS float*)(F.lds + F.wave * 16384);
        constexpr int I_IN = (2048 / 64) * (D_IN / 32);
        constexpr int I_BA = (512 / 64) * (2048 / 32), I_BB = (1024 / 64) * (2048 / 32), I_BC = I_BA, I_O = (2048 / 64) * (2048 / 32);
        constexpr int PER_L = I_IN + I_BA + I_BB + I_BC + I_O;
        for (int it = F.gw; it < DEPTH * PER_L; it += F.NGW) {
            const int l = it / PER_L; int r = it % PER_L;
            bf16* win = (bf16*)(F.ws + WS_WIN + l * WIN_L); bf16* wbr = (bf16*)(F.ws + WS_WBR + l * WBR_L); bf16* wo = (bf16*)(F.ws + WS_WO + l * WO_L);
            if (r < I_IN) { const int nb_ = r % (D_IN / 32);
                const bool has8 = nb_ < 56 || (nb_ >= 58 && nb_ <= 106) || nb_ >= 122, hasb = (nb_ >= 56 && nb_ <= 58) || (nb_ >= 106 && nb_ <= 122) || nb_ == 138;
                if (has8) transpose_item_fp8(F.in[I_WIN] + (size_t)l * 2048 * D_IN, D_IN, (unsigned char*)win, 2048, 64.0f, scr, r, F.lane, MapWin8{});
                if (hasb) transpose_item(F.in[I_WIN] + (size_t)l * 2048 * D_IN, D_IN, win + (size_t)12 * 1024 * 1024, 2048, 0, scr, r, F.lane, MapWinB{}, F.in[I_N1G] + l * D);
                continue; } r -= I_IN;
            if (r < I_BA) { transpose_item(F.in[I_WBA] + (size_t)l * 512 * 2048, 2048, wbr, 2048, 0, scr, r, F.lane, MapId{0}); continue; } r -= I_BA;
            if (r < I_BB) { transpose_item(F.in[I_WBB] + (size_t)l * 1024 * 2048, 2048, wbr, 2048, 512, scr, r, F.lane, MapId{0}); continue; } r -= I_BB;
            if (r < I_BC) { transpose_item(F.in[I_WBC] + (size_t)l * 512 * 2048, 2048, wbr, 2048, 1536, scr, r, F.lane, MapId{0}); continue; } r -= I_BC;
            transpose_item(F.in[I_WO] + (size_t)l * 2048 * 2048, 2048, wo, 2048, 0, scr, r, F.lane, MapId{0});
        }
        for (int i = F.gw * 64 + F.lane; i < DEPTH * 160 * 256; i += F.NGW * 64) { const int l = i / (160 * 256), r = (i / 256) % 160, c = i % 256;
            *(v4u*)((bf16*)(F.ws + WS_WIN + l * WIN_L) + (size_t)12 * 1024 * 1024 + (size_t)(ZC_PAD - 3328 + r) * 2048 + 8 * c) = (v4u){0u, 0u, 0u, 0u}; }
        for (int i = F.gw * 64 + F.lane; i < DEPTH * 96 * 2048; i += F.NGW * 64) { const int l = i / (96 * 2048), e = (i / 2048) % 96, k = i % 2048;
            float val = 0.f; if (e < 8) val = F.in[I_WRG][(size_t)l * D * 8 + (size_t)k * 8 + e]; else if (e < 72) val = F.in[I_WRE][(size_t)l * D * 64 + (size_t)k * 64 + (e - 8)];
            val *= F.in[I_N2G][l * D + k];
            const unsigned hi = f2bf(val); const float rem = val - bf1((bf16)hi);
            ((bf16*)(F.ws + WS_WRH + l * WR_L))[e * 2048 + k] = (bf16)hi; ((bf16*)(F.ws + WS_WRL + l * WR_L))[e * 2048 + k] = (bf16)f2bf(rem); }
        for (int mrow = F.gw; mrow < T; mrow += F.NGW) { f32x4 v[8]; load_row(F.in[I_X] + (size_t)mrow * D, F.lane, v); const float rstd = row_rstd(v);
            { v2u* hw_ = (v2u*)((bf16*)(F.ws + WS_HB) + (size_t)mrow * D) + F.lane;
#pragma unroll
              for (int j = 0; j < 8; ++j) hw_[64 * j] = (v2u){pg8::cvt_pk_bf16(v[j].x, v[j].y), pg8::cvt_pk_bf16(v[j].z, v[j].w)}; }
            if (F.lane == 0) ((float*)(F.ws + WS_RSTD1))[mrow] = rstd;
            norm_store_fp8(v, rstd, F.in[I_N1G], (unsigned char*)(F.ws + WS_XN8) + (size_t)mrow * D, F.lane); }
    }
    SEAM(0);

    layer_body<0>(F, bar, lo, hi);
    layer_body<1>(F, bar, lo, hi);
}


#ifndef N_LAUNCH_MODE
#define N_LAUNCH_MODE 1
#endif
extern "C" void kernel_launch(void* const* d_in, const int* in_sizes, int n_in, void* d_out, int out_size, void* d_ws, size_t ws_size, hipStream_t stream) {
    static int grid = 0;
    if (grid == 0) {
        if (n_in != 24 || out_size != T * D || ws_size < WS_END) { fprintf(stderr, "kernel_launch: unexpected shapes (n_in %d out %d ws %zu)\n", n_in, out_size, ws_size); grid = -1; return; }
        int dev = 0, cus = 0, per_cu = 0;
        if (hipGetDevice(&dev) != hipSuccess || hipDeviceGetAttribute(&cus, hipDeviceAttributeMultiprocessorCount, dev) != hipSuccess) { grid = -1; return; }
        if (hipFuncSetAttribute((const void*)fwd_kernel, hipFuncAttributeMaxDynamicSharedMemorySize, LDS_BYTES) != hipSuccess) { fprintf(stderr, "kernel_launch: hipFuncSetAttribute failed\n"); grid = -1; return; }
        if (hipOccupancyMaxActiveBlocksPerMultiprocessor(&per_cu, (const void*)fwd_kernel, NWAVES * 64, LDS_BYTES) != hipSuccess || per_cu < 1) { fprintf(stderr, "kernel_launch: occupancy query says %d\n", per_cu); }
        (void)hipGetLastError();
        grid = cus;
    }
    if (grid < 0) return;
    (void)hipMemsetAsync((char*)d_ws + WS_CTL, 0, CTL_ZERO_BYTES, stream);
    Args a{};
    for (int i = 0; i < 24; ++i) a.in[i] = (const float*)d_in[i];
    a.out = (float*)d_out; a.ws = (unsigned char*)d_ws;
    constexpr int NPH = 1 + 11 * DEPTH;
#if N_LAUNCH_MODE == 1
    a.ph_lo = 0; a.ph_hi = NPH;
    hipLaunchKernelGGL(fwd_kernel, dim3(grid), dim3(NWAVES * 64), LDS_BYTES, stream, a);
#else
    for (int p = 0; p < NPH; ++p) { a.ph_lo = p; a.ph_hi = p + 1; hipLaunchKernelGGL(fwd_kernel, dim3(grid), dim3(NWAVES * 64), LDS_BYTES, stream, a); }
#endif
    const hipError_t le = hipPeekAtLastError();
    if (le != hipSuccess) fprintf(stderr, "kernel_launch: launch failed: %s\n", hipGetErrorName(le));
}
```

```cpp
#include <hip/hip_runtime.h>
#include <cstdio>
#include <cstdint>

__device__ __forceinline__ int lane_id() { return (int)__builtin_amdgcn_mbcnt_hi(~0u, __builtin_amdgcn_mbcnt_lo(~0u, 0u)); }
namespace pg8 {
#define PG8_LAS __attribute__((address_space(3)))
typedef unsigned short bf16_t;
typedef short bf16x8 __attribute__((ext_vector_type(8)));
typedef float f32x4 __attribute__((ext_vector_type(4)));
typedef unsigned u32x4 __attribute__((ext_vector_type(4)));
typedef unsigned u32x2 __attribute__((ext_vector_type(2)));
constexpr int BM = 256, BK = 64, HALF = 128, HTB = HALF * BK * 2  , STAGE_BYTES = 8 * HTB, NXCD = 8, WGM = 8;

__host__ __device__ __forceinline__ int lds_byte(int r, int c) { const int st = (r >> 4) * 2 + (c >> 5), rr = r & 15, cc = c & 31, ob = rr * 64 + cc * 2; return st * 1024 + (ob ^ (((ob >> 9) & 1) << 5)); }
__host__ __device__ __forceinline__ void stage_rc(int b, int& R, int& C) { const int st = b / 1024, sb = b % 1024, swz = sb ^ (((sb >> 9) & 1) << 5); R = (st >> 1) * 16 + swz / 64; C = (st & 1) * 32 + (swz % 64) / 2; }
__host__ __device__ __forceinline__ int perm32(int rho) { const int n = rho >> 4, i = rho & 15; return 8 * (i >> 2) + 4 * n + (i & 3); }

struct Unit { int pm, pn, koff, nt, seg; };
struct Gemm { const bf16_t* A; const bf16_t* Bt; int M, N, K; };

struct StaticOrder {
    static constexpr bool GATHER = false;
    int nM, nN, nwg, G, c, nt0;
    __device__ __forceinline__ int row_token(const Unit&, int) const { return 0; }
    __device__ void init(int M, int N, int K, int G_, int c_) { nM = M / BM; nN = N / BM; nwg = nM * nN; G = G_; c = c_; nt0 = K / BK; }
    __device__ bool tile(long L, Unit& u) const {
        if (L >= nwg) return false;
        int wgid = (int)L; { const int q = nwg / NXCD, r = nwg % NXCD, xcd = wgid % NXCD, off = wgid / NXCD; wgid = (xcd < r ? xcd * (q + 1) : r * (q + 1) + (xcd - r) * q) + off; }
        const int nig = WGM * nN, gid = wgid / nig, fm = gid * WGM, gsz = (nM - fm) < WGM ? (nM - fm) : WGM;
        u.pm = fm + ((wgid % nig) % gsz); u.pn = (wgid % nig) / gsz; return true;
    }
    __device__ bool next(int i, Unit& u) const { u.koff = 0; u.nt = nt0; u.seg = 0; return tile((long)i * G + c, u); }
    __device__ __forceinline__ void a_ready(const Unit&) const {}
    __device__ __forceinline__ void done(const Unit&) const {}
};
struct MergeOrder : StaticOrder {
    __device__ bool next(int i, Unit& u) const { const int rnd = i / 3, sg = i - 3 * rnd; u.seg = sg; u.koff = sg == 0 ? 0 : (sg == 1 ? 512 : 1536); u.nt = sg == 1 ? 16 : 8; return tile((long)rnd * G + c, u); }
};
struct MoeOrder {
    static constexpr bool GATHER = false;
    int total, G, c, NJ, nt0; const PG8_LAS int* tile_exp;
    __device__ bool next(int i, Unit& u) const {
        const long L = (long)i * G + c; if (L >= total) return false;
        const int R = (int)L / NJ, j = (int)L % NJ; u.pm = R; u.pn = tile_exp[R] * NJ + j; u.koff = 0; u.nt = nt0; u.seg = 0; return true;
    }
    __device__ __forceinline__ int row_token(const Unit&, int) const { return 0; }
    __device__ __forceinline__ void a_ready(const Unit&) const {}
    __device__ __forceinline__ void done(const Unit&) const {}
};
struct MoeGatherOrder : MoeOrder {
    static constexpr bool GATHER = true;
    const PG8_LAS int* pst; const PG8_LAS int* cnt; const int* liste;
    __device__ __forceinline__ int row_token(const Unit& u, int r) const {
        const int e = tile_exp[u.pm], lr = u.pm * 256 - pst[e] + r;
        return lr < cnt[e] ? liste[(size_t)e * 32768 + lr] : 0;
    }
};

typedef __bf16 bf16x2v __attribute__((ext_vector_type(2)));
typedef float f32x2v __attribute__((ext_vector_type(2)));
__device__ __forceinline__ unsigned cvt_pk_bf16(float lo, float hi) { const f32x2v v = {lo, hi}; const bf16x2v b = __builtin_convertvector(v, bf16x2v); return __builtin_bit_cast(unsigned, b); }
__device__ __forceinline__ float bflo(unsigned w) { return __uint_as_float(w << 16); }
__device__ __forceinline__ float bfhi(unsigned w) { return __uint_as_float(w & 0xffff0000u); }
__device__ __forceinline__ float sigm(float v) { return __builtin_amdgcn_rcpf(1.0f + __builtin_amdgcn_exp2f(-1.44269504f * v)); }
__device__ __forceinline__ unsigned q8x4(const f32x4 s) {
    const unsigned a = (unsigned)fminf(s[0], 255.5f), b = (unsigned)fminf(s[1], 255.5f), c = (unsigned)fminf(s[2], 255.5f), d = (unsigned)fminf(s[3], 255.5f);
    return a | (b << 8) | (c << 16) | (d << 24);
}

constexpr int ZP = 5120;
constexpr int ZC_GA = 5120, ZC_GB = 7168, ZC_GC = 9216;
constexpr size_t GT_TILE = 65536, GT_GATE = (size_t)128 * 8 * GT_TILE;

template <int PN_OFF> struct EpiInProj {
    static constexpr bool PERM = true, AFTER_DRAIN = false, CHAIN = false;
    bf16_t* O; unsigned char* GT; PG8_LAS unsigned long long* ss;
    const PG8_LAS float* gains;
    const float* rstd;
    __device__ __forceinline__ void operator()(const f32x4 (&acc)[2][2][4][2], const Unit& u, int wr, int wc, int fr, int fq) const {
        const int pn = PN_OFF ? u.pn + 13 : (u.pn < 13 ? u.pn : u.pn + 3);
        int row0 = u.pm * BM + wr * 64 + fr, col0 = pn * BM + wc * 32 + 8 * fq;
        asm volatile("" : "+v"(row0), "+v"(col0));
        const int act = pn >= 20 ? 2 : (pn >= 18 ? 1 : 0);
        const bool hn = PN_OFF == 0 && pn <= 7;
        f32x4 gn0 = (f32x4){1.f, 1.f, 1.f, 1.f}, gn1 = gn0; int lr = 0;
        if (hn) {
            lr = wr * 64 + fr; asm volatile("" : "+v"(lr));
#pragma unroll
            for (int ai = 0; ai < 2; ++ai)
#pragma unroll
                for (int m = 0; m < 4; ++m)
#pragma unroll
                    for (int bj = 0; bj < 2; ++bj) { const f32x4 a = acc[ai][bj][m][0], b = acc[ai][bj][m][1];
                        float s = (a[0] * a[0] + a[1] * a[1]) + (a[2] * a[2] + a[3] * a[3]) + (b[0] * b[0] + b[1] * b[1]) + (b[2] * b[2] + b[3] * b[3]);
                        s += __shfl_xor(s, 16); s += __shfl_xor(s, 32);
                        if (fq == 0) __hip_atomic_fetch_add(ss + (ai * HALF + m * 16 + lr) * 2 + bj, (unsigned long long)(s * 1048576.0f), __ATOMIC_RELAXED, __HIP_MEMORY_SCOPE_WORKGROUP); }
            asm volatile("s_waitcnt lgkmcnt(0)" ::: "memory"); __builtin_amdgcn_s_barrier(); asm volatile("" ::: "memory");
            const PG8_LAS float* gp = gains + (pn <= 1 ? 0 : (pn == 2 ? 128 : (pn <= 6 ? 256 : 384))) + wc * 32 + 8 * fq;
            gn0 = *(const PG8_LAS f32x4*)gp; gn1 = *(const PG8_LAS f32x4*)(gp + 4);
        }
        if (act == 2) {
            int lo16 = (wr * 4 + wc) * 8192 + (fq * 16 + fr) * 16; asm volatile("" : "+v"(lo16));
            unsigned char* gp = GT + (size_t)((pn - 20) >> 3) * GT_GATE + ((size_t)u.pm * 8 + ((pn - 20) & 7)) * GT_TILE + lo16;
#pragma unroll
            for (int ai = 0; ai < 2; ++ai)
#pragma unroll
                for (int m = 0; m < 4; ++m) { u32x4 w;
#pragma unroll
                    for (int bj = 0; bj < 2; ++bj) { const f32x4 v0 = acc[ai][bj][m][0] * (-1.44269504f * 0.015625f), v1 = acc[ai][bj][m][1] * (-1.44269504f * 0.015625f); f32x4 s0, s1;
#pragma unroll
                        for (int j = 0; j < 4; ++j) { s0[j] = __builtin_amdgcn_exp2f(v0[j]); s1[j] = __builtin_amdgcn_exp2f(v1[j]); }
                        s0 = s0 * 0.00390625f + 0.00390625f; s1 = s1 * 0.00390625f + 0.00390625f;
#pragma unroll
                        for (int j = 0; j < 4; ++j) { s0[j] = __builtin_amdgcn_rcpf(s0[j]); s1[j] = __builtin_amdgcn_rcpf(s1[j]); }
                        w[2 * bj] = q8x4(s0); w[2 * bj + 1] = q8x4(s1); }
                    *(u32x4*)(gp + (ai * 4 + m) * 1024) = w; }
            return;
        }
#pragma unroll
        for (int ai = 0; ai < 2; ++ai)
#pragma unroll
            for (int m = 0; m < 4; ++m) { bf16_t* rowp = O + (size_t)(row0 + ai * HALF + m * 16) * ZP + col0; const float rs = PN_OFF ? rstd[row0 + ai * HALF + m * 16] : 1.0f;
#pragma unroll
                for (int bj = 0; bj < 2; ++bj) { f32x4 v0 = acc[ai][bj][m][0], v1 = acc[ai][bj][m][1];
                    if (hn && !(pn == 2 && bj == 1)) { const float r = rsqrtf((float)ss[(ai * HALF + m * 16 + lr) * 2 + bj] * (0.015625f * 0.015625f / 128.0f / 1048576.0f) + 1e-6f) * 0.015625f;
                        v0 = v0 * r * gn0; v1 = v1 * r * gn1; }
                    else if (PN_OFF == 0) { v0 = v0 * 0.015625f; v1 = v1 * 0.015625f; }
                    else { v0 = v0 * rs; v1 = v1 * rs; }
                    if (act) {
#pragma unroll
                        for (int j = 0; j < 4; ++j) { v0[j] *= sigm(v0[j]); v1[j] *= sigm(v1[j]); } }
                    u32x4 w; w.x = cvt_pk_bf16(v0[0], v0[1]); w.y = cvt_pk_bf16(v0[2], v0[3]); w.z = cvt_pk_bf16(v1[0], v1[1]); w.w = cvt_pk_bf16(v1[2], v1[3]);
                    *(u32x4*)(rowp + bj * HALF) = w; } }
        if (hn) { asm volatile("s_waitcnt lgkmcnt(0)" ::: "memory"); __builtin_amdgcn_s_barrier(); asm volatile("" ::: "memory");
            ss[(wr * 4 + wc) * 64 + fq * 16 + fr] = 0ull; }
    }
};
template <int MODE = 0> struct EpiMergeT {
    static constexpr bool PERM = true, AFTER_DRAIN = false, CHAIN = true;
    const unsigned char* GT; bf16_t* O;
    __device__ __forceinline__ void operator()(f32x4 (&acc)[2][2][4][2], const Unit& u, int wr, int wc, int fr, int fq) const {
        if (MODE == 2) return;
        const int row0 = u.pm * BM + wr * 64 + fr, col0 = u.pn * BM + wc * 32 + 8 * fq;
        int lo16 = (wr * 4 + wc) * 8192 + (fq * 16 + fr) * 16; asm volatile("" : "+v"(lo16));
        const unsigned char* gp = GT + ((size_t)u.pm * 8 + u.pn) * GT_TILE + lo16;
        const size_t cn = (size_t)u.seg * GT_GATE, cd = (size_t)(u.seg == 0 ? 1 : 2) * GT_GATE;
        const bool fin = u.seg == 2;
        u32x4 gn[2][4], gd[2][4];
#pragma unroll
        for (int ai = 0; ai < 2; ++ai)
#pragma unroll
            for (int m = 0; m < 4; ++m) {
                if (MODE == 1) { gn[ai][m] = (u32x4){0x80808080u + (unsigned)u.pm, 0x80808080u, 0x80808080u, 0x80808080u}; gd[ai][m] = gn[ai][m]; } else {
                gn[ai][m] = *(const u32x4*)(gp + cn + (ai * 4 + m) * 1024); gd[ai][m] = *(const u32x4*)(gp + cd + (ai * 4 + m) * 1024); } }
#pragma unroll
        for (int ai = 0; ai < 2; ++ai)
#pragma unroll
            for (int m = 0; m < 4; ++m)
#pragma unroll
                for (int bj = 0; bj < 2; ++bj) { const size_t r = (size_t)(row0 + ai * HALF + m * 16);
#pragma unroll
                    for (int w = 0; w < 2; ++w)
#pragma unroll
                        for (int k = 0; k < 4; ++k) { const float qn = (float)((gn[ai][m][2 * bj + w] >> (8 * k)) & 0xffu) + 0.5f, qd = (float)((gd[ai][m][2 * bj + w] >> (8 * k)) & 0xffu) + 0.5f;
                            acc[ai][bj][m][w][k] *= qn * __builtin_amdgcn_rcpf(fin ? 256.0f : qd); }
                    if (fin) { const f32x4 v0 = acc[ai][bj][m][0], v1 = acc[ai][bj][m][1];
                        u32x4 w; w.x = cvt_pk_bf16(v0[0], v0[1]); w.y = cvt_pk_bf16(v0[2], v0[3]); w.z = cvt_pk_bf16(v1[0], v1[1]); w.w = cvt_pk_bf16(v1[2], v1[3]);
                        *(u32x4*)(O + r * 2048 + col0 + bj * HALF) = w; } }
    }
};
typedef EpiMergeT<0> EpiMerge;
struct EpiResid {
    static constexpr int PERM = 2; static constexpr bool AFTER_DRAIN = false, CHAIN = false;
    bf16_t* hb; unsigned char* xu; const float* gain; PG8_LAS unsigned char* stg;
    __device__ __forceinline__ void operator()(const f32x4 (&acc)[2][2][4][2], const Unit& u, int wr, int wc, int fr, int fq) const {
        int lane = fq * 16 + fr; asm volatile("" : "+v"(lane));
        PG8_LAS unsigned char* s0 = stg + (wr * 4 + wc) * 1024;
        const int r8 = lane >> 3, pc = lane & 7;
        const int offc = r8 * 128 + ((pc ^ r8) << 4);
        const int offa0 = (fr >> 3) * 8192 + (fr & 7) * 128 + ((fq ^ (fr & 7)) << 4), offa1 = (fr >> 3) * 8192 + (fr & 7) * 128 + (((4 + fq) ^ (fr & 7)) << 4);
        const int xs = 2 * (fr >> 2), offxw0 = fr * 64 + ((fq ^ xs) << 3), offxw1 = fr * 64 + (((4 + fq) ^ xs) << 3);
        const int xr = lane >> 2, xq = lane & 3, offxr = xr * 64 + (((2 * xq) ^ (2 * (xr >> 2))) << 3);
        const size_t goff = (size_t)(u.pm * BM + wr * 64 + r8) * 2048 + u.pn * BM + wc * 64 + pc * 8;
        const size_t xoff = (size_t)(u.pm * BM + wr * 64 + xr) * 2048 + u.pn * BM + wc * 64 + xq * 16;
        f32x4 gv[2][2];
#pragma unroll
        for (int bj = 0; bj < 2; ++bj)
#pragma unroll
            for (int n = 0; n < 2; ++n) gv[bj][n] = *(const f32x4*)(gain + u.pn * BM + wc * 64 + bj * 32 + 8 * fq + 4 * n);
        const f32x4 lo4 = (f32x4){-440.f, -440.f, -440.f, -440.f}, hi4 = (f32x4){440.f, 440.f, 440.f, 440.f};
#pragma unroll
        for (int ai = 0; ai < 2; ++ai) {
            u32x4 bb[4][2];
#pragma unroll
            for (int m = 0; m < 4; ++m)
#pragma unroll
                for (int j = 0; j < 2; ++j) bb[m][j] = *(const u32x4*)(hb + goff + (size_t)(ai * HALF + m * 16 + 8 * j) * 2048);
#pragma unroll
            for (int m = 0; m < 4; ++m) {
                *(PG8_LAS u32x4*)(s0 + offc) = bb[m][0]; *(PG8_LAS u32x4*)(s0 + 8192 + offc) = bb[m][1];
                asm volatile("" ::: "memory");
                const u32x4 a0 = *(const PG8_LAS u32x4*)(s0 + offa0), a1 = *(const PG8_LAS u32x4*)(s0 + offa1);
                asm volatile("" ::: "memory");
                u32x2 xw[2];
#pragma unroll
                for (int bj = 0; bj < 2; ++bj) { const u32x4 w = bj ? a1 : a0;
                    const f32x4 h0 = (f32x4){bflo(w.x), bfhi(w.x), bflo(w.y), bfhi(w.y)} + acc[ai][bj][m][0], h1 = (f32x4){bflo(w.z), bfhi(w.z), bflo(w.w), bfhi(w.w)} + acc[ai][bj][m][1];
                    u32x4 hw; hw.x = cvt_pk_bf16(h0[0], h0[1]); hw.y = cvt_pk_bf16(h0[2], h0[3]); hw.z = cvt_pk_bf16(h1[0], h1[1]); hw.w = cvt_pk_bf16(h1[2], h1[3]);
                    *(PG8_LAS u32x4*)(s0 + (bj ? offa1 : offa0)) = hw;
                    const f32x4 x0 = __builtin_elementwise_min(__builtin_elementwise_max(h0 * gv[bj][0], lo4), hi4), x1 = __builtin_elementwise_min(__builtin_elementwise_max(h1 * gv[bj][1], lo4), hi4);
                    int w0 = 0, w1 = 0;
                    w0 = __builtin_amdgcn_cvt_pk_fp8_f32(x0[0], x0[1], w0, false); w0 = __builtin_amdgcn_cvt_pk_fp8_f32(x0[2], x0[3], w0, true);
                    w1 = __builtin_amdgcn_cvt_pk_fp8_f32(x1[0], x1[1], w1, false); w1 = __builtin_amdgcn_cvt_pk_fp8_f32(x1[2], x1[3], w1, true);
                    xw[bj] = (u32x2){(unsigned)w0, (unsigned)w1}; }
                asm volatile("" ::: "memory");
                const u32x4 o0 = *(const PG8_LAS u32x4*)(s0 + offc), o1 = *(const PG8_LAS u32x4*)(s0 + 8192 + offc);
                asm volatile("" ::: "memory");
                *(PG8_LAS u32x2*)(s0 + offxw0) = xw[0]; *(PG8_LAS u32x2*)(s0 + offxw1) = xw[1];
                asm volatile("" ::: "memory");
                const u32x4 xo = *(const PG8_LAS u32x4*)(s0 + offxr);
                asm volatile("" ::: "memory");
                *(u32x4*)(hb + goff + (size_t)(ai * HALF + m * 16) * 2048) = o0; *(u32x4*)(hb + goff + (size_t)(ai * HALF + m * 16 + 8) * 2048) = o1;
                *(u32x4*)(xu + xoff + (size_t)(ai * HALF + m * 16) * 2048) = xo;
            }
        }
        asm volatile("s_waitcnt lgkmcnt(0)" ::: "memory");
    }
};
struct EpiGlu {
    static constexpr bool PERM = false, AFTER_DRAIN = false, CHAIN = false;
    bf16_t* H; const PG8_LAS int* tile_exp; const PG8_LAS int* pst; const PG8_LAS int* cnt; const int* liste; const float* rstd;
    __device__ __forceinline__ void operator()(const f32x4 (&acc)[2][2][4][2], const Unit& u, int wr, int wc, int fr, int fq) const {
        const int row0 = u.pm * BM + wr * 64 + fr, pj = u.pn & 3;
        const int e = tile_exp[u.pm], lr0 = u.pm * 256 - pst[e] + wr * 64 + fr, ce = cnt[e];
        int tok[2][4]; float rs[2][4];
#pragma unroll
        for (int ai = 0; ai < 2; ++ai)
#pragma unroll
            for (int m = 0; m < 4; ++m) { const int lr = lr0 + ai * HALF + m * 16; tok[ai][m] = lr < ce ? liste[(size_t)e * 32768 + lr] : 0; }
#pragma unroll
        for (int ai = 0; ai < 2; ++ai)
#pragma unroll
            for (int m = 0; m < 4; ++m) rs[ai][m] = rstd[tok[ai][m]] * 0.015625f;
#pragma unroll
        for (int ai = 0; ai < 2; ++ai)
#pragma unroll
            for (int m = 0; m < 4; ++m) { unsigned char* rowp = (unsigned char*)H + (size_t)(row0 + ai * HALF + m * 16) * 512; const float r = rs[ai][m];
#pragma unroll
                for (int bj = 0; bj < 2; ++bj) { const f32x4 a = acc[ai][bj][m][0] * r, b = acc[ai][bj][m][1] * r;
                    const int hc = 16 * (8 * pj + 4 * bj + wc) + 4 * fq;
                    float hv[4];
#pragma unroll
                    for (int j = 0; j < 4; ++j) hv[j] = fminf(fmaxf(a[j] * sigm(a[j]) * b[j] * 8.0f, -440.0f), 440.0f);
                    int w = 0; w = __builtin_amdgcn_cvt_pk_fp8_f32(hv[0], hv[1], w, false); w = __builtin_amdgcn_cvt_pk_fp8_f32(hv[2], hv[3], w, true);
                    *(int*)(rowp + hc) = w; } }
    }
};
struct EpiY {
    static constexpr bool PERM = true, AFTER_DRAIN = false, CHAIN = false;
    unsigned char* Y;
    __device__ __forceinline__ void operator()(const f32x4 (&acc)[2][2][4][2], const Unit& u, int wr, int wc, int fr, int fq) const {
        const int row0 = u.pm * BM + wr * 64 + fr, col0 = (u.pn & 7) * BM + wc * 32 + 8 * fq;
        const f32x4 lo4 = (f32x4){-440.f, -440.f, -440.f, -440.f}, hi4 = (f32x4){440.f, 440.f, 440.f, 440.f};
#pragma unroll
        for (int ai = 0; ai < 2; ++ai)
#pragma unroll
            for (int m = 0; m < 4; ++m) { unsigned char* rowp = Y + (size_t)(row0 + ai * HALF + m * 16) * 2048 + col0;
#pragma unroll
                for (int bj = 0; bj < 2; ++bj) {
                    const f32x4 v0 = __builtin_elementwise_min(__builtin_elementwise_max(acc[ai][bj][m][0] * 0.125f, lo4), hi4), v1 = __builtin_elementwise_min(__builtin_elementwise_max(acc[ai][bj][m][1] * 0.125f, lo4), hi4);
                    int w0 = 0, w1 = 0;
                    w0 = __builtin_amdgcn_cvt_pk_fp8_f32(v0[0], v0[1], w0, false); w0 = __builtin_amdgcn_cvt_pk_fp8_f32(v0[2], v0[3], w0, true);
                    w1 = __builtin_amdgcn_cvt_pk_fp8_f32(v1[0], v1[1], w1, false); w1 = __builtin_amdgcn_cvt_pk_fp8_f32(v1[2], v1[3], w1, true);
                    *(u32x2*)(rowp + bj * HALF) = (u32x2){(unsigned)w0, (unsigned)w1}; } }
    }
};

typedef int v4i_t __attribute__((ext_vector_type(4)));
typedef int v8i_t __attribute__((ext_vector_type(8)));
template <class Epi, class Sched, bool ALIGN_EPI = false, bool FP8 = false>
__device__ __forceinline__ void gemm_phase(PG8_LAS unsigned char* lds, const Gemm g, const Sched& S, const Epi& E) {
    int tid = threadIdx.x; asm volatile("" : "+v"(tid));
    const int wid = __builtin_amdgcn_readfirstlane(tid >> 6), lane = tid & 63, wr = wid >> 2, wc = wid & 3, fr = lane & 15, fq = lane >> 4;
    const int K = g.K;
    unsigned voffA[2], voffB[2]; int RA[2]; unsigned CA2[2];
#pragma unroll
    for (int i = 0; i < 2; ++i) { int R, C; stage_rc(tid * 16 + i * 8192, R, C); const int Rb = Epi::PERM == 2 ? ((R >> 5) * 64 + perm32(R & 31)) : (Epi::PERM ? ((R & ~31) + perm32(R & 31)) : R);
        voffA[i] = (unsigned)(R * K + C) * 2u; voffB[i] = (unsigned)(Rb * K + C) * 2u; RA[i] = R; CA2[i] = (unsigned)C * 2u; }
    unsigned gAc[2][2], gAn[2][2];
#define PG8_GOFF(dst, uu) do { _Pragma("unroll") for (int h_ = 0; h_ < 2; ++h_) _Pragma("unroll") for (int i_ = 0; i_ < 2; ++i_) dst[h_][i_] = (unsigned)S.row_token(uu, 128 * h_ + RA[i_]) * (unsigned)(K * 2) + CA2[i_]; } while (0)
#define PG8_STAGE_A(bufoff, gbase, half, garr) do { if constexpr (Sched::GATHER) PG8_STAGE(bufoff, gbase, garr); else PG8_STAGE(bufoff, (gbase) + (half) * hstep, voffA); } while (0)
    const size_t kstep = (size_t)(BK * 2);
    const size_t hstep = (size_t)HALF * K * 2;
    const size_t hstepB = Epi::PERM == 2 ? (size_t)32 * K * 2 : hstep;
    const size_t tstep = 2 * hstep;
    const unsigned ldsw = (unsigned)wid * 1024u;
    const int aoff = lds_byte(wr * 64 + fr, fq * 8), boff = lds_byte(wc * 32 + fr, fq * 8);
#define PG8_SA(b, h) (((b) * 2 + (h)) * HTB)
#define PG8_SB(b, h) ((4 + (b) * 2 + (h)) * HTB)
#define PG8_STAGE(bufoff, gbase, voff) do { _Pragma("unroll") for (int _i = 0; _i < 2; ++_i) \
        __builtin_amdgcn_global_load_lds((const unsigned*)((const char*)(gbase) + (voff)[_i]), (PG8_LAS unsigned*)(lds + (bufoff) + ldsw + _i * 8192), 16, 0, 0); } while (0)
#define PG8_LDA(dst, b, h) do { if constexpr (FP8) { _Pragma("unroll") for (int m = 0; m < 4; ++m) dst##8[m] = __builtin_shufflevector(*(const PG8_LAS v4i_t*)(lds + PG8_SA(b, h) + aoff + m * 2048), *(const PG8_LAS v4i_t*)(lds + PG8_SA(b, h) + aoff + m * 2048 + 1024), 0, 1, 2, 3, 4, 5, 6, 7); } \
        else { _Pragma("unroll") for (int m = 0; m < 4; ++m) _Pragma("unroll") for (int k = 0; k < 2; ++k) dst[m][k] = *(const PG8_LAS bf16x8*)(lds + PG8_SA(b, h) + aoff + m * 2048 + k * 1024); } } while (0)
#define PG8_LDB(dst, b, h) do { if constexpr (FP8) { _Pragma("unroll") for (int n = 0; n < 2; ++n) dst##8[n] = __builtin_shufflevector(*(const PG8_LAS v4i_t*)(lds + PG8_SB(b, h) + boff + n * 2048), *(const PG8_LAS v4i_t*)(lds + PG8_SB(b, h) + boff + n * 2048 + 1024), 0, 1, 2, 3, 4, 5, 6, 7); } \
        else { _Pragma("unroll") for (int n = 0; n < 2; ++n) _Pragma("unroll") for (int k = 0; k < 2; ++k) dst[n][k] = *(const PG8_LAS bf16x8*)(lds + PG8_SB(b, h) + boff + n * 2048 + k * 1024); } } while (0)
#define PG8_MMA(ai, bj, At, Bt) do { __builtin_amdgcn_s_setprio(1); _Pragma("unroll") for (int m = 0; m < 4; ++m) _Pragma("unroll") for (int n = 0; n < 2; ++n) { \
        if constexpr (FP8) asm volatile("v_mfma_f32_16x16x128_f8f6f4 %0, %1, %2, %0" : "+v"(acc[ai][bj][m][n]) : "v"(Bt##8[n]), "v"(At##8[m])); \
        else { _Pragma("unroll") for (int k = 0; k < 2; ++k) acc[ai][bj][m][n] = __builtin_amdgcn_mfma_f32_16x16x32_bf16(Bt[n][k], At[m][k], acc[ai][bj][m][n], 0, 0, 0); } } \
        __builtin_amdgcn_s_setprio(0); } while (0)
#define PG8_WAIT_V(n) asm volatile("s_waitcnt vmcnt(" #n ")" ::: "memory")
#define PG8_WAIT_L(n) asm volatile("s_waitcnt lgkmcnt(" #n ")" ::: "memory")
#define PG8_BAR __builtin_amdgcn_s_barrier()
#define PG8_SCHED __builtin_amdgcn_sched_barrier(0)
    Unit cur, nxt; int ui = 0;
    if (!S.next(0, cur)) return;
    f32x4 acc[2][2][4][2];
#pragma unroll
    for (int a = 0; a < 2; ++a)
#pragma unroll
        for (int b = 0; b < 2; ++b)
#pragma unroll
            for (int m = 0; m < 4; ++m)
#pragma unroll
                for (int n = 0; n < 2; ++n) acc[a][b][m][n] = (f32x4){0.f, 0.f, 0.f, 0.f};
    bf16x8 At[4][2], B0[2][2], B1[2][2]; v8i_t At8[4], B08[2], B18[2];
    const size_t tstepA = Sched::GATHER ? (size_t)0 : tstep;
    const char* cA = (const char*)g.A + (size_t)cur.pm * tstepA + (size_t)cur.koff * 2; const char* cB = (const char*)g.Bt + (size_t)cur.pn * tstep + (size_t)cur.koff * 2;
    S.a_ready(cur);
    if constexpr (Sched::GATHER) { PG8_GOFF(gAc, cur); }
    PG8_STAGE(PG8_SB(0, 0), cB, voffB); PG8_STAGE(PG8_SB(0, 1), cB + hstepB, voffB); PG8_STAGE_A(PG8_SA(0, 0), cA, 0, gAc[0]); PG8_STAGE_A(PG8_SA(0, 1), cA, 1, gAc[1]);
    if (wr == 1) PG8_BAR;
    PG8_WAIT_V(2); PG8_BAR;
    PG8_STAGE(PG8_SB(1, 0), cB + kstep, voffB); PG8_STAGE_A(PG8_SA(1, 0), cA + kstep, 0, gAc[0]); PG8_STAGE(PG8_SB(1, 1), cB + hstepB + kstep, voffB);
    PG8_WAIT_V(6); PG8_BAR;
    for (;;) {
        const bool has_next = S.next(ui + 1, nxt);
        const char* nA = has_next ? (const char*)g.A + (size_t)nxt.pm * tstepA + (size_t)nxt.koff * 2 : cA; const char* nB = has_next ? (const char*)g.Bt + (size_t)nxt.pn * tstep + (size_t)nxt.koff * 2 : cB;
        if constexpr (Sched::GATHER) { if (has_next) { PG8_GOFF(gAn, nxt); } else {
#pragma unroll
            for (int h_ = 0; h_ < 2; ++h_)
#pragma unroll
                for (int i_ = 0; i_ < 2; ++i_) gAn[h_][i_] = gAc[h_][i_]; } }
        const int nt = cur.nt;
        for (int t = 0; t < nt; t += 2) {
            const bool last = (t == nt - 2);
            const char* a1 = cA + (size_t)(t + 1) * kstep;
            const char* a2 = last ? nA : cA + (size_t)(t + 2) * kstep; const char* b2 = last ? nB : cB + (size_t)(t + 2) * kstep;
            const char* a3 = a2 + kstep; const char* b3 = b2 + kstep;
            if (last && has_next) S.a_ready(nxt);
            unsigned g2a[2][2];
            if constexpr (Sched::GATHER) {
#pragma unroll
                for (int h_ = 0; h_ < 2; ++h_)
#pragma unroll
                    for (int i_ = 0; i_ < 2; ++i_) g2a[h_][i_] = last ? gAn[h_][i_] : gAc[h_][i_]; }
            PG8_LDB(B0, 0, 0); PG8_LDB(B1, 0, 1); PG8_SCHED; PG8_LDA(At, 0, 0); PG8_STAGE_A(PG8_SA(1, 1), a1, 1, gAc[1]);
            PG8_WAIT_V(8); PG8_WAIT_L(0); PG8_BAR; PG8_MMA(0, 0, At, B0); PG8_MMA(0, 1, At, B1); PG8_BAR; PG8_SCHED;
            PG8_LDA(At, 0, 1); PG8_STAGE(PG8_SB(0, 0), b2, voffB); PG8_STAGE(PG8_SB(0, 1), b2 + hstepB, voffB); PG8_STAGE_A(PG8_SA(0, 0), a2, 0, g2a[0]);
            PG8_WAIT_V(8); PG8_WAIT_L(0); PG8_BAR; PG8_MMA(1, 0, At, B0); PG8_MMA(1, 1, At, B1); PG8_BAR; PG8_SCHED;
            PG8_LDB(B0, 1, 0); PG8_LDB(B1, 1, 1); PG8_SCHED; PG8_LDA(At, 1, 0); PG8_STAGE_A(PG8_SA(0, 1), a2, 1, g2a[1]);
            PG8_WAIT_V(8); PG8_WAIT_L(0); PG8_BAR; PG8_MMA(0, 0, At, B0); PG8_MMA(0, 1, At, B1); PG8_BAR; PG8_SCHED;
            PG8_LDA(At, 1, 1); PG8_STAGE(PG8_SB(1, 0), b3, voffB); PG8_STAGE(PG8_SB(1, 1), b3 + hstepB, voffB); PG8_STAGE_A(PG8_SA(1, 0), a3, 0, g2a[0]);
            PG8_WAIT_V(8); PG8_WAIT_L(0); PG8_BAR; PG8_MMA(1, 0, At, B0); PG8_MMA(1, 1, At, B1); PG8_BAR; PG8_SCHED;
        }
        if constexpr (ALIGN_EPI) { if (wr == 0) PG8_BAR; }
        if constexpr (FP8) asm volatile("s_nop 15\n\ts_nop 15\n\ts_nop 15\n\ts_nop 15" ::: "memory");
        E(acc, cur, wr, wc, fr, fq); S.done(cur);
        if (!has_next) break;
        if (!Epi::CHAIN || cur.seg == 2)
#pragma unroll
        for (int a = 0; a < 2; ++a)
#pragma unroll
            for (int b = 0; b < 2; ++b)
#pragma unroll
                for (int m = 0; m < 4; ++m)
#pragma unroll
                    for (int n = 0; n < 2; ++n) acc[a][b][m][n] = (f32x4){0.f, 0.f, 0.f, 0.f};
        cur = nxt; cA = nA; cB = nB; ++ui;
        if constexpr (Sched::GATHER) {
#pragma unroll
            for (int h_ = 0; h_ < 2; ++h_)
#pragma unroll
                for (int i_ = 0; i_ < 2; ++i_) gAc[h_][i_] = gAn[h_][i_]; }
        if constexpr (ALIGN_EPI) { if (wr == 1) PG8_BAR; }
    }
    PG8_WAIT_V(0);
    if constexpr (!ALIGN_EPI) { if (wr == 0) PG8_BAR; }
    PG8_BAR;
#undef PG8_SA
#undef PG8_SB
#undef PG8_STAGE_A
#undef PG8_GOFF
#undef PG8_STAGE
#undef PG8_LDA
#undef PG8_LDB
#undef PG8_MMA
#undef PG8_WAIT_V
#undef PG8_WAIT_L
#undef PG8_BAR
#undef PG8_SCHED
}
}

constexpr int NWAVES = 8;
constexpr int T = 32768, SEQ = 2048, NB = 16, D = 2048, DEPTH = 2;
constexpr int ZP = pg8::ZP;
constexpr int ZC_AQ = 0, ZC_AK = 512, ZC_AV = 640, ZC_BQ = 768, ZC_BK = 1792, ZC_BV = 2048, ZC_IQ = 2304, ZC_IK = 3328, ZC_IW = 3392, ZC_CG = 3408, ZC_PAD = 3424, ZC_CQ = 3584, ZC_CK = 3840, ZC_CV = 4096, ZC_CR = 4608;
constexpr int D_IN = 11104;
constexpr int NEXP = 64, DEXP = 512, PMAX_TILES = 320;
constexpr float EPS = 1e-6f;

constexpr size_t MiB = 1u << 20;
constexpr size_t WS_CTL = 0, CTL_ZERO_BYTES = 1 * MiB;
constexpr size_t WS_ROUTE = 2 * MiB;
constexpr size_t WS_WRH = 4 * MiB, WS_WRL = 6 * MiB, WR_L = 96 * 2048 * 2;
constexpr size_t WS_WIN = 16 * MiB, WIN_L = 44 * MiB;
constexpr size_t WS_WBR = 104 * MiB, WBR_L = 8 * MiB;
constexpr size_t WS_WO = 120 * MiB, WO_L = 8 * MiB;
constexpr size_t WS_W13 = 136 * MiB;
constexpr size_t WS_HB = 264 * MiB;
constexpr size_t WS_W2 = 392 * MiB;
constexpr size_t WS_XN = 520 * MiB;
constexpr size_t WS_OCAT = 648 * MiB;
constexpr size_t WS_MERGED = 776 * MiB;
constexpr size_t WS_Z = 904 * MiB;
constexpr size_t WS_GT = 1224 * MiB;
constexpr size_t WS_S = 1608 * MiB;
constexpr size_t WS_MASK = 1864 * MiB;
constexpr size_t WS_GO = 1872 * MiB;
constexpr size_t WS_GCS = WS_GO;
constexpr size_t WS_GDEC = 8 * MiB;
constexpr size_t WS_RSTD1 = 10 * MiB;
constexpr size_t WS_RSTD = 9 * MiB;
constexpr size_t WS_LISTE = 904 * MiB;
constexpr size_t WS_XS = 904 * MiB;
constexpr size_t WS_Y = 1224 * MiB;
constexpr size_t WS_H = 1544 * MiB;
constexpr size_t WS_WG8 = 1936 * MiB, WG8_L = 12 * MiB;
constexpr size_t WS_XN8 = WS_S;
constexpr size_t WS_END = 1936 * MiB;
constexpr int CW_BAR = 4096;
constexpr int CW_CNT = 16384;

constexpr int RING_BYTES = 131072, MISC_OFF = RING_BYTES, LDS_BYTES = 155648;
constexpr int MO_BARW = 32, MO_GN = 256, MO_TEXP = 8192, MO_PST = 9728, MO_TOT = 9984, MO_TAB2 = 10240, MO_CNT = 16640, MO_SS = 16896;

#define GAS __attribute__((address_space(1)))
#define LAS __attribute__((address_space(3)))
typedef unsigned short bf16;
typedef unsigned v4u __attribute__((ext_vector_type(4)));
typedef unsigned v2u __attribute__((ext_vector_type(2)));
typedef float f32x4 __attribute__((ext_vector_type(4)));
#define LDS_WAIT() asm volatile("s_waitcnt lgkmcnt(0)" ::: "memory")
__device__ __forceinline__ unsigned f2bf(float f) { unsigned u = __builtin_bit_cast(unsigned, f); return (u + 0x7fffu + ((u >> 16) & 1u)) >> 16; }
__device__ __forceinline__ unsigned pk2(float lo, float hi) { return pg8::cvt_pk_bf16(lo, hi); }
__device__ __forceinline__ float bflo(unsigned w) { return __uint_as_float(w << 16); }
__device__ __forceinline__ float bfhi(unsigned w) { return __uint_as_float(w & 0xffff0000u); }
__device__ __forceinline__ float bf1(bf16 h) { return __uint_as_float(((unsigned)h) << 16); }

#define XB_TMO      128
#define XB_XCNT(j)  (256  + 64 * (j))
#define XB_XSUB(j)  (1280 + 64 * (j))
#define XB_XGEN(j)  (2304 + 64 * (j))
#define XB_TOP      3328
#define XB_TOPGEN   3392
#define XCD_BAR_WORDS 3456
#define XB_SPIN_CAP (1u << 18)
__device__ __forceinline__ unsigned xb_ld(unsigned* p)              { return __hip_atomic_load(p, __ATOMIC_RELAXED, __HIP_MEMORY_SCOPE_AGENT); }
__device__ __forceinline__ unsigned xb_add(unsigned* p, unsigned v) { return __hip_atomic_fetch_add(p, v, __ATOMIC_RELAXED, __HIP_MEMORY_SCOPE_AGENT); }
__device__ __forceinline__ unsigned xb_xcc_id() { return (unsigned)__builtin_amdgcn_s_getreg((3 << 11) | 20) & 0xFu; }
#define XB_SPIN(cond, bar) do { unsigned _sp = 0; while (cond) { __builtin_amdgcn_s_sleep(1); \
    if ((++_sp & 255u) == 0u) { if (xb_ld(&(bar)[XB_TMO])) break; if (_sp > XB_SPIN_CAP) { atomicAdd(&(bar)[XB_TMO], 1u); break; } } } } while (0)
struct XcdBarrier { unsigned* bar; unsigned x; volatile LAS unsigned* st; };
__device__ __forceinline__ XcdBarrier xcd_barrier_post(unsigned* bar, volatile LAS unsigned* st) {
    XcdBarrier b; b.bar = bar; b.x = xb_xcc_id(); b.st = st;
    if (threadIdx.x == 0) (void)xb_add(&bar[XB_XCNT(b.x)], 1u);
    return b;
}
__device__ __forceinline__ void xcd_barrier_complete(unsigned* bar, unsigned x, unsigned& nloc, unsigned& nx) {
    const unsigned G = gridDim.x * gridDim.y * gridDim.z;
    unsigned sum, cnt, mine, sp = 0u;
    for (;;) {
        sum = 0u; cnt = 0u; mine = 0u;
#pragma unroll
        for (unsigned j = 0; j < 16; ++j) { const unsigned c = xb_ld(&bar[XB_XCNT(j)]); sum += c; cnt += (c > 0u) ? 1u : 0u; mine = (j == x) ? c : mine; }
        if (sum == G) break;
        __builtin_amdgcn_s_sleep(1);
        if ((++sp & 255u) == 0u) { if (xb_ld(&bar[XB_TMO])) break; if (sp > XB_SPIN_CAP) { atomicAdd(&bar[XB_TMO], 1u); break; } }
    }
    nloc = mine > 0u ? mine : 1u; nx = cnt > 0u ? cnt : 1u;
}
__device__ __forceinline__ void xcd_barrier(const XcdBarrier& b) {
    asm volatile("s_waitcnt vmcnt(0)" ::: "memory");
    __syncthreads();
    if (threadIdx.x == 0) {
        unsigned* bar = b.bar;
        __builtin_amdgcn_s_waitcnt(0);
        unsigned nloc = b.st[0], nx = b.st[1];
        if (nloc == 0u) { xcd_barrier_complete(bar, b.x, nloc, nx); b.st[0] = nloc; b.st[1] = nx; }
        const unsigned old = xb_add(&bar[XB_XSUB(b.x)], 1u);
        const unsigned gen = old / nloc;
        if (old + 1u == (gen + 1u) * nloc) {
            __builtin_amdgcn_fence(__ATOMIC_RELEASE, "agent");
            asm volatile("s_waitcnt vmcnt(0)" ::: "memory");
            const unsigned og = xb_add(&bar[XB_TOP], 1u);
            const unsigned tg = og / nx;
            if (og + 1u == (tg + 1u) * nx) xb_add(&bar[XB_TOPGEN], 1u);
            else XB_SPIN(xb_ld(&bar[XB_TOPGEN]) == tg, bar);
            __builtin_amdgcn_fence(__ATOMIC_ACQUIRE, "agent");
            xb_add(&bar[XB_XGEN(b.x)], 1u);
            asm volatile("s_waitcnt vmcnt(0)" ::: "memory");
        } else {
            XB_SPIN(xb_ld(&bar[XB_XGEN(b.x)]) == gen, bar);
            __builtin_amdgcn_fence(__ATOMIC_ACQUIRE, "agent");
            asm volatile("s_waitcnt vmcnt(0)" ::: "memory");
        }
    }
    __syncthreads();
}

struct Args { const float* in[24]; float* out; unsigned char* ws; int ph_lo, ph_hi; };
enum { I_X = 0, I_RELB, I_N1G, I_WIN, I_AQG, I_AKG, I_BQG, I_BKG, I_SINK, I_CGW, I_CGB, I_CNG, I_WBA, I_WBB, I_WBC, I_WO, I_N2G, I_WRG, I_BRG, I_WRE, I_BRE, I_W1, I_W3, I_W2 };

struct Frame {
    LAS unsigned char* lds; LAS unsigned char* misc;
    unsigned* ctl;
    int tid, lane, wave, vcu, G, gw, NGW;
    const float* const* in; float* out; unsigned char* ws;
    bf16 *Z, *XN, *OCAT, *MERGED, *XS, *Y, *H;
    float *S, *GO; unsigned* MASK;
};

__device__ __forceinline__ float wave_sum(float v) {
#pragma unroll
    for (int o = 1; o < 64; o <<= 1) v += __shfl_xor(v, o);
    return v;
}
__device__ __forceinline__ float wave_max(float v) {
#pragma unroll
    for (int o = 1; o < 64; o <<= 1) v = fmaxf(v, __shfl_xor(v, o));
    return v;
}

template <class MAP>
__device__ __forceinline__ void transpose_item(const float* W, int N, bf16* WT, int dpitch, int koff, LAS float* scr, int item, int lane, const MAP& map, const float* kgain = nullptr) {
    const int nblk = N / 32, kb = item / nblk, nb = item % nblk, k0 = 64 * kb, n0 = 32 * nb;
    f32x4 v[8];
#pragma unroll
    for (int i = 0; i < 8; ++i) v[i] = *(const f32x4*)(W + (size_t)(k0 + 8 * i + (lane >> 3)) * N + n0 + 4 * (lane & 7));
    if (kgain) {
#pragma unroll
        for (int i = 0; i < 8; ++i) v[i] = v[i] * kgain[k0 + 8 * i + (lane >> 3)]; }
#pragma unroll
    for (int i = 0; i < 8; ++i) { LAS float* d = scr + (8 * i + (lane >> 3)) * 33 + 4 * (lane & 7); d[0] = v[i].x; d[1] = v[i].y; d[2] = v[i].z; d[3] = v[i].w; }
    LDS_WAIT(); asm volatile("" ::: "memory");
    const int c = lane & 7;
#pragma unroll
    for (int j = 0; j < 4; ++j) { const int n = (lane >> 3) + 8 * j; const LAS float* s = scr + (8 * c) * 33 + n;
        v4u o; o.x = pk2(s[0 * 33], s[1 * 33]); o.y = pk2(s[2 * 33], s[3 * 33]); o.z = pk2(s[4 * 33], s[5 * 33]); o.w = pk2(s[6 * 33], s[7 * 33]);
        const int dr_ = map(n0 + n); if (dr_ >= 0) *(v4u*)(WT + (size_t)dr_ * dpitch + koff + k0 + 8 * c) = o; }
    LDS_WAIT(); asm volatile("" ::: "memory");
}
__device__ __forceinline__ float clamp8(float v) { return fminf(fmaxf(v, -440.0f), 440.0f); }
template <class MAP>
__device__ __forceinline__ void transpose_item_fp8(const float* W, int N, unsigned char* WT, int dpitch, float scale, LAS float* scr, int item, int lane, const MAP& map) {
    const int nblk = N / 32, kb = item / nblk, nb = item % nblk, k0 = 64 * kb, n0 = 32 * nb;
    f32x4 v[8];
#pragma unroll
    for (int i = 0; i < 8; ++i) v[i] = *(const f32x4*)(W + (size_t)(k0 + 8 * i + (lane >> 3)) * N + n0 + 4 * (lane & 7));
#pragma unroll
    for (int i = 0; i < 8; ++i) { LAS float* d = scr + (8 * i + (lane >> 3)) * 33 + 4 * (lane & 7); d[0] = v[i].x; d[1] = v[i].y; d[2] = v[i].z; d[3] = v[i].w; }
    LDS_WAIT(); asm volatile("" ::: "memory");
    const int c = lane & 7;
#pragma unroll
    for (int j = 0; j < 4; ++j) { const int n = (lane >> 3) + 8 * j; const LAS float* s = scr + (8 * c) * 33 + n;
        int w0 = 0, w1 = 0;
        w0 = __builtin_amdgcn_cvt_pk_fp8_f32(clamp8(s[0 * 33] * scale), clamp8(s[1 * 33] * scale), w0, false); w0 = __builtin_amdgcn_cvt_pk_fp8_f32(clamp8(s[2 * 33] * scale), clamp8(s[3 * 33] * scale), w0, true);
        w1 = __builtin_amdgcn_cvt_pk_fp8_f32(clamp8(s[4 * 33] * scale), clamp8(s[5 * 33] * scale), w1, false); w1 = __builtin_amdgcn_cvt_pk_fp8_f32(clamp8(s[6 * 33] * scale), clamp8(s[7 * 33] * scale), w1, true);
        const int dr_ = map(n0 + n); if (dr_ >= 0) *(v2u*)(WT + (size_t)dr_ * dpitch + k0 + 8 * c) = (v2u){(unsigned)w0, (unsigned)w1}; }
    LDS_WAIT(); asm volatile("" ::: "memory");
}
struct MapId { int off; __device__ __forceinline__ int operator()(int n) const { return off + n; } };
struct MapWin {
    __device__ __forceinline__ int operator()(int n) const {
        if (n < 512) return ZC_AQ + n;
        if (n < 640) return ZC_AK + (n - 512);
        if (n < 768) return ZC_AV + (n - 640);
        if (n < 1792) return ZC_IQ + (n - 768);
        if (n < 1856) return ZC_IK + (n - 1792);
        if (n < 1872) return ZC_IW + (n - 1856);
        if (n < 2896) return ZC_BQ + (n - 1872);
        if (n < 3152) return ZC_BK + (n - 2896);
        if (n < 3408) return ZC_BV + (n - 3152);
        if (n < 3664) return ZC_CQ + (n - 3408);
        if (n < 3920) return ZC_CK + (n - 3664);
        if (n < 4432) return ZC_CV + (n - 3920);
        if (n < 4448) return ZC_CG + (n - 4432);
        if (n < 4960) return ZC_CR + (n - 4448);
        return pg8::ZC_GA + (n - 4960);
    }
};
struct MapWin8 { __device__ __forceinline__ int operator()(int n) const { const int z = MapWin{}(n); return z < 3328 ? z : (z >= 4096 ? z - 768 : -1); } };
struct MapWinB { __device__ __forceinline__ int operator()(int n) const { const int z = MapWin{}(n); return (z >= 3328 && z < 4096) ? z - 3328 : -1; } };
struct MapW13 { int sel; __device__ __forceinline__ int operator()(int n) const { return 32 * (n >> 4) + 16 * sel + (n & 15); } };

__device__ __forceinline__ void load_row(const float* row, int lane, f32x4 (&v)[8]) {
    const f32x4* xr = (const f32x4*)row + lane;
#pragma unroll
    for (int j = 0; j < 8; ++j) v[j] = xr[64 * j];
}
__device__ __forceinline__ float row_rstd(const f32x4 (&v)[8]) {
    float s = 0.f;
#pragma unroll
    for (int j = 0; j < 8; ++j) s += (v[j].x * v[j].x + v[j].y * v[j].y) + (v[j].z * v[j].z + v[j].w * v[j].w);
    return rsqrtf(wave_sum(s) * (1.0f / 2048.0f) + EPS);
}
__device__ __forceinline__ void norm_store_bf16(const f32x4 (&v)[8], float rstd, const float* g, bf16* orow, int lane) {
    const f32x4* gr = (const f32x4*)g + lane; unsigned long long* o8 = (unsigned long long*)orow + lane;
#pragma unroll
    for (int j = 0; j < 8; ++j) { const f32x4 gg = gr[64 * j];
        o8[64 * j] = (unsigned long long)pk2(v[j].x * rstd * gg.x, v[j].y * rstd * gg.y) | ((unsigned long long)pk2(v[j].z * rstd * gg.z, v[j].w * rstd * gg.w) << 32); }
}

__device__ __forceinline__ void norm_store_fp8(const f32x4 (&v)[8], float rstd, const float* g, unsigned char* orow, int lane) {
    const f32x4* gr = (const f32x4*)g + lane; unsigned* o4 = (unsigned*)orow + lane;
#pragma unroll
    for (int j = 0; j < 8; ++j) { const f32x4 gg = gr[64 * j]; int w = 0;
        w = __builtin_amdgcn_cvt_pk_fp8_f32(clamp8(v[j].x * rstd * gg.x), clamp8(v[j].y * rstd * gg.y), w, false); w = __builtin_amdgcn_cvt_pk_fp8_f32(clamp8(v[j].z * rstd * gg.z), clamp8(v[j].w * rstd * gg.w), w, true);
        o4[64 * j] = (unsigned)w; }
}
__device__ __forceinline__ void convert_moe(Frame& F, int l, int part, int nparts, int lds_off) {
    LAS float* scr = (LAS float*)(F.lds + lds_off + F.wave * 8704);
    bf16* W13 = (bf16*)(F.ws + WS_W13); bf16* W2 = (bf16*)(F.ws + WS_W2);
    constexpr int I13 = (2048 / 64) * (512 / 32);
    constexpr int I2 = (512 / 64) * (2048 / 32);
    constexpr int NIT = NEXP * (2 * I13 + I2);
    const int it_lo = (int)((long)NIT * part / nparts), it_hi = (int)((long)NIT * (part + 1) / nparts);
    for (int it = it_lo + F.gw; it < it_hi; it += F.NGW) {
        const int e = it / (2 * I13 + I2); int r = it % (2 * I13 + I2);
        if (r < I13) { transpose_item_fp8(F.in[I_W1] + ((size_t)l * NEXP + e) * 2048 * 512, 512, (unsigned char*)W13 + (size_t)e * 1024 * 2048, 2048, 64.0f, scr, r, F.lane, MapW13{0}); continue; } r -= I13;
        if (r < I13) { transpose_item_fp8(F.in[I_W3] + ((size_t)l * NEXP + e) * 2048 * 512, 512, (unsigned char*)W13 + (size_t)e * 1024 * 2048, 2048, 64.0f, scr, r, F.lane, MapW13{1}); continue; } r -= I13;
        transpose_item_fp8(F.in[I_W2] + ((size_t)l * NEXP + e) * 512 * 2048, 2048, (unsigned char*)W2 + (size_t)e * 2048 * 512, 512, 32.0f, scr, r, F.lane, MapId{0});
    }
}

typedef short bf16x8_t __attribute__((ext_vector_type(8)));
typedef float f32x16 __attribute__((ext_vector_type(16)));
typedef short s16x4 __attribute__((ext_vector_type(4)));
__device__ __forceinline__ void indexer_segment(Frame& F, int b, int qb, int tlo, int thi) {
    const int lane = F.lane, n = lane & 15, kq = lane >> 4;
    const bf16* qrow = F.Z + (size_t)(b * 2048 + 16 * qb + n) * ZP;
    bf16x8_t iqf[16][2];
#pragma unroll
    for (int h = 0; h < 16; ++h)
#pragma unroll
        for (int ks = 0; ks < 2; ++ks) iqf[h][ks] = *(const bf16x8_t*)(qrow + ZC_IQ + h * 64 + 32 * ks + 8 * kq);
    float wv[16];
    { const v4u w0 = *(const v4u*)(qrow + ZC_IW), w1 = *(const v4u*)(qrow + ZC_IW + 8);
      wv[0] = bflo(w0.x); wv[1] = bfhi(w0.x); wv[2] = bflo(w0.y); wv[3] = bfhi(w0.y); wv[4] = bflo(w0.z); wv[5] = bfhi(w0.z); wv[6] = bflo(w0.w); wv[7] = bfhi(w0.w);
      wv[8] = bflo(w1.x); wv[9] = bfhi(w1.x); wv[10] = bflo(w1.y); wv[11] = bfhi(w1.y); wv[12] = bflo(w1.z); wv[13] = bfhi(w1.z); wv[14] = bflo(w1.w); wv[15] = bfhi(w1.w); }
    const bf16* kbase = F.Z + (size_t)(b * 2048 + n) * ZP + ZC_IK + 8 * kq;
    float* srow = F.S + (size_t)(b * 2048 + 16 * qb + n) * 2048 + 4 * kq;
    bf16x8_t ka[3], kb[3];
#pragma unroll
    for (int u = 0; u < 3; ++u) { const int tt = tlo + u < thi ? tlo + u : thi - 1; ka[u] = *(const bf16x8_t*)(kbase + (size_t)(16 * tt) * ZP); kb[u] = *(const bf16x8_t*)(kbase + (size_t)(16 * tt) * ZP + 32); }
#pragma unroll 1
    for (int tile = tlo; tile < thi; tile += 3) {
#pragma unroll
        for (int u = 0; u < 3; ++u) {
            const int tt = tile + u;
            if (tt < thi) {
                f32x4 sc = (f32x4){0.f, 0.f, 0.f, 0.f};
#pragma unroll
                for (int h = 0; h < 16; ++h) {
                    f32x4 c = __builtin_amdgcn_mfma_f32_16x16x32_bf16(ka[u], iqf[h][0], (f32x4){0.f, 0.f, 0.f, 0.f}, 0, 0, 0);
                    c = __builtin_amdgcn_mfma_f32_16x16x32_bf16(kb[u], iqf[h][1], c, 0, 0, 0);
                    sc[0] += wv[h] * fmaxf(c[0], 0.f); sc[1] += wv[h] * fmaxf(c[1], 0.f); sc[2] += wv[h] * fmaxf(c[2], 0.f); sc[3] += wv[h] * fmaxf(c[3], 0.f);
                }
                *(f32x4*)(srow + 16 * tt) = sc * 0.03125f;
            }
            { const int tn = tt + 3 < thi ? tt + 3 : thi - 1; ka[u] = *(const bf16x8_t*)(kbase + (size_t)(16 * tn) * ZP); kb[u] = *(const bf16x8_t*)(kbase + (size_t)(16 * tn) * ZP + 32); }
        }
    }
}

constexpr int FA_KP = 272, FA_VP = 320;
constexpr int FA_KOFF = 0, FA_VOFF = 2 * 64 * FA_KP, FA_BYTES = FA_VOFF + 2 * 64 * FA_VP;
__device__ __forceinline__ s16x4 fa_vtr(const LAS unsigned char* p) { return __builtin_bit_cast(s16x4, __builtin_amdgcn_ds_read_tr16_b64_v4i16((LAS s16x4*)p)); }
template <int MODE>
__device__ __forceinline__ void flash_unit(Frame& F, int l, int b, int g, int t0) {
    const int tid = F.tid, lane = F.lane, wave = F.wave, hh = wave & 3, qh = wave >> 2, r = lane & 31, hf = lane >> 5;
    const int qcol = (MODE == 0 ? ZC_AQ : ZC_BQ + 512 * g) + 128 * hh, kcol = MODE == 0 ? ZC_AK : ZC_BK + 128 * g, vcol = MODE == 0 ? ZC_AV : ZC_BV + 128 * g;
    const int ocol = (MODE == 0 ? 0 : 512 + 512 * g) + 128 * hh, hd = (MODE == 0 ? 0 : 4 + 4 * g) + hh;
    const int tq = t0 + 32 * qh + r; const size_t qrow = (size_t)(b * 2048 + tq);
    const LAS float* tab2 = (const LAS float*)(F.misc + MO_TAB2) + hd * 129;
    LAS unsigned char* lds = F.lds;
    bf16x8_t qf[8];
#pragma unroll
    for (int ks = 0; ks < 8; ++ks) qf[ks] = *(const bf16x8_t*)(F.Z + qrow * ZP + qcol + 16 * ks + 8 * hf);
    f32x16 oacc[4];
#pragma unroll
    for (int dt = 0; dt < 4; ++dt)
#pragma unroll
        for (int i = 0; i < 16; ++i) oacc[dt][i] = 0.f;
    float m_run = -1e30f, l_run = 0.f;
    const int tile_lo = MODE == 0 ? 0 : (t0 >= 128 ? t0 / 64 - 2 : 0), tile_hi = t0 / 64 + 1;
    const int skey = tid >> 4, sdc = tid & 15;
    v4u kreg[2], vreg[2];
    { const bf16* zr = F.Z + (size_t)(b * 2048 + 64 * tile_lo + skey) * ZP;
#pragma unroll
      for (int i = 0; i < 2; ++i) { kreg[i] = *(const v4u*)(zr + (size_t)(32 * i) * ZP + kcol + 8 * sdc); vreg[i] = *(const v4u*)(zr + (size_t)(32 * i) * ZP + vcol + 8 * sdc); } }
    const float sc2 = 0.08838834764831845f * 1.4426950408889634f;
    unsigned mwn[2] = {0xffffffffu, 0xffffffffu};
    if (MODE == 0) { mwn[0] = F.MASK[qrow * 64 + 2 * tile_lo]; mwn[1] = F.MASK[qrow * 64 + 2 * tile_lo + 1]; }
#pragma unroll 1
    for (int kt = tile_lo; kt < tile_hi; ++kt) {
        const int bf = (kt - tile_lo) & 1, s0 = 64 * kt;
        LAS unsigned char* kb = lds + FA_KOFF + bf * (64 * FA_KP); LAS unsigned char* vb = lds + FA_VOFF + bf * (64 * FA_VP);
#pragma unroll
        for (int i = 0; i < 2; ++i) { *(LAS v4u*)(kb + (skey + 32 * i) * FA_KP + 16 * sdc) = kreg[i]; *(LAS v4u*)(vb + (skey + 32 * i) * FA_VP + 16 * sdc) = vreg[i]; }
        __syncthreads();
        if (kt + 1 < tile_hi) { const bf16* zr = F.Z + (size_t)(b * 2048 + 64 * (kt + 1) + skey) * ZP;
#pragma unroll
            for (int i = 0; i < 2; ++i) { kreg[i] = *(const v4u*)(zr + (size_t)(32 * i) * ZP + kcol + 8 * sdc); vreg[i] = *(const v4u*)(zr + (size_t)(32 * i) * ZP + vcol + 8 * sdc); } }
        unsigned mw[2] = {mwn[0], mwn[1]};
        if (MODE == 0 && kt + 1 < tile_hi) { mwn[0] = F.MASK[qrow * 64 + 2 * (kt + 1)]; mwn[1] = F.MASK[qrow * 64 + 2 * (kt + 1) + 1]; }
        f32x16 sacc[2];
#pragma unroll
        for (int k2 = 0; k2 < 2; ++k2) {
#pragma unroll
            for (int i = 0; i < 16; ++i) sacc[k2][i] = 0.f;
#pragma unroll
            for (int ks = 0; ks < 8; ++ks) { const bf16x8_t kf = *(const LAS bf16x8_t*)(kb + (32 * k2 + r) * FA_KP + (16 * ks + 8 * hf) * 2);
                sacc[k2] = __builtin_amdgcn_mfma_f32_32x32x16_bf16(kf, qf[ks], sacc[k2], 0, 0, 0); }
        }
        float mx = -1e30f;
        if (MODE == 0 && s0 + 63 + 128 <= t0) {
            const float bfar = tab2[128];
#pragma unroll
            for (int k2 = 0; k2 < 2; ++k2)
#pragma unroll
                for (int i = 0; i < 16; ++i) { const int cr = (i & 3) + 8 * (i >> 2) + 4 * hf;
                    const float v = ((mw[k2] >> cr) & 1u) ? sacc[k2][i] * sc2 + bfar : -__builtin_inff();
                    sacc[k2][i] = v; mx = fmaxf(mx, v); }
        } else
#pragma unroll
        for (int k2 = 0; k2 < 2; ++k2)
#pragma unroll
            for (int i = 0; i < 16; ++i) { const int cr = (i & 3) + 8 * (i >> 2) + 4 * hf; const int dist = tq - (s0 + 32 * k2 + cr);
                bool ok; if (MODE == 0) ok = (mw[k2] >> cr) & 1u; else ok = dist >= 0 && dist < 128;
                const int di = dist < 0 ? 0 : (dist > 128 ? 128 : dist);
                float vf = sacc[k2][i] * sc2 + tab2[di];
                asm volatile("" : "+v"(vf));
                const float v = ok ? vf : -__builtin_inff();
                sacc[k2][i] = v; mx = fmaxf(mx, v); }
        { const auto sw_ = __builtin_amdgcn_permlane32_swap(__float_as_uint(mx), __float_as_uint(mx), false, false); mx = fmaxf(__uint_as_float(sw_[0]), __uint_as_float(sw_[1])); }
        const float m_new = fmaxf(m_run, mx), alpha = __builtin_amdgcn_exp2f(m_run - m_new); m_run = m_new;
        float ps = 0.f;
#pragma unroll
        for (int k2 = 0; k2 < 2; ++k2)
#pragma unroll
            for (int i = 0; i < 16; ++i) { const float p = __builtin_amdgcn_exp2f(sacc[k2][i] - m_new); sacc[k2][i] = p; ps += p; }
        l_run = l_run * alpha + ps;
        if (__ballot(alpha != 1.0f)) {
#pragma unroll
        for (int dt = 0; dt < 4; ++dt)
#pragma unroll
            for (int i = 0; i < 16; ++i) oacc[dt][i] *= alpha;
        }
#pragma unroll
        for (int k2 = 0; k2 < 2; ++k2)
#pragma unroll
            for (int s2 = 0; s2 < 2; ++s2) {
                v4u pw; pw.x = pg8::cvt_pk_bf16(sacc[k2][8 * s2 + 0], sacc[k2][8 * s2 + 1]); pw.y = pg8::cvt_pk_bf16(sacc[k2][8 * s2 + 2], sacc[k2][8 * s2 + 3]);
                pw.z = pg8::cvt_pk_bf16(sacc[k2][8 * s2 + 4], sacc[k2][8 * s2 + 5]); pw.w = pg8::cvt_pk_bf16(sacc[k2][8 * s2 + 6], sacc[k2][8 * s2 + 7]);
                const bf16x8_t pb = __builtin_bit_cast(bf16x8_t, pw);
                const int i16 = lane & 15, grp = (lane >> 4) & 1;
                const LAS unsigned char* vp = vb + (32 * k2 + 16 * s2 + 4 * hf + (i16 >> 2)) * FA_VP + (16 * grp + 4 * (i16 & 3)) * 2;
#pragma unroll
                for (int dt = 0; dt < 4; ++dt) { const s16x4 lo = fa_vtr(vp + 64 * dt), hi = fa_vtr(vp + 8 * FA_VP + 64 * dt);
                    const bf16x8_t vf = __builtin_shufflevector(lo, hi, 0, 1, 2, 3, 4, 5, 6, 7);
                    oacc[dt] = __builtin_amdgcn_mfma_f32_32x32x16_bf16(vf, pb, oacc[dt], 0, 0, 0); }
            }
    }
    float l_tot = l_run + __shfl_xor(l_run, 32);
    if (MODE == 1) l_tot += __builtin_amdgcn_exp2f(F.in[I_SINK][l * 8 + hd - 4] * 1.4426950408889634f - m_run);
    const float inv = 1.0f / l_tot;
    bf16* orow = F.OCAT + qrow * 2048 + ocol + 4 * hf;
#pragma unroll
    for (int dt = 0; dt < 4; ++dt)
#pragma unroll
        for (int gq = 0; gq < 4; ++gq) { v2u w; w.x = pk2(oacc[dt][4 * gq] * inv, oacc[dt][4 * gq + 1] * inv); w.y = pk2(oacc[dt][4 * gq + 2] * inv, oacc[dt][4 * gq + 3] * inv);
            *(v2u*)(orow + 32 * dt + 8 * gq) = w; }
    __syncthreads();
}


#define GLA_GATE_PREFIX(LDS_TOT) \
        float la[8]; \
        _Pragma("unroll") for (int i = 0; i < 8; ++i) { const v4u c0 = rc0[i], c1 = rc1[i]; float x = gb; \
            x += bflo(c0.x) * gwv[0] + bfhi(c0.x) * gwv[1] + bflo(c0.y) * gwv[2] + bfhi(c0.y) * gwv[3] + bflo(c0.z) * gwv[4] + bfhi(c0.z) * gwv[5] + bflo(c0.w) * gwv[6] + bfhi(c0.w) * gwv[7]; \
            x += bflo(c1.x) * gwv[8] + bfhi(c1.x) * gwv[9] + bflo(c1.y) * gwv[10] + bfhi(c1.y) * gwv[11] + bflo(c1.z) * gwv[12] + bfhi(c1.z) * gwv[13] + bflo(c1.w) * gwv[14] + bfhi(c1.w) * gwv[15]; \
            la[i] = (fminf(x, 0.f) - __logf(1.0f + __expf(-fabsf(x)))) * 0.0625f; } \
        _Pragma("unroll") for (int i = 1; i < 8; ++i) la[i] += la[i - 1]; \
        ((LAS float*)(L + LDS_TOT))[cg * 64 + dk] = la[7];
#define GLA_OFFSETS(LDS_TOT) \
        float off = 0.f, tot = 0.f; \
        _Pragma("unroll") for (int g2 = 0; g2 < 8; ++g2) { const float tv = ((const LAS float*)(L + LDS_TOT))[g2 * 64 + dk]; tot += tv; off += g2 < cg ? tv : 0.f; }

__device__ __forceinline__ void gla_state_phase(Frame& F, int l) {
    const int tid = F.tid, lane = F.lane, wave = F.wave, r = lane & 31, hf = lane >> 5, i16 = lane & 15, grp = (lane >> 4) & 1;
    LAS unsigned char* L = F.lds;
    constexpr int KDT = 0, VT = 9216, TOT = 29696, RP = 144, VP = 320;
    const int dk = lane, cg = wave;
    float* GCS = (float*)(F.ws + WS_GCS); float* GDEC = (float*)(F.ws + WS_GDEC);
    v4u rc0[8], rc1[8], rv[2]; unsigned short rk[8];
#define GLS_LOAD(u_) do { const int bh_ = (u_) >> 5, n_ = (u_) & 31; const size_t r0_ = (size_t)((bh_ >> 2) * 2048 + 64 * n_); const int h_ = bh_ & 3; \
        _Pragma("unroll") for (int i = 0; i < 8; ++i) { const bf16* zr = F.Z + (r0_ + 8 * cg + i) * ZP; rc0[i] = *(const v4u*)(zr + ZC_CG); rc1[i] = *(const v4u*)(zr + ZC_CG + 8); rk[i] = zr[ZC_CK + h_ * 64 + dk]; } \
        _Pragma("unroll") for (int i = 0; i < 2; ++i) rv[i] = *(const v4u*)(F.Z + (r0_ + (tid >> 4) + 32 * i) * ZP + ZC_CV + h_ * 128 + 8 * (tid & 15)); } while (0)
    int u = F.vcu;
    if (u < 2048) GLS_LOAD(u);
    for (; u < 2048; u += F.G) {
        const int h = (u >> 5) & 3;
        float gwv[16];
#pragma unroll
        for (int q = 0; q < 16; ++q) gwv[q] = F.in[I_CGW][(size_t)l * 4096 + q * 256 + h * 64 + dk];
        const float gb = F.in[I_CGB][l * 256 + h * 64 + dk];
        GLA_GATE_PREFIX(TOT)
        float kv[8];
#pragma unroll
        for (int i = 0; i < 8; ++i) kv[i] = bf1(rk[i]);
#pragma unroll
        for (int i = 0; i < 2; ++i) *(LAS v4u*)(L + VT + ((tid >> 4) + 32 * i) * VP + 16 * (tid & 15)) = rv[i];
        __syncthreads();
        GLA_OFFSETS(TOT)
        { float kd[8];
#pragma unroll
          for (int i = 0; i < 8; ++i) kd[i] = kv[i] * __expf(tot - (off + la[i]));
          v4u w; w.x = pk2(kd[0], kd[1]); w.y = pk2(kd[2], kd[3]); w.z = pk2(kd[4], kd[5]); w.w = pk2(kd[6], kd[7]); *(LAS v4u*)(L + KDT + dk * RP + 16 * cg) = w; }
        if (cg == 0) GDEC[(size_t)u * 64 + dk] = __expf(tot);
        __syncthreads();
        if (u + F.G < 2048) GLS_LOAD(u + F.G);
        { const int dkt = wave >> 2, dvt = wave & 3;
          f32x16 cs;
#pragma unroll
          for (int i = 0; i < 16; ++i) cs[i] = 0.f;
#pragma unroll
          for (int ks = 0; ks < 4; ++ks) { const bf16x8_t a = *(const LAS bf16x8_t*)(L + KDT + (32 * dkt + r) * RP + (16 * ks + 8 * hf) * 2);
              const LAS unsigned char* vp = L + VT + (16 * ks + 8 * hf + (i16 >> 2)) * VP + (32 * dvt + 16 * grp + 4 * (i16 & 3)) * 2;
              const s16x4 lo = fa_vtr(vp), hi = fa_vtr(vp + 4 * VP);
              cs = __builtin_amdgcn_mfma_f32_32x32x16_bf16(a, __builtin_shufflevector(lo, hi, 0, 1, 2, 3, 4, 5, 6, 7), cs, 0, 0, 0); }
          float* gp = GCS + (size_t)u * 8192 + (size_t)(32 * dkt + 4 * hf) * 128 + 32 * dvt + r;
#pragma unroll
          for (int i = 0; i < 16; ++i) gp[((i & 3) + 8 * (i >> 2)) * 128] = cs[i]; }
        __syncthreads();
    }
#undef GLS_LOAD
}

__device__ __forceinline__ void gla_scan_phase(Frame& F) {
    float* GCS = (float*)(F.ws + WS_GCS); const float* GDEC = (const float*)(F.ws + WS_GDEC);
    for (int gt = F.gw * 64 + F.lane; gt < 64 * 2048; gt += F.NGW * 64) {
        const int bh = gt >> 11, e4 = gt & 2047, dk = e4 >> 5;
        f32x4* p = (f32x4*)(GCS + (size_t)bh * 32 * 8192) + e4; const float* dp = GDEC + (size_t)bh * 32 * 64 + dk;
        f32x4 st = (f32x4){0.f, 0.f, 0.f, 0.f};
#pragma unroll 1
        for (int n0 = 0; n0 < 32; n0 += 8) {
            f32x4 cs[8]; float dc[8];
#pragma unroll
            for (int j = 0; j < 8; ++j) { cs[j] = p[(size_t)(n0 + j) * 2048]; dc[j] = dp[(n0 + j) * 64]; }
#pragma unroll
            for (int j = 0; j < 8; ++j) { p[(size_t)(n0 + j) * 2048] = st; st = st * dc[j] + cs[j]; }
        }
    }
}

__device__ __forceinline__ void gla_out_phase(Frame& F, int l) {
    const int tid = F.tid, lane = F.lane, wave = F.wave, r = lane & 31, hf = lane >> 5, i16 = lane & 15, grp = (lane >> 4) & 1;
    LAS unsigned char* L = F.lds;
    constexpr int QG = 0, KG = 9216, VT = 18432, PT = 38912, TOT = 59392, OT = 61440, RP = 144, VP = 320, OP = 132;
    const int dk = lane, cg = wave;
    const float* GCS = (const float*)(F.ws + WS_GCS);
    v4u rc0[8], rc1[8], rv[2]; unsigned short rq[8], rk[8]; unsigned rg[8]; f32x4 rp[4];
#define GLO_LOAD(u_) do { const int bh_ = (u_) >> 5, n_ = (u_) & 31; const size_t r0_ = (size_t)((bh_ >> 2) * 2048 + 64 * n_); const int h_ = bh_ & 3; \
        _Pragma("unroll") for (int i = 0; i < 8; ++i) { const bf16* zr = F.Z + (r0_ + 8 * cg + i) * ZP; rc0[i] = *(const v4u*)(zr + ZC_CG); rc1[i] = *(const v4u*)(zr + ZC_CG + 8); rq[i] = zr[ZC_CQ + h_ * 64 + dk]; rk[i] = zr[ZC_CK + h_ * 64 + dk]; \
            rg[i] = *(const unsigned*)(zr + ZC_CR + h_ * 128 + 2 * lane); } \
        _Pragma("unroll") for (int i = 0; i < 2; ++i) rv[i] = *(const v4u*)(F.Z + (r0_ + (tid >> 4) + 32 * i) * ZP + ZC_CV + h_ * 128 + 8 * (tid & 15)); \
        _Pragma("unroll") for (int i = 0; i < 4; ++i) rp[i] = *(const f32x4*)(GCS + (size_t)(u_) * 8192 + (size_t)(tid >> 3) * 128 + 16 * (tid & 7) + 4 * i); } while (0)
    int u = F.vcu;
    if (u < 2048) GLO_LOAD(u);
    const float g0 = F.in[I_CNG][l * 128 + 2 * lane], g1 = F.in[I_CNG][l * 128 + 2 * lane + 1];
    for (; u < 2048; u += F.G) {
        const int bh = u >> 5, n = u & 31, h = bh & 3; const size_t row0 = (size_t)((bh >> 2) * 2048 + 64 * n);
        float gwv[16];
#pragma unroll
        for (int q = 0; q < 16; ++q) gwv[q] = F.in[I_CGW][(size_t)l * 4096 + q * 256 + h * 64 + dk];
        const float gb = F.in[I_CGB][l * 256 + h * 64 + dk];
        GLA_GATE_PREFIX(TOT)
        float qv[8], kv[8]; unsigned gr[8];
#pragma unroll
        for (int i = 0; i < 8; ++i) { qv[i] = bf1(rq[i]); kv[i] = bf1(rk[i]); gr[i] = rg[i]; }
#pragma unroll
        for (int i = 0; i < 2; ++i) *(LAS v4u*)(L + VT + ((tid >> 4) + 32 * i) * VP + 16 * (tid & 15)) = rv[i];
        { v4u w0, w1; w0.x = pk2(rp[0].x, rp[0].y); w0.y = pk2(rp[0].z, rp[0].w); w0.z = pk2(rp[1].x, rp[1].y); w0.w = pk2(rp[1].z, rp[1].w);
          w1.x = pk2(rp[2].x, rp[2].y); w1.y = pk2(rp[2].z, rp[2].w); w1.z = pk2(rp[3].x, rp[3].y); w1.w = pk2(rp[3].z, rp[3].w);
          *(LAS v4u*)(L + PT + (tid >> 3) * VP + 32 * (tid & 7)) = w0; *(LAS v4u*)(L + PT + (tid >> 3) * VP + 32 * (tid & 7) + 16) = w1; }
        __syncthreads();
        GLA_OFFSETS(TOT)
#pragma unroll
        for (int i = 0; i < 8; ++i) { const float bi = off + la[i];
            *(LAS bf16*)(L + QG + (8 * cg + i) * RP + 2 * dk) = (bf16)f2bf(qv[i] * 0.125f * __expf(bi));
            *(LAS bf16*)(L + KG + (8 * cg + i) * RP + 2 * dk) = (bf16)f2bf(kv[i] * __expf(-bi)); }
        __syncthreads();
        if (u + F.G < 2048) GLO_LOAD(u + F.G);
        { const int ct = wave >> 2, dvt = wave & 3;
          f32x16 o;
#pragma unroll
          for (int i = 0; i < 16; ++i) o[i] = 0.f;
#pragma unroll
          for (int st = 0; st < 2; ++st) if (st <= ct) {
              f32x16 at;
#pragma unroll
              for (int i = 0; i < 16; ++i) at[i] = 0.f;
#pragma unroll
              for (int ks = 0; ks < 4; ++ks) { const bf16x8_t a = *(const LAS bf16x8_t*)(L + KG + (32 * st + r) * RP + (16 * ks + 8 * hf) * 2), bq = *(const LAS bf16x8_t*)(L + QG + (32 * ct + r) * RP + (16 * ks + 8 * hf) * 2);
                  at = __builtin_amdgcn_mfma_f32_32x32x16_bf16(a, bq, at, 0, 0, 0); }
              if (st == ct) {
#pragma unroll
                  for (int i = 0; i < 16; ++i) { const int cr = (i & 3) + 8 * (i >> 2) + 4 * hf; at[i] = cr <= r ? at[i] : 0.f; } }
#pragma unroll
              for (int s2 = 0; s2 < 2; ++s2) {
                  v4u pw; pw.x = pg8::cvt_pk_bf16(at[8 * s2 + 0], at[8 * s2 + 1]); pw.y = pg8::cvt_pk_bf16(at[8 * s2 + 2], at[8 * s2 + 3]); pw.z = pg8::cvt_pk_bf16(at[8 * s2 + 4], at[8 * s2 + 5]); pw.w = pg8::cvt_pk_bf16(at[8 * s2 + 6], at[8 * s2 + 7]);
                  const LAS unsigned char* vp = L + VT + (32 * st + 16 * s2 + 4 * hf + (i16 >> 2)) * VP + (32 * dvt + 16 * grp + 4 * (i16 & 3)) * 2;
                  const s16x4 lo = fa_vtr(vp), hi = fa_vtr(vp + 8 * VP);
                  o = __builtin_amdgcn_mfma_f32_32x32x16_bf16(__builtin_bit_cast(bf16x8_t, pw), __builtin_shufflevector(lo, hi, 0, 1, 2, 3, 4, 5, 6, 7), o, 0, 0, 0);
              }
          }
#pragma unroll
          for (int ks = 0; ks < 4; ++ks) { const bf16x8_t a = *(const LAS bf16x8_t*)(L + QG + (32 * ct + r) * RP + (16 * ks + 8 * hf) * 2);
              const LAS unsigned char* pp = L + PT + (16 * ks + 8 * hf + (i16 >> 2)) * VP + (32 * dvt + 16 * grp + 4 * (i16 & 3)) * 2;
              const s16x4 lo = fa_vtr(pp), hi = fa_vtr(pp + 4 * VP);
              o = __builtin_amdgcn_mfma_f32_32x32x16_bf16(a, __builtin_shufflevector(lo, hi, 0, 1, 2, 3, 4, 5, 6, 7), o, 0, 0, 0); }
          LAS float* op = (LAS float*)(L + OT) + (32 * ct + 4 * hf) * OP + 32 * dvt + r;
#pragma unroll
          for (int i = 0; i < 16; ++i) op[((i & 3) + 8 * (i >> 2)) * OP] = o[i]; }
        __syncthreads();
        { float a[8], c[8], ss[8];
#pragma unroll
          for (int i = 0; i < 8; ++i) { const LAS float* orow = (const LAS float*)(L + OT) + (8 * wave + i) * OP + 2 * lane; a[i] = orow[0]; c[i] = orow[1]; ss[i] = a[i] * a[i] + c[i] * c[i]; }
#pragma unroll
          for (int o2 = 1; o2 < 64; o2 <<= 1) {
#pragma unroll
              for (int i = 0; i < 8; ++i) ss[i] += __shfl_xor(ss[i], o2); }
#pragma unroll
          for (int i = 0; i < 8; ++i) { const float rstd = rsqrtf(ss[i] * (1.0f / 128.0f) + EPS);
              *(unsigned*)(F.OCAT + (row0 + 8 * wave + i) * 2048 + 1536 + h * 128 + 2 * lane) = pk2(a[i] * rstd * g0 * bflo(gr[i]), c[i] * rstd * g1 * bfhi(gr[i])); } }
        __syncthreads();
    }
#undef GLO_LOAD
}
#undef GLA_GATE_PREFIX
#undef GLA_OFFSETS

__device__ __forceinline__ bool in_phase(int k, int lo, int hi) { asm volatile("" : "+s"(k)); return lo <= k && k < hi; }
#define IN(k) in_phase((k), lo, hi)
#define PHASE_LANE() do { int _tz = threadIdx.x; asm volatile("" : "+v"(_tz)); F.tid = _tz; F.lane = _tz & 63; } while (0)
#define SEAM(k) do { if (IN(k) && IN((k) + 1)) xcd_barrier(bar); } while (0)
template <int l>
__device__ __forceinline__ void layer_body(Frame& F, const XcdBarrier& bar, const int lo, const int hi) {
    constexpr int pb = 1 + 11 * l;
        if (IN(pb + 0)) {
            { pg8::Gemm g{(const bf16*)(F.ws + WS_HB), (const bf16*)(F.ws + WS_WIN + l * WIN_L + 24 * MiB), T, 768, D}; pg8::StaticOrder S; S.init(T, 768, D, F.G, (int)blockIdx.x);
              pg8::EpiInProj<1> E{F.Z, F.ws + WS_GT, (LAS unsigned long long*)(F.misc + MO_SS), (const LAS float*)(F.misc + MO_GN) + l * 512, (const float*)(F.ws + WS_RSTD1)};
              pg8::gemm_phase<pg8::EpiInProj<1>, pg8::StaticOrder, true, false>(F.lds, g, S, E); }
            { pg8::Gemm g{(const bf16*)(F.ws + WS_XN8), (const bf16*)(F.ws + WS_WIN + l * WIN_L), T, 10496, D / 2}; pg8::StaticOrder S; S.init(T, 10496, D / 2, F.G, ((int)blockIdx.x + F.G / 2) % F.G);
              pg8::EpiInProj<0> E{F.Z, F.ws + WS_GT, (LAS unsigned long long*)(F.misc + MO_SS), (const LAS float*)(F.misc + MO_GN) + l * 512, (const float*)(F.ws + WS_RSTD1)};
              pg8::gemm_phase<pg8::EpiInProj<0>, pg8::StaticOrder, true, true>(F.lds, g, S, E); }
        }
        SEAM(pb + 0);
        if (IN(pb + 1)) { PHASE_LANE();
            if (F.wave & 4) convert_moe(F, l, 0, 4, 40960);
            for (int it = F.gw; it < NB * 128; it += F.NGW) {
                const int b = it >> 7, j = it & 127;
                indexer_segment(F, b, j, 0, j < 64 ? j + 1 : 64);
                if (j < 64) indexer_segment(F, b, 127 - j, 64, 128 - j);
            }
            if (!(F.wave & 4)) convert_moe(F, l, 0, 4, 40960);
            PHASE_LANE();
            gla_state_phase(F, l);
        }
        SEAM(pb + 1);
        if (IN(pb + 2)) { PHASE_LANE();
            if (F.wave & 4) convert_moe(F, l, 1, 4, 0);
            for (int row = F.gw; row < T; row += F.NGW) {
                const int t = row & 2047;
                if (t < 256) { const int nb = t + 1 - 32 * F.lane; F.MASK[(size_t)row * 64 + F.lane] = nb >= 32 ? 0xffffffffu : (nb <= 0 ? 0u : ((1u << nb) - 1u)); continue; }
                float val[32];
#pragma unroll
                for (int j = 0; j < 32; ++j) { const int s_ = 64 * j + F.lane; val[j] = F.S[(size_t)row * 2048 + (s_ < t ? s_ : t)]; }
                float vmx = -3.0e38f, vmn = 3.0e38f;
#pragma unroll
                for (int j = 0; j < 32; ++j) { const bool ok = 64 * j + F.lane <= t; val[j] = ok ? val[j] : -3.0e38f; vmx = fmaxf(vmx, val[j]); vmn = fminf(vmn, ok ? val[j] : 3.0e38f); }
#pragma unroll
                for (int o = 1; o < 64; o <<= 1) { vmx = fmaxf(vmx, __shfl_xor(vmx, o)); vmn = fminf(vmn, __shfl_xor(vmn, o)); }
                float lo = vmn, hi = vmx, thf = 0.f; bool exact = false;
#pragma unroll 1
                for (int it = 0; it < 28; ++it) { const float mid = 0.5f * (lo + hi); if (!(mid > lo && mid < hi)) break; int cnt = 0;
#pragma unroll
                    for (int j = 0; j < 32; ++j) cnt += __popcll(__ballot(val[j] >= mid));
                    if (cnt == 256) { exact = true; thf = mid; break; }
                    if (cnt > 256) lo = mid; else hi = mid; }
                unsigned th = 0u; int need = 0;
#define KEYOF(x) ({ const unsigned u_ = __float_as_uint(x); (u_ & 0x80000000u) ? ~u_ : (u_ | 0x80000000u); })
                if (!exact) {
#pragma unroll 1
                    for (int bit = 31; bit >= 0; --bit) { const unsigned cand = th | (1u << bit); int cnt = 0;
#pragma unroll
                        for (int j = 0; j < 32; ++j) cnt += __popcll(__ballot(KEYOF(val[j]) >= cand));
                        if (cnt >= 256) th = cand; }
                    int cgt = 0;
#pragma unroll
                    for (int j = 0; j < 32; ++j) cgt += __popcll(__ballot(KEYOF(val[j]) > th));
                    need = 256 - cgt;
                }
                int run = 0; unsigned myword = 0u;
#pragma unroll
                for (int j = 0; j < 32; ++j) {
                    bool sel;
                    if (exact) sel = val[j] >= thf;
                    else { const unsigned kj = KEYOF(val[j]); const bool eq = kj == th; const unsigned long long eqm = __ballot(eq);
                        const int pre = run + __popcll(eqm & ((1ull << F.lane) - 1ull)); sel = (kj > th) || (eq && pre < need); run += __popcll(eqm); sel = sel && (64 * j + F.lane <= t); }
                    const unsigned long long sm = __ballot(sel);
                    if ((F.lane >> 1) == j) myword = (F.lane & 1) ? (unsigned)(sm >> 32) : (unsigned)sm;
                }
#undef KEYOF
                F.MASK[(size_t)row * 64 + F.lane] = myword;
            }
            if (!(F.wave & 4)) convert_moe(F, l, 1, 4, 0);
            gla_scan_phase(F);
        }
        SEAM(pb + 2);
        if (IN(pb + 3)) { PHASE_LANE();
            if (F.vcu & 1) { convert_moe(F, l, 1, 2, 0); __syncthreads(); PHASE_LANE(); }
            for (int u = F.vcu; u < NB * 16; u += F.G) { const int b = u >> 4, p = u & 15; flash_unit<0>(F, l, b, 0, 64 * (31 - p)); flash_unit<0>(F, l, b, 0, 64 * p); }
            for (int u = F.vcu; u < NB * 2 * 32; u += F.G) { const int b = u >> 6, g = (u >> 5) & 1, qb = u & 31; flash_unit<1>(F, l, b, g, 64 * qb); }
            gla_out_phase(F, l);
            if (!(F.vcu & 1)) { PHASE_LANE(); convert_moe(F, l, 1, 2, 0); }
        }
        SEAM(pb + 3);
        if (IN(pb + 4)) {
            pg8::Gemm g{F.OCAT, (const bf16*)(F.ws + WS_WBR + l * WBR_L), T, D, D}; pg8::MergeOrder S; S.init(T, D, D, F.G, (int)blockIdx.x);
#ifdef PROBE_MERGE
            { pg8::EpiMergeT<PROBE_MERGE> E{F.ws + WS_GT, (bf16*)(F.ws + WS_S)}; pg8::gemm_phase<pg8::EpiMergeT<PROBE_MERGE>, pg8::MergeOrder, true>(F.lds, g, S, E); }
#endif
            pg8::EpiMerge E{F.ws + WS_GT, F.MERGED};
            pg8::gemm_phase<pg8::EpiMerge, pg8::MergeOrder, true>(F.lds, g, S, E);
        }
        SEAM(pb + 4);
        if (IN(pb + 5)) {
            pg8::Gemm g{F.MERGED, (const bf16*)(F.ws + WS_WO + l * WO_L), T, D, D}; pg8::StaticOrder S; S.init(T, D, D, F.G, (int)blockIdx.x);
            pg8::EpiResid E{(bf16*)(F.ws + WS_HB), (unsigned char*)F.XN, F.in[I_N2G] + l * D, F.lds + 3 * pg8::HTB};
            pg8::gemm_phase<pg8::EpiResid, pg8::StaticOrder, true>(F.lds, g, S, E);
        }
        SEAM(pb + 5);
        if (IN(pb + 6)) { PHASE_LANE();
            unsigned* cnt = F.ctl + CW_CNT + 64 * l;
            const int lane = F.lane, fr = lane & 15, fq = lane >> 4;
            const int kh = F.wave & 1, tg = F.wave >> 1;
            LAS float* P = (LAS float*)F.lds;
            const bf16* wrh = (const bf16*)(F.ws + WS_WRH + l * WR_L) + (size_t)fr * 2048 + 8 * fq + 1024 * kh; const bf16* wrl = (const bf16*)(F.ws + WS_WRL + l * WR_L) + (size_t)fr * 2048 + 8 * fq + 1024 * kh;
            for (int unit = F.vcu; unit < T / 128; unit += F.G) {
                const bf16* hrow0 = (const bf16*)(F.ws + WS_HB) + (size_t)(128 * unit + 32 * tg + fr) * D + 8 * fq + 1024 * kh;
                const bf16* hrow1 = hrow0 + (size_t)16 * D;
                f32x4 acc0[6], acc1[6];
#pragma unroll
                for (int nt = 0; nt < 6; ++nt) { acc0[nt] = (f32x4){0.f, 0.f, 0.f, 0.f}; acc1[nt] = (f32x4){0.f, 0.f, 0.f, 0.f}; }
                float ss0 = 0.f, ss1 = 0.f;
#pragma unroll 2
                for (int ks = 0; ks < 32; ++ks) {
                    const v4u hw0 = *(const v4u*)(hrow0 + 32 * ks), hw1 = *(const v4u*)(hrow1 + 32 * ks);
                    { const float a0 = bflo(hw0.x), a1 = bfhi(hw0.x), a2 = bflo(hw0.y), a3 = bfhi(hw0.y), a4 = bflo(hw0.z), a5 = bfhi(hw0.z), a6 = bflo(hw0.w), a7 = bfhi(hw0.w);
                      ss0 += (a0 * a0 + a1 * a1) + (a2 * a2 + a3 * a3) + (a4 * a4 + a5 * a5) + (a6 * a6 + a7 * a7); }
                    { const float a0 = bflo(hw1.x), a1 = bfhi(hw1.x), a2 = bflo(hw1.y), a3 = bfhi(hw1.y), a4 = bflo(hw1.z), a5 = bfhi(hw1.z), a6 = bflo(hw1.w), a7 = bfhi(hw1.w);
                      ss1 += (a0 * a0 + a1 * a1) + (a2 * a2 + a3 * a3) + (a4 * a4 + a5 * a5) + (a6 * a6 + a7 * a7); }
                    const bf16x8_t ah0 = __builtin_bit_cast(bf16x8_t, hw0), ah1 = __builtin_bit_cast(bf16x8_t, hw1);
#pragma unroll
                    for (int nt = 0; nt < 6; ++nt) { const bf16x8_t bh = *(const bf16x8_t*)(wrh + (size_t)(16 * nt) * 2048 + 32 * ks), bl = *(const bf16x8_t*)(wrl + (size_t)(16 * nt) * 2048 + 32 * ks);
                        acc0[nt] = __builtin_amdgcn_mfma_f32_16x16x32_bf16(ah0, bh, acc0[nt], 0, 0, 0);
                        acc0[nt] = __builtin_amdgcn_mfma_f32_16x16x32_bf16(ah0, bl, acc0[nt], 0, 0, 0);
                        acc1[nt] = __builtin_amdgcn_mfma_f32_16x16x32_bf16(ah1, bh, acc1[nt], 0, 0, 0);
                        acc1[nt] = __builtin_amdgcn_mfma_f32_16x16x32_bf16(ah1, bl, acc1[nt], 0, 0, 0); }
                }
                ss0 += __shfl_xor(ss0, 16); ss0 += __shfl_xor(ss0, 32); ss1 += __shfl_xor(ss1, 16); ss1 += __shfl_xor(ss1, 32);
                { LAS float* L0 = P + (kh * 8 + 2 * tg) * 2048; LAS float* L1 = L0 + 2048;
                  if (fq == 0) { L0[1616 + fr] = ss0; L1[1616 + fr] = ss1; }
#pragma unroll
                  for (int nt = 0; nt < 6; ++nt)
#pragma unroll
                      for (int i = 0; i < 4; ++i) { L0[(4 * fq + i) * 100 + 16 * nt + fr] = acc0[nt][i]; L1[(4 * fq + i) * 100 + 16 * nt + fr] = acc1[nt][i]; } }
                __syncthreads();
                const int tile = 8 * unit + F.wave;
                LAS float* LG = P + F.wave * 2048; const LAS float* LH = LG + 8 * 2048;
                for (int idx = lane; idx < 1600; idx += 64) LG[idx] += LH[idx];
                if (lane < 16) { const float ss = LG[1616 + lane] + LH[1616 + lane]; const float rs_ = rsqrtf(ss * (1.0f / 2048.0f) + EPS); LG[1600 + lane] = rs_; ((float*)(F.ws + WS_RSTD))[16 * tile + lane] = rs_; }
                LDS_WAIT(); asm volatile("" ::: "memory");
                if (lane < 16) {
                    const int row = 16 * tile + lane; const float rstd = LG[1600 + lane]; const LAS float* lr = LG + lane * 100;
                    float lg[8]; int grp = 0; float gmax = -3.0e38f;
#pragma unroll
                    for (int e = 0; e < 8; ++e) { lg[e] = lr[e] * rstd + F.in[I_BRG][l * 8 + e]; if (lg[e] > gmax) { gmax = lg[e]; grp = e; } }
                    float gden = 0.f;
#pragma unroll
                    for (int e = 0; e < 8; ++e) gden += __expf(lg[e] - gmax);
                    const float gwt = 1.0f / gden;
                    int i0 = 0, i1 = 0; float m0 = -3.0e38f, m1 = -3.0e38f;
#pragma unroll
                    for (int e = 0; e < 8; ++e) { const float v = lr[8 + grp * 8 + e] * rstd + F.in[I_BRE][l * 64 + grp * 8 + e];
                        if (v > m0) { m1 = m0; i1 = i0; m0 = v; i0 = e; } else if (v > m1) { m1 = v; i1 = e; } }
                    const float e1 = __expf(m1 - m0); const float p0 = 1.0f / (1.0f + e1), p1 = e1 / (1.0f + e1);
                    const int ex0 = grp * 8 + i0, ex1 = grp * 8 + i1;
                    const unsigned r0 = atomicAdd(&cnt[ex0], 1u), r1 = atomicAdd(&cnt[ex1], 1u);
                    unsigned* rec = (unsigned*)(F.ws + WS_ROUTE) + (size_t)row * 8;
                    rec[0] = (unsigned)ex0; rec[1] = r0; rec[2] = (unsigned)ex1; rec[3] = r1; rec[4] = __float_as_uint(gwt * p0); rec[5] = __float_as_uint(gwt * p1);
                    int* liste = (int*)(F.ws + WS_LISTE); liste[(size_t)ex0 * 32768 + r0] = row; liste[(size_t)ex1 * 32768 + r1] = row;
                }
                LDS_WAIT(); asm volatile("" ::: "memory");
                __syncthreads();
            }
        }
        SEAM(pb + 6);
        if (IN(pb + 7) || IN(pb + 8) || IN(pb + 9) || IN(pb + 10)) { PHASE_LANE();
            if (F.tid == 0) { const unsigned* cnt = F.ctl + CW_CNT + 64 * l; LAS int* texp = (LAS int*)(F.misc + MO_TEXP); LAS int* pst = (LAS int*)(F.misc + MO_PST); int tb = 0;
                for (int e = 0; e < NEXP; ++e) { const int c = (int)__hip_atomic_load(&cnt[e], __ATOMIC_RELAXED, __HIP_MEMORY_SCOPE_AGENT); const int nt_ = (c + 255) >> 8; pst[e] = tb * 256; ((LAS int*)(F.misc + MO_CNT))[e] = c;
                    for (int r = 0; r < nt_; ++r) texp[tb + r] = e; tb += nt_; }
                *(LAS int*)(F.misc + MO_TOT) = tb; }
            __syncthreads();
        }
        if (IN(pb + 8)) {
            pg8::Gemm g{F.XN, (const bf16*)(F.ws + WS_W13), 0, 0, D / 2};
            pg8::MoeGatherOrder S; S.total = *(const LAS int*)(F.misc + MO_TOT) * 4; S.G = F.G; S.c = F.vcu; S.NJ = 4; S.nt0 = D / 128; S.tile_exp = (const LAS int*)(F.misc + MO_TEXP);
            S.pst = (const LAS int*)(F.misc + MO_PST); S.cnt = (const LAS int*)(F.misc + MO_CNT); S.liste = (const int*)(F.ws + WS_LISTE);
            pg8::EpiGlu E{F.H, S.tile_exp, S.pst, S.cnt, S.liste, (const float*)(F.ws + WS_RSTD)};
            pg8::gemm_phase<pg8::EpiGlu, pg8::MoeGatherOrder, true, true>(F.lds, g, S, E);
        }
        SEAM(pb + 8);
        if (IN(pb + 9)) {
            pg8::Gemm g{F.H, (const bf16*)(F.ws + WS_W2), 0, 0, DEXP / 2};
            pg8::MoeOrder S{*(const LAS int*)(F.misc + MO_TOT) * 8, F.G, F.vcu, 8, DEXP / 128, (const LAS int*)(F.misc + MO_TEXP)};
            pg8::EpiY E{(unsigned char*)F.Y};
            pg8::gemm_phase<pg8::EpiY, pg8::MoeOrder, true, true>(F.lds, g, S, E);
        }
        SEAM(pb + 9);
        if (IN(pb + 10)) { PHASE_LANE();
            for (int row = F.gw; row < T; row += F.NGW) {
                const unsigned* rec = (const unsigned*)(F.ws + WS_ROUTE) + (size_t)row * 8;
                const float w0 = __uint_as_float(rec[4]) * 0.03125f, w1 = __uint_as_float(rec[5]) * 0.03125f;
                const LAS int* pst = (const LAS int*)(F.misc + MO_PST); const int p0 = pst[rec[0]] + (int)rec[1], p1 = pst[rec[2]] + (int)rec[3];
                const unsigned* y0 = (const unsigned*)((const unsigned char*)F.Y + (size_t)p0 * D) + F.lane; const unsigned* y1 = (const unsigned*)((const unsigned char*)F.Y + (size_t)p1 * D) + F.lane;
                f32x4 v[8];
                { const v2u* hr = (const v2u*)((const bf16*)(F.ws + WS_HB) + (size_t)row * D) + F.lane;
#pragma unroll
                  for (int j = 0; j < 8; ++j) { const v2u w = hr[64 * j]; v[j] = (f32x4){bflo(w.x), bfhi(w.x), bflo(w.y), bfhi(w.y)}; } }
#pragma unroll
                for (int j = 0; j < 8; ++j) { const int a = (int)y0[64 * j], c = (int)y1[64 * j];
                    const auto a01 = __builtin_amdgcn_cvt_pk_f32_fp8(a, false), a23 = __builtin_amdgcn_cvt_pk_f32_fp8(a, true), c01 = __builtin_amdgcn_cvt_pk_f32_fp8(c, false), c23 = __builtin_amdgcn_cvt_pk_f32_fp8(c, true);
                    v[j].x += w0 * a01[0] + w1 * c01[0]; v[j].y += w0 * a01[1] + w1 * c01[1]; v[j].z += w0 * a23[0] + w1 * c23[0]; v[j].w += w0 * a23[1] + w1 * c23[1]; }
                if (l + 1 < DEPTH) { v2u* hw_ = (v2u*)((bf16*)(F.ws + WS_HB) + (size_t)row * D) + F.lane;
#pragma unroll
                    for (int j = 0; j < 8; ++j) hw_[64 * j] = (v2u){pg8::cvt_pk_bf16(v[j].x, v[j].y), pg8::cvt_pk_bf16(v[j].z, v[j].w)}; }
                else { f32x4* orow = (f32x4*)(F.out + (size_t)row * D) + F.lane;
#pragma unroll
                    for (int j = 0; j < 8; ++j) orow[64 * j] = v[j]; }
                if (l + 1 < DEPTH) { const float rstd = row_rstd(v); if (F.lane == 0) ((float*)(F.ws + WS_RSTD1))[row] = rstd; norm_store_fp8(v, rstd, F.in[I_N1G] + (l + 1) * D, (unsigned char*)(F.ws + WS_XN8) + (size_t)row * D, F.lane); }
            }
        }
        SEAM(pb + 10);
    }
__global__ void __launch_bounds__(NWAVES * 64, 2) fwd_kernel(Args args) {
    extern __shared__ __attribute__((aligned(16))) unsigned char lds_raw[];
    Frame F;
    F.lds = (LAS unsigned char*)lds_raw; F.misc = F.lds + MISC_OFF;
    F.tid = threadIdx.x; F.lane = F.tid & 63; F.wave = __builtin_amdgcn_readfirstlane(F.tid >> 6);
    F.G = gridDim.x; { const int bx = blockIdx.x; F.vcu = (F.G % 8 == 0) ? (bx % 8) * (F.G / 8) + bx / 8 : bx; }
    F.gw = F.vcu * NWAVES + F.wave; F.NGW = F.G * NWAVES;
    F.in = args.in; F.out = args.out; F.ws = args.ws; F.ctl = (unsigned*)(args.ws + WS_CTL);
    F.Z = (bf16*)(args.ws + WS_Z); F.XN = (bf16*)(args.ws + WS_XN); F.OCAT = (bf16*)(args.ws + WS_OCAT); F.MERGED = (bf16*)(args.ws + WS_MERGED);
    F.XS = (bf16*)(args.ws + WS_XS); F.Y = (bf16*)(args.ws + WS_Y); F.H = (bf16*)(args.ws + WS_H);
    F.S = (float*)(args.ws + WS_S); F.GO = (float*)(args.ws + WS_GO); F.MASK = (unsigned*)(args.ws + WS_MASK);
    const int lo = args.ph_lo, hi = args.ph_hi;
    const bool use_bar = (hi - lo) > 1;
    for (int u = F.tid; u < 64; u += NWAVES * 64) ((LAS unsigned*)F.misc)[u] = 0u;
    ((LAS unsigned long long*)(F.misc + MO_SS))[F.tid] = 0ull;
    for (int i = F.tid; i < 2 * 4 * 128; i += NWAVES * 64) { const int l_ = i >> 9, k_ = (i >> 7) & 3, d_ = i & 127; ((LAS float*)(F.misc + MO_GN))[i] = F.in[k_ == 0 ? I_AQG : (k_ == 1 ? I_AKG : (k_ == 2 ? I_BQG : I_BKG))][l_ * 128 + d_]; }
    for (int i = F.tid; i < 12 * 129; i += NWAVES * 64) { const int hd = i / 129, dd = i % 129; int bk;
        if (dd < 16) bk = dd; else { bk = 16 + (int)(logf((float)dd / 16.0f) / 2.0794415416798357f * 16.0f); bk = bk > 31 ? 31 : bk; }
        ((LAS float*)(F.misc + MO_TAB2))[i] = F.in[I_RELB][bk * 12 + hd] * 1.4426950408889634f; }
    __syncthreads();
    XcdBarrier bar; bar.bar = F.ctl + CW_BAR; bar.x = 0; bar.st = nullptr;
    if (use_bar) bar = xcd_barrier_post(F.ctl + CW_BAR, (volatile LAS unsigned*)(F.misc + MO_BARW));

    if (IN(0)) { PHASE_LANE();
        LAS float* scr = (LAS float*)(F.lds + F.wave * 16384);
        constexpr int I_IN = (2048 / 64) * (D_IN / 32);
        constexpr int I_BA = (512 / 64) * (2048 / 32), I_BB = (1024 / 64) * (2048 / 32), I_BC = I_BA, I_O = (2048 / 64) * (2048 / 32);
        constexpr int PER_L = I_IN + I_BA + I_BB + I_BC + I_O;
        for (int it = F.gw; it < DEPTH * PER_L; it += F.NGW) {
            const int l = it / PER_L; int r = it % PER_L;
            bf16* win = (bf16*)(F.ws + WS_WIN + l * WIN_L); bf16* wbr = (bf16*)(F.ws + WS_WBR + l * WBR_L); bf16* wo = (bf16*)(F.ws + WS_WO + l * WO_L);
            if (r < I_IN) { const int nb_ = r % (D_IN / 32);
                const bool has8 = nb_ < 56 || (nb_ >= 58 && nb_ <= 106) || nb_ >= 122, hasb = (nb_ >= 56 && nb_ <= 58) || (nb_ >= 106 && nb_ <= 122) || nb_ == 138;
                if (has8) transpose_item_fp8(F.in[I_WIN] + (size_t)l * 2048 * D_IN, D_IN, (unsigned char*)win, 2048, 64.0f, scr, r, F.lane, MapWin8{});
                if (hasb) transpose_item(F.in[I_WIN] + (size_t)l * 2048 * D_IN, D_IN, win + (size_t)12 * 1024 * 1024, 2048, 0, scr, r, F.lane, MapWinB{}, F.in[I_N1G] + l * D);
                continue; } r -= I_IN;
            if (r < I_BA) { transpose_item(F.in[I_WBA] + (size_t)l * 512 * 2048, 2048, wbr, 2048, 0, scr, r, F.lane, MapId{0}); continue; } r -= I_BA;
            if (r < I_BB) { transpose_item(F.in[I_WBB] + (size_t)l * 1024 * 2048, 2048, wbr, 2048, 512, scr, r, F.lane, MapId{0}); continue; } r -= I_BB;
            if (r < I_BC) { transpose_item(F.in[I_WBC] + (size_t)l * 512 * 2048, 2048, wbr, 2048, 1536, scr, r, F.lane, MapId{0}); continue; } r -= I_BC;
            transpose_item(F.in[I_WO] + (size_t)l * 2048 * 2048, 2048, wo, 2048, 0, scr, r, F.lane, MapId{0});
        }
        for (int i = F.gw * 64 + F.lane; i < DEPTH * 160 * 256; i += F.NGW * 64) { const int l = i / (160 * 256), r = (i / 256) % 160, c = i % 256;
            *(v4u*)((bf16*)(F.ws + WS_WIN + l * WIN_L) + (size_t)12 * 1024 * 1024 + (size_t)(ZC_PAD - 3328 + r) * 2048 + 8 * c) = (v4u){0u, 0u, 0u, 0u}; }
        for (int i = F.gw * 64 + F.lane; i < DEPTH * 96 * 2048; i += F.NGW * 64) { const int l = i / (96 * 2048), e = (i / 2048) % 96, k = i % 2048;
            float val = 0.f; if (e < 8) val = F.in[I_WRG][(size_t)l * D * 8 + (size_t)k * 8 + e]; else if (e < 72) val = F.in[I_WRE][(size_t)l * D * 64 + (size_t)k * 64 + (e - 8)];
            val *= F.in[I_N2G][l * D + k];
            const unsigned hi = f2bf(val); const float rem = val - bf1((bf16)hi);
            ((bf16*)(F.ws + WS_WRH + l * WR_L))[e * 2048 + k] = (bf16)hi; ((bf16*)(F.ws + WS_WRL + l * WR_L))[e * 2048 + k] = (bf16)f2bf(rem); }
        for (int mrow = F.gw; mrow < T; mrow += F.NGW) { f32x4 v[8]; load_row(F.in[I_X] + (size_t)mrow * D, F.lane, v); const float rstd = row_rstd(v);
            { v2u* hw_ = (v2u*)((bf16*)(F.ws + WS_HB) + (size_t)mrow * D) + F.lane;
#pragma unroll
              for (int j = 0; j < 8; ++j) hw_[64 * j] = (v2u){pg8::cvt_pk_bf16(v[j].x, v[j].y), pg8::cvt_pk_bf16(v[j].z, v[j].w)}; }
            if (F.lane == 0) ((float*)(F.ws + WS_RSTD1))[mrow] = rstd;
            norm_store_fp8(v, rstd, F.in[I_N1G], (unsigned char*)(F.ws + WS_XN8) + (size_t)mrow * D, F.lane); }
    }
    SEAM(0);

    layer_body<0>(F, bar, lo, hi);
    layer_body<1>(F, bar, lo, hi);
}


#ifndef N_LAUNCH_MODE
#define N_LAUNCH_MODE 1
#endif
extern "C" void kernel_launch(void* const* d_in, const int* in_sizes, int n_in, void* d_out, int out_size, void* d_ws, size_t ws_size, hipStream_t stream) {
    static int grid = 0;
    if (grid == 0) {
        if (n_in != 24 || out_size != T * D || ws_size < WS_END) { fprintf(stderr, "kernel_launch: unexpected shapes (n_in %d out %d ws %zu)\n", n_in, out_size, ws_size); grid = -1; return; }
        int dev = 0, cus = 0, per_cu = 0;
        if (hipGetDevice(&dev) != hipSuccess || hipDeviceGetAttribute(&cus, hipDeviceAttributeMultiprocessorCount, dev) != hipSuccess) { grid = -1; return; }
        if (hipFuncSetAttribute((const void*)fwd_kernel, hipFuncAttributeMaxDynamicSharedMemorySize, LDS_BYTES) != hipSuccess) { fprintf(stderr, "kernel_launch: hipFuncSetAttribute failed\n"); grid = -1; return; }
        if (hipOccupancyMaxActiveBlocksPerMultiprocessor(&per_cu, (const void*)fwd_kernel, NWAVES * 64, LDS_BYTES) != hipSuccess || per_cu < 1) { fprintf(stderr, "kernel_launch: occupancy query says %d\n", per_cu); }
        (void)hipGetLastError();
        grid = cus;
    }
    if (grid < 0) return;
    (void)hipMemsetAsync((char*)d_ws + WS_CTL, 0, CTL_ZERO_BYTES, stream);
    Args a{};
    for (int i = 0; i < 24; ++i) a.in[i] = (const float*)d_in[i];
    a.out = (float*)d_out; a.ws = (unsigned char*)d_ws;
    constexpr int NPH = 1 + 11 * DEPTH;
#if N_LAUNCH_MODE == 1
    a.ph_lo = 0; a.ph_hi = NPH;
    hipLaunchKernelGGL(fwd_kernel, dim3(grid), dim3(NWAVES * 64), LDS_BYTES, stream, a);
#else
    for (int p = 0; p < NPH; ++p) { a.ph_lo = p; a.ph_hi = p + 1; hipLaunchKernelGGL(fwd_kernel, dim3(grid), dim3(NWAVES * 64), LDS_BYTES, stream, a); }
#endif
    const hipError_t le = hipPeekAtLastError();
    if (le != hipSuccess) fprintf(stderr, "kernel_launch: launch failed: %s\n", hipGetErrorName(le));
}
```

```cpp
#include <hip/hip_runtime.h>
#include <cstdio>
#include <cstdint>

__device__ __forceinline__ int lane_id() { return (int)__builtin_amdgcn_mbcnt_hi(~0u, __builtin_amdgcn_mbcnt_lo(~0u, 0u)); }
namespace pg8 {
#define PG8_LAS __attribute__((address_space(3)))
typedef unsigned short bf16_t;
typedef short bf16x8 __attribute__((ext_vector_type(8)));
typedef float f32x4 __attribute__((ext_vector_type(4)));
typedef unsigned u32x4 __attribute__((ext_vector_type(4)));
typedef unsigned u32x2 __attribute__((ext_vector_type(2)));
constexpr int BM = 256, BK = 64, HALF = 128, HTB = HALF * BK * 2  , STAGE_BYTES = 8 * HTB, NXCD = 8, WGM = 8;

__host__ __device__ __forceinline__ int lds_byte(int r, int c) { const int st = (r >> 4) * 2 + (c >> 5), rr = r & 15, cc = c & 31, ob = rr * 64 + cc * 2; return st * 1024 + (ob ^ (((ob >> 9) & 1) << 5)); }
__host__ __device__ __forceinline__ void stage_rc(int b, int& R, int& C) { const int st = b / 1024, sb = b % 1024, swz = sb ^ (((sb >> 9) & 1) << 5); R = (st >> 1) * 16 + swz / 64; C = (st & 1) * 32 + (swz % 64) / 2; }
__host__ __device__ __forceinline__ int perm32(int rho) { const int n = rho >> 4, i = rho & 15; return 8 * (i >> 2) + 4 * n + (i & 3); }

struct Unit { int pm, pn, koff, nt, seg; };
struct Gemm { const bf16_t* A; const bf16_t* Bt; int M, N, K; };

struct StaticOrder {
    static constexpr bool GATHER = false;
    int nM, nN, nwg, G, c, nt0;
    __device__ __forceinline__ int row_token(const Unit&, int) const { return 0; }
    __device__ void init(int M, int N, int K, int G_, int c_) { nM = M / BM; nN = N / BM; nwg = nM * nN; G = G_; c = c_; nt0 = K / BK; }
    __device__ bool tile(long L, Unit& u) const {
        if (L >= nwg) return false;
        int wgid = (int)L; { const int q = nwg / NXCD, r = nwg % NXCD, xcd = wgid % NXCD, off = wgid / NXCD; wgid = (xcd < r ? xcd * (q + 1) : r * (q + 1) + (xcd - r) * q) + off; }
        const int nig = WGM * nN, gid = wgid / nig, fm = gid * WGM, gsz = (nM - fm) < WGM ? (nM - fm) : WGM;
        u.pm = fm + ((wgid % nig) % gsz); u.pn = (wgid % nig) / gsz; return true;
    }
    __device__ bool next(int i, Unit& u) const { u.koff = 0; u.nt = nt0; u.seg = 0; return tile((long)i * G + c, u); }
    __device__ __forceinline__ void a_ready(const Unit&) const {}
    __device__ __forceinline__ void done(const Unit&) const {}
};
struct MergeOrder : StaticOrder {
    __device__ bool next(int i, Unit& u) const { const int rnd = i / 3, sg = i - 3 * rnd; u.seg = sg; u.koff = sg == 0 ? 0 : (sg == 1 ? 512 : 1536); u.nt = sg == 1 ? 16 : 8; return tile((long)rnd * G + c, u); }
};
struct MoeOrder {
    static constexpr bool GATHER = false;
    int total, G, c, NJ, nt0; const PG8_LAS int* tile_exp;
    __device__ bool next(int i, Unit& u) const {
        const long L = (long)i * G + c; if (L >= total) return false;
        const int R = (int)L / NJ, j = (int)L % NJ; u.pm = R; u.pn = tile_exp[R] * NJ + j; u.koff = 0; u.nt = nt0; u.seg = 0; return true;
    }
    __device__ __forceinline__ int row_token(const Unit&, int) const { return 0; }
    __device__ __forceinline__ void a_ready(const Unit&) const {}
    __device__ __forceinline__ void done(const Unit&) const {}
};
struct MoeGatherOrder : MoeOrder {
    static constexpr bool GATHER = true;
    const PG8_LAS int* pst; const PG8_LAS int* cnt; const int* liste;
    __device__ __forceinline__ int row_token(const Unit& u, int r) const {
        const int e = tile_exp[u.pm], lr = u.pm * 256 - pst[e] + r;
        return lr < cnt[e] ? liste[(size_t)e * 32768 + lr] : 0;
    }
};

typedef __bf16 bf16x2v __attribute__((ext_vector_type(2)));
typedef float f32x2v __attribute__((ext_vector_type(2)));
__device__ __forceinline__ unsigned cvt_pk_bf16(float lo, float hi) { const f32x2v v = {lo, hi}; const bf16x2v b = __builtin_convertvector(v, bf16x2v); return __builtin_bit_cast(unsigned, b); }
__device__ __forceinline__ float bflo(unsigned w) { return __uint_as_float(w << 16); }
__device__ __forceinline__ float bfhi(unsigned w) { return __uint_as_float(w & 0xffff0000u); }
__device__ __forceinline__ float sigm(float v) { return __builtin_amdgcn_rcpf(1.0f + __builtin_amdgcn_exp2f(-1.44269504f * v)); }
__device__ __forceinline__ unsigned q8x4(const f32x4 s) {
    const unsigned a = (unsigned)fminf(s[0], 255.5f), b = (unsigned)fminf(s[1], 255.5f), c = (unsigned)fminf(s[2], 255.5f), d = (unsigned)fminf(s[3], 255.5f);
    return a | (b << 8) | (c << 16) | (d << 24);
}

constexpr int ZP = 5120;
constexpr int ZC_GA = 5120, ZC_GB = 7168, ZC_GC = 9216;
constexpr size_t GT_TILE = 65536, GT_GATE = (size_t)128 * 8 * GT_TILE;

template <int PN_OFF> struct EpiInProj {
    static constexpr bool PERM = true, AFTER_DRAIN = false, CHAIN = false;
    bf16_t* O; unsigned char* GT; PG8_LAS unsigned long long* ss;
    const PG8_LAS float* gains;
    const float* rstd;
    __device__ __forceinline__ void operator()(const f32x4 (&acc)[2][2][4][2], const Unit& u, int wr, int wc, int fr, int fq) const {
        const int pn = PN_OFF ? u.pn + 13 : (u.pn < 13 ? u.pn : u.pn + 3);
        int row0 = u.pm * BM + wr * 64 + fr, col0 = pn * BM + wc * 32 + 8 * fq;
        asm volatile("" : "+v"(row0), "+v"(col0));
        const int act = pn >= 20 ? 2 : (pn >= 18 ? 1 : 0);
        const bool hn = PN_OFF == 0 && pn <= 7;
        f32x4 gn0 = (f32x4){1.f, 1.f, 1.f, 1.f}, gn1 = gn0; int lr = 0;
        if (hn) {
            lr = wr * 64 + fr; asm volatile("" : "+v"(lr));
#pragma unroll
            for (int ai = 0; ai < 2; ++ai)
#pragma unroll
                for (int m = 0; m < 4; ++m)
#pragma unroll
                    for (int bj = 0; bj < 2; ++bj) { const f32x4 a = acc[ai][bj][m][0], b = acc[ai][bj][m][1];
                        float s = (a[0] * a[0] + a[1] * a[1]) + (a[2] * a[2] + a[3] * a[3]) + (b[0] * b[0] + b[1] * b[1]) + (b[2] * b[2] + b[3] * b[3]);
                        s += __shfl_xor(s, 16); s += __shfl_xor(s, 32);
                        if (fq == 0) __hip_atomic_fetch_add(ss + (ai * HALF + m * 16 + lr) * 2 + bj, (unsigned long long)(s * 1048576.0f), __ATOMIC_RELAXED, __HIP_MEMORY_SCOPE_WORKGROUP); }
            asm volatile("s_waitcnt lgkmcnt(0)" ::: "memory"); __builtin_amdgcn_s_barrier(); asm volatile("" ::: "memory");
            const PG8_LAS float* gp = gains + (pn <= 1 ? 0 : (pn == 2 ? 128 : (pn <= 6 ? 256 : 384))) + wc * 32 + 8 * fq;
            gn0 = *(const PG8_LAS f32x4*)gp; gn1 = *(const PG8_LAS f32x4*)(gp + 4);
        }
        if (act == 2) {
            int lo16 = (wr * 4 + wc) * 8192 + (fq * 16 + fr) * 16; asm volatile("" : "+v"(lo16));
            unsigned char* gp = GT + (size_t)((pn - 20) >> 3) * GT_GATE + ((size_t)u.pm * 8 + ((pn - 20) & 7)) * GT_TILE + lo16;
#pragma unroll
            for (int ai = 0; ai < 2; ++ai)
#pragma unroll
                for (int m = 0; m < 4; ++m) { u32x4 w;
#pragma unroll
                    for (int bj = 0; bj < 2; ++bj) { const f32x4 v0 = acc[ai][bj][m][0] * (-1.44269504f * 0.015625f), v1 = acc[ai][bj][m][1] * (-1.44269504f * 0.015625f); f32x4 s0, s1;
#pragma unroll
                        for (int j = 0; j < 4; ++j) { s0[j] = __builtin_amdgcn_exp2f(v0[j]); s1[j] = __builtin_amdgcn_exp2f(v1[j]); }
                        s0 = s0 * 0.00390625f + 0.00390625f; s1 = s1 * 0.00390625f + 0.00390625f;
#pragma unroll
                        for (int j = 0; j < 4; ++j) { s0[j] = __builtin_amdgcn_rcpf(s0[j]); s1[j] = __builtin_amdgcn_rcpf(s1[j]); }
                        w[2 * bj] = q8x4(s0); w[2 * bj + 1] = q8x4(s1); }
                    *(u32x4*)(gp + (ai * 4 + m) * 1024) = w; }
            return;
        }
#pragma unroll
        for (int ai = 0; ai < 2; ++ai)
#pragma unroll
            for (int m = 0; m < 4; ++m) { bf16_t* rowp = O + (size_t)(row0 + ai * HALF + m * 16) * ZP + col0; const float rs = PN_OFF ? rstd[row0 + ai * HALF + m * 16] : 1.0f;
#pragma unroll
                for (int bj = 0; bj < 2; ++bj) { f32x4 v0 = acc[ai][bj][m][0], v1 = acc[ai][bj][m][1];
                    if (hn && !(pn == 2 && bj == 1)) { const float r = rsqrtf((float)ss[(ai * HALF + m * 16 + lr) * 2 + bj] * (0.015625f * 0.015625f / 128.0f / 1048576.0f) + 1e-6f) * 0.015625f;
                        v0 = v0 * r * gn0; v1 = v1 * r * gn1; }
                    else if (PN_OFF == 0) { v0 = v0 * 0.015625f; v1 = v1 * 0.015625f; }
                    else { v0 = v0 * rs; v1 = v1 * rs; }
                    if (act) {
#pragma unroll
                        for (int j = 0; j < 4; ++j) { v0[j] *= sigm(v0[j]); v1[j] *= sigm(v1[j]); } }
                    u32x4 w; w.x = cvt_pk_bf16(v0[0], v0[1]); w.y = cvt_pk_bf16(v0[2], v0[3]); w.z = cvt_pk_bf16(v1[0], v1[1]); w.w = cvt_pk_bf16(v1[2], v1[3]);
                    *(u32x4*)(rowp + bj * HALF) = w; } }
        if (hn) { asm volatile("s_waitcnt lgkmcnt(0)" ::: "memory"); __builtin_amdgcn_s_barrier(); asm volatile("" ::: "memory");
            ss[(wr * 4 + wc) * 64 + fq * 16 + fr] = 0ull; }
    }
};
template <int MODE = 0> struct EpiMergeT {
    static constexpr bool PERM = true, AFTER_DRAIN = false, CHAIN = true;
    const unsigned char* GT; bf16_t* O;
    __device__ __forceinline__ void operator()(f32x4 (&acc)[2][2][4][2], const Unit& u, int wr, int wc, int fr, int fq) const {
        if (MODE == 2) return;
        const int row0 = u.pm * BM + wr * 64 + fr, col0 = u.pn * BM + wc * 32 + 8 * fq;
        int lo16 = (wr * 4 + wc) * 8192 + (fq * 16 + fr) * 16; asm volatile("" : "+v"(lo16));
        const unsigned char* gp = GT + ((size_t)u.pm * 8 + u.pn) * GT_TILE + lo16;
        const size_t cn = (size_t)u.seg * GT_GATE, cd = (size_t)(u.seg == 0 ? 1 : 2) * GT_GATE;
        const bool fin = u.seg == 2;
        u32x4 gn[2][4], gd[2][4];
#pragma unroll
        for (int ai = 0; ai < 2; ++ai)
#pragma unroll
            for (int m = 0; m < 4; ++m) {
                if (MODE == 1) { gn[ai][m] = (u32x4){0x80808080u + (unsigned)u.pm, 0x80808080u, 0x80808080u, 0x80808080u}; gd[ai][m] = gn[ai][m]; } else {
                gn[ai][m] = *(const u32x4*)(gp + cn + (ai * 4 + m) * 1024); gd[ai][m] = *(const u32x4*)(gp + cd + (ai * 4 + m) * 1024); } }
#pragma unroll
        for (int ai = 0; ai < 2; ++ai)
#pragma unroll
            for (int m = 0; m < 4; ++m)
#pragma unroll
                for (int bj = 0; bj < 2; ++bj) { const size_t r = (size_t)(row0 + ai * HALF + m * 16);
#pragma unroll
                    for (int w = 0; w < 2; ++w)
#pragma unroll
                        for (int k = 0; k < 4; ++k) { const float qn = (float)((gn[ai][m][2 * bj + w] >> (8 * k)) & 0xffu) + 0.5f, qd = (float)((gd[ai][m][2 * bj + w] >> (8 * k)) & 0xffu) + 0.5f;
                            acc[ai][bj][m][w][k] *= qn * __builtin_amdgcn_rcpf(fin ? 256.0f : qd); }
                    if (fin) { const f32x4 v0 = acc[ai][bj][m][0], v1 = acc[ai][bj][m][1];
                        u32x4 w; w.x = cvt_pk_bf16(v0[0], v0[1]); w.y = cvt_pk_bf16(v0[2], v0[3]); w.z = cvt_pk_bf16(v1[0], v1[1]); w.w = cvt_pk_bf16(v1[2], v1[3]);
                        *(u32x4*)(O + r * 2048 + col0 + bj * HALF) = w; } }
    }
};
typedef EpiMergeT<0> EpiMerge;
struct EpiResid {
    static constexpr int PERM = 2; static constexpr bool AFTER_DRAIN = false, CHAIN = false;
    bf16_t* hb; unsigned char* xu; const float* gain; PG8_LAS unsigned char* stg;
    __device__ __forceinline__ void operator()(const f32x4 (&acc)[2][2][4][2], const Unit& u, int wr, int wc, int fr, int fq) const {
        int lane = fq * 16 + fr; asm volatile("" : "+v"(lane));
        PG8_LAS unsigned char* s0 = stg + (wr * 4 + wc) * 1024;
        const int r8 = lane >> 3, pc = lane & 7;
        const int offc = r8 * 128 + ((pc ^ r8) << 4);
        const int offa0 = (fr >> 3) * 8192 + (fr & 7) * 128 + ((fq ^ (fr & 7)) << 4), offa1 = (fr >> 3) * 8192 + (fr & 7) * 128 + (((4 + fq) ^ (fr & 7)) << 4);
        const int xs = 2 * (fr >> 2), offxw0 = fr * 64 + ((fq ^ xs) << 3), offxw1 = fr * 64 + (((4 + fq) ^ xs) << 3);
        const int xr = lane >> 2, xq = lane & 3, offxr = xr * 64 + (((2 * xq) ^ (2 * (xr >> 2))) << 3);
        const size_t goff = (size_t)(u.pm * BM + wr * 64 + r8) * 2048 + u.pn * BM + wc * 64 + pc * 8;
        const size_t xoff = (size_t)(u.pm * BM + wr * 64 + xr) * 2048 + u.pn * BM + wc * 64 + xq * 16;
        f32x4 gv[2][2];
#pragma unroll
        for (int bj = 0; bj < 2; ++bj)
#pragma unroll
            for (int n = 0; n < 2; ++n) gv[bj][n] = *(const f32x4*)(gain + u.pn * BM + wc * 64 + bj * 32 + 8 * fq + 4 * n);
        const f32x4 lo4 = (f32x4){-440.f, -440.f, -440.f, -440.f}, hi4 = (f32x4){440.f, 440.f, 440.f, 440.f};
#pragma unroll
        for (int ai = 0; ai < 2; ++ai) {
            u32x4 bb[4][2];
#pragma unroll
            for (int m = 0; m < 4; ++m)
#pragma unroll
                for (int j = 0; j < 2; ++j) bb[m][j] = *(const u32x4*)(hb + goff + (size_t)(ai * HALF + m * 16 + 8 * j) * 2048);
#pragma unroll
            for (int m = 0; m < 4; ++m) {
                *(PG8_LAS u32x4*)(s0 + offc) = bb[m][0]; *(PG8_LAS u32x4*)(s0 + 8192 + offc) = bb[m][1];
                asm volatile("" ::: "memory");
                const u32x4 a0 = *(const PG8_LAS u32x4*)(s0 + offa0), a1 = *(const PG8_LAS u32x4*)(s0 + offa1);
                asm volatile("" ::: "memory");
                u32x2 xw[2];
#pragma unroll
                for (int bj = 0; bj < 2; ++bj) { const u32x4 w = bj ? a1 : a0;
                    const f32x4 h0 = (f32x4){bflo(w.x), bfhi(w.x), bflo(w.y), bfhi(w.y)} + acc[ai][bj][m][0], h1 = (f32x4){bflo(w.z), bfhi(w.z), bflo(w.w), bfhi(w.w)} + acc[ai][bj][m][1];
                    u32x4 hw; hw.x = cvt_pk_bf16(h0[0], h0[1]); hw.y = cvt_pk_bf16(h0[2], h0[3]); hw.z = cvt_pk_bf16(h1[0], h1[1]); hw.w = cvt_pk_bf16(h1[2], h1[3]);
                    *(PG8_LAS u32x4*)(s0 + (bj ? offa1 : offa0)) = hw;
                    const f32x4 x0 = __builtin_elementwise_min(__builtin_elementwise_max(h0 * gv[bj][0], lo4), hi4), x1 = __builtin_elementwise_min(__builtin_elementwise_max(h1 * gv[bj][1], lo4), hi4);
                    int w0 = 0, w1 = 0;
                    w0 = __builtin_amdgcn_cvt_pk_fp8_f32(x0[0], x0[1], w0, false); w0 = __builtin_amdgcn_cvt_pk_fp8_f32(x0[2], x0[3], w0, true);
                    w1 = __builtin_amdgcn_cvt_pk_fp8_f32(x1[0], x1[1], w1, false); w1 = __builtin_amdgcn_cvt_pk_fp8_f32(x1[2], x1[3], w1, true);
                    xw[bj] = (u32x2){(unsigned)w0, (unsigned)w1}; }
                asm volatile("" ::: "memory");
                const u32x4 o0 = *(const PG8_LAS u32x4*)(s0 + offc), o1 = *(const PG8_LAS u32x4*)(s0 + 8192 + offc);
                asm volatile("" ::: "memory");
                *(PG8_LAS u32x2*)(s0 + offxw0) = xw[0]; *(PG8_LAS u32x2*)(s0 + offxw1) = xw[1];
                asm volatile("" ::: "memory");
                const u32x4 xo = *(const PG8_LAS u32x4*)(s0 + offxr);
                asm volatile("" ::: "memory");
                *(u32x4*)(hb + goff + (size_t)(ai * HALF + m * 16) * 2048) = o0; *(u32x4*)(hb + goff + (size_t)(ai * HALF + m * 16 + 8) * 2048) = o1;
                *(u32x4*)(xu + xoff + (size_t)(ai * HALF + m * 16) * 2048) = xo;
            }
        }
        asm volatile("s_waitcnt lgkmcnt(0)" ::: "memory");
    }
};
struct EpiGlu {
    static constexpr bool PERM = false, AFTER_DRAIN = false, CHAIN = false;
    bf16_t* H; const PG8_LAS int* tile_exp; const PG8_LAS int* pst; const PG8_LAS int* cnt; const int* liste; const float* rstd;
    __device__ __forceinline__ void operator()(const f32x4 (&acc)[2][2][4][2], const Unit& u, int wr, int wc, int fr, int fq) const {
        const int row0 = u.pm * BM + wr * 64 + fr, pj = u.pn & 3;
        const int e = tile_exp[u.pm], lr0 = u.pm * 256 - pst[e] + wr * 64 + fr, ce = cnt[e];
        int tok[2][4]; float rs[2][4];
#pragma unroll
        for (int ai = 0; ai < 2; ++ai)
#pragma unroll
            for (int m = 0; m < 4; ++m) { const int lr = lr0 + ai * HALF + m * 16; tok[ai][m] = lr < ce ? liste[(size_t)e * 32768 + lr] : 0; }
#pragma unroll
        for (int ai = 0; ai < 2; ++ai)
#pragma unroll
            for (int m = 0; m < 4; ++m) rs[ai][m] = rstd[tok[ai][m]] * 0.015625f;
#pragma unroll
        for (int ai = 0; ai < 2; ++ai)
#pragma unroll
            for (int m = 0; m < 4; ++m) { unsigned char* rowp = (unsigned char*)H + (size_t)(row0 + ai * HALF + m * 16) * 512; const float r = rs[ai][m];
#pragma unroll
                for (int bj = 0; bj < 2; ++bj) { const f32x4 a = acc[ai][bj][m][0] * r, b = acc[ai][bj][m][1] * r;
                    const int hc = 16 * (8 * pj + 4 * bj + wc) + 4 * fq;
                    float hv[4];
#pragma unroll
                    for (int j = 0; j < 4; ++j) hv[j] = fminf(fmaxf(a[j] * sigm(a[j]) * b[j] * 8.0f, -440.0f), 440.0f);
                    int w = 0; w = __builtin_amdgcn_cvt_pk_fp8_f32(hv[0], hv[1], w, false); w = __builtin_amdgcn_cvt_pk_fp8_f32(hv[2], hv[3], w, true);
                    *(int*)(rowp + hc) = w; } }
    }
};
struct EpiY {
    static constexpr bool PERM = true, AFTER_DRAIN = false, CHAIN = false;
    unsigned char* Y;
    __device__ __forceinline__ void operator()(const f32x4 (&acc)[2][2][4][2], const Unit& u, int wr, int wc, int fr, int fq) const {
        const int row0 = u.pm * BM + wr * 64 + fr, col0 = (u.pn & 7) * BM + wc * 32 + 8 * fq;
        const f32x4 lo4 = (f32x4){-440.f, -440.f, -440.f, -440.f}, hi4 = (f32x4){440.f, 440.f, 440.f, 440.f};
#pragma unroll
        for (int ai = 0; ai < 2; ++ai)
#pragma unroll
            for (int m = 0; m < 4; ++m) { unsigned char* rowp = Y + (size_t)(row0 + ai * HALF + m * 16) * 2048 + col0;
#pragma unroll
                for (int bj = 0; bj < 2; ++bj) {
                    const f32x4 v0 = __builtin_elementwise_min(__builtin_elementwise_max(acc[ai][bj][m][0] * 0.125f, lo4), hi4), v1 = __builtin_elementwise_min(__builtin_elementwise_max(acc[ai][bj][m][1] * 0.125f, lo4), hi4);
                    int w0 = 0, w1 = 0;
                    w0 = __builtin_amdgcn_cvt_pk_fp8_f32(v0[0], v0[1], w0, false); w0 = __builtin_amdgcn_cvt_pk_fp8_f32(v0[2], v0[3], w0, true);
                    w1 = __builtin_amdgcn_cvt_pk_fp8_f32(v1[0], v1[1], w1, false); w1 = __builtin_amdgcn_cvt_pk_fp8_f32(v1[2], v1[3], w1, true);
                    *(u32x2*)(rowp + bj * HALF) = (u32x2){(unsigned)w0, (unsigned)w1}; } }
    }
};

typedef int v4i_t __attribute__((ext_vector_type(4)));
typedef int v8i_t __attribute__((ext_vector_type(8)));
template <class Epi, class Sched, bool ALIGN_EPI = false, bool FP8 = false>
__device__ __forceinline__ void gemm_phase(PG8_LAS unsigned char* lds, const Gemm g, const Sched& S, const Epi& E) {
    int tid = threadIdx.x; asm volatile("" : "+v"(tid));
    const int wid = __builtin_amdgcn_readfirstlane(tid >> 6), lane = tid & 63, wr = wid >> 2, wc = wid & 3, fr = lane & 15, fq = lane >> 4;
    const int K = g.K;
    unsigned voffA[2], voffB[2]; int RA[2]; unsigned CA2[2];
#pragma unroll
    for (int i = 0; i < 2; ++i) { int R, C; stage_rc(tid * 16 + i * 8192, R, C); const int Rb = Epi::PERM == 2 ? ((R >> 5) * 64 + perm32(R & 31)) : (Epi::PERM ? ((R & ~31) + perm32(R & 31)) : R);
        voffA[i] = (unsigned)(R * K + C) * 2u; voffB[i] = (unsigned)(Rb * K + C) * 2u; RA[i] = R; CA2[i] = (unsigned)C * 2u; }
    unsigned gAc[2][2], gAn[2][2];
#define PG8_GOFF(dst, uu) do { _Pragma("unroll") for (int h_ = 0; h_ < 2; ++h_) _Pragma("unroll") for (int i_ = 0; i_ < 2; ++i_) dst[h_][i_] = (unsigned)S.row_token(uu, 128 * h_ + RA[i_]) * (unsigned)(K * 2) + CA2[i_]; } while (0)
#define PG8_STAGE_A(bufoff, gbase, half, garr) do { if constexpr (Sched::GATHER) PG8_STAGE(bufoff, gbase, garr); else PG8_STAGE(bufoff, (gbase) + (half) * hstep, voffA); } while (0)
    const size_t kstep = (size_t)(BK * 2);
    const size_t hstep = (size_t)HALF * K * 2;
    const size_t hstepB = Epi::PERM == 2 ? (size_t)32 * K * 2 : hstep;
    const size_t tstep = 2 * hstep;
    const unsigned ldsw = (unsigned)wid * 1024u;
    const int aoff = lds_byte(wr * 64 + fr, fq * 8), boff = lds_byte(wc * 32 + fr, fq * 8);
#define PG8_SA(b, h) (((b) * 2 + (h)) * HTB)
#define PG8_SB(b, h) ((4 + (b) * 2 + (h)) * HTB)
#define PG8_STAGE(bufoff, gbase, voff) do { _Pragma("unroll") for (int _i = 0; _i < 2; ++_i) \
        __builtin_amdgcn_global_load_lds((const unsigned*)((const char*)(gbase) + (voff)[_i]), (PG8_LAS unsigned*)(lds + (bufoff) + ldsw + _i * 8192), 16, 0, 0); } while (0)
#define PG8_LDA(dst, b, h) do { if constexpr (FP8) { _Pragma("unroll") for (int m = 0; m < 4; ++m) dst##8[m] = __builtin_shufflevector(*(const PG8_LAS v4i_t*)(lds + PG8_SA(b, h) + aoff + m * 2048), *(const PG8_LAS v4i_t*)(lds + PG8_SA(b, h) + aoff + m * 2048 + 1024), 0, 1, 2, 3, 4, 5, 6, 7); } \
        else { _Pragma("unroll") for (int m = 0; m < 4; ++m) _Pragma("unroll") for (int k = 0; k < 2; ++k) dst[m][k] = *(const PG8_LAS bf16x8*)(lds + PG8_SA(b, h) + aoff + m * 2048 + k * 1024); } } while (0)
#define PG8_LDB(dst, b, h) do { if constexpr (FP8) { _Pragma("unroll") for (int n = 0; n < 2; ++n) dst##8[n] = __builtin_shufflevector(*(const PG8_LAS v4i_t*)(lds + PG8_SB(b, h) + boff + n * 2048), *(const PG8_LAS v4i_t*)(lds + PG8_SB(b, h) + boff + n * 2048 + 1024), 0, 1, 2, 3, 4, 5, 6, 7); } \
        else { _Pragma("unroll") for (int n = 0; n < 2; ++n) _Pragma("unroll") for (int k = 0; k < 2; ++k) dst[n][k] = *(const PG8_LAS bf16x8*)(lds + PG8_SB(b, h) + boff + n * 2048 + k * 1024); } } while (0)
#define PG8_MMA(ai, bj, At, Bt) do { __builtin_amdgcn_s_setprio(1); _Pragma("unroll") for (int m = 0; m < 4; ++m) _Pragma("unroll") for (int n = 0; n < 2; ++n) { \
        if constexpr (FP8) asm volatile("v_mfma_f32_16x16x128_f8f6f4 %0, %1, %2, %0" : "+v"(acc[ai][bj][m][n]) : "v"(Bt##8[n]), "v"(At##8[m])); \
        else { _Pragma("unroll") for (int k = 0; k < 2; ++k) acc[ai][bj][m][n] = __builtin_amdgcn_mfma_f32_16x16x32_bf16(Bt[n][k], At[m][k], acc[ai][bj][m][n], 0, 0, 0); } } \
        __builtin_amdgcn_s_setprio(0); } while (0)
#define PG8_WAIT_V(n) asm volatile("s_waitcnt vmcnt(" #n ")" ::: "memory")
#define PG8_WAIT_L(n) asm volatile("s_waitcnt lgkmcnt(" #n ")" ::: "memory")
#define PG8_BAR __builtin_amdgcn_s_barrier()
#define PG8_SCHED __builtin_amdgcn_sched_barrier(0)
    Unit cur, nxt; int ui = 0;
    if (!S.next(0, cur)) return;
    f32x4 acc[2][2][4][2];
#pragma unroll
    for (int a = 0; a < 2; ++a)
#pragma unroll
        for (int b = 0; b < 2; ++b)
#pragma unroll
            for (int m = 0; m < 4; ++m)
#pragma unroll
                for (int n = 0; n < 2; ++n) acc[a][b][m][n] = (f32x4){0.f, 0.f, 0.f, 0.f};
    bf16x8 At[4][2], B0[2][2], B1[2][2]; v8i_t At8[4], B08[2], B18[2];
    const size_t tstepA = Sched::GATHER ? (size_t)0 : tstep;
    const char* cA = (const char*)g.A + (size_t)cur.pm * tstepA + (size_t)cur.koff * 2; const char* cB = (const char*)g.Bt + (size_t)cur.pn * tstep + (size_t)cur.koff * 2;
    S.a_ready(cur);
    if constexpr (Sched::GATHER) { PG8_GOFF(gAc, cur); }
    PG8_STAGE(PG8_SB(0, 0), cB, voffB); PG8_STAGE(PG8_SB(0, 1), cB + hstepB, voffB); PG8_STAGE_A(PG8_SA(0, 0), cA, 0, gAc[0]); PG8_STAGE_A(PG8_SA(0, 1), cA, 1, gAc[1]);
    if (wr == 1) PG8_BAR;
    PG8_WAIT_V(2); PG8_BAR;
    PG8_STAGE(PG8_SB(1, 0), cB + kstep, voffB); PG8_STAGE_A(PG8_SA(1, 0), cA + kstep, 0, gAc[0]); PG8_STAGE(PG8_SB(1, 1), cB + hstepB + kstep, voffB);
    PG8_WAIT_V(6); PG8_BAR;
    for (;;) {
        const bool has_next = S.next(ui + 1, nxt);
        const char* nA = has_next ? (const char*)g.A + (size_t)nxt.pm * tstepA + (size_t)nxt.koff * 2 : cA; const char* nB = has_next ? (const char*)g.Bt + (size_t)nxt.pn * tstep + (size_t)nxt.koff * 2 : cB;
        if constexpr (Sched::GATHER) { if (has_next) { PG8_GOFF(gAn, nxt); } else {
#pragma unroll
            for (int h_ = 0; h_ < 2; ++h_)
#pragma unroll
                for (int i_ = 0; i_ < 2; ++i_) gAn[h_][i_] = gAc[h_][i_]; } }
        const int nt = cur.nt;
        for (int t = 0; t < nt; t += 2) {
            const bool last = (t == nt - 2);
            const char* a1 = cA + (size_t)(t + 1) * kstep;
            const char* a2 = last ? nA : cA + (size_t)(t + 2) * kstep; const char* b2 = last ? nB : cB + (size_t)(t + 2) * kstep;
            const char* a3 = a2 + kstep; const char* b3 = b2 + kstep;
            if (last && has_next) S.a_ready(nxt);
            unsigned g2a[2][2];
            if constexpr (Sched::GATHER) {
#pragma unroll
                for (int h_ = 0; h_ < 2; ++h_)
#pragma unroll
                    for (int i_ = 0; i_ < 2; ++i_) g2a[h_][i_] = last ? gAn[h_][i_] : gAc[h_][i_]; }
            PG8_LDB(B0, 0, 0); PG8_LDB(B1, 0, 1); PG8_SCHED; PG8_LDA(At, 0, 0); PG8_STAGE_A(PG8_SA(1, 1), a1, 1, gAc[1]);
            PG8_WAIT_V(8); PG8_WAIT_L(0); PG8_BAR; PG8_MMA(0, 0, At, B0); PG8_MMA(0, 1, At, B1); PG8_BAR; PG8_SCHED;
            PG8_LDA(At, 0, 1); PG8_STAGE(PG8_SB(0, 0), b2, voffB); PG8_STAGE(PG8_SB(0, 1), b2 + hstepB, voffB); PG8_STAGE_A(PG8_SA(0, 0), a2, 0, g2a[0]);
            PG8_WAIT_V(8); PG8_WAIT_L(0); PG8_BAR; PG8_MMA(1, 0, At, B0); PG8_MMA(1, 1, At, B1); PG8_BAR; PG8_SCHED;
            PG8_LDB(B0, 1, 0); PG8_LDB(B1, 1, 1); PG8_SCHED; PG8_LDA(At, 1, 0); PG8_STAGE_A(PG8_SA(0, 1), a2, 1, g2a[1]);
            PG8_WAIT_V(8); PG8_WAIT_L(0); PG8_BAR; PG8_MMA(0, 0, At, B0); PG8_MMA(0, 1, At, B1); PG8_BAR; PG8_SCHED;
            PG8_LDA(At, 1, 1); PG8_STAGE(PG8_SB(1, 0), b3, voffB); PG8_STAGE(PG8_SB(1, 1), b3 + hstepB, voffB); PG8_STAGE_A(PG8_SA(1, 0), a3, 0, g2a[0]);
            PG8_WAIT_V(8); PG8_WAIT_L(0); PG8_BAR; PG8_MMA(1, 0, At, B0); PG8_MMA(1, 1, At, B1); PG8_BAR; PG8_SCHED;
        }
        if constexpr (ALIGN_EPI) { if (wr == 0) PG8_BAR; }
        if constexpr (FP8) asm volatile("s_nop 15\n\ts_nop 15\n\ts_nop 15\n\ts_nop 15" ::: "memory");
        E(acc, cur, wr, wc, fr, fq); S.done(cur);
        if (!has_next) break;
        if (!Epi::CHAIN || cur.seg == 2)
#pragma unroll
        for (int a = 0; a < 2; ++a)
#pragma unroll
            for (int b = 0; b < 2; ++b)
#pragma unroll
                for (int m = 0; m < 4; ++m)
#pragma unroll
                    for (int n = 0; n < 2; ++n) acc[a][b][m][n] = (f32x4){0.f, 0.f, 0.f, 0.f};
        cur = nxt; cA = nA; cB = nB; ++ui;
        if constexpr (Sched::GATHER) {
#pragma unroll
            for (int h_ = 0; h_ < 2; ++h_)
#pragma unroll
                for (int i_ = 0; i_ < 2; ++i_) gAc[h_][i_] = gAn[h_][i_]; }
        if constexpr (ALIGN_EPI) { if (wr == 1) PG8_BAR; }
    }
    PG8_WAIT_V(0);
    if constexpr (!ALIGN_EPI) { if (wr == 0) PG8_BAR; }
    PG8_BAR;
#undef PG8_SA
#undef PG8_SB
#undef PG8_STAGE_A
#undef PG8_GOFF
#undef PG8_STAGE
#undef PG8_LDA
#undef PG8_LDB
#undef PG8_MMA
#undef PG8_WAIT_V
#undef PG8_WAIT_L
#undef PG8_BAR
#undef PG8_SCHED
}
}

constexpr int NWAVES = 8;
constexpr int T = 32768, SEQ = 2048, NB = 16, D = 2048, DEPTH = 2;
constexpr int ZP = pg8::ZP;
constexpr int ZC_AQ = 0, ZC_AK = 512, ZC_AV = 640, ZC_BQ = 768, ZC_BK = 1792, ZC_BV = 2048, ZC_IQ = 2304, ZC_IK = 3328, ZC_IW = 3392, ZC_CG = 3408, ZC_PAD = 3424, ZC_CQ = 3584, ZC_CK = 3840, ZC_CV = 4096, ZC_CR = 4608;
constexpr int D_IN = 11104;
constexpr int NEXP = 64, DEXP = 512, PMAX_TILES = 320;
constexpr float EPS = 1e-6f;

constexpr size_t MiB = 1u << 20;
constexpr size_t WS_CTL = 0, CTL_ZERO_BYTES = 1 * MiB;
constexpr size_t WS_ROUTE = 2 * MiB;
constexpr size_t WS_WRH = 4 * MiB, WS_WRL = 6 * MiB, WR_L = 96 * 2048 * 2;
constexpr size_t WS_WIN = 16 * MiB, WIN_L = 44 * MiB;
constexpr size_t WS_WBR = 104 * MiB, WBR_L = 8 * MiB;
constexpr size_t WS_WO = 120 * MiB, WO_L = 8 * MiB;
constexpr size_t WS_W13 = 136 * MiB;
constexpr size_t WS_HB = 264 * MiB;
constexpr size_t WS_W2 = 392 * MiB;
constexpr size_t WS_XN = 520 * MiB;
constexpr size_t WS_OCAT = 648 * MiB;
constexpr size_t WS_MERGED = 776 * MiB;
constexpr size_t WS_Z = 904 * MiB;
constexpr size_t WS_GT = 1224 * MiB;
constexpr size_t WS_S = 1608 * MiB;
constexpr size_t WS_MASK = 1864 * MiB;
constexpr size_t WS_GO = 1872 * MiB;
constexpr size_t WS_GCS = WS_GO;
constexpr size_t WS_GDEC = 8 * MiB;
constexpr size_t WS_RSTD1 = 10 * MiB;
constexpr size_t WS_RSTD = 9 * MiB;
constexpr size_t WS_LISTE = 904 * MiB;
constexpr size_t WS_XS = 904 * MiB;
constexpr size_t WS_Y = 1224 * MiB;
constexpr size_t WS_H = 1544 * MiB;
constexpr size_t WS_WG8 = 1936 * MiB, WG8_L = 12 * MiB;
constexpr size_t WS_XN8 = WS_S;
constexpr size_t WS_END = 1936 * MiB;
constexpr int CW_BAR = 4096;
constexpr int CW_CNT = 16384;

constexpr int RING_BYTES = 131072, MISC_OFF = RING_BYTES, LDS_BYTES = 155648;
constexpr int MO_BARW = 32, MO_GN = 256, MO_TEXP = 8192, MO_PST = 9728, MO_TOT = 9984, MO_TAB2 = 10240, MO_CNT = 16640, MO_SS = 16896;

#define GAS __attribute__((address_space(1)))
#define LAS __attribute__((address_space(3)))
typedef unsigned short bf16;
typedef unsigned v4u __attribute__((ext_vector_type(4)));
typedef unsigned v2u __attribute__((ext_vector_type(2)));
typedef float f32x4 __attribute__((ext_vector_type(4)));
#define LDS_WAIT() asm volatile("s_waitcnt lgkmcnt(0)" ::: "memory")
__device__ __forceinline__ unsigned f2bf(float f) { unsigned u = __builtin_bit_cast(unsigned, f); return (u + 0x7fffu + ((u >> 16) & 1u)) >> 16; }
__device__ __forceinline__ unsigned pk2(float lo, float hi) { return pg8::cvt_pk_bf16(lo, hi); }
__device__ __forceinline__ float bflo(unsigned w) { return __uint_as_float(w << 16); }
__device__ __forceinline__ float bfhi(unsigned w) { return __uint_as_float(w & 0xffff0000u); }
__device__ __forceinline__ float bf1(bf16 h) { return __uint_as_float(((unsigned)h) << 16); }

#define XB_TMO      128
#define XB_XCNT(j)  (256  + 64 * (j))
#define XB_XSUB(j)  (1280 + 64 * (j))
#define XB_XGEN(j)  (2304 + 64 * (j))
#define XB_TOP      3328
#define XB_TOPGEN   3392
#define XCD_BAR_WORDS 3456
#define XB_SPIN_CAP (1u << 18)
__device__ __forceinline__ unsigned xb_ld(unsigned* p)              { return __hip_atomic_load(p, __ATOMIC_RELAXED, __HIP_MEMORY_SCOPE_AGENT); }
__device__ __forceinline__ unsigned xb_add(unsigned* p, unsigned v) { return __hip_atomic_fetch_add(p, v, __ATOMIC_RELAXED, __HIP_MEMORY_SCOPE_AGENT); }
__device__ __forceinline__ unsigned xb_xcc_id() { return (unsigned)__builtin_amdgcn_s_getreg((3 << 11) | 20) & 0xFu; }
#define XB_SPIN(cond, bar) do { unsigned _sp = 0; while (cond) { __builtin_amdgcn_s_sleep(1); \
    if ((++_sp & 255u) == 0u) { if (xb_ld(&(bar)[XB_TMO])) break; if (_sp > XB_SPIN_CAP) { atomicAdd(&(bar)[XB_TMO], 1u); break; } } } } while (0)
struct XcdBarrier { unsigned* bar; unsigned x; volatile LAS unsigned* st; };
__device__ __forceinline__ XcdBarrier xcd_barrier_post(unsigned* bar, volatile LAS unsigned* st) {
    XcdBarrier b; b.bar = bar; b.x = xb_xcc_id(); b.st = st;
    if (threadIdx.x == 0) (void)xb_add(&bar[XB_XCNT(b.x)], 1u);
    return b;
}
__device__ __forceinline__ void xcd_barrier_complete(unsigned* bar, unsigned x, unsigned& nloc, unsigned& nx) {
    const unsigned G = gridDim.x * gridDim.y * gridDim.z;
    unsigned sum, cnt, mine, sp = 0u;
    for (;;) {
        sum = 0u; cnt = 0u; mine = 0u;
#pragma unroll
        for (unsigned j = 0; j < 16; ++j) { const unsigned c = xb_ld(&bar[XB_XCNT(j)]); sum += c; cnt += (c > 0u) ? 1u : 0u; mine = (j == x) ? c : mine; }
        if (sum == G) break;
        __builtin_amdgcn_s_sleep(1);
        if ((++sp & 255u) == 0u) { if (xb_ld(&bar[XB_TMO])) break; if (sp > XB_SPIN_CAP) { atomicAdd(&bar[XB_TMO], 1u); break; } }
    }
    nloc = mine > 0u ? mine : 1u; nx = cnt > 0u ? cnt : 1u;
}
__device__ __forceinline__ void xcd_barrier(const XcdBarrier& b) {
    asm volatile("s_waitcnt vmcnt(0)" ::: "memory");
    __syncthreads();
    if (threadIdx.x == 0) {
        unsigned* bar = b.bar;
        __builtin_amdgcn_s_waitcnt(0);
        unsigned nloc = b.st[0], nx = b.st[1];
        if (nloc == 0u) { xcd_barrier_complete(bar, b.x, nloc, nx); b.st[0] = nloc; b.st[1] = nx; }
        const unsigned old = xb_add(&bar[XB_XSUB(b.x)], 1u);
        const unsigned gen = old / nloc;
        if (old + 1u == (gen + 1u) * nloc) {
            __builtin_amdgcn_fence(__ATOMIC_RELEASE, "agent");
            asm volatile("s_waitcnt vmcnt(0)" ::: "memory");
            const unsigned og = xb_add(&bar[XB_TOP], 1u);
            const unsigned tg = og / nx;
            if (og + 1u == (tg + 1u) * nx) xb_add(&bar[XB_TOPGEN], 1u);
            else XB_SPIN(xb_ld(&bar[XB_TOPGEN]) == tg, bar);
            __builtin_amdgcn_fence(__ATOMIC_ACQUIRE, "agent");
            xb_add(&bar[XB_XGEN(b.x)], 1u);
            asm volatile("s_waitcnt vmcnt(0)" ::: "memory");
        } else {
            XB_SPIN(xb_ld(&bar[XB_XGEN(b.x)]) == gen, bar);
            __builtin_amdgcn_fence(__ATOMIC_ACQUIRE, "agent");
            asm volatile("s_waitcnt vmcnt(0)" ::: "memory");
        }
    }
    __syncthreads();
}

struct Args { const float* in[24]; float* out; unsigned char* ws; int ph_lo, ph_hi; };
enum { I_X = 0, I_RELB, I_N1G, I_WIN, I_AQG, I_AKG, I_BQG, I_BKG, I_SINK, I_CGW, I_CGB, I_CNG, I_WBA, I_WBB, I_WBC, I_WO, I_N2G, I_WRG, I_BRG, I_WRE, I_BRE, I_W1, I_W3, I_W2 };

struct Frame {
    LAS unsigned char* lds; LAS unsigned char* misc;
    unsigned* ctl;
    int tid, lane, wave, vcu, G, gw, NGW;
    const float* const* in; float* out; unsigned char* ws;
    bf16 *Z, *XN, *OCAT, *MERGED, *XS, *Y, *H;
    float *S, *GO; unsigned* MASK;
};

__device__ __forceinline__ float wave_sum(float v) {
#pragma unroll
    for (int o = 1; o < 64; o <<= 1) v += __shfl_xor(v, o);
    return v;
}
__device__ __forceinline__ float wave_max(float v) {
#pragma unroll
    for (int o = 1; o < 64; o <<= 1) v = fmaxf(v, __shfl_xor(v, o));
    return v;
}

template <class MAP>
__device__ __forceinline__ void transpose_item(const float* W, int N, bf16* WT, int dpitch, int koff, LAS float* scr, int item, int lane, const MAP& map, const float* kgain = nullptr) {
    const int nblk = N / 32, kb = item / nblk, nb = item % nblk, k0 = 64 * kb, n0 = 32 * nb;
    f32x4 v[8];
#pragma unroll
    for (int i = 0; i < 8; ++i) v[i] = *(const f32x4*)(W + (size_t)(k0 + 8 * i + (lane >> 3)) * N + n0 + 4 * (lane & 7));
    if (kgain) {
#pragma unroll
        for (int i = 0; i < 8; ++i) v[i] = v[i] * kgain[k0 + 8 * i + (lane >> 3)]; }
#pragma unroll
    for (int i = 0; i < 8; ++i) { LAS float* d = scr + (8 * i + (lane >> 3)) * 33 + 4 * (lane & 7); d[0] = v[i].x; d[1] = v[i].y; d[2] = v[i].z; d[3] = v[i].w; }
    LDS_WAIT(); asm volatile("" ::: "memory");
    const int c = lane & 7;
#pragma unroll
    for (int j = 0; j < 4; ++j) { const int n = (lane >> 3) + 8 * j; const LAS float* s = scr + (8 * c) * 33 + n;
        v4u o; o.x = pk2(s[0 * 33], s[1 * 33]); o.y = pk2(s[2 * 33], s[3 * 33]); o.z = pk2(s[4 * 33], s[5 * 33]); o.w = pk2(s[6 * 33], s[7 * 33]);
        const int dr_ = map(n0 + n); if (dr_ >= 0) *(v4u*)(WT + (size_t)dr_ * dpitch + koff + k0 + 8 * c) = o; }
    LDS_WAIT(); asm volatile("" ::: "memory");
}
__device__ __forceinline__ float clamp8(float v) { return fminf(fmaxf(v, -440.0f), 440.0f); }
template <class MAP>
__device__ __forceinline__ void transpose_item_fp8(const float* W, int N, unsigned char* WT, int dpitch, float scale, LAS float* scr, int item, int lane, const MAP& map) {
    const int nblk = N / 32, kb = item / nblk, nb = item % nblk, k0 = 64 * kb, n0 = 32 * nb;
    f32x4 v[8];
#pragma unroll
    for (int i = 0; i < 8; ++i) v[i] = *(const f32x4*)(W + (size_t)(k0 + 8 * i + (lane >> 3)) * N + n0 + 4 * (lane & 7));
#pragma unroll
    for (int i = 0; i < 8; ++i) { LAS float* d = scr + (8 * i + (lane >> 3)) * 33 + 4 * (lane & 7); d[0] = v[i].x; d[1] = v[i].y; d[2] = v[i].z; d[3] = v[i].w; }
    LDS_WAIT(); asm volatile("" ::: "memory");
    const int c = lane & 7;
#pragma unroll
    for (int j = 0; j < 4; ++j) { const int n = (lane >> 3) + 8 * j; const LAS float* s = scr + (8 * c) * 33 + n;
        int w0 = 0, w1 = 0;
        w0 = __builtin_amdgcn_cvt_pk_fp8_f32(clamp8(s[0 * 33] * scale), clamp8(s[1 * 33] * scale), w0, false); w0 = __builtin_amdgcn_cvt_pk_fp8_f32(clamp8(s[2 * 33] * scale), clamp8(s[3 * 33] * scale), w0, true);
        w1 = __builtin_amdgcn_cvt_pk_fp8_f32(clamp8(s[4 * 33] * scale), clamp8(s[5 * 33] * scale), w1, false); w1 = __builtin_amdgcn_cvt_pk_fp8_f32(clamp8(s[6 * 33] * scale), clamp8(s[7 * 33] * scale), w1, true);
        const int dr_ = map(n0 + n); if (dr_ >= 0) *(v2u*)(WT + (size_t)dr_ * dpitch + k0 + 8 * c) = (v2u){(unsigned)w0, (unsigned)w1}; }
    LDS_WAIT(); asm volatile("" ::: "memory");
}
struct MapId { int off; __device__ __forceinline__ int operator()(int n) const { return off + n; } };
struct MapWin {
    __device__ __forceinline__ int operator()(int n) const {
        if (n < 512) return ZC_AQ + n;
        if (n < 640) return ZC_AK + (n - 512);
        if (n < 768) return ZC_AV + (n - 640);
        if (n < 1792) return ZC_IQ + (n - 768);
        if (n < 1856) return ZC_IK + (n - 1792);
        if (n < 1872) return ZC_IW + (n - 1856);
        if (n < 2896) return ZC_BQ + (n - 1872);
        if (n < 3152) return ZC_BK + (n - 2896);
        if (n < 3408) return ZC_BV + (n - 3152);
        if (n < 3664) return ZC_CQ + (n - 3408);
        if (n < 3920) return ZC_CK + (n - 3664);
        if (n < 4432) return ZC_CV + (n - 3920);
        if (n < 4448) return ZC_CG + (n - 4432);
        if (n < 4960) return ZC_CR + (n - 4448);
        return pg8::ZC_GA + (n - 4960);
    }
};
struct MapWin8 { __device__ __forceinline__ int operator()(int n) const { const int z = MapWin{}(n); return z < 3328 ? z : (z >= 4096 ? z - 768 : -1); } };
struct MapWinB { __device__ __forceinline__ int operator()(int n) const { const int z = MapWin{}(n); return (z >= 3328 && z < 4096) ? z - 3328 : -1; } };
struct MapW13 { int sel; __device__ __forceinline__ int operator()(int n) const { return 32 * (n >> 4) + 16 * sel + (n & 15); } };

__device__ __forceinline__ void load_row(const float* row, int lane, f32x4 (&v)[8]) {
    const f32x4* xr = (const f32x4*)row + lane;
#pragma unroll
    for (int j = 0; j < 8; ++j) v[j] = xr[64 * j];
}
__device__ __forceinline__ float row_rstd(const f32x4 (&v)[8]) {
    float s = 0.f;
#pragma unroll
    for (int j = 0; j < 8; ++j) s += (v[j].x * v[j].x + v[j].y * v[j].y) + (v[j].z * v[j].z + v[j].w * v[j].w);
    return rsqrtf(wave_sum(s) * (1.0f / 2048.0f) + EPS);
}
__device__ __forceinline__ void norm_store_bf16(const f32x4 (&v)[8], float rstd, const float* g, bf16* orow, int lane) {
    const f32x4* gr = (const f32x4*)g + lane; unsigned long long* o8 = (unsigned long long*)orow + lane;
#pragma unroll
    for (int j = 0; j < 8; ++j) { const f32x4 gg = gr[64 * j];
        o8[64 * j] = (unsigned long long)pk2(v[j].x * rstd * gg.x, v[j].y * rstd * gg.y) | ((unsigned long long)pk2(v[j].z * rstd * gg.z, v[j].w * rstd * gg.w) << 32); }
}

__device__ __forceinline__ void norm_store_fp8(const f32x4 (&v)[8], float rstd, const float* g, unsigned char* orow, int lane) {
    const f32x4* gr = (const f32x4*)g + lane; unsigned* o4 = (unsigned*)orow + lane;
#pragma unroll
    for (int j = 0; j < 8; ++j) { const f32x4 gg = gr[64 * j]; int w = 0;
        w = __builtin_amdgcn_cvt_pk_fp8_f32(clamp8(v[j].x * rstd * gg.x), clamp8(v[j].y * rstd * gg.y), w, false); w = __builtin_amdgcn_cvt_pk_fp8_f32(clamp8(v[j].z * rstd * gg.z), clamp8(v[j].w * rstd * gg.w), w, true);
        o4[64 * j] = (unsigned)w; }
}
__device__ __forceinline__ void convert_moe(Frame& F, int l, int part, int nparts, int lds_off) {
    LAS float* scr = (LAS float*)(F.lds + lds_off + F.wave * 8704);
    bf16* W13 = (bf16*)(F.ws + WS_W13); bf16* W2 = (bf16*)(F.ws + WS_W2);
    constexpr int I13 = (2048 / 64) * (512 / 32);
    constexpr int I2 = (512 / 64) * (2048 / 32);
    constexpr int NIT = NEXP * (2 * I13 + I2);
    const int it_lo = (int)((long)NIT * part / nparts), it_hi = (int)((long)NIT * (part + 1) / nparts);
    for (int it = it_lo + F.gw; it < it_hi; it += F.NGW) {
        const int e = it / (2 * I13 + I2); int r = it % (2 * I13 + I2);
        if (r < I13) { transpose_item_fp8(F.in[I_W1] + ((size_t)l * NEXP + e) * 2048 * 512, 512, (unsigned char*)W13 + (size_t)e * 1024 * 2048, 2048, 64.0f, scr, r, F.lane, MapW13{0}); continue; } r -= I13;
        if (r < I13) { transpose_item_fp8(F.in[I_W3] + ((size_t)l * NEXP + e) * 2048 * 512, 512, (unsigned char*)W13 + (size_t)e * 1024 * 2048, 2048, 64.0f, scr, r, F.lane, MapW13{1}); continue; } r -= I13;
        transpose_item_fp8(F.in[I_W2] + ((size_t)l * NEXP + e) * 512 * 2048, 2048, (unsigned char*)W2 + (size_t)e * 2048 * 512, 512, 32.0f, scr, r, F.lane, MapId{0});
    }
}

typedef short bf16x8_t __attribute__((ext_vector_type(8)));
typedef float f32x16 __attribute__((ext_vector_type(16)));
typedef short s16x4 __attribute__((ext_vector_type(4)));
__device__ __forceinline__ void indexer_segment(Frame& F, int b, int qb, int tlo, int thi) {
    const int lane = F.lane, n = lane & 15, kq = lane >> 4;
    const bf16* qrow = F.Z + (size_t)(b * 2048 + 16 * qb + n) * ZP;
    bf16x8_t iqf[16][2];
#pragma unroll
    for (int h = 0; h < 16; ++h)
#pragma unroll
        for (int ks = 0; ks < 2; ++ks) iqf[h][ks] = *(const bf16x8_t*)(qrow + ZC_IQ + h * 64 + 32 * ks + 8 * kq);
    float wv[16];
    { const v4u w0 = *(const v4u*)(qrow + ZC_IW), w1 = *(const v4u*)(qrow + ZC_IW + 8);
      wv[0] = bflo(w0.x); wv[1] = bfhi(w0.x); wv[2] = bflo(w0.y); wv[3] = bfhi(w0.y); wv[4] = bflo(w0.z); wv[5] = bfhi(w0.z); wv[6] = bflo(w0.w); wv[7] = bfhi(w0.w);
      wv[8] = bflo(w1.x); wv[9] = bfhi(w1.x); wv[10] = bflo(w1.y); wv[11] = bfhi(w1.y); wv[12] = bflo(w1.z); wv[13] = bfhi(w1.z); wv[14] = bflo(w1.w); wv[15] = bfhi(w1.w); }
    const bf16* kbase = F.Z + (size_t)(b * 2048 + n) * ZP + ZC_IK + 8 * kq;
    float* srow = F.S + (size_t)(b * 2048 + 16 * qb + n) * 2048 + 4 * kq;
    bf16x8_t ka[3], kb[3];
#pragma unroll
    for (int u = 0; u < 3; ++u) { const int tt = tlo + u < thi ? tlo + u : thi - 1; ka[u] = *(const bf16x8_t*)(kbase + (size_t)(16 * tt) * ZP); kb[u] = *(const bf16x8_t*)(kbase + (size_t)(16 * tt) * ZP + 32); }
#pragma unroll 1
    for (int tile = tlo; tile < thi; tile += 3) {
#pragma unroll
        for (int u = 0; u < 3; ++u) {
            const int tt = tile + u;
            if (tt < thi) {
                f32x4 sc = (f32x4){0.f, 0.f, 0.f, 0.f};
#pragma unroll
                for (int h = 0; h < 16; ++h) {
                    f32x4 c = __builtin_amdgcn_mfma_f32_16x16x32_bf16(ka[u], iqf[h][0], (f32x4){0.f, 0.f, 0.f, 0.f}, 0, 0, 0);
                    c = __builtin_amdgcn_mfma_f32_16x16x32_bf16(kb[u], iqf[h][1], c, 0, 0, 0);
                    sc[0] += wv[h] * fmaxf(c[0], 0.f); sc[1] += wv[h] * fmaxf(c[1], 0.f); sc[2] += wv[h] * fmaxf(c[2], 0.f); sc[3] += wv[h] * fmaxf(c[3], 0.f);
                }
                *(f32x4*)(srow + 16 * tt) = sc * 0.03125f;
            }
            { const int tn = tt + 3 < thi ? tt + 3 : thi - 1; ka[u] = *(const bf16x8_t*)(kbase + (size_t)(16 * tn) * ZP); kb[u] = *(const bf16x8_t*)(kbase + (size_t)(16 * tn) * ZP + 32); }
        }
    }
}

constexpr int FA_KP = 272, FA_VP = 320;
constexpr int FA_KOFF = 0, FA_VOFF = 2 * 64 * FA_KP, FA_BYTES = FA_VOFF + 2 * 64 * FA_VP;
__device__ __forceinline__ s16x4 fa_vtr(const LAS unsigned char* p) { return __builtin_bit_cast(s16x4, __builtin_amdgcn_ds_read_tr16_b64_v4i16((LAS s16x4*)p)); }
template <int MODE>
__device__ __forceinline__ void flash_unit(Frame& F, int l, int b, int g, int t0) {
    const int tid = F.tid, lane = F.lane, wave = F.wave, hh = wave & 3, qh = wave >> 2, r = lane & 31, hf = lane >> 5;
    const int qcol = (MODE == 0 ? ZC_AQ : ZC_BQ + 512 * g) + 128 * hh, kcol = MODE == 0 ? ZC_AK : ZC_BK + 128 * g, vcol = MODE == 0 ? ZC_AV : ZC_BV + 128 * g;
    const int ocol = (MODE == 0 ? 0 : 512 + 512 * g) + 128 * hh, hd = (MODE == 0 ? 0 : 4 + 4 * g) + hh;
    const int tq = t0 + 32 * qh + r; const size_t qrow = (size_t)(b * 2048 + tq);
    const LAS float* tab2 = (const LAS float*)(F.misc + MO_TAB2) + hd * 129;
    LAS unsigned char* lds = F.lds;
    bf16x8_t qf[8];
#pragma unroll
    for (int ks = 0; ks < 8; ++ks) qf[ks] = *(const bf16x8_t*)(F.Z + qrow * ZP + qcol + 16 * ks + 8 * hf);
    f32x16 oacc[4];
#pragma unroll
    for (int dt = 0; dt < 4; ++dt)
#pragma unroll
        for (int i = 0; i < 16; ++i) oacc[dt][i] = 0.f;
    float m_run = -1e30f, l_run = 0.f;
    const int tile_lo = MODE == 0 ? 0 : (t0 >= 128 ? t0 / 64 - 2 : 0), tile_hi = t0 / 64 + 1;
    const int skey = tid >> 4, sdc = tid & 15;
    v4u kreg[2], vreg[2];
    { const bf16* zr = F.Z + (size_t)(b * 2048 + 64 * tile_lo + skey) * ZP;
#pragma unroll
      for (int i = 0; i < 2; ++i) { kreg[i] = *(const v4u*)(zr + (size_t)(32 * i) * ZP + kcol + 8 * sdc); vreg[i] = *(const v4u*)(zr + (size_t)(32 * i) * ZP + vcol + 8 * sdc); } }
    const float sc2 = 0.08838834764831845f * 1.4426950408889634f;
    unsigned mwn[2] = {0xffffffffu, 0xffffffffu};
    if (MODE == 0) { mwn[0] = F.MASK[qrow * 64 + 2 * tile_lo]; mwn[1] = F.MASK[qrow * 64 + 2 * tile_lo + 1]; }
#pragma unroll 1
    for (int kt = tile_lo; kt < tile_hi; ++kt) {
        const int bf = (kt - tile_lo) & 1, s0 = 64 * kt;
        LAS unsigned char* kb = lds + FA_KOFF + bf * (64 * FA_KP); LAS unsigned char* vb = lds + FA_VOFF + bf * (64 * FA_VP);
#pragma unroll
        for (int i = 0; i < 2; ++i) { *(LAS v4u*)(kb + (skey + 32 * i) * FA_KP + 16 * sdc) = kreg[i]; *(LAS v4u*)(vb + (skey + 32 * i) * FA_VP + 16 * sdc) = vreg[i]; }
        __syncthreads();
        if (kt + 1 < tile_hi) { const bf16* zr = F.Z + (size_t)(b * 2048 + 64 * (kt + 1) + skey) * ZP;
#pragma unroll
            for (int i = 0; i < 2; ++i) { kreg[i] = *(const v4u*)(zr + (size_t)(32 * i) * ZP + kcol + 8 * sdc); vreg[i] = *(const v4u*)(zr + (size_t)(32 * i) * ZP + vcol + 8 * sdc); } }
        unsigned mw[2] = {mwn[0], mwn[1]};
        if (MODE == 0 && kt + 1 < tile_hi) { mwn[0] = F.MASK[qrow * 64 + 2 * (kt + 1)]; mwn[1] = F.MASK[qrow * 64 + 2 * (kt + 1) + 1]; }
        f32x16 sacc[2];
#pragma unroll
        for (int k2 = 0; k2 < 2; ++k2) {
#pragma unroll
            for (int i = 0; i < 16; ++i) sacc[k2][i] = 0.f;
#pragma unroll
            for (int ks = 0; ks < 8; ++ks) { const bf16x8_t kf = *(const LAS bf16x8_t*)(kb + (32 * k2 + r) * FA_KP + (16 * ks + 8 * hf) * 2);
                sacc[k2] = __builtin_amdgcn_mfma_f32_32x32x16_bf16(kf, qf[ks], sacc[k2], 0, 0, 0); }
        }
        float mx = -1e30f;
        if (MODE == 0 && s0 + 63 + 128 <= t0) {
            const float bfar = tab2[128];
#pragma unroll
            for (int k2 = 0; k2 < 2; ++k2)
#pragma unroll
                for (int i = 0; i < 16; ++i) { const int cr = (i & 3) + 8 * (i >> 2) + 4 * hf;
                    const float v = ((mw[k2] >> cr) & 1u) ? sacc[k2][i] * sc2 + bfar : -__builtin_inff();
                    sacc[k2][i] = v; mx = fmaxf(mx, v); }
        } else
#pragma unroll
        for (int k2 = 0; k2 < 2; ++k2)
#pragma unroll
            for (int i = 0; i < 16; ++i) { const int cr = (i & 3) + 8 * (i >> 2) + 4 * hf; const int dist = tq - (s0 + 32 * k2 + cr);
                bool ok; if (MODE == 0) ok = (mw[k2] >> cr) & 1u; else ok = dist >= 0 && dist < 128;
                const int di = dist < 0 ? 0 : (dist > 128 ? 128 : dist);
                float vf = sacc[k2][i] * sc2 + tab2[di];
                asm volatile("" : "+v"(vf));
                const float v = ok ? vf : -__builtin_inff();
                sacc[k2][i] = v; mx = fmaxf(mx, v); }
        { const auto sw_ = __builtin_amdgcn_permlane32_swap(__float_as_uint(mx), __float_as_uint(mx), false, false); mx = fmaxf(__uint_as_float(sw_[0]), __uint_as_float(sw_[1])); }
        const float m_new = fmaxf(m_run, mx), alpha = __builtin_amdgcn_exp2f(m_run - m_new); m_run = m_new;
        float ps = 0.f;
#pragma unroll
        for (int k2 = 0; k2 < 2; ++k2)
#pragma unroll
            for (int i = 0; i < 16; ++i) { const float p = __builtin_amdgcn_exp2f(sacc[k2][i] - m_new); sacc[k2][i] = p; ps += p; }
        l_run = l_run * alpha + ps;
        if (__ballot(alpha != 1.0f)) {
#pragma unroll
        for (int dt = 0; dt < 4; ++dt)
#pragma unroll
            for (int i = 0; i < 16; ++i) oacc[dt][i] *= alpha;
        }
#pragma unroll
        for (int k2 = 0; k2 < 2; ++k2)
#pragma unroll
            for (int s2 = 0; s2 < 2; ++s2) {
                v4u pw; pw.x = pg8::cvt_pk_bf16(sacc[k2][8 * s2 + 0], sacc[k2][8 * s2 + 1]); pw.y = pg8::cvt_pk_bf16(sacc[k2][8 * s2 + 2], sacc[k2][8 * s2 + 3]);
                pw.z = pg8::cvt_pk_bf16(sacc[k2][8 * s2 + 4], sacc[k2][8 * s2 + 5]); pw.w = pg8::cvt_pk_bf16(sacc[k2][8 * s2 + 6], sacc[k2][8 * s2 + 7]);
                const bf16x8_t pb = __builtin_bit_cast(bf16x8_t, pw);
                const int i16 = lane & 15, grp = (lane >> 4) & 1;
                const LAS unsigned char* vp = vb + (32 * k2 + 16 * s2 + 4 * hf + (i16 >> 2)) * FA_VP + (16 * grp + 4 * (i16 & 3)) * 2;
#pragma unroll
                for (int dt = 0; dt < 4; ++dt) { const s16x4 lo = fa_vtr(vp + 64 * dt), hi = fa_vtr(vp + 8 * FA_VP + 64 * dt);
                    const bf16x8_t vf = __builtin_shufflevector(lo, hi, 0, 1, 2, 3, 4, 5, 6, 7);
                    oacc[dt] = __builtin_amdgcn_mfma_f32_32x32x16_bf16(vf, pb, oacc[dt], 0, 0, 0); }
            }
    }
    float l_tot = l_run + __shfl_xor(l_run, 32);
    if (MODE == 1) l_tot += __builtin_amdgcn_exp2f(F.in[I_SINK][l * 8 + hd - 4] * 1.4426950408889634f - m_run);
    const float inv = 1.0f / l_tot;
    bf16* orow = F.OCAT + qrow * 2048 + ocol + 4 * hf;
#pragma unroll
    for (int dt = 0; dt < 4; ++dt)
#pragma unroll
        for (int gq = 0; gq < 4; ++gq) { v2u w; w.x = pk2(oacc[dt][4 * gq] * inv, oacc[dt][4 * gq + 1] * inv); w.y = pk2(oacc[dt][4 * gq + 2] * inv, oacc[dt][4 * gq + 3] * inv);
            *(v2u*)(orow + 32 * dt + 8 * gq) = w; }
    __syncthreads();
}


#define GLA_GATE_PREFIX(LDS_TOT) \
        float la[8]; \
        _Pragma("unroll") for (int i = 0; i < 8; ++i) { const v4u c0 = rc0[i], c1 = rc1[i]; float x = gb; \
            x += bflo(c0.x) * gwv[0] + bfhi(c0.x) * gwv[1] + bflo(c0.y) * gwv[2] + bfhi(c0.y) * gwv[3] + bflo(c0.z) * gwv[4] + bfhi(c0.z) * gwv[5] + bflo(c0.w) * gwv[6] + bfhi(c0.w) * gwv[7]; \
            x += bflo(c1.x) * gwv[8] + bfhi(c1.x) * gwv[9] + bflo(c1.y) * gwv[10] + bfhi(c1.y) * gwv[11] + bflo(c1.z) * gwv[12] + bfhi(c1.z) * gwv[13] + bflo(c1.w) * gwv[14] + bfhi(c1.w) * gwv[15]; \
            la[i] = (fminf(x, 0.f) - __logf(1.0f + __expf(-fabsf(x)))) * 0.0625f; } \
        _Pragma("unroll") for (int i = 1; i < 8; ++i) la[i] += la[i - 1]; \
        ((LAS float*)(L + LDS_TOT))[cg * 64 + dk] = la[7];
#define GLA_OFFSETS(LDS_TOT) \
        float off = 0.f, tot = 0.f; \
        _Pragma("unroll") for (int g2 = 0; g2 < 8; ++g2) { const float tv = ((const LAS float*)(L + LDS_TOT))[g2 * 64 + dk]; tot += tv; off += g2 < cg ? tv : 0.f; }

__device__ __forceinline__ void gla_state_phase(Frame& F, int l) {
    const int tid = F.tid, lane = F.lane, wave = F.wave, r = lane & 31, hf = lane >> 5, i16 = lane & 15, grp = (lane >> 4) & 1;
    LAS unsigned char* L = F.lds;
    constexpr int KDT = 0, VT = 9216, TOT = 29696, RP = 144, VP = 320;
    const int dk = lane, cg = wave;
    float* GCS = (float*)(F.ws + WS_GCS); float* GDEC = (float*)(F.ws + WS_GDEC);
    v4u rc0[8], rc1[8], rv[2]; unsigned short rk[8];
#define GLS_LOAD(u_) do { const int bh_ = (u_) >> 5, n_ = (u_) & 31; const size_t r0_ = (size_t)((bh_ >> 2) * 2048 + 64 * n_); const int h_ = bh_ & 3; \
        _Pragma("unroll") for (int i = 0; i < 8; ++i) { const bf16* zr = F.Z + (r0_ + 8 * cg + i) * ZP; rc0[i] = *(const v4u*)(zr + ZC_CG); rc1[i] = *(const v4u*)(zr + ZC_CG + 8); rk[i] = zr[ZC_CK + h_ * 64 + dk]; } \
        _Pragma("unroll") for (int i = 0; i < 2; ++i) rv[i] = *(const v4u*)(F.Z + (r0_ + (tid >> 4) + 32 * i) * ZP + ZC_CV + h_ * 128 + 8 * (tid & 15)); } while (0)
    int u = F.vcu;
    if (u < 2048) GLS_LOAD(u);
    for (; u < 2048; u += F.G) {
        const int h = (u >> 5) & 3;
        float gwv[16];
#pragma unroll
        for (int q = 0; q < 16; ++q) gwv[q] = F.in[I_CGW][(size_t)l * 4096 + q * 256 + h * 64 + dk];
        const float gb = F.in[I_CGB][l * 256 + h * 64 + dk];
        GLA_GATE_PREFIX(TOT)
        float kv[8];
#pragma unroll
        for (int i = 0; i < 8; ++i) kv[i] = bf1(rk[i]);
#pragma unroll
        for (int i = 0; i < 2; ++i) *(LAS v4u*)(L + VT + ((tid >> 4) + 32 * i) * VP + 16 * (tid & 15)) = rv[i];
        __syncthreads();
        GLA_OFFSETS(TOT)
        { float kd[8];
#pragma unroll
          for (int i = 0; i < 8; ++i) kd[i] = kv[i] * __expf(tot - (off + la[i]));
          v4u w; w.x = pk2(kd[0], kd[1]); w.y = pk2(kd[2], kd[3]); w.z = pk2(kd[4], kd[5]); w.w = pk2(kd[6], kd[7]); *(LAS v4u*)(L + KDT + dk * RP + 16 * cg) = w; }
        if (cg == 0) GDEC[(size_t)u * 64 + dk] = __expf(tot);
        __syncthreads();
        if (u + F.G < 2048) GLS_LOAD(u + F.G);
        { const int dkt = wave >> 2, dvt = wave & 3;
          f32x16 cs;
#pragma unroll
          for (int i = 0; i < 16; ++i) cs[i] = 0.f;
#pragma unroll
          for (int ks = 0; ks < 4; ++ks) { const bf16x8_t a = *(const LAS bf16x8_t*)(L + KDT + (32 * dkt + r) * RP + (16 * ks + 8 * hf) * 2);
              const LAS unsigned char* vp = L + VT + (16 * ks + 8 * hf + (i16 >> 2)) * VP + (32 * dvt + 16 * grp + 4 * (i16 & 3)) * 2;
              const s16x4 lo = fa_vtr(vp), hi = fa_vtr(vp + 4 * VP);
              cs = __builtin_amdgcn_mfma_f32_32x32x16_bf16(a, __builtin_shufflevector(lo, hi, 0, 1, 2, 3, 4, 5, 6, 7), cs, 0, 0, 0); }
          float* gp = GCS + (size_t)u * 8192 + (size_t)(32 * dkt + 4 * hf) * 128 + 32 * dvt + r;
#pragma unroll
          for (int i = 0; i < 16; ++i) gp[((i & 3) + 8 * (i >> 2)) * 128] = cs[i]; }
        __syncthreads();
    }
#undef GLS_LOAD
}

__device__ __forceinline__ void gla_scan_phase(Frame& F) {
    float* GCS = (float*)(F.ws + WS_GCS); const float* GDEC = (const float*)(F.ws + WS_GDEC);
    for (int gt = F.gw * 64 + F.lane; gt < 64 * 2048; gt += F.NGW * 64) {
        const int bh = gt >> 11, e4 = gt & 2047, dk = e4 >> 5;
        f32x4* p = (f32x4*)(GCS + (size_t)bh * 32 * 8192) + e4; const float* dp = GDEC + (size_t)bh * 32 * 64 + dk;
        f32x4 st = (f32x4){0.f, 0.f, 0.f, 0.f};
#pragma unroll 1
        for (int n0 = 0; n0 < 32; n0 += 8) {
            f32x4 cs[8]; float dc[8];
#pragma unroll
            for (int j = 0; j < 8; ++j) { cs[j] = p[(size_t)(n0 + j) * 2048]; dc[j] = dp[(n0 + j) * 64]; }
#pragma unroll
            for (int j = 0; j < 8; ++j) { p[(size_t)(n0 + j) * 2048] = st; st = st * dc[j] + cs[j]; }
        }
    }
}

__device__ __forceinline__ void gla_out_phase(Frame& F, int l) {
    const int tid = F.tid, lane = F.lane, wave = F.wave, r = lane & 31, hf = lane >> 5, i16 = lane & 15, grp = (lane >> 4) & 1;
    LAS unsigned char* L = F.lds;
    constexpr int QG = 0, KG = 9216, VT = 18432, PT = 38912, TOT = 59392, OT = 61440, RP = 144, VP = 320, OP = 132;
    const int dk = lane, cg = wave;
    const float* GCS = (const float*)(F.ws + WS_GCS);
    v4u rc0[8], rc1[8], rv[2]; unsigned short rq[8], rk[8]; unsigned rg[8]; f32x4 rp[4];
#define GLO_LOAD(u_) do { const int bh_ = (u_) >> 5, n_ = (u_) & 31; const size_t r0_ = (size_t)((bh_ >> 2) * 2048 + 64 * n_); const int h_ = bh_ & 3; \
        _Pragma("unroll") for (int i = 0; i < 8; ++i) { const bf16* zr = F.Z + (r0_ + 8 * cg + i) * ZP; rc0[i] = *(const v4u*)(zr + ZC_CG); rc1[i] = *(const v4u*)(zr + ZC_CG + 8); rq[i] = zr[ZC_CQ + h_ * 64 + dk]; rk[i] = zr[ZC_CK + h_ * 64 + dk]; \
            rg[i] = *(const unsigned*)(zr + ZC_CR + h_ * 128 + 2 * lane); } \
        _Pragma("unroll") for (int i = 0; i < 2; ++i) rv[i] = *(const v4u*)(F.Z + (r0_ + (tid >> 4) + 32 * i) * ZP + ZC_CV + h_ * 128 + 8 * (tid & 15)); \
        _Pragma("unroll") for (int i = 0; i < 4; ++i) rp[i] = *(const f32x4*)(GCS + (size_t)(u_) * 8192 + (size_t)(tid >> 3) * 128 + 16 * (tid & 7) + 4 * i); } while (0)
    int u = F.vcu;
    if (u < 2048) GLO_LOAD(u);
    const float g0 = F.in[I_CNG][l * 128 + 2 * lane], g1 = F.in[I_CNG][l * 128 + 2 * lane + 1];
    for (; u < 2048; u += F.G) {
        const int bh = u >> 5, n = u & 31, h = bh & 3; const size_t row0 = (size_t)((bh >> 2) * 2048 + 64 * n);
        float gwv[16];
#pragma unroll
        for (int q = 0; q < 16; ++q) gwv[q] = F.in[I_CGW][(size_t)l * 4096 + q * 256 + h * 64 + dk];
        const float gb = F.in[I_CGB][l * 256 + h * 64 + dk];
        GLA_GATE_PREFIX(TOT)
        float qv[8], kv[8]; unsigned gr[8];
#pragma unroll
        for (int i = 0; i < 8; ++i) { qv[i] = bf1(rq[i]); kv[i] = bf1(rk[i]); gr[i] = rg[i]; }
#pragma unroll
        for (int i = 0; i < 2; ++i) *(LAS v4u*)(L + VT + ((tid >> 4) + 32 * i) * VP + 16 * (tid & 15)) = rv[i];
        { v4u w0, w1; w0.x = pk2(rp[0].x, rp[0].y); w0.y = pk2(rp[0].z, rp[0].w); w0.z = pk2(rp[1].x, rp[1].y); w0.w = pk2(rp[1].z, rp[1].w);
          w1.x = pk2(rp[2].x, rp[2].y); w1.y = pk2(rp[2].z, rp[2].w); w1.z = pk2(rp[3].x, rp[3].y); w1.w = pk2(rp[3].z, rp[3].w);
          *(LAS v4u*)(L + PT + (tid >> 3) * VP + 32 * (tid & 7)) = w0; *(LAS v4u*)(L + PT + (tid >> 3) * VP + 32 * (tid & 7) + 16) = w1; }
        __syncthreads();
        GLA_OFFSETS(TOT)
#pragma unroll
        for (int i = 0; i < 8; ++i) { const float bi = off + la[i];
            *(LAS bf16*)(L + QG + (8 * cg + i) * RP + 2 * dk) = (bf16)f2bf(qv[i] * 0.125f * __expf(bi));
            *(LAS bf16*)(L + KG + (8 * cg + i) * RP + 2 * dk) = (bf16)f2bf(kv[i] * __expf(-bi)); }
        __syncthreads();
        if (u + F.G < 2048) GLO_LOAD(u + F.G);
        { const int ct = wave >> 2, dvt = wave & 3;
          f32x16 o;
#pragma unroll
          for (int i = 0; i < 16; ++i) o[i] = 0.f;
#pragma unroll
          for (int st = 0; st < 2; ++st) if (st <= ct) {
              f32x16 at;
#pragma unroll
              for (int i = 0; i < 16; ++i) at[i] = 0.f;
#pragma unroll
              for (int ks = 0; ks < 4; ++ks) { const bf16x8_t a = *(const LAS bf16x8_t*)(L + KG + (32 * st + r) * RP + (16 * ks + 8 * hf) * 2), bq = *(const LAS bf16x8_t*)(L + QG + (32 * ct + r) * RP + (16 * ks + 8 * hf) * 2);
                  at = __builtin_amdgcn_mfma_f32_32x32x16_bf16(a, bq, at, 0, 0, 0); }
              if (st == ct) {
#pragma unroll
                  for (int i = 0; i < 16; ++i) { const int cr = (i & 3) + 8 * (i >> 2) + 4 * hf; at[i] = cr <= r ? at[i] : 0.f; } }
#pragma unroll
              for (int s2 = 0; s2 < 2; ++s2) {
                  v4u pw; pw.x = pg8::cvt_pk_bf16(at[8 * s2 + 0], at[8 * s2 + 1]); pw.y = pg8::cvt_pk_bf16(at[8 * s2 + 2], at[8 * s2 + 3]); pw.z = pg8::cvt_pk_bf16(at[8 * s2 + 4], at[8 * s2 + 5]); pw.w = pg8::cvt_pk_bf16(at[8 * s2 + 6], at[8 * s2 + 7]);
                  const LAS unsigned char* vp = L + VT + (32 * st + 16 * s2 + 4 * hf + (i16 >> 2)) * VP + (32 * dvt + 16 * grp + 4 * (i16 & 3)) * 2;
                  const s16x4 lo = fa_vtr(vp), hi = fa_vtr(vp + 8 * VP);
                  o = __builtin_amdgcn_mfma_f32_32x32x16_bf16(__builtin_bit_cast(bf16x8_t, pw), __builtin_shufflevector(lo, hi, 0, 1, 2, 3, 4, 5, 6, 7), o, 0, 0, 0);
              }
          }
#pragma unroll
          for (int ks = 0; ks < 4; ++ks) { const bf16x8_t a = *(const LAS bf16x8_t*)(L + QG + (32 * ct + r) * RP + (16 * ks + 8 * hf) * 2);
              const LAS unsigned char* pp = L + PT + (16 * ks + 8 * hf + (i16 >> 2)) * VP + (32 * dvt + 16 * grp + 4 * (i16 & 3)) * 2;
              const s16x4 lo = fa_vtr(pp), hi = fa_vtr(pp + 4 * VP);
              o = __builtin_amdgcn_mfma_f32_32x32x16_bf16(a, __builtin_shufflevector(lo, hi, 0, 1, 2, 3, 4, 5, 6, 7), o, 0, 0, 0); }
          LAS float* op = (LAS float*)(L + OT) + (32 * ct + 4 * hf) * OP + 32 * dvt + r;
#pragma unroll
          for (int i = 0; i < 16; ++i) op[((i & 3) + 8 * (i >> 2)) * OP] = o[i]; }
        __syncthreads();
        { float a[8], c[8], ss[8];
#pragma unroll
          for (int i = 0; i < 8; ++i) { const LAS float* orow = (const LAS float*)(L + OT) + (8 * wave + i) * OP + 2 * lane; a[i] = orow[0]; c[i] = orow[1]; ss[i] = a[i] * a[i] + c[i] * c[i]; }
#pragma unroll
          for (int o2 = 1; o2 < 64; o2 <<= 1) {
#pragma unroll
              for (int i = 0; i < 8; ++i) ss[i] += __shfl_xor(ss[i], o2); }
#pragma unroll
          for (int i = 0; i < 8; ++i) { const float rstd = rsqrtf(ss[i] * (1.0f / 128.0f) + EPS);
              *(unsigned*)(F.OCAT + (row0 + 8 * wave + i) * 2048 + 1536 + h * 128 + 2 * lane) = pk2(a[i] * rstd * g0 * bflo(gr[i]), c[i] * rstd * g1 * bfhi(gr[i])); } }
        __syncthreads();
    }
#undef GLO_LOAD
}
#undef GLA_GATE_PREFIX
#undef GLA_OFFSETS

__device__ __forceinline__ bool in_phase(int k, int lo, int hi) { asm volatile("" : "+s"(k)); return lo <= k && k < hi; }
#define IN(k) in_phase((k), lo, hi)
#define PHASE_LANE() do { int _tz = threadIdx.x; asm volatile("" : "+v"(_tz)); F.tid = _tz; F.lane = _tz & 63; } while (0)
#define SEAM(k) do { if (IN(k) && IN((k) + 1)) xcd_barrier(bar); } while (0)
template <int l>
__device__ __forceinline__ void layer_body(Frame& F, const XcdBarrier& bar, const int lo, const int hi) {
    constexpr int pb = 1 + 11 * l;
        if (IN(pb + 0)) {
            { pg8::Gemm g{(const bf16*)(F.ws + WS_HB), (const bf16*)(F.ws + WS_WIN + l * WIN_L + 24 * MiB), T, 768, D}; pg8::StaticOrder S; S.init(T, 768, D, F.G, (int)blockIdx.x);
              pg8::EpiInProj<1> E{F.Z, F.ws + WS_GT, (LAS unsigned long long*)(F.misc + MO_SS), (const LAS float*)(F.misc + MO_GN) + l * 512, (const float*)(F.ws + WS_RSTD1)};
              pg8::gemm_phase<pg8::EpiInProj<1>, pg8::StaticOrder, true, false>(F.lds, g, S, E); }
            { pg8::Gemm g{(const bf16*)(F.ws + WS_XN8), (const bf16*)(F.ws + WS_WIN + l * WIN_L), T, 10496, D / 2}; pg8::StaticOrder S; S.init(T, 10496, D / 2, F.G, ((int)blockIdx.x + F.G / 2) % F.G);
              pg8::EpiInProj<0> E{F.Z, F.ws + WS_GT, (LAS unsigned long long*)(F.misc + MO_SS), (const LAS float*)(F.misc + MO_GN) + l * 512, (const float*)(F.ws + WS_RSTD1)};
              pg8::gemm_phase<pg8::EpiInProj<0>, pg8::StaticOrder, true, true>(F.lds, g, S, E); }
        }
        SEAM(pb + 0);
        if (IN(pb + 1)) { PHASE_LANE();
            if (F.wave & 4) convert_moe(F, l, 0, 4, 40960);
            for (int it = F.gw; it < NB * 128; it += F.NGW) {
                const int b = it >> 7, j = it & 127;
                indexer_segment(F, b, j, 0, j < 64 ? j + 1 : 64);
                if (j < 64) indexer_segment(F, b, 127 - j, 64, 128 - j);
            }
            if (!(F.wave & 4)) convert_moe(F, l, 0, 4, 40960);
            PHASE_LANE();
            gla_state_phase(F, l);
        }
        SEAM(pb + 1);
        if (IN(pb + 2)) { PHASE_LANE();
            if (F.wave & 4) convert_moe(F, l, 1, 4, 0);
            for (int row = F.gw; row < T; row += F.NGW) {
                const int t = row & 2047;
                if (t < 256) { const int nb = t + 1 - 32 * F.lane; F.MASK[(size_t)row * 64 + F.lane] = nb >= 32 ? 0xffffffffu : (nb <= 0 ? 0u : ((1u << nb) - 1u)); continue; }
                float val[32];
#pragma unroll
                for (int j = 0; j < 32; ++j) { const int s_ = 64 * j + F.lane; val[j] = F.S[(size_t)row * 2048 + (s_ < t ? s_ : t)]; }
                float vmx = -3.0e38f, vmn = 3.0e38f;
#pragma unroll
                for (int j = 0; j < 32; ++j) { const bool ok = 64 * j + F.lane <= t; val[j] = ok ? val[j] : -3.0e38f; vmx = fmaxf(vmx, val[j]); vmn = fminf(vmn, ok ? val[j] : 3.0e38f); }
#pragma unroll
                for (int o = 1; o < 64; o <<= 1) { vmx = fmaxf(vmx, __shfl_xor(vmx, o)); vmn = fminf(vmn, __shfl_xor(vmn, o)); }
                float lo = vmn, hi = vmx, thf = 0.f; bool exact = false;
#pragma unroll 1
                for (int it = 0; it < 28; ++it) { const float mid = 0.5f * (lo + hi); if (!(mid > lo && mid < hi)) break; int cnt = 0;
#pragma unroll
                    for (int j = 0; j < 32; ++j) cnt += __popcll(__ballot(val[j] >= mid));
                    if (cnt == 256) { exact = true; thf = mid; break; }
                    if (cnt > 256) lo = mid; else hi = mid; }
                unsigned th = 0u; int need = 0;
#define KEYOF(x) ({ const unsigned u_ = __float_as_uint(x); (u_ & 0x80000000u) ? ~u_ : (u_ | 0x80000000u); })
                if (!exact) {
#pragma unroll 1
                    for (int bit = 31; bit >= 0; --bit) { const unsigned cand = th | (1u << bit); int cnt = 0;
#pragma unroll
                        for (int j = 0; j < 32; ++j) cnt += __popcll(__ballot(KEYOF(val[j]) >= cand));
                        if (cnt >= 256) th = cand; }
                    int cgt = 0;
#pragma unroll
                    for (int j = 0; j < 32; ++j) cgt += __popcll(__ballot(KEYOF(val[j]) > th));
                    need = 256 - cgt;
                }
                int run = 0; unsigned myword = 0u;
#pragma unroll
                for (int j = 0; j < 32; ++j) {
                    bool sel;
                    if (exact) sel = val[j] >= thf;
                    else { const unsigned kj = KEYOF(val[j]); const bool eq = kj == th; const unsigned long long eqm = __ballot(eq);
                        const int pre = run + __popcll(eqm & ((1ull << F.lane) - 1ull)); sel = (kj > th) || (eq && pre < need); run += __popcll(eqm); sel = sel && (64 * j + F.lane <= t); }
                    const unsigned long long sm = __ballot(sel);
                    if ((F.lane >> 1) == j) myword = (F.lane & 1) ? (unsigned)(sm >> 32) : (unsigned)sm;
                }
#undef KEYOF
                F.MASK[(size_t)row * 64 + F.lane] = myword;
            }
            if (!(F.wave & 4)) convert_moe(F, l, 1, 4, 0);
            gla_scan_phase(F);
        }
        SEAM(pb + 2);
        if (IN(pb + 3)) { PHASE_LANE();
            if (F.vcu & 1) { convert_moe(F, l, 1, 2, 0); __syncthreads(); PHASE_LANE(); }
            for (int u = F.vcu; u < NB * 16; u += F.G) { const int b = u >> 4, p = u & 15; flash_unit<0>(F, l, b, 0, 64 * (31 - p)); flash_unit<0>(F, l, b, 0, 64 * p); }
            for (int u = F.vcu; u < NB * 2 * 32; u += F.G) { const int b = u >> 6, g = (u >> 5) & 1, qb = u & 31; flash_unit<1>(F, l, b, g, 64 * qb); }
            gla_out_phase(F, l);
            if (!(F.vcu & 1)) { PHASE_LANE(); convert_moe(F, l, 1, 2, 0); }
        }
        SEAM(pb + 3);
        if (IN(pb + 4)) {
            pg8::Gemm g{F.OCAT, (const bf16*)(F.ws + WS_WBR + l * WBR_L), T, D, D}; pg8::MergeOrder S; S.init(T, D, D, F.G, (int)blockIdx.x);
#ifdef PROBE_MERGE
            { pg8::EpiMergeT<PROBE_MERGE> E{F.ws + WS_GT, (bf16*)(F.ws + WS_S)}; pg8::gemm_phase<pg8::EpiMergeT<PROBE_MERGE>, pg8::MergeOrder, true>(F.lds, g, S, E); }
#endif
            pg8::EpiMerge E{F.ws + WS_GT, F.MERGED};
            pg8::gemm_phase<pg8::EpiMerge, pg8::MergeOrder, true>(F.lds, g, S, E);
        }
        SEAM(pb + 4);
        if (IN(pb + 5)) {
            pg8::Gemm g{F.MERGED, (const bf16*)(F.ws + WS_WO + l * WO_L), T, D, D}; pg8::StaticOrder S; S.init(T, D, D, F.G, (int)blockIdx.x);
            pg8::EpiResid E{(bf16*)(F.ws + WS_HB), (unsigned char*)F.XN, F.in[I_N2G] + l * D, F.lds + 3 * pg8::HTB};
            pg8::gemm_phase<pg8::EpiResid, pg8::StaticOrder, true>(F.lds, g, S, E);
        }
        SEAM(pb + 5);
        if (IN(pb + 6)) { PHASE_LANE();
            unsigned* cnt = F.ctl + CW_CNT + 64 * l;
            const int lane = F.lane, fr = lane & 15, fq = lane >> 4;
            const int kh = F.wave & 1, tg = F.wave >> 1;
            LAS float* P = (LAS float*)F.lds;
            const bf16* wrh = (const bf16*)(F.ws + WS_WRH + l * WR_L) + (size_t)fr * 2048 + 8 * fq + 1024 * kh; const bf16* wrl = (const bf16*)(F.ws + WS_WRL + l * WR_L) + (size_t)fr * 2048 + 8 * fq + 1024 * kh;
            for (int unit = F.vcu; unit < T / 128; unit += F.G) {
                const bf16* hrow0 = (const bf16*)(F.ws + WS_HB) + (size_t)(128 * unit + 32 * tg + fr) * D + 8 * fq + 1024 * kh;
                const bf16* hrow1 = hrow0 + (size_t)16 * D;
                f32x4 acc0[5], acc1[5];
#pragma unroll
                for (int nt = 0; nt < 5; ++nt) { acc0[nt] = (f32x4){0.f, 0.f, 0.f, 0.f}; acc1[nt] = (f32x4){0.f, 0.f, 0.f, 0.f}; }
                float ss0 = 0.f, ss1 = 0.f;
#pragma unroll 2
                for (int ks = 0; ks < 32; ++ks) {
                    const v4u hw0 = *(const v4u*)(hrow0 + 32 * ks), hw1 = *(const v4u*)(hrow1 + 32 * ks);
                    { const float a0 = bflo(hw0.x), a1 = bfhi(hw0.x), a2 = bflo(hw0.y), a3 = bfhi(hw0.y), a4 = bflo(hw0.z), a5 = bfhi(hw0.z), a6 = bflo(hw0.w), a7 = bfhi(hw0.w);
                      ss0 += (a0 * a0 + a1 * a1) + (a2 * a2 + a3 * a3) + (a4 * a4 + a5 * a5) + (a6 * a6 + a7 * a7); }
                    { const float a0 = bflo(hw1.x), a1 = bfhi(hw1.x), a2 = bflo(hw1.y), a3 = bfhi(hw1.y), a4 = bflo(hw1.z), a5 = bfhi(hw1.z), a6 = bflo(hw1.w), a7 = bfhi(hw1.w);
                      ss1 += (a0 * a0 + a1 * a1) + (a2 * a2 + a3 * a3) + (a4 * a4 + a5 * a5) + (a6 * a6 + a7 * a7); }
                    const bf16x8_t ah0 = __builtin_bit_cast(bf16x8_t, hw0), ah1 = __builtin_bit_cast(bf16x8_t, hw1);
#pragma unroll
                    for (int nt = 0; nt < 5; ++nt) { const bf16x8_t bh = *(const bf16x8_t*)(wrh + (size_t)(16 * nt) * 2048 + 32 * ks), bl = *(const bf16x8_t*)(wrl + (size_t)(16 * nt) * 2048 + 32 * ks);
                        acc0[nt] = __builtin_amdgcn_mfma_f32_16x16x32_bf16(ah0, bh, acc0[nt], 0, 0, 0);
                        acc0[nt] = __builtin_amdgcn_mfma_f32_16x16x32_bf16(ah0, bl, acc0[nt], 0, 0, 0);
                        acc1[nt] = __builtin_amdgcn_mfma_f32_16x16x32_bf16(ah1, bh, acc1[nt], 0, 0, 0);
                        acc1[nt] = __builtin_amdgcn_mfma_f32_16x16x32_bf16(ah1, bl, acc1[nt], 0, 0, 0); }
                }
                ss0 += __shfl_xor(ss0, 16); ss0 += __shfl_xor(ss0, 32); ss1 += __shfl_xor(ss1, 16); ss1 += __shfl_xor(ss1, 32);
                { LAS float* L0 = P + (kh * 8 + 2 * tg) * 2048; LAS float* L1 = L0 + 2048;
                  if (fq == 0) { L0[1616 + fr] = ss0; L1[1616 + fr] = ss1; }
#pragma unroll
                  for (int nt = 0; nt < 5; ++nt)
#pragma unroll
                      for (int i = 0; i < 4; ++i) { L0[(4 * fq + i) * 100 + 16 * nt + fr] = acc0[nt][i]; L1[(4 * fq + i) * 100 + 16 * nt + fr] = acc1[nt][i]; } }
                __syncthreads();
                const int tile = 8 * unit + F.wave;
                LAS float* LG = P + F.wave * 2048; const LAS float* LH = LG + 8 * 2048;
                for (int idx = lane; idx < 1600; idx += 64) LG[idx] += LH[idx];
                if (lane < 16) { const float ss = LG[1616 + lane] + LH[1616 + lane]; const float rs_ = rsqrtf(ss * (1.0f / 2048.0f) + EPS); LG[1600 + lane] = rs_; ((float*)(F.ws + WS_RSTD))[16 * tile + lane] = rs_; }
                LDS_WAIT(); asm volatile("" ::: "memory");
                if (lane < 16) {
                    const int row = 16 * tile + lane; const float rstd = LG[1600 + lane]; const LAS float* lr = LG + lane * 100;
                    float lg[8]; int grp = 0; float gmax = -3.0e38f;
#pragma unroll
                    for (int e = 0; e < 8; ++e) { lg[e] = lr[e] * rstd + F.in[I_BRG][l * 8 + e]; if (lg[e] > gmax) { gmax = lg[e]; grp = e; } }
                    float gden = 0.f;
#pragma unroll
                    for (int e = 0; e < 8; ++e) gden += __expf(lg[e] - gmax);
                    const float gwt = 1.0f / gden;
                    int i0 = 0, i1 = 0; float m0 = -3.0e38f, m1 = -3.0e38f;
#pragma unroll
                    for (int e = 0; e < 8; ++e) { const float v = lr[8 + grp * 8 + e] * rstd + F.in[I_BRE][l * 64 + grp * 8 + e];
                        if (v > m0) { m1 = m0; i1 = i0; m0 = v; i0 = e; } else if (v > m1) { m1 = v; i1 = e; } }
                    const float e1 = __expf(m1 - m0); const float p0 = 1.0f / (1.0f + e1), p1 = e1 / (1.0f + e1);
                    const int ex0 = grp * 8 + i0, ex1 = grp * 8 + i1;
                    const unsigned r0 = atomicAdd(&cnt[ex0], 1u), r1 = atomicAdd(&cnt[ex1], 1u);
                    unsigned* rec = (unsigned*)(F.ws + WS_ROUTE) + (size_t)row * 8;
                    rec[0] = (unsigned)ex0; rec[1] = r0; rec[2] = (unsigned)ex1; rec[3] = r1; rec[4] = __float_as_uint(gwt * p0); rec[5] = __float_as_uint(gwt * p1);
                    int* liste = (int*)(F.ws + WS_LISTE); liste[(size_t)ex0 * 32768 + r0] = row; liste[(size_t)ex1 * 32768 + r1] = row;
                }
                LDS_WAIT(); asm volatile("" ::: "memory");
                __syncthreads();
            }
        }
        SEAM(pb + 6);
        if (IN(pb + 7) || IN(pb + 8) || IN(pb + 9) || IN(pb + 10)) { PHASE_LANE();
            if (F.tid == 0) { const unsigned* cnt = F.ctl + CW_CNT + 64 * l; LAS int* texp = (LAS int*)(F.misc + MO_TEXP); LAS int* pst = (LAS int*)(F.misc + MO_PST); int tb = 0;
                for (int e = 0; e < NEXP; ++e) { const int c = (int)__hip_atomic_load(&cnt[e], __ATOMIC_RELAXED, __HIP_MEMORY_SCOPE_AGENT); const int nt_ = (c + 255) >> 8; pst[e] = tb * 256; ((LAS int*)(F.misc + MO_CNT))[e] = c;
                    for (int r = 0; r < nt_; ++r) texp[tb + r] = e; tb += nt_; }
                *(LAS int*)(F.misc + MO_TOT) = tb; }
            __syncthreads();
        }
        if (IN(pb + 8)) {
            pg8::Gemm g{F.XN, (const bf16*)(F.ws + WS_W13), 0, 0, D / 2};
            pg8::MoeGatherOrder S; S.total = *(const LAS int*)(F.misc + MO_TOT) * 4; S.G = F.G; S.c = F.vcu; S.NJ = 4; S.nt0 = D / 128; S.tile_exp = (const LAS int*)(F.misc + MO_TEXP);
            S.pst = (const LAS int*)(F.misc + MO_PST); S.cnt = (const LAS int*)(F.misc + MO_CNT); S.liste = (const int*)(F.ws + WS_LISTE);
            pg8::EpiGlu E{F.H, S.tile_exp, S.pst, S.cnt, S.liste, (const float*)(F.ws + WS_RSTD)};
            pg8::gemm_phase<pg8::EpiGlu, pg8::MoeGatherOrder, true, true>(F.lds, g, S, E);
        }
        SEAM(pb + 8);
        if (IN(pb + 9)) {
            pg8::Gemm g{F.H, (const bf16*)(F.ws + WS_W2), 0, 0, DEXP / 2};
            pg8::MoeOrder S{*(const LAS int*)(F.misc + MO_TOT) * 8, F.G, F.vcu, 8, DEXP / 128, (const LAS int*)(F.misc + MO_TEXP)};
            pg8::EpiY E{(unsigned char*)F.Y};
            pg8::gemm_phase<pg8::EpiY, pg8::MoeOrder, true, true>(F.lds, g, S, E);
        }
        SEAM(pb + 9);
        if (IN(pb + 10)) { PHASE_LANE();
            for (int row = F.gw; row < T; row += F.NGW) {
                const unsigned* rec = (const unsigned*)(F.ws + WS_ROUTE) + (size_t)row * 8;
                const float w0 = __uint_as_float(rec[4]) * 0.03125f, w1 = __uint_as_float(rec[5]) * 0.03125f;
                const LAS int* pst = (const LAS int*)(F.misc + MO_PST); const int p0 = pst[rec[0]] + (int)rec[1], p1 = pst[rec[2]] + (int)rec[3];
                const unsigned* y0 = (const unsigned*)((const unsigned char*)F.Y + (size_t)p0 * D) + F.lane; const unsigned* y1 = (const unsigned*)((const unsigned char*)F.Y + (size_t)p1 * D) + F.lane;
                f32x4 v[8];
                { const v2u* hr = (const v2u*)((const bf16*)(F.ws + WS_HB) + (size_t)row * D) + F.lane;
#pragma unroll
                  for (int j = 0; j < 8; ++j) { const v2u w = hr[64 * j]; v[j] = (f32x4){bflo(w.x), bfhi(w.x), bflo(w.y), bfhi(w.y)}; } }
#pragma unroll
                for (int j = 0; j < 8; ++j) { const int a = (int)y0[64 * j], c = (int)y1[64 * j];
                    const auto a01 = __builtin_amdgcn_cvt_pk_f32_fp8(a, false), a23 = __builtin_amdgcn_cvt_pk_f32_fp8(a, true), c01 = __builtin_amdgcn_cvt_pk_f32_fp8(c, false), c23 = __builtin_amdgcn_cvt_pk_f32_fp8(c, true);
                    v[j].x += w0 * a01[0] + w1 * c01[0]; v[j].y += w0 * a01[1] + w1 * c01[1]; v[j].z += w0 * a23[0] + w1 * c23[0]; v[j].w += w0 * a23[1] + w1 * c23[1]; }
                if (l + 1 < DEPTH) { v2u* hw_ = (v2u*)((bf16*)(F.ws + WS_HB) + (size_t)row * D) + F.lane;
#pragma unroll
                    for (int j = 0; j < 8; ++j) hw_[64 * j] = (v2u){pg8::cvt_pk_bf16(v[j].x, v[j].y), pg8::cvt_pk_bf16(v[j].z, v[j].w)}; }
                else { f32x4* orow = (f32x4*)(F.out + (size_t)row * D) + F.lane;
#pragma unroll
                    for (int j = 0; j < 8; ++j) orow[64 * j] = v[j]; }
                if (l + 1 < DEPTH) { const float rstd = row_rstd(v); if (F.lane == 0) ((float*)(F.ws + WS_RSTD1))[row] = rstd; norm_store_fp8(v, rstd, F.in[I_N1G] + (l + 1) * D, (unsigned char*)(F.ws + WS_XN8) + (size_t)row * D, F.lane); }
            }
        }
        SEAM(pb + 10);
    }
__global__ void __launch_bounds__(NWAVES * 64, 2) fwd_kernel(Args args) {
    extern __shared__ __attribute__((aligned(16))) unsigned char lds_raw[];
    Frame F;
    F.lds = (LAS unsigned char*)lds_raw; F.misc = F.lds + MISC_OFF;
    F.tid = threadIdx.x; F.lane = F.tid & 63; F.wave = __builtin_amdgcn_readfirstlane(F.tid >> 6);
    F.G = gridDim.x; { const int bx = blockIdx.x; F.vcu = (F.G % 8 == 0) ? (bx % 8) * (F.G / 8) + bx / 8 : bx; }
    F.gw = F.vcu * NWAVES + F.wave; F.NGW = F.G * NWAVES;
    F.in = args.in; F.out = args.out; F.ws = args.ws; F.ctl = (unsigned*)(args.ws + WS_CTL);
    F.Z = (bf16*)(args.ws + WS_Z); F.XN = (bf16*)(args.ws + WS_XN); F.OCAT = (bf16*)(args.ws + WS_OCAT); F.MERGED = (bf16*)(args.ws + WS_MERGED);
    F.XS = (bf16*)(args.ws + WS_XS); F.Y = (bf16*)(args.ws + WS_Y); F.H = (bf16*)(args.ws + WS_H);
    F.S = (float*)(args.ws + WS_S); F.GO = (float*)(args.ws + WS_GO); F.MASK = (unsigned*)(args.ws + WS_MASK);
    const int lo = args.ph_lo, hi = args.ph_hi;
    const bool use_bar = (hi - lo) > 1;
    for (int u = F.tid; u < 64; u += NWAVES * 64) ((LAS unsigned*)F.misc)[u] = 0u;
    ((LAS unsigned long long*)(F.misc + MO_SS))[F.tid] = 0ull;
    for (int i = F.tid; i < 2 * 4 * 128; i += NWAVES * 64) { const int l_ = i >> 9, k_ = (i >> 7) & 3, d_ = i & 127; ((LAS float*)(F.misc + MO_GN))[i] = F.in[k_ == 0 ? I_AQG : (k_ == 1 ? I_AKG : (k_ == 2 ? I_BQG : I_BKG))][l_ * 128 + d_]; }
    for (int i = F.tid; i < 12 * 129; i += NWAVES * 64) { const int hd = i / 129, dd = i % 129; int bk;
        if (dd < 16) bk = dd; else { bk = 16 + (int)(logf((float)dd / 16.0f) / 2.0794415416798357f * 16.0f); bk = bk > 31 ? 31 : bk; }
        ((LAS float*)(F.misc + MO_TAB2))[i] = F.in[I_RELB][bk * 12 + hd] * 1.4426950408889634f; }
    __syncthreads();
    XcdBarrier bar; bar.bar = F.ctl + CW_BAR; bar.x = 0; bar.st = nullptr;
    if (use_bar) bar = xcd_barrier_post(F.ctl + CW_BAR, (volatile LAS unsigned*)(F.misc + MO_BARW));

    if (IN(0)) { PHASE_LANE();
        LAS float* scr = (LAS float*)(F.lds + F.wave * 16384);
        constexpr int I_IN = (2048 / 64) * (D_IN / 32);
        constexpr int I_BA = (512 / 64) * (2048 / 32), I_BB = (1024 / 64) * (2048 / 32), I_BC = I_BA, I_O = (2048 / 64) * (2048 / 32);
        constexpr int PER_L = I_IN + I_BA + I_BB + I_BC + I_O;
        for (int it = F.gw; it < DEPTH * PER_L; it += F.NGW) {
            const int l = it / PER_L; int r = it % PER_L;
            bf16* win = (bf16*)(F.ws + WS_WIN + l * WIN_L); bf16* wbr = (bf16*)(F.ws + WS_WBR + l * WBR_L); bf16* wo = (bf16*)(F.ws + WS_WO + l * WO_L);
            if (r < I_IN) { const int nb_ = r % (D_IN / 32);
                const bool has8 = nb_ < 56 || (nb_ >= 58 && nb_ <= 106) || nb_ >= 122, hasb = (nb_ >= 56 && nb_ <= 58) || (nb_ >= 106 && nb_ <= 122) || nb_ == 138;
                if (has8) transpose_item_fp8(F.in[I_WIN] + (size_t)l * 2048 * D_IN, D_IN, (unsigned char*)win, 2048, 64.0f, scr, r, F.lane, MapWin8{});
                if (hasb) transpose_item(F.in[I_WIN] + (size_t)l * 2048 * D_IN, D_IN, win + (size_t)12 * 1024 * 1024, 2048, 0, scr, r, F.lane, MapWinB{}, F.in[I_N1G] + l * D);
                continue; } r -= I_IN;
            if (r < I_BA) { transpose_item(F.in[I_WBA] + (size_t)l * 512 * 2048, 2048, wbr, 2048, 0, scr, r, F.lane, MapId{0}); continue; } r -= I_BA;
            if (r < I_BB) { transpose_item(F.in[I_WBB] + (size_t)l * 1024 * 2048, 2048, wbr, 2048, 512, scr, r, F.lane, MapId{0}); continue; } r -= I_BB;
            if (r < I_BC) { transpose_item(F.in[I_WBC] + (size_t)l * 512 * 2048, 2048, wbr, 2048, 1536, scr, r, F.lane, MapId{0}); continue; } r -= I_BC;
            transpose_item(F.in[I_WO] + (size_t)l * 2048 * 2048, 2048, wo, 2048, 0, scr, r, F.lane, MapId{0});
        }
        for (int i = F.gw * 64 + F.lane; i < DEPTH * 160 * 256; i += F.NGW * 64) { const int l = i / (160 * 256), r = (i / 256) % 160, c = i % 256;
            *(v4u*)((bf16*)(F.ws + WS_WIN + l * WIN_L) + (size_t)12 * 1024 * 1024 + (size_t)(ZC_PAD - 3328 + r) * 2048 + 8 * c) = (v4u){0u, 0u, 0u, 0u}; }
        for (int i = F.gw * 64 + F.lane; i < DEPTH * 96 * 2048; i += F.NGW * 64) { const int l = i / (96 * 2048), e = (i / 2048) % 96, k = i % 2048;
            float val = 0.f; if (e < 8) val = F.in[I_WRG][(size_t)l * D * 8 + (size_t)k * 8 + e]; else if (e < 72) val = F.in[I_WRE][(size_t)l * D * 64 + (size_t)k * 64 + (e - 8)];
            val *= F.in[I_N2G][l * D + k];
            const unsigned hi = f2bf(val); const float rem = val - bf1((bf16)hi);
            ((bf16*)(F.ws + WS_WRH + l * WR_L))[e * 2048 + k] = (bf16)hi; ((bf16*)(F.ws + WS_WRL + l * WR_L))[e * 2048 + k] = (bf16)f2bf(rem); }
        for (int mrow = F.gw; mrow < T; mrow += F.NGW) { f32x4 v[8]; load_row(F.in[I_X] + (size_t)mrow * D, F.lane, v); const float rstd = row_rstd(v);
            { v2u* hw_ = (v2u*)((bf16*)(F.ws + WS_HB) + (size_t)mrow * D) + F.lane;
#pragma unroll
              for (int j = 0; j < 8; ++j) hw_[64 * j] = (v2u){pg8::cvt_pk_bf16(v[j].x, v[j].y), pg8::cvt_pk_bf16(v[j].z, v[j].w)}; }
            if (F.lane == 0) ((float*)(F.ws + WS_RSTD1))[mrow] = rstd;
            norm_store_fp8(v, rstd, F.in[I_N1G], (unsigned char*)(F.ws + WS_XN8) + (size_t)mrow * D, F.lane); }
    }
    SEAM(0);

    layer_body<0>(F, bar, lo, hi);
    layer_body<1>(F, bar, lo, hi);
}


#ifndef N_LAUNCH_MODE
#define N_LAUNCH_MODE 1
#endif
extern "C" void kernel_launch(void* const* d_in, const int* in_sizes, int n_in, void* d_out, int out_size, void* d_ws, size_t ws_size, hipStream_t stream) {
    static int grid = 0;
    if (grid == 0) {
        if (n_in != 24 || out_size != T * D || ws_size < WS_END) { fprintf(stderr, "kernel_launch: unexpected shapes (n_in %d out %d ws %zu)\n", n_in, out_size, ws_size); grid = -1; return; }
        int dev = 0, cus = 0, per_cu = 0;
        if (hipGetDevice(&dev) != hipSuccess || hipDeviceGetAttribute(&cus, hipDeviceAttributeMultiprocessorCount, dev) != hipSuccess) { grid = -1; return; }
        if (hipFuncSetAttribute((const void*)fwd_kernel, hipFuncAttributeMaxDynamicSharedMemorySize, LDS_BYTES) != hipSuccess) { fprintf(stderr, "kernel_launch: hipFuncSetAttribute failed\n"); grid = -1; return; }
        if (hipOccupancyMaxActiveBlocksPerMultiprocessor(&per_cu, (const void*)fwd_kernel, NWAVES * 64, LDS_BYTES) != hipSuccess || per_cu < 1) { fprintf(stderr, "kernel_launch: occupancy query says %d\n", per_cu); }
        (void)hipGetLastError();
        grid = cus;
    }
    if (grid < 0) return;
    (void)hipMemsetAsync((char*)d_ws + WS_CTL, 0, CTL_ZERO_BYTES, stream);
    Args a{};
    for (int i = 0; i < 24; ++i) a.in[i] = (const float*)d_in[i];
    a.out = (float*)d_out; a.ws = (unsigned char*)d_ws;
    constexpr int NPH = 1 + 11 * DEPTH;
#if N_LAUNCH_MODE == 1
    a.ph_lo = 0; a.ph_hi = NPH;
    hipLaunchKernelGGL(fwd_kernel, dim3(grid), dim3(NWAVES * 64), LDS_BYTES, stream, a);
#else
    for (int p = 0; p < NPH; ++p) { a.ph_lo = p; a.ph_hi = p + 1; hipLaunchKernelGGL(fwd_kernel, dim3(grid), dim3(NWAVES * 64), LDS_BYTES, stream, a); }
#endif
    const hipError_t le = hipPeekAtLastError();
    if (le != hipSuccess) fprintf(stderr, "kernel_launch: launch failed: %s\n", hipGetErrorName(le));
}
```

```cpp
#include <hip/hip_runtime.h>
#include <cstdio>
#include <cstdint>

__device__ __forceinline__ int lane_id() { return (int)__builtin_amdgcn_mbcnt_hi(~0u, __builtin_amdgcn_mbcnt_lo(~0u, 0u)); }
namespace pg8 {
#define PG8_LAS __attribute__((address_space(3)))
typedef unsigned short bf16_t;
typedef short bf16x8 __attribute__((ext_vector_type(8)));
typedef float f32x4 __attribute__((ext_vector_type(4)));
typedef unsigned u32x4 __attribute__((ext_vector_type(4)));
typedef unsigned u32x2 __attribute__((ext_vector_type(2)));
constexpr int BM = 256, BK = 64, HALF = 128, HTB = HALF * BK * 2  , STAGE_BYTES = 8 * HTB, NXCD = 8, WGM = 8;

__host__ __device__ __forceinline__ int lds_byte(int r, int c) { const int st = (r >> 4) * 2 + (c >> 5), rr = r & 15, cc = c & 31, ob = rr * 64 + cc * 2; return st * 1024 + (ob ^ (((ob >> 9) & 1) << 5)); }
__host__ __device__ __forceinline__ void stage_rc(int b, int& R, int& C) { const int st = b / 1024, sb = b % 1024, swz = sb ^ (((sb >> 9) & 1) << 5); R = (st >> 1) * 16 + swz / 64; C = (st & 1) * 32 + (swz % 64) / 2; }
__host__ __device__ __forceinline__ int perm32(int rho) { const int n = rho >> 4, i = rho & 15; return 8 * (i >> 2) + 4 * n + (i & 3); }

struct Unit { int pm, pn, koff, nt, seg; };
struct Gemm { const bf16_t* A; const bf16_t* Bt; int M, N, K; };

struct StaticOrder {
    static constexpr bool GATHER = false;
    int nM, nN, nwg, G, c, nt0;
    __device__ __forceinline__ int row_token(const Unit&, int) const { return 0; }
    __device__ void init(int M, int N, int K, int G_, int c_) { nM = M / BM; nN = N / BM; nwg = nM * nN; G = G_; c = c_; nt0 = K / BK; }
    __device__ bool tile(long L, Unit& u) const {
        if (L >= nwg) return false;
        int wgid = (int)L; { const int q = nwg / NXCD, r = nwg % NXCD, xcd = wgid % NXCD, off = wgid / NXCD; wgid = (xcd < r ? xcd * (q + 1) : r * (q + 1) + (xcd - r) * q) + off; }
        const int nig = WGM * nN, gid = wgid / nig, fm = gid * WGM, gsz = (nM - fm) < WGM ? (nM - fm) : WGM;
        u.pm = fm + ((wgid % nig) % gsz); u.pn = (wgid % nig) / gsz; return true;
    }
    __device__ bool next(int i, Unit& u) const { u.koff = 0; u.nt = nt0; u.seg = 0; return tile((long)i * G + c, u); }
    __device__ __forceinline__ void a_ready(const Unit&) const {}
    __device__ __forceinline__ void done(const Unit&) const {}
};
struct MergeOrder : StaticOrder {
    __device__ bool next(int i, Unit& u) const { const int rnd = i / 3, sg = i - 3 * rnd; u.seg = sg; u.koff = sg == 0 ? 0 : (sg == 1 ? 512 : 1536); u.nt = sg == 1 ? 16 : 8; return tile((long)rnd * G + c, u); }
};
struct MoeOrder {
    static constexpr bool GATHER = false;
    int total, G, c, NJ, nt0; const PG8_LAS int* tile_exp;
    __device__ bool next(int i, Unit& u) const {
        const long L = (long)i * G + c; if (L >= total) return false;
        const int R = (int)L / NJ, j = (int)L % NJ; u.pm = R; u.pn = tile_exp[R] * NJ + j; u.koff = 0; u.nt = nt0; u.seg = 0; return true;
    }
    __device__ __forceinline__ int row_token(const Unit&, int) const { return 0; }
    __device__ __forceinline__ void a_ready(const Unit&) const {}
    __device__ __forceinline__ void done(const Unit&) const {}
};
struct MoeGatherOrder : MoeOrder {
    static constexpr bool GATHER = true;
    const PG8_LAS int* pst; const PG8_LAS int* cnt; const int* liste;
    __device__ __forceinline__ int row_token(const Unit& u, int r) const {
        const int e = tile_exp[u.pm], lr = u.pm * 256 - pst[e] + r;
        return lr < cnt[e] ? liste[(size_t)e * 32768 + lr] : 0;
    }
};

typedef __bf16 bf16x2v __attribute__((ext_vector_type(2)));
typedef float f32x2v __attribute__((ext_vector_type(2)));
__device__ __forceinline__ unsigned cvt_pk_bf16(float lo, float hi) { const f32x2v v = {lo, hi}; const bf16x2v b = __builtin_convertvector(v, bf16x2v); return __builtin_bit_cast(unsigned, b); }
__device__ __forceinline__ float bflo(unsigned w) { return __uint_as_float(w << 16); }
__device__ __forceinline__ float bfhi(unsigned w) { return __uint_as_float(w & 0xffff0000u); }
__device__ __forceinline__ float sigm(float v) { return __builtin_amdgcn_rcpf(1.0f + __builtin_amdgcn_exp2f(-1.44269504f * v)); }
__device__ __forceinline__ unsigned q8x4(const f32x4 s) {
    const unsigned a = (unsigned)fminf(s[0], 255.5f), b = (unsigned)fminf(s[1], 255.5f), c = (unsigned)fminf(s[2], 255.5f), d = (unsigned)fminf(s[3], 255.5f);
    return a | (b << 8) | (c << 16) | (d << 24);
}

constexpr int ZP = 5120;
constexpr int ZC_GA = 5120, ZC_GB = 7168, ZC_GC = 9216;
constexpr size_t GT_TILE = 65536, GT_GATE = (size_t)128 * 8 * GT_TILE;

template <int PN_OFF> struct EpiInProj {
    static constexpr bool PERM = true, AFTER_DRAIN = false, CHAIN = false;
    bf16_t* O; unsigned char* GT; PG8_LAS unsigned long long* ss;
    const PG8_LAS float* gains;
    const float* rstd;
    __device__ __forceinline__ void operator()(const f32x4 (&acc)[2][2][4][2], const Unit& u, int wr, int wc, int fr, int fq) const {
        const int pn = PN_OFF ? u.pn + 13 : (u.pn < 13 ? u.pn : u.pn + 3);
        int row0 = u.pm * BM + wr * 64 + fr, col0 = pn * BM + wc * 32 + 8 * fq;
        asm volatile("" : "+v"(row0), "+v"(col0));
        const int act = pn >= 20 ? 2 : (pn >= 18 ? 1 : 0);
        const bool hn = PN_OFF == 0 && pn <= 7;
        f32x4 gn0 = (f32x4){1.f, 1.f, 1.f, 1.f}, gn1 = gn0; int lr = 0;
        if (hn) {
            lr = wr * 64 + fr; asm volatile("" : "+v"(lr));
#pragma unroll
            for (int ai = 0; ai < 2; ++ai)
#pragma unroll
                for (int m = 0; m < 4; ++m)
#pragma unroll
                    for (int bj = 0; bj < 2; ++bj) { const f32x4 a = acc[ai][bj][m][0], b = acc[ai][bj][m][1];
                        float s = (a[0] * a[0] + a[1] * a[1]) + (a[2] * a[2] + a[3] * a[3]) + (b[0] * b[0] + b[1] * b[1]) + (b[2] * b[2] + b[3] * b[3]);
                        s += __shfl_xor(s, 16); s += __shfl_xor(s, 32);
                        if (fq == 0) __hip_atomic_fetch_add(ss + (ai * HALF + m * 16 + lr) * 2 + bj, (unsigned long long)(s * 1048576.0f), __ATOMIC_RELAXED, __HIP_MEMORY_SCOPE_WORKGROUP); }
            asm volatile("s_waitcnt lgkmcnt(0)" ::: "memory"); __builtin_amdgcn_s_barrier(); asm volatile("" ::: "memory");
            const PG8_LAS float* gp = gains + (pn <= 1 ? 0 : (pn == 2 ? 128 : (pn <= 6 ? 256 : 384))) + wc * 32 + 8 * fq;
            gn0 = *(const PG8_LAS f32x4*)gp; gn1 = *(const PG8_LAS f32x4*)(gp + 4);
        }
        if (act == 2) {
            int lo16 = (wr * 4 + wc) * 8192 + (fq * 16 + fr) * 16; asm volatile("" : "+v"(lo16));
            unsigned char* gp = GT + (size_t)((pn - 20) >> 3) * GT_GATE + ((size_t)u.pm * 8 + ((pn - 20) & 7)) * GT_TILE + lo16;
#pragma unroll
            for (int ai = 0; ai < 2; ++ai)
#pragma unroll
                for (int m = 0; m < 4; ++m) { u32x4 w;
#pragma unroll
                    for (int bj = 0; bj < 2; ++bj) { const f32x4 v0 = acc[ai][bj][m][0] * (-1.44269504f * 0.015625f), v1 = acc[ai][bj][m][1] * (-1.44269504f * 0.015625f); f32x4 s0, s1;
#pragma unroll
                        for (int j = 0; j < 4; ++j) { s0[j] = __builtin_amdgcn_exp2f(v0[j]); s1[j] = __builtin_amdgcn_exp2f(v1[j]); }
                        s0 = s0 * 0.00390625f + 0.00390625f; s1 = s1 * 0.00390625f + 0.00390625f;
#pragma unroll
                        for (int j = 0; j < 4; ++j) { s0[j] = __builtin_amdgcn_rcpf(s0[j]); s1[j] = __builtin_amdgcn_rcpf(s1[j]); }
                        w[2 * bj] = q8x4(s0); w[2 * bj + 1] = q8x4(s1); }
                    *(u32x4*)(gp + (ai * 4 + m) * 1024) = w; }
            return;
        }
#pragma unroll
        for (int ai = 0; ai < 2; ++ai)
#pragma unroll
            for (int m = 0; m < 4; ++m) { bf16_t* rowp = O + (size_t)(row0 + ai * HALF + m * 16) * ZP + col0; const float rs = PN_OFF ? rstd[row0 + ai * HALF + m * 16] : 1.0f;
#pragma unroll
                for (int bj = 0; bj < 2; ++bj) { f32x4 v0 = acc[ai][bj][m][0], v1 = acc[ai][bj][m][1];
                    if (hn && !(pn == 2 && bj == 1)) { const float r = rsqrtf((float)ss[(ai * HALF + m * 16 + lr) * 2 + bj] * (0.015625f * 0.015625f / 128.0f / 1048576.0f) + 1e-6f) * 0.015625f;
                        v0 = v0 * r * gn0; v1 = v1 * r * gn1; }
                    else if (PN_OFF == 0) { v0 = v0 * 0.015625f; v1 = v1 * 0.015625f; }
                    else { v0 = v0 * rs; v1 = v1 * rs; }
                    if (act) {
#pragma unroll
                        for (int j = 0; j < 4; ++j) { v0[j] *= sigm(v0[j]); v1[j] *= sigm(v1[j]); } }
                    u32x4 w; w.x = cvt_pk_bf16(v0[0], v0[1]); w.y = cvt_pk_bf16(v0[2], v0[3]); w.z = cvt_pk_bf16(v1[0], v1[1]); w.w = cvt_pk_bf16(v1[2], v1[3]);
                    *(u32x4*)(rowp + bj * HALF) = w; } }
        if (hn) { asm volatile("s_waitcnt lgkmcnt(0)" ::: "memory"); __builtin_amdgcn_s_barrier(); asm volatile("" ::: "memory");
            ss[(wr * 4 + wc) * 64 + fq * 16 + fr] = 0ull; }
    }
};
template <int MODE = 0> struct EpiMergeT {
    static constexpr bool PERM = true, AFTER_DRAIN = false, CHAIN = true;
    const unsigned char* GT; bf16_t* O;
    __device__ __forceinline__ void operator()(f32x4 (&acc)[2][2][4][2], const Unit& u, int wr, int wc, int fr, int fq) const {
        if (MODE == 2) return;
        const int row0 = u.pm * BM + wr * 64 + fr, col0 = u.pn * BM + wc * 32 + 8 * fq;
        int lo16 = (wr * 4 + wc) * 8192 + (fq * 16 + fr) * 16; asm volatile("" : "+v"(lo16));
        const unsigned char* gp = GT + ((size_t)u.pm * 8 + u.pn) * GT_TILE + lo16;
        const size_t cn = (size_t)u.seg * GT_GATE, cd = (size_t)(u.seg == 0 ? 1 : 2) * GT_GATE;
        const bool fin = u.seg == 2;
        u32x4 gn[2][4], gd[2][4];
#pragma unroll
        for (int ai = 0; ai < 2; ++ai)
#pragma unroll
            for (int m = 0; m < 4; ++m) {
                if (MODE == 1) { gn[ai][m] = (u32x4){0x80808080u + (unsigned)u.pm, 0x80808080u, 0x80808080u, 0x80808080u}; gd[ai][m] = gn[ai][m]; } else {
                gn[ai][m] = *(const u32x4*)(gp + cn + (ai * 4 + m) * 1024); gd[ai][m] = *(const u32x4*)(gp + cd + (ai * 4 + m) * 1024); } }
#pragma unroll
        for (int ai = 0; ai < 2; ++ai)
#pragma unroll
            for (int m = 0; m < 4; ++m)
#pragma unroll
                for (int bj = 0; bj < 2; ++bj) { const size_t r = (size_t)(row0 + ai * HALF + m * 16);
#pragma unroll
                    for (int w = 0; w < 2; ++w)
#pragma unroll
                        for (int k = 0; k < 4; ++k) { const float qn = (float)((gn[ai][m][2 * bj + w] >> (8 * k)) & 0xffu) + 0.5f, qd = (float)((gd[ai][m][2 * bj + w] >> (8 * k)) & 0xffu) + 0.5f;
                            acc[ai][bj][m][w][k] *= qn * __builtin_amdgcn_rcpf(fin ? 256.0f : qd); }
                    if (fin) { const f32x4 v0 = acc[ai][bj][m][0], v1 = acc[ai][bj][m][1];
                        u32x4 w; w.x = cvt_pk_bf16(v0[0], v0[1]); w.y = cvt_pk_bf16(v0[2], v0[3]); w.z = cvt_pk_bf16(v1[0], v1[1]); w.w = cvt_pk_bf16(v1[2], v1[3]);
                        *(u32x4*)(O + r * 2048 + col0 + bj * HALF) = w; } }
    }
};
typedef EpiMergeT<0> EpiMerge;
struct EpiResid {
    static constexpr int PERM = 2; static constexpr bool AFTER_DRAIN = false, CHAIN = false;
    bf16_t* hb; unsigned char* xu; const float* gain; PG8_LAS unsigned char* stg;
    __device__ __forceinline__ void operator()(const f32x4 (&acc)[2][2][4][2], const Unit& u, int wr, int wc, int fr, int fq) const {
        int lane = fq * 16 + fr; asm volatile("" : "+v"(lane));
        PG8_LAS unsigned char* s0 = stg + (wr * 4 + wc) * 1024;
        const int r8 = lane >> 3, pc = lane & 7;
        const int offc = r8 * 128 + ((pc ^ r8) << 4);
        const int offa0 = (fr >> 3) * 8192 + (fr & 7) * 128 + ((fq ^ (fr & 7)) << 4), offa1 = (fr >> 3) * 8192 + (fr & 7) * 128 + (((4 + fq) ^ (fr & 7)) << 4);
        const int xs = 2 * (fr >> 2), offxw0 = fr * 64 + ((fq ^ xs) << 3), offxw1 = fr * 64 + (((4 + fq) ^ xs) << 3);
        const int xr = lane >> 2, xq = lane & 3, offxr = xr * 64 + (((2 * xq) ^ (2 * (xr >> 2))) << 3);
        const size_t goff = (size_t)(u.pm * BM + wr * 64 + r8) * 2048 + u.pn * BM + wc * 64 + pc * 8;
        const size_t xoff = (size_t)(u.pm * BM + wr * 64 + xr) * 2048 + u.pn * BM + wc * 64 + xq * 16;
        f32x4 gv[2][2];
#pragma unroll
        for (int bj = 0; bj < 2; ++bj)
#pragma unroll
            for (int n = 0; n < 2; ++n) gv[bj][n] = *(const f32x4*)(gain + u.pn * BM + wc * 64 + bj * 32 + 8 * fq + 4 * n);
        const f32x4 lo4 = (f32x4){-440.f, -440.f, -440.f, -440.f}, hi4 = (f32x4){440.f, 440.f, 440.f, 440.f};
#pragma unroll
        for (int ai = 0; ai < 2; ++ai) {
            u32x4 bb[4][2];
#pragma unroll
            for (int m = 0; m < 4; ++m)
#pragma unroll
                for (int j = 0; j < 2; ++j) bb[m][j] = *(const u32x4*)(hb + goff + (size_t)(ai * HALF + m * 16 + 8 * j) * 2048);
#pragma unroll
            for (int m = 0; m < 4; ++m) {
                *(PG8_LAS u32x4*)(s0 + offc) = bb[m][0]; *(PG8_LAS u32x4*)(s0 + 8192 + offc) = bb[m][1];
                asm volatile("" ::: "memory");
                const u32x4 a0 = *(const PG8_LAS u32x4*)(s0 + offa0), a1 = *(const PG8_LAS u32x4*)(s0 + offa1);
                asm volatile("" ::: "memory");
                u32x2 xw[2];
#pragma unroll
                for (int bj = 0; bj < 2; ++bj) { const u32x4 w = bj ? a1 : a0;
                    const f32x4 h0 = (f32x4){bflo(w.x), bfhi(w.x), bflo(w.y), bfhi(w.y)} + acc[ai][bj][m][0], h1 = (f32x4){bflo(w.z), bfhi(w.z), bflo(w.w), bfhi(w.w)} + acc[ai][bj][m][1];
                    u32x4 hw; hw.x = cvt_pk_bf16(h0[0], h0[1]); hw.y = cvt_pk_bf16(h0[2], h0[3]); hw.z = cvt_pk_bf16(h1[0], h1[1]); hw.w = cvt_pk_bf16(h1[2], h1[3]);
                    *(PG8_LAS u32x4*)(s0 + (bj ? offa1 : offa0)) = hw;
                    const f32x4 x0 = __builtin_elementwise_min(__builtin_elementwise_max(h0 * gv[bj][0], lo4), hi4), x1 = __builtin_elementwise_min(__builtin_elementwise_max(h1 * gv[bj][1], lo4), hi4);
                    int w0 = 0, w1 = 0;
                    w0 = __builtin_amdgcn_cvt_pk_fp8_f32(x0[0], x0[1], w0, false); w0 = __builtin_amdgcn_cvt_pk_fp8_f32(x0[2], x0[3], w0, true);
                    w1 = __builtin_amdgcn_cvt_pk_fp8_f32(x1[0], x1[1], w1, false); w1 = __builtin_amdgcn_cvt_pk_fp8_f32(x1[2], x1[3], w1, true);
                    xw[bj] = (u32x2){(unsigned)w0, (unsigned)w1}; }
                asm volatile("" ::: "memory");
                const u32x4 o0 = *(const PG8_LAS u32x4*)(s0 + offc), o1 = *(const PG8_LAS u32x4*)(s0 + 8192 + offc);
                asm volatile("" ::: "memory");
                *(PG8_LAS u32x2*)(s0 + offxw0) = xw[0]; *(PG8_LAS u32x2*)(s0 + offxw1) = xw[1];
                asm volatile("" ::: "memory");
                const u32x4 xo = *(const PG8_LAS u32x4*)(s0 + offxr);
                asm volatile("" ::: "memory");
                *(u32x4*)(hb + goff + (size_t)(ai * HALF + m * 16) * 2048) = o0; *(u32x4*)(hb + goff + (size_t)(ai * HALF + m * 16 + 8) * 2048) = o1;
                *(u32x4*)(xu + xoff + (size_t)(ai * HALF + m * 16) * 2048) = xo;
            }
        }
        asm volatile("s_waitcnt lgkmcnt(0)" ::: "memory");
    }
};
struct EpiGlu {
    static constexpr bool PERM = false, AFTER_DRAIN = false, CHAIN = false;
    bf16_t* H; const PG8_LAS int* tile_exp; const PG8_LAS int* pst; const PG8_LAS int* cnt; const int* liste; const float* rstd;
    __device__ __forceinline__ void operator()(const f32x4 (&acc)[2][2][4][2], const Unit& u, int wr, int wc, int fr, int fq) const {
        const int row0 = u.pm * BM + wr * 64 + fr, pj = u.pn & 3;
        const int e = tile_exp[u.pm], lr0 = u.pm * 256 - pst[e] + wr * 64 + fr, ce = cnt[e];
        int tok[2][4]; float rs[2][4];
#pragma unroll
        for (int ai = 0; ai < 2; ++ai)
#pragma unroll
            for (int m = 0; m < 4; ++m) { const int lr = lr0 + ai * HALF + m * 16; tok[ai][m] = lr < ce ? liste[(size_t)e * 32768 + lr] : 0; }
#pragma unroll
        for (int ai = 0; ai < 2; ++ai)
#pragma unroll
            for (int m = 0; m < 4; ++m) rs[ai][m] = rstd[tok[ai][m]] * 0.015625f;
#pragma unroll
        for (int ai = 0; ai < 2; ++ai)
#pragma unroll
            for (int m = 0; m < 4; ++m) { unsigned char* rowp = (unsigned char*)H + (size_t)(row0 + ai * HALF + m * 16) * 512; const float r = rs[ai][m];
#pragma unroll
                for (int bj = 0; bj < 2; ++bj) { const f32x4 a = acc[ai][bj][m][0] * r, b = acc[ai][bj][m][1] * r;
                    const int hc = 16 * (8 * pj + 4 * bj + wc) + 4 * fq;
                    float hv[4];
#pragma unroll
                    for (int j = 0; j < 4; ++j) hv[j] = fminf(fmaxf(a[j] * sigm(a[j]) * b[j] * 8.0f, -440.0f), 440.0f);
                    int w = 0; w = __builtin_amdgcn_cvt_pk_fp8_f32(hv[0], hv[1], w, false); w = __builtin_amdgcn_cvt_pk_fp8_f32(hv[2], hv[3], w, true);
                    *(int*)(rowp + hc) = w; } }
    }
};
struct EpiY {
    static constexpr bool PERM = true, AFTER_DRAIN = false, CHAIN = false;
    unsigned char* Y;
    __device__ __forceinline__ void operator()(const f32x4 (&acc)[2][2][4][2], const Unit& u, int wr, int wc, int fr, int fq) const {
        const int row0 = u.pm * BM + wr * 64 + fr, col0 = (u.pn & 7) * BM + wc * 32 + 8 * fq;
        const f32x4 lo4 = (f32x4){-440.f, -440.f, -440.f, -440.f}, hi4 = (f32x4){440.f, 440.f, 440.f, 440.f};
#pragma unroll
        for (int ai = 0; ai < 2; ++ai)
#pragma unroll
            for (int m = 0; m < 4; ++m) { unsigned char* rowp = Y + (size_t)(row0 + ai * HALF + m * 16) * 2048 + col0;
#pragma unroll
                for (int bj = 0; bj < 2; ++bj) {
                    const f32x4 v0 = __builtin_elementwise_min(__builtin_elementwise_max(acc[ai][bj][m][0] * 0.125f, lo4), hi4), v1 = __builtin_elementwise_min(__builtin_elementwise_max(acc[ai][bj][m][1] * 0.125f, lo4), hi4);
                    int w0 = 0, w1 = 0;
                    w0 = __builtin_amdgcn_cvt_pk_fp8_f32(v0[0], v0[1], w0, false); w0 = __builtin_amdgcn_cvt_pk_fp8_f32(v0[2], v0[3], w0, true);
                    w1 = __builtin_amdgcn_cvt_pk_fp8_f32(v1[0], v1[1], w1, false); w1 = __builtin_amdgcn_cvt_pk_fp8_f32(v1[2], v1[3], w1, true);
                    *(u32x2*)(rowp + bj * HALF) = (u32x2){(unsigned)w0, (unsigned)w1}; } }
    }
};

typedef int v4i_t __attribute__((ext_vector_type(4)));
typedef int v8i_t __attribute__((ext_vector_type(8)));
template <class Epi, class Sched, bool ALIGN_EPI = false, bool FP8 = false>
__device__ __forceinline__ void gemm_phase(PG8_LAS unsigned char* lds, const Gemm g, const Sched& S, const Epi& E) {
    int tid = threadIdx.x; asm volatile("" : "+v"(tid));
    const int wid = __builtin_amdgcn_readfirstlane(tid >> 6), lane = tid & 63, wr = wid >> 2, wc = wid & 3, fr = lane & 15, fq = lane >> 4;
    const int K = g.K;
    unsigned voffA[2], voffB[2]; int RA[2]; unsigned CA2[2];
#pragma unroll
    for (int i = 0; i < 2; ++i) { int R, C; stage_rc(tid * 16 + i * 8192, R, C); const int Rb = Epi::PERM == 2 ? ((R >> 5) * 64 + perm32(R & 31)) : (Epi::PERM ? ((R & ~31) + perm32(R & 31)) : R);
        voffA[i] = (unsigned)(R * K + C) * 2u; voffB[i] = (unsigned)(Rb * K + C) * 2u; RA[i] = R; CA2[i] = (unsigned)C * 2u; }
    unsigned gAc[2][2], gAn[2][2];
#define PG8_GOFF(dst, uu) do { _Pragma("unroll") for (int h_ = 0; h_ < 2; ++h_) _Pragma("unroll") for (int i_ = 0; i_ < 2; ++i_) dst[h_][i_] = (unsigned)S.row_token(uu, 128 * h_ + RA[i_]) * (unsigned)(K * 2) + CA2[i_]; } while (0)
#define PG8_STAGE_A(bufoff, gbase, half, garr) do { if constexpr (Sched::GATHER) PG8_STAGE(bufoff, gbase, garr); else PG8_STAGE(bufoff, (gbase) + (half) * hstep, voffA); } while (0)
    const size_t kstep = (size_t)(BK * 2);
    const size_t hstep = (size_t)HALF * K * 2;
    const size_t hstepB = Epi::PERM == 2 ? (size_t)32 * K * 2 : hstep;
    const size_t tstep = 2 * hstep;
    const unsigned ldsw = (unsigned)wid * 1024u;
    const int aoff = lds_byte(wr * 64 + fr, fq * 8), boff = lds_byte(wc * 32 + fr, fq * 8);
#define PG8_SA(b, h) (((b) * 2 + (h)) * HTB)
#define PG8_SB(b, h) ((4 + (b) * 2 + (h)) * HTB)
#define PG8_STAGE(bufoff, gbase, voff) do { _Pragma("unroll") for (int _i = 0; _i < 2; ++_i) \
        __builtin_amdgcn_global_load_lds((const unsigned*)((const char*)(gbase) + (voff)[_i]), (PG8_LAS unsigned*)(lds + (bufoff) + ldsw + _i * 8192), 16, 0, 0); } while (0)
#define PG8_LDA(dst, b, h) do { if constexpr (FP8) { _Pragma("unroll") for (int m = 0; m < 4; ++m) dst##8[m] = __builtin_shufflevector(*(const PG8_LAS v4i_t*)(lds + PG8_SA(b, h) + aoff + m * 2048), *(const PG8_LAS v4i_t*)(lds + PG8_SA(b, h) + aoff + m * 2048 + 1024), 0, 1, 2, 3, 4, 5, 6, 7); } \
        else { _Pragma("unroll") for (int m = 0; m < 4; ++m) _Pragma("unroll") for (int k = 0; k < 2; ++k) dst[m][k] = *(const PG8_LAS bf16x8*)(lds + PG8_SA(b, h) + aoff + m * 2048 + k * 1024); } } while (0)
#define PG8_LDB(dst, b, h) do { if constexpr (FP8) { _Pragma("unroll") for (int n = 0; n < 2; ++n) dst##8[n] = __builtin_shufflevector(*(const PG8_LAS v4i_t*)(lds + PG8_SB(b, h) + boff + n * 2048), *(const PG8_LAS v4i_t*)(lds + PG8_SB(b, h) + boff + n * 2048 + 1024), 0, 1, 2, 3, 4, 5, 6, 7); } \
        else { _Pragma("unroll") for (int n = 0; n < 2; ++n) _Pragma("unroll") for (int k = 0; k < 2; ++k) dst[n][k] = *(const PG8_LAS bf16x8*)(lds + PG8_SB(b, h) + boff + n * 2048 + k * 1024); } } while (0)
#define PG8_MMA(ai, bj, At, Bt) do { __builtin_amdgcn_s_setprio(1); _Pragma("unroll") for (int m = 0; m < 4; ++m) _Pragma("unroll") for (int n = 0; n < 2; ++n) { \
        if constexpr (FP8) asm volatile("v_mfma_f32_16x16x128_f8f6f4 %0, %1, %2, %0" : "+v"(acc[ai][bj][m][n]) : "v"(Bt##8[n]), "v"(At##8[m])); \
        else { _Pragma("unroll") for (int k = 0; k < 2; ++k) acc[ai][bj][m][n] = __builtin_amdgcn_mfma_f32_16x16x32_bf16(Bt[n][k], At[m][k], acc[ai][bj][m][n], 0, 0, 0); } } \
        __builtin_amdgcn_s_setprio(0); } while (0)
#define PG8_WAIT_V(n) asm volatile("s_waitcnt vmcnt(" #n ")" ::: "memory")
#define PG8_WAIT_L(n) asm volatile("s_waitcnt lgkmcnt(" #n ")" ::: "memory")
#define PG8_BAR __builtin_amdgcn_s_barrier()
#define PG8_SCHED __builtin_amdgcn_sched_barrier(0)
    Unit cur, nxt; int ui = 0;
    if (!S.next(0, cur)) return;
    f32x4 acc[2][2][4][2];
#pragma unroll
    for (int a = 0; a < 2; ++a)
#pragma unroll
        for (int b = 0; b < 2; ++b)
#pragma unroll
            for (int m = 0; m < 4; ++m)
#pragma unroll
                for (int n = 0; n < 2; ++n) acc[a][b][m][n] = (f32x4){0.f, 0.f, 0.f, 0.f};
    bf16x8 At[4][2], B0[2][2], B1[2][2]; v8i_t At8[4], B08[2], B18[2];
    const size_t tstepA = Sched::GATHER ? (size_t)0 : tstep;
    const char* cA = (const char*)g.A + (size_t)cur.pm * tstepA + (size_t)cur.koff * 2; const char* cB = (const char*)g.Bt + (size_t)cur.pn * tstep + (size_t)cur.koff * 2;
    S.a_ready(cur);
    if constexpr (Sched::GATHER) { PG8_GOFF(gAc, cur); }
    PG8_STAGE(PG8_SB(0, 0), cB, voffB); PG8_STAGE(PG8_SB(0, 1), cB + hstepB, voffB); PG8_STAGE_A(PG8_SA(0, 0), cA, 0, gAc[0]); PG8_STAGE_A(PG8_SA(0, 1), cA, 1, gAc[1]);
    if (wr == 1) PG8_BAR;
    PG8_WAIT_V(2); PG8_BAR;
    PG8_STAGE(PG8_SB(1, 0), cB + kstep, voffB); PG8_STAGE_A(PG8_SA(1, 0), cA + kstep, 0, gAc[0]); PG8_STAGE(PG8_SB(1, 1), cB + hstepB + kstep, voffB);
    PG8_WAIT_V(6); PG8_BAR;
    for (;;) {
        const bool has_next = S.next(ui + 1, nxt);
        const char* nA = has_next ? (const char*)g.A + (size_t)nxt.pm * tstepA + (size_t)nxt.koff * 2 : cA; const char* nB = has_next ? (const char*)g.Bt + (size_t)nxt.pn * tstep + (size_t)nxt.koff * 2 : cB;
        if constexpr (Sched::GATHER) { if (has_next) { PG8_GOFF(gAn, nxt); } else {
#pragma unroll
            for (int h_ = 0; h_ < 2; ++h_)
#pragma unroll
                for (int i_ = 0; i_ < 2; ++i_) gAn[h_][i_] = gAc[h_][i_]; } }
        const int nt = cur.nt;
        for (int t = 0; t < nt; t += 2) {
            const bool last = (t == nt - 2);
            const char* a1 = cA + (size_t)(t + 1) * kstep;
            const char* a2 = last ? nA : cA + (size_t)(t + 2) * kstep; const char* b2 = last ? nB : cB + (size_t)(t + 2) * kstep;
            const char* a3 = a2 + kstep; const char* b3 = b2 + kstep;
            if (last && has_next) S.a_ready(nxt);
            unsigned g2a[2][2];
            if constexpr (Sched::GATHER) {
#pragma unroll
                for (int h_ = 0; h_ < 2; ++h_)
#pragma unroll
                    for (int i_ = 0; i_ < 2; ++i_) g2a[h_][i_] = last ? gAn[h_][i_] : gAc[h_][i_]; }
            PG8_LDB(B0, 0, 0); PG8_LDB(B1, 0, 1); PG8_SCHED; PG8_LDA(At, 0, 0); PG8_STAGE_A(PG8_SA(1, 1), a1, 1, gAc[1]);
            PG8_WAIT_V(8); PG8_WAIT_L(0); PG8_BAR; PG8_MMA(0, 0, At, B0); PG8_MMA(0, 1, At, B1); PG8_BAR; PG8_SCHED;
            PG8_LDA(At, 0, 1); PG8_STAGE(PG8_SB(0, 0), b2, voffB); PG8_STAGE(PG8_SB(0, 1), b2 + hstepB, voffB); PG8_STAGE_A(PG8_SA(0, 0), a2, 0, g2a[0]);
            PG8_WAIT_V(8); PG8_WAIT_L(0); PG8_BAR; PG8_MMA(1, 0, At, B0); PG8_MMA(1, 1, At, B1); PG8_BAR; PG8_SCHED;
            PG8_LDB(B0, 1, 0); PG8_LDB(B1, 1, 1); PG8_SCHED; PG8_LDA(At, 1, 0); PG8_STAGE_A(PG8_SA(0, 1), a2, 1, g2a[1]);
            PG8_WAIT_V(8); PG8_WAIT_L(0); PG8_BAR; PG8_MMA(0, 0, At, B0); PG8_MMA(0, 1, At, B1); PG8_BAR; PG8_SCHED;
            PG8_LDA(At, 1, 1); PG8_STAGE(PG8_SB(1, 0), b3, voffB); PG8_STAGE(PG8_SB(1, 1), b3 + hstepB, voffB); PG8_STAGE_A(PG8_SA(1, 0), a3, 0, g2a[0]);
            PG8_WAIT_V(8); PG8_WAIT_L(0); PG8_BAR; PG8_MMA(1, 0, At, B0); PG8_MMA(1, 1, At, B1); PG8_BAR; PG8_SCHED;
        }
        if constexpr (ALIGN_EPI) { if (wr == 0) PG8_BAR; }
        if constexpr (FP8) asm volatile("s_nop 15\n\ts_nop 15\n\ts_nop 15\n\ts_nop 15" ::: "memory");
        E(acc, cur, wr, wc, fr, fq); S.done(cur);
        if (!has_next) break;
        if (!Epi::CHAIN || cur.seg == 2)
#pragma unroll
        for (int a = 0; a < 2; ++a)
#pragma unroll
            for (int b = 0; b < 2; ++b)
#pragma unroll
                for (int m = 0; m < 4; ++m)
#pragma unroll
                    for (int n = 0; n < 2; ++n) acc[a][b][m][n] = (f32x4){0.f, 0.f, 0.f, 0.f};
        cur = nxt; cA = nA; cB = nB; ++ui;
        if constexpr (Sched::GATHER) {
#pragma unroll
            for (int h_ = 0; h_ < 2; ++h_)
#pragma unroll
                for (int i_ = 0; i_ < 2; ++i_) gAc[h_][i_] = gAn[h_][i_]; }
        if constexpr (ALIGN_EPI) { if (wr == 1) PG8_BAR; }
    }
    PG8_WAIT_V(0);
    if constexpr (!ALIGN_EPI) { if (wr == 0) PG8_BAR; }
    PG8_BAR;
#undef PG8_SA
#undef PG8_SB
#undef PG8_STAGE_A
#undef PG8_GOFF
#undef PG8_STAGE
#undef PG8_LDA
#undef PG8_LDB
#undef PG8_MMA
#undef PG8_WAIT_V
#undef PG8_WAIT_L
#undef PG8_BAR
#undef PG8_SCHED
}
}

constexpr int NWAVES = 8;
constexpr int T = 32768, SEQ = 2048, NB = 16, D = 2048, DEPTH = 2;
constexpr int ZP = pg8::ZP;
constexpr int ZC_AQ = 0, ZC_AK = 512, ZC_AV = 640, ZC_BQ = 768, ZC_BK = 1792, ZC_BV = 2048, ZC_IQ = 2304, ZC_IK = 3328, ZC_IW = 3392, ZC_CG = 3408, ZC_PAD = 3424, ZC_CQ = 3584, ZC_CK = 3840, ZC_CV = 4096, ZC_CR = 4608;
constexpr int D_IN = 11104;
constexpr int NEXP = 64, DEXP = 512, PMAX_TILES = 320;
constexpr float EPS = 1e-6f;

constexpr size_t MiB = 1u << 20;
constexpr size_t WS_CTL = 0, CTL_ZERO_BYTES = 1 * MiB;
constexpr size_t WS_ROUTE = 2 * MiB;
constexpr size_t WS_WRH = 4 * MiB, WS_WRL = 6 * MiB, WR_L = 96 * 2048 * 2;
constexpr size_t WS_WIN = 16 * MiB, WIN_L = 44 * MiB;
constexpr size_t WS_WBR = 104 * MiB, WBR_L = 8 * MiB;
constexpr size_t WS_WO = 120 * MiB, WO_L = 8 * MiB;
constexpr size_t WS_W13 = 136 * MiB;
constexpr size_t WS_HB = 264 * MiB;
constexpr size_t WS_W2 = 392 * MiB;
constexpr size_t WS_XN = 520 * MiB;
constexpr size_t WS_OCAT = 648 * MiB;
constexpr size_t WS_MERGED = 776 * MiB;
constexpr size_t WS_Z = 904 * MiB;
constexpr size_t WS_GT = 1224 * MiB;
constexpr size_t WS_S = 1608 * MiB;
constexpr size_t WS_MASK = 1864 * MiB;
constexpr size_t WS_GO = 1872 * MiB;
constexpr size_t WS_GCS = WS_GO;
constexpr size_t WS_GDEC = 8 * MiB;
constexpr size_t WS_RSTD1 = 10 * MiB;
constexpr size_t WS_RSTD = 9 * MiB;
constexpr size_t WS_LISTE = 904 * MiB;
constexpr size_t WS_XS = 904 * MiB;
constexpr size_t WS_Y = 1224 * MiB;
constexpr size_t WS_H = 1544 * MiB;
constexpr size_t WS_WG8 = 1936 * MiB, WG8_L = 12 * MiB;
constexpr size_t WS_XN8 = WS_S;
constexpr size_t WS_END = 1936 * MiB;
constexpr int CW_BAR = 4096;
constexpr int CW_CNT = 16384;

constexpr int RING_BYTES = 131072, MISC_OFF = RING_BYTES, LDS_BYTES = 155648;
constexpr int MO_BARW = 32, MO_GN = 256, MO_TEXP = 8192, MO_PST = 9728, MO_TOT = 9984, MO_TAB2 = 10240, MO_CNT = 16640, MO_SS = 16896;

#define GAS __attribute__((address_space(1)))
#define LAS __attribute__((address_space(3)))
typedef unsigned short bf16;
typedef unsigned v4u __attribute__((ext_vector_type(4)));
typedef unsigned v2u __attribute__((ext_vector_type(2)));
typedef float f32x4 __attribute__((ext_vector_type(4)));
#define LDS_WAIT() asm volatile("s_waitcnt lgkmcnt(0)" ::: "memory")
__device__ __forceinline__ unsigned f2bf(float f) { unsigned u = __builtin_bit_cast(unsigned, f); return (u + 0x7fffu + ((u >> 16) & 1u)) >> 16; }
__device__ __forceinline__ unsigned pk2(float lo, float hi) { return pg8::cvt_pk_bf16(lo, hi); }
__device__ __forceinline__ float bflo(unsigned w) { return __uint_as_float(w << 16); }
__device__ __forceinline__ float bfhi(unsigned w) { return __uint_as_float(w & 0xffff0000u); }
__device__ __forceinline__ float bf1(bf16 h) { return __uint_as_float(((unsigned)h) << 16); }

#define XB_TMO      128
#define XB_XCNT(j)  (256  + 64 * (j))
#define XB_XSUB(j)  (1280 + 64 * (j))
#define XB_XGEN(j)  (2304 + 64 * (j))
#define XB_TOP      3328
#define XB_TOPGEN   3392
#define XCD_BAR_WORDS 3456
#define XB_SPIN_CAP (1u << 18)
__device__ __forceinline__ unsigned xb_ld(unsigned* p)              { return __hip_atomic_load(p, __ATOMIC_RELAXED, __HIP_MEMORY_SCOPE_AGENT); }
__device__ __forceinline__ unsigned xb_add(unsigned* p, unsigned v) { return __hip_atomic_fetch_add(p, v, __ATOMIC_RELAXED, __HIP_MEMORY_SCOPE_AGENT); }
__device__ __forceinline__ unsigned xb_xcc_id() { return (unsigned)__builtin_amdgcn_s_getreg((3 << 11) | 20) & 0xFu; }
#define XB_SPIN(cond, bar) do { unsigned _sp = 0; while (cond) { __builtin_amdgcn_s_sleep(1); \
    if ((++_sp & 255u) == 0u) { if (xb_ld(&(bar)[XB_TMO])) break; if (_sp > XB_SPIN_CAP) { atomicAdd(&(bar)[XB_TMO], 1u); break; } } } } while (0)
struct XcdBarrier { unsigned* bar; unsigned x; volatile LAS unsigned* st; };
__device__ __forceinline__ XcdBarrier xcd_barrier_post(unsigned* bar, volatile LAS unsigned* st) {
    XcdBarrier b; b.bar = bar; b.x = xb_xcc_id(); b.st = st;
    if (threadIdx.x == 0) (void)xb_add(&bar[XB_XCNT(b.x)], 1u);
    return b;
}
__device__ __forceinline__ void xcd_barrier_complete(unsigned* bar, unsigned x, unsigned& nloc, unsigned& nx) {
    const unsigned G = gridDim.x * gridDim.y * gridDim.z;
    unsigned sum, cnt, mine, sp = 0u;
    for (;;) {
        sum = 0u; cnt = 0u; mine = 0u;
#pragma unroll
        for (unsigned j = 0; j < 16; ++j) { const unsigned c = xb_ld(&bar[XB_XCNT(j)]); sum += c; cnt += (c > 0u) ? 1u : 0u; mine = (j == x) ? c : mine; }
        if (sum == G) break;
        __builtin_amdgcn_s_sleep(1);
        if ((++sp & 255u) == 0u) { if (xb_ld(&bar[XB_TMO])) break; if (sp > XB_SPIN_CAP) { atomicAdd(&bar[XB_TMO], 1u); break; } }
    }
    nloc = mine > 0u ? mine : 1u; nx = cnt > 0u ? cnt : 1u;
}
__device__ __forceinline__ void xcd_barrier(const XcdBarrier& b) {
    asm volatile("s_waitcnt vmcnt(0)" ::: "memory");
    __syncthreads();
    if (threadIdx.x == 0) {
        unsigned* bar = b.bar;
        __builtin_amdgcn_s_waitcnt(0);
        unsigned nloc = b.st[0], nx = b.st[1];
        if (nloc == 0u) { xcd_barrier_complete(bar, b.x, nloc, nx); b.st[0] = nloc; b.st[1] = nx; }
        const unsigned old = xb_add(&bar[XB_XSUB(b.x)], 1u);
        const unsigned gen = old / nloc;
        if (old + 1u == (gen + 1u) * nloc) {
            __builtin_amdgcn_fence(__ATOMIC_RELEASE, "agent");
            asm volatile("s_waitcnt vmcnt(0)" ::: "memory");
            const unsigned og = xb_add(&bar[XB_TOP], 1u);
            const unsigned tg = og / nx;
            if (og + 1u == (tg + 1u) * nx) xb_add(&bar[XB_TOPGEN], 1u);
            else XB_SPIN(xb_ld(&bar[XB_TOPGEN]) == tg, bar);
            __builtin_amdgcn_fence(__ATOMIC_ACQUIRE, "agent");
            xb_add(&bar[XB_XGEN(b.x)], 1u);
            asm volatile("s_waitcnt vmcnt(0)" ::: "memory");
        } else {
            XB_SPIN(xb_ld(&bar[XB_XGEN(b.x)]) == gen, bar);
            __builtin_amdgcn_fence(__ATOMIC_ACQUIRE, "agent");
            asm volatile("s_waitcnt vmcnt(0)" ::: "memory");
        }
    }
    __syncthreads();
}

struct Args { const float* in[24]; float* out; unsigned char* ws; int ph_lo, ph_hi; };
enum { I_X = 0, I_RELB, I_N1G, I_WIN, I_AQG, I_AKG, I_BQG, I_BKG, I_SINK, I_CGW, I_CGB, I_CNG, I_WBA, I_WBB, I_WBC, I_WO, I_N2G, I_WRG, I_BRG, I_WRE, I_BRE, I_W1, I_W3, I_W2 };

struct Frame {
    LAS unsigned char* lds; LAS unsigned char* misc;
    unsigned* ctl;
    int tid, lane, wave, vcu, G, gw, NGW;
    const float* const* in; float* out; unsigned char* ws;
    bf16 *Z, *XN, *OCAT, *MERGED, *XS, *Y, *H;
    float *S, *GO; unsigned* MASK;
};

__device__ __forceinline__ float wave_sum(float v) {
#pragma unroll
    for (int o = 1; o < 64; o <<= 1) v += __shfl_xor(v, o);
    return v;
}
__device__ __forceinline__ float wave_max(float v) {
#pragma unroll
    for (int o = 1; o < 64; o <<= 1) v = fmaxf(v, __shfl_xor(v, o));
    return v;
}

template <class MAP>
__device__ __forceinline__ void transpose_item(const float* W, int N, bf16* WT, int dpitch, int koff, LAS float* scr, int item, int lane, const MAP& map, const float* kgain = nullptr) {
    const int nblk = N / 32, kb = item / nblk, nb = item % nblk, k0 = 64 * kb, n0 = 32 * nb;
    f32x4 v[8];
#pragma unroll
    for (int i = 0; i < 8; ++i) v[i] = *(const f32x4*)(W + (size_t)(k0 + 8 * i + (lane >> 3)) * N + n0 + 4 * (lane & 7));
    if (kgain) {
#pragma unroll
        for (int i = 0; i < 8; ++i) v[i] = v[i] * kgain[k0 + 8 * i + (lane >> 3)]; }
#pragma unroll
    for (int i = 0; i < 8; ++i) { LAS float* d = scr + (8 * i + (lane >> 3)) * 33 + 4 * (lane & 7); d[0] = v[i].x; d[1] = v[i].y; d[2] = v[i].z; d[3] = v[i].w; }
    LDS_WAIT(); asm volatile("" ::: "memory");
    const int c = lane & 7;
#pragma unroll
    for (int j = 0; j < 4; ++j) { const int n = (lane >> 3) + 8 * j; const LAS float* s = scr + (8 * c) * 33 + n;
        v4u o; o.x = pk2(s[0 * 33], s[1 * 33]); o.y = pk2(s[2 * 33], s[3 * 33]); o.z = pk2(s[4 * 33], s[5 * 33]); o.w = pk2(s[6 * 33], s[7 * 33]);
        const int dr_ = map(n0 + n); if (dr_ >= 0) *(v4u*)(WT + (size_t)dr_ * dpitch + koff + k0 + 8 * c) = o; }
    LDS_WAIT(); asm volatile("" ::: "memory");
}
__device__ __forceinline__ float clamp8(float v) { return fminf(fmaxf(v, -440.0f), 440.0f); }
template <class MAP>
__device__ __forceinline__ void transpose_item_fp8(const float* W, int N, unsigned char* WT, int dpitch, float scale, LAS float* scr, int item, int lane, const MAP& map) {
    const int nblk = N / 32, kb = item / nblk, nb = item % nblk, k0 = 64 * kb, n0 = 32 * nb;
    f32x4 v[8];
#pragma unroll
    for (int i = 0; i < 8; ++i) v[i] = *(const f32x4*)(W + (size_t)(k0 + 8 * i + (lane >> 3)) * N + n0 + 4 * (lane & 7));
#pragma unroll
    for (int i = 0; i < 8; ++i) { LAS float* d = scr + (8 * i + (lane >> 3)) * 33 + 4 * (lane & 7); d[0] = v[i].x; d[1] = v[i].y; d[2] = v[i].z; d[3] = v[i].w; }
    LDS_WAIT(); asm volatile("" ::: "memory");
    const int c = lane & 7;
#pragma unroll
    for (int j = 0; j < 4; ++j) { const int n = (lane >> 3) + 8 * j; const LAS float* s = scr + (8 * c) * 33 + n;
        int w0 = 0, w1 = 0;
        w0 = __builtin_amdgcn_cvt_pk_fp8_f32(clamp8(s[0 * 33] * scale), clamp8(s[1 * 33] * scale), w0, false); w0 = __builtin_amdgcn_cvt_pk_fp8_f32(clamp8(s[2 * 33] * scale), clamp8(s[3 * 33] * scale), w0, true);
        w1 = __builtin_amdgcn_cvt_pk_fp8_f32(clamp8(s[4 * 33] * scale), clamp8(s[5 * 33] * scale), w1, false); w1 = __builtin_amdgcn_cvt_pk_fp8_f32(clamp8(s[6 * 33] * scale), clamp8(s[7 * 33] * scale), w1, true);
        const int dr_ = map(n0 + n); if (dr_ >= 0) *(v2u*)(WT + (size_t)dr_ * dpitch + k0 + 8 * c) = (v2u){(unsigned)w0, (unsigned)w1}; }
    LDS_WAIT(); asm volatile("" ::: "memory");
}
struct MapId { int off; __device__ __forceinline__ int operator()(int n) const { return off + n; } };
struct MapWin {
    __device__ __forceinline__ int operator()(int n) const {
        if (n < 512) return ZC_AQ + n;
        if (n < 640) return ZC_AK + (n - 512);
        if (n < 768) return ZC_AV + (n - 640);
        if (n < 1792) return ZC_IQ + (n - 768);
        if (n < 1856) return ZC_IK + (n - 1792);
        if (n < 1872) return ZC_IW + (n - 1856);
        if (n < 2896) return ZC_BQ + (n - 1872);
        if (n < 3152) return ZC_BK + (n - 2896);
        if (n < 3408) return ZC_BV + (n - 3152);
        if (n < 3664) return ZC_CQ + (n - 3408);
        if (n < 3920) return ZC_CK + (n - 3664);
        if (n < 4432) return ZC_CV + (n - 3920);
        if (n < 4448) return ZC_CG + (n - 4432);
        if (n < 4960) return ZC_CR + (n - 4448);
        return pg8::ZC_GA + (n - 4960);
    }
};
struct MapWin8 { __device__ __forceinline__ int operator()(int n) const { const int z = MapWin{}(n); return z < 3328 ? z : (z >= 4096 ? z - 768 : -1); } };
struct MapWinB { __device__ __forceinline__ int operator()(int n) const { const int z = MapWin{}(n); return (z >= 3328 && z < 4096) ? z - 3328 : -1; } };
struct MapW13 { int sel; __device__ __forceinline__ int operator()(int n) const { return 32 * (n >> 4) + 16 * sel + (n & 15); } };

__device__ __forceinline__ void load_row(const float* row, int lane, f32x4 (&v)[8]) {
    const f32x4* xr = (const f32x4*)row + lane;
#pragma unroll
    for (int j = 0; j < 8; ++j) v[j] = xr[64 * j];
}
__device__ __forceinline__ float row_rstd(const f32x4 (&v)[8]) {
    float s = 0.f;
#pragma unroll
    for (int j = 0; j < 8; ++j) s += (v[j].x * v[j].x + v[j].y * v[j].y) + (v[j].z * v[j].z + v[j].w * v[j].w);
    return rsqrtf(wave_sum(s) * (1.0f / 2048.0f) + EPS);
}
__device__ __forceinline__ void norm_store_bf16(const f32x4 (&v)[8], float rstd, const float* g, bf16* orow, int lane) {
    const f32x4* gr = (const f32x4*)g + lane; unsigned long long* o8 = (unsigned long long*)orow + lane;
#pragma unroll
    for (int j = 0; j < 8; ++j) { const f32x4 gg = gr[64 * j];
        o8[64 * j] = (unsigned long long)pk2(v[j].x * rstd * gg.x, v[j].y * rstd * gg.y) | ((unsigned long long)pk2(v[j].z * rstd * gg.z, v[j].w * rstd * gg.w) << 32); }
}

__device__ __forceinline__ void norm_store_fp8(const f32x4 (&v)[8], float rstd, const float* g, unsigned char* orow, int lane) {
    const f32x4* gr = (const f32x4*)g + lane; unsigned* o4 = (unsigned*)orow + lane;
#pragma unroll
    for (int j = 0; j < 8; ++j) { const f32x4 gg = gr[64 * j]; int w = 0;
        w = __builtin_amdgcn_cvt_pk_fp8_f32(clamp8(v[j].x * rstd * gg.x), clamp8(v[j].y * rstd * gg.y), w, false); w = __builtin_amdgcn_cvt_pk_fp8_f32(clamp8(v[j].z * rstd * gg.z), clamp8(v[j].w * rstd * gg.w), w, true);
        o4[64 * j] = (unsigned)w; }
}
__device__ __forceinline__ void convert_moe(Frame& F, int l, int part, int nparts, int lds_off) {
    LAS float* scr = (LAS float*)(F.lds + lds_off + F.wave * 8704);
    bf16* W13 = (bf16*)(F.ws + WS_W13); bf16* W2 = (bf16*)(F.ws + WS_W2);
    constexpr int I13 = (2048 / 64) * (512 / 32);
    constexpr int I2 = (512 / 64) * (2048 / 32);
    constexpr int NIT = NEXP * (2 * I13 + I2);
    const int it_lo = (int)((long)NIT * part / nparts), it_hi = (int)((long)NIT * (part + 1) / nparts);
    for (int it = it_lo + F.gw; it < it_hi; it += F.NGW) {
        const int e = it / (2 * I13 + I2); int r = it % (2 * I13 + I2);
        if (r < I13) { transpose_item_fp8(F.in[I_W1] + ((size_t)l * NEXP + e) * 2048 * 512, 512, (unsigned char*)W13 + (size_t)e * 1024 * 2048, 2048, 64.0f, scr, r, F.lane, MapW13{0}); continue; } r -= I13;
        if (r < I13) { transpose_item_fp8(F.in[I_W3] + ((size_t)l * NEXP + e) * 2048 * 512, 512, (unsigned char*)W13 + (size_t)e * 1024 * 2048, 2048, 64.0f, scr, r, F.lane, MapW13{1}); continue; } r -= I13;
        transpose_item_fp8(F.in[I_W2] + ((size_t)l * NEXP + e) * 512 * 2048, 2048, (unsigned char*)W2 + (size_t)e * 2048 * 512, 512, 32.0f, scr, r, F.lane, MapId{0});
    }
}

typedef short bf16x8_t __attribute__((ext_vector_type(8)));
typedef float f32x16 __attribute__((ext_vector_type(16)));
typedef short s16x4 __attribute__((ext_vector_type(4)));
__device__ __forceinline__ void indexer_segment(Frame& F, int b, int qb, int tlo, int thi) {
    const int lane = F.lane, n = lane & 15, kq = lane >> 4;
    const bf16* qrow = F.Z + (size_t)(b * 2048 + 16 * qb + n) * ZP;
    bf16x8_t iqf[16][2];
#pragma unroll
    for (int h = 0; h < 16; ++h)
#pragma unroll
        for (int ks = 0; ks < 2; ++ks) iqf[h][ks] = *(const bf16x8_t*)(qrow + ZC_IQ + h * 64 + 32 * ks + 8 * kq);
    float wv[16];
    { const v4u w0 = *(const v4u*)(qrow + ZC_IW), w1 = *(const v4u*)(qrow + ZC_IW + 8);
      wv[0] = bflo(w0.x); wv[1] = bfhi(w0.x); wv[2] = bflo(w0.y); wv[3] = bfhi(w0.y); wv[4] = bflo(w0.z); wv[5] = bfhi(w0.z); wv[6] = bflo(w0.w); wv[7] = bfhi(w0.w);
      wv[8] = bflo(w1.x); wv[9] = bfhi(w1.x); wv[10] = bflo(w1.y); wv[11] = bfhi(w1.y); wv[12] = bflo(w1.z); wv[13] = bfhi(w1.z); wv[14] = bflo(w1.w); wv[15] = bfhi(w1.w); }
    const bf16* kbase = F.Z + (size_t)(b * 2048 + n) * ZP + ZC_IK + 8 * kq;
    float* srow = F.S + (size_t)(b * 2048 + 16 * qb + n) * 2048 + 4 * kq;
    bf16x8_t ka[3], kb[3];
#pragma unroll
    for (int u = 0; u < 3; ++u) { const int tt = tlo + u < thi ? tlo + u : thi - 1; ka[u] = *(const bf16x8_t*)(kbase + (size_t)(16 * tt) * ZP); kb[u] = *(const bf16x8_t*)(kbase + (size_t)(16 * tt) * ZP + 32); }
#pragma unroll 1
    for (int tile = tlo; tile < thi; tile += 3) {
#pragma unroll
        for (int u = 0; u < 3; ++u) {
            const int tt = tile + u;
            if (tt < thi) {
                f32x4 sc = (f32x4){0.f, 0.f, 0.f, 0.f};
#pragma unroll
                for (int h = 0; h < 16; ++h) {
                    f32x4 c = __builtin_amdgcn_mfma_f32_16x16x32_bf16(ka[u], iqf[h][0], (f32x4){0.f, 0.f, 0.f, 0.f}, 0, 0, 0);
                    c = __builtin_amdgcn_mfma_f32_16x16x32_bf16(kb[u], iqf[h][1], c, 0, 0, 0);
                    sc[0] += wv[h] * fmaxf(c[0], 0.f); sc[1] += wv[h] * fmaxf(c[1], 0.f); sc[2] += wv[h] * fmaxf(c[2], 0.f); sc[3] += wv[h] * fmaxf(c[3], 0.f);
                }
                *(f32x4*)(srow + 16 * tt) = sc * 0.03125f;
            }
            { const int tn = tt + 3 < thi ? tt + 3 : thi - 1; ka[u] = *(const bf16x8_t*)(kbase + (size_t)(16 * tn) * ZP); kb[u] = *(const bf16x8_t*)(kbase + (size_t)(16 * tn) * ZP + 32); }
        }
    }
}

constexpr int FA_KP = 272, FA_VP = 320;
constexpr int FA_KOFF = 0, FA_VOFF = 2 * 64 * FA_KP, FA_BYTES = FA_VOFF + 2 * 64 * FA_VP;
__device__ __forceinline__ s16x4 fa_vtr(const LAS unsigned char* p) { return __builtin_bit_cast(s16x4, __builtin_amdgcn_ds_read_tr16_b64_v4i16((LAS s16x4*)p)); }
template <int MODE>
__device__ __forceinline__ void flash_unit(Frame& F, int l, int b, int g, int t0) {
    const int tid = F.tid, lane = F.lane, wave = F.wave, hh = wave & 3, qh = wave >> 2, r = lane & 31, hf = lane >> 5;
    const int qcol = (MODE == 0 ? ZC_AQ : ZC_BQ + 512 * g) + 128 * hh, kcol = MODE == 0 ? ZC_AK : ZC_BK + 128 * g, vcol = MODE == 0 ? ZC_AV : ZC_BV + 128 * g;
    const int ocol = (MODE == 0 ? 0 : 512 + 512 * g) + 128 * hh, hd = (MODE == 0 ? 0 : 4 + 4 * g) + hh;
    const int tq = t0 + 32 * qh + r; const size_t qrow = (size_t)(b * 2048 + tq);
    const LAS float* tab2 = (const LAS float*)(F.misc + MO_TAB2) + hd * 129;
    LAS unsigned char* lds = F.lds;
    bf16x8_t qf[8];
#pragma unroll
    for (int ks = 0; ks < 8; ++ks) qf[ks] = *(const bf16x8_t*)(F.Z + qrow * ZP + qcol + 16 * ks + 8 * hf);
    f32x16 oacc[4];
#pragma unroll
    for (int dt = 0; dt < 4; ++dt)
#pragma unroll
        for (int i = 0; i < 16; ++i) oacc[dt][i] = 0.f;
    float m_run = -1e30f, l_run = 0.f;
    const int tile_lo = MODE == 0 ? 0 : (t0 >= 128 ? t0 / 64 - 2 : 0), tile_hi = t0 / 64 + 1;
    const int skey = tid >> 4, sdc = tid & 15;
    v4u kreg[2], vreg[2];
    { const bf16* zr = F.Z + (size_t)(b * 2048 + 64 * tile_lo + skey) * ZP;
#pragma unroll
      for (int i = 0; i < 2; ++i) { kreg[i] = *(const v4u*)(zr + (size_t)(32 * i) * ZP + kcol + 8 * sdc); vreg[i] = *(const v4u*)(zr + (size_t)(32 * i) * ZP + vcol + 8 * sdc); } }
    const float sc2 = 0.08838834764831845f * 1.4426950408889634f;
    unsigned mwn[2] = {0xffffffffu, 0xffffffffu};
    if (MODE == 0) { mwn[0] = F.MASK[qrow * 64 + 2 * tile_lo]; mwn[1] = F.MASK[qrow * 64 + 2 * tile_lo + 1]; }
#pragma unroll 1
    for (int kt = tile_lo; kt < tile_hi; ++kt) {
        const int bf = (kt - tile_lo) & 1, s0 = 64 * kt;
        LAS unsigned char* kb = lds + FA_KOFF + bf * (64 * FA_KP); LAS unsigned char* vb = lds + FA_VOFF + bf * (64 * FA_VP);
#pragma unroll
        for (int i = 0; i < 2; ++i) { *(LAS v4u*)(kb + (skey + 32 * i) * FA_KP + 16 * sdc) = kreg[i]; *(LAS v4u*)(vb + (skey + 32 * i) * FA_VP + 16 * sdc) = vreg[i]; }
        __syncthreads();
        if (kt + 1 < tile_hi) { const bf16* zr = F.Z + (size_t)(b * 2048 + 64 * (kt + 1) + skey) * ZP;
#pragma unroll
            for (int i = 0; i < 2; ++i) { kreg[i] = *(const v4u*)(zr + (size_t)(32 * i) * ZP + kcol + 8 * sdc); vreg[i] = *(const v4u*)(zr + (size_t)(32 * i) * ZP + vcol + 8 * sdc); } }
        unsigned mw[2] = {mwn[0], mwn[1]};
        if (MODE == 0 && kt + 1 < tile_hi) { mwn[0] = F.MASK[qrow * 64 + 2 * (kt + 1)]; mwn[1] = F.MASK[qrow * 64 + 2 * (kt + 1) + 1]; }
        f32x16 sacc[2];
#pragma unroll
        for (int k2 = 0; k2 < 2; ++k2) {
#pragma unroll
            for (int i = 0; i < 16; ++i) sacc[k2][i] = 0.f;
#pragma unroll
            for (int ks = 0; ks < 8; ++ks) { const bf16x8_t kf = *(const LAS bf16x8_t*)(kb + (32 * k2 + r) * FA_KP + (16 * ks + 8 * hf) * 2);
                sacc[k2] = __builtin_amdgcn_mfma_f32_32x32x16_bf16(kf, qf[ks], sacc[k2], 0, 0, 0); }
        }
        float mx = -1e30f;
        if (MODE == 0 && s0 + 63 + 128 <= t0) {
            const float bfar = tab2[128];
#pragma unroll
            for (int k2 = 0; k2 < 2; ++k2)
#pragma unroll
                for (int i = 0; i < 16; ++i) { const int cr = (i & 3) + 8 * (i >> 2) + 4 * hf;
                    const float v = ((mw[k2] >> cr) & 1u) ? sacc[k2][i] * sc2 + bfar : -__builtin_inff();
                    sacc[k2][i] = v; mx = fmaxf(mx, v); }
        } else
#pragma unroll
        for (int k2 = 0; k2 < 2; ++k2)
#pragma unroll
            for (int i = 0; i < 16; ++i) { const int cr = (i & 3) + 8 * (i >> 2) + 4 * hf; const int dist = tq - (s0 + 32 * k2 + cr);
                bool ok; if (MODE == 0) ok = (mw[k2] >> cr) & 1u; else ok = dist >= 0 && dist < 128;
                const int di = dist < 0 ? 0 : (dist > 128 ? 128 : dist);
                float vf = sacc[k2][i] * sc2 + tab2[di];
                asm volatile("" : "+v"(vf));
                const float v = ok ? vf : -__builtin_inff();
                sacc[k2][i] = v; mx = fmaxf(mx, v); }
        { const auto sw_ = __builtin_amdgcn_permlane32_swap(__float_as_uint(mx), __float_as_uint(mx), false, false); mx = fmaxf(__uint_as_float(sw_[0]), __uint_as_float(sw_[1])); }
        const float m_new = fmaxf(m_run, mx), alpha = __builtin_amdgcn_exp2f(m_run - m_new); m_run = m_new;
        float ps = 0.f;
#pragma unroll
        for (int k2 = 0; k2 < 2; ++k2)
#pragma unroll
            for (int i = 0; i < 16; ++i) { const float p = __builtin_amdgcn_exp2f(sacc[k2][i] - m_new); sacc[k2][i] = p; ps += p; }
        l_run = l_run * alpha + ps;
        if (__ballot(alpha != 1.0f)) {
#pragma unroll
        for (int dt = 0; dt < 4; ++dt)
#pragma unroll
            for (int i = 0; i < 16; ++i) oacc[dt][i] *= alpha;
        }
#pragma unroll
        for (int k2 = 0; k2 < 2; ++k2)
#pragma unroll
            for (int s2 = 0; s2 < 2; ++s2) {
                v4u pw; pw.x = pg8::cvt_pk_bf16(sacc[k2][8 * s2 + 0], sacc[k2][8 * s2 + 1]); pw.y = pg8::cvt_pk_bf16(sacc[k2][8 * s2 + 2], sacc[k2][8 * s2 + 3]);
                pw.z = pg8::cvt_pk_bf16(sacc[k2][8 * s2 + 4], sacc[k2][8 * s2 + 5]); pw.w = pg8::cvt_pk_bf16(sacc[k2][8 * s2 + 6], sacc[k2][8 * s2 + 7]);
                const bf16x8_t pb = __builtin_bit_cast(bf16x8_t, pw);
                const int i16 = lane & 15, grp = (lane >> 4) & 1;
                const LAS unsigned char* vp = vb + (32 * k2 + 16 * s2 + 4 * hf + (i16 >> 2)) * FA_VP + (16 * grp + 4 * (i16 & 3)) * 2;
#pragma unroll
                for (int dt = 0; dt < 4; ++dt) { const s16x4 lo = fa_vtr(vp + 64 * dt), hi = fa_vtr(vp + 8 * FA_VP + 64 * dt);
                    const bf16x8_t vf = __builtin_shufflevector(lo, hi, 0, 1, 2, 3, 4, 5, 6, 7);
                    oacc[dt] = __builtin_amdgcn_mfma_f32_32x32x16_bf16(vf, pb, oacc[dt], 0, 0, 0); }
            }
    }
    float l_tot = l_run + __shfl_xor(l_run, 32);
    if (MODE == 1) l_tot += __builtin_amdgcn_exp2f(F.in[I_SINK][l * 8 + hd - 4] * 1.4426950408889634f - m_run);
    const float inv = 1.0f / l_tot;
    bf16* orow = F.OCAT + qrow * 2048 + ocol + 4 * hf;
#pragma unroll
    for (int dt = 0; dt < 4; ++dt)
#pragma unroll
        for (int gq = 0; gq < 4; ++gq) { v2u w; w.x = pk2(oacc[dt][4 * gq] * inv, oacc[dt][4 * gq + 1] * inv); w.y = pk2(oacc[dt][4 * gq + 2] * inv, oacc[dt][4 * gq + 3] * inv);
            *(v2u*)(orow + 32 * dt + 8 * gq) = w; }
    __syncthreads();
}


#define GLA_GATE_PREFIX(LDS_TOT) \
        float la[8]; \
        _Pragma("unroll") for (int i = 0; i < 8; ++i) { const v4u c0 = rc0[i], c1 = rc1[i]; float x = gb; \
            x += bflo(c0.x) * gwv[0] + bfhi(c0.x) * gwv[1] + bflo(c0.y) * gwv[2] + bfhi(c0.y) * gwv[3] + bflo(c0.z) * gwv[4] + bfhi(c0.z) * gwv[5] + bflo(c0.w) * gwv[6] + bfhi(c0.w) * gwv[7]; \
            x += bflo(c1.x) * gwv[8] + bfhi(c1.x) * gwv[9] + bflo(c1.y) * gwv[10] + bfhi(c1.y) * gwv[11] + bflo(c1.z) * gwv[12] + bfhi(c1.z) * gwv[13] + bflo(c1.w) * gwv[14] + bfhi(c1.w) * gwv[15]; \
            la[i] = (fminf(x, 0.f) - __logf(1.0f + __expf(-fabsf(x)))) * 0.0625f; } \
        _Pragma("unroll") for (int i = 1; i < 8; ++i) la[i] += la[i - 1]; \
        ((LAS float*)(L + LDS_TOT))[cg * 64 + dk] = la[7];
#define GLA_OFFSETS(LDS_TOT) \
        float off = 0.f, tot = 0.f; \
        _Pragma("unroll") for (int g2 = 0; g2 < 8; ++g2) { const float tv = ((const LAS float*)(L + LDS_TOT))[g2 * 64 + dk]; tot += tv; off += g2 < cg ? tv : 0.f; }

__device__ __forceinline__ void gla_state_phase(Frame& F, int l) {
    const int tid = F.tid, lane = F.lane, wave = F.wave, r = lane & 31, hf = lane >> 5, i16 = lane & 15, grp = (lane >> 4) & 1;
    LAS unsigned char* L = F.lds;
    constexpr int KDT = 0, VT = 9216, TOT = 29696, RP = 144, VP = 320;
    const int dk = lane, cg = wave;
    float* GCS = (float*)(F.ws + WS_GCS); float* GDEC = (float*)(F.ws + WS_GDEC);
    v4u rc0[8], rc1[8], rv[2]; unsigned short rk[8];
#define GLS_LOAD(u_) do { const int bh_ = (u_) >> 5, n_ = (u_) & 31; const size_t r0_ = (size_t)((bh_ >> 2) * 2048 + 64 * n_); const int h_ = bh_ & 3; \
        _Pragma("unroll") for (int i = 0; i < 8; ++i) { const bf16* zr = F.Z + (r0_ + 8 * cg + i) * ZP; rc0[i] = *(const v4u*)(zr + ZC_CG); rc1[i] = *(const v4u*)(zr + ZC_CG + 8); rk[i] = zr[ZC_CK + h_ * 64 + dk]; } \
        _Pragma("unroll") for (int i = 0; i < 2; ++i) rv[i] = *(const v4u*)(F.Z + (r0_ + (tid >> 4) + 32 * i) * ZP + ZC_CV + h_ * 128 + 8 * (tid & 15)); } while (0)
    int u = F.vcu;
    if (u < 2048) GLS_LOAD(u);
    for (; u < 2048; u += F.G) {
        const int h = (u >> 5) & 3;
        float gwv[16];
#pragma unroll
        for (int q = 0; q < 16; ++q) gwv[q] = F.in[I_CGW][(size_t)l * 4096 + q * 256 + h * 64 + dk];
        const float gb = F.in[I_CGB][l * 256 + h * 64 + dk];
        GLA_GATE_PREFIX(TOT)
        float kv[8];
#pragma unroll
        for (int i = 0; i < 8; ++i) kv[i] = bf1(rk[i]);
#pragma unroll
        for (int i = 0; i < 2; ++i) *(LAS v4u*)(L + VT + ((tid >> 4) + 32 * i) * VP + 16 * (tid & 15)) = rv[i];
        __syncthreads();
        GLA_OFFSETS(TOT)
        { float kd[8];
#pragma unroll
          for (int i = 0; i < 8; ++i) kd[i] = kv[i] * __expf(tot - (off + la[i]));
          v4u w; w.x = pk2(kd[0], kd[1]); w.y = pk2(kd[2], kd[3]); w.z = pk2(kd[4], kd[5]); w.w = pk2(kd[6], kd[7]); *(LAS v4u*)(L + KDT + dk * RP + 16 * cg) = w; }
        if (cg == 0) GDEC[(size_t)u * 64 + dk] = __expf(tot);
        __syncthreads();
        if (u + F.G < 2048) GLS_LOAD(u + F.G);
        { const int dkt = wave >> 2, dvt = wave & 3;
          f32x16 cs;
#pragma unroll
          for (int i = 0; i < 16; ++i) cs[i] = 0.f;
#pragma unroll
          for (int ks = 0; ks < 4; ++ks) { const bf16x8_t a = *(const LAS bf16x8_t*)(L + KDT + (32 * dkt + r) * RP + (16 * ks + 8 * hf) * 2);
              const LAS unsigned char* vp = L + VT + (16 * ks + 8 * hf + (i16 >> 2)) * VP + (32 * dvt + 16 * grp + 4 * (i16 & 3)) * 2;
              const s16x4 lo = fa_vtr(vp), hi = fa_vtr(vp + 4 * VP);
              cs = __builtin_amdgcn_mfma_f32_32x32x16_bf16(a, __builtin_shufflevector(lo, hi, 0, 1, 2, 3, 4, 5, 6, 7), cs, 0, 0, 0); }
          float* gp = GCS + (size_t)u * 8192 + (size_t)(32 * dkt + 4 * hf) * 128 + 32 * dvt + r;
#pragma unroll
          for (int i = 0; i < 16; ++i) gp[((i & 3) + 8 * (i >> 2)) * 128] = cs[i]; }
        __syncthreads();
    }
#undef GLS_LOAD
}

__device__ __forceinline__ void gla_scan_phase(Frame& F) {
    float* GCS = (float*)(F.ws + WS_GCS); const float* GDEC = (const float*)(F.ws + WS_GDEC);
    for (int gt = F.gw * 64 + F.lane; gt < 64 * 2048; gt += F.NGW * 64) {
        const int bh = gt >> 11, e4 = gt & 2047, dk = e4 >> 5;
        f32x4* p = (f32x4*)(GCS + (size_t)bh * 32 * 8192) + e4; const float* dp = GDEC + (size_t)bh * 32 * 64 + dk;
        f32x4 st = (f32x4){0.f, 0.f, 0.f, 0.f};
#pragma unroll 1
        for (int n0 = 0; n0 < 32; n0 += 8) {
            f32x4 cs[8]; float dc[8];
#pragma unroll
            for (int j = 0; j < 8; ++j) { cs[j] = p[(size_t)(n0 + j) * 2048]; dc[j] = dp[(n0 + j) * 64]; }
#pragma unroll
            for (int j = 0; j < 8; ++j) { p[(size_t)(n0 + j) * 2048] = st; st = st * dc[j] + cs[j]; }
        }
    }
}

__device__ __forceinline__ void gla_out_phase(Frame& F, int l) {
    const int tid = F.tid, lane = F.lane, wave = F.wave, r = lane & 31, hf = lane >> 5, i16 = lane & 15, grp = (lane >> 4) & 1;
    LAS unsigned char* L = F.lds;
    constexpr int QG = 0, KG = 9216, VT = 18432, PT = 38912, TOT = 59392, OT = 61440, RP = 144, VP = 320, OP = 132;
    const int dk = lane, cg = wave;
    const float* GCS = (const float*)(F.ws + WS_GCS);
    v4u rc0[8], rc1[8], rv[2]; unsigned short rq[8], rk[8]; unsigned rg[8]; f32x4 rp[4];
#define GLO_LOAD(u_) do { const int bh_ = (u_) >> 5, n_ = (u_) & 31; const size_t r0_ = (size_t)((bh_ >> 2) * 2048 + 64 * n_); const int h_ = bh_ & 3; \
        _Pragma("unroll") for (int i = 0; i < 8; ++i) { const bf16* zr = F.Z + (r0_ + 8 * cg + i) * ZP; rc0[i] = *(const v4u*)(zr + ZC_CG); rc1[i] = *(const v4u*)(zr + ZC_CG + 8); rq[i] = zr[ZC_CQ + h_ * 64 + dk]; rk[i] = zr[ZC_CK + h_ * 64 + dk]; \
            rg[i] = *(const unsigned*)(zr + ZC_CR + h_ * 128 + 2 * lane); } \
        _Pragma("unroll") for (int i = 0; i < 2; ++i) rv[i] = *(const v4u*)(F.Z + (r0_ + (tid >> 4) + 32 * i) * ZP + ZC_CV + h_ * 128 + 8 * (tid & 15)); \
        _Pragma("unroll") for (int i = 0; i < 4; ++i) rp[i] = *(const f32x4*)(GCS + (size_t)(u_) * 8192 + (size_t)(tid >> 3) * 128 + 16 * (tid & 7) + 4 * i); } while (0)
    int u = F.vcu;
    if (u < 2048) GLO_LOAD(u);
    const float g0 = F.in[I_CNG][l * 128 + 2 * lane], g1 = F.in[I_CNG][l * 128 + 2 * lane + 1];
    for (; u < 2048; u += F.G) {
        const int bh = u >> 5, n = u & 31, h = bh & 3; const size_t row0 = (size_t)((bh >> 2) * 2048 + 64 * n);
        float gwv[16];
#pragma unroll
        for (int q = 0; q < 16; ++q) gwv[q] = F.in[I_CGW][(size_t)l * 4096 + q * 256 + h * 64 + dk];
        const float gb = F.in[I_CGB][l * 256 + h * 64 + dk];
        GLA_GATE_PREFIX(TOT)
        float qv[8], kv[8]; unsigned gr[8];
#pragma unroll
        for (int i = 0; i < 8; ++i) { qv[i] = bf1(rq[i]); kv[i] = bf1(rk[i]); gr[i] = rg[i]; }
#pragma unroll
        for (int i = 0; i < 2; ++i) *(LAS v4u*)(L + VT + ((tid >> 4) + 32 * i) * VP + 16 * (tid & 15)) = rv[i];
        { v4u w0, w1; w0.x = pk2(rp[0].x, rp[0].y); w0.y = pk2(rp[0].z, rp[0].w); w0.z = pk2(rp[1].x, rp[1].y); w0.w = pk2(rp[1].z, rp[1].w);
          w1.x = pk2(rp[2].x, rp[2].y); w1.y = pk2(rp[2].z, rp[2].w); w1.z = pk2(rp[3].x, rp[3].y); w1.w = pk2(rp[3].z, rp[3].w);
          *(LAS v4u*)(L + PT + (tid >> 3) * VP + 32 * (tid & 7)) = w0; *(LAS v4u*)(L + PT + (tid >> 3) * VP + 32 * (tid & 7) + 16) = w1; }
        __syncthreads();
        GLA_OFFSETS(TOT)
#pragma unroll
        for (int i = 0; i < 8; ++i) { const float bi = off + la[i];
            *(LAS bf16*)(L + QG + (8 * cg + i) * RP + 2 * dk) = (bf16)f2bf(qv[i] * 0.125f * __expf(bi));
            *(LAS bf16*)(L + KG + (8 * cg + i) * RP + 2 * dk) = (bf16)f2bf(kv[i] * __expf(-bi)); }
        __syncthreads();
        if (u + F.G < 2048) GLO_LOAD(u + F.G);
        { const int ct = wave >> 2, dvt = wave & 3;
          f32x16 o;
#pragma unroll
          for (int i = 0; i < 16; ++i) o[i] = 0.f;
#pragma unroll
          for (int st = 0; st < 2; ++st) if (st <= ct) {
              f32x16 at;
#pragma unroll
              for (int i = 0; i < 16; ++i) at[i] = 0.f;
#pragma unroll
              for (int ks = 0; ks < 4; ++ks) { const bf16x8_t a = *(const LAS bf16x8_t*)(L + KG + (32 * st + r) * RP + (16 * ks + 8 * hf) * 2), bq = *(const LAS bf16x8_t*)(L + QG + (32 * ct + r) * RP + (16 * ks + 8 * hf) * 2);
                  at = __builtin_amdgcn_mfma_f32_32x32x16_bf16(a, bq, at, 0, 0, 0); }
              if (st == ct) {
#pragma unroll
                  for (int i = 0; i < 16; ++i) { const int cr = (i & 3) + 8 * (i >> 2) + 4 * hf; at[i] = cr <= r ? at[i] : 0.f; } }
#pragma unroll
              for (int s2 = 0; s2 < 2; ++s2) {
                  v4u pw; pw.x = pg8::cvt_pk_bf16(at[8 * s2 + 0], at[8 * s2 + 1]); pw.y = pg8::cvt_pk_bf16(at[8 * s2 + 2], at[8 * s2 + 3]); pw.z = pg8::cvt_pk_bf16(at[8 * s2 + 4], at[8 * s2 + 5]); pw.w = pg8::cvt_pk_bf16(at[8 * s2 + 6], at[8 * s2 + 7]);
                  const LAS unsigned char* vp = L + VT + (32 * st + 16 * s2 + 4 * hf + (i16 >> 2)) * VP + (32 * dvt + 16 * grp + 4 * (i16 & 3)) * 2;
                  const s16x4 lo = fa_vtr(vp), hi = fa_vtr(vp + 8 * VP);
                  o = __builtin_amdgcn_mfma_f32_32x32x16_bf16(__builtin_bit_cast(bf16x8_t, pw), __builtin_shufflevector(lo, hi, 0, 1, 2, 3, 4, 5, 6, 7), o, 0, 0, 0);
              }
          }
#pragma unroll
          for (int ks = 0; ks < 4; ++ks) { const bf16x8_t a = *(const LAS bf16x8_t*)(L + QG + (32 * ct + r) * RP + (16 * ks + 8 * hf) * 2);
              const LAS unsigned char* pp = L + PT + (16 * ks + 8 * hf + (i16 >> 2)) * VP + (32 * dvt + 16 * grp + 4 * (i16 & 3)) * 2;
              const s16x4 lo = fa_vtr(pp), hi = fa_vtr(pp + 4 * VP);
              o = __builtin_amdgcn_mfma_f32_32x32x16_bf16(a, __builtin_shufflevector(lo, hi, 0, 1, 2, 3, 4, 5, 6, 7), o, 0, 0, 0); }
          LAS float* op = (LAS float*)(L + OT) + (32 * ct + 4 * hf) * OP + 32 * dvt + r;
#pragma unroll
          for (int i = 0; i < 16; ++i) op[((i & 3) + 8 * (i >> 2)) * OP] = o[i]; }
        __syncthreads();
        { float a[8], c[8], ss[8];
#pragma unroll
          for (int i = 0; i < 8; ++i) { const LAS float* orow = (const LAS float*)(L + OT) + (8 * wave + i) * OP + 2 * lane; a[i] = orow[0]; c[i] = orow[1]; ss[i] = a[i] * a[i] + c[i] * c[i]; }
#pragma unroll
          for (int o2 = 1; o2 < 64; o2 <<= 1) {
#pragma unroll
              for (int i = 0; i < 8; ++i) ss[i] += __shfl_xor(ss[i], o2); }
#pragma unroll
          for (int i = 0; i < 8; ++i) { const float rstd = rsqrtf(ss[i] * (1.0f / 128.0f) + EPS);
              *(unsigned*)(F.OCAT + (row0 + 8 * wave + i) * 2048 + 1536 + h * 128 + 2 * lane) = pk2(a[i] * rstd * g0 * bflo(gr[i]), c[i] * rstd * g1 * bfhi(gr[i])); } }
        __syncthreads();
    }
#undef GLO_LOAD
}
#undef GLA_GATE_PREFIX
#undef GLA_OFFSETS

__device__ __forceinline__ bool in_phase(int k, int lo, int hi) { asm volatile("" : "+s"(k)); return lo <= k && k < hi; }
#define IN(k) in_phase((k), lo, hi)
#define PHASE_LANE() do { int _tz = threadIdx.x; asm volatile("" : "+v"(_tz)); F.tid = _tz; F.lane = _tz & 63; } while (0)
#define SEAM(k) do { if (IN(k) && IN((k) + 1)) xcd_barrier(bar); } while (0)
template <int l>
__device__ __forceinline__ void layer_body(Frame& F, const XcdBarrier& bar, const int lo, const int hi) {
    constexpr int pb = 1 + 11 * l;
        if (IN(pb + 0)) {
            { pg8::Gemm g{(const bf16*)(F.ws + WS_HB), (const bf16*)(F.ws + WS_WIN + l * WIN_L + 24 * MiB), T, 768, D}; pg8::StaticOrder S; S.init(T, 768, D, F.G, (int)blockIdx.x);
              pg8::EpiInProj<1> E{F.Z, F.ws + WS_GT, (LAS unsigned long long*)(F.misc + MO_SS), (const LAS float*)(F.misc + MO_GN) + l * 512, (const float*)(F.ws + WS_RSTD1)};
              pg8::gemm_phase<pg8::EpiInProj<1>, pg8::StaticOrder, true, false>(F.lds, g, S, E); }
            { pg8::Gemm g{(const bf16*)(F.ws + WS_XN8), (const bf16*)(F.ws + WS_WIN + l * WIN_L), T, 10496, D / 2}; pg8::StaticOrder S; S.init(T, 10496, D / 2, F.G, ((int)blockIdx.x + F.G / 2) % F.G);
              pg8::EpiInProj<0> E{F.Z, F.ws + WS_GT, (LAS unsigned long long*)(F.misc + MO_SS), (const LAS float*)(F.misc + MO_GN) + l * 512, (const float*)(F.ws + WS_RSTD1)};
              pg8::gemm_phase<pg8::EpiInProj<0>, pg8::StaticOrder, true, true>(F.lds, g, S, E); }
        }
        SEAM(pb + 0);
        if (IN(pb + 1)) { PHASE_LANE();
            if (F.wave & 4) convert_moe(F, l, 0, 4, 40960);
            for (int it = F.gw; it < NB * 128; it += F.NGW) {
                const int b = it >> 7, j = it & 127;
                indexer_segment(F, b, j, 0, j < 64 ? j + 1 : 64);
                if (j < 64) indexer_segment(F, b, 127 - j, 64, 128 - j);
            }
            if (!(F.wave & 4)) convert_moe(F, l, 0, 4, 40960);
            PHASE_LANE();
            gla_state_phase(F, l);
        }
        SEAM(pb + 1);
        if (IN(pb + 2)) { PHASE_LANE();
            if (F.wave & 4) convert_moe(F, l, 1, 4, 0);
            for (int row = F.gw; row < T; row += F.NGW) {
                const int t = row & 2047;
                if (t < 256) { const int nb = t + 1 - 32 * F.lane; F.MASK[(size_t)row * 64 + F.lane] = nb >= 32 ? 0xffffffffu : (nb <= 0 ? 0u : ((1u << nb) - 1u)); continue; }
                float val[32];
#pragma unroll
                for (int j = 0; j < 32; ++j) { const int s_ = 64 * j + F.lane; val[j] = F.S[(size_t)row * 2048 + (s_ < t ? s_ : t)]; }
                float vmx = -3.0e38f, vmn = 3.0e38f;
#pragma unroll
                for (int j = 0; j < 32; ++j) { const bool ok = 64 * j + F.lane <= t; val[j] = ok ? val[j] : -3.0e38f; vmx = fmaxf(vmx, val[j]); vmn = fminf(vmn, ok ? val[j] : 3.0e38f); }
#pragma unroll
                for (int o = 1; o < 64; o <<= 1) { vmx = fmaxf(vmx, __shfl_xor(vmx, o)); vmn = fminf(vmn, __shfl_xor(vmn, o)); }
                float lo = vmn, hi = vmx, thf = 0.f; bool exact = false;
#pragma unroll 1
                for (int it = 0; it < 28; ++it) { const float mid = 0.5f * (lo + hi); if (!(mid > lo && mid < hi)) break; int cnt = 0;
#pragma unroll
                    for (int j = 0; j < 32; ++j) cnt += __popcll(__ballot(val[j] >= mid));
                    if (cnt == 256) { exact = true; thf = mid; break; }
                    if (cnt > 256) lo = mid; else hi = mid; }
                unsigned th = 0u; int need = 0;
#define KEYOF(x) ({ const unsigned u_ = __float_as_uint(x); (u_ & 0x80000000u) ? ~u_ : (u_ | 0x80000000u); })
                if (!exact) {
#pragma unroll 1
                    for (int bit = 31; bit >= 0; --bit) { const unsigned cand = th | (1u << bit); int cnt = 0;
#pragma unroll
                        for (int j = 0; j < 32; ++j) cnt += __popcll(__ballot(KEYOF(val[j]) >= cand));
                        if (cnt >= 256) th = cand; }
                    int cgt = 0;
#pragma unroll
                    for (int j = 0; j < 32; ++j) cgt += __popcll(__ballot(KEYOF(val[j]) > th));
                    need = 256 - cgt;
                }
                int run = 0; unsigned myword = 0u;
#pragma unroll
                for (int j = 0; j < 32; ++j) {
                    bool sel;
                    if (exact) sel = val[j] >= thf;
                    else { const unsigned kj = KEYOF(val[j]); const bool eq = kj == th; const unsigned long long eqm = __ballot(eq);
                        const int pre = run + __popcll(eqm & ((1ull << F.lane) - 1ull)); sel = (kj > th) || (eq && pre < need); run += __popcll(eqm); sel = sel && (64 * j + F.lane <= t); }
                    const unsigned long long sm = __ballot(sel);
                    if ((F.lane >> 1) == j) myword = (F.lane & 1) ? (unsigned)(sm >> 32) : (unsigned)sm;
                }
#undef KEYOF
                F.MASK[(size_t)row * 64 + F.lane] = myword;
            }
            if (!(F.wave & 4)) convert_moe(F, l, 1, 4, 0);
            gla_scan_phase(F);
        }
        SEAM(pb + 2);
        if (IN(pb + 3)) { PHASE_LANE();
            if (F.vcu & 1) { convert_moe(F, l, 1, 2, 0); __syncthreads(); PHASE_LANE(); }
            for (int u = F.vcu; u < NB * 16; u += F.G) { const int b = u >> 4, p = u & 15; flash_unit<0>(F, l, b, 0, 64 * (31 - p)); flash_unit<0>(F, l, b, 0, 64 * p); }
            for (int u = F.vcu; u < NB * 2 * 32; u += F.G) { const int b = u >> 6, g = (u >> 5) & 1, qb = u & 31; flash_unit<1>(F, l, b, g, 64 * qb); }
            gla_out_phase(F, l);
            if (!(F.vcu & 1)) { PHASE_LANE(); convert_moe(F, l, 1, 2, 0); }
        }
        SEAM(pb + 3);
        if (IN(pb + 4)) {
            pg8::Gemm g{F.OCAT, (const bf16*)(F.ws + WS_WBR + l * WBR_L), T, D, D}; pg8::MergeOrder S; S.init(T, D, D, F.G, (int)blockIdx.x);
#ifdef PROBE_MERGE
            { pg8::EpiMergeT<PROBE_MERGE> E{F.ws + WS_GT, (bf16*)(F.ws + WS_S)}; pg8::gemm_phase<pg8::EpiMergeT<PROBE_MERGE>, pg8::MergeOrder, true>(F.lds, g, S, E); }
#endif
            pg8::EpiMerge E{F.ws + WS_GT, F.MERGED};
            pg8::gemm_phase<pg8::EpiMerge, pg8::MergeOrder, true>(F.lds, g, S, E);
        }
        SEAM(pb + 4);
        if (IN(pb + 5)) {
            pg8::Gemm g{F.MERGED, (const bf16*)(F.ws + WS_WO + l * WO_L), T, D, D}; pg8::StaticOrder S; S.init(T, D, D, F.G, (int)blockIdx.x);
            pg8::EpiResid E{(bf16*)(F.ws + WS_HB), (unsigned char*)F.XN, F.in[I_N2G] + l * D, F.lds + 3 * pg8::HTB};
            pg8::gemm_phase<pg8::EpiResid, pg8::StaticOrder, true>(F.lds, g, S, E);
        }
        SEAM(pb + 5);
        if (IN(pb + 6)) { PHASE_LANE();
            unsigned* cnt = F.ctl + CW_CNT + 64 * l;
            const int lane = F.lane, fr = lane & 15, fq = lane >> 4;
            const int kh = F.wave & 3, tg = F.wave >> 2;
            LAS float* P = (LAS float*)F.lds;
            const bf16* wrh = (const bf16*)(F.ws + WS_WRH + l * WR_L) + (size_t)fr * 2048 + 8 * fq + 512 * kh; const bf16* wrl = (const bf16*)(F.ws + WS_WRL + l * WR_L) + (size_t)fr * 2048 + 8 * fq + 512 * kh;
            for (int unit = F.vcu; unit < T / 128; unit += F.G) {
                const bf16* hrow = (const bf16*)(F.ws + WS_HB) + (size_t)(128 * unit + 64 * tg + fr) * D + 8 * fq + 512 * kh;
                f32x4 acc[4][5];
                float ss[4];
#pragma unroll
                for (int s = 0; s < 4; ++s) { ss[s] = 0.f;
#pragma unroll
                    for (int nt = 0; nt < 5; ++nt) acc[s][nt] = (f32x4){0.f, 0.f, 0.f, 0.f}; }
#pragma unroll 2
                for (int ks = 0; ks < 16; ++ks) {
                    v4u hw[4];
#pragma unroll
                    for (int s = 0; s < 4; ++s) hw[s] = *(const v4u*)(hrow + (size_t)(16 * s) * D + 32 * ks);
#pragma unroll
                    for (int s = 0; s < 4; ++s) { const float a0 = bflo(hw[s].x), a1 = bfhi(hw[s].x), a2 = bflo(hw[s].y), a3 = bfhi(hw[s].y), a4 = bflo(hw[s].z), a5 = bfhi(hw[s].z), a6 = bflo(hw[s].w), a7 = bfhi(hw[s].w);
                        ss[s] += (a0 * a0 + a1 * a1) + (a2 * a2 + a3 * a3) + (a4 * a4 + a5 * a5) + (a6 * a6 + a7 * a7); }
#pragma unroll
                    for (int nt = 0; nt < 5; ++nt) { const bf16x8_t bh = *(const bf16x8_t*)(wrh + (size_t)(16 * nt) * 2048 + 32 * ks), bl = *(const bf16x8_t*)(wrl + (size_t)(16 * nt) * 2048 + 32 * ks);
#pragma unroll
                        for (int s = 0; s < 4; ++s) { const bf16x8_t ah = __builtin_bit_cast(bf16x8_t, hw[s]);
                            acc[s][nt] = __builtin_amdgcn_mfma_f32_16x16x32_bf16(ah, bh, acc[s][nt], 0, 0, 0);
                            acc[s][nt] = __builtin_amdgcn_mfma_f32_16x16x32_bf16(ah, bl, acc[s][nt], 0, 0, 0); } }
                }
#pragma unroll
                for (int s = 0; s < 4; ++s) { ss[s] += __shfl_xor(ss[s], 16); ss[s] += __shfl_xor(ss[s], 32); }
#define K6_PUT(slot_) do { LAS float* L_ = P + (slot_) * 2048; _Pragma("unroll") for (int s = 0; s < 4; ++s) { LAS float* Ls = L_ + s * 2048; if (fq == 0) Ls[1616 + fr] = ss[s]; \
                    _Pragma("unroll") for (int nt = 0; nt < 5; ++nt) _Pragma("unroll") for (int i = 0; i < 4; ++i) Ls[(4 * fq + i) * 100 + 16 * nt + fr] = acc[s][nt][i]; } } while (0)
#define K6_ADD(slot_) do { const LAS float* L_ = P + (slot_) * 2048; _Pragma("unroll") for (int s = 0; s < 4; ++s) { const LAS float* Ls = L_ + s * 2048; ss[s] += Ls[1616 + fr]; \
                    _Pragma("unroll") for (int nt = 0; nt < 5; ++nt) _Pragma("unroll") for (int i = 0; i < 4; ++i) acc[s][nt][i] += Ls[(4 * fq + i) * 100 + 16 * nt + fr]; } } while (0)
                if (kh >= 2) K6_PUT((kh - 2) * 8 + 4 * tg);
                __syncthreads();
                if (kh < 2) { K6_ADD(kh * 8 + 4 * tg); }
                if (kh == 1) { LDS_WAIT(); asm volatile("" ::: "memory"); K6_PUT(8 + 4 * tg); }
                __syncthreads();
                if (kh == 0) { K6_ADD(8 + 4 * tg); LDS_WAIT(); asm volatile("" ::: "memory"); K6_PUT(4 * tg); }
                __syncthreads();
#undef K6_PUT
#undef K6_ADD
                const int tile = 8 * unit + F.wave;
                LAS float* LG = P + F.wave * 2048;
                if (lane < 16) { const float ssq = LG[1616 + lane]; const float rs_ = rsqrtf(ssq * (1.0f / 2048.0f) + EPS); LG[1600 + lane] = rs_; ((float*)(F.ws + WS_RSTD))[16 * tile + lane] = rs_; }
                LDS_WAIT(); asm volatile("" ::: "memory");
                if (lane < 16) {
                    const int row = 16 * tile + lane; const float rstd = LG[1600 + lane]; const LAS float* lr = LG + lane * 100;
                    float lg[8]; int grp = 0; float gmax = -3.0e38f;
#pragma unroll
                    for (int e = 0; e < 8; ++e) { lg[e] = lr[e] * rstd + F.in[I_BRG][l * 8 + e]; if (lg[e] > gmax) { gmax = lg[e]; grp = e; } }
                    float gden = 0.f;
#pragma unroll
                    for (int e = 0; e < 8; ++e) gden += __expf(lg[e] - gmax);
                    const float gwt = 1.0f / gden;
                    int i0 = 0, i1 = 0; float m0 = -3.0e38f, m1 = -3.0e38f;
#pragma unroll
                    for (int e = 0; e < 8; ++e) { const float v = lr[8 + grp * 8 + e] * rstd + F.in[I_BRE][l * 64 + grp * 8 + e];
                        if (v > m0) { m1 = m0; i1 = i0; m0 = v; i0 = e; } else if (v > m1) { m1 = v; i1 = e; } }
                    const float e1 = __expf(m1 - m0); const float p0 = 1.0f / (1.0f + e1), p1 = e1 / (1.0f + e1);
                    const int ex0 = grp * 8 + i0, ex1 = grp * 8 + i1;
                    const unsigned r0 = atomicAdd(&cnt[ex0], 1u), r1 = atomicAdd(&cnt[ex1], 1u);
                    unsigned* rec = (unsigned*)(F.ws + WS_ROUTE) + (size_t)row * 8;
                    rec[0] = (unsigned)ex0; rec[1] = r0; rec[2] = (unsigned)ex1; rec[3] = r1; rec[4] = __float_as_uint(gwt * p0); rec[5] = __float_as_uint(gwt * p1);
                    int* liste = (int*)(F.ws + WS_LISTE); liste[(size_t)ex0 * 32768 + r0] = row; liste[(size_t)ex1 * 32768 + r1] = row;
                }
                LDS_WAIT(); asm volatile("" ::: "memory");
                __syncthreads();
            }
        }
        SEAM(pb + 6);
        if (IN(pb + 7) || IN(pb + 8) || IN(pb + 9) || IN(pb + 10)) { PHASE_LANE();
            if (F.tid == 0) { const unsigned* cnt = F.ctl + CW_CNT + 64 * l; LAS int* texp = (LAS int*)(F.misc + MO_TEXP); LAS int* pst = (LAS int*)(F.misc + MO_PST); int tb = 0;
                for (int e = 0; e < NEXP; ++e) { const int c = (int)__hip_atomic_load(&cnt[e], __ATOMIC_RELAXED, __HIP_MEMORY_SCOPE_AGENT); const int nt_ = (c + 255) >> 8; pst[e] = tb * 256; ((LAS int*)(F.misc + MO_CNT))[e] = c;
                    for (int r = 0; r < nt_; ++r) texp[tb + r] = e; tb += nt_; }
                *(LAS int*)(F.misc + MO_TOT) = tb; }
            __syncthreads();
        }
        if (IN(pb + 8)) {
            pg8::Gemm g{F.XN, (const bf16*)(F.ws + WS_W13), 0, 0, D / 2};
            pg8::MoeGatherOrder S; S.total = *(const LAS int*)(F.misc + MO_TOT) * 4; S.G = F.G; S.c = F.vcu; S.NJ = 4; S.nt0 = D / 128; S.tile_exp = (const LAS int*)(F.misc + MO_TEXP);
            S.pst = (const LAS int*)(F.misc + MO_PST); S.cnt = (const LAS int*)(F.misc + MO_CNT); S.liste = (const int*)(F.ws + WS_LISTE);
            pg8::EpiGlu E{F.H, S.tile_exp, S.pst, S.cnt, S.liste, (const float*)(F.ws + WS_RSTD)};
            pg8::gemm_phase<pg8::EpiGlu, pg8::MoeGatherOrder, true, true>(F.lds, g, S, E);
        }
        SEAM(pb + 8);
        if (IN(pb + 9)) {
            pg8::Gemm g{F.H, (const bf16*)(F.ws + WS_W2), 0, 0, DEXP / 2};
            pg8::MoeOrder S{*(const LAS int*)(F.misc + MO_TOT) * 8, F.G, F.vcu, 8, DEXP / 128, (const LAS int*)(F.misc + MO_TEXP)};
            pg8::EpiY E{(unsigned char*)F.Y};
            pg8::gemm_phase<pg8::EpiY, pg8::MoeOrder, true, true>(F.lds, g, S, E);
        }
        SEAM(pb + 9);
        if (IN(pb + 10)) { PHASE_LANE();
            for (int row = F.gw; row < T; row += F.NGW) {
                const unsigned* rec = (const unsigned*)(F.ws + WS_ROUTE) + (size_t)row * 8;
                const float w0 = __uint_as_float(rec[4]) * 0.03125f, w1 = __uint_as_float(rec[5]) * 0.03125f;
                const LAS int* pst = (const LAS int*)(F.misc + MO_PST); const int p0 = pst[rec[0]] + (int)rec[1], p1 = pst[rec[2]] + (int)rec[3];
                const unsigned* y0 = (const unsigned*)((const unsigned char*)F.Y + (size_t)p0 * D) + F.lane; const unsigned* y1 = (const unsigned*)((const unsigned char*)F.Y + (size_t)p1 * D) + F.lane;
                f32x4 v[8];
                { const v2u* hr = (const v2u*)((const bf16*)(F.ws + WS_HB) + (size_t)row * D) + F.lane;
#pragma unroll
                  for (int j = 0; j < 8; ++j) { const v2u w = hr[64 * j]; v[j] = (f32x4){bflo(w.x), bfhi(w.x), bflo(w.y), bfhi(w.y)}; } }
#pragma unroll
                for (int j = 0; j < 8; ++j) { const int a = (int)y0[64 * j], c = (int)y1[64 * j];
                    const auto a01 = __builtin_amdgcn_cvt_pk_f32_fp8(a, false), a23 = __builtin_amdgcn_cvt_pk_f32_fp8(a, true), c01 = __builtin_amdgcn_cvt_pk_f32_fp8(c, false), c23 = __builtin_amdgcn_cvt_pk_f32_fp8(c, true);
                    v[j].x += w0 * a01[0] + w1 * c01[0]; v[j].y += w0 * a01[1] + w1 * c01[1]; v[j].z += w0 * a23[0] + w1 * c23[0]; v[j].w += w0 * a23[1] + w1 * c23[1]; }
                if (l + 1 < DEPTH) { v2u* hw_ = (v2u*)((bf16*)(F.ws + WS_HB) + (size_t)row * D) + F.lane;
#pragma unroll
                    for (int j = 0; j < 8; ++j) hw_[64 * j] = (v2u){pg8::cvt_pk_bf16(v[j].x, v[j].y), pg8::cvt_pk_bf16(v[j].z, v[j].w)}; }
                else { f32x4* orow = (f32x4*)(F.out + (size_t)row * D) + F.lane;
#pragma unroll
                    for (int j = 0; j < 8; ++j) orow[64 * j] = v[j]; }
                if (l + 1 < DEPTH) { const float rstd = row_rstd(v); if (F.lane == 0) ((float*)(F.ws + WS_RSTD1))[row] = rstd; norm_store_fp8(v, rstd, F.in[I_N1G] + (l + 1) * D, (unsigned char*)(F.ws + WS_XN8) + (size_t)row * D, F.lane); }
            }
        }
        SEAM(pb + 10);
    }
__global__ void __launch_bounds__(NWAVES * 64, 2) fwd_kernel(Args args) {
    extern __shared__ __attribute__((aligned(16))) unsigned char lds_raw[];
    Frame F;
    F.lds = (LAS unsigned char*)lds_raw; F.misc = F.lds + MISC_OFF;
    F.tid = threadIdx.x; F.lane = F.tid & 63; F.wave = __builtin_amdgcn_readfirstlane(F.tid >> 6);
    F.G = gridDim.x; { const int bx = blockIdx.x; F.vcu = (F.G % 8 == 0) ? (bx % 8) * (F.G / 8) + bx / 8 : bx; }
    F.gw = F.vcu * NWAVES + F.wave; F.NGW = F.G * NWAVES;
    F.in = args.in; F.out = args.out; F.ws = args.ws; F.ctl = (unsigned*)(args.ws + WS_CTL);
    F.Z = (bf16*)(args.ws + WS_Z); F.XN = (bf16*)(args.ws + WS_XN); F.OCAT = (bf16*)(args.ws + WS_OCAT); F.MERGED = (bf16*)(args.ws + WS_MERGED);
    F.XS = (bf16*)(args.ws + WS_XS); F.Y = (bf16*)(args.ws + WS_Y); F.H = (bf16*)(args.ws + WS_H);
    F.S = (float*)(args.ws + WS_S); F.GO = (float*)(args.ws + WS_GO); F.MASK = (unsigned*)(args.ws + WS_MASK);
    const int lo = args.ph_lo, hi = args.ph_hi;
    const bool use_bar = (hi - lo) > 1;
    for (int u = F.tid; u < 64; u += NWAVES * 64) ((LAS unsigned*)F.misc)[u] = 0u;
    ((LAS unsigned long long*)(F.misc + MO_SS))[F.tid] = 0ull;
    for (int i = F.tid; i < 2 * 4 * 128; i += NWAVES * 64) { const int l_ = i >> 9, k_ = (i >> 7) & 3, d_ = i & 127; ((LAS float*)(F.misc + MO_GN))[i] = F.in[k_ == 0 ? I_AQG : (k_ == 1 ? I_AKG : (k_ == 2 ? I_BQG : I_BKG))][l_ * 128 + d_]; }
    for (int i = F.tid; i < 12 * 129; i += NWAVES * 64) { const int hd = i / 129, dd = i % 129; int bk;
        if (dd < 16) bk = dd; else { bk = 16 + (int)(logf((float)dd / 16.0f) / 2.0794415416798357f * 16.0f); bk = bk > 31 ? 31 : bk; }
        ((LAS float*)(F.misc + MO_TAB2))[i] = F.in[I_RELB][bk * 12 + hd] * 1.4426950408889634f; }
    __syncthreads();
    XcdBarrier bar; bar.bar = F.ctl + CW_BAR; bar.x = 0; bar.st = nullptr;
    if (use_bar) bar = xcd_barrier_post(F.ctl + CW_BAR, (volatile LAS unsigned*)(F.misc + MO_BARW));

    if (IN(0)) { PHASE_LANE();
        LAS float* scr = (LAS float*)(F.lds + F.wave * 16384);
        constexpr int I_IN = (2048 / 64) * (D_IN / 32);
        constexpr int I_BA = (512 / 64) * (2048 / 32), I_BB = (1024 / 64) * (2048 / 32), I_BC = I_BA, I_O = (2048 / 64) * (2048 / 32);
        constexpr int PER_L = I_IN + I_BA + I_BB + I_BC + I_O;
        for (int it = F.gw; it < DEPTH * PER_L; it += F.NGW) {
            const int l = it / PER_L; int r = it % PER_L;
            bf16* win = (bf16*)(F.ws + WS_WIN + l * WIN_L); bf16* wbr = (bf16*)(F.ws + WS_WBR + l * WBR_L); bf16* wo = (bf16*)(F.ws + WS_WO + l * WO_L);
            if (r < I_IN) { const int nb_ = r % (D_IN / 32);
                const bool has8 = nb_ < 56 || (nb_ >= 58 && nb_ <= 106) || nb_ >= 122, hasb = (nb_ >= 56 && nb_ <= 58) || (nb_ >= 106 && nb_ <= 122) || nb_ == 138;
                if (has8) transpose_item_fp8(F.in[I_WIN] + (size_t)l * 2048 * D_IN, D_IN, (unsigned char*)win, 2048, 64.0f, scr, r, F.lane, MapWin8{});
                if (hasb) transpose_item(F.in[I_WIN] + (size_t)l * 2048 * D_IN, D_IN, win + (size_t)12 * 1024 * 1024, 2048, 0, scr, r, F.lane, MapWinB{}, F.in[I_N1G] + l * D);
                continue; } r -= I_IN;
            if (r < I_BA) { transpose_item(F.in[I_WBA] + (size_t)l * 512 * 2048, 2048, wbr, 2048, 0, scr, r, F.lane, MapId{0}); continue; } r -= I_BA;
            if (r < I_BB) { transpose_item(F.in[I_WBB] + (size_t)l * 1024 * 2048, 2048, wbr, 2048, 512, scr, r, F.lane, MapId{0}); continue; } r -= I_BB;
            if (r < I_BC) { transpose_item(F.in[I_WBC] + (size_t)l * 512 * 2048, 2048, wbr, 2048, 1536, scr, r, F.lane, MapId{0}); continue; } r -= I_BC;
            transpose_item(F.in[I_WO] + (size_t)l * 2048 * 2048, 2048, wo, 2048, 0, scr, r, F.lane, MapId{0});
        }
        for (int i = F.gw * 64 + F.lane; i < DEPTH * 160 * 256; i += F.NGW * 64) { const int l = i / (160 * 256), r = (i / 256) % 160, c = i % 256;
            *(v4u*)((bf16*)(F.ws + WS_WIN + l * WIN_L) + (size_t)12 * 1024 * 1024 + (size_t)(ZC_PAD - 3328 + r) * 2048 + 8 * c) = (v4u){0u, 0u, 0u, 0u}; }
        for (int i = F.gw * 64 + F.lane; i < DEPTH * 96 * 2048; i += F.NGW * 64) { const int l = i / (96 * 2048), e = (i / 2048) % 96, k = i % 2048;
            float val = 0.f; if (e < 8) val = F.in[I_WRG][(size_t)l * D * 8 + (size_t)k * 8 + e]; else if (e < 72) val = F.in[I_WRE][(size_t)l * D * 64 + (size_t)k * 64 + (e - 8)];
            val *= F.in[I_N2G][l * D + k];
            const unsigned hi = f2bf(val); const float rem = val - bf1((bf16)hi);
            ((bf16*)(F.ws + WS_WRH + l * WR_L))[e * 2048 + k] = (bf16)hi; ((bf16*)(F.ws + WS_WRL + l * WR_L))[e * 2048 + k] = (bf16)f2bf(rem); }
        for (int mrow = F.gw; mrow < T; mrow += F.NGW) { f32x4 v[8]; load_row(F.in[I_X] + (size_t)mrow * D, F.lane, v); const float rstd = row_rstd(v);
            { v2u* hw_ = (v2u*)((bf16*)(F.ws + WS_HB) + (size_t)mrow * D) + F.lane;
#pragma unroll
              for (int j = 0; j < 8; ++j) hw_[64 * j] = (v2u){pg8::cvt_pk_bf16(v[j].x, v[j].y), pg8::cvt_pk_bf16(v[j].z, v[j].w)}; }
            if (F.lane == 0) ((float*)(F.ws + WS_RSTD1))[mrow] = rstd;
            norm_store_fp8(v, rstd, F.in[I_N1G], (unsigned char*)(F.ws + WS_XN8) + (size_t)mrow * D, F.lane); }
    }
    SEAM(0);

    layer_body<0>(F, bar, lo, hi);
    layer_body<1>(F, bar, lo, hi);
}


#ifndef N_LAUNCH_MODE
#define N_LAUNCH_MODE 1
#endif
extern "C" void kernel_launch(void* const* d_in, const int* in_sizes, int n_in, void* d_out, int out_size, void* d_ws, size_t ws_size, hipStream_t stream) {
    static int grid = 0;
    if (grid == 0) {
        if (n_in != 24 || out_size != T * D || ws_size < WS_END) { fprintf(stderr, "kernel_launch: unexpected shapes (n_in %d out %d ws %zu)\n", n_in, out_size, ws_size); grid = -1; return; }
        int dev = 0, cus = 0, per_cu = 0;
        if (hipGetDevice(&dev) != hipSuccess || hipDeviceGetAttribute(&cus, hipDeviceAttributeMultiprocessorCount, dev) != hipSuccess) { grid = -1; return; }
        if (hipFuncSetAttribute((const void*)fwd_kernel, hipFuncAttributeMaxDynamicSharedMemorySize, LDS_BYTES) != hipSuccess) { fprintf(stderr, "kernel_launch: hipFuncSetAttribute failed\n"); grid = -1; return; }
        if (hipOccupancyMaxActiveBlocksPerMultiprocessor(&per_cu, (const void*)fwd_kernel, NWAVES * 64, LDS_BYTES) != hipSuccess || per_cu < 1) { fprintf(stderr, "kernel_launch: occupancy query says %d\n", per_cu); }
        (void)hipGetLastError();
        grid = cus;
    }
    if (grid < 0) return;
    (void)hipMemsetAsync((char*)d_ws + WS_CTL, 0, CTL_ZERO_BYTES, stream);
    Args a{};
    for (int i = 0; i < 24; ++i) a.in[i] = (const float*)d_in[i];
    a.out = (float*)d_out; a.ws = (unsigned char*)d_ws;
    constexpr int NPH = 1 + 11 * DEPTH;
#if N_LAUNCH_MODE == 1
    a.ph_lo = 0; a.ph_hi = NPH;
    hipLaunchKernelGGL(fwd_kernel, dim3(grid), dim3(NWAVES * 64), LDS_BYTES, stream, a);
#else
    for (int p = 0; p < NPH; ++p) { a.ph_lo = p; a.ph_hi = p + 1; hipLaunchKernelGGL(fwd_kernel, dim3(grid), dim3(NWAVES * 64), LDS_BYTES, stream, a); }
#endif
    const hipError_t le = hipPeekAtLastError();
    if (le != hipSuccess) fprintf(stderr, "kernel_launch: launch failed: %s\n", hipGetErrorName(le));
}
```

```cpp
#include <hip/hip_runtime.h>
#include <cstdio>
#include <cstdint>

__device__ __forceinline__ int lane_id() { return (int)__builtin_amdgcn_mbcnt_hi(~0u, __builtin_amdgcn_mbcnt_lo(~0u, 0u)); }
namespace pg8 {
#define PG8_LAS __attribute__((address_space(3)))
typedef unsigned short bf16_t;
typedef short bf16x8 __attribute__((ext_vector_type(8)));
typedef float f32x4 __attribute__((ext_vector_type(4)));
typedef unsigned u32x4 __attribute__((ext_vector_type(4)));
typedef unsigned u32x2 __attribute__((ext_vector_type(2)));
constexpr int BM = 256, BK = 64, HALF = 128, HTB = HALF * BK * 2  , STAGE_BYTES = 8 * HTB, NXCD = 8, WGM = 8;

__host__ __device__ __forceinline__ int lds_byte(int r, int c) { const int st = (r >> 4) * 2 + (c >> 5), rr = r & 15, cc = c & 31, ob = rr * 64 + cc * 2; return st * 1024 + (ob ^ (((ob >> 9) & 1) << 5)); }
__host__ __device__ __forceinline__ void stage_rc(int b, int& R, int& C) { const int st = b / 1024, sb = b % 1024, swz = sb ^ (((sb >> 9) & 1) << 5); R = (st >> 1) * 16 + swz / 64; C = (st & 1) * 32 + (swz % 64) / 2; }
__host__ __device__ __forceinline__ int perm32(int rho) { const int n = rho >> 4, i = rho & 15; return 8 * (i >> 2) + 4 * n + (i & 3); }

struct Unit { int pm, pn, koff, nt, seg; };
struct Gemm { const bf16_t* A; const bf16_t* Bt; int M, N, K; };

struct StaticOrder {
    static constexpr bool GATHER = false;
    int nM, nN, nwg, G, c, nt0;
    __device__ __forceinline__ int row_token(const Unit&, int) const { return 0; }
    __device__ void init(int M, int N, int K, int G_, int c_) { nM = M / BM; nN = N / BM; nwg = nM * nN; G = G_; c = c_; nt0 = K / BK; }
    __device__ bool tile(long L, Unit& u) const {
        if (L >= nwg) return false;
        int wgid = (int)L; { const int q = nwg / NXCD, r = nwg % NXCD, xcd = wgid % NXCD, off = wgid / NXCD; wgid = (xcd < r ? xcd * (q + 1) : r * (q + 1) + (xcd - r) * q) + off; }
        const int nig = WGM * nN, gid = wgid / nig, fm = gid * WGM, gsz = (nM - fm) < WGM ? (nM - fm) : WGM;
        u.pm = fm + ((wgid % nig) % gsz); u.pn = (wgid % nig) / gsz; return true;
    }
    __device__ bool next(int i, Unit& u) const { u.koff = 0; u.nt = nt0; u.seg = 0; return tile((long)i * G + c, u); }
    __device__ __forceinline__ void a_ready(const Unit&) const {}
    __device__ __forceinline__ void done(const Unit&) const {}
};
struct MergeOrder : StaticOrder {
    __device__ bool next(int i, Unit& u) const { const int rnd = i / 3, sg = i - 3 * rnd; u.seg = sg; u.koff = sg == 0 ? 0 : (sg == 1 ? 512 : 1536); u.nt = sg == 1 ? 16 : 8; return tile((long)rnd * G + c, u); }
};
struct MoeOrder {
    static constexpr bool GATHER = false;
    int total, G, c, NJ, nt0; const PG8_LAS int* tile_exp;
    __device__ bool next(int i, Unit& u) const {
        const long L = (long)i * G + c; if (L >= total) return false;
        const int R = (int)L / NJ, j = (int)L % NJ; u.pm = R; u.pn = tile_exp[R] * NJ + j; u.koff = 0; u.nt = nt0; u.seg = 0; return true;
    }
    __device__ __forceinline__ int row_token(const Unit&, int) const { return 0; }
    __device__ __forceinline__ void a_ready(const Unit&) const {}
    __device__ __forceinline__ void done(const Unit&) const {}
};
struct MoeGatherOrder : MoeOrder {
    static constexpr bool GATHER = true;
    const PG8_LAS int* pst; const PG8_LAS int* cnt; const int* liste;
    __device__ __forceinline__ int row_token(const Unit& u, int r) const {
        const int e = tile_exp[u.pm], lr = u.pm * 256 - pst[e] + r;
        return lr < cnt[e] ? liste[(size_t)e * 32768 + lr] : 0;
    }
};

typedef __bf16 bf16x2v __attribute__((ext_vector_type(2)));
typedef float f32x2v __attribute__((ext_vector_type(2)));
__device__ __forceinline__ unsigned cvt_pk_bf16(float lo, float hi) { const f32x2v v = {lo, hi}; const bf16x2v b = __builtin_convertvector(v, bf16x2v); return __builtin_bit_cast(unsigned, b); }
__device__ __forceinline__ float bflo(unsigned w) { return __uint_as_float(w << 16); }
__device__ __forceinline__ float bfhi(unsigned w) { return __uint_as_float(w & 0xffff0000u); }
__device__ __forceinline__ float sigm(float v) { return __builtin_amdgcn_rcpf(1.0f + __builtin_amdgcn_exp2f(-1.44269504f * v)); }
__device__ __forceinline__ unsigned q8x4(const f32x4 s) {
    const unsigned a = (unsigned)fminf(s[0], 255.5f), b = (unsigned)fminf(s[1], 255.5f), c = (unsigned)fminf(s[2], 255.5f), d = (unsigned)fminf(s[3], 255.5f);
    return a | (b << 8) | (c << 16) | (d << 24);
}

constexpr int ZP = 5120;
constexpr int ZC_GA = 5120, ZC_GB = 7168, ZC_GC = 9216;
constexpr size_t GT_TILE = 65536, GT_GATE = (size_t)128 * 8 * GT_TILE;

template <int PN_OFF> struct EpiInProj {
    static constexpr bool PERM = true, AFTER_DRAIN = false, CHAIN = false;
    bf16_t* O; unsigned char* GT; PG8_LAS unsigned long long* ss;
    const PG8_LAS float* gains;
    const float* rstd;
    __device__ __forceinline__ void operator()(const f32x4 (&acc)[2][2][4][2], const Unit& u, int wr, int wc, int fr, int fq) const {
        const int pn = PN_OFF ? u.pn + 13 : (u.pn < 13 ? u.pn : u.pn + 3);
        int row0 = u.pm * BM + wr * 64 + fr, col0 = pn * BM + wc * 32 + 8 * fq;
        asm volatile("" : "+v"(row0), "+v"(col0));
        const int act = pn >= 20 ? 2 : (pn >= 18 ? 1 : 0);
        const bool hn = PN_OFF == 0 && pn <= 7;
        f32x4 gn0 = (f32x4){1.f, 1.f, 1.f, 1.f}, gn1 = gn0; int lr = 0;
        if (hn) {
            lr = wr * 64 + fr; asm volatile("" : "+v"(lr));
#pragma unroll
            for (int ai = 0; ai < 2; ++ai)
#pragma unroll
                for (int m = 0; m < 4; ++m)
#pragma unroll
                    for (int bj = 0; bj < 2; ++bj) { const f32x4 a = acc[ai][bj][m][0], b = acc[ai][bj][m][1];
                        float s = (a[0] * a[0] + a[1] * a[1]) + (a[2] * a[2] + a[3] * a[3]) + (b[0] * b[0] + b[1] * b[1]) + (b[2] * b[2] + b[3] * b[3]);
                        s += __shfl_xor(s, 16); s += __shfl_xor(s, 32);
                        if (fq == 0) __hip_atomic_fetch_add(ss + (ai * HALF + m * 16 + lr) * 2 + bj, (unsigned long long)(s * 1048576.0f), __ATOMIC_RELAXED, __HIP_MEMORY_SCOPE_WORKGROUP); }
            asm volatile("s_waitcnt lgkmcnt(0)" ::: "memory"); __builtin_amdgcn_s_barrier(); asm volatile("" ::: "memory");
            const PG8_LAS float* gp = gains + (pn <= 1 ? 0 : (pn == 2 ? 128 : (pn <= 6 ? 256 : 384))) + wc * 32 + 8 * fq;
            gn0 = *(const PG8_LAS f32x4*)gp; gn1 = *(const PG8_LAS f32x4*)(gp + 4);
        }
        if (act == 2) {
            int lo16 = (wr * 4 + wc) * 8192 + (fq * 16 + fr) * 16; asm volatile("" : "+v"(lo16));
            unsigned char* gp = GT + (size_t)((pn - 20) >> 3) * GT_GATE + ((size_t)u.pm * 8 + ((pn - 20) & 7)) * GT_TILE + lo16;
#pragma unroll
            for (int ai = 0; ai < 2; ++ai)
#pragma unroll
                for (int m = 0; m < 4; ++m) { u32x4 w;
#pragma unroll
                    for (int bj = 0; bj < 2; ++bj) { const f32x4 v0 = acc[ai][bj][m][0] * (-1.44269504f * 0.015625f), v1 = acc[ai][bj][m][1] * (-1.44269504f * 0.015625f); f32x4 s0, s1;
#pragma unroll
                        for (int j = 0; j < 4; ++j) { s0[j] = __builtin_amdgcn_exp2f(v0[j]); s1[j] = __builtin_amdgcn_exp2f(v1[j]); }
                        s0 = s0 * 0.00390625f + 0.00390625f; s1 = s1 * 0.00390625f + 0.00390625f;
#pragma unroll
                        for (int j = 0; j < 4; ++j) { s0[j] = __builtin_amdgcn_rcpf(s0[j]); s1[j] = __builtin_amdgcn_rcpf(s1[j]); }
                        w[2 * bj] = q8x4(s0); w[2 * bj + 1] = q8x4(s1); }
                    *(u32x4*)(gp + (ai * 4 + m) * 1024) = w; }
            return;
        }
#pragma unroll
        for (int ai = 0; ai < 2; ++ai)
#pragma unroll
            for (int m = 0; m < 4; ++m) { bf16_t* rowp = O + (size_t)(row0 + ai * HALF + m * 16) * ZP + col0; const float rs = PN_OFF ? rstd[row0 + ai * HALF + m * 16] : 1.0f;
#pragma unroll
                for (int bj = 0; bj < 2; ++bj) { f32x4 v0 = acc[ai][bj][m][0], v1 = acc[ai][bj][m][1];
                    if (hn && !(pn == 2 && bj == 1)) { const float r = rsqrtf((float)ss[(ai * HALF + m * 16 + lr) * 2 + bj] * (0.015625f * 0.015625f / 128.0f / 1048576.0f) + 1e-6f) * 0.015625f;
                        v0 = v0 * r * gn0; v1 = v1 * r * gn1; }
                    else if (PN_OFF == 0) { v0 = v0 * 0.015625f; v1 = v1 * 0.015625f; }
                    else { v0 = v0 * rs; v1 = v1 * rs; }
                    if (act) {
#pragma unroll
                        for (int j = 0; j < 4; ++j) { v0[j] *= sigm(v0[j]); v1[j] *= sigm(v1[j]); } }
                    u32x4 w; w.x = cvt_pk_bf16(v0[0], v0[1]); w.y = cvt_pk_bf16(v0[2], v0[3]); w.z = cvt_pk_bf16(v1[0], v1[1]); w.w = cvt_pk_bf16(v1[2], v1[3]);
                    *(u32x4*)(rowp + bj * HALF) = w; } }
        if (hn) { asm volatile("s_waitcnt lgkmcnt(0)" ::: "memory"); __builtin_amdgcn_s_barrier(); asm volatile("" ::: "memory");
            ss[(wr * 4 + wc) * 64 + fq * 16 + fr] = 0ull; }
    }
};
template <int MODE = 0> struct EpiMergeT {
    static constexpr bool PERM = true, AFTER_DRAIN = false, CHAIN = true;
    const unsigned char* GT; bf16_t* O;
    __device__ __forceinline__ void operator()(f32x4 (&acc)[2][2][4][2], const Unit& u, int wr, int wc, int fr, int fq) const {
        if (MODE == 2) return;
        const int row0 = u.pm * BM + wr * 64 + fr, col0 = u.pn * BM + wc * 32 + 8 * fq;
        int lo16 = (wr * 4 + wc) * 8192 + (fq * 16 + fr) * 16; asm volatile("" : "+v"(lo16));
        const unsigned char* gp = GT + ((size_t)u.pm * 8 + u.pn) * GT_TILE + lo16;
        const size_t cn = (size_t)u.seg * GT_GATE, cd = (size_t)(u.seg == 0 ? 1 : 2) * GT_GATE;
        const bool fin = u.seg == 2;
        u32x4 gn[2][4], gd[2][4];
#pragma unroll
        for (int ai = 0; ai < 2; ++ai)
#pragma unroll
            for (int m = 0; m < 4; ++m) {
                if (MODE == 1) { gn[ai][m] = (u32x4){0x80808080u + (unsigned)u.pm, 0x80808080u, 0x80808080u, 0x80808080u}; gd[ai][m] = gn[ai][m]; } else {
                gn[ai][m] = *(const u32x4*)(gp + cn + (ai * 4 + m) * 1024); gd[ai][m] = *(const u32x4*)(gp + cd + (ai * 4 + m) * 1024); } }
#pragma unroll
        for (int ai = 0; ai < 2; ++ai)
#pragma unroll
            for (int m = 0; m < 4; ++m)
#pragma unroll
                for (int bj = 0; bj < 2; ++bj) { const size_t r = (size_t)(row0 + ai * HALF + m * 16);
#pragma unroll
                    for (int w = 0; w < 2; ++w)
#pragma unroll
                        for (int k = 0; k < 4; ++k) { const float qn = (float)((gn[ai][m][2 * bj + w] >> (8 * k)) & 0xffu) + 0.5f, qd = (float)((gd[ai][m][2 * bj + w] >> (8 * k)) & 0xffu) + 0.5f;
                            acc[ai][bj][m][w][k] *= qn * __builtin_amdgcn_rcpf(fin ? 256.0f : qd); }
                    if (fin) { const f32x4 v0 = acc[ai][bj][m][0], v1 = acc[ai][bj][m][1];
                        u32x4 w; w.x = cvt_pk_bf16(v0[0], v0[1]); w.y = cvt_pk_bf16(v0[2], v0[3]); w.z = cvt_pk_bf16(v1[0], v1[1]); w.w = cvt_pk_bf16(v1[2], v1[3]);
                        *(u32x4*)(O + r * 2048 + col0 + bj * HALF) = w; } }
    }
};
typedef EpiMergeT<0> EpiMerge;
struct EpiResid {
    static constexpr int PERM = 2; static constexpr bool AFTER_DRAIN = false, CHAIN = false;
    bf16_t* hb; unsigned char* xu; const float* gain; PG8_LAS unsigned char* stg;
    __device__ __forceinline__ void operator()(const f32x4 (&acc)[2][2][4][2], const Unit& u, int wr, int wc, int fr, int fq) const {
        int lane = fq * 16 + fr; asm volatile("" : "+v"(lane));
        PG8_LAS unsigned char* s0 = stg + (wr * 4 + wc) * 1024;
        const int r8 = lane >> 3, pc = lane & 7;
        const int offc = r8 * 128 + ((pc ^ r8) << 4);
        const int offa0 = (fr >> 3) * 8192 + (fr & 7) * 128 + ((fq ^ (fr & 7)) << 4), offa1 = (fr >> 3) * 8192 + (fr & 7) * 128 + (((4 + fq) ^ (fr & 7)) << 4);
        const int xs = 2 * (fr >> 2), offxw0 = fr * 64 + ((fq ^ xs) << 3), offxw1 = fr * 64 + (((4 + fq) ^ xs) << 3);
        const int xr = lane >> 2, xq = lane & 3, offxr = xr * 64 + (((2 * xq) ^ (2 * (xr >> 2))) << 3);
        const size_t goff = (size_t)(u.pm * BM + wr * 64 + r8) * 2048 + u.pn * BM + wc * 64 + pc * 8;
        const size_t xoff = (size_t)(u.pm * BM + wr * 64 + xr) * 2048 + u.pn * BM + wc * 64 + xq * 16;
        f32x4 gv[2][2];
#pragma unroll
        for (int bj = 0; bj < 2; ++bj)
#pragma unroll
            for (int n = 0; n < 2; ++n) gv[bj][n] = *(const f32x4*)(gain + u.pn * BM + wc * 64 + bj * 32 + 8 * fq + 4 * n);
        const f32x4 lo4 = (f32x4){-440.f, -440.f, -440.f, -440.f}, hi4 = (f32x4){440.f, 440.f, 440.f, 440.f};
#pragma unroll
        for (int ai = 0; ai < 2; ++ai) {
            u32x4 bb[4][2];
#pragma unroll
            for (int m = 0; m < 4; ++m)
#pragma unroll
                for (int j = 0; j < 2; ++j) bb[m][j] = *(const u32x4*)(hb + goff + (size_t)(ai * HALF + m * 16 + 8 * j) * 2048);
#pragma unroll
            for (int m = 0; m < 4; ++m) {
                *(PG8_LAS u32x4*)(s0 + offc) = bb[m][0]; *(PG8_LAS u32x4*)(s0 + 8192 + offc) = bb[m][1];
                asm volatile("" ::: "memory");
                const u32x4 a0 = *(const PG8_LAS u32x4*)(s0 + offa0), a1 = *(const PG8_LAS u32x4*)(s0 + offa1);
                asm volatile("" ::: "memory");
                u32x2 xw[2];
#pragma unroll
                for (int bj = 0; bj < 2; ++bj) { const u32x4 w = bj ? a1 : a0;
                    const f32x4 h0 = (f32x4){bflo(w.x), bfhi(w.x), bflo(w.y), bfhi(w.y)} + acc[ai][bj][m][0], h1 = (f32x4){bflo(w.z), bfhi(w.z), bflo(w.w), bfhi(w.w)} + acc[ai][bj][m][1];
                    u32x4 hw; hw.x = cvt_pk_bf16(h0[0], h0[1]); hw.y = cvt_pk_bf16(h0[2], h0[3]); hw.z = cvt_pk_bf16(h1[0], h1[1]); hw.w = cvt_pk_bf16(h1[2], h1[3]);
                    *(PG8_LAS u32x4*)(s0 + (bj ? offa1 : offa0)) = hw;
                    const f32x4 x0 = __builtin_elementwise_min(__builtin_elementwise_max(h0 * gv[bj][0], lo4), hi4), x1 = __builtin_elementwise_min(__builtin_elementwise_max(h1 * gv[bj][1], lo4), hi4);
                    int w0 = 0, w1 = 0;
                    w0 = __builtin_amdgcn_cvt_pk_fp8_f32(x0[0], x0[1], w0, false); w0 = __builtin_amdgcn_cvt_pk_fp8_f32(x0[2], x0[3], w0, true);
                    w1 = __builtin_amdgcn_cvt_pk_fp8_f32(x1[0], x1[1], w1, false); w1 = __builtin_amdgcn_cvt_pk_fp8_f32(x1[2], x1[3], w1, true);
                    xw[bj] = (u32x2){(unsigned)w0, (unsigned)w1}; }
                asm volatile("" ::: "memory");
                const u32x4 o0 = *(const PG8_LAS u32x4*)(s0 + offc), o1 = *(const PG8_LAS u32x4*)(s0 + 8192 + offc);
                asm volatile("" ::: "memory");
                *(PG8_LAS u32x2*)(s0 + offxw0) = xw[0]; *(PG8_LAS u32x2*)(s0 + offxw1) = xw[1];
                asm volatile("" ::: "memory");
                const u32x4 xo = *(const PG8_LAS u32x4*)(s0 + offxr);
                asm volatile("" ::: "memory");
                *(u32x4*)(hb + goff + (size_t)(ai * HALF + m * 16) * 2048) = o0; *(u32x4*)(hb + goff + (size_t)(ai * HALF + m * 16 + 8) * 2048) = o1;
                *(u32x4*)(xu + xoff + (size_t)(ai * HALF + m * 16) * 2048) = xo;
            }
        }
        asm volatile("s_waitcnt lgkmcnt(0)" ::: "memory");
    }
};
struct EpiGlu {
    static constexpr bool PERM = false, AFTER_DRAIN = false, CHAIN = false;
    bf16_t* H; const PG8_LAS int* tile_exp; const PG8_LAS int* pst; const PG8_LAS int* cnt; const int* liste; const float* rstd;
    __device__ __forceinline__ void operator()(const f32x4 (&acc)[2][2][4][2], const Unit& u, int wr, int wc, int fr, int fq) const {
        const int row0 = u.pm * BM + wr * 64 + fr, pj = u.pn & 3;
        const int e = tile_exp[u.pm], lr0 = u.pm * 256 - pst[e] + wr * 64 + fr, ce = cnt[e];
        int tok[2][4]; float rs[2][4];
#pragma unroll
        for (int ai = 0; ai < 2; ++ai)
#pragma unroll
            for (int m = 0; m < 4; ++m) { const int lr = lr0 + ai * HALF + m * 16; tok[ai][m] = lr < ce ? liste[(size_t)e * 32768 + lr] : 0; }
#pragma unroll
        for (int ai = 0; ai < 2; ++ai)
#pragma unroll
            for (int m = 0; m < 4; ++m) rs[ai][m] = rstd[tok[ai][m]] * 0.015625f;
#pragma unroll
        for (int ai = 0; ai < 2; ++ai)
#pragma unroll
            for (int m = 0; m < 4; ++m) { unsigned char* rowp = (unsigned char*)H + (size_t)(row0 + ai * HALF + m * 16) * 512; const float r = rs[ai][m];
#pragma unroll
                for (int bj = 0; bj < 2; ++bj) { const f32x4 a = acc[ai][bj][m][0] * r, b = acc[ai][bj][m][1] * r;
                    const int hc = 16 * (8 * pj + 4 * bj + wc) + 4 * fq;
                    float hv[4];
#pragma unroll
                    for (int j = 0; j < 4; ++j) hv[j] = fminf(fmaxf(a[j] * sigm(a[j]) * b[j] * 8.0f, -440.0f), 440.0f);
                    int w = 0; w = __builtin_amdgcn_cvt_pk_fp8_f32(hv[0], hv[1], w, false); w = __builtin_amdgcn_cvt_pk_fp8_f32(hv[2], hv[3], w, true);
                    *(int*)(rowp + hc) = w; } }
    }
};
struct EpiY {
    static constexpr bool PERM = true, AFTER_DRAIN = false, CHAIN = false;
    unsigned char* Y;
    __device__ __forceinline__ void operator()(const f32x4 (&acc)[2][2][4][2], const Unit& u, int wr, int wc, int fr, int fq) const {
        const int row0 = u.pm * BM + wr * 64 + fr, col0 = (u.pn & 7) * BM + wc * 32 + 8 * fq;
        const f32x4 lo4 = (f32x4){-440.f, -440.f, -440.f, -440.f}, hi4 = (f32x4){440.f, 440.f, 440.f, 440.f};
#pragma unroll
        for (int ai = 0; ai < 2; ++ai)
#pragma unroll
            for (int m = 0; m < 4; ++m) { unsigned char* rowp = Y + (size_t)(row0 + ai * HALF + m * 16) * 2048 + col0;
#pragma unroll
                for (int bj = 0; bj < 2; ++bj) {
                    const f32x4 v0 = __builtin_elementwise_min(__builtin_elementwise_max(acc[ai][bj][m][0] * 0.125f, lo4), hi4), v1 = __builtin_elementwise_min(__builtin_elementwise_max(acc[ai][bj][m][1] * 0.125f, lo4), hi4);
                    int w0 = 0, w1 = 0;
                    w0 = __builtin_amdgcn_cvt_pk_fp8_f32(v0[0], v0[1], w0, false); w0 = __builtin_amdgcn_cvt_pk_fp8_f32(v0[2], v0[3], w0, true);
                    w1 = __builtin_amdgcn_cvt_pk_fp8_f32(v1[0], v1[1], w1, false); w1 = __builtin_amdgcn_cvt_pk_fp8_f32(v1[2], v1[3], w1, true);
                    *(u32x2*)(rowp + bj * HALF) = (u32x2){(unsigned)w0, (unsigned)w1}; } }
    }
};

typedef int v4i_t __attribute__((ext_vector_type(4)));
typedef int v8i_t __attribute__((ext_vector_type(8)));
template <class Epi, class Sched, bool ALIGN_EPI = false, bool FP8 = false>
__device__ __forceinline__ void gemm_phase(PG8_LAS unsigned char* lds, const Gemm g, const Sched& S, const Epi& E) {
    int tid = threadIdx.x; asm volatile("" : "+v"(tid));
    const int wid = __builtin_amdgcn_readfirstlane(tid >> 6), lane = tid & 63, wr = wid >> 2, wc = wid & 3, fr = lane & 15, fq = lane >> 4;
    const int K = g.K;
    unsigned voffA[2], voffB[2]; int RA[2]; unsigned CA2[2];
#pragma unroll
    for (int i = 0; i < 2; ++i) { int R, C; stage_rc(tid * 16 + i * 8192, R, C); const int Rb = Epi::PERM == 2 ? ((R >> 5) * 64 + perm32(R & 31)) : (Epi::PERM ? ((R & ~31) + perm32(R & 31)) : R);
        voffA[i] = (unsigned)(R * K + C) * 2u; voffB[i] = (unsigned)(Rb * K + C) * 2u; RA[i] = R; CA2[i] = (unsigned)C * 2u; }
    unsigned gAc[2][2], gAn[2][2];
#define PG8_GOFF(dst, uu) do { _Pragma("unroll") for (int h_ = 0; h_ < 2; ++h_) _Pragma("unroll") for (int i_ = 0; i_ < 2; ++i_) dst[h_][i_] = (unsigned)S.row_token(uu, 128 * h_ + RA[i_]) * (unsigned)(K * 2) + CA2[i_]; } while (0)
#define PG8_STAGE_A(bufoff, gbase, half, garr) do { if constexpr (Sched::GATHER) PG8_STAGE(bufoff, gbase, garr); else PG8_STAGE(bufoff, (gbase) + (half) * hstep, voffA); } while (0)
    const size_t kstep = (size_t)(BK * 2);
    const size_t hstep = (size_t)HALF * K * 2;
    const size_t hstepB = Epi::PERM == 2 ? (size_t)32 * K * 2 : hstep;
    const size_t tstep = 2 * hstep;
    const unsigned ldsw = (unsigned)wid * 1024u;
    const int aoff = lds_byte(wr * 64 + fr, fq * 8), boff = lds_byte(wc * 32 + fr, fq * 8);
#define PG8_SA(b, h) (((b) * 2 + (h)) * HTB)
#define PG8_SB(b, h) ((4 + (b) * 2 + (h)) * HTB)
#define PG8_STAGE(bufoff, gbase, voff) do { _Pragma("unroll") for (int _i = 0; _i < 2; ++_i) \
        __builtin_amdgcn_global_load_lds((const unsigned*)((const char*)(gbase) + (voff)[_i]), (PG8_LAS unsigned*)(lds + (bufoff) + ldsw + _i * 8192), 16, 0, 0); } while (0)
#define PG8_LDA(dst, b, h) do { if constexpr (FP8) { _Pragma("unroll") for (int m = 0; m < 4; ++m) dst##8[m] = __builtin_shufflevector(*(const PG8_LAS v4i_t*)(lds + PG8_SA(b, h) + aoff + m * 2048), *(const PG8_LAS v4i_t*)(lds + PG8_SA(b, h) + aoff + m * 2048 + 1024), 0, 1, 2, 3, 4, 5, 6, 7); } \
        else { _Pragma("unroll") for (int m = 0; m < 4; ++m) _Pragma("unroll") for (int k = 0; k < 2; ++k) dst[m][k] = *(const PG8_LAS bf16x8*)(lds + PG8_SA(b, h) + aoff + m * 2048 + k * 1024); } } while (0)
#define PG8_LDB(dst, b, h) do { if constexpr (FP8) { _Pragma("unroll") for (int n = 0; n < 2; ++n) dst##8[n] = __builtin_shufflevector(*(const PG8_LAS v4i_t*)(lds + PG8_SB(b, h) + boff + n * 2048), *(const PG8_LAS v4i_t*)(lds + PG8_SB(b, h) + boff + n * 2048 + 1024), 0, 1, 2, 3, 4, 5, 6, 7); } \
        else { _Pragma("unroll") for (int n = 0; n < 2; ++n) _Pragma("unroll") for (int k = 0; k < 2; ++k) dst[n][k] = *(const PG8_LAS bf16x8*)(lds + PG8_SB(b, h) + boff + n * 2048 + k * 1024); } } while (0)
#define PG8_MMA(ai, bj, At, Bt) do { __builtin_amdgcn_s_setprio(1); _Pragma("unroll") for (int m = 0; m < 4; ++m) _Pragma("unroll") for (int n = 0; n < 2; ++n) { \
        if constexpr (FP8) asm volatile("v_mfma_f32_16x16x128_f8f6f4 %0, %1, %2, %0" : "+v"(acc[ai][bj][m][n]) : "v"(Bt##8[n]), "v"(At##8[m])); \
        else { _Pragma("unroll") for (int k = 0; k < 2; ++k) acc[ai][bj][m][n] = __builtin_amdgcn_mfma_f32_16x16x32_bf16(Bt[n][k], At[m][k], acc[ai][bj][m][n], 0, 0, 0); } } \
        __builtin_amdgcn_s_setprio(0); } while (0)
#define PG8_WAIT_V(n) asm volatile("s_waitcnt vmcnt(" #n ")" ::: "memory")
#define PG8_WAIT_L(n) asm volatile("s_waitcnt lgkmcnt(" #n ")" ::: "memory")
#define PG8_BAR __builtin_amdgcn_s_barrier()
#define PG8_SCHED __builtin_amdgcn_sched_barrier(0)
    Unit cur, nxt; int ui = 0;
    if (!S.next(0, cur)) return;
    f32x4 acc[2][2][4][2];
#pragma unroll
    for (int a = 0; a < 2; ++a)
#pragma unroll
        for (int b = 0; b < 2; ++b)
#pragma unroll
            for (int m = 0; m < 4; ++m)
#pragma unroll
                for (int n = 0; n < 2; ++n) acc[a][b][m][n] = (f32x4){0.f, 0.f, 0.f, 0.f};
    bf16x8 At[4][2], B0[2][2], B1[2][2]; v8i_t At8[4], B08[2], B18[2];
    const size_t tstepA = Sched::GATHER ? (size_t)0 : tstep;
    const char* cA = (const char*)g.A + (size_t)cur.pm * tstepA + (size_t)cur.koff * 2; const char* cB = (const char*)g.Bt + (size_t)cur.pn * tstep + (size_t)cur.koff * 2;
    S.a_ready(cur);
    if constexpr (Sched::GATHER) { PG8_GOFF(gAc, cur); }
    PG8_STAGE(PG8_SB(0, 0), cB, voffB); PG8_STAGE(PG8_SB(0, 1), cB + hstepB, voffB); PG8_STAGE_A(PG8_SA(0, 0), cA, 0, gAc[0]); PG8_STAGE_A(PG8_SA(0, 1), cA, 1, gAc[1]);
    if (wr == 1) PG8_BAR;
    PG8_WAIT_V(2); PG8_BAR;
    PG8_STAGE(PG8_SB(1, 0), cB + kstep, voffB); PG8_STAGE_A(PG8_SA(1, 0), cA + kstep, 0, gAc[0]); PG8_STAGE(PG8_SB(1, 1), cB + hstepB + kstep, voffB);
    PG8_WAIT_V(6); PG8_BAR;
    for (;;) {
        const bool has_next = S.next(ui + 1, nxt);
        const char* nA = has_next ? (const char*)g.A + (size_t)nxt.pm * tstepA + (size_t)nxt.koff * 2 : cA; const char* nB = has_next ? (const char*)g.Bt + (size_t)nxt.pn * tstep + (size_t)nxt.koff * 2 : cB;
        if constexpr (Sched::GATHER) { if (has_next) { PG8_GOFF(gAn, nxt); } else {
#pragma unroll
            for (int h_ = 0; h_ < 2; ++h_)
#pragma unroll
                for (int i_ = 0; i_ < 2; ++i_) gAn[h_][i_] = gAc[h_][i_]; } }
        const int nt = cur.nt;
        for (int t = 0; t < nt; t += 2) {
            const bool last = (t == nt - 2);
            const char* a1 = cA + (size_t)(t + 1) * kstep;
            const char* a2 = last ? nA : cA + (size_t)(t + 2) * kstep; const char* b2 = last ? nB : cB + (size_t)(t + 2) * kstep;
            const char* a3 = a2 + kstep; const char* b3 = b2 + kstep;
            if (last && has_next) S.a_ready(nxt);
            unsigned g2a[2][2];
            if constexpr (Sched::GATHER) {
#pragma unroll
                for (int h_ = 0; h_ < 2; ++h_)
#pragma unroll
                    for (int i_ = 0; i_ < 2; ++i_) g2a[h_][i_] = last ? gAn[h_][i_] : gAc[h_][i_]; }
            PG8_LDB(B0, 0, 0); PG8_LDB(B1, 0, 1); PG8_SCHED; PG8_LDA(At, 0, 0); PG8_STAGE_A(PG8_SA(1, 1), a1, 1, gAc[1]);
            PG8_WAIT_V(8); PG8_WAIT_L(0); PG8_BAR; PG8_MMA(0, 0, At, B0); PG8_MMA(0, 1, At, B1); PG8_BAR; PG8_SCHED;
            PG8_LDA(At, 0, 1); PG8_STAGE(PG8_SB(0, 0), b2, voffB); PG8_STAGE(PG8_SB(0, 1), b2 + hstepB, voffB); PG8_STAGE_A(PG8_SA(0, 0), a2, 0, g2a[0]);
            PG8_WAIT_V(8); PG8_WAIT_L(0); PG8_BAR; PG8_MMA(1, 0, At, B0); PG8_MMA(1, 1, At, B1); PG8_BAR; PG8_SCHED;
            PG8_LDB(B0, 1, 0); PG8_LDB(B1, 1, 1); PG8_SCHED; PG8_LDA(At, 1, 0); PG8_STAGE_A(PG8_SA(0, 1), a2, 1, g2a[1]);
            PG8_WAIT_V(8); PG8_WAIT_L(0); PG8_BAR; PG8_MMA(0, 0, At, B0); PG8_MMA(0, 1, At, B1); PG8_BAR; PG8_SCHED;
            PG8_LDA(At, 1, 1); PG8_STAGE(PG8_SB(1, 0), b3, voffB); PG8_STAGE(PG8_SB(1, 1), b3 + hstepB, voffB); PG8_STAGE_A(PG8_SA(1, 0), a3, 0, g2a[0]);
            PG8_WAIT_V(8); PG8_WAIT_L(0); PG8_BAR; PG8_MMA(1, 0, At, B0); PG8_MMA(1, 1, At, B1); PG8_BAR; PG8_SCHED;
        }
        if constexpr (ALIGN_EPI) { if (wr == 0) PG8_BAR; }
        if constexpr (FP8) asm volatile("s_nop 15\n\ts_nop 15\n\ts_nop 15\n\ts_nop 15" ::: "memory");
        E(acc, cur, wr, wc, fr, fq); S.done(cur);
        if (!has_next) break;
        if (!Epi::CHAIN || cur.seg == 2)
#pragma unroll
        for (int a = 0; a < 2; ++a)
#pragma unroll
            for (int b = 0; b < 2; ++b)
#pragma unroll
                for (int m = 0; m < 4; ++m)
#pragma unroll
                    for (int n = 0; n < 2; ++n) acc[a][b][m][n] = (f32x4){0.f, 0.f, 0.f, 0.f};
        cur = nxt; cA = nA; cB = nB; ++ui;
        if constexpr (Sched::GATHER) {
#pragma unroll
            for (int h_ = 0; h_ < 2; ++h_)
#pragma unroll
                for (int i_ = 0; i_ < 2; ++i_) gAc[h_][i_] = gAn[h_][i_]; }
        if constexpr (ALIGN_EPI) { if (wr == 1) PG8_BAR; }
    }
    PG8_WAIT_V(0);
    if constexpr (!ALIGN_EPI) { if (wr == 0) PG8_BAR; }
    PG8_BAR;
#undef PG8_SA
#undef PG8_SB
#undef PG8_STAGE_A
#undef PG8_GOFF
#undef PG8_STAGE
#undef PG8_LDA
#undef PG8_LDB
#undef PG8_MMA
#undef PG8_WAIT_V
#undef PG8_WAIT_L
#undef PG8_BAR
#undef PG8_SCHED
}
}

constexpr int NWAVES = 8;
constexpr int T = 32768, SEQ = 2048, NB = 16, D = 2048, DEPTH = 2;
constexpr int ZP = pg8::ZP;
constexpr int ZC_AQ = 0, ZC_AK = 512, ZC_AV = 640, ZC_BQ = 768, ZC_BK = 1792, ZC_BV = 2048, ZC_IQ = 2304, ZC_IK = 3328, ZC_IW = 3392, ZC_CG = 3408, ZC_PAD = 3424, ZC_CQ = 3584, ZC_CK = 3840, ZC_CV = 4096, ZC_CR = 4608;
constexpr int D_IN = 11104;
constexpr int NEXP = 64, DEXP = 512, PMAX_TILES = 320;
constexpr float EPS = 1e-6f;

constexpr size_t MiB = 1u << 20;
constexpr size_t WS_CTL = 0, CTL_ZERO_BYTES = 128 * 1024;
constexpr size_t WS_ROUTE = 2 * MiB;
constexpr size_t WS_WRH = 4 * MiB, WS_WRL = 6 * MiB, WR_L = 96 * 2048 * 2;
constexpr size_t WS_WIN = 16 * MiB, WIN_L = 44 * MiB;
constexpr size_t WS_WBR = 104 * MiB, WBR_L = 8 * MiB;
constexpr size_t WS_WO = 120 * MiB, WO_L = 8 * MiB;
constexpr size_t WS_W13 = 136 * MiB;
constexpr size_t WS_HB = 264 * MiB;
constexpr size_t WS_W2 = 392 * MiB;
constexpr size_t WS_XN = 520 * MiB;
constexpr size_t WS_OCAT = 648 * MiB;
constexpr size_t WS_MERGED = 776 * MiB;
constexpr size_t WS_Z = 904 * MiB;
constexpr size_t WS_GT = 1224 * MiB;
constexpr size_t WS_S = 1608 * MiB;
constexpr size_t WS_MASK = 1864 * MiB;
constexpr size_t WS_GO = 1872 * MiB;
constexpr size_t WS_GCS = WS_GO;
constexpr size_t WS_GDEC = 8 * MiB;
constexpr size_t WS_RSTD1 = 10 * MiB;
constexpr size_t WS_RSTD = 9 * MiB;
constexpr size_t WS_LISTE = 904 * MiB;
constexpr size_t WS_XS = 904 * MiB;
constexpr size_t WS_Y = 1224 * MiB;
constexpr size_t WS_H = 1544 * MiB;
constexpr size_t WS_WG8 = 1936 * MiB, WG8_L = 12 * MiB;
constexpr size_t WS_XN8 = WS_S;
constexpr size_t WS_END = 1936 * MiB;
constexpr int CW_BAR = 4096;
constexpr int CW_CNT = 16384, CNT_STRIDE = 32;

constexpr int RING_BYTES = 131072, MISC_OFF = RING_BYTES, LDS_BYTES = 155648;
constexpr int MO_BARW = 32, MO_GN = 256, MO_TEXP = 8192, MO_PST = 9728, MO_TOT = 9984, MO_TAB2 = 10240, MO_CNT = 16640, MO_SS = 16896;

#define GAS __attribute__((address_space(1)))
#define LAS __attribute__((address_space(3)))
typedef unsigned short bf16;
typedef unsigned v4u __attribute__((ext_vector_type(4)));
typedef unsigned v2u __attribute__((ext_vector_type(2)));
typedef float f32x4 __attribute__((ext_vector_type(4)));
#define LDS_WAIT() asm volatile("s_waitcnt lgkmcnt(0)" ::: "memory")
__device__ __forceinline__ unsigned f2bf(float f) { unsigned u = __builtin_bit_cast(unsigned, f); return (u + 0x7fffu + ((u >> 16) & 1u)) >> 16; }
__device__ __forceinline__ unsigned pk2(float lo, float hi) { return pg8::cvt_pk_bf16(lo, hi); }
__device__ __forceinline__ float bflo(unsigned w) { return __uint_as_float(w << 16); }
__device__ __forceinline__ float bfhi(unsigned w) { return __uint_as_float(w & 0xffff0000u); }
__device__ __forceinline__ float bf1(bf16 h) { return __uint_as_float(((unsigned)h) << 16); }

#define XB_TMO      128
#define XB_XCNT(j)  (256  + 64 * (j))
#define XB_XSUB(j)  (1280 + 64 * (j))
#define XB_XGEN(j)  (2304 + 64 * (j))
#define XB_TOP      3328
#define XB_TOPGEN   3392
#define XCD_BAR_WORDS 3456
#define XB_SPIN_CAP (1u << 18)
__device__ __forceinline__ unsigned xb_ld(unsigned* p)              { return __hip_atomic_load(p, __ATOMIC_RELAXED, __HIP_MEMORY_SCOPE_AGENT); }
__device__ __forceinline__ unsigned xb_add(unsigned* p, unsigned v) { return __hip_atomic_fetch_add(p, v, __ATOMIC_RELAXED, __HIP_MEMORY_SCOPE_AGENT); }
__device__ __forceinline__ unsigned xb_xcc_id() { return (unsigned)__builtin_amdgcn_s_getreg((3 << 11) | 20) & 0xFu; }
#define XB_SPIN(cond, bar) do { unsigned _sp = 0; while (cond) { __builtin_amdgcn_s_sleep(1); \
    if ((++_sp & 255u) == 0u) { if (xb_ld(&(bar)[XB_TMO])) break; if (_sp > XB_SPIN_CAP) { atomicAdd(&(bar)[XB_TMO], 1u); break; } } } } while (0)
struct XcdBarrier { unsigned* bar; unsigned x; volatile LAS unsigned* st; };
__device__ __forceinline__ XcdBarrier xcd_barrier_post(unsigned* bar, volatile LAS unsigned* st) {
    XcdBarrier b; b.bar = bar; b.x = xb_xcc_id(); b.st = st;
    if (threadIdx.x == 0) (void)xb_add(&bar[XB_XCNT(b.x)], 1u);
    return b;
}
__device__ __forceinline__ void xcd_barrier_complete(unsigned* bar, unsigned x, unsigned& nloc, unsigned& nx) {
    const unsigned G = gridDim.x * gridDim.y * gridDim.z;
    unsigned sum, cnt, mine, sp = 0u;
    for (;;) {
        sum = 0u; cnt = 0u; mine = 0u;
#pragma unroll
        for (unsigned j = 0; j < 16; ++j) { const unsigned c = xb_ld(&bar[XB_XCNT(j)]); sum += c; cnt += (c > 0u) ? 1u : 0u; mine = (j == x) ? c : mine; }
        if (sum == G) break;
        __builtin_amdgcn_s_sleep(1);
        if ((++sp & 255u) == 0u) { if (xb_ld(&bar[XB_TMO])) break; if (sp > XB_SPIN_CAP) { atomicAdd(&bar[XB_TMO], 1u); break; } }
    }
    nloc = mine > 0u ? mine : 1u; nx = cnt > 0u ? cnt : 1u;
}
__device__ __forceinline__ void xcd_barrier(const XcdBarrier& b) {
    asm volatile("s_waitcnt vmcnt(0)" ::: "memory");
    __syncthreads();
    if (threadIdx.x == 0) {
        unsigned* bar = b.bar;
        __builtin_amdgcn_s_waitcnt(0);
        unsigned nloc = b.st[0], nx = b.st[1];
        if (nloc == 0u) { xcd_barrier_complete(bar, b.x, nloc, nx); b.st[0] = nloc; b.st[1] = nx; }
        const unsigned old = xb_add(&bar[XB_XSUB(b.x)], 1u);
        const unsigned gen = old / nloc;
        if (old + 1u == (gen + 1u) * nloc) {
            __builtin_amdgcn_fence(__ATOMIC_RELEASE, "agent");
            asm volatile("s_waitcnt vmcnt(0)" ::: "memory");
            const unsigned og = xb_add(&bar[XB_TOP], 1u);
            const unsigned tg = og / nx;
            if (og + 1u == (tg + 1u) * nx) xb_add(&bar[XB_TOPGEN], 1u);
            else XB_SPIN(xb_ld(&bar[XB_TOPGEN]) == tg, bar);
            __builtin_amdgcn_fence(__ATOMIC_ACQUIRE, "agent");
            xb_add(&bar[XB_XGEN(b.x)], 1u);
            asm volatile("s_waitcnt vmcnt(0)" ::: "memory");
        } else {
            XB_SPIN(xb_ld(&bar[XB_XGEN(b.x)]) == gen, bar);
            __builtin_amdgcn_fence(__ATOMIC_ACQUIRE, "agent");
            asm volatile("s_waitcnt vmcnt(0)" ::: "memory");
        }
    }
    __syncthreads();
}

struct Args { const float* in[24]; float* out; unsigned char* ws; int ph_lo, ph_hi; };
enum { I_X = 0, I_RELB, I_N1G, I_WIN, I_AQG, I_AKG, I_BQG, I_BKG, I_SINK, I_CGW, I_CGB, I_CNG, I_WBA, I_WBB, I_WBC, I_WO, I_N2G, I_WRG, I_BRG, I_WRE, I_BRE, I_W1, I_W3, I_W2 };

struct Frame {
    LAS unsigned char* lds; LAS unsigned char* misc;
    unsigned* ctl;
    int tid, lane, wave, vcu, G, gw, NGW;
    const float* const* in; float* out; unsigned char* ws;
    bf16 *Z, *XN, *OCAT, *MERGED, *XS, *Y, *H;
    float *S, *GO; unsigned* MASK;
};

__device__ __forceinline__ float wave_sum(float v) {
#pragma unroll
    for (int o = 1; o < 64; o <<= 1) v += __shfl_xor(v, o);
    return v;
}
__device__ __forceinline__ float wave_max(float v) {
#pragma unroll
    for (int o = 1; o < 64; o <<= 1) v = fmaxf(v, __shfl_xor(v, o));
    return v;
}

template <class MAP>
__device__ __forceinline__ void transpose_item(const float* W, int N, bf16* WT, int dpitch, int koff, LAS float* scr, int item, int lane, const MAP& map, const float* kgain = nullptr) {
    const int nblk = N / 32, kb = item / nblk, nb = item % nblk, k0 = 64 * kb, n0 = 32 * nb;
    f32x4 v[8];
#pragma unroll
    for (int i = 0; i < 8; ++i) v[i] = *(const f32x4*)(W + (size_t)(k0 + 8 * i + (lane >> 3)) * N + n0 + 4 * (lane & 7));
    if (kgain) {
#pragma unroll
        for (int i = 0; i < 8; ++i) v[i] = v[i] * kgain[k0 + 8 * i + (lane >> 3)]; }
#pragma unroll
    for (int i = 0; i < 8; ++i) { LAS float* d = scr + (8 * i + (lane >> 3)) * 33 + 4 * (lane & 7); d[0] = v[i].x; d[1] = v[i].y; d[2] = v[i].z; d[3] = v[i].w; }
    LDS_WAIT(); asm volatile("" ::: "memory");
    const int c = lane & 7;
#pragma unroll
    for (int j = 0; j < 4; ++j) { const int n = (lane >> 3) + 8 * j; const LAS float* s = scr + (8 * c) * 33 + n;
        v4u o; o.x = pk2(s[0 * 33], s[1 * 33]); o.y = pk2(s[2 * 33], s[3 * 33]); o.z = pk2(s[4 * 33], s[5 * 33]); o.w = pk2(s[6 * 33], s[7 * 33]);
        const int dr_ = map(n0 + n); if (dr_ >= 0) *(v4u*)(WT + (size_t)dr_ * dpitch + koff + k0 + 8 * c) = o; }
    LDS_WAIT(); asm volatile("" ::: "memory");
}
__device__ __forceinline__ float clamp8(float v) { return fminf(fmaxf(v, -440.0f), 440.0f); }
template <class MAP>
__device__ __forceinline__ void transpose_item_fp8(const float* W, int N, unsigned char* WT, int dpitch, float scale, LAS float* scr, int item, int lane, const MAP& map) {
    const int nblk = N / 32, kb = item / nblk, nb = item % nblk, k0 = 64 * kb, n0 = 32 * nb;
    f32x4 v[8];
#pragma unroll
    for (int i = 0; i < 8; ++i) v[i] = *(const f32x4*)(W + (size_t)(k0 + 8 * i + (lane >> 3)) * N + n0 + 4 * (lane & 7));
#pragma unroll
    for (int i = 0; i < 8; ++i) { LAS float* d = scr + (8 * i + (lane >> 3)) * 33 + 4 * (lane & 7); d[0] = v[i].x; d[1] = v[i].y; d[2] = v[i].z; d[3] = v[i].w; }
    LDS_WAIT(); asm volatile("" ::: "memory");
    const int c = lane & 7;
#pragma unroll
    for (int j = 0; j < 4; ++j) { const int n = (lane >> 3) + 8 * j; const LAS float* s = scr + (8 * c) * 33 + n;
        int w0 = 0, w1 = 0;
        w0 = __builtin_amdgcn_cvt_pk_fp8_f32(clamp8(s[0 * 33] * scale), clamp8(s[1 * 33] * scale), w0, false); w0 = __builtin_amdgcn_cvt_pk_fp8_f32(clamp8(s[2 * 33] * scale), clamp8(s[3 * 33] * scale), w0, true);
        w1 = __builtin_amdgcn_cvt_pk_fp8_f32(clamp8(s[4 * 33] * scale), clamp8(s[5 * 33] * scale), w1, false); w1 = __builtin_amdgcn_cvt_pk_fp8_f32(clamp8(s[6 * 33] * scale), clamp8(s[7 * 33] * scale), w1, true);
        const int dr_ = map(n0 + n); if (dr_ >= 0) *(v2u*)(WT + (size_t)dr_ * dpitch + k0 + 8 * c) = (v2u){(unsigned)w0, (unsigned)w1}; }
    LDS_WAIT(); asm volatile("" ::: "memory");
}
struct MapId { int off; __device__ __forceinline__ int operator()(int n) const { return off + n; } };
struct MapWin {
    __device__ __forceinline__ int operator()(int n) const {
        if (n < 512) return ZC_AQ + n;
        if (n < 640) return ZC_AK + (n - 512);
        if (n < 768) return ZC_AV + (n - 640);
        if (n < 1792) return ZC_IQ + (n - 768);
        if (n < 1856) return ZC_IK + (n - 1792);
        if (n < 1872) return ZC_IW + (n - 1856);
        if (n < 2896) return ZC_BQ + (n - 1872);
        if (n < 3152) return ZC_BK + (n - 2896);
        if (n < 3408) return ZC_BV + (n - 3152);
        if (n < 3664) return ZC_CQ + (n - 3408);
        if (n < 3920) return ZC_CK + (n - 3664);
        if (n < 4432) return ZC_CV + (n - 3920);
        if (n < 4448) return ZC_CG + (n - 4432);
        if (n < 4960) return ZC_CR + (n - 4448);
        return pg8::ZC_GA + (n - 4960);
    }
};
struct MapWin8 { __device__ __forceinline__ int operator()(int n) const { const int z = MapWin{}(n); return z < 3328 ? z : (z >= 4096 ? z - 768 : -1); } };
struct MapWinB { __device__ __forceinline__ int operator()(int n) const { const int z = MapWin{}(n); return (z >= 3328 && z < 4096) ? z - 3328 : -1; } };
struct MapW13 { int sel; __device__ __forceinline__ int operator()(int n) const { return 32 * (n >> 4) + 16 * sel + (n & 15); } };

__device__ __forceinline__ void load_row(const float* row, int lane, f32x4 (&v)[8]) {
    const f32x4* xr = (const f32x4*)row + lane;
#pragma unroll
    for (int j = 0; j < 8; ++j) v[j] = xr[64 * j];
}
__device__ __forceinline__ float row_rstd(const f32x4 (&v)[8]) {
    float s = 0.f;
#pragma unroll
    for (int j = 0; j < 8; ++j) s += (v[j].x * v[j].x + v[j].y * v[j].y) + (v[j].z * v[j].z + v[j].w * v[j].w);
    return rsqrtf(wave_sum(s) * (1.0f / 2048.0f) + EPS);
}
__device__ __forceinline__ void norm_store_bf16(const f32x4 (&v)[8], float rstd, const float* g, bf16* orow, int lane) {
    const f32x4* gr = (const f32x4*)g + lane; unsigned long long* o8 = (unsigned long long*)orow + lane;
#pragma unroll
    for (int j = 0; j < 8; ++j) { const f32x4 gg = gr[64 * j];
        o8[64 * j] = (unsigned long long)pk2(v[j].x * rstd * gg.x, v[j].y * rstd * gg.y) | ((unsigned long long)pk2(v[j].z * rstd * gg.z, v[j].w * rstd * gg.w) << 32); }
}

__device__ __forceinline__ void norm_store_fp8(const f32x4 (&v)[8], float rstd, const float* g, unsigned char* orow, int lane) {
    const f32x4* gr = (const f32x4*)g + lane; unsigned* o4 = (unsigned*)orow + lane;
#pragma unroll
    for (int j = 0; j < 8; ++j) { const f32x4 gg = gr[64 * j]; int w = 0;
        w = __builtin_amdgcn_cvt_pk_fp8_f32(clamp8(v[j].x * rstd * gg.x), clamp8(v[j].y * rstd * gg.y), w, false); w = __builtin_amdgcn_cvt_pk_fp8_f32(clamp8(v[j].z * rstd * gg.z), clamp8(v[j].w * rstd * gg.w), w, true);
        o4[64 * j] = (unsigned)w; }
}
__device__ __forceinline__ void convert_moe(Frame& F, int l, int part, int nparts, int lds_off) {
    LAS float* scr = (LAS float*)(F.lds + lds_off + F.wave * 8704);
    bf16* W13 = (bf16*)(F.ws + WS_W13); bf16* W2 = (bf16*)(F.ws + WS_W2);
    constexpr int I13 = (2048 / 64) * (512 / 32);
    constexpr int I2 = (512 / 64) * (2048 / 32);
    constexpr int NIT = NEXP * (2 * I13 + I2);
    const int it_lo = (int)((long)NIT * part / nparts), it_hi = (int)((long)NIT * (part + 1) / nparts);
    for (int it = it_lo + F.gw; it < it_hi; it += F.NGW) {
        const int e = it / (2 * I13 + I2); int r = it % (2 * I13 + I2);
        if (r < I13) { transpose_item_fp8(F.in[I_W1] + ((size_t)l * NEXP + e) * 2048 * 512, 512, (unsigned char*)W13 + (size_t)e * 1024 * 2048, 2048, 64.0f, scr, r, F.lane, MapW13{0}); continue; } r -= I13;
        if (r < I13) { transpose_item_fp8(F.in[I_W3] + ((size_t)l * NEXP + e) * 2048 * 512, 512, (unsigned char*)W13 + (size_t)e * 1024 * 2048, 2048, 64.0f, scr, r, F.lane, MapW13{1}); continue; } r -= I13;
        transpose_item_fp8(F.in[I_W2] + ((size_t)l * NEXP + e) * 512 * 2048, 2048, (unsigned char*)W2 + (size_t)e * 2048 * 512, 512, 32.0f, scr, r, F.lane, MapId{0});
    }
}

typedef short bf16x8_t __attribute__((ext_vector_type(8)));
typedef float f32x16 __attribute__((ext_vector_type(16)));
typedef short s16x4 __attribute__((ext_vector_type(4)));
__device__ __forceinline__ void indexer_segment(Frame& F, int b, int qb, int tlo, int thi) {
    const int lane = F.lane, n = lane & 15, kq = lane >> 4;
    const bf16* qrow = F.Z + (size_t)(b * 2048 + 16 * qb + n) * ZP;
    bf16x8_t iqf[16][2];
#pragma unroll
    for (int h = 0; h < 16; ++h)
#pragma unroll
        for (int ks = 0; ks < 2; ++ks) iqf[h][ks] = *(const bf16x8_t*)(qrow + ZC_IQ + h * 64 + 32 * ks + 8 * kq);
    float wv[16];
    { const v4u w0 = *(const v4u*)(qrow + ZC_IW), w1 = *(const v4u*)(qrow + ZC_IW + 8);
      wv[0] = bflo(w0.x); wv[1] = bfhi(w0.x); wv[2] = bflo(w0.y); wv[3] = bfhi(w0.y); wv[4] = bflo(w0.z); wv[5] = bfhi(w0.z); wv[6] = bflo(w0.w); wv[7] = bfhi(w0.w);
      wv[8] = bflo(w1.x); wv[9] = bfhi(w1.x); wv[10] = bflo(w1.y); wv[11] = bfhi(w1.y); wv[12] = bflo(w1.z); wv[13] = bfhi(w1.z); wv[14] = bflo(w1.w); wv[15] = bfhi(w1.w); }
    const bf16* kbase = F.Z + (size_t)(b * 2048 + n) * ZP + ZC_IK + 8 * kq;
    float* srow = F.S + (size_t)(b * 2048 + 16 * qb + n) * 2048 + 4 * kq;
    bf16x8_t ka[3], kb[3];
#pragma unroll
    for (int u = 0; u < 3; ++u) { const int tt = tlo + u < thi ? tlo + u : thi - 1; ka[u] = *(const bf16x8_t*)(kbase + (size_t)(16 * tt) * ZP); kb[u] = *(const bf16x8_t*)(kbase + (size_t)(16 * tt) * ZP + 32); }
#pragma unroll 1
    for (int tile = tlo; tile < thi; tile += 3) {
#pragma unroll
        for (int u = 0; u < 3; ++u) {
            const int tt = tile + u;
            if (tt < thi) {
                f32x4 sc = (f32x4){0.f, 0.f, 0.f, 0.f};
#pragma unroll
                for (int h = 0; h < 16; ++h) {
                    f32x4 c = __builtin_amdgcn_mfma_f32_16x16x32_bf16(ka[u], iqf[h][0], (f32x4){0.f, 0.f, 0.f, 0.f}, 0, 0, 0);
                    c = __builtin_amdgcn_mfma_f32_16x16x32_bf16(kb[u], iqf[h][1], c, 0, 0, 0);
                    sc[0] += wv[h] * fmaxf(c[0], 0.f); sc[1] += wv[h] * fmaxf(c[1], 0.f); sc[2] += wv[h] * fmaxf(c[2], 0.f); sc[3] += wv[h] * fmaxf(c[3], 0.f);
                }
                *(f32x4*)(srow + 16 * tt) = sc * 0.03125f;
            }
            { const int tn = tt + 3 < thi ? tt + 3 : thi - 1; ka[u] = *(const bf16x8_t*)(kbase + (size_t)(16 * tn) * ZP); kb[u] = *(const bf16x8_t*)(kbase + (size_t)(16 * tn) * ZP + 32); }
        }
    }
}

constexpr int FA_KP = 272, FA_VP = 320;
constexpr int FA_KOFF = 0, FA_VOFF = 2 * 64 * FA_KP, FA_BYTES = FA_VOFF + 2 * 64 * FA_VP;
__device__ __forceinline__ s16x4 fa_vtr(const LAS unsigned char* p) { return __builtin_bit_cast(s16x4, __builtin_amdgcn_ds_read_tr16_b64_v4i16((LAS s16x4*)p)); }
template <int MODE>
__device__ __forceinline__ void flash_unit(Frame& F, int l, int b, int g, int t0) {
    const int tid = F.tid, lane = F.lane, wave = F.wave, hh = wave & 3, qh = wave >> 2, r = lane & 31, hf = lane >> 5;
    const int qcol = (MODE == 0 ? ZC_AQ : ZC_BQ + 512 * g) + 128 * hh, kcol = MODE == 0 ? ZC_AK : ZC_BK + 128 * g, vcol = MODE == 0 ? ZC_AV : ZC_BV + 128 * g;
    const int ocol = (MODE == 0 ? 0 : 512 + 512 * g) + 128 * hh, hd = (MODE == 0 ? 0 : 4 + 4 * g) + hh;
    const int tq = t0 + 32 * qh + r; const size_t qrow = (size_t)(b * 2048 + tq);
    const LAS float* tab2 = (const LAS float*)(F.misc + MO_TAB2) + hd * 129;
    LAS unsigned char* lds = F.lds;
    bf16x8_t qf[8];
#pragma unroll
    for (int ks = 0; ks < 8; ++ks) qf[ks] = *(const bf16x8_t*)(F.Z + qrow * ZP + qcol + 16 * ks + 8 * hf);
    f32x16 oacc[4];
#pragma unroll
    for (int dt = 0; dt < 4; ++dt)
#pragma unroll
        for (int i = 0; i < 16; ++i) oacc[dt][i] = 0.f;
    float m_run = -1e30f, l_run = 0.f;
    const int tile_lo = MODE == 0 ? 0 : (t0 >= 128 ? t0 / 64 - 2 : 0), tile_hi = t0 / 64 + 1;
    const int skey = tid >> 4, sdc = tid & 15;
    v4u kreg[2], vreg[2];
    { const bf16* zr = F.Z + (size_t)(b * 2048 + 64 * tile_lo + skey) * ZP;
#pragma unroll
      for (int i = 0; i < 2; ++i) { kreg[i] = *(const v4u*)(zr + (size_t)(32 * i) * ZP + kcol + 8 * sdc); vreg[i] = *(const v4u*)(zr + (size_t)(32 * i) * ZP + vcol + 8 * sdc); } }
    const float sc2 = 0.08838834764831845f * 1.4426950408889634f;
    unsigned mwn[2] = {0xffffffffu, 0xffffffffu};
    if (MODE == 0) { mwn[0] = F.MASK[qrow * 64 + 2 * tile_lo]; mwn[1] = F.MASK[qrow * 64 + 2 * tile_lo + 1]; }
#pragma unroll 1
    for (int kt = tile_lo; kt < tile_hi; ++kt) {
        const int bf = (kt - tile_lo) & 1, s0 = 64 * kt;
        LAS unsigned char* kb = lds + FA_KOFF + bf * (64 * FA_KP); LAS unsigned char* vb = lds + FA_VOFF + bf * (64 * FA_VP);
#pragma unroll
        for (int i = 0; i < 2; ++i) { *(LAS v4u*)(kb + (skey + 32 * i) * FA_KP + 16 * sdc) = kreg[i]; *(LAS v4u*)(vb + (skey + 32 * i) * FA_VP + 16 * sdc) = vreg[i]; }
        __syncthreads();
        if (kt + 1 < tile_hi) { const bf16* zr = F.Z + (size_t)(b * 2048 + 64 * (kt + 1) + skey) * ZP;
#pragma unroll
            for (int i = 0; i < 2; ++i) { kreg[i] = *(const v4u*)(zr + (size_t)(32 * i) * ZP + kcol + 8 * sdc); vreg[i] = *(const v4u*)(zr + (size_t)(32 * i) * ZP + vcol + 8 * sdc); } }
        unsigned mw[2] = {mwn[0], mwn[1]};
        if (MODE == 0 && kt + 1 < tile_hi) { mwn[0] = F.MASK[qrow * 64 + 2 * (kt + 1)]; mwn[1] = F.MASK[qrow * 64 + 2 * (kt + 1) + 1]; }
        f32x16 sacc[2];
#pragma unroll
        for (int k2 = 0; k2 < 2; ++k2) {
#pragma unroll
            for (int i = 0; i < 16; ++i) sacc[k2][i] = 0.f;
#pragma unroll
            for (int ks = 0; ks < 8; ++ks) { const bf16x8_t kf = *(const LAS bf16x8_t*)(kb + (32 * k2 + r) * FA_KP + (16 * ks + 8 * hf) * 2);
                sacc[k2] = __builtin_amdgcn_mfma_f32_32x32x16_bf16(kf, qf[ks], sacc[k2], 0, 0, 0); }
        }
        float mx = -1e30f;
        if (MODE == 0 && s0 + 63 + 128 <= t0) {
            const float bfar = tab2[128];
#pragma unroll
            for (int k2 = 0; k2 < 2; ++k2)
#pragma unroll
                for (int i = 0; i < 16; ++i) { const int cr = (i & 3) + 8 * (i >> 2) + 4 * hf;
                    const float v = ((mw[k2] >> cr) & 1u) ? sacc[k2][i] * sc2 + bfar : -__builtin_inff();
                    sacc[k2][i] = v; mx = fmaxf(mx, v); }
        } else
#pragma unroll
        for (int k2 = 0; k2 < 2; ++k2)
#pragma unroll
            for (int i = 0; i < 16; ++i) { const int cr = (i & 3) + 8 * (i >> 2) + 4 * hf; const int dist = tq - (s0 + 32 * k2 + cr);
                bool ok; if (MODE == 0) ok = (mw[k2] >> cr) & 1u; else ok = dist >= 0 && dist < 128;
                const int di = dist < 0 ? 0 : (dist > 128 ? 128 : dist);
                float vf = sacc[k2][i] * sc2 + tab2[di];
                asm volatile("" : "+v"(vf));
                const float v = ok ? vf : -__builtin_inff();
                sacc[k2][i] = v; mx = fmaxf(mx, v); }
        { const auto sw_ = __builtin_amdgcn_permlane32_swap(__float_as_uint(mx), __float_as_uint(mx), false, false); mx = fmaxf(__uint_as_float(sw_[0]), __uint_as_float(sw_[1])); }
        const float m_cand = fmaxf(m_run, mx), m_new = (m_cand - m_run > 8.0f) ? m_cand : m_run, alpha = __builtin_amdgcn_exp2f(m_run - m_new); m_run = m_new;
        float ps = 0.f;
#pragma unroll
        for (int k2 = 0; k2 < 2; ++k2)
#pragma unroll
            for (int i = 0; i < 16; ++i) { const float p = __builtin_amdgcn_exp2f(sacc[k2][i] - m_new); sacc[k2][i] = p; ps += p; }
        l_run = l_run * alpha + ps;
        if (__ballot(alpha != 1.0f)) {
#pragma unroll
        for (int dt = 0; dt < 4; ++dt)
#pragma unroll
            for (int i = 0; i < 16; ++i) oacc[dt][i] *= alpha;
        }
#pragma unroll
        for (int k2 = 0; k2 < 2; ++k2)
#pragma unroll
            for (int s2 = 0; s2 < 2; ++s2) {
                v4u pw; pw.x = pg8::cvt_pk_bf16(sacc[k2][8 * s2 + 0], sacc[k2][8 * s2 + 1]); pw.y = pg8::cvt_pk_bf16(sacc[k2][8 * s2 + 2], sacc[k2][8 * s2 + 3]);
                pw.z = pg8::cvt_pk_bf16(sacc[k2][8 * s2 + 4], sacc[k2][8 * s2 + 5]); pw.w = pg8::cvt_pk_bf16(sacc[k2][8 * s2 + 6], sacc[k2][8 * s2 + 7]);
                const bf16x8_t pb = __builtin_bit_cast(bf16x8_t, pw);
                const int i16 = lane & 15, grp = (lane >> 4) & 1;
                const LAS unsigned char* vp = vb + (32 * k2 + 16 * s2 + 4 * hf + (i16 >> 2)) * FA_VP + (16 * grp + 4 * (i16 & 3)) * 2;
#pragma unroll
                for (int dt = 0; dt < 4; ++dt) { const s16x4 lo = fa_vtr(vp + 64 * dt), hi = fa_vtr(vp + 8 * FA_VP + 64 * dt);
                    const bf16x8_t vf = __builtin_shufflevector(lo, hi, 0, 1, 2, 3, 4, 5, 6, 7);
                    oacc[dt] = __builtin_amdgcn_mfma_f32_32x32x16_bf16(vf, pb, oacc[dt], 0, 0, 0); }
            }
    }
    float l_tot = l_run + __shfl_xor(l_run, 32);
    if (MODE == 1) l_tot += __builtin_amdgcn_exp2f(F.in[I_SINK][l * 8 + hd - 4] * 1.4426950408889634f - m_run);
    const float inv = 1.0f / l_tot;
    bf16* orow = F.OCAT + qrow * 2048 + ocol + 8 * hf;
#pragma unroll
    for (int dt = 0; dt < 4; ++dt)
#pragma unroll
        for (int gp = 0; gp < 2; ++gp) { const int g0 = 2 * gp, g1 = 2 * gp + 1;
            const unsigned ax = pk2(oacc[dt][4 * g0] * inv, oacc[dt][4 * g0 + 1] * inv), ay = pk2(oacc[dt][4 * g0 + 2] * inv, oacc[dt][4 * g0 + 3] * inv);
            const unsigned bx = pk2(oacc[dt][4 * g1] * inv, oacc[dt][4 * g1 + 1] * inv), by = pk2(oacc[dt][4 * g1 + 2] * inv, oacc[dt][4 * g1 + 3] * inv);
            const auto sx = __builtin_amdgcn_permlane32_swap(ax, bx, false, false), sy = __builtin_amdgcn_permlane32_swap(ay, by, false, false);
            *(v4u*)(orow + 32 * dt + 16 * gp) = (v4u){sx[0], sy[0], sx[1], sy[1]}; }
    __syncthreads();
}


#define GLA_GATE_PREFIX(LDS_TOT) \
        float la[8]; \
        _Pragma("unroll") for (int i = 0; i < 8; ++i) { const v4u c0 = rc0[i], c1 = rc1[i]; float x = gb; \
            x += bflo(c0.x) * gwv[0] + bfhi(c0.x) * gwv[1] + bflo(c0.y) * gwv[2] + bfhi(c0.y) * gwv[3] + bflo(c0.z) * gwv[4] + bfhi(c0.z) * gwv[5] + bflo(c0.w) * gwv[6] + bfhi(c0.w) * gwv[7]; \
            x += bflo(c1.x) * gwv[8] + bfhi(c1.x) * gwv[9] + bflo(c1.y) * gwv[10] + bfhi(c1.y) * gwv[11] + bflo(c1.z) * gwv[12] + bfhi(c1.z) * gwv[13] + bflo(c1.w) * gwv[14] + bfhi(c1.w) * gwv[15]; \
            la[i] = (fminf(x, 0.f) - __logf(1.0f + __expf(-fabsf(x)))) * 0.0625f; } \
        _Pragma("unroll") for (int i = 1; i < 8; ++i) la[i] += la[i - 1]; \
        ((LAS float*)(L + LDS_TOT))[cg * 64 + dk] = la[7];
#define GLA_OFFSETS(LDS_TOT) \
        float off = 0.f, tot = 0.f; \
        _Pragma("unroll") for (int g2 = 0; g2 < 8; ++g2) { const float tv = ((const LAS float*)(L + LDS_TOT))[g2 * 64 + dk]; tot += tv; off += g2 < cg ? tv : 0.f; }

__device__ __forceinline__ void gla_state_phase(Frame& F, int l) {
    const int tid = F.tid, lane = F.lane, wave = F.wave, r = lane & 31, hf = lane >> 5, i16 = lane & 15, grp = (lane >> 4) & 1;
    LAS unsigned char* L = F.lds;
    constexpr int KDT = 0, VT = 9216, TOT = 29696, RP = 144, VP = 320;
    const int dk = lane, cg = wave;
    float* GCS = (float*)(F.ws + WS_GCS); float* GDEC = (float*)(F.ws + WS_GDEC);
    v4u rc0[8], rc1[8], rv[2]; unsigned short rk[8];
#define GLS_LOAD(u_) do { const int bh_ = (u_) >> 5, n_ = (u_) & 31; const size_t r0_ = (size_t)((bh_ >> 2) * 2048 + 64 * n_); const int h_ = bh_ & 3; \
        _Pragma("unroll") for (int i = 0; i < 8; ++i) { const bf16* zr = F.Z + (r0_ + 8 * cg + i) * ZP; rc0[i] = *(const v4u*)(zr + ZC_CG); rc1[i] = *(const v4u*)(zr + ZC_CG + 8); rk[i] = zr[ZC_CK + h_ * 64 + dk]; } \
        _Pragma("unroll") for (int i = 0; i < 2; ++i) rv[i] = *(const v4u*)(F.Z + (r0_ + (tid >> 4) + 32 * i) * ZP + ZC_CV + h_ * 128 + 8 * (tid & 15)); } while (0)
    int u = F.vcu;
    if (u < 2048) GLS_LOAD(u);
    int hcur = -1; float gwv[16]; float gb = 0.f;
#pragma unroll
    for (int q = 0; q < 16; ++q) gwv[q] = 0.f;
    for (; u < 2048; u += F.G) {
        const int h = (u >> 5) & 3;
        if (h != hcur) { hcur = h;
#pragma unroll
            for (int q = 0; q < 16; ++q) gwv[q] = F.in[I_CGW][(size_t)l * 4096 + q * 256 + h * 64 + dk];
            gb = F.in[I_CGB][l * 256 + h * 64 + dk]; }
        GLA_GATE_PREFIX(TOT)
        float kv[8];
#pragma unroll
        for (int i = 0; i < 8; ++i) kv[i] = bf1(rk[i]);
#pragma unroll
        for (int i = 0; i < 2; ++i) *(LAS v4u*)(L + VT + ((tid >> 4) + 32 * i) * VP + 16 * (tid & 15)) = rv[i];
        __syncthreads();
        GLA_OFFSETS(TOT)
        { float kd[8];
#pragma unroll
          for (int i = 0; i < 8; ++i) kd[i] = kv[i] * __expf(tot - (off + la[i]));
          v4u w; w.x = pk2(kd[0], kd[1]); w.y = pk2(kd[2], kd[3]); w.z = pk2(kd[4], kd[5]); w.w = pk2(kd[6], kd[7]); *(LAS v4u*)(L + KDT + dk * RP + 16 * cg) = w; }
        if (cg == 0) GDEC[(size_t)u * 64 + dk] = __expf(tot);
        __syncthreads();
        if (u + F.G < 2048) GLS_LOAD(u + F.G);
        { const int dkt = wave >> 2, dvt = wave & 3;
          f32x16 cs;
#pragma unroll
          for (int i = 0; i < 16; ++i) cs[i] = 0.f;
#pragma unroll
          for (int ks = 0; ks < 4; ++ks) { const bf16x8_t a = *(const LAS bf16x8_t*)(L + KDT + (32 * dkt + r) * RP + (16 * ks + 8 * hf) * 2);
              const LAS unsigned char* vp = L + VT + (16 * ks + 8 * hf + (i16 >> 2)) * VP + (32 * dvt + 16 * grp + 4 * (i16 & 3)) * 2;
              const s16x4 lo = fa_vtr(vp), hi = fa_vtr(vp + 4 * VP);
              cs = __builtin_amdgcn_mfma_f32_32x32x16_bf16(a, __builtin_shufflevector(lo, hi, 0, 1, 2, 3, 4, 5, 6, 7), cs, 0, 0, 0); }
          float* gp = GCS + (size_t)u * 8192 + (size_t)(32 * dkt + 4 * hf) * 128 + 32 * dvt + r;
#pragma unroll
          for (int i = 0; i < 16; ++i) gp[((i & 3) + 8 * (i >> 2)) * 128] = cs[i]; }
        __syncthreads();
    }
#undef GLS_LOAD
}

__device__ __forceinline__ void gla_scan_phase(Frame& F) {
    float* GCS = (float*)(F.ws + WS_GCS); const float* GDEC = (const float*)(F.ws + WS_GDEC);
    for (int gt = F.gw * 64 + F.lane; gt < 64 * 2048; gt += F.NGW * 64) {
        const int bh = gt >> 11, e4 = gt & 2047, dk = e4 >> 5;
        f32x4* p = (f32x4*)(GCS + (size_t)bh * 32 * 8192) + e4; const float* dp = GDEC + (size_t)bh * 32 * 64 + dk;
        f32x4 st = (f32x4){0.f, 0.f, 0.f, 0.f};
#pragma unroll 1
        for (int n0 = 0; n0 < 32; n0 += 8) {
            f32x4 cs[8]; float dc[8];
#pragma unroll
            for (int j = 0; j < 8; ++j) { cs[j] = p[(size_t)(n0 + j) * 2048]; dc[j] = dp[(n0 + j) * 64]; }
#pragma unroll
            for (int j = 0; j < 8; ++j) { p[(size_t)(n0 + j) * 2048] = st; st = st * dc[j] + cs[j]; }
        }
    }
}

__device__ __forceinline__ void gla_out_phase(Frame& F, int l) {
    const int tid = F.tid, lane = F.lane, wave = F.wave, r = lane & 31, hf = lane >> 5, i16 = lane & 15, grp = (lane >> 4) & 1;
    LAS unsigned char* L = F.lds;
    constexpr int QG = 0, KG = 9216, VT = 18432, PT = 38912, TOT = 59392, OT = 61440, RP = 144, VP = 320, OP = 132;
    const int dk = lane, cg = wave;
    const float* GCS = (const float*)(F.ws + WS_GCS);
    v4u rc0[8], rc1[8], rv[2]; unsigned short rq[8], rk[8]; unsigned rg[8]; f32x4 rp[4];
#define GLO_LOAD(u_) do { const int bh_ = (u_) >> 5, n_ = (u_) & 31; const size_t r0_ = (size_t)((bh_ >> 2) * 2048 + 64 * n_); const int h_ = bh_ & 3; \
        _Pragma("unroll") for (int i = 0; i < 8; ++i) { const bf16* zr = F.Z + (r0_ + 8 * cg + i) * ZP; rc0[i] = *(const v4u*)(zr + ZC_CG); rc1[i] = *(const v4u*)(zr + ZC_CG + 8); rq[i] = zr[ZC_CQ + h_ * 64 + dk]; rk[i] = zr[ZC_CK + h_ * 64 + dk]; \
            rg[i] = *(const unsigned*)(zr + ZC_CR + h_ * 128 + 2 * lane); } \
        _Pragma("unroll") for (int i = 0; i < 2; ++i) rv[i] = *(const v4u*)(F.Z + (r0_ + (tid >> 4) + 32 * i) * ZP + ZC_CV + h_ * 128 + 8 * (tid & 15)); \
        _Pragma("unroll") for (int i = 0; i < 4; ++i) rp[i] = *(const f32x4*)(GCS + (size_t)(u_) * 8192 + (size_t)(tid >> 3) * 128 + 16 * (tid & 7) + 4 * i); } while (0)
    int u = F.vcu;
    if (u < 2048) GLO_LOAD(u);
    const float g0 = F.in[I_CNG][l * 128 + 2 * lane], g1 = F.in[I_CNG][l * 128 + 2 * lane + 1];
    int hcur = -1; float gwv[16]; float gb = 0.f;
#pragma unroll
    for (int q = 0; q < 16; ++q) gwv[q] = 0.f;
    for (; u < 2048; u += F.G) {
        const int bh = u >> 5, n = u & 31, h = bh & 3; const size_t row0 = (size_t)((bh >> 2) * 2048 + 64 * n);
        if (h != hcur) { hcur = h;
#pragma unroll
            for (int q = 0; q < 16; ++q) gwv[q] = F.in[I_CGW][(size_t)l * 4096 + q * 256 + h * 64 + dk];
            gb = F.in[I_CGB][l * 256 + h * 64 + dk]; }
        GLA_GATE_PREFIX(TOT)
        float qv[8], kv[8]; unsigned gr[8];
#pragma unroll
        for (int i = 0; i < 8; ++i) { qv[i] = bf1(rq[i]); kv[i] = bf1(rk[i]); gr[i] = rg[i]; }
#pragma unroll
        for (int i = 0; i < 2; ++i) *(LAS v4u*)(L + VT + ((tid >> 4) + 32 * i) * VP + 16 * (tid & 15)) = rv[i];
        { v4u w0, w1; w0.x = pk2(rp[0].x, rp[0].y); w0.y = pk2(rp[0].z, rp[0].w); w0.z = pk2(rp[1].x, rp[1].y); w0.w = pk2(rp[1].z, rp[1].w);
          w1.x = pk2(rp[2].x, rp[2].y); w1.y = pk2(rp[2].z, rp[2].w); w1.z = pk2(rp[3].x, rp[3].y); w1.w = pk2(rp[3].z, rp[3].w);
          *(LAS v4u*)(L + PT + (tid >> 3) * VP + 32 * (tid & 7)) = w0; *(LAS v4u*)(L + PT + (tid >> 3) * VP + 32 * (tid & 7) + 16) = w1; }
        __syncthreads();
        GLA_OFFSETS(TOT)
#pragma unroll
        for (int i = 0; i < 8; ++i) { const float bi = off + la[i];
            *(LAS bf16*)(L + QG + (8 * cg + i) * RP + 2 * dk) = (bf16)f2bf(qv[i] * 0.125f * __expf(bi));
            *(LAS bf16*)(L + KG + (8 * cg + i) * RP + 2 * dk) = (bf16)f2bf(kv[i] * __expf(-bi)); }
        __syncthreads();
        if (u + F.G < 2048) GLO_LOAD(u + F.G);
        { const int ct = wave >> 2, dvt = wave & 3;
          f32x16 o;
#pragma unroll
          for (int i = 0; i < 16; ++i) o[i] = 0.f;
#pragma unroll
          for (int st = 0; st < 2; ++st) if (st <= ct) {
              f32x16 at;
#pragma unroll
              for (int i = 0; i < 16; ++i) at[i] = 0.f;
#pragma unroll
              for (int ks = 0; ks < 4; ++ks) { const bf16x8_t a = *(const LAS bf16x8_t*)(L + KG + (32 * st + r) * RP + (16 * ks + 8 * hf) * 2), bq = *(const LAS bf16x8_t*)(L + QG + (32 * ct + r) * RP + (16 * ks + 8 * hf) * 2);
                  at = __builtin_amdgcn_mfma_f32_32x32x16_bf16(a, bq, at, 0, 0, 0); }
              if (st == ct) {
#pragma unroll
                  for (int i = 0; i < 16; ++i) { const int cr = (i & 3) + 8 * (i >> 2) + 4 * hf; at[i] = cr <= r ? at[i] : 0.f; } }
#pragma unroll
              for (int s2 = 0; s2 < 2; ++s2) {
                  v4u pw; pw.x = pg8::cvt_pk_bf16(at[8 * s2 + 0], at[8 * s2 + 1]); pw.y = pg8::cvt_pk_bf16(at[8 * s2 + 2], at[8 * s2 + 3]); pw.z = pg8::cvt_pk_bf16(at[8 * s2 + 4], at[8 * s2 + 5]); pw.w = pg8::cvt_pk_bf16(at[8 * s2 + 6], at[8 * s2 + 7]);
                  const LAS unsigned char* vp = L + VT + (32 * st + 16 * s2 + 4 * hf + (i16 >> 2)) * VP + (32 * dvt + 16 * grp + 4 * (i16 & 3)) * 2;
                  const s16x4 lo = fa_vtr(vp), hi = fa_vtr(vp + 8 * VP);
                  o = __builtin_amdgcn_mfma_f32_32x32x16_bf16(__builtin_bit_cast(bf16x8_t, pw), __builtin_shufflevector(lo, hi, 0, 1, 2, 3, 4, 5, 6, 7), o, 0, 0, 0);
              }
          }
#pragma unroll
          for (int ks = 0; ks < 4; ++ks) { const bf16x8_t a = *(const LAS bf16x8_t*)(L + QG + (32 * ct + r) * RP + (16 * ks + 8 * hf) * 2);
              const LAS unsigned char* pp = L + PT + (16 * ks + 8 * hf + (i16 >> 2)) * VP + (32 * dvt + 16 * grp + 4 * (i16 & 3)) * 2;
              const s16x4 lo = fa_vtr(pp), hi = fa_vtr(pp + 4 * VP);
              o = __builtin_amdgcn_mfma_f32_32x32x16_bf16(a, __builtin_shufflevector(lo, hi, 0, 1, 2, 3, 4, 5, 6, 7), o, 0, 0, 0); }
          LAS float* op = (LAS float*)(L + OT) + (32 * ct + 4 * hf) * OP + 32 * dvt + r;
#pragma unroll
          for (int i = 0; i < 16; ++i) op[((i & 3) + 8 * (i >> 2)) * OP] = o[i]; }
        __syncthreads();
        { float a[8], c[8], ss[8];
#pragma unroll
          for (int i = 0; i < 8; ++i) { const LAS float* orow = (const LAS float*)(L + OT) + (8 * wave + i) * OP + 2 * lane; a[i] = orow[0]; c[i] = orow[1]; ss[i] = a[i] * a[i] + c[i] * c[i]; }
#pragma unroll
          for (int o2 = 1; o2 < 64; o2 <<= 1) {
#pragma unroll
              for (int i = 0; i < 8; ++i) ss[i] += __shfl_xor(ss[i], o2); }
#pragma unroll
          for (int i = 0; i < 8; ++i) { const float rstd = rsqrtf(ss[i] * (1.0f / 128.0f) + EPS);
              *(unsigned*)(F.OCAT + (row0 + 8 * wave + i) * 2048 + 1536 + h * 128 + 2 * lane) = pk2(a[i] * rstd * g0 * bflo(gr[i]), c[i] * rstd * g1 * bfhi(gr[i])); } }
        __syncthreads();
    }
#undef GLO_LOAD
}
#undef GLA_GATE_PREFIX
#undef GLA_OFFSETS

__device__ __forceinline__ bool in_phase(int k, int lo, int hi) { asm volatile("" : "+s"(k)); return lo <= k && k < hi; }
#define IN(k) in_phase((k), lo, hi)
#define PHASE_LANE() do { int _tz = threadIdx.x; asm volatile("" : "+v"(_tz)); F.tid = _tz; F.lane = _tz & 63; } while (0)
#define SEAM(k) do { if (IN(k) && IN((k) + 1)) xcd_barrier(bar); } while (0)
template <int l>
__device__ __forceinline__ void layer_body(Frame& F, const XcdBarrier& bar, const int lo, const int hi) {
    constexpr int pb = 1 + 11 * l;
        if (IN(pb + 0)) {
            { pg8::Gemm g{(const bf16*)(F.ws + WS_HB), (const bf16*)(F.ws + WS_WIN + l * WIN_L + 24 * MiB), T, 768, D}; pg8::StaticOrder S; S.init(T, 768, D, F.G, (int)blockIdx.x);
              pg8::EpiInProj<1> E{F.Z, F.ws + WS_GT, (LAS unsigned long long*)(F.misc + MO_SS), (const LAS float*)(F.misc + MO_GN) + l * 512, (const float*)(F.ws + WS_RSTD1)};
              pg8::gemm_phase<pg8::EpiInProj<1>, pg8::StaticOrder, true, false>(F.lds, g, S, E); }
            { pg8::Gemm g{(const bf16*)(F.ws + WS_XN8), (const bf16*)(F.ws + WS_WIN + l * WIN_L), T, 10496, D / 2}; pg8::StaticOrder S; S.init(T, 10496, D / 2, F.G, ((int)blockIdx.x + F.G / 2) % F.G);
              pg8::EpiInProj<0> E{F.Z, F.ws + WS_GT, (LAS unsigned long long*)(F.misc + MO_SS), (const LAS float*)(F.misc + MO_GN) + l * 512, (const float*)(F.ws + WS_RSTD1)};
              pg8::gemm_phase<pg8::EpiInProj<0>, pg8::StaticOrder, true, true>(F.lds, g, S, E); }
        }
        SEAM(pb + 0);
        if (IN(pb + 1)) { PHASE_LANE();
            if (F.wave & 4) convert_moe(F, l, 0, 4, 40960);
            for (int it = F.gw; it < NB * 128; it += F.NGW) {
                const int b = it >> 7, j = it & 127;
                indexer_segment(F, b, j, 0, j < 64 ? j + 1 : 64);
                if (j < 64) indexer_segment(F, b, 127 - j, 64, 128 - j);
            }
            if (!(F.wave & 4)) convert_moe(F, l, 0, 4, 40960);
            PHASE_LANE();
            gla_state_phase(F, l);
        }
        SEAM(pb + 1);
        if (IN(pb + 2)) { PHASE_LANE();
            if (F.wave & 4) convert_moe(F, l, 1, 4, 0);
            for (int row = F.gw; row < T; row += F.NGW) {
                const int t = row & 2047;
                if (t < 256) { const int nb = t + 1 - 32 * F.lane; F.MASK[(size_t)row * 64 + F.lane] = nb >= 32 ? 0xffffffffu : (nb <= 0 ? 0u : ((1u << nb) - 1u)); continue; }
                float val[32];
#pragma unroll
                for (int j = 0; j < 32; ++j) { const int s_ = 64 * j + F.lane; val[j] = F.S[(size_t)row * 2048 + (s_ < t ? s_ : t)]; }
                float vmx = -3.0e38f, vmn = 3.0e38f;
#pragma unroll
                for (int j = 0; j < 32; ++j) { const bool ok = 64 * j + F.lane <= t; val[j] = ok ? val[j] : -3.0e38f; vmx = fmaxf(vmx, val[j]); vmn = fminf(vmn, ok ? val[j] : 3.0e38f); }
#pragma unroll
                for (int o = 1; o < 64; o <<= 1) { vmx = fmaxf(vmx, __shfl_xor(vmx, o)); vmn = fminf(vmn, __shfl_xor(vmn, o)); }
                float lo = vmn, hi = vmx, thf = 0.f; bool exact = false;
#pragma unroll 1
                for (int it = 0; it < 28; ++it) { const float mid = 0.5f * (lo + hi); if (!(mid > lo && mid < hi)) break; int cnt = 0;
#pragma unroll
                    for (int j = 0; j < 32; ++j) cnt += __popcll(__ballot(val[j] >= mid));
                    if (cnt == 256) { exact = true; thf = mid; break; }
                    if (cnt > 256) lo = mid; else hi = mid; }
                unsigned th = 0u; int need = 0;
#define KEYOF(x) ({ const unsigned u_ = __float_as_uint(x); (u_ & 0x80000000u) ? ~u_ : (u_ | 0x80000000u); })
                if (!exact) {
#pragma unroll 1
                    for (int bit = 31; bit >= 0; --bit) { const unsigned cand = th | (1u << bit); int cnt = 0;
#pragma unroll
                        for (int j = 0; j < 32; ++j) cnt += __popcll(__ballot(KEYOF(val[j]) >= cand));
                        if (cnt >= 256) th = cand; }
                    int cgt = 0;
#pragma unroll
                    for (int j = 0; j < 32; ++j) cgt += __popcll(__ballot(KEYOF(val[j]) > th));
                    need = 256 - cgt;
                }
                int run = 0; unsigned myword = 0u;
#pragma unroll
                for (int j = 0; j < 32; ++j) {
                    bool sel;
                    if (exact) sel = val[j] >= thf;
                    else { const unsigned kj = KEYOF(val[j]); const bool eq = kj == th; const unsigned long long eqm = __ballot(eq);
                        const int pre = run + __popcll(eqm & ((1ull << F.lane) - 1ull)); sel = (kj > th) || (eq && pre < need); run += __popcll(eqm); sel = sel && (64 * j + F.lane <= t); }
                    const unsigned long long sm = __ballot(sel);
                    if ((F.lane >> 1) == j) myword = (F.lane & 1) ? (unsigned)(sm >> 32) : (unsigned)sm;
                }
#undef KEYOF
                F.MASK[(size_t)row * 64 + F.lane] = myword;
            }
            if (!(F.wave & 4)) convert_moe(F, l, 1, 4, 0);
            gla_scan_phase(F);
        }
        SEAM(pb + 2);
        if (IN(pb + 3)) { PHASE_LANE();
            if (F.vcu & 1) { convert_moe(F, l, 1, 2, 0); __syncthreads(); PHASE_LANE(); }
            for (int u = F.vcu; u < NB * 16; u += F.G) { const int b = u >> 4, p = u & 15; flash_unit<0>(F, l, b, 0, 64 * (31 - p)); flash_unit<0>(F, l, b, 0, 64 * p); }
            for (int u = F.vcu; u < NB * 2 * 32; u += F.G) { const int b = u >> 6, g = (u >> 5) & 1, qb = u & 31; flash_unit<1>(F, l, b, g, 64 * qb); }
            gla_out_phase(F, l);
            if (!(F.vcu & 1)) { PHASE_LANE(); convert_moe(F, l, 1, 2, 0); }
        }
        SEAM(pb + 3);
        if (IN(pb + 4)) {
            pg8::Gemm g{F.OCAT, (const bf16*)(F.ws + WS_WBR + l * WBR_L), T, D, D}; pg8::MergeOrder S; S.init(T, D, D, F.G, (int)blockIdx.x);
#ifdef PROBE_MERGE
            { pg8::EpiMergeT<PROBE_MERGE> E{F.ws + WS_GT, (bf16*)(F.ws + WS_S)}; pg8::gemm_phase<pg8::EpiMergeT<PROBE_MERGE>, pg8::MergeOrder, true>(F.lds, g, S, E); }
#endif
            pg8::EpiMerge E{F.ws + WS_GT, F.MERGED};
            pg8::gemm_phase<pg8::EpiMerge, pg8::MergeOrder, true>(F.lds, g, S, E);
        }
        SEAM(pb + 4);
        if (IN(pb + 5)) {
            pg8::Gemm g{F.MERGED, (const bf16*)(F.ws + WS_WO + l * WO_L), T, D, D}; pg8::StaticOrder S; S.init(T, D, D, F.G, (int)blockIdx.x);
            pg8::EpiResid E{(bf16*)(F.ws + WS_HB), (unsigned char*)F.XN, F.in[I_N2G] + l * D, F.lds + 3 * pg8::HTB};
            pg8::gemm_phase<pg8::EpiResid, pg8::StaticOrder, true>(F.lds, g, S, E);
        }
        SEAM(pb + 5);
        if (IN(pb + 6)) { PHASE_LANE();
            unsigned* cnt = F.ctl + CW_CNT + 64 * CNT_STRIDE * l;
            const int lane = F.lane, fr = lane & 15, fq = lane >> 4;
            const int kh = F.wave & 3, tg = F.wave >> 2;
            LAS unsigned* lcnt = (LAS unsigned*)(F.misc + 21504); LAS unsigned* lbase = lcnt + 64;
            if (F.tid < NEXP) lcnt[F.tid] = 0u;
            LAS float* P = (LAS float*)F.lds;
            const bf16* wrh = (const bf16*)(F.ws + WS_WRH + l * WR_L) + (size_t)fr * 2048 + 8 * fq + 512 * kh; const bf16* wrl = (const bf16*)(F.ws + WS_WRL + l * WR_L) + (size_t)fr * 2048 + 8 * fq + 512 * kh;
            for (int unit = F.vcu; unit < T / 128; unit += F.G) {
                const bf16* hrow = (const bf16*)(F.ws + WS_HB) + (size_t)(128 * unit + 64 * tg + fr) * D + 8 * fq + 512 * kh;
                f32x4 acc[4][5];
                float ss[4];
#pragma unroll
                for (int s = 0; s < 4; ++s) { ss[s] = 0.f;
#pragma unroll
                    for (int nt = 0; nt < 5; ++nt) acc[s][nt] = (f32x4){0.f, 0.f, 0.f, 0.f}; }
#pragma unroll 2
                for (int ks = 0; ks < 16; ++ks) {
                    v4u hw[4];
#pragma unroll
                    for (int s = 0; s < 4; ++s) hw[s] = *(const v4u*)(hrow + (size_t)(16 * s) * D + 32 * ks);
#pragma unroll
                    for (int s = 0; s < 4; ++s) { const float a0 = bflo(hw[s].x), a1 = bfhi(hw[s].x), a2 = bflo(hw[s].y), a3 = bfhi(hw[s].y), a4 = bflo(hw[s].z), a5 = bfhi(hw[s].z), a6 = bflo(hw[s].w), a7 = bfhi(hw[s].w);
                        ss[s] += (a0 * a0 + a1 * a1) + (a2 * a2 + a3 * a3) + (a4 * a4 + a5 * a5) + (a6 * a6 + a7 * a7); }
#pragma unroll
                    for (int nt = 0; nt < 5; ++nt) { const bf16x8_t bh = *(const bf16x8_t*)(wrh + (size_t)(16 * nt) * 2048 + 32 * ks), bl = *(const bf16x8_t*)(wrl + (size_t)(16 * nt) * 2048 + 32 * ks);
#pragma unroll
                        for (int s = 0; s < 4; ++s) { const bf16x8_t ah = __builtin_bit_cast(bf16x8_t, hw[s]);
                            acc[s][nt] = __builtin_amdgcn_mfma_f32_16x16x32_bf16(ah, bh, acc[s][nt], 0, 0, 0);
                            acc[s][nt] = __builtin_amdgcn_mfma_f32_16x16x32_bf16(ah, bl, acc[s][nt], 0, 0, 0); } }
                }
#pragma unroll
                for (int s = 0; s < 4; ++s) { ss[s] += __shfl_xor(ss[s], 16); ss[s] += __shfl_xor(ss[s], 32); }
#define K6_PUT(slot_) do { LAS float* L_ = P + (slot_) * 2048; _Pragma("unroll") for (int s = 0; s < 4; ++s) { LAS float* Ls = L_ + s * 2048; if (fq == 0) Ls[1616 + fr] = ss[s]; \
                    _Pragma("unroll") for (int nt = 0; nt < 5; ++nt) _Pragma("unroll") for (int i = 0; i < 4; ++i) Ls[(4 * fq + i) * 100 + 16 * nt + fr] = acc[s][nt][i]; } } while (0)
#define K6_ADD(slot_) do { const LAS float* L_ = P + (slot_) * 2048; _Pragma("unroll") for (int s = 0; s < 4; ++s) { const LAS float* Ls = L_ + s * 2048; ss[s] += Ls[1616 + fr]; \
                    _Pragma("unroll") for (int nt = 0; nt < 5; ++nt) _Pragma("unroll") for (int i = 0; i < 4; ++i) acc[s][nt][i] += Ls[(4 * fq + i) * 100 + 16 * nt + fr]; } } while (0)
                if (kh >= 2) K6_PUT((kh - 2) * 8 + 4 * tg);
                __syncthreads();
                if (kh < 2) { K6_ADD(kh * 8 + 4 * tg); }
                if (kh == 1) { LDS_WAIT(); asm volatile("" ::: "memory"); K6_PUT(8 + 4 * tg); }
                __syncthreads();
                if (kh == 0) { K6_ADD(8 + 4 * tg); LDS_WAIT(); asm volatile("" ::: "memory"); K6_PUT(4 * tg); }
                __syncthreads();
#undef K6_PUT
#undef K6_ADD
                const int tile = 8 * unit + F.wave;
                LAS float* LG = P + F.wave * 2048;
                if (lane < 16) { const float ssq = LG[1616 + lane]; const float rs_ = rsqrtf(ssq * (1.0f / 2048.0f) + EPS); LG[1600 + lane] = rs_; ((float*)(F.ws + WS_RSTD))[16 * tile + lane] = rs_; }
                LDS_WAIT(); asm volatile("" ::: "memory");
                int ex0 = 0, ex1 = 0; unsigned l0 = 0u, l1 = 0u; float wt0 = 0.f, wt1 = 0.f;
                if (lane < 16) {
                    const float rstd = LG[1600 + lane]; const LAS float* lr = LG + lane * 100;
                    float lg[8]; int grp = 0; float gmax = -3.0e38f;
#pragma unroll
                    for (int e = 0; e < 8; ++e) { lg[e] = lr[e] * rstd + F.in[I_BRG][l * 8 + e]; if (lg[e] > gmax) { gmax = lg[e]; grp = e; } }
                    float gden = 0.f;
#pragma unroll
                    for (int e = 0; e < 8; ++e) gden += __expf(lg[e] - gmax);
                    const float gwt = 1.0f / gden;
                    int i0 = 0, i1 = 0; float m0 = -3.0e38f, m1 = -3.0e38f;
#pragma unroll
                    for (int e = 0; e < 8; ++e) { const float v = lr[8 + grp * 8 + e] * rstd + F.in[I_BRE][l * 64 + grp * 8 + e];
                        if (v > m0) { m1 = m0; i1 = i0; m0 = v; i0 = e; } else if (v > m1) { m1 = v; i1 = e; } }
                    const float e1 = __expf(m1 - m0); const float p0 = 1.0f / (1.0f + e1), p1 = e1 / (1.0f + e1);
                    ex0 = grp * 8 + i0; ex1 = grp * 8 + i1; wt0 = gwt * p0; wt1 = gwt * p1;
                    l0 = __hip_atomic_fetch_add(lcnt + ex0, 1u, __ATOMIC_RELAXED, __HIP_MEMORY_SCOPE_WORKGROUP); l1 = __hip_atomic_fetch_add(lcnt + ex1, 1u, __ATOMIC_RELAXED, __HIP_MEMORY_SCOPE_WORKGROUP);
                }
                LDS_WAIT(); asm volatile("" ::: "memory");
                __syncthreads();
                if (F.tid < NEXP) { const unsigned c_ = lcnt[F.tid]; lbase[F.tid] = c_ ? atomicAdd(&cnt[F.tid * CNT_STRIDE], c_) : 0u; lcnt[F.tid] = 0u; }
                LDS_WAIT(); asm volatile("" ::: "memory");
                __syncthreads();
                if (lane < 16) {
                    const int row = 16 * tile + lane;
                    const unsigned r0 = lbase[ex0] + l0, r1 = lbase[ex1] + l1;
                    unsigned* rec = (unsigned*)(F.ws + WS_ROUTE) + (size_t)row * 8;
                    rec[0] = (unsigned)ex0; rec[1] = r0; rec[2] = (unsigned)ex1; rec[3] = r1; rec[4] = __float_as_uint(wt0); rec[5] = __float_as_uint(wt1);
                    int* liste = (int*)(F.ws + WS_LISTE); liste[(size_t)ex0 * 32768 + r0] = row; liste[(size_t)ex1 * 32768 + r1] = row;
                }
                LDS_WAIT(); asm volatile("" ::: "memory");
                __syncthreads();
            }
        }
        SEAM(pb + 6);
        if (IN(pb + 7) || IN(pb + 8) || IN(pb + 9) || IN(pb + 10)) { PHASE_LANE();
            if (F.tid == 0) { const unsigned* cnt = F.ctl + CW_CNT + 64 * CNT_STRIDE * l; LAS int* texp = (LAS int*)(F.misc + MO_TEXP); LAS int* pst = (LAS int*)(F.misc + MO_PST); int tb = 0;
                for (int e = 0; e < NEXP; ++e) { const int c = (int)__hip_atomic_load(&cnt[e * CNT_STRIDE], __ATOMIC_RELAXED, __HIP_MEMORY_SCOPE_AGENT); const int nt_ = (c + 255) >> 8; pst[e] = tb * 256; ((LAS int*)(F.misc + MO_CNT))[e] = c;
                    for (int r = 0; r < nt_; ++r) texp[tb + r] = e; tb += nt_; }
                *(LAS int*)(F.misc + MO_TOT) = tb; }
            __syncthreads();
        }
        if (IN(pb + 8)) {
            pg8::Gemm g{F.XN, (const bf16*)(F.ws + WS_W13), 0, 0, D / 2};
            pg8::MoeGatherOrder S; S.total = *(const LAS int*)(F.misc + MO_TOT) * 4; S.G = F.G; S.c = F.vcu; S.NJ = 4; S.nt0 = D / 128; S.tile_exp = (const LAS int*)(F.misc + MO_TEXP);
            S.pst = (const LAS int*)(F.misc + MO_PST); S.cnt = (const LAS int*)(F.misc + MO_CNT); S.liste = (const int*)(F.ws + WS_LISTE);
            pg8::EpiGlu E{F.H, S.tile_exp, S.pst, S.cnt, S.liste, (const float*)(F.ws + WS_RSTD)};
            pg8::gemm_phase<pg8::EpiGlu, pg8::MoeGatherOrder, true, true>(F.lds, g, S, E);
        }
        SEAM(pb + 8);
        if (IN(pb + 9)) {
            pg8::Gemm g{F.H, (const bf16*)(F.ws + WS_W2), 0, 0, DEXP / 2};
            pg8::MoeOrder S{*(const LAS int*)(F.misc + MO_TOT) * 8, F.G, F.vcu, 8, DEXP / 128, (const LAS int*)(F.misc + MO_TEXP)};
            pg8::EpiY E{(unsigned char*)F.Y};
            pg8::gemm_phase<pg8::EpiY, pg8::MoeOrder, true, true>(F.lds, g, S, E);
        }
        SEAM(pb + 9);
        if (IN(pb + 10)) { PHASE_LANE();
            for (int row = F.gw; row < T; row += F.NGW) {
                const unsigned* rec = (const unsigned*)(F.ws + WS_ROUTE) + (size_t)row * 8;
                const float w0 = __uint_as_float(rec[4]) * 0.03125f, w1 = __uint_as_float(rec[5]) * 0.03125f;
                const LAS int* pst = (const LAS int*)(F.misc + MO_PST); const int p0 = pst[rec[0]] + (int)rec[1], p1 = pst[rec[2]] + (int)rec[3];
                const unsigned* y0 = (const unsigned*)((const unsigned char*)F.Y + (size_t)p0 * D) + F.lane; const unsigned* y1 = (const unsigned*)((const unsigned char*)F.Y + (size_t)p1 * D) + F.lane;
                f32x4 v[8];
                { const v2u* hr = (const v2u*)((const bf16*)(F.ws + WS_HB) + (size_t)row * D) + F.lane;
#pragma unroll
                  for (int j = 0; j < 8; ++j) { const v2u w = hr[64 * j]; v[j] = (f32x4){bflo(w.x), bfhi(w.x), bflo(w.y), bfhi(w.y)}; } }
#pragma unroll
                for (int j = 0; j < 8; ++j) { const int a = (int)y0[64 * j], c = (int)y1[64 * j];
                    const auto a01 = __builtin_amdgcn_cvt_pk_f32_fp8(a, false), a23 = __builtin_amdgcn_cvt_pk_f32_fp8(a, true), c01 = __builtin_amdgcn_cvt_pk_f32_fp8(c, false), c23 = __builtin_amdgcn_cvt_pk_f32_fp8(c, true);
                    v[j].x += w0 * a01[0] + w1 * c01[0]; v[j].y += w0 * a01[1] + w1 * c01[1]; v[j].z += w0 * a23[0] + w1 * c23[0]; v[j].w += w0 * a23[1] + w1 * c23[1]; }
                if (l + 1 < DEPTH) { v2u* hw_ = (v2u*)((bf16*)(F.ws + WS_HB) + (size_t)row * D) + F.lane;
#pragma unroll
                    for (int j = 0; j < 8; ++j) hw_[64 * j] = (v2u){pg8::cvt_pk_bf16(v[j].x, v[j].y), pg8::cvt_pk_bf16(v[j].z, v[j].w)}; }
                else { f32x4* orow = (f32x4*)(F.out + (size_t)row * D) + F.lane;
#pragma unroll
                    for (int j = 0; j < 8; ++j) orow[64 * j] = v[j]; }
                if (l + 1 < DEPTH) { const float rstd = row_rstd(v); if (F.lane == 0) ((float*)(F.ws + WS_RSTD1))[row] = rstd; norm_store_fp8(v, rstd, F.in[I_N1G] + (l + 1) * D, (unsigned char*)(F.ws + WS_XN8) + (size_t)row * D, F.lane); }
            }
        }
        SEAM(pb + 10);
    }
__global__ void __launch_bounds__(NWAVES * 64, 2) fwd_kernel(Args args) {
    extern __shared__ __attribute__((aligned(16))) unsigned char lds_raw[];
    Frame F;
    F.lds = (LAS unsigned char*)lds_raw; F.misc = F.lds + MISC_OFF;
    F.tid = threadIdx.x; F.lane = F.tid & 63; F.wave = __builtin_amdgcn_readfirstlane(F.tid >> 6);
    F.G = gridDim.x; { const int bx = blockIdx.x; F.vcu = (F.G % 8 == 0) ? (bx % 8) * (F.G / 8) + bx / 8 : bx; }
    F.gw = F.vcu * NWAVES + F.wave; F.NGW = F.G * NWAVES;
    F.in = args.in; F.out = args.out; F.ws = args.ws; F.ctl = (unsigned*)(args.ws + WS_CTL);
    F.Z = (bf16*)(args.ws + WS_Z); F.XN = (bf16*)(args.ws + WS_XN); F.OCAT = (bf16*)(args.ws + WS_OCAT); F.MERGED = (bf16*)(args.ws + WS_MERGED);
    F.XS = (bf16*)(args.ws + WS_XS); F.Y = (bf16*)(args.ws + WS_Y); F.H = (bf16*)(args.ws + WS_H);
    F.S = (float*)(args.ws + WS_S); F.GO = (float*)(args.ws + WS_GO); F.MASK = (unsigned*)(args.ws + WS_MASK);
    const int lo = args.ph_lo, hi = args.ph_hi;
    const bool use_bar = (hi - lo) > 1;
    for (int u = F.tid; u < 64; u += NWAVES * 64) ((LAS unsigned*)F.misc)[u] = 0u;
    ((LAS unsigned long long*)(F.misc + MO_SS))[F.tid] = 0ull;
    for (int i = F.tid; i < 2 * 4 * 128; i += NWAVES * 64) { const int l_ = i >> 9, k_ = (i >> 7) & 3, d_ = i & 127; ((LAS float*)(F.misc + MO_GN))[i] = F.in[k_ == 0 ? I_AQG : (k_ == 1 ? I_AKG : (k_ == 2 ? I_BQG : I_BKG))][l_ * 128 + d_]; }
    for (int i = F.tid; i < 12 * 129; i += NWAVES * 64) { const int hd = i / 129, dd = i % 129; int bk;
        if (dd < 16) bk = dd; else { bk = 16 + (int)(logf((float)dd / 16.0f) / 2.0794415416798357f * 16.0f); bk = bk > 31 ? 31 : bk; }
        ((LAS float*)(F.misc + MO_TAB2))[i] = F.in[I_RELB][bk * 12 + hd] * 1.4426950408889634f; }
    __syncthreads();
    XcdBarrier bar; bar.bar = F.ctl + CW_BAR; bar.x = 0; bar.st = nullptr;
    if (use_bar) bar = xcd_barrier_post(F.ctl + CW_BAR, (volatile LAS unsigned*)(F.misc + MO_BARW));

    if (IN(0)) { PHASE_LANE();
        LAS float* scr = (LAS float*)(F.lds + F.wave * 16384);
        constexpr int I_IN = (2048 / 64) * (D_IN / 32);
        constexpr int I_BA = (512 / 64) * (2048 / 32), I_BB = (1024 / 64) * (2048 / 32), I_BC = I_BA, I_O = (2048 / 64) * (2048 / 32);
        constexpr int PER_L = I_IN + I_BA + I_BB + I_BC + I_O;
        for (int it = F.gw; it < DEPTH * PER_L; it += F.NGW) {
            const int l = it / PER_L; int r = it % PER_L;
            bf16* win = (bf16*)(F.ws + WS_WIN + l * WIN_L); bf16* wbr = (bf16*)(F.ws + WS_WBR + l * WBR_L); bf16* wo = (bf16*)(F.ws + WS_WO + l * WO_L);
            if (r < I_IN) { const int nb_ = r % (D_IN / 32);
                const bool has8 = nb_ < 56 || (nb_ >= 58 && nb_ <= 106) || nb_ >= 122, hasb = (nb_ >= 56 && nb_ <= 58) || (nb_ >= 106 && nb_ <= 122) || nb_ == 138;
                if (has8) transpose_item_fp8(F.in[I_WIN] + (size_t)l * 2048 * D_IN, D_IN, (unsigned char*)win, 2048, 64.0f, scr, r, F.lane, MapWin8{});
                if (hasb) transpose_item(F.in[I_WIN] + (size_t)l * 2048 * D_IN, D_IN, win + (size_t)12 * 1024 * 1024, 2048, 0, scr, r, F.lane, MapWinB{}, F.in[I_N1G] + l * D);
                continue; } r -= I_IN;
            if (r < I_BA) { transpose_item(F.in[I_WBA] + (size_t)l * 512 * 2048, 2048, wbr, 2048, 0, scr, r, F.lane, MapId{0}); continue; } r -= I_BA;
            if (r < I_BB) { transpose_item(F.in[I_WBB] + (size_t)l * 1024 * 2048, 2048, wbr, 2048, 512, scr, r, F.lane, MapId{0}); continue; } r -= I_BB;
            if (r < I_BC) { transpose_item(F.in[I_WBC] + (size_t)l * 512 * 2048, 2048, wbr, 2048, 1536, scr, r, F.lane, MapId{0}); continue; } r -= I_BC;
            transpose_item(F.in[I_WO] + (size_t)l * 2048 * 2048, 2048, wo, 2048, 0, scr, r, F.lane, MapId{0});
        }
        for (int i = F.gw * 64 + F.lane; i < DEPTH * 160 * 256; i += F.NGW * 64) { const int l = i / (160 * 256), r = (i / 256) % 160, c = i % 256;
            *(v4u*)((bf16*)(F.ws + WS_WIN + l * WIN_L) + (size_t)12 * 1024 * 1024 + (size_t)(ZC_PAD - 3328 + r) * 2048 + 8 * c) = (v4u){0u, 0u, 0u, 0u}; }
        for (int i = F.gw * 64 + F.lane; i < DEPTH * 96 * 2048; i += F.NGW * 64) { const int l = i / (96 * 2048), e = (i / 2048) % 96, k = i % 2048;
            float val = 0.f; if (e < 8) val = F.in[I_WRG][(size_t)l * D * 8 + (size_t)k * 8 + e]; else if (e < 72) val = F.in[I_WRE][(size_t)l * D * 64 + (size_t)k * 64 + (e - 8)];
            val *= F.in[I_N2G][l * D + k];
            const unsigned hi = f2bf(val); const float rem = val - bf1((bf16)hi);
            ((bf16*)(F.ws + WS_WRH + l * WR_L))[e * 2048 + k] = (bf16)hi; ((bf16*)(F.ws + WS_WRL + l * WR_L))[e * 2048 + k] = (bf16)f2bf(rem); }
        for (int mrow = F.gw; mrow < T; mrow += F.NGW) { f32x4 v[8]; load_row(F.in[I_X] + (size_t)mrow * D, F.lane, v); const float rstd = row_rstd(v);
            { v2u* hw_ = (v2u*)((bf16*)(F.ws + WS_HB) + (size_t)mrow * D) + F.lane;
#pragma unroll
              for (int j = 0; j < 8; ++j) hw_[64 * j] = (v2u){pg8::cvt_pk_bf16(v[j].x, v[j].y), pg8::cvt_pk_bf16(v[j].z, v[j].w)}; }
            if (F.lane == 0) ((float*)(F.ws + WS_RSTD1))[mrow] = rstd;
            norm_store_fp8(v, rstd, F.in[I_N1G], (unsigned char*)(F.ws + WS_XN8) + (size_t)mrow * D, F.lane); }
    }
    SEAM(0);

    layer_body<0>(F, bar, lo, hi);
    layer_body<1>(F, bar, lo, hi);
}


#ifndef N_LAUNCH_MODE
#define N_LAUNCH_MODE 1
#endif
extern "C" void kernel_launch(void* const* d_in, const int* in_sizes, int n_in, void* d_out, int out_size, void* d_ws, size_t ws_size, hipStream_t stream) {
    static int grid = 0;
    if (grid == 0) {
        if (n_in != 24 || out_size != T * D || ws_size < WS_END) { fprintf(stderr, "kernel_launch: unexpected shapes (n_in %d out %d ws %zu)\n", n_in, out_size, ws_size); grid = -1; return; }
        int dev = 0, cus = 0, per_cu = 0;
        if (hipGetDevice(&dev) != hipSuccess || hipDeviceGetAttribute(&cus, hipDeviceAttributeMultiprocessorCount, dev) != hipSuccess) { grid = -1; return; }
        if (hipFuncSetAttribute((const void*)fwd_kernel, hipFuncAttributeMaxDynamicSharedMemorySize, LDS_BYTES) != hipSuccess) { fprintf(stderr, "kernel_launch: hipFuncSetAttribute failed\n"); grid = -1; return; }
        if (hipOccupancyMaxActiveBlocksPerMultiprocessor(&per_cu, (const void*)fwd_kernel, NWAVES * 64, LDS_BYTES) != hipSuccess || per_cu < 1) { fprintf(stderr, "kernel_launch: occupancy query says %d\n", per_cu); }
        (void)hipGetLastError();
        grid = cus;
    }
    if (grid < 0) return;
    (void)hipMemsetAsync((char*)d_ws + WS_CTL, 0, CTL_ZERO_BYTES, stream);
    Args a{};
    for (int i = 0; i < 24; ++i) a.in[i] = (const float*)d_in[i];
    a.out = (float*)d_out; a.ws = (unsigned char*)d_ws;
    constexpr int NPH = 1 + 11 * DEPTH;
#if N_LAUNCH_MODE == 1
    a.ph_lo = 0; a.ph_hi = NPH;
    hipLaunchKernelGGL(fwd_kernel, dim3(grid), dim3(NWAVES * 64), LDS_BYTES, stream, a);
#else
    for (int p = 0; p < NPH; ++p) { a.ph_lo = p; a.ph_hi = p + 1; hipLaunchKernelGGL(fwd_kernel, dim3(grid), dim3(NWAVES * 64), LDS_BYTES, stream, a); }
#endif
    const hipError_t le = hipPeekAtLastError();
    if (le != hipSuccess) fprintf(stderr, "kernel_launch: launch failed: %s\n", hipGetErrorName(le));
}
```
